# Optimizing an MI355X kernel written in HIP

```python
import math
import jax, jax.numpy as jnp
from jax import lax
import numpy as np

D_MODEL = 2048
BATCH = 2
SEQ = 16384
DEPTH = 2
DEC_BATCH = 32
DEC_SEQ = 64
PAST_LEN = 1024

CHUNK = 64
N_REC_LAYERS = (DEPTH + 1) // 2
N_ATT_LAYERS = DEPTH // 2
RMS_EPS = 1e-6

LRU_WIDTH = D_MODEL // 2
LRU_HEADS = 8
LRU_HEAD_DIM = LRU_WIDTH // LRU_HEADS
CONV_WIDTH = 4
LRU_C = 8.0
POOL_WIDTH = D_MODEL // 2
POOL_WINDOWS = (2, 4, 8, 16)
POOL_GROUPS = len(POOL_WINDOWS)
POOL_GROUP_DIM = POOL_WIDTH // POOL_GROUPS
POOL_MAX = 16
MIX_IN = 2 * LRU_WIDTH + POOL_WIDTH
MIX_OUT = LRU_WIDTH + POOL_WIDTH

MLA_HEADS = 16
Q_LORA = 512
KV_LORA = 256
NOPE_DIM = 128
ROPE_DIM = 64
V_DIM = 128
QK_DIM = NOPE_DIM + ROPE_DIM
ROPE_THETA = 10000.0
Q_BLOCK = 128

PEER_HEADS = 8
N_KEYS = 128
N_EXPERTS = N_KEYS * N_KEYS
PEER_TOPK = 16
D_KEY = 256
HALF_KEY = D_KEY // 2
PEER_BLOCK = 128

kernel_name = 'hybrid_rglru_pool_mla_peer_stream_step'


def rmsnorm(x, g):
    xf = x.astype(jnp.float32)
    y = xf * lax.rsqrt(jnp.mean(xf * xf, axis=-1, keepdims=True) + RMS_EPS)
    return (y * g.astype(jnp.float32)).astype(x.dtype)


def modulate(h, shift, scale):
    return h * (1.0 + scale[:, None, :]) + shift[:, None, :]


def causal_dwconv(u, prev, w, b):
    t = u.shape[1]
    z = jnp.concatenate([prev.astype(u.dtype), u], axis=1)
    out = b + sum(z[:, k:k + t, :] * w[k] for k in range(CONV_WIDTH))
    return out, z[:, -(CONV_WIDTH - 1):, :]


def _lin_combine(left, right):
    a_l, b_l = left
    a_r, b_r = right
    return a_r * a_l, a_r * b_l + b_r


def rg_lru(xc, h_prev, pos, w_a, b_a, w_x, b_x, lam):
    bsz, t, _ = xc.shape
    xf = xc.astype(jnp.float32)
    xh = xf.reshape(bsz, t, LRU_HEADS, LRU_HEAD_DIM)
    r = jax.nn.sigmoid(jnp.einsum('bthi,hij->bthj', xh, w_a.astype(jnp.float32)).reshape(bsz, t, LRU_WIDTH)
                       + b_a.astype(jnp.float32))
    i = jax.nn.sigmoid(jnp.einsum('bthi,hij->bthj', xh, w_x.astype(jnp.float32)).reshape(bsz, t, LRU_WIDTH)
                       + b_x.astype(jnp.float32))
    log_a = -LRU_C * r * jax.nn.softplus(-lam.astype(jnp.float32))
    a = jnp.exp(log_a)
    mult = jnp.sqrt(-jnp.expm1(2.0 * log_a))
    mult = jnp.where((pos == 0)[None, :, None], 1.0, mult)
    u = mult * (i * xf)
    u = u.at[:, 0].add(a[:, 0] * h_prev.astype(jnp.float32))
    _, h = lax.associative_scan(_lin_combine, (a, u), axis=1)
    return h, h[:, -1]


def pool_mix(u, prev, pos, w_pool, s_pool):
    bsz, t, c = u.shape
    p_len = POOL_MAX - 1
    z = jnp.concatenate([prev.astype(u.dtype), u], axis=1)
    zf = z.astype(jnp.float32)
    cs = jnp.cumsum(jnp.pad(zf, ((0, 0), (1, 0), (0, 0))), axis=1)
    end = cs[:, p_len + 1:]
    means = []
    for g, w in enumerate(POOL_WINDOWS):
        sl = slice(g * POOL_GROUP_DIM, (g + 1) * POOL_GROUP_DIM)
        start = cs[:, p_len + 1 - w:p_len + 1 - w + t, sl]
        cnt = jnp.minimum(pos + 1, w).astype(jnp.float32)[None, :, None]
        means.append((end[..., sl] - start) / cnt)
    pooled = jnp.concatenate(means, axis=-1) - u.astype(jnp.float32)
    pooled = pooled.astype(u.dtype).reshape(bsz, t, POOL_GROUPS, POOL_GROUP_DIM)
    out = jnp.einsum('btgi,gij->btgj', pooled, w_pool).reshape(bsz, t, c) * s_pool
    return out, z[:, -p_len:, :]


def apply_rope(x, pos):
    half = ROPE_DIM // 2
    inv = ROPE_THETA ** (-(jnp.arange(half, dtype=jnp.float32) / half))
    ang = pos.astype(jnp.float32)[:, None] * inv[None, :]
    shape = (1, pos.shape[0]) + (1,) * (x.ndim - 3) + (half,)
    cos = jnp.cos(ang).reshape(shape)
    sin = jnp.sin(ang).reshape(shape)
    x1 = x[..., :half].astype(jnp.float32)
    x2 = x[..., half:].astype(jnp.float32)
    return jnp.concatenate([x1 * cos - x2 * sin, x1 * sin + x2 * cos], axis=-1).astype(x.dtype)


def mla_project(h, pos, w_dq, g_q, w_uq, w_dkv, g_kv):
    bsz, t, _ = h.shape
    cq = rmsnorm(h @ w_dq, g_q)
    q = (cq @ w_uq).reshape(bsz, t, MLA_HEADS, QK_DIM)
    q_nope = q[..., :NOPE_DIM]
    q_pe = apply_rope(q[..., NOPE_DIM:], pos)
    kv = h @ w_dkv
    c_kv = rmsnorm(kv[..., :KV_LORA], g_kv)
    k_pe = apply_rope(kv[..., KV_LORA:], pos)
    return q_nope, q_pe, c_kv, k_pe


def mla_attend(q_nope, q_pe, q_pos, c_kv, k_pe, k_pos, w_ukv):
    bsz, tk, _ = c_kv.shape
    tq = q_nope.shape[1]
    kv = (c_kv @ w_ukv).reshape(bsz, tk, MLA_HEADS, NOPE_DIM + V_DIM)
    k_nope = kv[..., :NOPE_DIM]
    v = kv[..., NOPE_DIM:]
    k_chunk = k_pos // CHUNK
    scale = QK_DIM ** -0.5

    def block(args):
        qn, qp, qpos = args
        s = (jnp.einsum('bqhd,bkhd->bhqk', qn, k_nope) + jnp.einsum('bqhr,bkr->bhqk', qp, k_pe))
        s = s.astype(jnp.float32) * scale
        mask = k_chunk[None, :] <= (qpos // CHUNK)[:, None]
        s = jnp.where(mask[None, None], s, -jnp.inf)
        p = jax.nn.softmax(s, axis=-1).astype(v.dtype)
        return jnp.einsum('bhqk,bkhd->bqhd', p, v)

    if tq <= Q_BLOCK:
        return block((q_nope, q_pe, q_pos))
    nb = tq // Q_BLOCK

    def split(a):
        return jnp.moveaxis(a.reshape((a.shape[0], nb, Q_BLOCK) + a.shape[2:]), 1, 0)

    o = lax.map(block, (split(q_nope), split(q_pe), q_pos.reshape(nb, Q_BLOCK)))
    return jnp.moveaxis(o, 0, 1).reshape(bsz, tq, MLA_HEADS, V_DIM)


def peer_ffn(h, w_q, sub_keys, u_emb, v_emb):
    bsz, t, d = h.shape
    m = bsz * t
    hf = h.reshape(m, d)
    q = (hf @ w_q).reshape(m, PEER_HEADS, 2, HALF_KEY)
    s = jnp.einsum('mhpd,hpnd->mhpn', q, sub_keys).astype(jnp.float32)
    s1, i1 = lax.top_k(s[:, :, 0], PEER_TOPK)
    s2, i2 = lax.top_k(s[:, :, 1], PEER_TOPK)
    cand_s = (s1[..., :, None] + s2[..., None, :]).reshape(m, PEER_HEADS, PEER_TOPK * PEER_TOPK)
    cand_i = (i1[..., :, None] * N_KEYS + i2[..., None, :]).reshape(m, PEER_HEADS, PEER_TOPK * PEER_TOPK)
    top_s, sel = lax.top_k(cand_s, PEER_TOPK)
    idx = jnp.take_along_axis(cand_i, sel, axis=-1)
    gate = jax.nn.softmax(top_s, axis=-1)
    pad = (-m) % PEER_BLOCK
    nb = (m + pad) // PEER_BLOCK
    hp = jnp.pad(hf, ((0, pad), (0, 0))).reshape(nb, PEER_BLOCK, d)
    ip = jnp.pad(idx, ((0, pad), (0, 0), (0, 0))).reshape(nb, PEER_BLOCK, PEER_HEADS, PEER_TOPK)
    gp = jnp.pad(gate, ((0, pad), (0, 0), (0, 0))).reshape(nb, PEER_BLOCK, PEER_HEADS, PEER_TOPK)

    def block(args):
        xb, ib, gb = args
        act = jax.nn.gelu(jnp.einsum('pd,phkd->phk', xb, u_emb[ib]).astype(jnp.float32), approximate=False) * gb
        return jnp.einsum('phk,phkd->pd', act.astype(xb.dtype), v_emb[ib])

    out = lax.map(block, (hp, ip, gp))
    return out.reshape(nb * PEER_BLOCK, d)[:m].reshape(bsz, t, d)


def run_trunk(x, c, pos, past_pos, conv_prev, h_prev, pool_prev, ckv_prev, kpe_prev, w):
    bsz, t, _ = x.shape
    sc = jax.nn.silu(c.astype(jnp.float32)).astype(x.dtype)
    new_conv, new_h, new_pool, new_ckv, new_kpe = [], [], [], [], []
    for l in range(DEPTH):
        mod = sc @ w['ada_w'][l] + w['ada_b'][l]
        sh1, sc1, g1, sh2, sc2, g2 = jnp.split(mod, 6, axis=-1)
        hn = modulate(rmsnorm(x, w['norm1_g'][l]), sh1, sc1)
        if l % 2 == 0:
            r = l // 2
            z = hn @ w['rec_w_in'][r]
            gate_br = z[..., :LRU_WIDTH]
            rec_br = z[..., LRU_WIDTH:2 * LRU_WIDTH]
            pool_in = z[..., 2 * LRU_WIDTH:]
            xc, conv_s = causal_dwconv(rec_br, conv_prev[r], w['rec_conv_w'][r], w['rec_conv_b'][r])
            hseq, h_last = rg_lru(xc, h_prev[r], pos, w['rec_w_a'][r], w['rec_b_a'][r],
                                  w['rec_w_x'][r], w['rec_b_x'][r], w['rec_lambda'][r])
            a_out = jax.nn.gelu(gate_br) * hseq.astype(x.dtype)
            b_out, pool_s = pool_mix(pool_in, pool_prev[r], pos, w['pool_w'][r], w['pool_scale'][r])
            mix = jnp.concatenate([a_out, b_out], axis=-1) @ w['rec_w_out'][r]
            new_conv.append(conv_s)
            new_h.append(h_last.astype(x.dtype))
            new_pool.append(pool_s)
        else:
            a = l // 2
            q_nope, q_pe, ckv, kpe = mla_project(hn, pos, w['att_w_dq'][a], w['att_g_q'][a], w['att_w_uq'][a],
                                                 w['att_w_dkv'][a], w['att_g_kv'][a])
            ckv_all = jnp.concatenate([ckv_prev[a].astype(ckv.dtype), ckv], axis=1)
            kpe_all = jnp.concatenate([kpe_prev[a].astype(kpe.dtype), kpe], axis=1)
            k_pos = jnp.concatenate([past_pos, pos])
            o = mla_attend(q_nope, q_pe, pos, ckv_all, kpe_all, k_pos, w['att_w_ukv'][a])
            mix = o.reshape(bsz, t, MLA_HEADS * V_DIM) @ w['att_w_out'][a]
            new_ckv.append(ckv)
            new_kpe.append(kpe)
        x = x + g1[:, None, :] * mix
        hn2 = modulate(rmsnorm(x, w['norm2_g'][l]), sh2, sc2)
        x = x + g2[:, None, :] * peer_ffn(hn2, w['peer_w_q'][l], w['peer_keys'][l], w['peer_u'][l], w['peer_v'][l])
    y = rmsnorm(x, w['final_g'])
    return (y, jnp.stack(new_conv), jnp.stack(new_h), jnp.stack(new_pool), jnp.stack(new_ckv), jnp.stack(new_kpe))


def setup_inputs(seed: int = 0) -> dict:
    key = jax.random.key(seed)
    ks = iter(jax.random.split(key, 48))
    f32 = jnp.float32

    def nrm(shape, s):
        return jax.random.normal(next(ks), shape, f32) * s

    def gain(shape):
        return 1.0 + nrm(shape, 0.02)

    a8 = jax.random.uniform(next(ks), (N_REC_LAYERS, LRU_WIDTH), f32, 0.9, 0.999)
    a_base = a8 ** (1.0 / LRU_C)
    rec_lambda = jnp.log(a_base) - jnp.log1p(-a_base)
    return {
        'x_prompt': nrm((BATCH, SEQ, D_MODEL), 1.0),
        'x_sample': nrm((DEC_BATCH, DEC_SEQ, D_MODEL), 1.0),
        'c_prompt': nrm((BATCH, D_MODEL), 1.0),
        'c_sample': nrm((DEC_BATCH, D_MODEL), 1.0),
        'state_conv': nrm((N_REC_LAYERS, DEC_BATCH, CONV_WIDTH - 1, LRU_WIDTH), 1.0),
        'state_lru_h': nrm((N_REC_LAYERS, DEC_BATCH, LRU_WIDTH), 0.5),
        'state_pool': nrm((N_REC_LAYERS, DEC_BATCH, POOL_MAX - 1, POOL_WIDTH), 1.0),
        'cache_ckv': nrm((N_ATT_LAYERS, DEC_BATCH, PAST_LEN, KV_LORA), 1.0),
        'cache_kpe': nrm((N_ATT_LAYERS, DEC_BATCH, PAST_LEN, ROPE_DIM), 1.0),
        'ada_w': nrm((DEPTH, D_MODEL, 6 * D_MODEL), 0.5 * D_MODEL ** -0.5),
        'ada_b': nrm((DEPTH, 6 * D_MODEL), 0.01),
        'norm1_g': gain((DEPTH, D_MODEL)),
        'norm2_g': gain((DEPTH, D_MODEL)),
        'rec_w_in': nrm((N_REC_LAYERS, D_MODEL, MIX_IN), D_MODEL ** -0.5),
        'rec_conv_w': nrm((N_REC_LAYERS, CONV_WIDTH, LRU_WIDTH), CONV_WIDTH ** -0.5),
        'rec_conv_b': nrm((N_REC_LAYERS, LRU_WIDTH), 0.01),
        'rec_w_a': nrm((N_REC_LAYERS, LRU_HEADS, LRU_HEAD_DIM, LRU_HEAD_DIM), LRU_HEAD_DIM ** -0.5),
        'rec_b_a': nrm((N_REC_LAYERS, LRU_WIDTH), 0.1),
        'rec_w_x': nrm((N_REC_LAYERS, LRU_HEADS, LRU_HEAD_DIM, LRU_HEAD_DIM), LRU_HEAD_DIM ** -0.5),
        'rec_b_x': nrm((N_REC_LAYERS, LRU_WIDTH), 0.1),
        'rec_lambda': rec_lambda,
        'pool_w': nrm((N_REC_LAYERS, POOL_GROUPS, POOL_GROUP_DIM, POOL_GROUP_DIM), POOL_GROUP_DIM ** -0.5),
        'pool_scale': 1.0 + nrm((N_REC_LAYERS, POOL_WIDTH), 0.1),
        'rec_w_out': nrm((N_REC_LAYERS, MIX_OUT, D_MODEL), MIX_OUT ** -0.5),
        'att_w_dq': nrm((N_ATT_LAYERS, D_MODEL, Q_LORA), D_MODEL ** -0.5),
        'att_g_q': gain((N_ATT_LAYERS, Q_LORA)),
        'att_w_uq': nrm((N_ATT_LAYERS, Q_LORA, MLA_HEADS * QK_DIM), Q_LORA ** -0.5),
        'att_w_dkv': nrm((N_ATT_LAYERS, D_MODEL, KV_LORA + ROPE_DIM), D_MODEL ** -0.5),
        'att_g_kv': gain((N_ATT_LAYERS, KV_LORA)),
        'att_w_ukv': nrm((N_ATT_LAYERS, KV_LORA, MLA_HEADS * (NOPE_DIM + V_DIM)), KV_LORA ** -0.5),
        'att_w_out': nrm((N_ATT_LAYERS, MLA_HEADS * V_DIM, D_MODEL), (MLA_HEADS * V_DIM) ** -0.5),
        'peer_w_q': nrm((DEPTH, D_MODEL, PEER_HEADS * D_KEY), D_MODEL ** -0.5),
        'peer_keys': nrm((DEPTH, PEER_HEADS, 2, N_KEYS, HALF_KEY), HALF_KEY ** -0.5),
        'peer_u': nrm((DEPTH, N_EXPERTS, D_MODEL), D_MODEL ** -0.5),
        'peer_v': nrm((DEPTH, N_EXPERTS, D_MODEL), 0.25),
        'final_g': gain((D_MODEL,)),
    }


def reference(x_prompt, x_sample, c_prompt, c_sample, state_conv, state_lru_h, state_pool, cache_ckv, cache_kpe,
              ada_w, ada_b, norm1_g, norm2_g, rec_w_in, rec_conv_w, rec_conv_b, rec_w_a, rec_b_a, rec_w_x, rec_b_x,
              rec_lambda, pool_w, pool_scale, rec_w_out, att_w_dq, att_g_q, att_w_uq, att_w_dkv, att_g_kv, att_w_ukv,
              att_w_out, peer_w_q, peer_keys, peer_u, peer_v, final_g):
    w = dict(ada_w=ada_w, ada_b=ada_b, norm1_g=norm1_g, norm2_g=norm2_g, rec_w_in=rec_w_in, rec_conv_w=rec_conv_w,
             rec_conv_b=rec_conv_b, rec_w_a=rec_w_a, rec_b_a=rec_b_a, rec_w_x=rec_w_x, rec_b_x=rec_b_x,
             rec_lambda=rec_lambda, pool_w=pool_w, pool_scale=pool_scale, rec_w_out=rec_w_out, att_w_dq=att_w_dq,
             att_g_q=att_g_q, att_w_uq=att_w_uq, att_w_dkv=att_w_dkv, att_g_kv=att_g_kv, att_w_ukv=att_w_ukv,
             att_w_out=att_w_out, peer_w_q=peer_w_q, peer_keys=peer_keys, peer_u=peer_u, peer_v=peer_v,
             final_g=final_g)
    dt = x_prompt.dtype
    bp, tp, _ = x_prompt.shape
    pos_p = jnp.arange(tp, dtype=jnp.int32)
    (y_prompt, new_conv_prompt, new_h_prompt, new_pool_prompt, new_ckv_prompt, new_kpe_prompt) = run_trunk(
        x_prompt, c_prompt, pos_p, jnp.zeros((0,), jnp.int32),
        jnp.zeros((N_REC_LAYERS, bp, CONV_WIDTH - 1, LRU_WIDTH), dt),
        jnp.zeros((N_REC_LAYERS, bp, LRU_WIDTH), dt),
        jnp.zeros((N_REC_LAYERS, bp, POOL_MAX - 1, POOL_WIDTH), dt),
        jnp.zeros((N_ATT_LAYERS, bp, 0, KV_LORA), dt),
        jnp.zeros((N_ATT_LAYERS, bp, 0, ROPE_DIM), dt), w)
    past_len = cache_ckv.shape[2]
    ts = x_sample.shape[1]
    pos_s = past_len + jnp.arange(ts, dtype=jnp.int32)
    (y_sample, new_conv_sample, new_h_sample, new_pool_sample, new_ckv_sample, new_kpe_sample) = run_trunk(
        x_sample, c_sample, pos_s, jnp.arange(past_len, dtype=jnp.int32),
        state_conv, state_lru_h, state_pool, cache_ckv, cache_kpe, w)
    return (y_prompt, y_sample, new_conv_prompt, new_conv_sample, new_h_prompt, new_h_sample,
            new_pool_prompt, new_pool_sample, new_ckv_prompt, new_ckv_sample, new_kpe_prompt, new_kpe_sample)
```

```cpp
#include <hip/hip_runtime.h>
#include <cstdio>
#include <cstdint>

#define LAS __attribute__((address_space(3)))
#define GAS __attribute__((address_space(1)))
typedef unsigned short bf16_t;
typedef short bf16x8 __attribute__((ext_vector_type(8)));
typedef short s16x4 __attribute__((ext_vector_type(4)));
typedef float f32x2 __attribute__((ext_vector_type(2)));
typedef float f32x4 __attribute__((ext_vector_type(4)));
typedef float f32x16 __attribute__((ext_vector_type(16)));
typedef unsigned u32x2 __attribute__((ext_vector_type(2)));
typedef unsigned u32x4 __attribute__((ext_vector_type(4)));

constexpr int DM = 2048;
constexpr int MP = 32768, MS = 2048, MT = MP + MS;
constexpr int NSEQ = 34;
constexpr int KVROWS = MP + 32 * 1088;
constexpr float RMS_EPS = 1e-6f;

__device__ __forceinline__ int seq_of_row(int m) { return m < MP ? (m >> 14) : 2 + ((m - MP) >> 6); }
__device__ __forceinline__ int pos_of_row(int m) { return m < MP ? (m & 16383) : 1024 + ((m - MP) & 63); }
__device__ __forceinline__ int kvrow_of_row(int m) { return m < MP ? m : MP + ((m - MP) >> 6) * 1088 + 1024 + ((m - MP) & 63); }

__device__ __forceinline__ unsigned cvt_pk_bf16(float lo, float hi) { unsigned r; asm volatile("v_cvt_pk_bf16_f32 %0, %1, %2" : "=v"(r) : "v"(lo), "v"(hi)); return r; }
__device__ __forceinline__ float bf_lo(unsigned w) { return __uint_as_float(w << 16); }
__device__ __forceinline__ float bf_hi(unsigned w) { return __uint_as_float(w & 0xffff0000u); }
__device__ __forceinline__ float fexp(float x) { return __builtin_amdgcn_exp2f(x * 1.4426950408889634f); }
__device__ __forceinline__ float fsigmoid(float x) { return __builtin_amdgcn_rcpf(1.0f + __builtin_amdgcn_exp2f(-1.4426950408889634f * x)); }
__device__ __forceinline__ float gelu_tanh(float x) { const float u = x * (1.0f + 0.044715f * x * x); return x * __builtin_amdgcn_rcpf(1.0f + __builtin_amdgcn_exp2f(-2.302208198f * u)); }
__device__ __forceinline__ float gelu_erf(float v) {
    const float av = __builtin_fabsf(v), t = __builtin_amdgcn_rcpf(av * 0.2316418882f + 1.0f);
    float q = t * 0.5307027145f + (-0.7265760135f); q = q * t + 0.7107068705f; q = q * t + (-0.142248368f); q = q * t + 0.127414796f; q = q * t;
    const float e = __builtin_amdgcn_exp2f((v * v) * (-0.72134752044f));
    const float m = v * (q * e); return v < 0.f ? m : v - m;
}
__device__ __forceinline__ float wave_sum(float v) {
#pragma unroll
    for (int o = 32; o >= 1; o >>= 1) v += __shfl_xor(v, o);
    return v;
}

namespace pg8 {
constexpr int BM = 256, BK = 64, HALF = 128, HTB = HALF * BK * 2, STAGE_BYTES = 8 * HTB, NXCD = 8, WGM = 8;
__host__ __device__ __forceinline__ int lds_byte(int r, int c) { const int st = (r >> 4) * 2 + (c >> 5), rr = r & 15, cc = c & 31, ob = rr * 64 + cc * 2; return st * 1024 + (ob ^ (((ob >> 9) & 1) << 5)); }
__host__ __device__ __forceinline__ void stage_rc(int b, int& R, int& C) { const int st = b / 1024, sb = b % 1024, swz = sb ^ (((sb >> 9) & 1) << 5); R = (st >> 1) * 16 + swz / 64; C = (st & 1) * 32 + (swz % 64) / 2; }
__host__ __device__ __forceinline__ int perm32(int rho) { const int n = rho >> 4, i = rho & 15; return 8 * (i >> 2) + 4 * n + (i & 3); }

struct Unit { int pm, pn; };
struct Gemm { const bf16_t* A; const bf16_t* Bt; int M, N, K, lda, ldb, kshift, kmul; };

struct StaticOrder {
    int nM, nN, nwg, G, c;
    __host__ __device__ void init(int M, int N, int G_, int c_) { nM = M / BM; nN = N / BM; nwg = nM * nN; G = G_; c = c_; }
    __host__ __device__ bool next(int i, Unit& u) const {
        const long L = (long)i * G + c; if (L >= nwg) return false;
        int wgid = (int)L; { const int q = nwg / NXCD, r = nwg % NXCD, xcd = wgid % NXCD, off = wgid / NXCD; wgid = (xcd < r ? xcd * (q + 1) : r * (q + 1) + (xcd - r) * q) + off; }
        const int nig = WGM * nN, gid = wgid / nig, fm = gid * WGM, gsz = (nM - fm) < WGM ? (nM - fm) : WGM;
        u.pm = fm + ((wgid % nig) % gsz); u.pn = (wgid % nig) / gsz; return true;
    }
};

template <class Epi>
__device__ __forceinline__ void gemm_phase(LAS unsigned char* lds, const Gemm g, const StaticOrder& S, const Epi& E) {
    const int tid = threadIdx.x, wid = __builtin_amdgcn_readfirstlane(tid >> 6), lane = tid & 63, wr = wid >> 2, wc = wid & 3, fr = lane & 15, fq = lane >> 4;
    int Kq = g.K; asm volatile("" : "+s"(Kq));
    const int K = Kq, nt = K / BK;
    unsigned voffA[2], voffB[2];
#pragma unroll
    for (int i = 0; i < 2; ++i) { int R, C; stage_rc(tid * 16 + i * 8192, R, C); const int Rb = Epi::PERM ? ((R & ~31) + perm32(R & 31)) : R;
        voffA[i] = (unsigned)(R * g.lda + C) * 2u; voffB[i] = (unsigned)(Rb * g.ldb + C) * 2u; }
    const size_t kstep = (size_t)(BK * 2);
    const size_t hstepA = (size_t)HALF * g.lda * 2, hstepB = (size_t)HALF * g.ldb * 2;
    const unsigned ldsw = (unsigned)wid * 1024u;
    const int aoff = lds_byte(wr * 64 + fr, fq * 8), boff = lds_byte(wc * 32 + fr, fq * 8);
#define PG8_SA(b, h) (((b) * 2 + (h)) * HTB)
#define PG8_SB(b, h) ((4 + (b) * 2 + (h)) * HTB)
#define PG8_STAGE(bufoff, gbase, voff) do { _Pragma("unroll") for (int _i = 0; _i < 2; ++_i) \
        __builtin_amdgcn_global_load_lds((const unsigned*)((const char*)(gbase) + (voff)[_i]), (LAS unsigned*)(lds + (bufoff) + ldsw + _i * 8192), 16, 0, 0); } while (0)
#define PG8_LDA(dst, b, h) do { _Pragma("unroll") for (int m = 0; m < 4; ++m) _Pragma("unroll") for (int k = 0; k < 2; ++k) dst[m][k] = *(const LAS bf16x8*)(lds + PG8_SA(b, h) + aoff + m * 2048 + k * 1024); } while (0)
#define PG8_LDB(dst, b, h) do { _Pragma("unroll") for (int n = 0; n < 2; ++n) _Pragma("unroll") for (int k = 0; k < 2; ++k) dst[n][k] = *(const LAS bf16x8*)(lds + PG8_SB(b, h) + boff + n * 2048 + k * 1024); } while (0)
#define PG8_MMA(ai, bj, At, Bt) do { __builtin_amdgcn_s_setprio(1); _Pragma("unroll") for (int m = 0; m < 4; ++m) _Pragma("unroll") for (int n = 0; n < 2; ++n) _Pragma("unroll") for (int k = 0; k < 2; ++k) \
        acc[ai][bj][m][n] = __builtin_amdgcn_mfma_f32_16x16x32_bf16(Bt[n][k], At[m][k], acc[ai][bj][m][n], 0, 0, 0); __builtin_amdgcn_s_setprio(0); } while (0)
#define PG8_WAIT_V(n) asm volatile("s_waitcnt vmcnt(" #n ")" ::: "memory")
#define PG8_WAIT_L(n) asm volatile("s_waitcnt lgkmcnt(" #n ")" ::: "memory")
#define PG8_BAR __builtin_amdgcn_s_barrier()
#define PG8_SCHED __builtin_amdgcn_sched_barrier(0)
#define PG8_ABASE(u) ((const char*)g.A + (size_t)(u).pm * (2 * hstepA) + (size_t)(((u).pn >> g.kshift) * g.kmul) * 2)
#define PG8_BBASE(u) ((const char*)g.Bt + (size_t)(u).pn * (2 * hstepB))
    Unit cur, nxt; int ui = 0;
    if (!S.next(0, cur)) return;
    f32x4 acc[2][2][4][2];
#pragma unroll
    for (int a = 0; a < 2; ++a)
#pragma unroll
        for (int b = 0; b < 2; ++b)
#pragma unroll
            for (int m = 0; m < 4; ++m)
#pragma unroll
                for (int n = 0; n < 2; ++n) acc[a][b][m][n] = (f32x4){0.f, 0.f, 0.f, 0.f};
    bf16x8 At[4][2], B0[2][2], B1[2][2];
    const char* cA = PG8_ABASE(cur); const char* cB = PG8_BBASE(cur);
    PG8_STAGE(PG8_SB(0, 0), cB, voffB); PG8_STAGE(PG8_SB(0, 1), cB + hstepB, voffB); PG8_STAGE(PG8_SA(0, 0), cA, voffA); PG8_STAGE(PG8_SA(0, 1), cA + hstepA, voffA);
    if (wr == 1) PG8_BAR;
    PG8_WAIT_V(2); PG8_BAR;
    PG8_STAGE(PG8_SB(1, 0), cB + kstep, voffB); PG8_STAGE(PG8_SA(1, 0), cA + kstep, voffA); PG8_STAGE(PG8_SB(1, 1), cB + hstepB + kstep, voffB);
    PG8_WAIT_V(6); PG8_BAR;
    for (;;) {
        const bool has_next = S.next(ui + 1, nxt);
        const char* nA = has_next ? PG8_ABASE(nxt) : cA; const char* nB = has_next ? PG8_BBASE(nxt) : cB;
        for (int t = 0; t < nt; t += 2) {
            const bool last = (t == nt - 2);
            const char* a1 = cA + (size_t)(t + 1) * kstep;
            const char* a2 = last ? nA : cA + (size_t)(t + 2) * kstep; const char* b2 = last ? nB : cB + (size_t)(t + 2) * kstep;
            const char* a3 = a2 + kstep; const char* b3 = b2 + kstep;
            PG8_LDB(B0, 0, 0); PG8_LDB(B1, 0, 1); PG8_SCHED; PG8_LDA(At, 0, 0); PG8_STAGE(PG8_SA(1, 1), a1 + hstepA, voffA);
            PG8_WAIT_V(8); PG8_WAIT_L(0); PG8_BAR; PG8_MMA(0, 0, At, B0); PG8_MMA(0, 1, At, B1); PG8_BAR; PG8_SCHED;
            PG8_LDA(At, 0, 1); PG8_STAGE(PG8_SB(0, 0), b2, voffB); PG8_STAGE(PG8_SB(0, 1), b2 + hstepB, voffB); PG8_STAGE(PG8_SA(0, 0), a2, voffA);
            PG8_WAIT_V(8); PG8_WAIT_L(0); PG8_BAR; PG8_MMA(1, 0, At, B0); PG8_MMA(1, 1, At, B1); PG8_BAR; PG8_SCHED;
            PG8_LDB(B0, 1, 0); PG8_LDB(B1, 1, 1); PG8_SCHED; PG8_LDA(At, 1, 0); PG8_STAGE(PG8_SA(0, 1), a2 + hstepA, voffA);
            PG8_WAIT_V(8); PG8_WAIT_L(0); PG8_BAR; PG8_MMA(0, 0, At, B0); PG8_MMA(0, 1, At, B1); PG8_BAR; PG8_SCHED;
            PG8_LDA(At, 1, 1); PG8_STAGE(PG8_SB(1, 0), b3, voffB); PG8_STAGE(PG8_SB(1, 1), b3 + hstepB, voffB); PG8_STAGE(PG8_SA(1, 0), a3, voffA);
            PG8_WAIT_V(8); PG8_WAIT_L(0); PG8_BAR; PG8_MMA(1, 0, At, B0); PG8_MMA(1, 1, At, B1); PG8_BAR; PG8_SCHED;
        }
        if (wr == 0) PG8_BAR;
        E(acc, cur, wr, wc, fr, fq);
        if (!has_next) break;
#pragma unroll
        for (int a = 0; a < 2; ++a)
#pragma unroll
            for (int b = 0; b < 2; ++b)
#pragma unroll
                for (int m = 0; m < 4; ++m)
#pragma unroll
                    for (int n = 0; n < 2; ++n) acc[a][b][m][n] = (f32x4){0.f, 0.f, 0.f, 0.f};
        cur = nxt; cA = nA; cB = nB; ++ui;
        if (wr == 1) PG8_BAR;
    }
    PG8_WAIT_V(0);
    PG8_BAR;
#undef PG8_SA
#undef PG8_SB
#undef PG8_STAGE
#undef PG8_LDA
#undef PG8_LDB
#undef PG8_MMA
#undef PG8_WAIT_V
#undef PG8_WAIT_L
#undef PG8_BAR
#undef PG8_SCHED
#undef PG8_ABASE
#undef PG8_BBASE
}
}
namespace pg8 {
#define EPI_ROWS(expr_row) for (int ai = 0; ai < 2; ++ai) for (int m = 0; m < 4; ++m)
struct EpiBf16 {
    static constexpr bool PERM = true;
    bf16_t* O; int ldc;
    __device__ __forceinline__ void operator()(const f32x4 (&acc)[2][2][4][2], const Unit& u, int wr, int wc, int fr, int fq) const {
        const int row0 = u.pm * BM + wr * 64 + fr, col0 = u.pn * BM + wc * 32 + 8 * fq;
#pragma unroll
        for (int ai = 0; ai < 2; ++ai)
#pragma unroll
            for (int m = 0; m < 4; ++m) { bf16_t* rowp = O + (size_t)(row0 + ai * HALF + m * 16) * ldc + col0;
#pragma unroll
                for (int bj = 0; bj < 2; ++bj) { const f32x4 v0 = acc[ai][bj][m][0], v1 = acc[ai][bj][m][1];
                    u32x4 w; w.x = cvt_pk_bf16(v0[0], v0[1]); w.y = cvt_pk_bf16(v0[2], v0[3]); w.z = cvt_pk_bf16(v1[0], v1[1]); w.w = cvt_pk_bf16(v1[2], v1[3]);
                    *(u32x4*)(rowp + bj * HALF) = w; } }
    }
};
struct EpiZ {
    static constexpr bool PERM = true;
    bf16_t* GG; bf16_t* REC; bf16_t* POOL;
    __device__ __forceinline__ void operator()(const f32x4 (&acc)[2][2][4][2], const Unit& u, int wr, int wc, int fr, int fq) const {
        const int t = u.pn >> 2; bf16_t* base = GG + (size_t)t * ((size_t)MT * 1024);
        const int row0 = u.pm * BM + wr * 64 + fr, col0 = (u.pn & 3) * BM + wc * 32 + 8 * fq;
#pragma unroll
        for (int ai = 0; ai < 2; ++ai)
#pragma unroll
            for (int m = 0; m < 4; ++m) { bf16_t* rowp = base + (size_t)(row0 + ai * HALF + m * 16) * 1024 + col0;
#pragma unroll
                for (int bj = 0; bj < 2; ++bj) { f32x4 v0 = acc[ai][bj][m][0], v1 = acc[ai][bj][m][1];
                    if (t == 0) {
#pragma unroll
                        for (int j = 0; j < 4; ++j) { v0[j] = gelu_tanh(v0[j]); v1[j] = gelu_tanh(v1[j]); } }
                    u32x4 w; w.x = cvt_pk_bf16(v0[0], v0[1]); w.y = cvt_pk_bf16(v0[2], v0[3]); w.z = cvt_pk_bf16(v1[0], v1[1]); w.w = cvt_pk_bf16(v1[2], v1[3]);
                    *(u32x4*)(rowp + bj * HALF) = w; } }
    }
};
struct EpiGate {
    static constexpr bool PERM = false;
    const bf16_t* XC; const float* gp; float* Aout;
    __device__ __forceinline__ void operator()(const f32x4 (&acc)[2][2][4][2], const Unit& u, int wr, int wc, int fr, int fq) const {
        const int row0 = u.pm * BM + wr * 64 + fr, ch0 = u.pn * 128 + wc * 32 + 4 * fq;
#pragma unroll
        for (int n = 0; n < 2; ++n) {
            const f32x4 bav = *(const f32x4*)(gp + ch0 + 16 * n), bxv = *(const f32x4*)(gp + 1024 + ch0 + 16 * n), spv = *(const f32x4*)(gp + 2048 + ch0 + 16 * n);
#pragma unroll
            for (int ai = 0; ai < 2; ++ai)
#pragma unroll
                for (int m = 0; m < 4; ++m) { const int row = row0 + ai * HALF + m * 16; const bool pos0 = (row < MP) && ((row & 16383) == 0);
                    const size_t off = (size_t)row * 1024 + ch0 + 16 * n;
                    const u32x2 xw = *(const u32x2*)(XC + off); const float xc[4] = {bf_lo(xw.x), bf_hi(xw.x), bf_lo(xw.y), bf_hi(xw.y)};
                    f32x4 av, uv;
#pragma unroll
                    for (int j = 0; j < 4; ++j) { const float r = fsigmoid(acc[ai][0][m][n][j] + bav[j]), ig = fsigmoid(acc[ai][1][m][n][j] + bxv[j]);
                        const float log_a = -8.0f * r * spv[j]; const float a = fexp(log_a); const float mult = pos0 ? 1.0f : __builtin_sqrtf(fmaxf(1.0f - a * a, 0.0f));
                        av[j] = a; uv[j] = mult * ig * xc[j]; }
                    *(f32x4*)(Aout + off) = av; { u32x2 uw; uw.x = cvt_pk_bf16(uv[0], uv[1]); uw.y = cvt_pk_bf16(uv[2], uv[3]); *(u32x2*)((bf16_t*)(Aout + (size_t)MT * 1024) + off) = uw; } asm volatile("" ::: "memory"); }
        }
    }
};
struct EpiPool {
    static constexpr bool PERM = true;
    bf16_t* CAT; const float* spool;
    __device__ __forceinline__ void operator()(const f32x4 (&acc)[2][2][4][2], const Unit& u, int wr, int wc, int fr, int fq) const {
        const int row0 = u.pm * BM + wr * 64 + fr, col0 = u.pn * BM + wc * 32 + 8 * fq;
        f32x4 s0[2], s1[2];
#pragma unroll
        for (int bj = 0; bj < 2; ++bj) { s0[bj] = *(const f32x4*)(spool + col0 + bj * HALF); s1[bj] = *(const f32x4*)(spool + col0 + bj * HALF + 4); }
#pragma unroll
        for (int ai = 0; ai < 2; ++ai)
#pragma unroll
            for (int m = 0; m < 4; ++m) { bf16_t* rowp = CAT + (size_t)(row0 + ai * HALF + m * 16) * 2048 + 1024 + col0;
#pragma unroll
                for (int bj = 0; bj < 2; ++bj) { const f32x4 v0 = acc[ai][bj][m][0] * s0[bj], v1 = acc[ai][bj][m][1] * s1[bj];
                    u32x4 w; w.x = cvt_pk_bf16(v0[0], v0[1]); w.y = cvt_pk_bf16(v0[2], v0[3]); w.z = cvt_pk_bf16(v1[0], v1[1]); w.w = cvt_pk_bf16(v1[2], v1[3]);
                    *(u32x4*)(rowp + bj * HALF) = w; } }
    }
};
struct EpiResid {
    static constexpr bool PERM = false;
    const float* xinP; const float* xinS; float* xout; const float* gate;
    __device__ __forceinline__ void operator()(const f32x4 (&acc)[2][2][4][2], const Unit& u, int wr, int wc, int fr, int fq) const {
        const int row0 = u.pm * BM + wr * 64 + fr, col0 = u.pn * BM + wc * 32 + 4 * fq;
#pragma unroll
        for (int ai = 0; ai < 2; ++ai)
#pragma unroll
            for (int m = 0; m < 4; ++m) { const int row = row0 + ai * HALF + m * 16; const float* gp = gate + (size_t)seq_of_row(row) * 12288 + col0;
                const float* xi = (row < MP ? xinP + (size_t)row * DM : xinS + (size_t)(row - MP) * DM) + col0; float* xo = xout + (size_t)row * DM + col0;
#pragma unroll
                for (int bj = 0; bj < 2; ++bj)
#pragma unroll
                    for (int n = 0; n < 2; ++n) { const int o = bj * HALF + n * 16; *(f32x4*)(xo + o) = *(const f32x4*)(xi + o) + *(const f32x4*)(gp + o) * acc[ai][bj][m][n]; }
                asm volatile("" ::: "memory"); }
    }
};
struct EpiF32 {
    static constexpr bool PERM = false;
    float* C; int ldc;
    __device__ __forceinline__ void operator()(const f32x4 (&acc)[2][2][4][2], const Unit& u, int wr, int wc, int fr, int fq) const {
        const int row0 = u.pm * BM + wr * 64 + fr, col0 = u.pn * BM + wc * 32 + 4 * fq;
#pragma unroll
        for (int ai = 0; ai < 2; ++ai)
#pragma unroll
            for (int m = 0; m < 4; ++m) { float* rowp = C + (size_t)(row0 + ai * HALF + m * 16) * ldc + col0;
#pragma unroll
                for (int bj = 0; bj < 2; ++bj)
#pragma unroll
                    for (int n = 0; n < 2; ++n) *(f32x4*)(rowp + bj * HALF + n * 16) = acc[ai][bj][m][n]; }
    }
};
struct EpiQ {
    static constexpr bool PERM = true;
    bf16_t* Qn; bf16_t* Qp; const float* rope;
    __device__ __forceinline__ void operator()(const f32x4 (&acc)[2][2][4][2], const Unit& u, int wr, int wc, int fr, int fq) const {
        const int row0 = u.pm * BM + wr * 64 + fr;
        if (u.pn < 8) {
            const int col0 = u.pn * BM + wc * 32 + 8 * fq;
#pragma unroll
            for (int ai = 0; ai < 2; ++ai)
#pragma unroll
                for (int m = 0; m < 4; ++m) { bf16_t* rowp = Qn + (size_t)(row0 + ai * HALF + m * 16) * 2048 + col0;
#pragma unroll
                    for (int bj = 0; bj < 2; ++bj) { const f32x4 v0 = acc[ai][bj][m][0], v1 = acc[ai][bj][m][1];
                        u32x4 w; w.x = cvt_pk_bf16(v0[0], v0[1]); w.y = cvt_pk_bf16(v0[2], v0[3]); w.z = cvt_pk_bf16(v1[0], v1[1]); w.w = cvt_pk_bf16(v1[2], v1[3]);
                        *(u32x4*)(rowp + bj * HALF) = w; } }
        } else {
            const int head = (u.pn - 8) * 4 + wc, j0 = 8 * fq;
#pragma unroll
            for (int ai = 0; ai < 2; ++ai)
#pragma unroll
                for (int m = 0; m < 4; ++m) { const int row = row0 + ai * HALF + m * 16; const float* rp = rope + (size_t)pos_of_row(row) * 64 + j0;
                    const f32x4 c0 = *(const f32x4*)(rp), c1 = *(const f32x4*)(rp + 4), s0 = *(const f32x4*)(rp + 32), s1 = *(const f32x4*)(rp + 36);
                    const f32x4 x10 = acc[ai][0][m][0], x11 = acc[ai][0][m][1], x20 = acc[ai][1][m][0], x21 = acc[ai][1][m][1];
                    const f32x4 a0 = x10 * c0 - x20 * s0, a1 = x11 * c1 - x21 * s1, b0 = x10 * s0 + x20 * c0, b1 = x11 * s1 + x21 * c1;
                    bf16_t* qp = Qp + (size_t)row * 1024 + head * 64 + j0;
                    u32x4 w; w.x = cvt_pk_bf16(a0[0], a0[1]); w.y = cvt_pk_bf16(a0[2], a0[3]); w.z = cvt_pk_bf16(a1[0], a1[1]); w.w = cvt_pk_bf16(a1[2], a1[3]); *(u32x4*)qp = w;
                    w.x = cvt_pk_bf16(b0[0], b0[1]); w.y = cvt_pk_bf16(b0[2], b0[3]); w.z = cvt_pk_bf16(b1[0], b1[1]); w.w = cvt_pk_bf16(b1[2], b1[3]); *(u32x4*)(qp + 32) = w; }
        }
    }
};
struct EpiKV {
    static constexpr bool PERM = true;
    bf16_t* Kn; bf16_t* V;
    __device__ __forceinline__ void operator()(const f32x4 (&acc)[2][2][4][2], const Unit& u, int wr, int wc, int fr, int fq) const {
        const int row0 = u.pm * BM + wr * 64 + fr, col0 = u.pn * 128 + wc * 32 + 8 * fq;
#pragma unroll
        for (int ai = 0; ai < 2; ++ai)
#pragma unroll
            for (int m = 0; m < 4; ++m) { const size_t off = (size_t)(row0 + ai * HALF + m * 16) * 2048 + col0;
#pragma unroll
                for (int bj = 0; bj < 2; ++bj) { const f32x4 v0 = acc[ai][bj][m][0], v1 = acc[ai][bj][m][1];
                    u32x4 w; w.x = cvt_pk_bf16(v0[0], v0[1]); w.y = cvt_pk_bf16(v0[2], v0[3]); w.z = cvt_pk_bf16(v1[0], v1[1]); w.w = cvt_pk_bf16(v1[2], v1[3]);
                    *(u32x4*)((bj ? V : Kn) + off) = w; } }
    }
};
#undef EPI_ROWS
}

#define XB_TMO      128
#define XB_XCNT(j)  (256  + 64 * (j))
#define XB_XSUB(j)  (1280 + 64 * (j))
#define XB_XGEN(j)  (2304 + 64 * (j))
#define XB_TOP      3328
#define XB_TOPGEN   3392
#define XCD_BAR_WORDS 3456
#define XB_SPIN_CAP (1u << 18)
__device__ __forceinline__ unsigned xb_ld(unsigned* p)              { return __hip_atomic_load(p, __ATOMIC_RELAXED, __HIP_MEMORY_SCOPE_AGENT); }
__device__ __forceinline__ unsigned xb_add(unsigned* p, unsigned v) { return __hip_atomic_fetch_add(p, v, __ATOMIC_RELAXED, __HIP_MEMORY_SCOPE_AGENT); }
__device__ __forceinline__ unsigned xb_xcc_id() { return (unsigned)__builtin_amdgcn_s_getreg((3 << 11) | 20) & 0xFu; }
#define XB_SPIN(cond, bar) do { unsigned _sp = 0; while (cond) { __builtin_amdgcn_s_sleep(1); \
    if ((++_sp & 255u) == 0u) { if (xb_ld(&(bar)[XB_TMO])) break; if (_sp > XB_SPIN_CAP) { atomicAdd(&(bar)[XB_TMO], 1u); break; } } } } while (0)
struct XcdBarrier { unsigned* bar; unsigned x; volatile LAS unsigned* st; };
__device__ __forceinline__ XcdBarrier xcd_barrier_post(unsigned* bar, volatile LAS unsigned* st) {
    XcdBarrier b; b.bar = bar; b.x = xb_xcc_id(); b.st = st;
    if (threadIdx.x == 0) (void)xb_add(&bar[XB_XCNT(b.x)], 1u);
    return b;
}
__device__ __forceinline__ void xcd_barrier_complete(unsigned* bar, unsigned x, unsigned& nloc, unsigned& nx) {
    const unsigned G = gridDim.x * gridDim.y * gridDim.z;
    unsigned sum, cnt, mine, sp = 0u;
    for (;;) {
        sum = 0u; cnt = 0u; mine = 0u;
#pragma unroll
        for (unsigned j = 0; j < 16; ++j) { const unsigned c = xb_ld(&bar[XB_XCNT(j)]); sum += c; cnt += (c > 0u) ? 1u : 0u; mine = (j == x) ? c : mine; }
        if (sum == G) break;
        __builtin_amdgcn_s_sleep(1);
        if ((++sp & 255u) == 0u) { if (xb_ld(&bar[XB_TMO])) break; if (sp > XB_SPIN_CAP) { atomicAdd(&bar[XB_TMO], 1u); break; } }
    }
    nloc = mine > 0u ? mine : 1u; nx = cnt > 0u ? cnt : 1u;
}
__device__ __forceinline__ void xcd_barrier(const XcdBarrier& b) {
    asm volatile("s_waitcnt vmcnt(0)" ::: "memory");
    __syncthreads();
    if (threadIdx.x == 0) {
        unsigned* bar = b.bar;
        __builtin_amdgcn_s_waitcnt(0);
        unsigned nloc = b.st[0], nx = b.st[1];
        if (nloc == 0u) { xcd_barrier_complete(bar, b.x, nloc, nx); b.st[0] = nloc; b.st[1] = nx; }
        const unsigned old = xb_add(&bar[XB_XSUB(b.x)], 1u);
        const unsigned gen = old / nloc;
        if (old + 1u == (gen + 1u) * nloc) {
            __builtin_amdgcn_fence(__ATOMIC_RELEASE, "agent");
            asm volatile("s_waitcnt vmcnt(0)" ::: "memory");
            const unsigned og = xb_add(&bar[XB_TOP], 1u);
            const unsigned tg = og / nx;
            if (og + 1u == (tg + 1u) * nx) xb_add(&bar[XB_TOPGEN], 1u);
            else XB_SPIN(xb_ld(&bar[XB_TOPGEN]) == tg, bar);
            __builtin_amdgcn_fence(__ATOMIC_ACQUIRE, "agent");
            xb_add(&bar[XB_XGEN(b.x)], 1u);
            asm volatile("s_waitcnt vmcnt(0)" ::: "memory");
        } else {
            XB_SPIN(xb_ld(&bar[XB_XGEN(b.x)]) == gen, bar);
            __builtin_amdgcn_fence(__ATOMIC_ACQUIRE, "agent");
            asm volatile("s_waitcnt vmcnt(0)" ::: "memory");
        }
    }
    __syncthreads();
}
constexpr float U8_SCALE = 256.0f, V8_SCALE = 16.0f;
__device__ __forceinline__ void convert_fp8_range(const float* src, unsigned char* dst, float scale, size_t n16, size_t i0, size_t stride) {
    for (size_t i = i0; i < n16; i += stride) { u32x4 w;
#pragma unroll
        for (int q = 0; q < 4; ++q) { f32x4 a = *(const f32x4*)(src + i * 16 + 4 * q) * scale;
#pragma unroll
            for (int j = 0; j < 4; ++j) a[j] = fminf(fmaxf(a[j], -448.0f), 448.0f);
            int t = 0; t = __builtin_amdgcn_cvt_pk_fp8_f32(a[0], a[1], t, false); t = __builtin_amdgcn_cvt_pk_fp8_f32(a[2], a[3], t, true); w[q] = (unsigned)t; }
        *(u32x4*)(dst + i * 16) = w; }
}
constexpr float U4_SCALE = 90.50966799f, V4_SCALE = 8.0f;
__device__ __forceinline__ void convert_fp4_rows(const float* src, unsigned char* dst, float scale, int nrows, int w0, int wstride, int lane) {
    for (int r = w0; r < nrows; r += wstride) { const float* sr = src + (size_t)r * 2048 + 4 * lane; u32x4 w;
        f32x4 a[8];
#pragma unroll
        for (int b = 0; b < 8; ++b) a[b] = *(const f32x4*)(sr + 256 * b) * scale;
#pragma unroll
        for (int q = 0; q < 4; ++q) { float e[8] = {a[2 * q][0], a[2 * q][1], a[2 * q][2], a[2 * q][3], a[2 * q + 1][0], a[2 * q + 1][1], a[2 * q + 1][2], a[2 * q + 1][3]};
#pragma unroll
            for (int j = 0; j < 8; ++j) e[j] = fminf(fmaxf(e[j], -6.0f), 6.0f);
            unsigned t = 0u; t = __builtin_amdgcn_cvt_scalef32_pk_fp4_f32(t, e[0], e[1], 1.0f, 0); t = __builtin_amdgcn_cvt_scalef32_pk_fp4_f32(t, e[2], e[3], 1.0f, 1);
            t = __builtin_amdgcn_cvt_scalef32_pk_fp4_f32(t, e[4], e[5], 1.0f, 2); t = __builtin_amdgcn_cvt_scalef32_pk_fp4_f32(t, e[6], e[7], 1.0f, 3); w[q] = t; }
        *(u32x4*)(dst + (size_t)r * 1024 + 16 * lane) = w; }
}
constexpr size_t MiB = (size_t)1 << 20;
constexpr size_t WS_CTL = 0, WS_WGATE = 1 * MiB, WS_WDQKV = 2 * MiB, WS_ZERO_BYTES = 6 * MiB;
constexpr size_t WS_WIN = 6 * MiB, WS_WOUTR = 18 * MiB, WS_WQ = 26 * MiB, WS_WUQ = 42 * MiB, WS_WUKV = 45 * MiB, WS_WOUTA = 47 * MiB;
constexpr size_t WS_WPOOL = 55 * MiB, WS_KEYS = 56 * MiB, WS_MOD = 57 * MiB, WS_ROPE = 61 * MiB, WS_SP = 65 * MiB, WS_SCAN = 66 * MiB;
constexpr size_t WS_U = 73 * MiB, WS_V = 137 * MiB;
constexpr size_t A_HN = 201 * MiB, A_GG = 337 * MiB, A_B2 = 405 * MiB, A_B3 = 541 * MiB, A_B4 = 677 * MiB;
constexpr size_t A_KN = 405 * MiB, A_VV = 669 * MiB, A_KP = 933 * MiB, A_CQ = 942 * MiB, A_CKV = 976 * MiB, WS_END = 1009 * MiB;
constexpr int CW_BAR = 4096;
constexpr size_t SCAN_WORDS = (size_t)544 * 1024;
constexpr size_t O_Y = 0, O_CONV_P = 71303168, O_CONV_S = 71309312, O_H_P = 71407616, O_H_S = 71409664, O_POOL_P = 71442432, O_POOL_S = 71473152,
                 O_CKV = 71964672, O_KPE = 80877568, O_TOTAL = 83105792;
constexpr int LDS_BYTES = 147456, LDS_MISC = 147200;

struct Args { const float* in[36]; float* out; unsigned char* ws; int ph_lo, ph_hi; };

struct Ctx {
    LAS unsigned char* lds; int tid, lane, wave, vcu, G, gw, NGW;
    const float* const* in; float* out; unsigned char* ws;
};

__device__ __forceinline__ void transpose_item(const float* W, int N, int k0, int n0, bf16_t* WT, int dld, int drow0, int dcol0, LAS float* scr, int lane) {
#pragma unroll 8
    for (int i = 0; i < 32; ++i) { const int kk = 2 * i + (lane >> 5); scr[kk * 33 + (lane & 31)] = W[(size_t)(k0 + kk) * N + n0 + (lane & 31)]; }
    asm volatile("s_waitcnt lgkmcnt(0)" ::: "memory");
    const int c = lane & 7;
#pragma unroll
    for (int j = 0; j < 4; ++j) { const int n = (lane >> 3) + 8 * j; const LAS float* s = scr + (8 * c) * 33 + n;
        u32x4 o; o.x = cvt_pk_bf16(s[0 * 33], s[1 * 33]); o.y = cvt_pk_bf16(s[2 * 33], s[3 * 33]); o.z = cvt_pk_bf16(s[4 * 33], s[5 * 33]); o.w = cvt_pk_bf16(s[6 * 33], s[7 * 33]);
        *(u32x4*)(WT + (size_t)(drow0 + n) * dld + dcol0 + 8 * c) = o; }
    asm volatile("s_waitcnt lgkmcnt(0)" ::: "memory");
}
__device__ __forceinline__ void transpose_mat_item(const float* W, int K, int N, bf16_t* WT, int dld, int drow_base, int dcol_base, int item, LAS float* scr, int lane) {
    const int nblk = N / 32, kb = item / nblk, nb = item % nblk;
    transpose_item(W, N, 64 * kb, 32 * nb, WT, dld, drow_base + 32 * nb, dcol_base + 64 * kb, scr, lane);
}
__device__ __forceinline__ void convert_range(const float* src, bf16_t* dst, size_t n8, size_t i0, size_t stride) {
    for (size_t i = i0; i < n8; i += stride) { const f32x4 a = *(const f32x4*)(src + i * 8), b = *(const f32x4*)(src + i * 8 + 4);
        u32x4 w; w.x = cvt_pk_bf16(a[0], a[1]); w.y = cvt_pk_bf16(a[2], a[3]); w.z = cvt_pk_bf16(b[0], b[1]); w.w = cvt_pk_bf16(b[2], b[3]);
        *(u32x4*)(dst + i * 8) = w; }
}

__device__ __forceinline__ void ada_item(const Ctx& C, int item) {
    const int l = item / 96, nb = item % 96, n0 = nb * 128, w = C.wave, lane = C.lane;
    const float* cP = C.in[2]; const float* cS = C.in[3]; const float* W = C.in[9] + (size_t)l * 2048 * 12288 + n0 + 2 * lane; const float* bias = C.in[10] + (size_t)l * 12288 + n0;
    LAS float* scr = (LAS float*)(C.lds + w * 4608);
    LAS float* sum = (LAS float*)(C.lds + 36864);
    f32x2 acc[34];
#pragma unroll
    for (int s = 0; s < 34; ++s) acc[s] = (f32x2){0.f, 0.f};
    for (int sub = 0; sub < 8; ++sub) {
        const int k0 = 256 * w + 32 * sub;
#pragma unroll
        for (int i = 0; i < 17; ++i) { const int idx = lane + 64 * i, s = idx >> 5, kk = idx & 31;
            const float cv = (s < 2) ? cP[s * 2048 + k0 + kk] : cS[(s - 2) * 2048 + k0 + kk];
            scr[kk * 36 + s] = cv * fsigmoid(cv); }
        asm volatile("s_waitcnt lgkmcnt(0)" ::: "memory");
#pragma unroll 8
        for (int kk = 0; kk < 32; ++kk) {
            const f32x2 w2 = *(const f32x2*)(W + (size_t)(k0 + kk) * 12288);
#pragma unroll
            for (int s4 = 0; s4 < 9; ++s4) { const f32x4 sv = *(const LAS f32x4*)(scr + kk * 36 + 4 * s4);
#pragma unroll
                for (int i = 0; i < 4; ++i) if (4 * s4 + i < 34) acc[4 * s4 + i] += w2 * sv[i]; }
        }
        asm volatile("s_waitcnt lgkmcnt(0)" ::: "memory");
    }
    for (int ww = 0; ww < 8; ++ww) {
        if (w == ww) {
#pragma unroll
            for (int s = 0; s < 34; ++s) { LAS f32x2* p = (LAS f32x2*)(sum + s * 128) + lane; if (ww == 0) *p = acc[s]; else *p = *p + acc[s]; }
        }
        __syncthreads();
    }
    float* mod = (float*)(C.ws + WS_MOD);
    for (int s = w; s < 34; s += 8) { const f32x2 v = *((LAS f32x2*)(sum + s * 128) + lane) + *(const f32x2*)(bias + 2 * lane);
        *(f32x2*)(mod + ((size_t)l * NSEQ + s) * 12288 + n0 + 2 * lane) = v; }
    __syncthreads();
}

__device__ __forceinline__ void phase_prologue(const Ctx& C) {
    const int lane = C.lane;
    constexpr int NADA = 192;
    if (C.vcu < NADA && C.G > NADA) { ada_item(C, C.vcu); }
    else if (C.G <= NADA) { for (int it = C.vcu; it < NADA; it += C.G) ada_item(C, it); }
    {
        unsigned* qhead = (unsigned*)(C.ws + WS_CTL) + 64;
        {
            LAS float* scr = (LAS float*)(C.lds + 72704 + C.wave * 8448);
            bf16_t* w_in = (bf16_t*)(C.ws + WS_WIN); bf16_t* w_outr = (bf16_t*)(C.ws + WS_WOUTR); bf16_t* w_q = (bf16_t*)(C.ws + WS_WQ);
            bf16_t* w_dqkv = (bf16_t*)(C.ws + WS_WDQKV); bf16_t* w_uq = (bf16_t*)(C.ws + WS_WUQ); bf16_t* w_ukv = (bf16_t*)(C.ws + WS_WUKV);
            bf16_t* w_outa = (bf16_t*)(C.ws + WS_WOUTA); bf16_t* w_gate = (bf16_t*)(C.ws + WS_WGATE); bf16_t* w_pool = (bf16_t*)(C.ws + WS_WPOOL);
            constexpr int I_IN = 32 * 96, I_OUTR = 32 * 64, I_Q = 32 * 64, I_DQ = 32 * 16, I_DKV = 32 * 10, I_UQ = 8 * 96, I_UKV = 4 * 128, I_OUTA = 32 * 64, I_GATE = 16 * 8, I_POOL = 4 * 32;
            constexpr int NIT = I_IN + I_OUTR + 2 * I_Q + I_DQ + I_DKV + I_UQ + I_UKV + I_OUTA + I_GATE + I_POOL;
            for (;;) {
                int it = 0; if (lane == 0) it = (int)__hip_atomic_fetch_add(qhead, 1u, __ATOMIC_RELAXED, __HIP_MEMORY_SCOPE_AGENT);
                it = __builtin_amdgcn_readfirstlane(it); if (it >= NIT) break;
                int r = it;
                if (r < I_IN) { transpose_mat_item(C.in[13], 2048, 3072, w_in, 2048, 0, 0, r, scr, lane); continue; } r -= I_IN;
                if (r < I_OUTR) { transpose_mat_item(C.in[23], 2048, 2048, w_outr, 2048, 0, 0, r, scr, lane); continue; } r -= I_OUTR;
                if (r < 2 * I_Q) { const int l = r / I_Q; transpose_mat_item(C.in[31] + (size_t)l * 2048 * 2048, 2048, 2048, w_q + (size_t)l * 2048 * 2048, 2048, 0, 0, r % I_Q, scr, lane); continue; } r -= 2 * I_Q;
                if (r < I_DQ) { transpose_mat_item(C.in[24], 2048, 512, w_dqkv, 2048, 0, 0, r, scr, lane); continue; } r -= I_DQ;
                if (r < I_DKV) { transpose_mat_item(C.in[27], 2048, 320, w_dqkv, 2048, 512, 0, r, scr, lane); continue; } r -= I_DKV;
                if (r < I_UQ) {
                    const int kb = r / 96, nb = r % 96, n0 = 32 * nb, h = n0 / 192, d = n0 % 192;
                    const int drow = (d < 128) ? h * 128 + d : 2048 + (h >> 2) * 256 + ((d - 128) >> 5) * 128 + (h & 3) * 32;
                    transpose_item(C.in[26], 3072, 64 * kb, n0, w_uq, 512, drow, 64 * kb, scr, lane); continue; } r -= I_UQ;
                if (r < I_UKV) { transpose_mat_item(C.in[29], 256, 4096, w_ukv, 256, 0, 0, r, scr, lane); continue; } r -= I_UKV;
                if (r < I_OUTA) { transpose_mat_item(C.in[30], 2048, 2048, w_outa, 2048, 0, 0, r, scr, lane); continue; } r -= I_OUTA;
                if (r < I_GATE) {
                    const int q = r / 8, sub = r % 8, h = q >> 1, gsel = q & 1;
                    const float* src = (gsel ? C.in[18] : C.in[16]) + (size_t)h * 128 * 128;
                    transpose_mat_item(src, 128, 128, w_gate, 256, h * 256 + gsel * 128, (h & 1) * 128, sub, scr, lane); continue; } r -= I_GATE;
                { const int gq = r / 32, sub = r % 32;
                  transpose_mat_item(C.in[21] + (size_t)gq * 256 * 256, 256, 256, w_pool, 256, gq * 256, 0, sub, scr, lane); }
            }
        }
    }
    const size_t gt = (size_t)C.vcu * 512 + C.tid, GT = (size_t)C.G * 512;
    convert_fp4_rows(C.in[33], C.ws + WS_U, U4_SCALE, 16384, C.gw, C.NGW, lane);
    convert_fp4_rows(C.in[34], C.ws + WS_V, V4_SCALE, 16384, C.gw, C.NGW, lane);
    convert_range(C.in[32], (bf16_t*)(C.ws + WS_KEYS), (size_t)2 * 8 * 2 * 128 * 128 / 8, gt, GT);
    { float* rope = (float*)(C.ws + WS_ROPE);
      for (size_t i = gt; i < (size_t)16384 * 32; i += GT) { const int pos = (int)(i >> 5), j = (int)(i & 31);
          double inv = 1.0; for (int q = 0; q < j; ++q) inv *= 0.7498942093324559;
          const double rev = (double)pos * inv * 0.15915494309189535; const float fr = (float)(rev - __builtin_floor(rev));
          rope[(size_t)pos * 64 + j] = __builtin_amdgcn_cosf(fr); rope[(size_t)pos * 64 + 32 + j] = __builtin_amdgcn_sinf(fr); } }
    { float* sp = (float*)(C.ws + WS_SP);
      for (size_t i = gt; i < 1024; i += GT) { sp[i] = C.in[17][i]; sp[1024 + i] = C.in[19][i]; const float y = fexp(-C.in[20][i]); sp[2048 + i] = (y < 0.03f) ? y * (1.0f - y * (0.5f - y * (0.33333333f - y * (0.25f - 0.2f * y)))) : 0.6931471805599453f * __builtin_amdgcn_logf(1.0f + y); } }
}
__device__ __forceinline__ void norm_mod_row(const float* xrow, const float* g, const float* shift, const float* scale, bf16_t* orow, int lane) {
    f32x4 v[8]; float ss = 0.f;
#pragma unroll
    for (int j = 0; j < 8; ++j) { v[j] = *((const f32x4*)xrow + lane + 64 * j); ss += (v[j].x * v[j].x + v[j].y * v[j].y) + (v[j].z * v[j].z + v[j].w * v[j].w); }
    const float rstd = __builtin_amdgcn_rsqf(wave_sum(ss) * (1.0f / DM) + RMS_EPS);
#pragma unroll
    for (int j = 0; j < 8; ++j) { const int q = lane + 64 * j; const f32x4 gv = *((const f32x4*)g + q), sc = *((const f32x4*)scale + q), sh = *((const f32x4*)shift + q);
        const f32x4 y = v[j] * rstd * gv * (sc + 1.0f) + sh;
        u32x2 w; w.x = cvt_pk_bf16(y.x, y.y); w.y = cvt_pk_bf16(y.z, y.w); *((u32x2*)orow + q) = w; }
}
__device__ __forceinline__ void phase_norm(const Ctx& C, const float* xP, const float* xS, const float* g, const float* modl, int part, bf16_t* hn) {
    for (int m = C.gw; m < MT; m += C.NGW) {
        const float* xr = (m < MP) ? xP + (size_t)m * DM : xS + (size_t)(m - MP) * DM; const float* mp = modl + (size_t)seq_of_row(m) * 12288 + part * 2048;
        norm_mod_row(xr, g, mp, mp + 2048, hn + (size_t)m * DM, C.lane);
    }
}

__device__ __forceinline__ void phase_resid_norm(const Ctx& C, const float* xP, const float* xS, const bf16_t* mix, float* X, const float* g, const float* modl, bf16_t* hn) {
    const int lane = C.lane;
    for (int m = C.gw; m < MT; m += C.NGW) {
        const float* xr = (m < MP) ? xP + (size_t)m * DM : xS + (size_t)(m - MP) * DM; const float* mp = modl + (size_t)seq_of_row(m) * 12288;
        f32x4 v[8]; float ss = 0.f;
#pragma unroll
        for (int j = 0; j < 8; ++j) { const int q = lane + 64 * j; const f32x4 xo = *((const f32x4*)xr + q), g1 = *((const f32x4*)(mp + 2 * 2048) + q); const u32x2 mw = *((const u32x2*)(mix + (size_t)m * DM) + q);
            v[j] = xo + g1 * (f32x4){bf_lo(mw.x), bf_hi(mw.x), bf_lo(mw.y), bf_hi(mw.y)}; ss += (v[j].x * v[j].x + v[j].y * v[j].y) + (v[j].z * v[j].z + v[j].w * v[j].w);
            *((f32x4*)(X + (size_t)m * DM) + q) = v[j]; }
        const float rstd = __builtin_amdgcn_rsqf(wave_sum(ss) * (1.0f / DM) + RMS_EPS);
#pragma unroll
        for (int j = 0; j < 8; ++j) { const int q = lane + 64 * j; const f32x4 gv = *((const f32x4*)g + q), sh = *((const f32x4*)(mp + 3 * 2048) + q), sc = *((const f32x4*)(mp + 4 * 2048) + q);
            const f32x4 y = v[j] * rstd * gv * (sc + 1.0f) + sh;
            u32x2 w; w.x = cvt_pk_bf16(y.x, y.y); w.y = cvt_pk_bf16(y.z, y.w); *((u32x2*)(hn + (size_t)m * DM) + q) = w; }
    }
}

__device__ __forceinline__ void ld8bf(const bf16_t* p, float (&v)[8]) { const u32x4 w = *(const u32x4*)p; v[0] = bf_lo(w.x); v[1] = bf_hi(w.x); v[2] = bf_lo(w.y); v[3] = bf_hi(w.y); v[4] = bf_lo(w.z); v[5] = bf_hi(w.z); v[6] = bf_lo(w.w); v[7] = bf_hi(w.w); }
__device__ __forceinline__ void ld8f(const float* p, float (&v)[8]) { const f32x4 a = *(const f32x4*)p, b = *(const f32x4*)(p + 4); v[0] = a.x; v[1] = a.y; v[2] = a.z; v[3] = a.w; v[4] = b.x; v[5] = b.y; v[6] = b.z; v[7] = b.w; }
__device__ __forceinline__ void st8bf(bf16_t* p, const float (&v)[8]) { u32x4 w; w.x = cvt_pk_bf16(v[0], v[1]); w.y = cvt_pk_bf16(v[2], v[3]); w.z = cvt_pk_bf16(v[4], v[5]); w.w = cvt_pk_bf16(v[6], v[7]); *(u32x4*)p = w; }
__device__ __forceinline__ void st8f(float* p, const float (&v)[8]) { *(f32x4*)p = (f32x4){v[0], v[1], v[2], v[3]}; *(f32x4*)(p + 4) = (f32x4){v[4], v[5], v[6], v[7]}; }

__device__ __forceinline__ void phase_convpool(const Ctx& C) {
    const bf16_t* __restrict__ REC = (const bf16_t*)(C.ws + A_B2); const bf16_t* __restrict__ PIN = REC + (size_t)MT * 1024;
    bf16_t* __restrict__ XC = (bf16_t*)(C.ws + A_B3); bf16_t* __restrict__ POOLED = XC + (size_t)MT * 1024;
    const float* convw = C.in[14]; const float* convb = C.in[15]; const float* st_conv = C.in[4]; const float* st_pool = C.in[6];
    const int NITEM = 2 * 544 * 128;
    for (int it0 = C.vcu * 512 + C.tid; it0 < NITEM; it0 += C.G * 512) {
        const bool is_pool = it0 >= 544 * 128; const int it = is_pool ? it0 - 544 * 128 : it0;
        const int chunk = it >> 7, ch0 = (it & 127) * 8;
        const bool samp = chunk >= 512; const int sb = chunk - 512;
        const int row0 = samp ? MP + sb * 64 : chunk * 64;
        const int t0 = samp ? 0 : (chunk & 255) * 64;
        const bool lastc = samp || ((chunk & 255) == 255);
        if (!is_pool) {
            float w0[8], w1[8], w2[8], w3[8], bb[8], p0[8], p1[8], p2[8];
            ld8f(convw + ch0, w0); ld8f(convw + 1024 + ch0, w1); ld8f(convw + 2048 + ch0, w2); ld8f(convw + 3072 + ch0, w3); ld8f(convb + ch0, bb);
            if (samp) { ld8f(st_conv + ((size_t)sb * 3 + 0) * 1024 + ch0, p0); ld8f(st_conv + ((size_t)sb * 3 + 1) * 1024 + ch0, p1); ld8f(st_conv + ((size_t)sb * 3 + 2) * 1024 + ch0, p2); }
            else if (t0 > 0) { ld8bf(REC + (size_t)(row0 - 3) * 1024 + ch0, p0); ld8bf(REC + (size_t)(row0 - 2) * 1024 + ch0, p1); ld8bf(REC + (size_t)(row0 - 1) * 1024 + ch0, p2); }
            else {
#pragma unroll
                for (int j = 0; j < 8; ++j) { p0[j] = 0.f; p1[j] = 0.f; p2[j] = 0.f; } }
            for (int tb = 0; tb < 64; tb += 8) {
                u32x4 raw[8];
#pragma unroll
                for (int q = 0; q < 8; ++q) raw[q] = *(const u32x4*)(REC + (size_t)(row0 + tb + q) * 1024 + ch0);
#pragma unroll
                for (int q = 0; q < 8; ++q) { const u32x4 w = raw[q]; const float cur[8] = {bf_lo(w.x), bf_hi(w.x), bf_lo(w.y), bf_hi(w.y), bf_lo(w.z), bf_hi(w.z), bf_lo(w.w), bf_hi(w.w)}; float o[8];
#pragma unroll
                    for (int j = 0; j < 8; ++j) { o[j] = bb[j] + w0[j] * p0[j] + w1[j] * p1[j] + w2[j] * p2[j] + w3[j] * cur[j]; p0[j] = p1[j]; p1[j] = p2[j]; p2[j] = cur[j]; }
                    st8bf(XC + (size_t)(row0 + tb + q) * 1024 + ch0, o); } }
            if (lastc) { float* dst = samp ? C.out + O_CONV_S + (size_t)sb * 3 * 1024 : C.out + O_CONV_P + (size_t)(chunk >> 8) * 3 * 1024;
                st8f(dst + ch0, p0); st8f(dst + 1024 + ch0, p1); st8f(dst + 2048 + ch0, p2); }
        } else {
            const int gsel = ch0 >> 8, w = 2 << gsel;
            float S[8];
#pragma unroll
            for (int j = 0; j < 8; ++j) S[j] = 0.f;
            for (int tt = 1 - w; tt < 0; ++tt) { float v[8];
                if (samp) ld8f(st_pool + ((size_t)sb * 15 + 15 + tt) * 1024 + ch0, v);
                else if (t0 + tt >= 0) ld8bf(PIN + (size_t)(row0 + tt) * 1024 + ch0, v);
                else {
#pragma unroll
                    for (int j = 0; j < 8; ++j) v[j] = 0.f; }
#pragma unroll
                for (int j = 0; j < 8; ++j) S[j] += v[j]; }
            for (int tb = 0; tb < 64; tb += 8) {
                u32x4 rawc[8]; float oldv[8][8];
#pragma unroll
                for (int q = 0; q < 8; ++q) rawc[q] = *(const u32x4*)(PIN + (size_t)(row0 + tb + q) * 1024 + ch0);
#pragma unroll
                for (int q = 0; q < 8; ++q) { const int tt = tb + q - w + 1;
                    if (tt >= 0 || (!samp && t0 + tt >= 0)) ld8bf(PIN + (size_t)(row0 + tt) * 1024 + ch0, oldv[q]);
                    else if (samp) ld8f(st_pool + ((size_t)sb * 15 + 15 + tt) * 1024 + ch0, oldv[q]);
                    else {
#pragma unroll
                        for (int j = 0; j < 8; ++j) oldv[q][j] = 0.f; } }
#pragma unroll
                for (int q = 0; q < 8; ++q) { const u32x4 wv = rawc[q]; const float cur[8] = {bf_lo(wv.x), bf_hi(wv.x), bf_lo(wv.y), bf_hi(wv.y), bf_lo(wv.z), bf_hi(wv.z), bf_lo(wv.w), bf_hi(wv.w)}; float o[8];
                    const int pos = samp ? 1024 + tb + q : t0 + tb + q; const float rc = 1.0f / (float)((pos + 1 < w) ? pos + 1 : w);
#pragma unroll
                    for (int j = 0; j < 8; ++j) { S[j] += cur[j]; o[j] = S[j] * rc - cur[j]; S[j] -= oldv[q][j]; }
                    st8bf(POOLED + (size_t)(row0 + tb + q) * 1024 + ch0, o); } }
            if (lastc) { float* dst = samp ? C.out + O_POOL_S + (size_t)sb * 15 * 1024 : C.out + O_POOL_P + (size_t)(chunk >> 8) * 15 * 1024;
                for (int i = 0; i < 15; ++i) { float v[8]; ld8bf(PIN + (size_t)(row0 + 49 + i) * 1024 + ch0, v); st8f(dst + (size_t)i * 1024 + ch0, v); } }
        }
    }
}

__device__ __forceinline__ void phase_scanA(const Ctx& C) {
    const float* __restrict__ A = (const float*)(C.ws + A_B4); const bf16_t* __restrict__ U = (const bf16_t*)(A + (size_t)MT * 1024);
    float* __restrict__ cP = (float*)(C.ws + WS_SCAN); float* __restrict__ cH = cP + SCAN_WORDS;
    for (int it = C.vcu * 512 + C.tid; it < 544 * 256; it += C.G * 512) {
        const int chunk = it >> 8, ch = (it & 255) * 4; const int row0 = chunk * 64;
        f32x4 P = {1.f, 1.f, 1.f, 1.f}, H = {0.f, 0.f, 0.f, 0.f};
        for (int tb = 0; tb < 64; tb += 8) { f32x4 av[8], uv[8];
#pragma unroll
            for (int q = 0; q < 8; ++q) { av[q] = *(const f32x4*)(A + (size_t)(row0 + tb + q) * 1024 + ch); const u32x2 uw = *(const u32x2*)(U + (size_t)(row0 + tb + q) * 1024 + ch); uv[q] = (f32x4){bf_lo(uw.x), bf_hi(uw.x), bf_lo(uw.y), bf_hi(uw.y)}; }
#pragma unroll
            for (int q = 0; q < 8; ++q) { H = av[q] * H + uv[q]; P = P * av[q]; } }
        *(f32x4*)(cP + (size_t)chunk * 1024 + ch) = P; *(f32x4*)(cH + (size_t)chunk * 1024 + ch) = H;
    }
}
__device__ __forceinline__ void phase_scanB(const Ctx& C) {
    const float* __restrict__ cP = (const float*)(C.ws + WS_SCAN); const float* __restrict__ cH = cP + SCAN_WORDS; float* __restrict__ cI = (float*)(C.ws + WS_SCAN) + 2 * SCAN_WORDS;
    const int it = C.vcu * 512 + C.tid;
    if (it < 2048) { const int s = it >> 10, ch = it & 1023; float carry = 0.f;
        for (int cb = 0; cb < 256; cb += 16) { float pv[16], hv[16];
#pragma unroll
            for (int q = 0; q < 16; ++q) { const size_t o = (size_t)(s * 256 + cb + q) * 1024 + ch; pv[q] = cP[o]; hv[q] = cH[o]; }
#pragma unroll
            for (int q = 0; q < 16; ++q) { cI[(size_t)(s * 256 + cb + q) * 1024 + ch] = carry; carry = pv[q] * carry + hv[q]; } } }
}
__device__ __forceinline__ void phase_scanC(const Ctx& C) {
    const float* __restrict__ A = (const float*)(C.ws + A_B4); const bf16_t* __restrict__ U = (const bf16_t*)(A + (size_t)MT * 1024); const float* __restrict__ cI = (const float*)(C.ws + WS_SCAN) + 2 * SCAN_WORDS;
    const bf16_t* __restrict__ GG = (const bf16_t*)(C.ws + A_GG); bf16_t* __restrict__ CAT = (bf16_t*)(C.ws + A_HN); const float* hprev = C.in[5];
    for (int it = C.vcu * 512 + C.tid; it < 544 * 256; it += C.G * 512) {
        const int chunk = it >> 8, ch = (it & 255) * 4; const int row0 = chunk * 64; const bool samp = chunk >= 512;
        f32x4 h = samp ? *(const f32x4*)(hprev + (size_t)(chunk - 512) * 1024 + ch) : *(const f32x4*)(cI + (size_t)chunk * 1024 + ch);
        for (int tb = 0; tb < 64; tb += 8) { f32x4 av[8], uv[8]; u32x2 gv[8];
#pragma unroll
            for (int q = 0; q < 8; ++q) { const size_t o = (size_t)(row0 + tb + q) * 1024 + ch; av[q] = *(const f32x4*)(A + o); { const u32x2 uw = *(const u32x2*)(U + o); uv[q] = (f32x4){bf_lo(uw.x), bf_hi(uw.x), bf_lo(uw.y), bf_hi(uw.y)}; } gv[q] = *(const u32x2*)(GG + o); }
#pragma unroll
            for (int q = 0; q < 8; ++q) { h = av[q] * h + uv[q];
                u32x2 w; w.x = cvt_pk_bf16(bf_lo(gv[q].x) * h.x, bf_hi(gv[q].x) * h.y); w.y = cvt_pk_bf16(bf_lo(gv[q].y) * h.z, bf_hi(gv[q].y) * h.w);
                *(u32x2*)(CAT + (size_t)(row0 + tb + q) * 2048 + ch) = w; } }
        if (samp) *(f32x4*)(C.out + O_H_S + (size_t)(chunk - 512) * 1024 + ch) = h;
        else if ((chunk & 255) == 255) *(f32x4*)(C.out + O_H_P + (size_t)(chunk >> 8) * 1024 + ch) = h;
    }
}

__device__ __forceinline__ void phase_latent(const Ctx& C) {
    const float* CQKV = (const float*)(C.ws + A_B3); bf16_t* CQ = (bf16_t*)(C.ws + A_CQ); bf16_t* CKV = (bf16_t*)(C.ws + A_CKV); bf16_t* KP = (bf16_t*)(C.ws + A_KP);
    const float* gq = C.in[25]; const float* gkv = C.in[28]; const float* rope = (const float*)(C.ws + WS_ROPE); const int lane = C.lane;
    for (int m = C.gw; m < MT; m += C.NGW) {
        const float* r = CQKV + (size_t)m * 1024; const int kvr = kvrow_of_row(m);
        { float v[8]; ld8f(r + lane * 8, v); float ss = 0.f;
#pragma unroll
          for (int j = 0; j < 8; ++j) ss += v[j] * v[j];
          const float rstd = __builtin_amdgcn_rsqf(wave_sum(ss) * (1.0f / 512) + RMS_EPS); float g[8]; ld8f(gq + lane * 8, g);
#pragma unroll
          for (int j = 0; j < 8; ++j) v[j] = v[j] * rstd * g[j];
          st8bf(CQ + (size_t)m * 512 + lane * 8, v); }
        { const f32x4 v = *(const f32x4*)(r + 512 + lane * 4); const float ss = (v.x * v.x + v.y * v.y) + (v.z * v.z + v.w * v.w);
          const float rstd = __builtin_amdgcn_rsqf(wave_sum(ss) * (1.0f / 256) + RMS_EPS); const f32x4 y = v * rstd * *(const f32x4*)(gkv + lane * 4);
          *(f32x4*)(C.out + O_CKV + (size_t)m * 256 + lane * 4) = y;
          u32x2 w; w.x = cvt_pk_bf16(y.x, y.y); w.y = cvt_pk_bf16(y.z, y.w); *(u32x2*)(CKV + (size_t)kvr * 256 + lane * 4) = w; }
        { const float x = r[768 + lane]; const float xo = __shfl_xor(x, 32); const int j = lane & 31; const float* rp = rope + (size_t)pos_of_row(m) * 64;
          const float c = rp[j], s = rp[32 + j]; const float y = (lane < 32) ? x * c - xo * s : xo * s + x * c;
          C.out[O_KPE + (size_t)m * 64 + lane] = y; const unsigned yb = cvt_pk_bf16(y, y); KP[(size_t)kvr * 64 + lane] = (bf16_t)(yb & 0xffffu); }
    }
    const size_t gt = (size_t)C.vcu * 512 + C.tid, GT = (size_t)C.G * 512;
    for (size_t i = gt; i < (size_t)32 * 1024 * 256 / 8; i += GT) { const size_t e = i * 8, rowc = e / 256, col = e % 256, b = rowc / 1024, p = rowc % 1024;
        float v[8]; ld8f(C.in[7] + e, v); st8bf(CKV + ((size_t)MP + b * 1088 + p) * 256 + col, v); }
    for (size_t i = gt; i < (size_t)32 * 1024 * 64 / 8; i += GT) { const size_t e = i * 8, rowc = e / 64, col = e % 64, b = rowc / 1024, p = rowc % 1024;
        float v[8]; ld8f(C.in[8] + e, v); st8bf(KP + ((size_t)MP + b * 1088 + p) * 64 + col, v); }
    convert_fp4_rows(C.in[33] + (size_t)16384 * 2048, C.ws + WS_U, U4_SCALE, 16384, C.gw, C.NGW, lane);
    convert_fp4_rows(C.in[34] + (size_t)16384 * 2048, C.ws + WS_V, V4_SCALE, 16384, C.gw, C.NGW, lane);
}
typedef __bf16 bf2_t __attribute__((ext_vector_type(2)));
__device__ __forceinline__ unsigned ford(float f) { const unsigned u = __float_as_uint(f); return (u & 0x80000000u) ? ~u : (u | 0x80000000u); }
__device__ __forceinline__ float funord(unsigned o) { return __uint_as_float((o & 0x80000000u) ? (o & 0x7fffffffu) : ~o); }
__device__ __forceinline__ unsigned umax(unsigned a, unsigned b) { return a > b ? a : b; }
__device__ __forceinline__ unsigned umin(unsigned a, unsigned b) { return a < b ? a : b; }
__device__ __forceinline__ void ins16(unsigned (&L)[16], unsigned x) {
#pragma unroll
    for (int i = 0; i < 16; ++i) { const unsigned t = umax(L[i], x); x = umin(L[i], x); L[i] = t; }
}
__device__ __forceinline__ void ins16p(unsigned (&K)[16], unsigned (&P)[16], unsigned key, unsigned pay) {
#pragma unroll
    for (int i = 0; i < 16; ++i) { const bool c = key > K[i]; const unsigned tk = c ? key : K[i], nk = c ? K[i] : key, tp = c ? pay : P[i], np = c ? P[i] : pay; K[i] = tk; P[i] = tp; key = nk; pay = np; }
}
__device__ __forceinline__ void sort16_desc(unsigned (&v)[16]) {
#pragma unroll
    for (int k = 2; k <= 16; k <<= 1)
#pragma unroll
        for (int j = k >> 1; j >= 1; j >>= 1)
#pragma unroll
            for (int i = 0; i < 16; ++i) { const int l = i ^ j; if (l > i) { const bool desc = ((i & k) == 0); const unsigned a = v[i], b = v[l], hi = umax(a, b), lo = umin(a, b); v[i] = desc ? hi : lo; v[l] = desc ? lo : hi; } }
}
__device__ __forceinline__ void merge16_desc(unsigned (&A)[16], const unsigned (&B)[16]) {
#pragma unroll
    for (int i = 0; i < 16; ++i) A[i] = umax(A[i], B[15 - i]);
#pragma unroll
    for (int st = 8; st >= 1; st >>= 1)
#pragma unroll
        for (int i = 0; i < 16; ++i) if ((i & st) == 0) { const unsigned a = A[i], b = A[i + st]; A[i] = umax(a, b); A[i + st] = umin(a, b); }
}
__device__ __forceinline__ void subkey_top16(const bf16_t* qrow  , const bf16_t* krow  , int hh, unsigned (&S)[16]) {
    bf16x8 qf[8];
#pragma unroll
    for (int s = 0; s < 8; ++s) qf[s] = *(const bf16x8*)(qrow + 16 * s);
    unsigned L[16];
#pragma unroll
    for (int i = 0; i < 16; ++i) L[i] = 0u;
#pragma unroll 1
    for (int kb = 0; kb < 4; ++kb) {
        bf16x8 kf[8];
#pragma unroll
        for (int s = 0; s < 8; ++s) kf[s] = *(const bf16x8*)(krow + (size_t)kb * 32 * 128 + 16 * s);
        f32x16 a = {0.f, 0.f, 0.f, 0.f, 0.f, 0.f, 0.f, 0.f, 0.f, 0.f, 0.f, 0.f, 0.f, 0.f, 0.f, 0.f};
#pragma unroll
        for (int s = 0; s < 8; ++s) a = __builtin_amdgcn_mfma_f32_32x32x16_bf16(kf[s], qf[s], a, 0, 0, 0);
        unsigned N[16];
#pragma unroll
        for (int r = 0; r < 16; ++r) { const unsigned idx = (unsigned)(32 * kb + (r & 3) + 8 * (r >> 2) + 4 * hh); N[r] = (ford(a[r]) & ~0x7fu) | idx; }
        sort16_desc(N); merge16_desc(L, N);
        asm volatile("" ::: "memory");
    }
    unsigned P[16];
#pragma unroll
    for (int i = 0; i < 16; ++i) P[i] = (unsigned)__shfl_xor((int)L[i], 32);
#pragma unroll
    for (int i = 0; i < 16; ++i) S[i] = L[i];
    merge16_desc(S, P);
}
__device__ __forceinline__ void phase_topk(const Ctx& C, int layer) {
    const bf16_t* Q = (const bf16_t*)(C.ws + A_B3); const bf16_t* KEYS = (const bf16_t*)(C.ws + WS_KEYS) + (size_t)layer * 8 * 2 * 128 * 128;
    int* IDX = (int*)(C.ws + A_B4); float* GATE = (float*)(C.ws + A_B4) + (size_t)MT * 128;
    const int lane = C.lane, r = lane & 31, hh = lane >> 5;
    for (int task = C.gw; task < (MT / 32) * 8; task += C.NGW) {
        const int tg = task >> 3, h = task & 7, m = tg * 32 + r;
        unsigned S1[16], S2[16];
        subkey_top16(Q + (size_t)m * 2048 + h * 256 + 8 * hh, KEYS + ((size_t)(h * 2 + 0) * 128 + r) * 128 + 8 * hh, hh, S1);
        subkey_top16(Q + (size_t)m * 2048 + h * 256 + 128 + 8 * hh, KEYS + ((size_t)(h * 2 + 1) * 128 + r) * 128 + 8 * hh, hh, S2);
#define CKEY(a, b) ((ford(funord(S1[a] & ~0x7fu) + funord(S2[b] & ~0x7fu)) & ~0xffu) | (unsigned)((a) << 4 | (b)))
        unsigned FK[16], G[16];
#pragma unroll
        for (int b = 0; b < 16; ++b) FK[b] = CKEY(0, b);
#pragma unroll
        for (int b = 0; b < 8; ++b) G[b] = CKEY(1, b);
#pragma unroll
        for (int b = 0; b < 5; ++b) G[8 + b] = CKEY(2, b);
#pragma unroll
        for (int b = 0; b < 3; ++b) G[13 + b] = CKEY(4, b);
        sort16_desc(G); merge16_desc(FK, G);
#pragma unroll
        for (int b = 0; b < 4; ++b) G[b] = CKEY(3, b);
#pragma unroll
        for (int b = 0; b < 2; ++b) { G[4 + b] = CKEY(5, b); G[6 + b] = CKEY(6, b); G[8 + b] = CKEY(7, b); }
#pragma unroll
        for (int a = 8; a < 14; ++a) G[2 + a] = CKEY(a, 0);
        sort16_desc(G); merge16_desc(FK, G);
        ins16(FK, CKEY(14, 0)); ins16(FK, CKEY(15, 0));
#undef CKEY
        unsigned I1p[4], I2p[4];
#pragma unroll
        for (int w = 0; w < 4; ++w) { I1p[w] = (S1[4 * w] & 0x7fu) | ((S1[4 * w + 1] & 0x7fu) << 8) | ((S1[4 * w + 2] & 0x7fu) << 16) | ((S1[4 * w + 3] & 0x7fu) << 24);
                                      I2p[w] = (S2[4 * w] & 0x7fu) | ((S2[4 * w + 1] & 0x7fu) << 8) | ((S2[4 * w + 2] & 0x7fu) << 16) | ((S2[4 * w + 3] & 0x7fu) << 24); }
        const float mx = funord(FK[0] & ~0xffu); float sum = 0.f;
#pragma unroll
        for (int i = 0; i < 16; ++i) sum += fexp(funord(FK[i] & ~0xffu) - mx);
        const float rs = 1.0f / sum;
        int oi[8]; float og[8];
#pragma unroll
        for (int i = 0; i < 8; ++i) { const unsigned key = hh ? FK[8 + i] : FK[i]; const unsigned a = (key >> 4) & 15u, b = key & 15u;
            const unsigned w1 = (a >> 2) == 0u ? I1p[0] : ((a >> 2) == 1u ? I1p[1] : ((a >> 2) == 2u ? I1p[2] : I1p[3]));
            const unsigned w2 = (b >> 2) == 0u ? I2p[0] : ((b >> 2) == 1u ? I2p[1] : ((b >> 2) == 2u ? I2p[2] : I2p[3]));
            oi[i] = (int)((((w1 >> ((a & 3u) * 8u)) & 0x7fu) << 7) | ((w2 >> ((b & 3u) * 8u)) & 0x7fu));
            og[i] = fexp(funord(key & ~0xffu) - mx) * rs; }
        const size_t o = (size_t)m * 128 + h * 16 + 8 * hh;
        *(u32x4*)(IDX + o) = (u32x4){(unsigned)oi[0], (unsigned)oi[1], (unsigned)oi[2], (unsigned)oi[3]}; *(u32x4*)(IDX + o + 4) = (u32x4){(unsigned)oi[4], (unsigned)oi[5], (unsigned)oi[6], (unsigned)oi[7]};
        *(f32x4*)(GATE + o) = (f32x4){og[0], og[1], og[2], og[3]}; *(f32x4*)(GATE + o + 4) = (f32x4){og[4], og[5], og[6], og[7]};
    }
}

template <int CTRL, int ROWMASK> __device__ __forceinline__ float dppf(float v) { return __builtin_bit_cast(float, __builtin_amdgcn_update_dpp(0, __builtin_bit_cast(int, v), CTRL, ROWMASK, 0xF, false)); }
__device__ __forceinline__ float wave_sum_u(float v) {
    v += dppf<0xB1, 0xF>(v); v += dppf<0x4E, 0xF>(v); v += dppf<0x141, 0xF>(v); v += dppf<0x140, 0xF>(v);
    v += dppf<0x142, 0xA>(v); v += dppf<0x143, 0xC>(v);
    return __builtin_bit_cast(float, __builtin_amdgcn_readlane(__builtin_bit_cast(int, v), 63));
}
struct RowSet4 { u32x4 u, v; };
__device__ __forceinline__ void load_rows4(RowSet4& R, const unsigned char* U4, const unsigned char* V4, int eid, int lane) {
    const size_t o = (size_t)eid * 1024 + lane * 16; R.u = *(const u32x4*)(U4 + o); R.v = *(const u32x4*)(V4 + o);
}
__device__ __forceinline__ void use_rows4(const u32x4 Ru, const u32x4 Rv, const float (&xf)[32], float gate, float (&out)[32]) {
    float d0 = 0.f, d1 = 0.f;
#define U4_STEP(w, b) { const f32x2 t = __builtin_amdgcn_cvt_scalef32_pk_f32_fp4(Ru[w], 1.0f, b); d0 = fmaf(xf[8 * (w) + 2 * (b)], t.x, d0); d1 = fmaf(xf[8 * (w) + 2 * (b) + 1], t.y, d1); }
#define U4_WORD(w) U4_STEP(w, 0) U4_STEP(w, 1) U4_STEP(w, 2) U4_STEP(w, 3)
    U4_WORD(0) U4_WORD(1) U4_WORD(2) U4_WORD(3)
#undef U4_WORD
#undef U4_STEP
    const float d = wave_sum_u(d0 + d1) * (1.0f / U4_SCALE);
    const float a = gelu_erf(d) * gate * (1.0f / V4_SCALE);
#define V4_STEP(w, b) { const f32x2 t = __builtin_amdgcn_cvt_scalef32_pk_f32_fp4(Rv[w], 1.0f, b); out[8 * (w) + 2 * (b)] = fmaf(a, t.x, out[8 * (w) + 2 * (b)]); out[8 * (w) + 2 * (b) + 1] = fmaf(a, t.y, out[8 * (w) + 2 * (b) + 1]); }
#define V4_WORD(w) V4_STEP(w, 0) V4_STEP(w, 1) V4_STEP(w, 2) V4_STEP(w, 3)
    V4_WORD(0) V4_WORD(1) V4_WORD(2) V4_WORD(3)
#undef V4_WORD
#undef V4_STEP
}
__device__ __forceinline__ void phase_gather(const Ctx& C, int layer) {
    const bf16_t* HN2 = (const bf16_t*)(C.ws + A_B2); const unsigned char* U4 = C.ws + WS_U; const unsigned char* V4 = C.ws + WS_V;
    const int* IDX = (const int*)(C.ws + A_B4); const float* GATE = (const float*)(C.ws + A_B4) + (size_t)MT * 128;
    const float* mod = (const float*)(C.ws + WS_MOD); float* X = C.out + O_Y; bf16_t* HN = (bf16_t*)(C.ws + A_HN);
    const int lane = C.lane;
    for (int m = C.gw; m < MT; m += C.NGW) {
        const int i0 = IDX[(size_t)m * 128 + lane], i1 = IDX[(size_t)m * 128 + 64 + lane];
        const float g0 = GATE[(size_t)m * 128 + lane], g1 = GATE[(size_t)m * 128 + 64 + lane];
        float xf[32];
#pragma unroll
        for (int b = 0; b < 8; ++b) { const u32x2 w = *(const u32x2*)(HN2 + (size_t)m * 2048 + 256 * b + 4 * lane); xf[4 * b] = bf_lo(w.x); xf[4 * b + 1] = bf_hi(w.x); xf[4 * b + 2] = bf_lo(w.y); xf[4 * b + 3] = bf_hi(w.y); }
        float out[32];
#pragma unroll
        for (int i = 0; i < 32; ++i) out[i] = 0.f;
#define EID(j) __builtin_amdgcn_readlane(((j) < 64) ? i0 : i1, (j) & 63)
#define EGT(j) __builtin_bit_cast(float, __builtin_amdgcn_readlane(__builtin_bit_cast(int, ((j) < 64) ? g0 : g1), (j) & 63))
#define SB() __builtin_amdgcn_sched_barrier(0)
        LAS unsigned char* ring = C.lds + C.wave * 16384;
#define RING_ISSUE(j) do { const int eid_ = EID((j) & 127); const int sl_ = (j) & 7; \
            __builtin_amdgcn_global_load_lds((const unsigned*)(U4 + (size_t)eid_ * 1024 + lane * 16), (LAS unsigned*)(ring + sl_ * 2048), 16, 0, 0); \
            __builtin_amdgcn_global_load_lds((const unsigned*)(V4 + (size_t)eid_ * 1024 + lane * 16), (LAS unsigned*)(ring + sl_ * 2048 + 1024), 16, 0, 0); } while (0)
#pragma unroll
        for (int i = 0; i < 32; ++i) asm volatile("" : "+v"(xf[i]));
        { int t0_ = i0, t1_ = i1; float t2_ = g0, t3_ = g1; asm volatile("" : "+v"(t0_), "+v"(t1_), "+v"(t2_), "+v"(t3_)); }
        asm volatile("s_waitcnt vmcnt(0)" ::: "memory");
#pragma unroll
        for (int j = 0; j < 7; ++j) RING_ISSUE(j);
        for (int e = 0; e < 128; ++e) {
            RING_ISSUE(e + 7);
            asm volatile("s_waitcnt vmcnt(14)" ::: "memory");
            const u32x4 ru = *(const LAS u32x4*)(ring + (e & 7) * 2048 + lane * 16), rv = *(const LAS u32x4*)(ring + (e & 7) * 2048 + 1024 + lane * 16);
            use_rows4(ru, rv, xf, EGT(e), out);
        }
        asm volatile("s_waitcnt vmcnt(0)" ::: "memory");
#undef RING_ISSUE
#undef SB
#undef EID
#undef EGT
        const int sq = seq_of_row(m); const float* g2 = mod + ((size_t)layer * NSEQ + sq) * 12288 + 5 * 2048; float* xr = X + (size_t)m * DM;
        float ss = 0.f;
#pragma unroll
        for (int b = 0; b < 8; ++b) { const int c = 256 * b + 4 * lane; const f32x4 xo = *(const f32x4*)(xr + c), gg = *(const f32x4*)(g2 + c);
#pragma unroll
            for (int j = 0; j < 4; ++j) { const float v = xo[j] + gg[j] * out[4 * b + j]; out[4 * b + j] = v; ss += v * v; } }
        const float rstd = __builtin_amdgcn_rsqf(wave_sum(ss) * (1.0f / DM) + RMS_EPS);
        if (layer == 0) {
            const float* n1g = C.in[11] + 2048; const float* mp = mod + ((size_t)1 * NSEQ + sq) * 12288;
#pragma unroll
            for (int b = 0; b < 8; ++b) { const int c = 256 * b + 4 * lane; const f32x4 gv = *(const f32x4*)(n1g + c), sh = *(const f32x4*)(mp + c), sc = *(const f32x4*)(mp + 2048 + c);
                const f32x4 xs = {out[4 * b], out[4 * b + 1], out[4 * b + 2], out[4 * b + 3]}; const f32x4 y = xs * rstd * gv * (sc + 1.0f) + sh;
                *(f32x4*)(xr + c) = xs; u32x2 w; w.x = cvt_pk_bf16(y[0], y[1]); w.y = cvt_pk_bf16(y[2], y[3]); *(u32x2*)(HN + (size_t)m * DM + c) = w; }
        } else {
            const float* fg = C.in[35];
#pragma unroll
            for (int b = 0; b < 8; ++b) { const int c = 256 * b + 4 * lane; const f32x4 gv = *(const f32x4*)(fg + c); const f32x4 xs = {out[4 * b], out[4 * b + 1], out[4 * b + 2], out[4 * b + 3]};
                *(f32x4*)(xr + c) = xs * rstd * gv; }
        }
    }
}
namespace att {
constexpr int SHM_K = 64 * 384, SHM_V = 64 * 256;
constexpr int OFF_K = 0, OFF_V = 2 * SHM_K, OFF_WS = 2 * SHM_K + 3 * SHM_V;
constexpr float SCALE = 0.07216878364870322f;
constexpr float THR = 8.f;
__device__ __forceinline__ int crow(int r, int hi) { return (r & 3) + 8 * (r >> 2) + 4 * hi; }
__device__ __forceinline__ void partialSM(f32x16& p0, f32x16& p1, float& m_reg, float& mn, float& alpha) {
    constexpr float Cc = SCALE * 1.4426950408889634f;
    float pmax = p0[0];
#pragma unroll
    for (int r = 1; r < 16; ++r) pmax = fmaxf(pmax, p0[r]);
#pragma unroll
    for (int r = 0; r < 16; ++r) pmax = fmaxf(pmax, p1[r]);
    { auto rr = __builtin_amdgcn_permlane32_swap(__float_as_uint(pmax), __float_as_uint(pmax), false, false);
      pmax = fmaxf(__uint_as_float(rr[0]), __uint_as_float(rr[1])); }
    if (__builtin_expect(__all(pmax - m_reg <= THR / SCALE), 1)) { mn = m_reg; alpha = 1.f; }
    else { mn = fmaxf(m_reg, pmax); alpha = __builtin_amdgcn_exp2f((m_reg - mn) * Cc); m_reg = mn; }
    const float mnC = -mn * Cc;
#pragma unroll
    for (int r = 0; r < 16; ++r) p0[r] = __builtin_amdgcn_exp2f(fmaf(p0[r], Cc, mnC));
#pragma unroll
    for (int r = 0; r < 16; ++r) p1[r] = __builtin_amdgcn_exp2f(fmaf(p1[r], Cc, mnC));
}
__device__ __forceinline__ void finishSM(const f32x16& p0, const f32x16& p1, float alpha, float& l_reg, bf16x8& pa0, bf16x8& pa1, bf16x8& pa2, bf16x8& pa3) {
    float ps = 0;
#pragma unroll
    for (int r = 0; r < 16; ++r) ps += p0[r];
#pragma unroll
    for (int r = 0; r < 16; ++r) ps += p1[r];
    { auto rr = __builtin_amdgcn_permlane32_swap(__float_as_uint(ps), __float_as_uint(ps), false, false);
      ps = __uint_as_float(rr[0]) + __uint_as_float(rr[1]); }
    l_reg = l_reg * alpha + ps;
#define PK4(P, BASE, OUT) do { unsigned a0 = cvt_pk_bf16(P[BASE + 0], P[BASE + 1]), a1 = cvt_pk_bf16(P[BASE + 2], P[BASE + 3]);   \
    unsigned b0 = cvt_pk_bf16(P[BASE + 4], P[BASE + 5]), b1 = cvt_pk_bf16(P[BASE + 6], P[BASE + 7]);                              \
    auto r0 = __builtin_amdgcn_permlane32_swap(a0, b0, false, false); auto r1 = __builtin_amdgcn_permlane32_swap(a1, b1, false, false); \
    u32x4 w = {r0[0], r1[0], r0[1], r1[1]}; OUT = __builtin_bit_cast(bf16x8, w); } while (0)
    PK4(p0, 0, pa0); PK4(p0, 8, pa1); PK4(p1, 0, pa2); PK4(p1, 8, pa3);
#undef PK4
}
__device__ __forceinline__ int v_rd_base(int lane) { return ((lane & 3) << 3) | (((lane >> 2) & 3) << 6) | (((lane >> 4) & 1) << 5) | (((lane >> 5) & 1) << 8); }
constexpr int v_rd_off(int d0, int ks, int half) { return d0 * 512 + ks * 4096 + half * 2048; }
template <int OFF> __device__ __forceinline__ s16x4 tr_read(int vb) {
    s16x4 r; asm volatile("ds_read_b64_tr_b16 %0, %1 offset:%2" : "=&v"(r) : "v"(vb), "i"(OFF) : "memory"); return r;
}
template <int D0> __device__ __forceinline__ void pv_one(f32x16& od, int vb, bf16x8 pa0, bf16x8 pa1, bf16x8 pa2, bf16x8 pa3) {
    const s16x4 l0 = tr_read<v_rd_off(D0, 0, 0)>(vb), h0 = tr_read<v_rd_off(D0, 0, 1)>(vb), l1 = tr_read<v_rd_off(D0, 1, 0)>(vb), h1 = tr_read<v_rd_off(D0, 1, 1)>(vb);
    const s16x4 l2 = tr_read<v_rd_off(D0, 2, 0)>(vb), h2 = tr_read<v_rd_off(D0, 2, 1)>(vb), l3 = tr_read<v_rd_off(D0, 3, 0)>(vb), h3 = tr_read<v_rd_off(D0, 3, 1)>(vb);
    asm volatile("s_waitcnt lgkmcnt(0)" ::: "memory"); __builtin_amdgcn_sched_barrier(0);
#define PKV(L, H) (bf16x8){L[0], L[1], L[2], L[3], H[0], H[1], H[2], H[3]}
    od = __builtin_amdgcn_mfma_f32_32x32x16_bf16(pa0, PKV(l0, h0), od, 0, 0, 0);
    od = __builtin_amdgcn_mfma_f32_32x32x16_bf16(pa1, PKV(l1, h1), od, 0, 0, 0);
    od = __builtin_amdgcn_mfma_f32_32x32x16_bf16(pa2, PKV(l2, h2), od, 0, 0, 0);
    od = __builtin_amdgcn_mfma_f32_32x32x16_bf16(pa3, PKV(l3, h3), od, 0, 0, 0);
#undef PKV
}
struct AUnit { int qrow0, kvrow0, ntiles, head, vis0, nact; };

__device__ __forceinline__ bool next_unit(int i, int vcu, int G, AUnit& u) {
    int flat;
    if (G == 256) {
        if (i >= 10) return false;
        if (i < 8) { const int bh = vcu >> 3, s = vcu & 7, base = 16 * (i >> 1); const int qb = (i & 1) ? base + 15 - s : base + s; flat = bh * 64 + qb; }
        else flat = 2048 + vcu * 2 + (i - 8);
    } else { flat = i * G + vcu; if (flat >= 2560) return false; }
    if (flat < 2048) { const int bh = flat >> 6, qb = flat & 63, b = bh >> 4; u.head = bh & 15; u.qrow0 = b * 16384 + qb * 256; u.kvrow0 = b * 16384; u.ntiles = 4 * qb + 4; u.vis0 = 4 * qb; u.nact = 8; }
    else { const int f = flat - 2048, b = f >> 4; u.head = f & 15; u.qrow0 = MP + b * 64; u.kvrow0 = MP + b * 1088; u.ntiles = 17; u.vis0 = 1 << 20; u.nact = 2; }
    return true;
}

__device__ __forceinline__ void attn_phase(const Ctx& C) {
    bf16_t* Qn = (bf16_t*)(C.ws + A_HN); const bf16_t* Qp = (const bf16_t*)(C.ws + A_GG);
    const bf16_t* Kn = (const bf16_t*)(C.ws + A_KN); const bf16_t* Kp = (const bf16_t*)(C.ws + A_KP); const bf16_t* Vv = (const bf16_t*)(C.ws + A_VV);
    LAS unsigned char* lds = C.lds; const int wid = C.wave, lane = C.lane, r32 = lane & 31, hi = lane >> 5;
    LAS float* wsp = (LAS float*)(lds + OFF_WS) + wid * 64; LAS float* li_l = wsp; LAS float* al_l = wsp + 32;
    long koff[3]; bool kisn[3];
#pragma unroll
    for (int i = 0; i < 3; ++i) { const int Uq = (wid * 3 + i) * 64 + lane, row = Uq / 24, cp = Uq % 24, c = cp ^ ((row >> 1) & 7);
        kisn[i] = c < 16; koff[i] = kisn[i] ? (long)row * 2048 + c * 8 : (long)row * 64 + (c - 16) * 8; }
    long voff[2];
#pragma unroll
    for (int i = 0; i < 2; ++i) { const int by = ((wid * 2 + i) * 64 + lane) * 16, sub = by >> 9, within = by & 511, kk = (sub >> 2) * 8 + (within >> 6), cc = (sub & 3) * 32 + ((within & 63) >> 1);
        const int k = (kk & ~0xC) | ((kk & 4) << 1) | ((kk & 8) >> 1); voff[i] = (long)k * 2048 + cc; }
    int klo[4];
#pragma unroll
    for (int q = 0; q < 4; ++q) klo[q] = r32 * 384 + ((((2 * q + hi) ^ ((r32 >> 1) & 7))) << 4);
    const int vb0 = (int)(uintptr_t)(lds + OFF_V) + v_rd_base(lane);
#define ATT_BAR() __builtin_amdgcn_s_barrier()
#define ATT_ISSUE(j, kb, vbi) do { _Pragma("unroll") for (int _i = 0; _i < 3; ++_i) { const bf16_t* src = kisn[_i] ? Kn + ((long)(u.kvrow0 + (j) * 64) * 2048 + u.head * 128) + koff[_i] : Kp + (long)(u.kvrow0 + (j) * 64) * 64 + koff[_i]; \
        __builtin_amdgcn_global_load_lds((const unsigned*)src, (LAS unsigned*)(lds + OFF_K + (kb) * SHM_K + (wid * 3 + _i) * 1024), 16, 0, 0); } \
      _Pragma("unroll") for (int _i = 0; _i < 2; ++_i) { const bf16_t* src = Vv + ((long)(u.kvrow0 + (j) * 64) * 2048 + u.head * 128) + voff[_i]; \
        __builtin_amdgcn_global_load_lds((const unsigned*)src, (LAS unsigned*)(lds + OFF_V + (vbi) * SHM_V + (wid * 2 + _i) * 1024), 16, 0, 0); } } while (0)
#define ATT_PV(VBI) do { const int vb = vb0 + (VBI) * SHM_V; \
      pv_one<0>(o[0], vb, pa0, pa1, pa2, pa3); pv_one<1>(o[1], vb, pa0, pa1, pa2, pa3); pv_one<2>(o[2], vb, pa0, pa1, pa2, pa3); pv_one<3>(o[3], vb, pa0, pa1, pa2, pa3); } while (0)
    const bool grpY = wid >= 4;
    AUnit u;
    for (int ui = 0; next_unit(ui, C.vcu, C.G, u); ++ui) {
        const bool active = wid < u.nact; const int vis = u.vis0 + (wid >> 1);
        const int qrow = u.qrow0 + wid * 32 + r32;
        bf16x8 qr[12];
        if (active) {
#pragma unroll
            for (int d0 = 0; d0 < 8; ++d0) qr[d0] = *(const bf16x8*)(Qn + (size_t)qrow * 2048 + u.head * 128 + d0 * 16 + hi * 8);
#pragma unroll
            for (int d0 = 0; d0 < 4; ++d0) qr[8 + d0] = *(const bf16x8*)(Qp + (size_t)qrow * 1024 + u.head * 64 + d0 * 16 + hi * 8);
        } else {
#pragma unroll
            for (int d0 = 0; d0 < 12; ++d0) qr[d0] = (bf16x8){0, 0, 0, 0, 0, 0, 0, 0};
        }
#pragma unroll
        for (int d0 = 0; d0 < 12; ++d0) asm volatile("" : "+v"(qr[d0]));
        float m_reg = -1e30f, l_reg = 0.f; f32x16 o[4];
#pragma unroll
        for (int d = 0; d < 4; ++d)
#pragma unroll
            for (int r = 0; r < 16; ++r) o[d][r] = 0.f;
        bf16x8 pa0 = (bf16x8){0, 0, 0, 0, 0, 0, 0, 0}, pa1 = pa0, pa2 = pa0, pa3 = pa0;
        const int NT = u.ntiles;
        int vprev = 2, vcur = 0, vnext = 1;
        ATT_ISSUE(0, 0, 0);
        for (int j = 0; j < NT; ++j) {
            const int buf = j & 1;
            if (j + 1 < NT) { ATT_ISSUE(j + 1, buf ^ 1, vnext); asm volatile("s_waitcnt vmcnt(5)" ::: "memory"); }
            else asm volatile("s_waitcnt vmcnt(0)" ::: "memory");
            ATT_BAR();
            if (active) {
                if (grpY && j >= 1 && j - 1 <= vis) ATT_PV(vprev);
                if (j <= vis) {
                    const LAS unsigned char* Kb = lds + OFF_K + buf * SHM_K;
                    f32x16 p0, p1;
#pragma unroll
                    for (int r = 0; r < 16; ++r) { p0[r] = 0.f; p1[r] = 0.f; }
#pragma unroll
                    for (int d0 = 0; d0 < 12; ++d0) {
                        const bf16x8 b0 = *(const LAS bf16x8*)(Kb + klo[d0 & 3] + (d0 >> 2) * 128);
                        const bf16x8 b1 = *(const LAS bf16x8*)(Kb + klo[d0 & 3] + (d0 >> 2) * 128 + 32 * 384);
                        p0 = __builtin_amdgcn_mfma_f32_32x32x16_bf16(b0, qr[d0], p0, 0, 0, 0);
                        p1 = __builtin_amdgcn_mfma_f32_32x32x16_bf16(b1, qr[d0], p1, 0, 0, 0);
                    }
                    float mn, alpha; partialSM(p0, p1, m_reg, mn, alpha);
                    if (__any(alpha < 1.f)) { if (hi == 0) al_l[r32] = alpha; asm volatile("s_waitcnt lgkmcnt(0)" ::: "memory");
#pragma unroll
                        for (int r = 0; r < 16; ++r) { const float al = al_l[crow(r, hi)];
#pragma unroll
                            for (int d = 0; d < 4; ++d) o[d][r] *= al; } }
                    finishSM(p0, p1, alpha, l_reg, pa0, pa1, pa2, pa3);
                    if (!grpY) ATT_PV(vcur);
                }
            }
            asm volatile("s_waitcnt lgkmcnt(0)" ::: "memory");
            ATT_BAR();
            { const int t_ = vprev; vprev = vcur; vcur = vnext; vnext = t_; }
        }
        if (active && grpY && NT - 1 <= vis) ATT_PV(vprev);
        asm volatile("s_waitcnt lgkmcnt(0)" ::: "memory");
        ATT_BAR();
        if (active) {
            if (hi == 0) li_l[r32] = l_reg; asm volatile("s_waitcnt lgkmcnt(0)" ::: "memory");
            bf16_t* Ow = Qn + (size_t)(u.qrow0 + wid * 32) * 2048 + u.head * 128;
#pragma unroll
            for (int r = 0; r < 16; ++r) { const int orow = crow(r, hi); const float rl = __builtin_amdgcn_rcpf(li_l[orow]);
#pragma unroll
                for (int d0 = 0; d0 < 4; ++d0) { const unsigned w = cvt_pk_bf16(o[d0][r] * rl, 0.f); Ow[(size_t)orow * 2048 + d0 * 32 + r32] = (bf16_t)(w & 0xffffu); } }
        }
    }
#undef ATT_BAR
#undef ATT_ISSUE
#undef ATT_PV
}
}
#ifndef MK_SPLIT
#define MK_SPLIT 0
#endif
constexpr int N_PHASES = 22;

__global__ void __launch_bounds__(512, 2) mega_fwd(Args args) {
    extern __shared__ __attribute__((aligned(16))) unsigned char lds_raw[];
    Ctx C;
    C.lds = (LAS unsigned char*)lds_raw;
    C.tid = threadIdx.x; C.lane = C.tid & 63; C.wave = __builtin_amdgcn_readfirstlane(C.tid >> 6);
    C.G = gridDim.x; { const int bx = blockIdx.x; C.vcu = (C.G % 8 == 0) ? (bx % 8) * (C.G / 8) + bx / 8 : bx; }
    C.gw = C.vcu * 8 + C.wave; C.NGW = C.G * 8;
    C.in = args.in; C.out = args.out; C.ws = args.ws;
    volatile LAS unsigned* misc = (volatile LAS unsigned*)(C.lds + LDS_MISC);
    if (C.tid < 4) misc[C.tid] = 0u;
    __syncthreads();
    const int lo = args.ph_lo, hi = args.ph_hi;
    XcdBarrier bar; bar.bar = (unsigned*)(C.ws + WS_CTL) + CW_BAR; bar.x = 0; bar.st = misc;
    if (hi - lo > 1) bar = xcd_barrier_post((unsigned*)(C.ws + WS_CTL) + CW_BAR, misc);
#ifdef PH_ONLY
#define IN(k) ((k) == PH_ONLY)
#else
#define IN(k) (lo <= (k) && (k) < hi)
#endif
#define SEAM(k) do { if (IN(k) && IN((k) + 1)) xcd_barrier(bar); } while (0)
    unsigned char* ws = C.ws;
    const float* mod = (const float*)(ws + WS_MOD);
    float* X = C.out + O_Y;
    LAS unsigned char* glds = C.lds;

    if (IN(0)) { phase_prologue(C); } SEAM(0);
    if (IN(1)) { phase_norm(C, C.in[0], C.in[1], C.in[11], mod, 0, (bf16_t*)(ws + A_HN)); } SEAM(1);
    if (IN(2)) {
        pg8::Gemm g{(const bf16_t*)(ws + A_HN), (const bf16_t*)(ws + WS_WIN), MT, 3072, 2048, 2048, 2048, 0, 0}; pg8::StaticOrder S; S.init(MT, 3072, C.G, (int)blockIdx.x);
        pg8::EpiZ E{(bf16_t*)(ws + A_GG), (bf16_t*)(ws + A_B2), (bf16_t*)(ws + A_B2) + (size_t)MT * 1024};
        pg8::gemm_phase<pg8::EpiZ>(glds, g, S, E); } SEAM(2);
    if (IN(3)) { phase_convpool(C); } SEAM(3);
    if (IN(4)) {
        { pg8::Gemm g{(const bf16_t*)(ws + A_B3), (const bf16_t*)(ws + WS_WGATE), MT, 2048, 256, 1024, 256, 1, 256}; pg8::StaticOrder S; S.init(MT, 2048, C.G, (int)blockIdx.x);
          pg8::EpiGate E{(const bf16_t*)(ws + A_B3), (const float*)(ws + WS_SP), (float*)(ws + A_B4)};
          pg8::gemm_phase<pg8::EpiGate>(glds, g, S, E); }
 } SEAM(4);
    if (IN(5)) {
        { pg8::Gemm g{(const bf16_t*)(ws + A_B3) + (size_t)MT * 1024, (const bf16_t*)(ws + WS_WPOOL), MT, 1024, 256, 1024, 256, 0, 256}; pg8::StaticOrder S; S.init(MT, 1024, C.G, (int)blockIdx.x);
          pg8::EpiPool E{(bf16_t*)(ws + A_HN), C.in[22]};
          pg8::gemm_phase<pg8::EpiPool>(glds, g, S, E); }
        phase_scanA(C); } SEAM(5);
    if (IN(6)) { phase_scanB(C); } SEAM(6);
    if (IN(7)) { phase_scanC(C); } SEAM(7);
    if (IN(8)) {
        pg8::Gemm g{(const bf16_t*)(ws + A_HN), (const bf16_t*)(ws + WS_WOUTR), MT, 2048, 2048, 2048, 2048, 0, 0}; pg8::StaticOrder S; S.init(MT, 2048, C.G, (int)blockIdx.x);
        pg8::EpiBf16 E{(bf16_t*)(ws + A_B3), 2048};
        pg8::gemm_phase<pg8::EpiBf16>(glds, g, S, E); } SEAM(8);
#define PEER_BLOCK(P0, L) \
    if (IN(P0)) { phase_resid_norm(C, (L) == 0 ? C.in[0] : X, (L) == 0 ? C.in[1] : X + (size_t)MP * DM, (const bf16_t*)(ws + A_B3), X, C.in[12] + (L) * 2048, mod + (size_t)(L) * NSEQ * 12288, (bf16_t*)(ws + A_B2)); } SEAM(P0); \
    if (IN(P0 + 1)) { pg8::Gemm g{(const bf16_t*)(ws + A_B2), (const bf16_t*)(ws + WS_WQ) + (size_t)(L) * 2048 * 2048, MT, 2048, 2048, 2048, 2048, 0, 0}; pg8::StaticOrder S; S.init(MT, 2048, C.G, (int)blockIdx.x); \
        pg8::EpiBf16 E{(bf16_t*)(ws + A_B3), 2048}; pg8::gemm_phase<pg8::EpiBf16>(glds, g, S, E); } SEAM(P0 + 1); \
    if (IN(P0 + 2)) { phase_topk(C, L); } SEAM(P0 + 2); \
    if (IN(P0 + 3)) { phase_gather(C, L); }
    PEER_BLOCK(9, 0) SEAM(12);
    if (IN(13)) {
        pg8::Gemm g{(const bf16_t*)(ws + A_HN), (const bf16_t*)(ws + WS_WDQKV), MT, 1024, 2048, 2048, 2048, 0, 0}; pg8::StaticOrder S; S.init(MT, 1024, C.G, (int)blockIdx.x);
        pg8::EpiF32 E{(float*)(ws + A_B3), 1024};
        pg8::gemm_phase<pg8::EpiF32>(glds, g, S, E); } SEAM(13);
    if (IN(14)) { phase_latent(C); } SEAM(14);
    if (IN(15)) {
        { pg8::Gemm g{(const bf16_t*)(ws + A_CQ), (const bf16_t*)(ws + WS_WUQ), MT, 3072, 512, 512, 512, 0, 0}; pg8::StaticOrder S; S.init(MT, 3072, C.G, (int)blockIdx.x);
          pg8::EpiQ E{(bf16_t*)(ws + A_HN), (bf16_t*)(ws + A_GG), (const float*)(ws + WS_ROPE)};
          pg8::gemm_phase<pg8::EpiQ>(glds, g, S, E); }
        { pg8::Gemm g{(const bf16_t*)(ws + A_CKV), (const bf16_t*)(ws + WS_WUKV), KVROWS, 4096, 256, 256, 256, 0, 0}; pg8::StaticOrder S; S.init(KVROWS, 4096, C.G, (int)blockIdx.x);
          pg8::EpiKV E{(bf16_t*)(ws + A_KN), (bf16_t*)(ws + A_VV)};
          pg8::gemm_phase<pg8::EpiKV>(glds, g, S, E); } } SEAM(15);
    if (IN(16)) { att::attn_phase(C); } SEAM(16);
    if (IN(17)) {
        pg8::Gemm g{(const bf16_t*)(ws + A_HN), (const bf16_t*)(ws + WS_WOUTA), MT, 2048, 2048, 2048, 2048, 0, 0}; pg8::StaticOrder S; S.init(MT, 2048, C.G, (int)blockIdx.x);
        pg8::EpiBf16 E{(bf16_t*)(ws + A_B3), 2048};
        pg8::gemm_phase<pg8::EpiBf16>(glds, g, S, E); } SEAM(17);
    PEER_BLOCK(18, 1)
#undef PEER_BLOCK
#undef IN
#undef SEAM
}

extern "C" void kernel_launch(void* const* d_in, const int* in_sizes, int n_in, void* d_out, int out_size, void* d_ws, size_t ws_size, hipStream_t stream) {
    static int grid = 0;
    if (grid == 0) {
        if (n_in != 36 || out_size != (int)O_TOTAL || ws_size < WS_END) { fprintf(stderr, "kernel_launch: built for 36 inputs, %zu outputs, >= %zu B workspace; got n_in %d out %d ws %zu\n", (size_t)O_TOTAL, (size_t)WS_END, n_in, out_size, ws_size); grid = -1; return; }
        int dev = 0, cus = 0, per_cu = 0;
        if (hipGetDevice(&dev) != hipSuccess || hipDeviceGetAttribute(&cus, hipDeviceAttributeMultiprocessorCount, dev) != hipSuccess) { fprintf(stderr, "kernel_launch: device query failed\n"); grid = -1; return; }
        if (hipFuncSetAttribute((const void*)mega_fwd, hipFuncAttributeMaxDynamicSharedMemorySize, LDS_BYTES) != hipSuccess) { fprintf(stderr, "kernel_launch: hipFuncSetAttribute failed\n"); grid = -1; return; }
        if (hipOccupancyMaxActiveBlocksPerMultiprocessor(&per_cu, (const void*)mega_fwd, 512, LDS_BYTES) != hipSuccess || per_cu < 1) { fprintf(stderr, "kernel_launch: occupancy query says %d blocks per CU\n", per_cu); }
        (void)hipGetLastError();
        grid = cus;
    }
    if (grid < 0) return;
    (void)hipMemsetAsync(d_ws, 0, WS_ZERO_BYTES, stream);
    Args a{};
    for (int i = 0; i < 36; ++i) a.in[i] = (const float*)d_in[i];
    a.out = (float*)d_out; a.ws = (unsigned char*)d_ws;
#if MK_SPLIT
    for (int p = 0; p < N_PHASES; ++p) { a.ph_lo = p; a.ph_hi = p + 1; hipLaunchKernelGGL(mega_fwd, dim3(grid), dim3(512), LDS_BYTES, stream, a); }
#elif defined(PROBE_RANGES)
    { const int rg[][2] = {PROBE_RANGES};
      for (unsigned i = 0; i < sizeof(rg) / sizeof(rg[0]); ++i) { if (i) (void)hipMemsetAsync(d_ws, 0, 1 * MiB, stream); a.ph_lo = rg[i][0]; a.ph_hi = rg[i][1]; hipLaunchKernelGGL(mega_fwd, dim3(grid), dim3(512), LDS_BYTES, stream, a); } }
#else
    a.ph_lo = 0; a.ph_hi = N_PHASES; hipLaunchKernelGGL(mega_fwd, dim3(grid), dim3(512), LDS_BYTES, stream, a);
#endif
    const hipError_t le = hipPeekAtLastError();
    if (le != hipSuccess) fprintf(stderr, "kernel_launch: launch failed: %s\n", hipGetErrorName(le));
}
```

```cpp
#include <hip/hip_runtime.h>
#include <cstdio>
#include <cstdint>

#define LAS __attribute__((address_space(3)))
#define GAS __attribute__((address_space(1)))
typedef unsigned short bf16_t;
typedef short bf16x8 __attribute__((ext_vector_type(8)));
typedef short s16x4 __attribute__((ext_vector_type(4)));
typedef float f32x2 __attribute__((ext_vector_type(2)));
typedef float f32x4 __attribute__((ext_vector_type(4)));
typedef float f32x16 __attribute__((ext_vector_type(16)));
typedef unsigned u32x2 __attribute__((ext_vector_type(2)));
typedef unsigned u32x4 __attribute__((ext_vector_type(4)));

constexpr int DM = 2048;
constexpr int MP = 32768, MS = 2048, MT = MP + MS;
constexpr int NSEQ = 34;
constexpr int KVROWS = MP + 32 * 1088;
constexpr float RMS_EPS = 1e-6f;

__device__ __forceinline__ int seq_of_row(int m) { return m < MP ? (m >> 14) : 2 + ((m - MP) >> 6); }
__device__ __forceinline__ int pos_of_row(int m) { return m < MP ? (m & 16383) : 1024 + ((m - MP) & 63); }
__device__ __forceinline__ int kvrow_of_row(int m) { return m < MP ? m : MP + ((m - MP) >> 6) * 1088 + 1024 + ((m - MP) & 63); }

__device__ __forceinline__ unsigned cvt_pk_bf16(float lo, float hi) { unsigned r; asm volatile("v_cvt_pk_bf16_f32 %0, %1, %2" : "=v"(r) : "v"(lo), "v"(hi)); return r; }
__device__ __forceinline__ float bf_lo(unsigned w) { return __uint_as_float(w << 16); }
__device__ __forceinline__ float bf_hi(unsigned w) { return __uint_as_float(w & 0xffff0000u); }
__device__ __forceinline__ float fexp(float x) { return __builtin_amdgcn_exp2f(x * 1.4426950408889634f); }
__device__ __forceinline__ float fsigmoid(float x) { return __builtin_amdgcn_rcpf(1.0f + __builtin_amdgcn_exp2f(-1.4426950408889634f * x)); }
__device__ __forceinline__ float gelu_tanh(float x) { const float u = x * (1.0f + 0.044715f * x * x); return x * __builtin_amdgcn_rcpf(1.0f + __builtin_amdgcn_exp2f(-2.302208198f * u)); }
__device__ __forceinline__ float gelu_erf(float v) {
    const float av = __builtin_fabsf(v), t = __builtin_amdgcn_rcpf(av * 0.2316418882f + 1.0f);
    float q = t * 0.5307027145f + (-0.7265760135f); q = q * t + 0.7107068705f; q = q * t + (-0.142248368f); q = q * t + 0.127414796f; q = q * t;
    const float e = __builtin_amdgcn_exp2f((v * v) * (-0.72134752044f));
    const float m = v * (q * e); return v < 0.f ? m : v - m;
}
__device__ __forceinline__ float wave_sum(float v) {
#pragma unroll
    for (int o = 32; o >= 1; o >>= 1) v += __shfl_xor(v, o);
    return v;
}

namespace pg8 {
constexpr int BM = 256, BK = 64, HALF = 128, HTB = HALF * BK * 2, STAGE_BYTES = 8 * HTB, NXCD = 8, WGM = 8;
__host__ __device__ __forceinline__ int lds_byte(int r, int c) { const int st = (r >> 4) * 2 + (c >> 5), rr = r & 15, cc = c & 31, ob = rr * 64 + cc * 2; return st * 1024 + (ob ^ (((ob >> 9) & 1) << 5)); }
__host__ __device__ __forceinline__ void stage_rc(int b, int& R, int& C) { const int st = b / 1024, sb = b % 1024, swz = sb ^ (((sb >> 9) & 1) << 5); R = (st >> 1) * 16 + swz / 64; C = (st & 1) * 32 + (swz % 64) / 2; }
__host__ __device__ __forceinline__ int perm32(int rho) { const int n = rho >> 4, i = rho & 15; return 8 * (i >> 2) + 4 * n + (i & 3); }

struct Unit { int pm, pn; };
struct Gemm { const bf16_t* A; const bf16_t* Bt; int M, N, K, lda, ldb, kshift, kmul; };

struct StaticOrder {
    int nM, nN, nwg, G, c;
    __host__ __device__ void init(int M, int N, int G_, int c_) { nM = M / BM; nN = N / BM; nwg = nM * nN; G = G_; c = c_; }
    __host__ __device__ bool next(int i, Unit& u) const {
        const long L = (long)i * G + c; if (L >= nwg) return false;
        int wgid = (int)L; { const int q = nwg / NXCD, r = nwg % NXCD, xcd = wgid % NXCD, off = wgid / NXCD; wgid = (xcd < r ? xcd * (q + 1) : r * (q + 1) + (xcd - r) * q) + off; }
        const int nig = WGM * nN, gid = wgid / nig, fm = gid * WGM, gsz = (nM - fm) < WGM ? (nM - fm) : WGM;
        u.pm = fm + ((wgid % nig) % gsz); u.pn = (wgid % nig) / gsz; return true;
    }
};

template <class Epi>
__device__ __forceinline__ void gemm_phase(LAS unsigned char* lds, const Gemm g, const StaticOrder& S, const Epi& E) {
    const int tid = threadIdx.x, wid = __builtin_amdgcn_readfirstlane(tid >> 6), lane = tid & 63, wr = wid >> 2, wc = wid & 3, fr = lane & 15, fq = lane >> 4;
    int Kq = g.K; asm volatile("" : "+s"(Kq));
    const int K = Kq, nt = K / BK;
    unsigned voffA[2], voffB[2];
#pragma unroll
    for (int i = 0; i < 2; ++i) { int R, C; stage_rc(tid * 16 + i * 8192, R, C); const int Rb = Epi::PERM ? ((R & ~31) + perm32(R & 31)) : R;
        voffA[i] = (unsigned)(R * g.lda + C) * 2u; voffB[i] = (unsigned)(Rb * g.ldb + C) * 2u; }
    const size_t kstep = (size_t)(BK * 2);
    const size_t hstepA = (size_t)HALF * g.lda * 2, hstepB = (size_t)HALF * g.ldb * 2;
    const unsigned ldsw = (unsigned)wid * 1024u;
    const int aoff = lds_byte(wr * 64 + fr, fq * 8), boff = lds_byte(wc * 32 + fr, fq * 8);
#define PG8_SA(b, h) (((b) * 2 + (h)) * HTB)
#define PG8_SB(b, h) ((4 + (b) * 2 + (h)) * HTB)
#define PG8_STAGE(bufoff, gbase, voff) do { _Pragma("unroll") for (int _i = 0; _i < 2; ++_i) \
        __builtin_amdgcn_global_load_lds((const unsigned*)((const char*)(gbase) + (voff)[_i]), (LAS unsigned*)(lds + (bufoff) + ldsw + _i * 8192), 16, 0, 0); } while (0)
#define PG8_LDA(dst, b, h) do { _Pragma("unroll") for (int m = 0; m < 4; ++m) _Pragma("unroll") for (int k = 0; k < 2; ++k) dst[m][k] = *(const LAS bf16x8*)(lds + PG8_SA(b, h) + aoff + m * 2048 + k * 1024); } while (0)
#define PG8_LDB(dst, b, h) do { _Pragma("unroll") for (int n = 0; n < 2; ++n) _Pragma("unroll") for (int k = 0; k < 2; ++k) dst[n][k] = *(const LAS bf16x8*)(lds + PG8_SB(b, h) + boff + n * 2048 + k * 1024); } while (0)
#define PG8_MMA(ai, bj, At, Bt) do { __builtin_amdgcn_s_setprio(1); _Pragma("unroll") for (int m = 0; m < 4; ++m) _Pragma("unroll") for (int n = 0; n < 2; ++n) _Pragma("unroll") for (int k = 0; k < 2; ++k) \
        acc[ai][bj][m][n] = __builtin_amdgcn_mfma_f32_16x16x32_bf16(Bt[n][k], At[m][k], acc[ai][bj][m][n], 0, 0, 0); __builtin_amdgcn_s_setprio(0); } while (0)
#define PG8_WAIT_V(n) asm volatile("s_waitcnt vmcnt(" #n ")" ::: "memory")
#define PG8_WAIT_L(n) asm volatile("s_waitcnt lgkmcnt(" #n ")" ::: "memory")
#define PG8_BAR __builtin_amdgcn_s_barrier()
#define PG8_SCHED __builtin_amdgcn_sched_barrier(0)
#define PG8_ABASE(u) ((const char*)g.A + (size_t)(u).pm * (2 * hstepA) + (size_t)(((u).pn >> g.kshift) * g.kmul) * 2)
#define PG8_BBASE(u) ((const char*)g.Bt + (size_t)(u).pn * (2 * hstepB))
    Unit cur, nxt; int ui = 0;
    if (!S.next(0, cur)) return;
    f32x4 acc[2][2][4][2];
#pragma unroll
    for (int a = 0; a < 2; ++a)
#pragma unroll
        for (int b = 0; b < 2; ++b)
#pragma unroll
            for (int m = 0; m < 4; ++m)
#pragma unroll
                for (int n = 0; n < 2; ++n) acc[a][b][m][n] = (f32x4){0.f, 0.f, 0.f, 0.f};
    bf16x8 At[4][2], B0[2][2], B1[2][2];
    const char* cA = PG8_ABASE(cur); const char* cB = PG8_BBASE(cur);
    PG8_STAGE(PG8_SB(0, 0), cB, voffB); PG8_STAGE(PG8_SB(0, 1), cB + hstepB, voffB); PG8_STAGE(PG8_SA(0, 0), cA, voffA); PG8_STAGE(PG8_SA(0, 1), cA + hstepA, voffA);
    if (wr == 1) PG8_BAR;
    PG8_WAIT_V(2); PG8_BAR;
    PG8_STAGE(PG8_SB(1, 0), cB + kstep, voffB); PG8_STAGE(PG8_SA(1, 0), cA + kstep, voffA); PG8_STAGE(PG8_SB(1, 1), cB + hstepB + kstep, voffB);
    PG8_WAIT_V(6); PG8_BAR;
    for (;;) {
        const bool has_next = S.next(ui + 1, nxt);
        const char* nA = has_next ? PG8_ABASE(nxt) : cA; const char* nB = has_next ? PG8_BBASE(nxt) : cB;
        for (int t = 0; t < nt; t += 2) {
            const bool last = (t == nt - 2);
            const char* a1 = cA + (size_t)(t + 1) * kstep;
            const char* a2 = last ? nA : cA + (size_t)(t + 2) * kstep; const char* b2 = last ? nB : cB + (size_t)(t + 2) * kstep;
            const char* a3 = a2 + kstep; const char* b3 = b2 + kstep;
            PG8_LDB(B0, 0, 0); PG8_LDB(B1, 0, 1); PG8_SCHED; PG8_LDA(At, 0, 0); PG8_STAGE(PG8_SA(1, 1), a1 + hstepA, voffA);
            PG8_WAIT_V(8); PG8_WAIT_L(0); PG8_BAR; PG8_MMA(0, 0, At, B0); PG8_MMA(0, 1, At, B1); PG8_BAR; PG8_SCHED;
            PG8_LDA(At, 0, 1); PG8_STAGE(PG8_SB(0, 0), b2, voffB); PG8_STAGE(PG8_SB(0, 1), b2 + hstepB, voffB); PG8_STAGE(PG8_SA(0, 0), a2, voffA);
            PG8_WAIT_V(8); PG8_WAIT_L(0); PG8_BAR; PG8_MMA(1, 0, At, B0); PG8_MMA(1, 1, At, B1); PG8_BAR; PG8_SCHED;
            PG8_LDB(B0, 1, 0); PG8_LDB(B1, 1, 1); PG8_SCHED; PG8_LDA(At, 1, 0); PG8_STAGE(PG8_SA(0, 1), a2 + hstepA, voffA);
            PG8_WAIT_V(8); PG8_WAIT_L(0); PG8_BAR; PG8_MMA(0, 0, At, B0); PG8_MMA(0, 1, At, B1); PG8_BAR; PG8_SCHED;
            PG8_LDA(At, 1, 1); PG8_STAGE(PG8_SB(1, 0), b3, voffB); PG8_STAGE(PG8_SB(1, 1), b3 + hstepB, voffB); PG8_STAGE(PG8_SA(1, 0), a3, voffA);
            PG8_WAIT_V(8); PG8_WAIT_L(0); PG8_BAR; PG8_MMA(1, 0, At, B0); PG8_MMA(1, 1, At, B1); PG8_BAR; PG8_SCHED;
        }
        if (wr == 0) PG8_BAR;
        E(acc, cur, wr, wc, fr, fq);
        if (!has_next) break;
#pragma unroll
        for (int a = 0; a < 2; ++a)
#pragma unroll
            for (int b = 0; b < 2; ++b)
#pragma unroll
                for (int m = 0; m < 4; ++m)
#pragma unroll
                    for (int n = 0; n < 2; ++n) acc[a][b][m][n] = (f32x4){0.f, 0.f, 0.f, 0.f};
        cur = nxt; cA = nA; cB = nB; ++ui;
        if (wr == 1) PG8_BAR;
    }
    PG8_WAIT_V(0);
    PG8_BAR;
#undef PG8_SA
#undef PG8_SB
#undef PG8_STAGE
#undef PG8_LDA
#undef PG8_LDB
#undef PG8_MMA
#undef PG8_WAIT_V
#undef PG8_WAIT_L
#undef PG8_BAR
#undef PG8_SCHED
#undef PG8_ABASE
#undef PG8_BBASE
}
}
namespace pg8 {
#define EPI_ROWS(expr_row) for (int ai = 0; ai < 2; ++ai) for (int m = 0; m < 4; ++m)
struct EpiBf16 {
    static constexpr bool PERM = true;
    bf16_t* O; int ldc;
    __device__ __forceinline__ void operator()(const f32x4 (&acc)[2][2][4][2], const Unit& u, int wr, int wc, int fr, int fq) const {
        const int row0 = u.pm * BM + wr * 64 + fr, col0 = u.pn * BM + wc * 32 + 8 * fq;
#pragma unroll
        for (int ai = 0; ai < 2; ++ai)
#pragma unroll
            for (int m = 0; m < 4; ++m) { bf16_t* rowp = O + (size_t)(row0 + ai * HALF + m * 16) * ldc + col0;
#pragma unroll
                for (int bj = 0; bj < 2; ++bj) { const f32x4 v0 = acc[ai][bj][m][0], v1 = acc[ai][bj][m][1];
                    u32x4 w; w.x = cvt_pk_bf16(v0[0], v0[1]); w.y = cvt_pk_bf16(v0[2], v0[3]); w.z = cvt_pk_bf16(v1[0], v1[1]); w.w = cvt_pk_bf16(v1[2], v1[3]);
                    *(u32x4*)(rowp + bj * HALF) = w; } }
    }
};
struct EpiZ {
    static constexpr bool PERM = true;
    bf16_t* GG; bf16_t* REC; bf16_t* POOL;
    __device__ __forceinline__ void operator()(const f32x4 (&acc)[2][2][4][2], const Unit& u, int wr, int wc, int fr, int fq) const {
        const int t = u.pn >> 2; bf16_t* base = GG + (size_t)t * ((size_t)MT * 1024);
        const int row0 = u.pm * BM + wr * 64 + fr, col0 = (u.pn & 3) * BM + wc * 32 + 8 * fq;
#pragma unroll
        for (int ai = 0; ai < 2; ++ai)
#pragma unroll
            for (int m = 0; m < 4; ++m) { bf16_t* rowp = base + (size_t)(row0 + ai * HALF + m * 16) * 1024 + col0;
#pragma unroll
                for (int bj = 0; bj < 2; ++bj) { f32x4 v0 = acc[ai][bj][m][0], v1 = acc[ai][bj][m][1];
                    if (t == 0) {
#pragma unroll
                        for (int j = 0; j < 4; ++j) { v0[j] = gelu_tanh(v0[j]); v1[j] = gelu_tanh(v1[j]); } }
                    u32x4 w; w.x = cvt_pk_bf16(v0[0], v0[1]); w.y = cvt_pk_bf16(v0[2], v0[3]); w.z = cvt_pk_bf16(v1[0], v1[1]); w.w = cvt_pk_bf16(v1[2], v1[3]);
                    *(u32x4*)(rowp + bj * HALF) = w; } }
    }
};
struct EpiGate {
    static constexpr bool PERM = false;
    const bf16_t* XC; const float* gp; float* Aout;
    __device__ __forceinline__ void operator()(const f32x4 (&acc)[2][2][4][2], const Unit& u, int wr, int wc, int fr, int fq) const {
        const int row0 = u.pm * BM + wr * 64 + fr, ch0 = u.pn * 128 + wc * 32 + 4 * fq;
#pragma unroll
        for (int n = 0; n < 2; ++n) {
            const f32x4 bav = *(const f32x4*)(gp + ch0 + 16 * n), bxv = *(const f32x4*)(gp + 1024 + ch0 + 16 * n), spv = *(const f32x4*)(gp + 2048 + ch0 + 16 * n);
#pragma unroll
            for (int ai = 0; ai < 2; ++ai)
#pragma unroll
                for (int m = 0; m < 4; ++m) { const int row = row0 + ai * HALF + m * 16; const bool pos0 = (row < MP) && ((row & 16383) == 0);
                    const size_t off = (size_t)row * 1024 + ch0 + 16 * n;
                    const u32x2 xw = *(const u32x2*)(XC + off); const float xc[4] = {bf_lo(xw.x), bf_hi(xw.x), bf_lo(xw.y), bf_hi(xw.y)};
                    f32x4 av, uv;
#pragma unroll
                    for (int j = 0; j < 4; ++j) { const float r = fsigmoid(acc[ai][0][m][n][j] + bav[j]), ig = fsigmoid(acc[ai][1][m][n][j] + bxv[j]);
                        const float log_a = -8.0f * r * spv[j]; const float a = fexp(log_a); const float mult = pos0 ? 1.0f : __builtin_sqrtf(fmaxf(1.0f - a * a, 0.0f));
                        av[j] = a; uv[j] = mult * ig * xc[j]; }
                    *(f32x4*)(Aout + off) = av; { u32x2 uw; uw.x = cvt_pk_bf16(uv[0], uv[1]); uw.y = cvt_pk_bf16(uv[2], uv[3]); *(u32x2*)((bf16_t*)(Aout + (size_t)MT * 1024) + off) = uw; } asm volatile("" ::: "memory"); }
        }
    }
};
struct EpiPool {
    static constexpr bool PERM = true;
    bf16_t* CAT; const float* spool;
    __device__ __forceinline__ void operator()(const f32x4 (&acc)[2][2][4][2], const Unit& u, int wr, int wc, int fr, int fq) const {
        const int row0 = u.pm * BM + wr * 64 + fr, col0 = u.pn * BM + wc * 32 + 8 * fq;
        f32x4 s0[2], s1[2];
#pragma unroll
        for (int bj = 0; bj < 2; ++bj) { s0[bj] = *(const f32x4*)(spool + col0 + bj * HALF); s1[bj] = *(const f32x4*)(spool + col0 + bj * HALF + 4); }
#pragma unroll
        for (int ai = 0; ai < 2; ++ai)
#pragma unroll
            for (int m = 0; m < 4; ++m) { bf16_t* rowp = CAT + (size_t)(row0 + ai * HALF + m * 16) * 2048 + 1024 + col0;
#pragma unroll
                for (int bj = 0; bj < 2; ++bj) { const f32x4 v0 = acc[ai][bj][m][0] * s0[bj], v1 = acc[ai][bj][m][1] * s1[bj];
                    u32x4 w; w.x = cvt_pk_bf16(v0[0], v0[1]); w.y = cvt_pk_bf16(v0[2], v0[3]); w.z = cvt_pk_bf16(v1[0], v1[1]); w.w = cvt_pk_bf16(v1[2], v1[3]);
                    *(u32x4*)(rowp + bj * HALF) = w; } }
    }
};
struct EpiResid {
    static constexpr bool PERM = false;
    const float* xinP; const float* xinS; float* xout; const float* gate;
    __device__ __forceinline__ void operator()(const f32x4 (&acc)[2][2][4][2], const Unit& u, int wr, int wc, int fr, int fq) const {
        const int row0 = u.pm * BM + wr * 64 + fr, col0 = u.pn * BM + wc * 32 + 4 * fq;
#pragma unroll
        for (int ai = 0; ai < 2; ++ai)
#pragma unroll
            for (int m = 0; m < 4; ++m) { const int row = row0 + ai * HALF + m * 16; const float* gp = gate + (size_t)seq_of_row(row) * 12288 + col0;
                const float* xi = (row < MP ? xinP + (size_t)row * DM : xinS + (size_t)(row - MP) * DM) + col0; float* xo = xout + (size_t)row * DM + col0;
#pragma unroll
                for (int bj = 0; bj < 2; ++bj)
#pragma unroll
                    for (int n = 0; n < 2; ++n) { const int o = bj * HALF + n * 16; *(f32x4*)(xo + o) = *(const f32x4*)(xi + o) + *(const f32x4*)(gp + o) * acc[ai][bj][m][n]; }
                asm volatile("" ::: "memory"); }
    }
};
struct EpiF32 {
    static constexpr bool PERM = false;
    float* C; int ldc;
    __device__ __forceinline__ void operator()(const f32x4 (&acc)[2][2][4][2], const Unit& u, int wr, int wc, int fr, int fq) const {
        const int row0 = u.pm * BM + wr * 64 + fr, col0 = u.pn * BM + wc * 32 + 4 * fq;
#pragma unroll
        for (int ai = 0; ai < 2; ++ai)
#pragma unroll
            for (int m = 0; m < 4; ++m) { float* rowp = C + (size_t)(row0 + ai * HALF + m * 16) * ldc + col0;
#pragma unroll
                for (int bj = 0; bj < 2; ++bj)
#pragma unroll
                    for (int n = 0; n < 2; ++n) *(f32x4*)(rowp + bj * HALF + n * 16) = acc[ai][bj][m][n]; }
    }
};
struct EpiQ {
    static constexpr bool PERM = true;
    bf16_t* Qn; bf16_t* Qp; const float* rope;
    __device__ __forceinline__ void operator()(const f32x4 (&acc)[2][2][4][2], const Unit& u, int wr, int wc, int fr, int fq) const {
        const int row0 = u.pm * BM + wr * 64 + fr;
        if (u.pn < 8) {
            const int col0 = u.pn * BM + wc * 32 + 8 * fq;
#pragma unroll
            for (int ai = 0; ai < 2; ++ai)
#pragma unroll
                for (int m = 0; m < 4; ++m) { bf16_t* rowp = Qn + (size_t)(row0 + ai * HALF + m * 16) * 2048 + col0;
#pragma unroll
                    for (int bj = 0; bj < 2; ++bj) { const f32x4 v0 = acc[ai][bj][m][0], v1 = acc[ai][bj][m][1];
                        u32x4 w; w.x = cvt_pk_bf16(v0[0], v0[1]); w.y = cvt_pk_bf16(v0[2], v0[3]); w.z = cvt_pk_bf16(v1[0], v1[1]); w.w = cvt_pk_bf16(v1[2], v1[3]);
                        *(u32x4*)(rowp + bj * HALF) = w; } }
        } else {
            const int head = (u.pn - 8) * 4 + wc, j0 = 8 * fq;
#pragma unroll
            for (int ai = 0; ai < 2; ++ai)
#pragma unroll
                for (int m = 0; m < 4; ++m) { const int row = row0 + ai * HALF + m * 16; const float* rp = rope + (size_t)pos_of_row(row) * 64 + j0;
                    const f32x4 c0 = *(const f32x4*)(rp), c1 = *(const f32x4*)(rp + 4), s0 = *(const f32x4*)(rp + 32), s1 = *(const f32x4*)(rp + 36);
                    const f32x4 x10 = acc[ai][0][m][0], x11 = acc[ai][0][m][1], x20 = acc[ai][1][m][0], x21 = acc[ai][1][m][1];
                    const f32x4 a0 = x10 * c0 - x20 * s0, a1 = x11 * c1 - x21 * s1, b0 = x10 * s0 + x20 * c0, b1 = x11 * s1 + x21 * c1;
                    bf16_t* qp = Qp + (size_t)row * 1024 + head * 64 + j0;
                    u32x4 w; w.x = cvt_pk_bf16(a0[0], a0[1]); w.y = cvt_pk_bf16(a0[2], a0[3]); w.z = cvt_pk_bf16(a1[0], a1[1]); w.w = cvt_pk_bf16(a1[2], a1[3]); *(u32x4*)qp = w;
                    w.x = cvt_pk_bf16(b0[0], b0[1]); w.y = cvt_pk_bf16(b0[2], b0[3]); w.z = cvt_pk_bf16(b1[0], b1[1]); w.w = cvt_pk_bf16(b1[2], b1[3]); *(u32x4*)(qp + 32) = w; }
        }
    }
};
struct EpiKV {
    static constexpr bool PERM = true;
    bf16_t* Kn; bf16_t* V;
    __device__ __forceinline__ void operator()(const f32x4 (&acc)[2][2][4][2], const Unit& u, int wr, int wc, int fr, int fq) const {
        const int row0 = u.pm * BM + wr * 64 + fr, col0 = u.pn * 128 + wc * 32 + 8 * fq;
#pragma unroll
        for (int ai = 0; ai < 2; ++ai)
#pragma unroll
            for (int m = 0; m < 4; ++m) { const size_t off = (size_t)(row0 + ai * HALF + m * 16) * 2048 + col0;
#pragma unroll
                for (int bj = 0; bj < 2; ++bj) { const f32x4 v0 = acc[ai][bj][m][0], v1 = acc[ai][bj][m][1];
                    u32x4 w; w.x = cvt_pk_bf16(v0[0], v0[1]); w.y = cvt_pk_bf16(v0[2], v0[3]); w.z = cvt_pk_bf16(v1[0], v1[1]); w.w = cvt_pk_bf16(v1[2], v1[3]);
                    *(u32x4*)((bj ? V : Kn) + off) = w; } }
    }
};
#undef EPI_ROWS
}

#define XB_TMO      128
#define XB_XCNT(j)  (256  + 64 * (j))
#define XB_XSUB(j)  (1280 + 64 * (j))
#define XB_XGEN(j)  (2304 + 64 * (j))
#define XB_TOP      3328
#define XB_TOPGEN   3392
#define XCD_BAR_WORDS 3456
#define XB_SPIN_CAP (1u << 18)
__device__ __forceinline__ unsigned xb_ld(unsigned* p)              { return __hip_atomic_load(p, __ATOMIC_RELAXED, __HIP_MEMORY_SCOPE_AGENT); }
__device__ __forceinline__ unsigned xb_add(unsigned* p, unsigned v) { return __hip_atomic_fetch_add(p, v, __ATOMIC_RELAXED, __HIP_MEMORY_SCOPE_AGENT); }
__device__ __forceinline__ unsigned xb_xcc_id() { return (unsigned)__builtin_amdgcn_s_getreg((3 << 11) | 20) & 0xFu; }
#define XB_SPIN(cond, bar) do { unsigned _sp = 0; while (cond) { __builtin_amdgcn_s_sleep(1); \
    if ((++_sp & 255u) == 0u) { if (xb_ld(&(bar)[XB_TMO])) break; if (_sp > XB_SPIN_CAP) { atomicAdd(&(bar)[XB_TMO], 1u); break; } } } } while (0)
struct XcdBarrier { unsigned* bar; unsigned x; volatile LAS unsigned* st; };
__device__ __forceinline__ XcdBarrier xcd_barrier_post(unsigned* bar, volatile LAS unsigned* st) {
    XcdBarrier b; b.bar = bar; b.x = xb_xcc_id(); b.st = st;
    if (threadIdx.x == 0) (void)xb_add(&bar[XB_XCNT(b.x)], 1u);
    return b;
}
__device__ __forceinline__ void xcd_barrier_complete(unsigned* bar, unsigned x, unsigned& nloc, unsigned& nx) {
    const unsigned G = gridDim.x * gridDim.y * gridDim.z;
    unsigned sum, cnt, mine, sp = 0u;
    for (;;) {
        sum = 0u; cnt = 0u; mine = 0u;
#pragma unroll
        for (unsigned j = 0; j < 16; ++j) { const unsigned c = xb_ld(&bar[XB_XCNT(j)]); sum += c; cnt += (c > 0u) ? 1u : 0u; mine = (j == x) ? c : mine; }
        if (sum == G) break;
        __builtin_amdgcn_s_sleep(1);
        if ((++sp & 255u) == 0u) { if (xb_ld(&bar[XB_TMO])) break; if (sp > XB_SPIN_CAP) { atomicAdd(&bar[XB_TMO], 1u); break; } }
    }
    nloc = mine > 0u ? mine : 1u; nx = cnt > 0u ? cnt : 1u;
}
__device__ __forceinline__ void xcd_barrier(const XcdBarrier& b) {
    asm volatile("s_waitcnt vmcnt(0)" ::: "memory");
    __syncthreads();
    if (threadIdx.x == 0) {
        unsigned* bar = b.bar;
        __builtin_amdgcn_s_waitcnt(0);
        unsigned nloc = b.st[0], nx = b.st[1];
        if (nloc == 0u) { xcd_barrier_complete(bar, b.x, nloc, nx); b.st[0] = nloc; b.st[1] = nx; }
        const unsigned old = xb_add(&bar[XB_XSUB(b.x)], 1u);
        const unsigned gen = old / nloc;
        if (old + 1u == (gen + 1u) * nloc) {
            __builtin_amdgcn_fence(__ATOMIC_RELEASE, "agent");
            asm volatile("s_waitcnt vmcnt(0)" ::: "memory");
            const unsigned og = xb_add(&bar[XB_TOP], 1u);
            const unsigned tg = og / nx;
            if (og + 1u == (tg + 1u) * nx) xb_add(&bar[XB_TOPGEN], 1u);
            else XB_SPIN(xb_ld(&bar[XB_TOPGEN]) == tg, bar);
            __builtin_amdgcn_fence(__ATOMIC_ACQUIRE, "agent");
            xb_add(&bar[XB_XGEN(b.x)], 1u);
            asm volatile("s_waitcnt vmcnt(0)" ::: "memory");
        } else {
            XB_SPIN(xb_ld(&bar[XB_XGEN(b.x)]) == gen, bar);
            __builtin_amdgcn_fence(__ATOMIC_ACQUIRE, "agent");
            asm volatile("s_waitcnt vmcnt(0)" ::: "memory");
        }
    }
    __syncthreads();
}
constexpr float U8_SCALE = 256.0f, V8_SCALE = 16.0f;
__device__ __forceinline__ void convert_fp8_range(const float* src, unsigned char* dst, float scale, size_t n16, size_t i0, size_t stride) {
    for (size_t i = i0; i < n16; i += stride) { u32x4 w;
#pragma unroll
        for (int q = 0; q < 4; ++q) { f32x4 a = *(const f32x4*)(src + i * 16 + 4 * q) * scale;
#pragma unroll
            for (int j = 0; j < 4; ++j) a[j] = fminf(fmaxf(a[j], -448.0f), 448.0f);
            int t = 0; t = __builtin_amdgcn_cvt_pk_fp8_f32(a[0], a[1], t, false); t = __builtin_amdgcn_cvt_pk_fp8_f32(a[2], a[3], t, true); w[q] = (unsigned)t; }
        *(u32x4*)(dst + i * 16) = w; }
}
constexpr float U4_SCALE = 90.50966799f, V4_SCALE = 8.0f;
__device__ __forceinline__ void convert_fp4_rows(const float* src, unsigned char* dst, float scale, int nrows, int w0, int wstride, int lane) {
    for (int r = w0; r < nrows; r += wstride) { const float* sr = src + (size_t)r * 2048 + 4 * lane; u32x4 w;
        f32x4 a[8];
#pragma unroll
        for (int b = 0; b < 8; ++b) a[b] = *(const f32x4*)(sr + 256 * b) * scale;
#pragma unroll
        for (int q = 0; q < 4; ++q) { float e[8] = {a[2 * q][0], a[2 * q][1], a[2 * q][2], a[2 * q][3], a[2 * q + 1][0], a[2 * q + 1][1], a[2 * q + 1][2], a[2 * q + 1][3]};
#pragma unroll
            for (int j = 0; j < 8; ++j) e[j] = fminf(fmaxf(e[j], -6.0f), 6.0f);
            unsigned t = 0u; t = __builtin_amdgcn_cvt_scalef32_pk_fp4_f32(t, e[0], e[1], 1.0f, 0); t = __builtin_amdgcn_cvt_scalef32_pk_fp4_f32(t, e[2], e[3], 1.0f, 1);
            t = __builtin_amdgcn_cvt_scalef32_pk_fp4_f32(t, e[4], e[5], 1.0f, 2); t = __builtin_amdgcn_cvt_scalef32_pk_fp4_f32(t, e[6], e[7], 1.0f, 3); w[q] = t; }
        *(u32x4*)(dst + (size_t)r * 1024 + 16 * lane) = w; }
}
constexpr size_t MiB = (size_t)1 << 20;
constexpr size_t WS_CTL = 0, WS_WGATE = 1 * MiB, WS_WDQKV = 2 * MiB, WS_ZERO_BYTES = 6 * MiB;
constexpr size_t WS_WIN = 6 * MiB, WS_WOUTR = 18 * MiB, WS_WQ = 26 * MiB, WS_WUQ = 42 * MiB, WS_WUKV = 45 * MiB, WS_WOUTA = 47 * MiB;
constexpr size_t WS_WPOOL = 55 * MiB, WS_KEYS = 56 * MiB, WS_MOD = 57 * MiB, WS_ROPE = 61 * MiB, WS_SP = 65 * MiB, WS_SCAN = 66 * MiB;
constexpr size_t WS_U = 73 * MiB, WS_V = 137 * MiB;
constexpr size_t A_HN = 201 * MiB, A_GG = 337 * MiB, A_B2 = 405 * MiB, A_B3 = 541 * MiB, A_B4 = 677 * MiB;
constexpr size_t A_KN = 405 * MiB, A_VV = 669 * MiB, A_KP = 933 * MiB, A_CQ = 942 * MiB, A_CKV = 976 * MiB, WS_END = 1009 * MiB;
constexpr int CW_BAR = 4096;
constexpr size_t SCAN_WORDS = (size_t)544 * 1024;
constexpr size_t O_Y = 0, O_CONV_P = 71303168, O_CONV_S = 71309312, O_H_P = 71407616, O_H_S = 71409664, O_POOL_P = 71442432, O_POOL_S = 71473152,
                 O_CKV = 71964672, O_KPE = 80877568, O_TOTAL = 83105792;
constexpr int LDS_BYTES = 147456, LDS_MISC = 147200;

struct Args { const float* in[36]; float* out; unsigned char* ws; int ph_lo, ph_hi; };

struct Ctx {
    LAS unsigned char* lds; int tid, lane, wave, vcu, G, gw, NGW;
    const float* const* in; float* out; unsigned char* ws;
};

__device__ __forceinline__ void transpose_item(const float* W, int N, int k0, int n0, bf16_t* WT, int dld, int drow0, int dcol0, LAS float* scr, int lane) {
#pragma unroll 8
    for (int i = 0; i < 32; ++i) { const int kk = 2 * i + (lane >> 5); scr[kk * 33 + (lane & 31)] = W[(size_t)(k0 + kk) * N + n0 + (lane & 31)]; }
    asm volatile("s_waitcnt lgkmcnt(0)" ::: "memory");
    const int c = lane & 7;
#pragma unroll
    for (int j = 0; j < 4; ++j) { const int n = (lane >> 3) + 8 * j; const LAS float* s = scr + (8 * c) * 33 + n;
        u32x4 o; o.x = cvt_pk_bf16(s[0 * 33], s[1 * 33]); o.y = cvt_pk_bf16(s[2 * 33], s[3 * 33]); o.z = cvt_pk_bf16(s[4 * 33], s[5 * 33]); o.w = cvt_pk_bf16(s[6 * 33], s[7 * 33]);
        *(u32x4*)(WT + (size_t)(drow0 + n) * dld + dcol0 + 8 * c) = o; }
    asm volatile("s_waitcnt lgkmcnt(0)" ::: "memory");
}
__device__ __forceinline__ void transpose_mat_item(const float* W, int K, int N, bf16_t* WT, int dld, int drow_base, int dcol_base, int item, LAS float* scr, int lane) {
    const int nblk = N / 32, kb = item / nblk, nb = item % nblk;
    transpose_item(W, N, 64 * kb, 32 * nb, WT, dld, drow_base + 32 * nb, dcol_base + 64 * kb, scr, lane);
}
__device__ __forceinline__ void convert_range(const float* src, bf16_t* dst, size_t n8, size_t i0, size_t stride) {
    for (size_t i = i0; i < n8; i += stride) { const f32x4 a = *(const f32x4*)(src + i * 8), b = *(const f32x4*)(src + i * 8 + 4);
        u32x4 w; w.x = cvt_pk_bf16(a[0], a[1]); w.y = cvt_pk_bf16(a[2], a[3]); w.z = cvt_pk_bf16(b[0], b[1]); w.w = cvt_pk_bf16(b[2], b[3]);
        *(u32x4*)(dst + i * 8) = w; }
}

__device__ __forceinline__ void ada_item(const Ctx& C, int item) {
    const int l = item / 96, nb = item % 96, n0 = nb * 128, w = C.wave, lane = C.lane;
    const float* cP = C.in[2]; const float* cS = C.in[3]; const float* W = C.in[9] + (size_t)l * 2048 * 12288 + n0 + 2 * lane; const float* bias = C.in[10] + (size_t)l * 12288 + n0;
    LAS float* scr = (LAS float*)(C.lds + w * 4608);
    LAS float* sum = (LAS float*)(C.lds + 36864);
    f32x2 acc[34];
#pragma unroll
    for (int s = 0; s < 34; ++s) acc[s] = (f32x2){0.f, 0.f};
    for (int sub = 0; sub < 8; ++sub) {
        const int k0 = 256 * w + 32 * sub;
#pragma unroll
        for (int i = 0; i < 17; ++i) { const int idx = lane + 64 * i, s = idx >> 5, kk = idx & 31;
            const float cv = (s < 2) ? cP[s * 2048 + k0 + kk] : cS[(s - 2) * 2048 + k0 + kk];
            scr[kk * 36 + s] = cv * fsigmoid(cv); }
        asm volatile("s_waitcnt lgkmcnt(0)" ::: "memory");
#pragma unroll 8
        for (int kk = 0; kk < 32; ++kk) {
            const f32x2 w2 = *(const f32x2*)(W + (size_t)(k0 + kk) * 12288);
#pragma unroll
            for (int s4 = 0; s4 < 9; ++s4) { const f32x4 sv = *(const LAS f32x4*)(scr + kk * 36 + 4 * s4);
#pragma unroll
                for (int i = 0; i < 4; ++i) if (4 * s4 + i < 34) acc[4 * s4 + i] += w2 * sv[i]; }
        }
        asm volatile("s_waitcnt lgkmcnt(0)" ::: "memory");
    }
    for (int ww = 0; ww < 8; ++ww) {
        if (w == ww) {
#pragma unroll
            for (int s = 0; s < 34; ++s) { LAS f32x2* p = (LAS f32x2*)(sum + s * 128) + lane; if (ww == 0) *p = acc[s]; else *p = *p + acc[s]; }
        }
        __syncthreads();
    }
    float* mod = (float*)(C.ws + WS_MOD);
    for (int s = w; s < 34; s += 8) { const f32x2 v = *((LAS f32x2*)(sum + s * 128) + lane) + *(const f32x2*)(bias + 2 * lane);
        *(f32x2*)(mod + ((size_t)l * NSEQ + s) * 12288 + n0 + 2 * lane) = v; }
    __syncthreads();
}

__device__ __forceinline__ void phase_prologue(const Ctx& C) {
    const int lane = C.lane;
    constexpr int NADA = 192;
    if (C.vcu < NADA && C.G > NADA) { ada_item(C, C.vcu); }
    else if (C.G <= NADA) { for (int it = C.vcu; it < NADA; it += C.G) ada_item(C, it); }
    {
        unsigned* qhead = (unsigned*)(C.ws + WS_CTL) + 64;
        {
            LAS float* scr = (LAS float*)(C.lds + 72704 + C.wave * 8448);
            bf16_t* w_in = (bf16_t*)(C.ws + WS_WIN); bf16_t* w_outr = (bf16_t*)(C.ws + WS_WOUTR); bf16_t* w_q = (bf16_t*)(C.ws + WS_WQ);
            bf16_t* w_dqkv = (bf16_t*)(C.ws + WS_WDQKV); bf16_t* w_uq = (bf16_t*)(C.ws + WS_WUQ); bf16_t* w_ukv = (bf16_t*)(C.ws + WS_WUKV);
            bf16_t* w_outa = (bf16_t*)(C.ws + WS_WOUTA); bf16_t* w_gate = (bf16_t*)(C.ws + WS_WGATE); bf16_t* w_pool = (bf16_t*)(C.ws + WS_WPOOL);
            constexpr int I_IN = 32 * 96, I_OUTR = 32 * 64, I_Q = 32 * 64, I_DQ = 32 * 16, I_DKV = 32 * 10, I_UQ = 8 * 96, I_UKV = 4 * 128, I_OUTA = 32 * 64, I_GATE = 16 * 8, I_POOL = 4 * 32;
            constexpr int NIT = I_IN + I_OUTR + 2 * I_Q + I_DQ + I_DKV + I_UQ + I_UKV + I_OUTA + I_GATE + I_POOL;
            for (;;) {
                int it = 0; if (lane == 0) it = (int)__hip_atomic_fetch_add(qhead, 1u, __ATOMIC_RELAXED, __HIP_MEMORY_SCOPE_AGENT);
                it = __builtin_amdgcn_readfirstlane(it); if (it >= NIT) break;
                int r = it;
                if (r < I_IN) { transpose_mat_item(C.in[13], 2048, 3072, w_in, 2048, 0, 0, r, scr, lane); continue; } r -= I_IN;
                if (r < I_OUTR) { transpose_mat_item(C.in[23], 2048, 2048, w_outr, 2048, 0, 0, r, scr, lane); continue; } r -= I_OUTR;
                if (r < 2 * I_Q) { const int l = r / I_Q; transpose_mat_item(C.in[31] + (size_t)l * 2048 * 2048, 2048, 2048, w_q + (size_t)l * 2048 * 2048, 2048, 0, 0, r % I_Q, scr, lane); continue; } r -= 2 * I_Q;
                if (r < I_DQ) { transpose_mat_item(C.in[24], 2048, 512, w_dqkv, 2048, 0, 0, r, scr, lane); continue; } r -= I_DQ;
                if (r < I_DKV) { transpose_mat_item(C.in[27], 2048, 320, w_dqkv, 2048, 512, 0, r, scr, lane); continue; } r -= I_DKV;
                if (r < I_UQ) {
                    const int kb = r / 96, nb = r % 96, n0 = 32 * nb, h = n0 / 192, d = n0 % 192;
                    const int drow = (d < 128) ? h * 128 + d : 2048 + (h >> 2) * 256 + ((d - 128) >> 5) * 128 + (h & 3) * 32;
                    transpose_item(C.in[26], 3072, 64 * kb, n0, w_uq, 512, drow, 64 * kb, scr, lane); continue; } r -= I_UQ;
                if (r < I_UKV) { transpose_mat_item(C.in[29], 256, 4096, w_ukv, 256, 0, 0, r, scr, lane); continue; } r -= I_UKV;
                if (r < I_OUTA) { transpose_mat_item(C.in[30], 2048, 2048, w_outa, 2048, 0, 0, r, scr, lane); continue; } r -= I_OUTA;
                if (r < I_GATE) {
                    const int q = r / 8, sub = r % 8, h = q >> 1, gsel = q & 1;
                    const float* src = (gsel ? C.in[18] : C.in[16]) + (size_t)h * 128 * 128;
                    transpose_mat_item(src, 128, 128, w_gate, 256, h * 256 + gsel * 128, (h & 1) * 128, sub, scr, lane); continue; } r -= I_GATE;
                { const int gq = r / 32, sub = r % 32;
                  transpose_mat_item(C.in[21] + (size_t)gq * 256 * 256, 256, 256, w_pool, 256, gq * 256, 0, sub, scr, lane); }
            }
        }
    }
    const size_t gt = (size_t)C.vcu * 512 + C.tid, GT = (size_t)C.G * 512;
    convert_fp4_rows(C.in[33], C.ws + WS_U, U4_SCALE, 16384, C.gw, C.NGW, lane);
    convert_fp4_rows(C.in[34], C.ws + WS_V, V4_SCALE, 16384, C.gw, C.NGW, lane);
    convert_range(C.in[32], (bf16_t*)(C.ws + WS_KEYS), (size_t)2 * 8 * 2 * 128 * 128 / 8, gt, GT);
    { float* rope = (float*)(C.ws + WS_ROPE);
      for (size_t i = gt; i < (size_t)16384 * 32; i += GT) { const int pos = (int)(i >> 5), j = (int)(i & 31);
          double inv = 1.0; for (int q = 0; q < j; ++q) inv *= 0.7498942093324559;
          const double rev = (double)pos * inv * 0.15915494309189535; const float fr = (float)(rev - __builtin_floor(rev));
          rope[(size_t)pos * 64 + j] = __builtin_amdgcn_cosf(fr); rope[(size_t)pos * 64 + 32 + j] = __builtin_amdgcn_sinf(fr); } }
    { float* sp = (float*)(C.ws + WS_SP);
      for (size_t i = gt; i < 1024; i += GT) { sp[i] = C.in[17][i]; sp[1024 + i] = C.in[19][i]; const float y = fexp(-C.in[20][i]); sp[2048 + i] = (y < 0.03f) ? y * (1.0f - y * (0.5f - y * (0.33333333f - y * (0.25f - 0.2f * y)))) : 0.6931471805599453f * __builtin_amdgcn_logf(1.0f + y); } }
}
__device__ __forceinline__ void norm_mod_row(const float* xrow, const float* g, const float* shift, const float* scale, bf16_t* orow, int lane) {
    f32x4 v[8]; float ss = 0.f;
#pragma unroll
    for (int j = 0; j < 8; ++j) { v[j] = *((const f32x4*)xrow + lane + 64 * j); ss += (v[j].x * v[j].x + v[j].y * v[j].y) + (v[j].z * v[j].z + v[j].w * v[j].w); }
    const float rstd = __builtin_amdgcn_rsqf(wave_sum(ss) * (1.0f / DM) + RMS_EPS);
#pragma unroll
    for (int j = 0; j < 8; ++j) { const int q = lane + 64 * j; const f32x4 gv = *((const f32x4*)g + q), sc = *((const f32x4*)scale + q), sh = *((const f32x4*)shift + q);
        const f32x4 y = v[j] * rstd * gv * (sc + 1.0f) + sh;
        u32x2 w; w.x = cvt_pk_bf16(y.x, y.y); w.y = cvt_pk_bf16(y.z, y.w); *((u32x2*)orow + q) = w; }
}
__device__ __forceinline__ void phase_norm(const Ctx& C, const float* xP, const float* xS, const float* g, const float* modl, int part, bf16_t* hn) {
    for (int m = C.gw; m < MT; m += C.NGW) {
        const float* xr = (m < MP) ? xP + (size_t)m * DM : xS + (size_t)(m - MP) * DM; const float* mp = modl + (size_t)seq_of_row(m) * 12288 + part * 2048;
        norm_mod_row(xr, g, mp, mp + 2048, hn + (size_t)m * DM, C.lane);
    }
}

__device__ __forceinline__ void phase_resid_norm(const Ctx& C, const float* xP, const float* xS, const bf16_t* mix, float* X, const float* g, const float* modl, bf16_t* hn) {
    const int lane = C.lane;
    for (int m = C.gw; m < MT; m += C.NGW) {
        const float* xr = (m < MP) ? xP + (size_t)m * DM : xS + (size_t)(m - MP) * DM; const float* mp = modl + (size_t)seq_of_row(m) * 12288;
        f32x4 v[8]; float ss = 0.f;
#pragma unroll
        for (int j = 0; j < 8; ++j) { const int q = lane + 64 * j; const f32x4 xo = *((const f32x4*)xr + q), g1 = *((const f32x4*)(mp + 2 * 2048) + q); const u32x2 mw = *((const u32x2*)(mix + (size_t)m * DM) + q);
            v[j] = xo + g1 * (f32x4){bf_lo(mw.x), bf_hi(mw.x), bf_lo(mw.y), bf_hi(mw.y)}; ss += (v[j].x * v[j].x + v[j].y * v[j].y) + (v[j].z * v[j].z + v[j].w * v[j].w);
            *((f32x4*)(X + (size_t)m * DM) + q) = v[j]; }
        const float rstd = __builtin_amdgcn_rsqf(wave_sum(ss) * (1.0f / DM) + RMS_EPS);
#pragma unroll
        for (int j = 0; j < 8; ++j) { const int q = lane + 64 * j; const f32x4 gv = *((const f32x4*)g + q), sh = *((const f32x4*)(mp + 3 * 2048) + q), sc = *((const f32x4*)(mp + 4 * 2048) + q);
            const f32x4 y = v[j] * rstd * gv * (sc + 1.0f) + sh;
            u32x2 w; w.x = cvt_pk_bf16(y.x, y.y); w.y = cvt_pk_bf16(y.z, y.w); *((u32x2*)(hn + (size_t)m * DM) + q) = w; }
    }
}

__device__ __forceinline__ void ld8bf(const bf16_t* p, float (&v)[8]) { const u32x4 w = *(const u32x4*)p; v[0] = bf_lo(w.x); v[1] = bf_hi(w.x); v[2] = bf_lo(w.y); v[3] = bf_hi(w.y); v[4] = bf_lo(w.z); v[5] = bf_hi(w.z); v[6] = bf_lo(w.w); v[7] = bf_hi(w.w); }
__device__ __forceinline__ void ld8f(const float* p, float (&v)[8]) { const f32x4 a = *(const f32x4*)p, b = *(const f32x4*)(p + 4); v[0] = a.x; v[1] = a.y; v[2] = a.z; v[3] = a.w; v[4] = b.x; v[5] = b.y; v[6] = b.z; v[7] = b.w; }
__device__ __forceinline__ void st8bf(bf16_t* p, const float (&v)[8]) { u32x4 w; w.x = cvt_pk_bf16(v[0], v[1]); w.y = cvt_pk_bf16(v[2], v[3]); w.z = cvt_pk_bf16(v[4], v[5]); w.w = cvt_pk_bf16(v[6], v[7]); *(u32x4*)p = w; }
__device__ __forceinline__ void st8f(float* p, const float (&v)[8]) { *(f32x4*)p = (f32x4){v[0], v[1], v[2], v[3]}; *(f32x4*)(p + 4) = (f32x4){v[4], v[5], v[6], v[7]}; }

__device__ __forceinline__ void phase_convpool(const Ctx& C) {
    const bf16_t* __restrict__ REC = (const bf16_t*)(C.ws + A_B2); const bf16_t* __restrict__ PIN = REC + (size_t)MT * 1024;
    bf16_t* __restrict__ XC = (bf16_t*)(C.ws + A_B3); bf16_t* __restrict__ POOLED = XC + (size_t)MT * 1024;
    const float* convw = C.in[14]; const float* convb = C.in[15]; const float* st_conv = C.in[4]; const float* st_pool = C.in[6];
    const int NITEM = 2 * 544 * 128;
    for (int it0 = C.vcu * 512 + C.tid; it0 < NITEM; it0 += C.G * 512) {
        const bool is_pool = it0 >= 544 * 128; const int it = is_pool ? it0 - 544 * 128 : it0;
        const int chunk = it >> 7, ch0 = (it & 127) * 8;
        const bool samp = chunk >= 512; const int sb = chunk - 512;
        const int row0 = samp ? MP + sb * 64 : chunk * 64;
        const int t0 = samp ? 0 : (chunk & 255) * 64;
        const bool lastc = samp || ((chunk & 255) == 255);
        if (!is_pool) {
            float w0[8], w1[8], w2[8], w3[8], bb[8], p0[8], p1[8], p2[8];
            ld8f(convw + ch0, w0); ld8f(convw + 1024 + ch0, w1); ld8f(convw + 2048 + ch0, w2); ld8f(convw + 3072 + ch0, w3); ld8f(convb + ch0, bb);
            if (samp) { ld8f(st_conv + ((size_t)sb * 3 + 0) * 1024 + ch0, p0); ld8f(st_conv + ((size_t)sb * 3 + 1) * 1024 + ch0, p1); ld8f(st_conv + ((size_t)sb * 3 + 2) * 1024 + ch0, p2); }
            else if (t0 > 0) { ld8bf(REC + (size_t)(row0 - 3) * 1024 + ch0, p0); ld8bf(REC + (size_t)(row0 - 2) * 1024 + ch0, p1); ld8bf(REC + (size_t)(row0 - 1) * 1024 + ch0, p2); }
            else {
#pragma unroll
                for (int j = 0; j < 8; ++j) { p0[j] = 0.f; p1[j] = 0.f; p2[j] = 0.f; } }
            for (int tb = 0; tb < 64; tb += 8) {
                u32x4 raw[8];
#pragma unroll
                for (int q = 0; q < 8; ++q) raw[q] = *(const u32x4*)(REC + (size_t)(row0 + tb + q) * 1024 + ch0);
#pragma unroll
                for (int q = 0; q < 8; ++q) { const u32x4 w = raw[q]; const float cur[8] = {bf_lo(w.x), bf_hi(w.x), bf_lo(w.y), bf_hi(w.y), bf_lo(w.z), bf_hi(w.z), bf_lo(w.w), bf_hi(w.w)}; float o[8];
#pragma unroll
                    for (int j = 0; j < 8; ++j) { o[j] = bb[j] + w0[j] * p0[j] + w1[j] * p1[j] + w2[j] * p2[j] + w3[j] * cur[j]; p0[j] = p1[j]; p1[j] = p2[j]; p2[j] = cur[j]; }
                    st8bf(XC + (size_t)(row0 + tb + q) * 1024 + ch0, o); } }
            if (lastc) { float* dst = samp ? C.out + O_CONV_S + (size_t)sb * 3 * 1024 : C.out + O_CONV_P + (size_t)(chunk >> 8) * 3 * 1024;
                st8f(dst + ch0, p0); st8f(dst + 1024 + ch0, p1); st8f(dst + 2048 + ch0, p2); }
        } else {
            const int gsel = ch0 >> 8, w = 2 << gsel;
            float S[8];
#pragma unroll
            for (int j = 0; j < 8; ++j) S[j] = 0.f;
            for (int tt = 1 - w; tt < 0; ++tt) { float v[8];
                if (samp) ld8f(st_pool + ((size_t)sb * 15 + 15 + tt) * 1024 + ch0, v);
                else if (t0 + tt >= 0) ld8bf(PIN + (size_t)(row0 + tt) * 1024 + ch0, v);
                else {
#pragma unroll
                    for (int j = 0; j < 8; ++j) v[j] = 0.f; }
#pragma unroll
                for (int j = 0; j < 8; ++j) S[j] += v[j]; }
            for (int tb = 0; tb < 64; tb += 8) {
                u32x4 rawc[8]; float oldv[8][8];
#pragma unroll
                for (int q = 0; q < 8; ++q) rawc[q] = *(const u32x4*)(PIN + (size_t)(row0 + tb + q) * 1024 + ch0);
#pragma unroll
                for (int q = 0; q < 8; ++q) { const int tt = tb + q - w + 1;
                    if (tt >= 0 || (!samp && t0 + tt >= 0)) ld8bf(PIN + (size_t)(row0 + tt) * 1024 + ch0, oldv[q]);
                    else if (samp) ld8f(st_pool + ((size_t)sb * 15 + 15 + tt) * 1024 + ch0, oldv[q]);
                    else {
#pragma unroll
                        for (int j = 0; j < 8; ++j) oldv[q][j] = 0.f; } }
#pragma unroll
                for (int q = 0; q < 8; ++q) { const u32x4 wv = rawc[q]; const float cur[8] = {bf_lo(wv.x), bf_hi(wv.x), bf_lo(wv.y), bf_hi(wv.y), bf_lo(wv.z), bf_hi(wv.z), bf_lo(wv.w), bf_hi(wv.w)}; float o[8];
                    const int pos = samp ? 1024 + tb + q : t0 + tb + q; const float rc = 1.0f / (float)((pos + 1 < w) ? pos + 1 : w);
#pragma unroll
                    for (int j = 0; j < 8; ++j) { S[j] += cur[j]; o[j] = S[j] * rc - cur[j]; S[j] -= oldv[q][j]; }
                    st8bf(POOLED + (size_t)(row0 + tb + q) * 1024 + ch0, o); } }
            if (lastc) { float* dst = samp ? C.out + O_POOL_S + (size_t)sb * 15 * 1024 : C.out + O_POOL_P + (size_t)(chunk >> 8) * 15 * 1024;
                for (int i = 0; i < 15; ++i) { float v[8]; ld8bf(PIN + (size_t)(row0 + 49 + i) * 1024 + ch0, v); st8f(dst + (size_t)i * 1024 + ch0, v); } }
        }
    }
}

__device__ __forceinline__ void phase_scanA(const Ctx& C) {
    const float* __restrict__ A = (const float*)(C.ws + A_B4); const bf16_t* __restrict__ U = (const bf16_t*)(A + (size_t)MT * 1024);
    float* __restrict__ cP = (float*)(C.ws + WS_SCAN); float* __restrict__ cH = cP + SCAN_WORDS;
    for (int it = C.vcu * 512 + C.tid; it < 544 * 256; it += C.G * 512) {
        const int chunk = it >> 8, ch = (it & 255) * 4; const int row0 = chunk * 64;
        f32x4 P = {1.f, 1.f, 1.f, 1.f}, H = {0.f, 0.f, 0.f, 0.f};
        for (int tb = 0; tb < 64; tb += 8) { f32x4 av[8], uv[8];
#pragma unroll
            for (int q = 0; q < 8; ++q) { av[q] = *(const f32x4*)(A + (size_t)(row0 + tb + q) * 1024 + ch); const u32x2 uw = *(const u32x2*)(U + (size_t)(row0 + tb + q) * 1024 + ch); uv[q] = (f32x4){bf_lo(uw.x), bf_hi(uw.x), bf_lo(uw.y), bf_hi(uw.y)}; }
#pragma unroll
            for (int q = 0; q < 8; ++q) { H = av[q] * H + uv[q]; P = P * av[q]; } }
        *(f32x4*)(cP + (size_t)chunk * 1024 + ch) = P; *(f32x4*)(cH + (size_t)chunk * 1024 + ch) = H;
    }
}
__device__ __forceinline__ void phase_scanB(const Ctx& C) {
    const float* __restrict__ cP = (const float*)(C.ws + WS_SCAN); const float* __restrict__ cH = cP + SCAN_WORDS; float* __restrict__ cI = (float*)(C.ws + WS_SCAN) + 2 * SCAN_WORDS;
    const int it = C.vcu * 512 + C.tid;
    if (it < 2048) { const int s = it >> 10, ch = it & 1023; float carry = 0.f;
        for (int cb = 0; cb < 256; cb += 16) { float pv[16], hv[16];
#pragma unroll
            for (int q = 0; q < 16; ++q) { const size_t o = (size_t)(s * 256 + cb + q) * 1024 + ch; pv[q] = cP[o]; hv[q] = cH[o]; }
#pragma unroll
            for (int q = 0; q < 16; ++q) { cI[(size_t)(s * 256 + cb + q) * 1024 + ch] = carry; carry = pv[q] * carry + hv[q]; } } }
}
__device__ __forceinline__ void phase_scanC(const Ctx& C) {
    const float* __restrict__ A = (const float*)(C.ws + A_B4); const bf16_t* __restrict__ U = (const bf16_t*)(A + (size_t)MT * 1024); const float* __restrict__ cI = (const float*)(C.ws + WS_SCAN) + 2 * SCAN_WORDS;
    const bf16_t* __restrict__ GG = (const bf16_t*)(C.ws + A_GG); bf16_t* __restrict__ CAT = (bf16_t*)(C.ws + A_HN); const float* hprev = C.in[5];
    for (int it = C.vcu * 512 + C.tid; it < 544 * 256; it += C.G * 512) {
        const int chunk = it >> 8, ch = (it & 255) * 4; const int row0 = chunk * 64; const bool samp = chunk >= 512;
        f32x4 h = samp ? *(const f32x4*)(hprev + (size_t)(chunk - 512) * 1024 + ch) : *(const f32x4*)(cI + (size_t)chunk * 1024 + ch);
        for (int tb = 0; tb < 64; tb += 8) { f32x4 av[8], uv[8]; u32x2 gv[8];
#pragma unroll
            for (int q = 0; q < 8; ++q) { const size_t o = (size_t)(row0 + tb + q) * 1024 + ch; av[q] = *(const f32x4*)(A + o); { const u32x2 uw = *(const u32x2*)(U + o); uv[q] = (f32x4){bf_lo(uw.x), bf_hi(uw.x), bf_lo(uw.y), bf_hi(uw.y)}; } gv[q] = *(const u32x2*)(GG + o); }
#pragma unroll
            for (int q = 0; q < 8; ++q) { h = av[q] * h + uv[q];
                u32x2 w; w.x = cvt_pk_bf16(bf_lo(gv[q].x) * h.x, bf_hi(gv[q].x) * h.y); w.y = cvt_pk_bf16(bf_lo(gv[q].y) * h.z, bf_hi(gv[q].y) * h.w);
                *(u32x2*)(CAT + (size_t)(row0 + tb + q) * 2048 + ch) = w; } }
        if (samp) *(f32x4*)(C.out + O_H_S + (size_t)(chunk - 512) * 1024 + ch) = h;
        else if ((chunk & 255) == 255) *(f32x4*)(C.out + O_H_P + (size_t)(chunk >> 8) * 1024 + ch) = h;
    }
}

__device__ __forceinline__ void phase_latent(const Ctx& C) {
    const float* CQKV = (const float*)(C.ws + A_B3); bf16_t* CQ = (bf16_t*)(C.ws + A_CQ); bf16_t* CKV = (bf16_t*)(C.ws + A_CKV); bf16_t* KP = (bf16_t*)(C.ws + A_KP);
    const float* gq = C.in[25]; const float* gkv = C.in[28]; const float* rope = (const float*)(C.ws + WS_ROPE); const int lane = C.lane;
    for (int m = C.gw; m < MT; m += C.NGW) {
        const float* r = CQKV + (size_t)m * 1024; const int kvr = kvrow_of_row(m);
        { float v[8]; ld8f(r + lane * 8, v); float ss = 0.f;
#pragma unroll
          for (int j = 0; j < 8; ++j) ss += v[j] * v[j];
          const float rstd = __builtin_amdgcn_rsqf(wave_sum(ss) * (1.0f / 512) + RMS_EPS); float g[8]; ld8f(gq + lane * 8, g);
#pragma unroll
          for (int j = 0; j < 8; ++j) v[j] = v[j] * rstd * g[j];
          st8bf(CQ + (size_t)m * 512 + lane * 8, v); }
        { const f32x4 v = *(const f32x4*)(r + 512 + lane * 4); const float ss = (v.x * v.x + v.y * v.y) + (v.z * v.z + v.w * v.w);
          const float rstd = __builtin_amdgcn_rsqf(wave_sum(ss) * (1.0f / 256) + RMS_EPS); const f32x4 y = v * rstd * *(const f32x4*)(gkv + lane * 4);
          *(f32x4*)(C.out + O_CKV + (size_t)m * 256 + lane * 4) = y;
          u32x2 w; w.x = cvt_pk_bf16(y.x, y.y); w.y = cvt_pk_bf16(y.z, y.w); *(u32x2*)(CKV + (size_t)kvr * 256 + lane * 4) = w; }
        { const float x = r[768 + lane]; const float xo = __shfl_xor(x, 32); const int j = lane & 31; const float* rp = rope + (size_t)pos_of_row(m) * 64;
          const float c = rp[j], s = rp[32 + j]; const float y = (lane < 32) ? x * c - xo * s : xo * s + x * c;
          C.out[O_KPE + (size_t)m * 64 + lane] = y; const unsigned yb = cvt_pk_bf16(y, y); KP[(size_t)kvr * 64 + lane] = (bf16_t)(yb & 0xffffu); }
    }
    const size_t gt = (size_t)C.vcu * 512 + C.tid, GT = (size_t)C.G * 512;
    for (size_t i = gt; i < (size_t)32 * 1024 * 256 / 8; i += GT) { const size_t e = i * 8, rowc = e / 256, col = e % 256, b = rowc / 1024, p = rowc % 1024;
        float v[8]; ld8f(C.in[7] + e, v); st8bf(CKV + ((size_t)MP + b * 1088 + p) * 256 + col, v); }
    for (size_t i = gt; i < (size_t)32 * 1024 * 64 / 8; i += GT) { const size_t e = i * 8, rowc = e / 64, col = e % 64, b = rowc / 1024, p = rowc % 1024;
        float v[8]; ld8f(C.in[8] + e, v); st8bf(KP + ((size_t)MP + b * 1088 + p) * 64 + col, v); }
    convert_fp4_rows(C.in[33] + (size_t)16384 * 2048, C.ws + WS_U, U4_SCALE, 16384, C.gw, C.NGW, lane);
    convert_fp4_rows(C.in[34] + (size_t)16384 * 2048, C.ws + WS_V, V4_SCALE, 16384, C.gw, C.NGW, lane);
}
typedef __bf16 bf2_t __attribute__((ext_vector_type(2)));
__device__ __forceinline__ unsigned ford(float f) { const unsigned u = __float_as_uint(f); return (u & 0x80000000u) ? ~u : (u | 0x80000000u); }
__device__ __forceinline__ float funord(unsigned o) { return __uint_as_float((o & 0x80000000u) ? (o & 0x7fffffffu) : ~o); }
__device__ __forceinline__ unsigned umax(unsigned a, unsigned b) { return a > b ? a : b; }
__device__ __forceinline__ unsigned umin(unsigned a, unsigned b) { return a < b ? a : b; }
__device__ __forceinline__ void ins16(unsigned (&L)[16], unsigned x) {
#pragma unroll
    for (int i = 0; i < 16; ++i) { const unsigned t = umax(L[i], x); x = umin(L[i], x); L[i] = t; }
}
__device__ __forceinline__ void ins16p(unsigned (&K)[16], unsigned (&P)[16], unsigned key, unsigned pay) {
#pragma unroll
    for (int i = 0; i < 16; ++i) { const bool c = key > K[i]; const unsigned tk = c ? key : K[i], nk = c ? K[i] : key, tp = c ? pay : P[i], np = c ? P[i] : pay; K[i] = tk; P[i] = tp; key = nk; pay = np; }
}
__device__ __forceinline__ void sort16_desc(unsigned (&v)[16]) {
#pragma unroll
    for (int k = 2; k <= 16; k <<= 1)
#pragma unroll
        for (int j = k >> 1; j >= 1; j >>= 1)
#pragma unroll
            for (int i = 0; i < 16; ++i) { const int l = i ^ j; if (l > i) { const bool desc = ((i & k) == 0); const unsigned a = v[i], b = v[l], hi = umax(a, b), lo = umin(a, b); v[i] = desc ? hi : lo; v[l] = desc ? lo : hi; } }
}
__device__ __forceinline__ void merge16_desc(unsigned (&A)[16], const unsigned (&B)[16]) {
#pragma unroll
    for (int i = 0; i < 16; ++i) A[i] = umax(A[i], B[15 - i]);
#pragma unroll
    for (int st = 8; st >= 1; st >>= 1)
#pragma unroll
        for (int i = 0; i < 16; ++i) if ((i & st) == 0) { const unsigned a = A[i], b = A[i + st]; A[i] = umax(a, b); A[i + st] = umin(a, b); }
}
__device__ __forceinline__ void subkey_top16(const bf16_t* qrow  , const bf16_t* krow  , int hh, unsigned (&S)[16]) {
    bf16x8 qf[8];
#pragma unroll
    for (int s = 0; s < 8; ++s) qf[s] = *(const bf16x8*)(qrow + 16 * s);
    unsigned L[16];
#pragma unroll
    for (int i = 0; i < 16; ++i) L[i] = 0u;
#pragma unroll 1
    for (int kb = 0; kb < 4; ++kb) {
        bf16x8 kf[8];
#pragma unroll
        for (int s = 0; s < 8; ++s) kf[s] = *(const bf16x8*)(krow + (size_t)kb * 32 * 128 + 16 * s);
        f32x16 a = {0.f, 0.f, 0.f, 0.f, 0.f, 0.f, 0.f, 0.f, 0.f, 0.f, 0.f, 0.f, 0.f, 0.f, 0.f, 0.f};
#pragma unroll
        for (int s = 0; s < 8; ++s) a = __builtin_amdgcn_mfma_f32_32x32x16_bf16(kf[s], qf[s], a, 0, 0, 0);
        unsigned N[16];
#pragma unroll
        for (int r = 0; r < 16; ++r) { const unsigned idx = (unsigned)(32 * kb + (r & 3) + 8 * (r >> 2) + 4 * hh); N[r] = (ford(a[r]) & ~0x7fu) | idx; }
        sort16_desc(N); merge16_desc(L, N);
        asm volatile("" ::: "memory");
    }
    unsigned P[16];
#pragma unroll
    for (int i = 0; i < 16; ++i) P[i] = (unsigned)__shfl_xor((int)L[i], 32);
#pragma unroll
    for (int i = 0; i < 16; ++i) S[i] = L[i];
    merge16_desc(S, P);
}
__device__ __forceinline__ void phase_topk(const Ctx& C, int layer) {
    const bf16_t* Q = (const bf16_t*)(C.ws + A_B3); const bf16_t* KEYS = (const bf16_t*)(C.ws + WS_KEYS) + (size_t)layer * 8 * 2 * 128 * 128;
    int* IDX = (int*)(C.ws + A_B4); float* GATE = (float*)(C.ws + A_B4) + (size_t)MT * 128;
    const int lane = C.lane, r = lane & 31, hh = lane >> 5;
    for (int task = C.gw; task < (MT / 32) * 8; task += C.NGW) {
        const int tg = task >> 3, h = task & 7, m = tg * 32 + r;
        unsigned S1[16], S2[16];
        subkey_top16(Q + (size_t)m * 2048 + h * 256 + 8 * hh, KEYS + ((size_t)(h * 2 + 0) * 128 + r) * 128 + 8 * hh, hh, S1);
        subkey_top16(Q + (size_t)m * 2048 + h * 256 + 128 + 8 * hh, KEYS + ((size_t)(h * 2 + 1) * 128 + r) * 128 + 8 * hh, hh, S2);
#define CKEY(a, b) ((ford(funord(S1[a] & ~0x7fu) + funord(S2[b] & ~0x7fu)) & ~0xffu) | (unsigned)((a) << 4 | (b)))
        unsigned FK[16], G[16];
#pragma unroll
        for (int b = 0; b < 16; ++b) FK[b] = CKEY(0, b);
#pragma unroll
        for (int b = 0; b < 8; ++b) G[b] = CKEY(1, b);
#pragma unroll
        for (int b = 0; b < 5; ++b) G[8 + b] = CKEY(2, b);
#pragma unroll
        for (int b = 0; b < 3; ++b) G[13 + b] = CKEY(4, b);
        sort16_desc(G); merge16_desc(FK, G);
#pragma unroll
        for (int b = 0; b < 4; ++b) G[b] = CKEY(3, b);
#pragma unroll
        for (int b = 0; b < 2; ++b) { G[4 + b] = CKEY(5, b); G[6 + b] = CKEY(6, b); G[8 + b] = CKEY(7, b); }
#pragma unroll
        for (int a = 8; a < 14; ++a) G[2 + a] = CKEY(a, 0);
        sort16_desc(G); merge16_desc(FK, G);
        ins16(FK, CKEY(14, 0)); ins16(FK, CKEY(15, 0));
#undef CKEY
        unsigned I1p[4], I2p[4];
#pragma unroll
        for (int w = 0; w < 4; ++w) { I1p[w] = (S1[4 * w] & 0x7fu) | ((S1[4 * w + 1] & 0x7fu) << 8) | ((S1[4 * w + 2] & 0x7fu) << 16) | ((S1[4 * w + 3] & 0x7fu) << 24);
                                      I2p[w] = (S2[4 * w] & 0x7fu) | ((S2[4 * w + 1] & 0x7fu) << 8) | ((S2[4 * w + 2] & 0x7fu) << 16) | ((S2[4 * w + 3] & 0x7fu) << 24); }
        const float mx = funord(FK[0] & ~0xffu); float sum = 0.f;
#pragma unroll
        for (int i = 0; i < 16; ++i) sum += fexp(funord(FK[i] & ~0xffu) - mx);
        const float rs = 1.0f / sum;
        int oi[8]; float og[8];
#pragma unroll
        for (int i = 0; i < 8; ++i) { const unsigned key = hh ? FK[8 + i] : FK[i]; const unsigned a = (key >> 4) & 15u, b = key & 15u;
            const unsigned w1 = (a >> 2) == 0u ? I1p[0] : ((a >> 2) == 1u ? I1p[1] : ((a >> 2) == 2u ? I1p[2] : I1p[3]));
            const unsigned w2 = (b >> 2) == 0u ? I2p[0] : ((b >> 2) == 1u ? I2p[1] : ((b >> 2) == 2u ? I2p[2] : I2p[3]));
            oi[i] = (int)((((w1 >> ((a & 3u) * 8u)) & 0x7fu) << 7) | ((w2 >> ((b & 3u) * 8u)) & 0x7fu));
            og[i] = fexp(funord(key & ~0xffu) - mx) * rs; }
        const size_t o = (size_t)m * 128 + h * 16 + 8 * hh;
        *(u32x4*)(IDX + o) = (u32x4){(unsigned)oi[0], (unsigned)oi[1], (unsigned)oi[2], (unsigned)oi[3]}; *(u32x4*)(IDX + o + 4) = (u32x4){(unsigned)oi[4], (unsigned)oi[5], (unsigned)oi[6], (unsigned)oi[7]};
        *(f32x4*)(GATE + o) = (f32x4){og[0], og[1], og[2], og[3]}; *(f32x4*)(GATE + o + 4) = (f32x4){og[4], og[5], og[6], og[7]};
    }
}

template <int CTRL, int ROWMASK> __device__ __forceinline__ float dppf(float v) { return __builtin_bit_cast(float, __builtin_amdgcn_update_dpp(0, __builtin_bit_cast(int, v), CTRL, ROWMASK, 0xF, false)); }
__device__ __forceinline__ float wave_sum_u(float v) {
    v += dppf<0xB1, 0xF>(v); v += dppf<0x4E, 0xF>(v); v += dppf<0x141, 0xF>(v); v += dppf<0x140, 0xF>(v);
    v += dppf<0x142, 0xA>(v); v += dppf<0x143, 0xC>(v);
    return __builtin_bit_cast(float, __builtin_amdgcn_readlane(__builtin_bit_cast(int, v), 63));
}
struct RowSet4 { u32x4 u, v; };
__device__ __forceinline__ void load_rows4(RowSet4& R, const unsigned char* U4, const unsigned char* V4, int eid, int lane) {
    const size_t o = (size_t)eid * 1024 + lane * 16; R.u = *(const u32x4*)(U4 + o); R.v = *(const u32x4*)(V4 + o);
}
__device__ __forceinline__ void use_rows4(const u32x4 Ru, const u32x4 Rv, const float (&xf)[32], float gate, float (&out)[32]) {
    float d0 = 0.f, d1 = 0.f;
#define U4_STEP(w, b) { const f32x2 t = __builtin_amdgcn_cvt_scalef32_pk_f32_fp4(Ru[w], 1.0f, b); d0 = fmaf(xf[8 * (w) + 2 * (b)], t.x, d0); d1 = fmaf(xf[8 * (w) + 2 * (b) + 1], t.y, d1); }
#define U4_WORD(w) U4_STEP(w, 0) U4_STEP(w, 1) U4_STEP(w, 2) U4_STEP(w, 3)
    U4_WORD(0) U4_WORD(1) U4_WORD(2) U4_WORD(3)
#undef U4_WORD
#undef U4_STEP
    const float d = wave_sum_u(d0 + d1) * (1.0f / U4_SCALE);
    const float a = gelu_erf(d) * gate * (1.0f / V4_SCALE);
#define V4_STEP(w, b) { const f32x2 t = __builtin_amdgcn_cvt_scalef32_pk_f32_fp4(Rv[w], 1.0f, b); out[8 * (w) + 2 * (b)] = fmaf(a, t.x, out[8 * (w) + 2 * (b)]); out[8 * (w) + 2 * (b) + 1] = fmaf(a, t.y, out[8 * (w) + 2 * (b) + 1]); }
#define V4_WORD(w) V4_STEP(w, 0) V4_STEP(w, 1) V4_STEP(w, 2) V4_STEP(w, 3)
    V4_WORD(0) V4_WORD(1) V4_WORD(2) V4_WORD(3)
#undef V4_WORD
#undef V4_STEP
}
__device__ __forceinline__ void phase_gather(const Ctx& C, int layer) {
    const bf16_t* HN2 = (const bf16_t*)(C.ws + A_B2); const unsigned char* U4 = C.ws + WS_U; const unsigned char* V4 = C.ws + WS_V;
    const int* IDX = (const int*)(C.ws + A_B4); const float* GATE = (const float*)(C.ws + A_B4) + (size_t)MT * 128;
    const float* mod = (const float*)(C.ws + WS_MOD); float* X = C.out + O_Y; bf16_t* HN = (bf16_t*)(C.ws + A_HN);
    const int lane = C.lane;
    for (int m = C.gw; m < MT; m += C.NGW) {
        const int i0 = IDX[(size_t)m * 128 + lane], i1 = IDX[(size_t)m * 128 + 64 + lane];
        const float g0 = GATE[(size_t)m * 128 + lane], g1 = GATE[(size_t)m * 128 + 64 + lane];
        float xf[32];
#pragma unroll
        for (int b = 0; b < 8; ++b) { const u32x2 w = *(const u32x2*)(HN2 + (size_t)m * 2048 + 256 * b + 4 * lane); xf[4 * b] = bf_lo(w.x); xf[4 * b + 1] = bf_hi(w.x); xf[4 * b + 2] = bf_lo(w.y); xf[4 * b + 3] = bf_hi(w.y); }
        float out[32];
#pragma unroll
        for (int i = 0; i < 32; ++i) out[i] = 0.f;
#define EID(j) __builtin_amdgcn_readlane(((j) < 64) ? i0 : i1, (j) & 63)
#define EGT(j) __builtin_bit_cast(float, __builtin_amdgcn_readlane(__builtin_bit_cast(int, ((j) < 64) ? g0 : g1), (j) & 63))
#define SB() __builtin_amdgcn_sched_barrier(0)
        LAS unsigned char* ring = C.lds + C.wave * 16384;
#define RING_ISSUE(j) do { const int eid_ = EID((j) & 127); const int sl_ = (j) & 7; \
            __builtin_amdgcn_global_load_lds((const unsigned*)(U4 + (size_t)eid_ * 1024 + lane * 16), (LAS unsigned*)(ring + sl_ * 2048), 16, 0, 0); \
            __builtin_amdgcn_global_load_lds((const unsigned*)(V4 + (size_t)eid_ * 1024 + lane * 16), (LAS unsigned*)(ring + sl_ * 2048 + 1024), 16, 0, 0); } while (0)
#pragma unroll
        for (int i = 0; i < 32; ++i) asm volatile("" : "+v"(xf[i]));
        { int t0_ = i0, t1_ = i1; float t2_ = g0, t3_ = g1; asm volatile("" : "+v"(t0_), "+v"(t1_), "+v"(t2_), "+v"(t3_)); }
        asm volatile("s_waitcnt vmcnt(0)" ::: "memory");
#pragma unroll
        for (int j = 0; j < 7; ++j) RING_ISSUE(j);
        for (int e = 0; e < 128; ++e) {
            RING_ISSUE(e + 7);
            asm volatile("s_waitcnt vmcnt(14)" ::: "memory");
            const u32x4 ru = *(const LAS u32x4*)(ring + (e & 7) * 2048 + lane * 16), rv = *(const LAS u32x4*)(ring + (e & 7) * 2048 + 1024 + lane * 16);
            use_rows4(ru, rv, xf, EGT(e), out);
        }
        asm volatile("s_waitcnt vmcnt(0)" ::: "memory");
#undef RING_ISSUE
#undef SB
#undef EID
#undef EGT
        const int sq = seq_of_row(m); const float* g2 = mod + ((size_t)layer * NSEQ + sq) * 12288 + 5 * 2048; float* xr = X + (size_t)m * DM;
        float ss = 0.f;
#pragma unroll
        for (int b = 0; b < 8; ++b) { const int c = 256 * b + 4 * lane; const f32x4 xo = *(const f32x4*)(xr + c), gg = *(const f32x4*)(g2 + c);
#pragma unroll
            for (int j = 0; j < 4; ++j) { const float v = xo[j] + gg[j] * out[4 * b + j]; out[4 * b + j] = v; ss += v * v; } }
        const float rstd = __builtin_amdgcn_rsqf(wave_sum(ss) * (1.0f / DM) + RMS_EPS);
        if (layer == 0) {
            const float* n1g = C.in[11] + 2048; const float* mp = mod + ((size_t)1 * NSEQ + sq) * 12288;
#pragma unroll
            for (int b = 0; b < 8; ++b) { const int c = 256 * b + 4 * lane; const f32x4 gv = *(const f32x4*)(n1g + c), sh = *(const f32x4*)(mp + c), sc = *(const f32x4*)(mp + 2048 + c);
                const f32x4 xs = {out[4 * b], out[4 * b + 1], out[4 * b + 2], out[4 * b + 3]}; const f32x4 y = xs * rstd * gv * (sc + 1.0f) + sh;
                *(f32x4*)(xr + c) = xs; u32x2 w; w.x = cvt_pk_bf16(y[0], y[1]); w.y = cvt_pk_bf16(y[2], y[3]); *(u32x2*)(HN + (size_t)m * DM + c) = w; }
        } else {
            const float* fg = C.in[35];
#pragma unroll
            for (int b = 0; b < 8; ++b) { const int c = 256 * b + 4 * lane; const f32x4 gv = *(const f32x4*)(fg + c); const f32x4 xs = {out[4 * b], out[4 * b + 1], out[4 * b + 2], out[4 * b + 3]};
                *(f32x4*)(xr + c) = xs * rstd * gv; }
        }
    }
}
namespace att {
constexpr int SHM_K = 64 * 384, SHM_V = 64 * 256;
constexpr int OFF_K = 0, OFF_V = 2 * SHM_K, OFF_WS = 2 * SHM_K + 3 * SHM_V;
constexpr float SCALE = 0.07216878364870322f;
constexpr float THR = 8.f;
__device__ __forceinline__ int crow(int r, int hi) { return (r & 3) + 8 * (r >> 2) + 4 * hi; }
__device__ __forceinline__ void partialSM(f32x16& p0, f32x16& p1, float& m_reg, float& mn, float& alpha) {
    constexpr float Cc = SCALE * 1.4426950408889634f;
    float pmax = p0[0];
#pragma unroll
    for (int r = 1; r < 16; ++r) pmax = fmaxf(pmax, p0[r]);
#pragma unroll
    for (int r = 0; r < 16; ++r) pmax = fmaxf(pmax, p1[r]);
    { auto rr = __builtin_amdgcn_permlane32_swap(__float_as_uint(pmax), __float_as_uint(pmax), false, false);
      pmax = fmaxf(__uint_as_float(rr[0]), __uint_as_float(rr[1])); }
    if (__builtin_expect(__all(pmax - m_reg <= THR / SCALE), 1)) { mn = m_reg; alpha = 1.f; }
    else { mn = fmaxf(m_reg, pmax); alpha = __builtin_amdgcn_exp2f((m_reg - mn) * Cc); m_reg = mn; }
    const float mnC = -mn * Cc;
#pragma unroll
    for (int r = 0; r < 16; ++r) p0[r] = __builtin_amdgcn_exp2f(fmaf(p0[r], Cc, mnC));
#pragma unroll
    for (int r = 0; r < 16; ++r) p1[r] = __builtin_amdgcn_exp2f(fmaf(p1[r], Cc, mnC));
}
__device__ __forceinline__ void finishSM(const f32x16& p0, const f32x16& p1, float alpha, float& l_reg, bf16x8& pa0, bf16x8& pa1, bf16x8& pa2, bf16x8& pa3) {
    float ps = 0;
#pragma unroll
    for (int r = 0; r < 16; ++r) ps += p0[r];
#pragma unroll
    for (int r = 0; r < 16; ++r) ps += p1[r];
    { auto rr = __builtin_amdgcn_permlane32_swap(__float_as_uint(ps), __float_as_uint(ps), false, false);
      ps = __uint_as_float(rr[0]) + __uint_as_float(rr[1]); }
    l_reg = l_reg * alpha + ps;
#define PK4(P, BASE, OUT) do { unsigned a0 = cvt_pk_bf16(P[BASE + 0], P[BASE + 1]), a1 = cvt_pk_bf16(P[BASE + 2], P[BASE + 3]);   \
    unsigned b0 = cvt_pk_bf16(P[BASE + 4], P[BASE + 5]), b1 = cvt_pk_bf16(P[BASE + 6], P[BASE + 7]);                              \
    auto r0 = __builtin_amdgcn_permlane32_swap(a0, b0, false, false); auto r1 = __builtin_amdgcn_permlane32_swap(a1, b1, false, false); \
    u32x4 w = {r0[0], r1[0], r0[1], r1[1]}; OUT = __builtin_bit_cast(bf16x8, w); } while (0)
    PK4(p0, 0, pa0); PK4(p0, 8, pa1); PK4(p1, 0, pa2); PK4(p1, 8, pa3);
#undef PK4
}
__device__ __forceinline__ int v_rd_base(int lane) { return ((lane & 3) << 3) | (((lane >> 2) & 3) << 6) | (((lane >> 4) & 1) << 5) | (((lane >> 5) & 1) << 8); }
constexpr int v_rd_off(int d0, int ks, int half) { return d0 * 512 + ks * 4096 + half * 2048; }
template <int OFF> __device__ __forceinline__ s16x4 tr_read(int vb) {
    s16x4 r; asm volatile("ds_read_b64_tr_b16 %0, %1 offset:%2" : "=&v"(r) : "v"(vb), "i"(OFF) : "memory"); return r;
}
template <int D0> __device__ __forceinline__ void pv_one(f32x16& od, int vb, bf16x8 pa0, bf16x8 pa1, bf16x8 pa2, bf16x8 pa3) {
    const s16x4 l0 = tr_read<v_rd_off(D0, 0, 0)>(vb), h0 = tr_read<v_rd_off(D0, 0, 1)>(vb), l1 = tr_read<v_rd_off(D0, 1, 0)>(vb), h1 = tr_read<v_rd_off(D0, 1, 1)>(vb);
    const s16x4 l2 = tr_read<v_rd_off(D0, 2, 0)>(vb), h2 = tr_read<v_rd_off(D0, 2, 1)>(vb), l3 = tr_read<v_rd_off(D0, 3, 0)>(vb), h3 = tr_read<v_rd_off(D0, 3, 1)>(vb);
    asm volatile("s_waitcnt lgkmcnt(0)" ::: "memory"); __builtin_amdgcn_sched_barrier(0);
#define PKV(L, H) (bf16x8){L[0], L[1], L[2], L[3], H[0], H[1], H[2], H[3]}
    od = __builtin_amdgcn_mfma_f32_32x32x16_bf16(pa0, PKV(l0, h0), od, 0, 0, 0);
    od = __builtin_amdgcn_mfma_f32_32x32x16_bf16(pa1, PKV(l1, h1), od, 0, 0, 0);
    od = __builtin_amdgcn_mfma_f32_32x32x16_bf16(pa2, PKV(l2, h2), od, 0, 0, 0);
    od = __builtin_amdgcn_mfma_f32_32x32x16_bf16(pa3, PKV(l3, h3), od, 0, 0, 0);
#undef PKV
}
struct AUnit { int qrow0, kvrow0, ntiles, head, vis0, nact; };

__device__ __forceinline__ bool next_unit(int i, int vcu, int G, AUnit& u) {
    int flat;
    if (G == 256) {
        if (i >= 10) return false;
        if (i < 8) { const int bh = vcu >> 3, s = vcu & 7, base = 16 * (i >> 1); const int qb = (i & 1) ? base + 15 - s : base + s; flat = bh * 64 + qb; }
        else flat = 2048 + vcu * 2 + (i - 8);
    } else { flat = i * G + vcu; if (flat >= 2560) return false; }
    if (flat < 2048) { const int bh = flat >> 6, qb = flat & 63, b = bh >> 4; u.head = bh & 15; u.qrow0 = b * 16384 + qb * 256; u.kvrow0 = b * 16384; u.ntiles = 4 * qb + 4; u.vis0 = 4 * qb; u.nact = 8; }
    else { const int f = flat - 2048, b = f >> 4; u.head = f & 15; u.qrow0 = MP + b * 64; u.kvrow0 = MP + b * 1088; u.ntiles = 17; u.vis0 = 1 << 20; u.nact = 2; }
    return true;
}

__device__ __forceinline__ void attn_phase(const Ctx& C) {
    bf16_t* Qn = (bf16_t*)(C.ws + A_HN); const bf16_t* Qp = (const bf16_t*)(C.ws + A_GG);
    const bf16_t* Kn = (const bf16_t*)(C.ws + A_KN); const bf16_t* Kp = (const bf16_t*)(C.ws + A_KP); const bf16_t* Vv = (const bf16_t*)(C.ws + A_VV);
    LAS unsigned char* lds = C.lds; const int wid = C.wave, lane = C.lane, r32 = lane & 31, hi = lane >> 5;
    LAS float* wsp = (LAS float*)(lds + OFF_WS) + wid * 64; LAS float* li_l = wsp; LAS float* al_l = wsp + 32;
    unsigned ka[3], kst[3]; bool kisn[3];
#pragma unroll
    for (int i = 0; i < 3; ++i) { const int Uq = (wid * 3 + i) * 64 + lane, row = Uq / 24, cp = Uq % 24, c = cp ^ ((row >> 1) & 7);
        kisn[i] = c < 16; ka[i] = kisn[i] ? (unsigned)(row * 4096 + c * 16) : (unsigned)(A_KP - A_KN) + (unsigned)(row * 128 + (c - 16) * 16); kst[i] = kisn[i] ? 64u * 4096u : 64u * 128u; }
    unsigned va[2];
#pragma unroll
    for (int i = 0; i < 2; ++i) { const int by = ((wid * 2 + i) * 64 + lane) * 16, sub = by >> 9, within = by & 511, kk = (sub >> 2) * 8 + (within >> 6), cc = (sub & 3) * 32 + ((within & 63) >> 1);
        const int k = (kk & ~0xC) | ((kk & 4) << 1) | ((kk & 8) >> 1); va[i] = (unsigned)(k * 4096 + cc * 2); }
    int klo[4];
#pragma unroll
    for (int q = 0; q < 4; ++q) klo[q] = r32 * 384 + ((((2 * q + hi) ^ ((r32 >> 1) & 7))) << 4);
    const int vb0 = (int)(uintptr_t)(lds + OFF_V) + v_rd_base(lane);
#define ATT_BAR() __builtin_amdgcn_s_barrier()
#define ATT_ISSUE(j, kb, vbi) do { _Pragma("unroll") for (int _i = 0; _i < 3; ++_i) { \
        __builtin_amdgcn_global_load_lds((const unsigned*)((const char*)Kn + kc[_i]), (LAS unsigned*)(lds + OFF_K + (kb) * SHM_K + (wid * 3 + _i) * 1024), 16, 0, 0); kc[_i] += kst[_i]; } \
      _Pragma("unroll") for (int _i = 0; _i < 2; ++_i) { \
        __builtin_amdgcn_global_load_lds((const unsigned*)((const char*)Vv + vc[_i]), (LAS unsigned*)(lds + OFF_V + (vbi) * SHM_V + (wid * 2 + _i) * 1024), 16, 0, 0); vc[_i] += 64u * 4096u; } } while (0)
#define ATT_PV(VBI) do { const int vb = vb0 + (VBI) * SHM_V; \
      pv_one<0>(o[0], vb, pa0, pa1, pa2, pa3); pv_one<1>(o[1], vb, pa0, pa1, pa2, pa3); pv_one<2>(o[2], vb, pa0, pa1, pa2, pa3); pv_one<3>(o[3], vb, pa0, pa1, pa2, pa3); } while (0)
    const bool grpY = wid >= 4;
    AUnit u;
    for (int ui = 0; next_unit(ui, C.vcu, C.G, u); ++ui) {
        const bool active = wid < u.nact; const int vis = u.vis0 + (wid >> 1);
        const int qrow = u.qrow0 + wid * 32 + r32;
        bf16x8 qr[12];
        if (active) {
#pragma unroll
            for (int d0 = 0; d0 < 8; ++d0) qr[d0] = *(const bf16x8*)(Qn + (size_t)qrow * 2048 + u.head * 128 + d0 * 16 + hi * 8);
#pragma unroll
            for (int d0 = 0; d0 < 4; ++d0) qr[8 + d0] = *(const bf16x8*)(Qp + (size_t)qrow * 1024 + u.head * 64 + d0 * 16 + hi * 8);
        } else {
#pragma unroll
            for (int d0 = 0; d0 < 12; ++d0) qr[d0] = (bf16x8){0, 0, 0, 0, 0, 0, 0, 0};
        }
#pragma unroll
        for (int d0 = 0; d0 < 12; ++d0) asm volatile("" : "+v"(qr[d0]));
        float m_reg = -1e30f, l_reg = 0.f; f32x16 o[4];
#pragma unroll
        for (int d = 0; d < 4; ++d)
#pragma unroll
            for (int r = 0; r < 16; ++r) o[d][r] = 0.f;
        bf16x8 pa0 = (bf16x8){0, 0, 0, 0, 0, 0, 0, 0}, pa1 = pa0, pa2 = pa0, pa3 = pa0;
        const int NT = u.ntiles;
        int vprev = 2, vcur = 0, vnext = 1;
        unsigned kc[3], vc[2];
#pragma unroll
        for (int i = 0; i < 3; ++i) kc[i] = ka[i] + (kisn[i] ? (unsigned)u.kvrow0 * 4096u + (unsigned)u.head * 256u : (unsigned)u.kvrow0 * 128u);
#pragma unroll
        for (int i = 0; i < 2; ++i) vc[i] = va[i] + (unsigned)u.kvrow0 * 4096u + (unsigned)u.head * 256u;
        ATT_ISSUE(0, 0, 0);
        for (int j = 0; j < NT; ++j) {
            const int buf = j & 1;
            if (j + 1 < NT) { ATT_ISSUE(j + 1, buf ^ 1, vnext); asm volatile("s_waitcnt vmcnt(5)" ::: "memory"); }
            else asm volatile("s_waitcnt vmcnt(0)" ::: "memory");
            ATT_BAR();
            if (active) {
                if (grpY && j >= 1 && j - 1 <= vis) ATT_PV(vprev);
                if (j <= vis) {
                    const LAS unsigned char* Kb = lds + OFF_K + buf * SHM_K;
                    f32x16 p0, p1;
#pragma unroll
                    for (int r = 0; r < 16; ++r) { p0[r] = 0.f; p1[r] = 0.f; }
#pragma unroll
                    for (int d0 = 0; d0 < 12; ++d0) {
                        const bf16x8 b0 = *(const LAS bf16x8*)(Kb + klo[d0 & 3] + (d0 >> 2) * 128);
                        const bf16x8 b1 = *(const LAS bf16x8*)(Kb + klo[d0 & 3] + (d0 >> 2) * 128 + 32 * 384);
                        p0 = __builtin_amdgcn_mfma_f32_32x32x16_bf16(b0, qr[d0], p0, 0, 0, 0);
                        p1 = __builtin_amdgcn_mfma_f32_32x32x16_bf16(b1, qr[d0], p1, 0, 0, 0);
                    }
                    float mn, alpha; partialSM(p0, p1, m_reg, mn, alpha);
                    if (__any(alpha < 1.f)) { if (hi == 0) al_l[r32] = alpha; asm volatile("s_waitcnt lgkmcnt(0)" ::: "memory");
#pragma unroll
                        for (int r = 0; r < 16; ++r) { const float al = al_l[crow(r, hi)];
#pragma unroll
                            for (int d = 0; d < 4; ++d) o[d][r] *= al; } }
                    finishSM(p0, p1, alpha, l_reg, pa0, pa1, pa2, pa3);
                    if (!grpY) ATT_PV(vcur);
                }
            }
            asm volatile("s_waitcnt lgkmcnt(0)" ::: "memory");
            ATT_BAR();
            { const int t_ = vprev; vprev = vcur; vcur = vnext; vnext = t_; }
        }
        if (active && grpY && NT - 1 <= vis) ATT_PV(vprev);
        asm volatile("s_waitcnt lgkmcnt(0)" ::: "memory");
        ATT_BAR();
        if (active) {
            if (hi == 0) li_l[r32] = l_reg; asm volatile("s_waitcnt lgkmcnt(0)" ::: "memory");
            bf16_t* Ow = Qn + (size_t)(u.qrow0 + wid * 32) * 2048 + u.head * 128;
#pragma unroll
            for (int r = 0; r < 16; ++r) { const int orow = crow(r, hi); const float rl = __builtin_amdgcn_rcpf(li_l[orow]);
#pragma unroll
                for (int d0 = 0; d0 < 4; ++d0) { const unsigned w = cvt_pk_bf16(o[d0][r] * rl, 0.f); Ow[(size_t)orow * 2048 + d0 * 32 + r32] = (bf16_t)(w & 0xffffu); } }
        }
    }
#undef ATT_BAR
#undef ATT_ISSUE
#undef ATT_PV
}
}
#ifndef MK_SPLIT
#define MK_SPLIT 0
#endif
constexpr int N_PHASES = 22;

__global__ void __launch_bounds__(512, 2) mega_fwd(Args args) {
    extern __shared__ __attribute__((aligned(16))) unsigned char lds_raw[];
    Ctx C;
    C.lds = (LAS unsigned char*)lds_raw;
    C.tid = threadIdx.x; C.lane = C.tid & 63; C.wave = __builtin_amdgcn_readfirstlane(C.tid >> 6);
    C.G = gridDim.x; { const int bx = blockIdx.x; C.vcu = (C.G % 8 == 0) ? (bx % 8) * (C.G / 8) + bx / 8 : bx; }
    C.gw = C.vcu * 8 + C.wave; C.NGW = C.G * 8;
    C.in = args.in; C.out = args.out; C.ws = args.ws;
    volatile LAS unsigned* misc = (volatile LAS unsigned*)(C.lds + LDS_MISC);
    if (C.tid < 4) misc[C.tid] = 0u;
    __syncthreads();
    const int lo = args.ph_lo, hi = args.ph_hi;
    XcdBarrier bar; bar.bar = (unsigned*)(C.ws + WS_CTL) + CW_BAR; bar.x = 0; bar.st = misc;
    if (hi - lo > 1) bar = xcd_barrier_post((unsigned*)(C.ws + WS_CTL) + CW_BAR, misc);
#ifdef PH_ONLY
#define IN(k) ((k) == PH_ONLY)
#else
#define IN(k) (lo <= (k) && (k) < hi)
#endif
#define SEAM(k) do { if (IN(k) && IN((k) + 1)) xcd_barrier(bar); } while (0)
    unsigned char* ws = C.ws;
    const float* mod = (const float*)(ws + WS_MOD);
    float* X = C.out + O_Y;
    LAS unsigned char* glds = C.lds;

    if (IN(0)) { phase_prologue(C); } SEAM(0);
    if (IN(1)) { phase_norm(C, C.in[0], C.in[1], C.in[11], mod, 0, (bf16_t*)(ws + A_HN)); } SEAM(1);
    if (IN(2)) {
        pg8::Gemm g{(const bf16_t*)(ws + A_HN), (const bf16_t*)(ws + WS_WIN), MT, 3072, 2048, 2048, 2048, 0, 0}; pg8::StaticOrder S; S.init(MT, 3072, C.G, (int)blockIdx.x);
        pg8::EpiZ E{(bf16_t*)(ws + A_GG), (bf16_t*)(ws + A_B2), (bf16_t*)(ws + A_B2) + (size_t)MT * 1024};
        pg8::gemm_phase<pg8::EpiZ>(glds, g, S, E); } SEAM(2);
    if (IN(3)) { phase_convpool(C); } SEAM(3);
    if (IN(4)) {
        { pg8::Gemm g{(const bf16_t*)(ws + A_B3), (const bf16_t*)(ws + WS_WGATE), MT, 2048, 256, 1024, 256, 1, 256}; pg8::StaticOrder S; S.init(MT, 2048, C.G, (int)blockIdx.x);
          pg8::EpiGate E{(const bf16_t*)(ws + A_B3), (const float*)(ws + WS_SP), (float*)(ws + A_B4)};
          pg8::gemm_phase<pg8::EpiGate>(glds, g, S, E); }
 } SEAM(4);
    if (IN(5)) {
        { pg8::Gemm g{(const bf16_t*)(ws + A_B3) + (size_t)MT * 1024, (const bf16_t*)(ws + WS_WPOOL), MT, 1024, 256, 1024, 256, 0, 256}; pg8::StaticOrder S; S.init(MT, 1024, C.G, (int)blockIdx.x);
          pg8::EpiPool E{(bf16_t*)(ws + A_HN), C.in[22]};
          pg8::gemm_phase<pg8::EpiPool>(glds, g, S, E); }
        phase_scanA(C); } SEAM(5);
    if (IN(6)) { phase_scanB(C); } SEAM(6);
    if (IN(7)) { phase_scanC(C); } SEAM(7);
    if (IN(8)) {
        pg8::Gemm g{(const bf16_t*)(ws + A_HN), (const bf16_t*)(ws + WS_WOUTR), MT, 2048, 2048, 2048, 2048, 0, 0}; pg8::StaticOrder S; S.init(MT, 2048, C.G, (int)blockIdx.x);
        pg8::EpiBf16 E{(bf16_t*)(ws + A_B3), 2048};
        pg8::gemm_phase<pg8::EpiBf16>(glds, g, S, E); } SEAM(8);
#define PEER_BLOCK(P0, L) \
    if (IN(P0)) { phase_resid_norm(C, (L) == 0 ? C.in[0] : X, (L) == 0 ? C.in[1] : X + (size_t)MP * DM, (const bf16_t*)(ws + A_B3), X, C.in[12] + (L) * 2048, mod + (size_t)(L) * NSEQ * 12288, (bf16_t*)(ws + A_B2)); } SEAM(P0); \
    if (IN(P0 + 1)) { pg8::Gemm g{(const bf16_t*)(ws + A_B2), (const bf16_t*)(ws + WS_WQ) + (size_t)(L) * 2048 * 2048, MT, 2048, 2048, 2048, 2048, 0, 0}; pg8::StaticOrder S; S.init(MT, 2048, C.G, (int)blockIdx.x); \
        pg8::EpiBf16 E{(bf16_t*)(ws + A_B3), 2048}; pg8::gemm_phase<pg8::EpiBf16>(glds, g, S, E); } SEAM(P0 + 1); \
    if (IN(P0 + 2)) { phase_topk(C, L); } SEAM(P0 + 2); \
    if (IN(P0 + 3)) { phase_gather(C, L); }
    PEER_BLOCK(9, 0) SEAM(12);
    if (IN(13)) {
        pg8::Gemm g{(const bf16_t*)(ws + A_HN), (const bf16_t*)(ws + WS_WDQKV), MT, 1024, 2048, 2048, 2048, 0, 0}; pg8::StaticOrder S; S.init(MT, 1024, C.G, (int)blockIdx.x);
        pg8::EpiF32 E{(float*)(ws + A_B3), 1024};
        pg8::gemm_phase<pg8::EpiF32>(glds, g, S, E); } SEAM(13);
    if (IN(14)) { phase_latent(C); } SEAM(14);
    if (IN(15)) {
        { pg8::Gemm g{(const bf16_t*)(ws + A_CQ), (const bf16_t*)(ws + WS_WUQ), MT, 3072, 512, 512, 512, 0, 0}; pg8::StaticOrder S; S.init(MT, 3072, C.G, (int)blockIdx.x);
          pg8::EpiQ E{(bf16_t*)(ws + A_HN), (bf16_t*)(ws + A_GG), (const float*)(ws + WS_ROPE)};
          pg8::gemm_phase<pg8::EpiQ>(glds, g, S, E); }
        { pg8::Gemm g{(const bf16_t*)(ws + A_CKV), (const bf16_t*)(ws + WS_WUKV), KVROWS, 4096, 256, 256, 256, 0, 0}; pg8::StaticOrder S; S.init(KVROWS, 4096, C.G, (int)blockIdx.x);
          pg8::EpiKV E{(bf16_t*)(ws + A_KN), (bf16_t*)(ws + A_VV)};
          pg8::gemm_phase<pg8::EpiKV>(glds, g, S, E); } } SEAM(15);
    if (IN(16)) { att::attn_phase(C); } SEAM(16);
    if (IN(17)) {
        pg8::Gemm g{(const bf16_t*)(ws + A_HN), (const bf16_t*)(ws + WS_WOUTA), MT, 2048, 2048, 2048, 2048, 0, 0}; pg8::StaticOrder S; S.init(MT, 2048, C.G, (int)blockIdx.x);
        pg8::EpiBf16 E{(bf16_t*)(ws + A_B3), 2048};
        pg8::gemm_phase<pg8::EpiBf16>(glds, g, S, E); } SEAM(17);
    PEER_BLOCK(18, 1)
#undef PEER_BLOCK
#undef IN
#undef SEAM
}

extern "C" void kernel_launch(void* const* d_in, const int* in_sizes, int n_in, void* d_out, int out_size, void* d_ws, size_t ws_size, hipStream_t stream) {
    static int grid = 0;
    if (grid == 0) {
        if (n_in != 36 || out_size != (int)O_TOTAL || ws_size < WS_END) { fprintf(stderr, "kernel_launch: built for 36 inputs, %zu outputs, >= %zu B workspace; got n_in %d out %d ws %zu\n", (size_t)O_TOTAL, (size_t)WS_END, n_in, out_size, ws_size); grid = -1; return; }
        int dev = 0, cus = 0, per_cu = 0;
        if (hipGetDevice(&dev) != hipSuccess || hipDeviceGetAttribute(&cus, hipDeviceAttributeMultiprocessorCount, dev) != hipSuccess) { fprintf(stderr, "kernel_launch: device query failed\n"); grid = -1; return; }
        if (hipFuncSetAttribute((const void*)mega_fwd, hipFuncAttributeMaxDynamicSharedMemorySize, LDS_BYTES) != hipSuccess) { fprintf(stderr, "kernel_launch: hipFuncSetAttribute failed\n"); grid = -1; return; }
        if (hipOccupancyMaxActiveBlocksPerMultiprocessor(&per_cu, (const void*)mega_fwd, 512, LDS_BYTES) != hipSuccess || per_cu < 1) { fprintf(stderr, "kernel_launch: occupancy query says %d blocks per CU\n", per_cu); }
        (void)hipGetLastError();
        grid = cus;
    }
    if (grid < 0) return;
    (void)hipMemsetAsync(d_ws, 0, WS_ZERO_BYTES, stream);
    Args a{};
    for (int i = 0; i < 36; ++i) a.in[i] = (const float*)d_in[i];
    a.out = (float*)d_out; a.ws = (unsigned char*)d_ws;
#if MK_SPLIT
    for (int p = 0; p < N_PHASES; ++p) { a.ph_lo = p; a.ph_hi = p + 1; hipLaunchKernelGGL(mega_fwd, dim3(grid), dim3(512), LDS_BYTES, stream, a); }
#elif defined(PROBE_RANGES)
    { const int rg[][2] = {PROBE_RANGES};
      for (unsigned i = 0; i < sizeof(rg) / sizeof(rg[0]); ++i) { if (i) (void)hipMemsetAsync(d_ws, 0, 1 * MiB, stream); a.ph_lo = rg[i][0]; a.ph_hi = rg[i][1]; hipLaunchKernelGGL(mega_fwd, dim3(grid), dim3(512), LDS_BYTES, stream, a); } }
#else
    a.ph_lo = 0; a.ph_hi = N_PHASES; hipLaunchKernelGGL(mega_fwd, dim3(grid), dim3(512), LDS_BYTES, stream, a);
#endif
    const hipError_t le = hipPeekAtLastError();
    if (le != hipSuccess) fprintf(stderr, "kernel_launch: launch failed: %s\n", hipGetErrorName(le));
}
```

```cpp
#include <hip/hip_runtime.h>
#include <cstdio>
#include <cstdint>

#define LAS __attribute__((address_space(3)))
#define GAS __attribute__((address_space(1)))
typedef unsigned short bf16_t;
typedef short bf16x8 __attribute__((ext_vector_type(8)));
typedef short s16x4 __attribute__((ext_vector_type(4)));
typedef float f32x2 __attribute__((ext_vector_type(2)));
typedef float f32x4 __attribute__((ext_vector_type(4)));
typedef float f32x16 __attribute__((ext_vector_type(16)));
typedef unsigned u32x2 __attribute__((ext_vector_type(2)));
typedef unsigned u32x4 __attribute__((ext_vector_type(4)));

constexpr int DM = 2048;
constexpr int MP = 32768, MS = 2048, MT = MP + MS;
constexpr int NSEQ = 34;
constexpr int KVROWS = MP + 32 * 1088;
constexpr float RMS_EPS = 1e-6f;

__device__ __forceinline__ int seq_of_row(int m) { return m < MP ? (m >> 14) : 2 + ((m - MP) >> 6); }
__device__ __forceinline__ int pos_of_row(int m) { return m < MP ? (m & 16383) : 1024 + ((m - MP) & 63); }
__device__ __forceinline__ int kvrow_of_row(int m) { return m < MP ? m : MP + ((m - MP) >> 6) * 1088 + 1024 + ((m - MP) & 63); }

__device__ __forceinline__ unsigned cvt_pk_bf16(float lo, float hi) { unsigned r; asm volatile("v_cvt_pk_bf16_f32 %0, %1, %2" : "=v"(r) : "v"(lo), "v"(hi)); return r; }
__device__ __forceinline__ float bf_lo(unsigned w) { return __uint_as_float(w << 16); }
__device__ __forceinline__ float bf_hi(unsigned w) { return __uint_as_float(w & 0xffff0000u); }
__device__ __forceinline__ float fexp(float x) { return __builtin_amdgcn_exp2f(x * 1.4426950408889634f); }
__device__ __forceinline__ float fsigmoid(float x) { return __builtin_amdgcn_rcpf(1.0f + __builtin_amdgcn_exp2f(-1.4426950408889634f * x)); }
__device__ __forceinline__ float gelu_tanh(float x) { const float u = x * (1.0f + 0.044715f * x * x); return x * __builtin_amdgcn_rcpf(1.0f + __builtin_amdgcn_exp2f(-2.302208198f * u)); }
__device__ __forceinline__ float gelu_erf(float v) {
    const float av = __builtin_fabsf(v), t = __builtin_amdgcn_rcpf(av * 0.2316418882f + 1.0f);
    float q = t * 0.5307027145f + (-0.7265760135f); q = q * t + 0.7107068705f; q = q * t + (-0.142248368f); q = q * t + 0.127414796f; q = q * t;
    const float e = __builtin_amdgcn_exp2f((v * v) * (-0.72134752044f));
    const float m = v * (q * e); return v < 0.f ? m : v - m;
}
__device__ __forceinline__ float wave_sum(float v) {
#pragma unroll
    for (int o = 32; o >= 1; o >>= 1) v += __shfl_xor(v, o);
    return v;
}

namespace pg8 {
constexpr int BM = 256, BK = 64, HALF = 128, HTB = HALF * BK * 2, STAGE_BYTES = 8 * HTB, NXCD = 8, WGM = 8;
__host__ __device__ __forceinline__ int lds_byte(int r, int c) { const int st = (r >> 4) * 2 + (c >> 5), rr = r & 15, cc = c & 31, ob = rr * 64 + cc * 2; return st * 1024 + (ob ^ (((ob >> 9) & 1) << 5)); }
__host__ __device__ __forceinline__ void stage_rc(int b, int& R, int& C) { const int st = b / 1024, sb = b % 1024, swz = sb ^ (((sb >> 9) & 1) << 5); R = (st >> 1) * 16 + swz / 64; C = (st & 1) * 32 + (swz % 64) / 2; }
__host__ __device__ __forceinline__ int perm32(int rho) { const int n = rho >> 4, i = rho & 15; return 8 * (i >> 2) + 4 * n + (i & 3); }

struct Unit { int pm, pn; };
struct Gemm { const bf16_t* A; const bf16_t* Bt; int M, N, K, lda, ldb, kshift, kmul; };

struct StaticOrder {
    int nM, nN, nwg, G, c;
    __host__ __device__ void init(int M, int N, int G_, int c_) { nM = M / BM; nN = N / BM; nwg = nM * nN; G = G_; c = c_; }
    __host__ __device__ bool next(int i, Unit& u) const {
        const long L = (long)i * G + c; if (L >= nwg) return false;
        int wgid = (int)L; { const int q = nwg / NXCD, r = nwg % NXCD, xcd = wgid % NXCD, off = wgid / NXCD; wgid = (xcd < r ? xcd * (q + 1) : r * (q + 1) + (xcd - r) * q) + off; }
        const int nig = WGM * nN, gid = wgid / nig, fm = gid * WGM, gsz = (nM - fm) < WGM ? (nM - fm) : WGM;
        u.pm = fm + ((wgid % nig) % gsz); u.pn = (wgid % nig) / gsz; return true;
    }
};

template <class Epi>
__device__ __forceinline__ void gemm_phase(LAS unsigned char* lds, const Gemm g, const StaticOrder& S, const Epi& E) {
    const int tid = threadIdx.x, wid = __builtin_amdgcn_readfirstlane(tid >> 6), lane = tid & 63, wr = wid >> 2, wc = wid & 3, fr = lane & 15, fq = lane >> 4;
    int Kq = g.K; asm volatile("" : "+s"(Kq));
    const int K = Kq, nt = K / BK;
    unsigned voffA[2], voffB[2];
#pragma unroll
    for (int i = 0; i < 2; ++i) { int R, C; stage_rc(tid * 16 + i * 8192, R, C); const int Rb = Epi::PERM ? ((R & ~31) + perm32(R & 31)) : R;
        voffA[i] = (unsigned)(R * g.lda + C) * 2u; voffB[i] = (unsigned)(Rb * g.ldb + C) * 2u; }
    const size_t kstep = (size_t)(BK * 2);
    const size_t hstepA = (size_t)HALF * g.lda * 2, hstepB = (size_t)HALF * g.ldb * 2;
    const unsigned ldsw = (unsigned)wid * 1024u;
    const int aoff = lds_byte(wr * 64 + fr, fq * 8), boff = lds_byte(wc * 32 + fr, fq * 8);
#define PG8_SA(b, h) (((b) * 2 + (h)) * HTB)
#define PG8_SB(b, h) ((4 + (b) * 2 + (h)) * HTB)
#define PG8_STAGE(bufoff, gbase, voff) do { _Pragma("unroll") for (int _i = 0; _i < 2; ++_i) \
        __builtin_amdgcn_global_load_lds((const unsigned*)((const char*)(gbase) + (voff)[_i]), (LAS unsigned*)(lds + (bufoff) + ldsw + _i * 8192), 16, 0, 0); } while (0)
#define PG8_LDA(dst, b, h) do { _Pragma("unroll") for (int m = 0; m < 4; ++m) _Pragma("unroll") for (int k = 0; k < 2; ++k) dst[m][k] = *(const LAS bf16x8*)(lds + PG8_SA(b, h) + aoff + m * 2048 + k * 1024); } while (0)
#define PG8_LDB(dst, b, h) do { _Pragma("unroll") for (int n = 0; n < 2; ++n) _Pragma("unroll") for (int k = 0; k < 2; ++k) dst[n][k] = *(const LAS bf16x8*)(lds + PG8_SB(b, h) + boff + n * 2048 + k * 1024); } while (0)
#define PG8_MMA(ai, bj, At, Bt) do { __builtin_amdgcn_s_setprio(1); _Pragma("unroll") for (int m = 0; m < 4; ++m) _Pragma("unroll") for (int n = 0; n < 2; ++n) _Pragma("unroll") for (int k = 0; k < 2; ++k) \
        acc[ai][bj][m][n] = __builtin_amdgcn_mfma_f32_16x16x32_bf16(Bt[n][k], At[m][k], acc[ai][bj][m][n], 0, 0, 0); __builtin_amdgcn_s_setprio(0); } while (0)
#define PG8_WAIT_V(n) asm volatile("s_waitcnt vmcnt(" #n ")" ::: "memory")
#define PG8_WAIT_L(n) asm volatile("s_waitcnt lgkmcnt(" #n ")" ::: "memory")
#define PG8_BAR __builtin_amdgcn_s_barrier()
#define PG8_SCHED __builtin_amdgcn_sched_barrier(0)
#define PG8_ABASE(u) ((const char*)g.A + (size_t)(u).pm * (2 * hstepA) + (size_t)(((u).pn >> g.kshift) * g.kmul) * 2)
#define PG8_BBASE(u) ((const char*)g.Bt + (size_t)(u).pn * (2 * hstepB))
    Unit cur, nxt; int ui = 0;
    if (!S.next(0, cur)) return;
    f32x4 acc[2][2][4][2];
#pragma unroll
    for (int a = 0; a < 2; ++a)
#pragma unroll
        for (int b = 0; b < 2; ++b)
#pragma unroll
            for (int m = 0; m < 4; ++m)
#pragma unroll
                for (int n = 0; n < 2; ++n) acc[a][b][m][n] = (f32x4){0.f, 0.f, 0.f, 0.f};
    bf16x8 At[4][2], B0[2][2], B1[2][2];
    const char* cA = PG8_ABASE(cur); const char* cB = PG8_BBASE(cur);
    PG8_STAGE(PG8_SB(0, 0), cB, voffB); PG8_STAGE(PG8_SB(0, 1), cB + hstepB, voffB); PG8_STAGE(PG8_SA(0, 0), cA, voffA); PG8_STAGE(PG8_SA(0, 1), cA + hstepA, voffA);
    if (wr == 1) PG8_BAR;
    PG8_WAIT_V(2); PG8_BAR;
    PG8_STAGE(PG8_SB(1, 0), cB + kstep, voffB); PG8_STAGE(PG8_SA(1, 0), cA + kstep, voffA); PG8_STAGE(PG8_SB(1, 1), cB + hstepB + kstep, voffB);
    PG8_WAIT_V(6); PG8_BAR;
    for (;;) {
        const bool has_next = S.next(ui + 1, nxt);
        const char* nA = has_next ? PG8_ABASE(nxt) : cA; const char* nB = has_next ? PG8_BBASE(nxt) : cB;
        for (int t = 0; t < nt; t += 2) {
            const bool last = (t == nt - 2);
            const char* a1 = cA + (size_t)(t + 1) * kstep;
            const char* a2 = last ? nA : cA + (size_t)(t + 2) * kstep; const char* b2 = last ? nB : cB + (size_t)(t + 2) * kstep;
            const char* a3 = a2 + kstep; const char* b3 = b2 + kstep;
            PG8_LDB(B0, 0, 0); PG8_LDB(B1, 0, 1); PG8_SCHED; PG8_LDA(At, 0, 0); PG8_STAGE(PG8_SA(1, 1), a1 + hstepA, voffA);
            PG8_WAIT_V(8); PG8_WAIT_L(0); PG8_BAR; PG8_MMA(0, 0, At, B0); PG8_MMA(0, 1, At, B1); PG8_BAR; PG8_SCHED;
            PG8_LDA(At, 0, 1); PG8_STAGE(PG8_SB(0, 0), b2, voffB); PG8_STAGE(PG8_SB(0, 1), b2 + hstepB, voffB); PG8_STAGE(PG8_SA(0, 0), a2, voffA);
            PG8_WAIT_V(8); PG8_WAIT_L(0); PG8_BAR; PG8_MMA(1, 0, At, B0); PG8_MMA(1, 1, At, B1); PG8_BAR; PG8_SCHED;
            PG8_LDB(B0, 1, 0); PG8_LDB(B1, 1, 1); PG8_SCHED; PG8_LDA(At, 1, 0); PG8_STAGE(PG8_SA(0, 1), a2 + hstepA, voffA);
            PG8_WAIT_V(8); PG8_WAIT_L(0); PG8_BAR; PG8_MMA(0, 0, At, B0); PG8_MMA(0, 1, At, B1); PG8_BAR; PG8_SCHED;
            PG8_LDA(At, 1, 1); PG8_STAGE(PG8_SB(1, 0), b3, voffB); PG8_STAGE(PG8_SB(1, 1), b3 + hstepB, voffB); PG8_STAGE(PG8_SA(1, 0), a3, voffA);
            PG8_WAIT_V(8); PG8_WAIT_L(0); PG8_BAR; PG8_MMA(1, 0, At, B0); PG8_MMA(1, 1, At, B1); PG8_BAR; PG8_SCHED;
        }
        if (wr == 0) PG8_BAR;
        E(acc, cur, wr, wc, fr, fq);
        if (!has_next) break;
#pragma unroll
        for (int a = 0; a < 2; ++a)
#pragma unroll
            for (int b = 0; b < 2; ++b)
#pragma unroll
                for (int m = 0; m < 4; ++m)
#pragma unroll
                    for (int n = 0; n < 2; ++n) acc[a][b][m][n] = (f32x4){0.f, 0.f, 0.f, 0.f};
        cur = nxt; cA = nA; cB = nB; ++ui;
        if (wr == 1) PG8_BAR;
    }
    PG8_WAIT_V(0);
    PG8_BAR;
#undef PG8_SA
#undef PG8_SB
#undef PG8_STAGE
#undef PG8_LDA
#undef PG8_LDB
#undef PG8_MMA
#undef PG8_WAIT_V
#undef PG8_WAIT_L
#undef PG8_BAR
#undef PG8_SCHED
#undef PG8_ABASE
#undef PG8_BBASE
}
}
namespace pg8 {
#define EPI_ROWS(expr_row) for (int ai = 0; ai < 2; ++ai) for (int m = 0; m < 4; ++m)
struct EpiBf16 {
    static constexpr bool PERM = true;
    bf16_t* O; int ldc;
    __device__ __forceinline__ void operator()(const f32x4 (&acc)[2][2][4][2], const Unit& u, int wr, int wc, int fr, int fq) const {
        const int row0 = u.pm * BM + wr * 64 + fr, col0 = u.pn * BM + wc * 32 + 8 * fq;
#pragma unroll
        for (int ai = 0; ai < 2; ++ai)
#pragma unroll
            for (int m = 0; m < 4; ++m) { bf16_t* rowp = O + (size_t)(row0 + ai * HALF + m * 16) * ldc + col0;
#pragma unroll
                for (int bj = 0; bj < 2; ++bj) { const f32x4 v0 = acc[ai][bj][m][0], v1 = acc[ai][bj][m][1];
                    u32x4 w; w.x = cvt_pk_bf16(v0[0], v0[1]); w.y = cvt_pk_bf16(v0[2], v0[3]); w.z = cvt_pk_bf16(v1[0], v1[1]); w.w = cvt_pk_bf16(v1[2], v1[3]);
                    *(u32x4*)(rowp + bj * HALF) = w; } }
    }
};
struct EpiZ {
    static constexpr bool PERM = true;
    bf16_t* GG; bf16_t* REC; bf16_t* POOL;
    __device__ __forceinline__ void operator()(const f32x4 (&acc)[2][2][4][2], const Unit& u, int wr, int wc, int fr, int fq) const {
        const int t = u.pn >> 2; bf16_t* base = GG + (size_t)t * ((size_t)MT * 1024);
        const int row0 = u.pm * BM + wr * 64 + fr, col0 = (u.pn & 3) * BM + wc * 32 + 8 * fq;
#pragma unroll
        for (int ai = 0; ai < 2; ++ai)
#pragma unroll
            for (int m = 0; m < 4; ++m) { bf16_t* rowp = base + (size_t)(row0 + ai * HALF + m * 16) * 1024 + col0;
#pragma unroll
                for (int bj = 0; bj < 2; ++bj) { f32x4 v0 = acc[ai][bj][m][0], v1 = acc[ai][bj][m][1];
                    if (t == 0) {
#pragma unroll
                        for (int j = 0; j < 4; ++j) { v0[j] = gelu_tanh(v0[j]); v1[j] = gelu_tanh(v1[j]); } }
                    u32x4 w; w.x = cvt_pk_bf16(v0[0], v0[1]); w.y = cvt_pk_bf16(v0[2], v0[3]); w.z = cvt_pk_bf16(v1[0], v1[1]); w.w = cvt_pk_bf16(v1[2], v1[3]);
                    *(u32x4*)(rowp + bj * HALF) = w; } }
    }
};
struct EpiGate {
    static constexpr bool PERM = false;
    const bf16_t* XC; const float* gp; float* Aout;
    __device__ __forceinline__ void operator()(const f32x4 (&acc)[2][2][4][2], const Unit& u, int wr, int wc, int fr, int fq) const {
        const int row0 = u.pm * BM + wr * 64 + fr, ch0 = u.pn * 128 + wc * 32 + 4 * fq;
#pragma unroll
        for (int n = 0; n < 2; ++n) {
            const f32x4 bav = *(const f32x4*)(gp + ch0 + 16 * n), bxv = *(const f32x4*)(gp + 1024 + ch0 + 16 * n), spv = *(const f32x4*)(gp + 2048 + ch0 + 16 * n);
#pragma unroll
            for (int ai = 0; ai < 2; ++ai)
#pragma unroll
                for (int m = 0; m < 4; ++m) { const int row = row0 + ai * HALF + m * 16; const bool pos0 = (row < MP) && ((row & 16383) == 0);
                    const size_t off = (size_t)row * 1024 + ch0 + 16 * n;
                    const u32x2 xw = *(const u32x2*)(XC + off); const float xc[4] = {bf_lo(xw.x), bf_hi(xw.x), bf_lo(xw.y), bf_hi(xw.y)};
                    f32x4 av, uv;
#pragma unroll
                    for (int j = 0; j < 4; ++j) { const float r = fsigmoid(acc[ai][0][m][n][j] + bav[j]), ig = fsigmoid(acc[ai][1][m][n][j] + bxv[j]);
                        const float log_a = -8.0f * r * spv[j]; const float a = fexp(log_a); const float mult = pos0 ? 1.0f : __builtin_sqrtf(fmaxf(1.0f - a * a, 0.0f));
                        av[j] = a; uv[j] = mult * ig * xc[j]; }
                    *(f32x4*)(Aout + off) = av; { u32x2 uw; uw.x = cvt_pk_bf16(uv[0], uv[1]); uw.y = cvt_pk_bf16(uv[2], uv[3]); *(u32x2*)((bf16_t*)(Aout + (size_t)MT * 1024) + off) = uw; } asm volatile("" ::: "memory"); }
        }
    }
};
struct EpiPool {
    static constexpr bool PERM = true;
    bf16_t* CAT; const float* spool;
    __device__ __forceinline__ void operator()(const f32x4 (&acc)[2][2][4][2], const Unit& u, int wr, int wc, int fr, int fq) const {
        const int row0 = u.pm * BM + wr * 64 + fr, col0 = u.pn * BM + wc * 32 + 8 * fq;
        f32x4 s0[2], s1[2];
#pragma unroll
        for (int bj = 0; bj < 2; ++bj) { s0[bj] = *(const f32x4*)(spool + col0 + bj * HALF); s1[bj] = *(const f32x4*)(spool + col0 + bj * HALF + 4); }
#pragma unroll
        for (int ai = 0; ai < 2; ++ai)
#pragma unroll
            for (int m = 0; m < 4; ++m) { bf16_t* rowp = CAT + (size_t)(row0 + ai * HALF + m * 16) * 2048 + 1024 + col0;
#pragma unroll
                for (int bj = 0; bj < 2; ++bj) { const f32x4 v0 = acc[ai][bj][m][0] * s0[bj], v1 = acc[ai][bj][m][1] * s1[bj];
                    u32x4 w; w.x = cvt_pk_bf16(v0[0], v0[1]); w.y = cvt_pk_bf16(v0[2], v0[3]); w.z = cvt_pk_bf16(v1[0], v1[1]); w.w = cvt_pk_bf16(v1[2], v1[3]);
                    *(u32x4*)(rowp + bj * HALF) = w; } }
    }
};
struct EpiResid {
    static constexpr bool PERM = false;
    const float* xinP; const float* xinS; float* xout; const float* gate;
    __device__ __forceinline__ void operator()(const f32x4 (&acc)[2][2][4][2], const Unit& u, int wr, int wc, int fr, int fq) const {
        const int row0 = u.pm * BM + wr * 64 + fr, col0 = u.pn * BM + wc * 32 + 4 * fq;
#pragma unroll
        for (int ai = 0; ai < 2; ++ai)
#pragma unroll
            for (int m = 0; m < 4; ++m) { const int row = row0 + ai * HALF + m * 16; const float* gp = gate + (size_t)seq_of_row(row) * 12288 + col0;
                const float* xi = (row < MP ? xinP + (size_t)row * DM : xinS + (size_t)(row - MP) * DM) + col0; float* xo = xout + (size_t)row * DM + col0;
#pragma unroll
                for (int bj = 0; bj < 2; ++bj)
#pragma unroll
                    for (int n = 0; n < 2; ++n) { const int o = bj * HALF + n * 16; *(f32x4*)(xo + o) = *(const f32x4*)(xi + o) + *(const f32x4*)(gp + o) * acc[ai][bj][m][n]; }
                asm volatile("" ::: "memory"); }
    }
};
struct EpiF32 {
    static constexpr bool PERM = false;
    float* C; int ldc;
    __device__ __forceinline__ void operator()(const f32x4 (&acc)[2][2][4][2], const Unit& u, int wr, int wc, int fr, int fq) const {
        const int row0 = u.pm * BM + wr * 64 + fr, col0 = u.pn * BM + wc * 32 + 4 * fq;
#pragma unroll
        for (int ai = 0; ai < 2; ++ai)
#pragma unroll
            for (int m = 0; m < 4; ++m) { float* rowp = C + (size_t)(row0 + ai * HALF + m * 16) * ldc + col0;
#pragma unroll
                for (int bj = 0; bj < 2; ++bj)
#pragma unroll
                    for (int n = 0; n < 2; ++n) *(f32x4*)(rowp + bj * HALF + n * 16) = acc[ai][bj][m][n]; }
    }
};
struct EpiQ {
    static constexpr bool PERM = true;
    static constexpr float QS = 0.07216878364870322f * 1.4426950408889634f;
    bf16_t* Qn; bf16_t* Qp; const float* rope;
    __device__ __forceinline__ void operator()(const f32x4 (&acc)[2][2][4][2], const Unit& u, int wr, int wc, int fr, int fq) const {
        const int row0 = u.pm * BM + wr * 64 + fr;
        if (u.pn < 8) {
            const int col0 = u.pn * BM + wc * 32 + 8 * fq;
#pragma unroll
            for (int ai = 0; ai < 2; ++ai)
#pragma unroll
                for (int m = 0; m < 4; ++m) { bf16_t* rowp = Qn + (size_t)(row0 + ai * HALF + m * 16) * 2048 + col0;
#pragma unroll
                    for (int bj = 0; bj < 2; ++bj) { const f32x4 v0 = acc[ai][bj][m][0] * QS, v1 = acc[ai][bj][m][1] * QS;
                        u32x4 w; w.x = cvt_pk_bf16(v0[0], v0[1]); w.y = cvt_pk_bf16(v0[2], v0[3]); w.z = cvt_pk_bf16(v1[0], v1[1]); w.w = cvt_pk_bf16(v1[2], v1[3]);
                        *(u32x4*)(rowp + bj * HALF) = w; } }
        } else {
            const int head = (u.pn - 8) * 4 + wc, j0 = 8 * fq;
#pragma unroll
            for (int ai = 0; ai < 2; ++ai)
#pragma unroll
                for (int m = 0; m < 4; ++m) { const int row = row0 + ai * HALF + m * 16; const float* rp = rope + (size_t)pos_of_row(row) * 64 + j0;
                    const f32x4 c0 = *(const f32x4*)(rp), c1 = *(const f32x4*)(rp + 4), s0 = *(const f32x4*)(rp + 32), s1 = *(const f32x4*)(rp + 36);
                    const f32x4 x10 = acc[ai][0][m][0] * QS, x11 = acc[ai][0][m][1] * QS, x20 = acc[ai][1][m][0] * QS, x21 = acc[ai][1][m][1] * QS;
                    const f32x4 a0 = x10 * c0 - x20 * s0, a1 = x11 * c1 - x21 * s1, b0 = x10 * s0 + x20 * c0, b1 = x11 * s1 + x21 * c1;
                    bf16_t* qp = Qp + (size_t)row * 1024 + head * 64 + j0;
                    u32x4 w; w.x = cvt_pk_bf16(a0[0], a0[1]); w.y = cvt_pk_bf16(a0[2], a0[3]); w.z = cvt_pk_bf16(a1[0], a1[1]); w.w = cvt_pk_bf16(a1[2], a1[3]); *(u32x4*)qp = w;
                    w.x = cvt_pk_bf16(b0[0], b0[1]); w.y = cvt_pk_bf16(b0[2], b0[3]); w.z = cvt_pk_bf16(b1[0], b1[1]); w.w = cvt_pk_bf16(b1[2], b1[3]); *(u32x4*)(qp + 32) = w; }
        }
    }
};
struct EpiKV {
    static constexpr bool PERM = true;
    bf16_t* Kn; bf16_t* V;
    __device__ __forceinline__ void operator()(const f32x4 (&acc)[2][2][4][2], const Unit& u, int wr, int wc, int fr, int fq) const {
        const int row0 = u.pm * BM + wr * 64 + fr, col0 = u.pn * 128 + wc * 32 + 8 * fq;
#pragma unroll
        for (int ai = 0; ai < 2; ++ai)
#pragma unroll
            for (int m = 0; m < 4; ++m) { const size_t off = (size_t)(row0 + ai * HALF + m * 16) * 2048 + col0;
#pragma unroll
                for (int bj = 0; bj < 2; ++bj) { const f32x4 v0 = acc[ai][bj][m][0], v1 = acc[ai][bj][m][1];
                    u32x4 w; w.x = cvt_pk_bf16(v0[0], v0[1]); w.y = cvt_pk_bf16(v0[2], v0[3]); w.z = cvt_pk_bf16(v1[0], v1[1]); w.w = cvt_pk_bf16(v1[2], v1[3]);
                    *(u32x4*)((bj ? V : Kn) + off) = w; } }
    }
};
#undef EPI_ROWS
}

#define XB_TMO      128
#define XB_XCNT(j)  (256  + 64 * (j))
#define XB_XSUB(j)  (1280 + 64 * (j))
#define XB_XGEN(j)  (2304 + 64 * (j))
#define XB_TOP      3328
#define XB_TOPGEN   3392
#define XCD_BAR_WORDS 3456
#define XB_SPIN_CAP (1u << 18)
__device__ __forceinline__ unsigned xb_ld(unsigned* p)              { return __hip_atomic_load(p, __ATOMIC_RELAXED, __HIP_MEMORY_SCOPE_AGENT); }
__device__ __forceinline__ unsigned xb_add(unsigned* p, unsigned v) { return __hip_atomic_fetch_add(p, v, __ATOMIC_RELAXED, __HIP_MEMORY_SCOPE_AGENT); }
__device__ __forceinline__ unsigned xb_xcc_id() { return (unsigned)__builtin_amdgcn_s_getreg((3 << 11) | 20) & 0xFu; }
#define XB_SPIN(cond, bar) do { unsigned _sp = 0; while (cond) { __builtin_amdgcn_s_sleep(1); \
    if ((++_sp & 255u) == 0u) { if (xb_ld(&(bar)[XB_TMO])) break; if (_sp > XB_SPIN_CAP) { atomicAdd(&(bar)[XB_TMO], 1u); break; } } } } while (0)
struct XcdBarrier { unsigned* bar; unsigned x; volatile LAS unsigned* st; };
__device__ __forceinline__ XcdBarrier xcd_barrier_post(unsigned* bar, volatile LAS unsigned* st) {
    XcdBarrier b; b.bar = bar; b.x = xb_xcc_id(); b.st = st;
    if (threadIdx.x == 0) (void)xb_add(&bar[XB_XCNT(b.x)], 1u);
    return b;
}
__device__ __forceinline__ void xcd_barrier_complete(unsigned* bar, unsigned x, unsigned& nloc, unsigned& nx) {
    const unsigned G = gridDim.x * gridDim.y * gridDim.z;
    unsigned sum, cnt, mine, sp = 0u;
    for (;;) {
        sum = 0u; cnt = 0u; mine = 0u;
#pragma unroll
        for (unsigned j = 0; j < 16; ++j) { const unsigned c = xb_ld(&bar[XB_XCNT(j)]); sum += c; cnt += (c > 0u) ? 1u : 0u; mine = (j == x) ? c : mine; }
        if (sum == G) break;
        __builtin_amdgcn_s_sleep(1);
        if ((++sp & 255u) == 0u) { if (xb_ld(&bar[XB_TMO])) break; if (sp > XB_SPIN_CAP) { atomicAdd(&bar[XB_TMO], 1u); break; } }
    }
    nloc = mine > 0u ? mine : 1u; nx = cnt > 0u ? cnt : 1u;
}
__device__ __forceinline__ void xcd_barrier(const XcdBarrier& b) {
    asm volatile("s_waitcnt vmcnt(0)" ::: "memory");
    __syncthreads();
    if (threadIdx.x == 0) {
        unsigned* bar = b.bar;
        __builtin_amdgcn_s_waitcnt(0);
        unsigned nloc = b.st[0], nx = b.st[1];
        if (nloc == 0u) { xcd_barrier_complete(bar, b.x, nloc, nx); b.st[0] = nloc; b.st[1] = nx; }
        const unsigned old = xb_add(&bar[XB_XSUB(b.x)], 1u);
        const unsigned gen = old / nloc;
        if (old + 1u == (gen + 1u) * nloc) {
            __builtin_amdgcn_fence(__ATOMIC_RELEASE, "agent");
            asm volatile("s_waitcnt vmcnt(0)" ::: "memory");
            const unsigned og = xb_add(&bar[XB_TOP], 1u);
            const unsigned tg = og / nx;
            if (og + 1u == (tg + 1u) * nx) xb_add(&bar[XB_TOPGEN], 1u);
            else XB_SPIN(xb_ld(&bar[XB_TOPGEN]) == tg, bar);
            __builtin_amdgcn_fence(__ATOMIC_ACQUIRE, "agent");
            xb_add(&bar[XB_XGEN(b.x)], 1u);
            asm volatile("s_waitcnt vmcnt(0)" ::: "memory");
        } else {
            XB_SPIN(xb_ld(&bar[XB_XGEN(b.x)]) == gen, bar);
            __builtin_amdgcn_fence(__ATOMIC_ACQUIRE, "agent");
            asm volatile("s_waitcnt vmcnt(0)" ::: "memory");
        }
    }
    __syncthreads();
}
constexpr float U8_SCALE = 256.0f, V8_SCALE = 16.0f;
__device__ __forceinline__ void convert_fp8_range(const float* src, unsigned char* dst, float scale, size_t n16, size_t i0, size_t stride) {
    for (size_t i = i0; i < n16; i += stride) { u32x4 w;
#pragma unroll
        for (int q = 0; q < 4; ++q) { f32x4 a = *(const f32x4*)(src + i * 16 + 4 * q) * scale;
#pragma unroll
            for (int j = 0; j < 4; ++j) a[j] = fminf(fmaxf(a[j], -448.0f), 448.0f);
            int t = 0; t = __builtin_amdgcn_cvt_pk_fp8_f32(a[0], a[1], t, false); t = __builtin_amdgcn_cvt_pk_fp8_f32(a[2], a[3], t, true); w[q] = (unsigned)t; }
        *(u32x4*)(dst + i * 16) = w; }
}
constexpr float U4_SCALE = 90.50966799f, V4_SCALE = 8.0f;
__device__ __forceinline__ void convert_fp4_rows(const float* src, unsigned char* dst, float scale, int nrows, int w0, int wstride, int lane) {
    for (int r = w0; r < nrows; r += wstride) { const float* sr = src + (size_t)r * 2048 + 4 * lane; u32x4 w;
        f32x4 a[8];
#pragma unroll
        for (int b = 0; b < 8; ++b) a[b] = *(const f32x4*)(sr + 256 * b) * scale;
#pragma unroll
        for (int q = 0; q < 4; ++q) { float e[8] = {a[2 * q][0], a[2 * q][1], a[2 * q][2], a[2 * q][3], a[2 * q + 1][0], a[2 * q + 1][1], a[2 * q + 1][2], a[2 * q + 1][3]};
#pragma unroll
            for (int j = 0; j < 8; ++j) e[j] = fminf(fmaxf(e[j], -6.0f), 6.0f);
            unsigned t = 0u; t = __builtin_amdgcn_cvt_scalef32_pk_fp4_f32(t, e[0], e[1], 1.0f, 0); t = __builtin_amdgcn_cvt_scalef32_pk_fp4_f32(t, e[2], e[3], 1.0f, 1);
            t = __builtin_amdgcn_cvt_scalef32_pk_fp4_f32(t, e[4], e[5], 1.0f, 2); t = __builtin_amdgcn_cvt_scalef32_pk_fp4_f32(t, e[6], e[7], 1.0f, 3); w[q] = t; }
        *(u32x4*)(dst + (size_t)r * 1024 + 16 * lane) = w; }
}
constexpr size_t MiB = (size_t)1 << 20;
constexpr size_t WS_CTL = 0, WS_WGATE = 1 * MiB, WS_WDQKV = 2 * MiB, WS_ZERO_BYTES = 6 * MiB;
constexpr size_t WS_WIN = 6 * MiB, WS_WOUTR = 18 * MiB, WS_WQ = 26 * MiB, WS_WUQ = 42 * MiB, WS_WUKV = 45 * MiB, WS_WOUTA = 47 * MiB;
constexpr size_t WS_WPOOL = 55 * MiB, WS_KEYS = 56 * MiB, WS_MOD = 57 * MiB, WS_ROPE = 61 * MiB, WS_SP = 65 * MiB, WS_SCAN = 66 * MiB;
constexpr size_t WS_U = 73 * MiB, WS_V = 137 * MiB;
constexpr size_t A_HN = 201 * MiB, A_GG = 337 * MiB, A_B2 = 405 * MiB, A_B3 = 541 * MiB, A_B4 = 677 * MiB;
constexpr size_t A_KN = 405 * MiB, A_VV = 669 * MiB, A_KP = 933 * MiB, A_CQ = 942 * MiB, A_CKV = 976 * MiB, WS_END = 1009 * MiB;
constexpr int CW_BAR = 4096;
constexpr size_t SCAN_WORDS = (size_t)544 * 1024;
constexpr size_t O_Y = 0, O_CONV_P = 71303168, O_CONV_S = 71309312, O_H_P = 71407616, O_H_S = 71409664, O_POOL_P = 71442432, O_POOL_S = 71473152,
                 O_CKV = 71964672, O_KPE = 80877568, O_TOTAL = 83105792;
constexpr int LDS_BYTES = 147456, LDS_MISC = 147200;

struct Args { const float* in[36]; float* out; unsigned char* ws; int ph_lo, ph_hi; };

struct Ctx {
    LAS unsigned char* lds; int tid, lane, wave, vcu, G, gw, NGW;
    const float* const* in; float* out; unsigned char* ws;
};

__device__ __forceinline__ void transpose_item(const float* W, int N, int k0, int n0, bf16_t* WT, int dld, int drow0, int dcol0, LAS float* scr, int lane) {
#pragma unroll 8
    for (int i = 0; i < 32; ++i) { const int kk = 2 * i + (lane >> 5); scr[kk * 33 + (lane & 31)] = W[(size_t)(k0 + kk) * N + n0 + (lane & 31)]; }
    asm volatile("s_waitcnt lgkmcnt(0)" ::: "memory");
    const int c = lane & 7;
#pragma unroll
    for (int j = 0; j < 4; ++j) { const int n = (lane >> 3) + 8 * j; const LAS float* s = scr + (8 * c) * 33 + n;
        u32x4 o; o.x = cvt_pk_bf16(s[0 * 33], s[1 * 33]); o.y = cvt_pk_bf16(s[2 * 33], s[3 * 33]); o.z = cvt_pk_bf16(s[4 * 33], s[5 * 33]); o.w = cvt_pk_bf16(s[6 * 33], s[7 * 33]);
        *(u32x4*)(WT + (size_t)(drow0 + n) * dld + dcol0 + 8 * c) = o; }
    asm volatile("s_waitcnt lgkmcnt(0)" ::: "memory");
}
__device__ __forceinline__ void transpose_mat_item(const float* W, int K, int N, bf16_t* WT, int dld, int drow_base, int dcol_base, int item, LAS float* scr, int lane) {
    const int nblk = N / 32, kb = item / nblk, nb = item % nblk;
    transpose_item(W, N, 64 * kb, 32 * nb, WT, dld, drow_base + 32 * nb, dcol_base + 64 * kb, scr, lane);
}
__device__ __forceinline__ void convert_range(const float* src, bf16_t* dst, size_t n8, size_t i0, size_t stride) {
    for (size_t i = i0; i < n8; i += stride) { const f32x4 a = *(const f32x4*)(src + i * 8), b = *(const f32x4*)(src + i * 8 + 4);
        u32x4 w; w.x = cvt_pk_bf16(a[0], a[1]); w.y = cvt_pk_bf16(a[2], a[3]); w.z = cvt_pk_bf16(b[0], b[1]); w.w = cvt_pk_bf16(b[2], b[3]);
        *(u32x4*)(dst + i * 8) = w; }
}

__device__ __forceinline__ void ada_item(const Ctx& C, int item) {
    const int l = item / 96, nb = item % 96, n0 = nb * 128, w = C.wave, lane = C.lane;
    const float* cP = C.in[2]; const float* cS = C.in[3]; const float* W = C.in[9] + (size_t)l * 2048 * 12288 + n0 + 2 * lane; const float* bias = C.in[10] + (size_t)l * 12288 + n0;
    LAS float* scr = (LAS float*)(C.lds + w * 4608);
    LAS float* sum = (LAS float*)(C.lds + 36864);
    f32x2 acc[34];
#pragma unroll
    for (int s = 0; s < 34; ++s) acc[s] = (f32x2){0.f, 0.f};
    for (int sub = 0; sub < 8; ++sub) {
        const int k0 = 256 * w + 32 * sub;
#pragma unroll
        for (int i = 0; i < 17; ++i) { const int idx = lane + 64 * i, s = idx >> 5, kk = idx & 31;
            const float cv = (s < 2) ? cP[s * 2048 + k0 + kk] : cS[(s - 2) * 2048 + k0 + kk];
            scr[kk * 36 + s] = cv * fsigmoid(cv); }
        asm volatile("s_waitcnt lgkmcnt(0)" ::: "memory");
#pragma unroll 8
        for (int kk = 0; kk < 32; ++kk) {
            const f32x2 w2 = *(const f32x2*)(W + (size_t)(k0 + kk) * 12288);
#pragma unroll
            for (int s4 = 0; s4 < 9; ++s4) { const f32x4 sv = *(const LAS f32x4*)(scr + kk * 36 + 4 * s4);
#pragma unroll
                for (int i = 0; i < 4; ++i) if (4 * s4 + i < 34) acc[4 * s4 + i] += w2 * sv[i]; }
        }
        asm volatile("s_waitcnt lgkmcnt(0)" ::: "memory");
    }
    for (int ww = 0; ww < 8; ++ww) {
        if (w == ww) {
#pragma unroll
            for (int s = 0; s < 34; ++s) { LAS f32x2* p = (LAS f32x2*)(sum + s * 128) + lane; if (ww == 0) *p = acc[s]; else *p = *p + acc[s]; }
        }
        __syncthreads();
    }
    float* mod = (float*)(C.ws + WS_MOD);
    for (int s = w; s < 34; s += 8) { const f32x2 v = *((LAS f32x2*)(sum + s * 128) + lane) + *(const f32x2*)(bias + 2 * lane);
        *(f32x2*)(mod + ((size_t)l * NSEQ + s) * 12288 + n0 + 2 * lane) = v; }
    __syncthreads();
}

__device__ __forceinline__ void phase_prologue(const Ctx& C) {
    const int lane = C.lane;
    constexpr int NADA = 192;
    if (C.vcu < NADA && C.G > NADA) { ada_item(C, C.vcu); }
    else if (C.G <= NADA) { for (int it = C.vcu; it < NADA; it += C.G) ada_item(C, it); }
    {
        unsigned* qhead = (unsigned*)(C.ws + WS_CTL) + 64;
        {
            LAS float* scr = (LAS float*)(C.lds + 72704 + C.wave * 8448);
            bf16_t* w_in = (bf16_t*)(C.ws + WS_WIN); bf16_t* w_outr = (bf16_t*)(C.ws + WS_WOUTR); bf16_t* w_q = (bf16_t*)(C.ws + WS_WQ);
            bf16_t* w_dqkv = (bf16_t*)(C.ws + WS_WDQKV); bf16_t* w_uq = (bf16_t*)(C.ws + WS_WUQ); bf16_t* w_ukv = (bf16_t*)(C.ws + WS_WUKV);
            bf16_t* w_outa = (bf16_t*)(C.ws + WS_WOUTA); bf16_t* w_gate = (bf16_t*)(C.ws + WS_WGATE); bf16_t* w_pool = (bf16_t*)(C.ws + WS_WPOOL);
            constexpr int I_IN = 32 * 96, I_OUTR = 32 * 64, I_Q = 32 * 64, I_DQ = 32 * 16, I_DKV = 32 * 10, I_UQ = 8 * 96, I_UKV = 4 * 128, I_OUTA = 32 * 64, I_GATE = 16 * 8, I_POOL = 4 * 32;
            constexpr int NIT = I_IN + I_OUTR + 2 * I_Q + I_DQ + I_DKV + I_UQ + I_UKV + I_OUTA + I_GATE + I_POOL;
            for (;;) {
                int it = 0; if (lane == 0) it = (int)__hip_atomic_fetch_add(qhead, 1u, __ATOMIC_RELAXED, __HIP_MEMORY_SCOPE_AGENT);
                it = __builtin_amdgcn_readfirstlane(it); if (it >= NIT) break;
                int r = it;
                if (r < I_IN) { transpose_mat_item(C.in[13], 2048, 3072, w_in, 2048, 0, 0, r, scr, lane); continue; } r -= I_IN;
                if (r < I_OUTR) { transpose_mat_item(C.in[23], 2048, 2048, w_outr, 2048, 0, 0, r, scr, lane); continue; } r -= I_OUTR;
                if (r < 2 * I_Q) { const int l = r / I_Q; transpose_mat_item(C.in[31] + (size_t)l * 2048 * 2048, 2048, 2048, w_q + (size_t)l * 2048 * 2048, 2048, 0, 0, r % I_Q, scr, lane); continue; } r -= 2 * I_Q;
                if (r < I_DQ) { transpose_mat_item(C.in[24], 2048, 512, w_dqkv, 2048, 0, 0, r, scr, lane); continue; } r -= I_DQ;
                if (r < I_DKV) { transpose_mat_item(C.in[27], 2048, 320, w_dqkv, 2048, 512, 0, r, scr, lane); continue; } r -= I_DKV;
                if (r < I_UQ) {
                    const int kb = r / 96, nb = r % 96, n0 = 32 * nb, h = n0 / 192, d = n0 % 192;
                    const int drow = (d < 128) ? h * 128 + d : 2048 + (h >> 2) * 256 + ((d - 128) >> 5) * 128 + (h & 3) * 32;
                    transpose_item(C.in[26], 3072, 64 * kb, n0, w_uq, 512, drow, 64 * kb, scr, lane); continue; } r -= I_UQ;
                if (r < I_UKV) { transpose_mat_item(C.in[29], 256, 4096, w_ukv, 256, 0, 0, r, scr, lane); continue; } r -= I_UKV;
                if (r < I_OUTA) { transpose_mat_item(C.in[30], 2048, 2048, w_outa, 2048, 0, 0, r, scr, lane); continue; } r -= I_OUTA;
                if (r < I_GATE) {
                    const int q = r / 8, sub = r % 8, h = q >> 1, gsel = q & 1;
                    const float* src = (gsel ? C.in[18] : C.in[16]) + (size_t)h * 128 * 128;
                    transpose_mat_item(src, 128, 128, w_gate, 256, h * 256 + gsel * 128, (h & 1) * 128, sub, scr, lane); continue; } r -= I_GATE;
                { const int gq = r / 32, sub = r % 32;
                  transpose_mat_item(C.in[21] + (size_t)gq * 256 * 256, 256, 256, w_pool, 256, gq * 256, 0, sub, scr, lane); }
            }
        }
    }
    const size_t gt = (size_t)C.vcu * 512 + C.tid, GT = (size_t)C.G * 512;
    convert_fp4_rows(C.in[33], C.ws + WS_U, U4_SCALE, 16384, C.gw, C.NGW, lane);
    convert_fp4_rows(C.in[34], C.ws + WS_V, V4_SCALE, 16384, C.gw, C.NGW, lane);
    convert_range(C.in[32], (bf16_t*)(C.ws + WS_KEYS), (size_t)2 * 8 * 2 * 128 * 128 / 8, gt, GT);
    { float* rope = (float*)(C.ws + WS_ROPE);
      for (size_t i = gt; i < (size_t)16384 * 32; i += GT) { const int pos = (int)(i >> 5), j = (int)(i & 31);
          double inv = 1.0; for (int q = 0; q < j; ++q) inv *= 0.7498942093324559;
          const double rev = (double)pos * inv * 0.15915494309189535; const float fr = (float)(rev - __builtin_floor(rev));
          rope[(size_t)pos * 64 + j] = __builtin_amdgcn_cosf(fr); rope[(size_t)pos * 64 + 32 + j] = __builtin_amdgcn_sinf(fr); } }
    { float* sp = (float*)(C.ws + WS_SP);
      for (size_t i = gt; i < 1024; i += GT) { sp[i] = C.in[17][i]; sp[1024 + i] = C.in[19][i]; const float y = fexp(-C.in[20][i]); sp[2048 + i] = (y < 0.03f) ? y * (1.0f - y * (0.5f - y * (0.33333333f - y * (0.25f - 0.2f * y)))) : 0.6931471805599453f * __builtin_amdgcn_logf(1.0f + y); } }
}
__device__ __forceinline__ void norm_mod_row(const float* xrow, const float* g, const float* shift, const float* scale, bf16_t* orow, int lane) {
    f32x4 v[8]; float ss = 0.f;
#pragma unroll
    for (int j = 0; j < 8; ++j) { v[j] = *((const f32x4*)xrow + lane + 64 * j); ss += (v[j].x * v[j].x + v[j].y * v[j].y) + (v[j].z * v[j].z + v[j].w * v[j].w); }
    const float rstd = __builtin_amdgcn_rsqf(wave_sum(ss) * (1.0f / DM) + RMS_EPS);
#pragma unroll
    for (int j = 0; j < 8; ++j) { const int q = lane + 64 * j; const f32x4 gv = *((const f32x4*)g + q), sc = *((const f32x4*)scale + q), sh = *((const f32x4*)shift + q);
        const f32x4 y = v[j] * rstd * gv * (sc + 1.0f) + sh;
        u32x2 w; w.x = cvt_pk_bf16(y.x, y.y); w.y = cvt_pk_bf16(y.z, y.w); *((u32x2*)orow + q) = w; }
}
__device__ __forceinline__ void phase_norm(const Ctx& C, const float* xP, const float* xS, const float* g, const float* modl, int part, bf16_t* hn) {
    for (int m = C.gw; m < MT; m += C.NGW) {
        const float* xr = (m < MP) ? xP + (size_t)m * DM : xS + (size_t)(m - MP) * DM; const float* mp = modl + (size_t)seq_of_row(m) * 12288 + part * 2048;
        norm_mod_row(xr, g, mp, mp + 2048, hn + (size_t)m * DM, C.lane);
    }
}

__device__ __forceinline__ void phase_resid_norm(const Ctx& C, const float* xP, const float* xS, const bf16_t* mix, float* X, const float* g, const float* modl, bf16_t* hn) {
    const int lane = C.lane;
    for (int m = C.gw; m < MT; m += C.NGW) {
        const float* xr = (m < MP) ? xP + (size_t)m * DM : xS + (size_t)(m - MP) * DM; const float* mp = modl + (size_t)seq_of_row(m) * 12288;
        f32x4 v[8]; float ss = 0.f;
#pragma unroll
        for (int j = 0; j < 8; ++j) { const int q = lane + 64 * j; const f32x4 xo = *((const f32x4*)xr + q), g1 = *((const f32x4*)(mp + 2 * 2048) + q); const u32x2 mw = *((const u32x2*)(mix + (size_t)m * DM) + q);
            v[j] = xo + g1 * (f32x4){bf_lo(mw.x), bf_hi(mw.x), bf_lo(mw.y), bf_hi(mw.y)}; ss += (v[j].x * v[j].x + v[j].y * v[j].y) + (v[j].z * v[j].z + v[j].w * v[j].w);
            *((f32x4*)(X + (size_t)m * DM) + q) = v[j]; }
        const float rstd = __builtin_amdgcn_rsqf(wave_sum(ss) * (1.0f / DM) + RMS_EPS);
#pragma unroll
        for (int j = 0; j < 8; ++j) { const int q = lane + 64 * j; const f32x4 gv = *((const f32x4*)g + q), sh = *((const f32x4*)(mp + 3 * 2048) + q), sc = *((const f32x4*)(mp + 4 * 2048) + q);
            const f32x4 y = v[j] * rstd * gv * (sc + 1.0f) + sh;
            u32x2 w; w.x = cvt_pk_bf16(y.x, y.y); w.y = cvt_pk_bf16(y.z, y.w); *((u32x2*)(hn + (size_t)m * DM) + q) = w; }
    }
}

__device__ __forceinline__ void ld8bf(const bf16_t* p, float (&v)[8]) { const u32x4 w = *(const u32x4*)p; v[0] = bf_lo(w.x); v[1] = bf_hi(w.x); v[2] = bf_lo(w.y); v[3] = bf_hi(w.y); v[4] = bf_lo(w.z); v[5] = bf_hi(w.z); v[6] = bf_lo(w.w); v[7] = bf_hi(w.w); }
__device__ __forceinline__ void ld8f(const float* p, float (&v)[8]) { const f32x4 a = *(const f32x4*)p, b = *(const f32x4*)(p + 4); v[0] = a.x; v[1] = a.y; v[2] = a.z; v[3] = a.w; v[4] = b.x; v[5] = b.y; v[6] = b.z; v[7] = b.w; }
__device__ __forceinline__ void st8bf(bf16_t* p, const float (&v)[8]) { u32x4 w; w.x = cvt_pk_bf16(v[0], v[1]); w.y = cvt_pk_bf16(v[2], v[3]); w.z = cvt_pk_bf16(v[4], v[5]); w.w = cvt_pk_bf16(v[6], v[7]); *(u32x4*)p = w; }
__device__ __forceinline__ void st8f(float* p, const float (&v)[8]) { *(f32x4*)p = (f32x4){v[0], v[1], v[2], v[3]}; *(f32x4*)(p + 4) = (f32x4){v[4], v[5], v[6], v[7]}; }

__device__ __forceinline__ void phase_convpool(const Ctx& C) {
    const bf16_t* __restrict__ REC = (const bf16_t*)(C.ws + A_B2); const bf16_t* __restrict__ PIN = REC + (size_t)MT * 1024;
    bf16_t* __restrict__ XC = (bf16_t*)(C.ws + A_B3); bf16_t* __restrict__ POOLED = XC + (size_t)MT * 1024;
    const float* convw = C.in[14]; const float* convb = C.in[15]; const float* st_conv = C.in[4]; const float* st_pool = C.in[6];
    const int NITEM = 2 * 544 * 128;
    for (int it0 = C.vcu * 512 + C.tid; it0 < NITEM; it0 += C.G * 512) {
        const bool is_pool = it0 >= 544 * 128; const int it = is_pool ? it0 - 544 * 128 : it0;
        const int chunk = it >> 7, ch0 = (it & 127) * 8;
        const bool samp = chunk >= 512; const int sb = chunk - 512;
        const int row0 = samp ? MP + sb * 64 : chunk * 64;
        const int t0 = samp ? 0 : (chunk & 255) * 64;
        const bool lastc = samp || ((chunk & 255) == 255);
        if (!is_pool) {
            float w0[8], w1[8], w2[8], w3[8], bb[8], p0[8], p1[8], p2[8];
            ld8f(convw + ch0, w0); ld8f(convw + 1024 + ch0, w1); ld8f(convw + 2048 + ch0, w2); ld8f(convw + 3072 + ch0, w3); ld8f(convb + ch0, bb);
            if (samp) { ld8f(st_conv + ((size_t)sb * 3 + 0) * 1024 + ch0, p0); ld8f(st_conv + ((size_t)sb * 3 + 1) * 1024 + ch0, p1); ld8f(st_conv + ((size_t)sb * 3 + 2) * 1024 + ch0, p2); }
            else if (t0 > 0) { ld8bf(REC + (size_t)(row0 - 3) * 1024 + ch0, p0); ld8bf(REC + (size_t)(row0 - 2) * 1024 + ch0, p1); ld8bf(REC + (size_t)(row0 - 1) * 1024 + ch0, p2); }
            else {
#pragma unroll
                for (int j = 0; j < 8; ++j) { p0[j] = 0.f; p1[j] = 0.f; p2[j] = 0.f; } }
            for (int tb = 0; tb < 64; tb += 8) {
                u32x4 raw[8];
#pragma unroll
                for (int q = 0; q < 8; ++q) raw[q] = *(const u32x4*)(REC + (size_t)(row0 + tb + q) * 1024 + ch0);
#pragma unroll
                for (int q = 0; q < 8; ++q) { const u32x4 w = raw[q]; const float cur[8] = {bf_lo(w.x), bf_hi(w.x), bf_lo(w.y), bf_hi(w.y), bf_lo(w.z), bf_hi(w.z), bf_lo(w.w), bf_hi(w.w)}; float o[8];
#pragma unroll
                    for (int j = 0; j < 8; ++j) { o[j] = bb[j] + w0[j] * p0[j] + w1[j] * p1[j] + w2[j] * p2[j] + w3[j] * cur[j]; p0[j] = p1[j]; p1[j] = p2[j]; p2[j] = cur[j]; }
                    st8bf(XC + (size_t)(row0 + tb + q) * 1024 + ch0, o); } }
            if (lastc) { float* dst = samp ? C.out + O_CONV_S + (size_t)sb * 3 * 1024 : C.out + O_CONV_P + (size_t)(chunk >> 8) * 3 * 1024;
                st8f(dst + ch0, p0); st8f(dst + 1024 + ch0, p1); st8f(dst + 2048 + ch0, p2); }
        } else {
            const int gsel = ch0 >> 8, w = 2 << gsel;
            float S[8];
#pragma unroll
            for (int j = 0; j < 8; ++j) S[j] = 0.f;
            for (int tt = 1 - w; tt < 0; ++tt) { float v[8];
                if (samp) ld8f(st_pool + ((size_t)sb * 15 + 15 + tt) * 1024 + ch0, v);
                else if (t0 + tt >= 0) ld8bf(PIN + (size_t)(row0 + tt) * 1024 + ch0, v);
                else {
#pragma unroll
                    for (int j = 0; j < 8; ++j) v[j] = 0.f; }
#pragma unroll
                for (int j = 0; j < 8; ++j) S[j] += v[j]; }
            for (int tb = 0; tb < 64; tb += 8) {
                u32x4 rawc[8]; float oldv[8][8];
#pragma unroll
                for (int q = 0; q < 8; ++q) rawc[q] = *(const u32x4*)(PIN + (size_t)(row0 + tb + q) * 1024 + ch0);
#pragma unroll
                for (int q = 0; q < 8; ++q) { const int tt = tb + q - w + 1;
                    if (tt >= 0 || (!samp && t0 + tt >= 0)) ld8bf(PIN + (size_t)(row0 + tt) * 1024 + ch0, oldv[q]);
                    else if (samp) ld8f(st_pool + ((size_t)sb * 15 + 15 + tt) * 1024 + ch0, oldv[q]);
                    else {
#pragma unroll
                        for (int j = 0; j < 8; ++j) oldv[q][j] = 0.f; } }
#pragma unroll
                for (int q = 0; q < 8; ++q) { const u32x4 wv = rawc[q]; const float cur[8] = {bf_lo(wv.x), bf_hi(wv.x), bf_lo(wv.y), bf_hi(wv.y), bf_lo(wv.z), bf_hi(wv.z), bf_lo(wv.w), bf_hi(wv.w)}; float o[8];
                    const int pos = samp ? 1024 + tb + q : t0 + tb + q; const float rc = 1.0f / (float)((pos + 1 < w) ? pos + 1 : w);
#pragma unroll
                    for (int j = 0; j < 8; ++j) { S[j] += cur[j]; o[j] = S[j] * rc - cur[j]; S[j] -= oldv[q][j]; }
                    st8bf(POOLED + (size_t)(row0 + tb + q) * 1024 + ch0, o); } }
            if (lastc) { float* dst = samp ? C.out + O_POOL_S + (size_t)sb * 15 * 1024 : C.out + O_POOL_P + (size_t)(chunk >> 8) * 15 * 1024;
                for (int i = 0; i < 15; ++i) { float v[8]; ld8bf(PIN + (size_t)(row0 + 49 + i) * 1024 + ch0, v); st8f(dst + (size_t)i * 1024 + ch0, v); } }
        }
    }
}

__device__ __forceinline__ void phase_scanA(const Ctx& C) {
    const float* __restrict__ A = (const float*)(C.ws + A_B4); const bf16_t* __restrict__ U = (const bf16_t*)(A + (size_t)MT * 1024);
    float* __restrict__ cP = (float*)(C.ws + WS_SCAN); float* __restrict__ cH = cP + SCAN_WORDS;
    for (int it = C.vcu * 512 + C.tid; it < 544 * 256; it += C.G * 512) {
        const int chunk = it >> 8, ch = (it & 255) * 4; const int row0 = chunk * 64;
        f32x4 P = {1.f, 1.f, 1.f, 1.f}, H = {0.f, 0.f, 0.f, 0.f};
        for (int tb = 0; tb < 64; tb += 8) { f32x4 av[8], uv[8];
#pragma unroll
            for (int q = 0; q < 8; ++q) { av[q] = *(const f32x4*)(A + (size_t)(row0 + tb + q) * 1024 + ch); const u32x2 uw = *(const u32x2*)(U + (size_t)(row0 + tb + q) * 1024 + ch); uv[q] = (f32x4){bf_lo(uw.x), bf_hi(uw.x), bf_lo(uw.y), bf_hi(uw.y)}; }
#pragma unroll
            for (int q = 0; q < 8; ++q) { H = av[q] * H + uv[q]; P = P * av[q]; } }
        *(f32x4*)(cP + (size_t)chunk * 1024 + ch) = P; *(f32x4*)(cH + (size_t)chunk * 1024 + ch) = H;
    }
}
__device__ __forceinline__ void phase_scanB(const Ctx& C) {
    const float* __restrict__ cP = (const float*)(C.ws + WS_SCAN); const float* __restrict__ cH = cP + SCAN_WORDS; float* __restrict__ cI = (float*)(C.ws + WS_SCAN) + 2 * SCAN_WORDS;
    const int it = C.vcu * 512 + C.tid;
    if (it < 2048) { const int s = it >> 10, ch = it & 1023; float carry = 0.f;
        for (int cb = 0; cb < 256; cb += 16) { float pv[16], hv[16];
#pragma unroll
            for (int q = 0; q < 16; ++q) { const size_t o = (size_t)(s * 256 + cb + q) * 1024 + ch; pv[q] = cP[o]; hv[q] = cH[o]; }
#pragma unroll
            for (int q = 0; q < 16; ++q) { cI[(size_t)(s * 256 + cb + q) * 1024 + ch] = carry; carry = pv[q] * carry + hv[q]; } } }
}
__device__ __forceinline__ void phase_scanC(const Ctx& C) {
    const float* __restrict__ A = (const float*)(C.ws + A_B4); const bf16_t* __restrict__ U = (const bf16_t*)(A + (size_t)MT * 1024); const float* __restrict__ cI = (const float*)(C.ws + WS_SCAN) + 2 * SCAN_WORDS;
    const bf16_t* __restrict__ GG = (const bf16_t*)(C.ws + A_GG); bf16_t* __restrict__ CAT = (bf16_t*)(C.ws + A_HN); const float* hprev = C.in[5];
    for (int it = C.vcu * 512 + C.tid; it < 544 * 256; it += C.G * 512) {
        const int chunk = it >> 8, ch = (it & 255) * 4; const int row0 = chunk * 64; const bool samp = chunk >= 512;
        f32x4 h = samp ? *(const f32x4*)(hprev + (size_t)(chunk - 512) * 1024 + ch) : *(const f32x4*)(cI + (size_t)chunk * 1024 + ch);
        for (int tb = 0; tb < 64; tb += 8) { f32x4 av[8], uv[8]; u32x2 gv[8];
#pragma unroll
            for (int q = 0; q < 8; ++q) { const size_t o = (size_t)(row0 + tb + q) * 1024 + ch; av[q] = *(const f32x4*)(A + o); { const u32x2 uw = *(const u32x2*)(U + o); uv[q] = (f32x4){bf_lo(uw.x), bf_hi(uw.x), bf_lo(uw.y), bf_hi(uw.y)}; } gv[q] = *(const u32x2*)(GG + o); }
#pragma unroll
            for (int q = 0; q < 8; ++q) { h = av[q] * h + uv[q];
                u32x2 w; w.x = cvt_pk_bf16(bf_lo(gv[q].x) * h.x, bf_hi(gv[q].x) * h.y); w.y = cvt_pk_bf16(bf_lo(gv[q].y) * h.z, bf_hi(gv[q].y) * h.w);
                *(u32x2*)(CAT + (size_t)(row0 + tb + q) * 2048 + ch) = w; } }
        if (samp) *(f32x4*)(C.out + O_H_S + (size_t)(chunk - 512) * 1024 + ch) = h;
        else if ((chunk & 255) == 255) *(f32x4*)(C.out + O_H_P + (size_t)(chunk >> 8) * 1024 + ch) = h;
    }
}

__device__ __forceinline__ void phase_latent(const Ctx& C) {
    const float* CQKV = (const float*)(C.ws + A_B3); bf16_t* CQ = (bf16_t*)(C.ws + A_CQ); bf16_t* CKV = (bf16_t*)(C.ws + A_CKV); bf16_t* KP = (bf16_t*)(C.ws + A_KP);
    const float* gq = C.in[25]; const float* gkv = C.in[28]; const float* rope = (const float*)(C.ws + WS_ROPE); const int lane = C.lane;
    for (int m = C.gw; m < MT; m += C.NGW) {
        const float* r = CQKV + (size_t)m * 1024; const int kvr = kvrow_of_row(m);
        { float v[8]; ld8f(r + lane * 8, v); float ss = 0.f;
#pragma unroll
          for (int j = 0; j < 8; ++j) ss += v[j] * v[j];
          const float rstd = __builtin_amdgcn_rsqf(wave_sum(ss) * (1.0f / 512) + RMS_EPS); float g[8]; ld8f(gq + lane * 8, g);
#pragma unroll
          for (int j = 0; j < 8; ++j) v[j] = v[j] * rstd * g[j];
          st8bf(CQ + (size_t)m * 512 + lane * 8, v); }
        { const f32x4 v = *(const f32x4*)(r + 512 + lane * 4); const float ss = (v.x * v.x + v.y * v.y) + (v.z * v.z + v.w * v.w);
          const float rstd = __builtin_amdgcn_rsqf(wave_sum(ss) * (1.0f / 256) + RMS_EPS); const f32x4 y = v * rstd * *(const f32x4*)(gkv + lane * 4);
          *(f32x4*)(C.out + O_CKV + (size_t)m * 256 + lane * 4) = y;
          u32x2 w; w.x = cvt_pk_bf16(y.x, y.y); w.y = cvt_pk_bf16(y.z, y.w); *(u32x2*)(CKV + (size_t)kvr * 256 + lane * 4) = w; }
        { const float x = r[768 + lane]; const float xo = __shfl_xor(x, 32); const int j = lane & 31; const float* rp = rope + (size_t)pos_of_row(m) * 64;
          const float c = rp[j], s = rp[32 + j]; const float y = (lane < 32) ? x * c - xo * s : xo * s + x * c;
          C.out[O_KPE + (size_t)m * 64 + lane] = y; const unsigned yb = cvt_pk_bf16(y, y); KP[(size_t)kvr * 64 + lane] = (bf16_t)(yb & 0xffffu); }
    }
    const size_t gt = (size_t)C.vcu * 512 + C.tid, GT = (size_t)C.G * 512;
    for (size_t i = gt; i < (size_t)32 * 1024 * 256 / 8; i += GT) { const size_t e = i * 8, rowc = e / 256, col = e % 256, b = rowc / 1024, p = rowc % 1024;
        float v[8]; ld8f(C.in[7] + e, v); st8bf(CKV + ((size_t)MP + b * 1088 + p) * 256 + col, v); }
    for (size_t i = gt; i < (size_t)32 * 1024 * 64 / 8; i += GT) { const size_t e = i * 8, rowc = e / 64, col = e % 64, b = rowc / 1024, p = rowc % 1024;
        float v[8]; ld8f(C.in[8] + e, v); st8bf(KP + ((size_t)MP + b * 1088 + p) * 64 + col, v); }
    convert_fp4_rows(C.in[33] + (size_t)16384 * 2048, C.ws + WS_U, U4_SCALE, 16384, C.gw, C.NGW, lane);
    convert_fp4_rows(C.in[34] + (size_t)16384 * 2048, C.ws + WS_V, V4_SCALE, 16384, C.gw, C.NGW, lane);
}
typedef __bf16 bf2_t __attribute__((ext_vector_type(2)));
__device__ __forceinline__ unsigned ford(float f) { const unsigned u = __float_as_uint(f); return (u & 0x80000000u) ? ~u : (u | 0x80000000u); }
__device__ __forceinline__ float funord(unsigned o) { return __uint_as_float((o & 0x80000000u) ? (o & 0x7fffffffu) : ~o); }
__device__ __forceinline__ unsigned umax(unsigned a, unsigned b) { return a > b ? a : b; }
__device__ __forceinline__ unsigned umin(unsigned a, unsigned b) { return a < b ? a : b; }
__device__ __forceinline__ void ins16(unsigned (&L)[16], unsigned x) {
#pragma unroll
    for (int i = 0; i < 16; ++i) { const unsigned t = umax(L[i], x); x = umin(L[i], x); L[i] = t; }
}
__device__ __forceinline__ void ins16p(unsigned (&K)[16], unsigned (&P)[16], unsigned key, unsigned pay) {
#pragma unroll
    for (int i = 0; i < 16; ++i) { const bool c = key > K[i]; const unsigned tk = c ? key : K[i], nk = c ? K[i] : key, tp = c ? pay : P[i], np = c ? P[i] : pay; K[i] = tk; P[i] = tp; key = nk; pay = np; }
}
__device__ __forceinline__ void sort16_desc(unsigned (&v)[16]) {
#pragma unroll
    for (int k = 2; k <= 16; k <<= 1)
#pragma unroll
        for (int j = k >> 1; j >= 1; j >>= 1)
#pragma unroll
            for (int i = 0; i < 16; ++i) { const int l = i ^ j; if (l > i) { const bool desc = ((i & k) == 0); const unsigned a = v[i], b = v[l], hi = umax(a, b), lo = umin(a, b); v[i] = desc ? hi : lo; v[l] = desc ? lo : hi; } }
}
__device__ __forceinline__ void merge16_desc(unsigned (&A)[16], const unsigned (&B)[16]) {
#pragma unroll
    for (int i = 0; i < 16; ++i) A[i] = umax(A[i], B[15 - i]);
#pragma unroll
    for (int st = 8; st >= 1; st >>= 1)
#pragma unroll
        for (int i = 0; i < 16; ++i) if ((i & st) == 0) { const unsigned a = A[i], b = A[i + st]; A[i] = umax(a, b); A[i + st] = umin(a, b); }
}
__device__ __forceinline__ void subkey_top16(const bf16_t* qrow  , const bf16_t* krow  , int hh, unsigned (&S)[16]) {
    bf16x8 qf[8];
#pragma unroll
    for (int s = 0; s < 8; ++s) qf[s] = *(const bf16x8*)(qrow + 16 * s);
    unsigned L[16];
#pragma unroll
    for (int i = 0; i < 16; ++i) L[i] = 0u;
#pragma unroll 1
    for (int kb = 0; kb < 4; ++kb) {
        bf16x8 kf[8];
#pragma unroll
        for (int s = 0; s < 8; ++s) kf[s] = *(const bf16x8*)(krow + (size_t)kb * 32 * 128 + 16 * s);
        f32x16 a = {0.f, 0.f, 0.f, 0.f, 0.f, 0.f, 0.f, 0.f, 0.f, 0.f, 0.f, 0.f, 0.f, 0.f, 0.f, 0.f};
#pragma unroll
        for (int s = 0; s < 8; ++s) a = __builtin_amdgcn_mfma_f32_32x32x16_bf16(kf[s], qf[s], a, 0, 0, 0);
        unsigned N[16];
#pragma unroll
        for (int r = 0; r < 16; ++r) { const unsigned idx = (unsigned)(32 * kb + (r & 3) + 8 * (r >> 2) + 4 * hh); N[r] = (ford(a[r]) & ~0x7fu) | idx; }
        sort16_desc(N); merge16_desc(L, N);
        asm volatile("" ::: "memory");
    }
    unsigned P[16];
#pragma unroll
    for (int i = 0; i < 16; ++i) P[i] = (unsigned)__shfl_xor((int)L[i], 32);
#pragma unroll
    for (int i = 0; i < 16; ++i) S[i] = L[i];
    merge16_desc(S, P);
}
__device__ __forceinline__ void phase_topk(const Ctx& C, int layer) {
    const bf16_t* Q = (const bf16_t*)(C.ws + A_B3); const bf16_t* KEYS = (const bf16_t*)(C.ws + WS_KEYS) + (size_t)layer * 8 * 2 * 128 * 128;
    int* IDX = (int*)(C.ws + A_B4); float* GATE = (float*)(C.ws + A_B4) + (size_t)MT * 128;
    const int lane = C.lane, r = lane & 31, hh = lane >> 5;
    for (int task = C.gw; task < (MT / 32) * 8; task += C.NGW) {
        const int tg = task >> 3, h = task & 7, m = tg * 32 + r;
        unsigned S1[16], S2[16];
        subkey_top16(Q + (size_t)m * 2048 + h * 256 + 8 * hh, KEYS + ((size_t)(h * 2 + 0) * 128 + r) * 128 + 8 * hh, hh, S1);
        subkey_top16(Q + (size_t)m * 2048 + h * 256 + 128 + 8 * hh, KEYS + ((size_t)(h * 2 + 1) * 128 + r) * 128 + 8 * hh, hh, S2);
#define CKEY(a, b) ((ford(funord(S1[a] & ~0x7fu) + funord(S2[b] & ~0x7fu)) & ~0xffu) | (unsigned)((a) << 4 | (b)))
        unsigned FK[16], G[16];
#pragma unroll
        for (int b = 0; b < 16; ++b) FK[b] = CKEY(0, b);
#pragma unroll
        for (int b = 0; b < 8; ++b) G[b] = CKEY(1, b);
#pragma unroll
        for (int b = 0; b < 5; ++b) G[8 + b] = CKEY(2, b);
#pragma unroll
        for (int b = 0; b < 3; ++b) G[13 + b] = CKEY(4, b);
        sort16_desc(G); merge16_desc(FK, G);
#pragma unroll
        for (int b = 0; b < 4; ++b) G[b] = CKEY(3, b);
#pragma unroll
        for (int b = 0; b < 2; ++b) { G[4 + b] = CKEY(5, b); G[6 + b] = CKEY(6, b); G[8 + b] = CKEY(7, b); }
#pragma unroll
        for (int a = 8; a < 14; ++a) G[2 + a] = CKEY(a, 0);
        sort16_desc(G); merge16_desc(FK, G);
        ins16(FK, CKEY(14, 0)); ins16(FK, CKEY(15, 0));
#undef CKEY
        unsigned I1p[4], I2p[4];
#pragma unroll
        for (int w = 0; w < 4; ++w) { I1p[w] = (S1[4 * w] & 0x7fu) | ((S1[4 * w + 1] & 0x7fu) << 8) | ((S1[4 * w + 2] & 0x7fu) << 16) | ((S1[4 * w + 3] & 0x7fu) << 24);
                                      I2p[w] = (S2[4 * w] & 0x7fu) | ((S2[4 * w + 1] & 0x7fu) << 8) | ((S2[4 * w + 2] & 0x7fu) << 16) | ((S2[4 * w + 3] & 0x7fu) << 24); }
        const float mx = funord(FK[0] & ~0xffu); float sum = 0.f;
#pragma unroll
        for (int i = 0; i < 16; ++i) sum += fexp(funord(FK[i] & ~0xffu) - mx);
        const float rs = 1.0f / sum;
        int oi[8]; float og[8];
#pragma unroll
        for (int i = 0; i < 8; ++i) { const unsigned key = hh ? FK[8 + i] : FK[i]; const unsigned a = (key >> 4) & 15u, b = key & 15u;
            const unsigned w1 = (a >> 2) == 0u ? I1p[0] : ((a >> 2) == 1u ? I1p[1] : ((a >> 2) == 2u ? I1p[2] : I1p[3]));
            const unsigned w2 = (b >> 2) == 0u ? I2p[0] : ((b >> 2) == 1u ? I2p[1] : ((b >> 2) == 2u ? I2p[2] : I2p[3]));
            oi[i] = (int)((((w1 >> ((a & 3u) * 8u)) & 0x7fu) << 7) | ((w2 >> ((b & 3u) * 8u)) & 0x7fu));
            og[i] = fexp(funord(key & ~0xffu) - mx) * rs; }
        const size_t o = (size_t)m * 128 + h * 16 + 8 * hh;
        *(u32x4*)(IDX + o) = (u32x4){(unsigned)oi[0], (unsigned)oi[1], (unsigned)oi[2], (unsigned)oi[3]}; *(u32x4*)(IDX + o + 4) = (u32x4){(unsigned)oi[4], (unsigned)oi[5], (unsigned)oi[6], (unsigned)oi[7]};
        *(f32x4*)(GATE + o) = (f32x4){og[0], og[1], og[2], og[3]}; *(f32x4*)(GATE + o + 4) = (f32x4){og[4], og[5], og[6], og[7]};
    }
}

template <int CTRL, int ROWMASK> __device__ __forceinline__ float dppf(float v) { return __builtin_bit_cast(float, __builtin_amdgcn_update_dpp(0, __builtin_bit_cast(int, v), CTRL, ROWMASK, 0xF, false)); }
__device__ __forceinline__ float wave_sum_u(float v) {
    v += dppf<0xB1, 0xF>(v); v += dppf<0x4E, 0xF>(v); v += dppf<0x141, 0xF>(v); v += dppf<0x140, 0xF>(v);
    v += dppf<0x142, 0xA>(v); v += dppf<0x143, 0xC>(v);
    return __builtin_bit_cast(float, __builtin_amdgcn_readlane(__builtin_bit_cast(int, v), 63));
}
struct RowSet4 { u32x4 u, v; };
__device__ __forceinline__ void load_rows4(RowSet4& R, const unsigned char* U4, const unsigned char* V4, int eid, int lane) {
    const size_t o = (size_t)eid * 1024 + lane * 16; R.u = *(const u32x4*)(U4 + o); R.v = *(const u32x4*)(V4 + o);
}
__device__ __forceinline__ void use_rows4(const u32x4 Ru, const u32x4 Rv, const float (&xf)[32], float gate, float (&out)[32]) {
    float d0 = 0.f, d1 = 0.f;
#define U4_STEP(w, b) { const f32x2 t = __builtin_amdgcn_cvt_scalef32_pk_f32_fp4(Ru[w], 1.0f, b); d0 = fmaf(xf[8 * (w) + 2 * (b)], t.x, d0); d1 = fmaf(xf[8 * (w) + 2 * (b) + 1], t.y, d1); }
#define U4_WORD(w) U4_STEP(w, 0) U4_STEP(w, 1) U4_STEP(w, 2) U4_STEP(w, 3)
    U4_WORD(0) U4_WORD(1) U4_WORD(2) U4_WORD(3)
#undef U4_WORD
#undef U4_STEP
    const float d = wave_sum_u(d0 + d1) * (1.0f / U4_SCALE);
    const float a = gelu_erf(d) * gate * (1.0f / V4_SCALE);
#define V4_STEP(w, b) { const f32x2 t = __builtin_amdgcn_cvt_scalef32_pk_f32_fp4(Rv[w], 1.0f, b); out[8 * (w) + 2 * (b)] = fmaf(a, t.x, out[8 * (w) + 2 * (b)]); out[8 * (w) + 2 * (b) + 1] = fmaf(a, t.y, out[8 * (w) + 2 * (b) + 1]); }
#define V4_WORD(w) V4_STEP(w, 0) V4_STEP(w, 1) V4_STEP(w, 2) V4_STEP(w, 3)
    V4_WORD(0) V4_WORD(1) V4_WORD(2) V4_WORD(3)
#undef V4_WORD
#undef V4_STEP
}
__device__ __forceinline__ void phase_gather(const Ctx& C, int layer) {
    const bf16_t* HN2 = (const bf16_t*)(C.ws + A_B2); const unsigned char* U4 = C.ws + WS_U; const unsigned char* V4 = C.ws + WS_V;
    const int* IDX = (const int*)(C.ws + A_B4); const float* GATE = (const float*)(C.ws + A_B4) + (size_t)MT * 128;
    const float* mod = (const float*)(C.ws + WS_MOD); float* X = C.out + O_Y; bf16_t* HN = (bf16_t*)(C.ws + A_HN);
    const int lane = C.lane;
    for (int m = C.gw; m < MT; m += C.NGW) {
        const int i0 = IDX[(size_t)m * 128 + lane], i1 = IDX[(size_t)m * 128 + 64 + lane];
        const float g0 = GATE[(size_t)m * 128 + lane], g1 = GATE[(size_t)m * 128 + 64 + lane];
        float xf[32];
#pragma unroll
        for (int b = 0; b < 8; ++b) { const u32x2 w = *(const u32x2*)(HN2 + (size_t)m * 2048 + 256 * b + 4 * lane); xf[4 * b] = bf_lo(w.x); xf[4 * b + 1] = bf_hi(w.x); xf[4 * b + 2] = bf_lo(w.y); xf[4 * b + 3] = bf_hi(w.y); }
        float out[32];
#pragma unroll
        for (int i = 0; i < 32; ++i) out[i] = 0.f;
#define EID(j) __builtin_amdgcn_readlane(((j) < 64) ? i0 : i1, (j) & 63)
#define EGT(j) __builtin_bit_cast(float, __builtin_amdgcn_readlane(__builtin_bit_cast(int, ((j) < 64) ? g0 : g1), (j) & 63))
#define SB() __builtin_amdgcn_sched_barrier(0)
        LAS unsigned char* ring = C.lds + C.wave * 16384;
#define RING_ISSUE(j) do { const int eid_ = EID((j) & 127); const int sl_ = (j) & 7; \
            __builtin_amdgcn_global_load_lds((const unsigned*)(U4 + (size_t)eid_ * 1024 + lane * 16), (LAS unsigned*)(ring + sl_ * 2048), 16, 0, 0); \
            __builtin_amdgcn_global_load_lds((const unsigned*)(V4 + (size_t)eid_ * 1024 + lane * 16), (LAS unsigned*)(ring + sl_ * 2048 + 1024), 16, 0, 0); } while (0)
#pragma unroll
        for (int i = 0; i < 32; ++i) asm volatile("" : "+v"(xf[i]));
        { int t0_ = i0, t1_ = i1; float t2_ = g0, t3_ = g1; asm volatile("" : "+v"(t0_), "+v"(t1_), "+v"(t2_), "+v"(t3_)); }
        asm volatile("s_waitcnt vmcnt(0)" ::: "memory");
#pragma unroll
        for (int j = 0; j < 7; ++j) RING_ISSUE(j);
        for (int e = 0; e < 128; ++e) {
            RING_ISSUE(e + 7);
            asm volatile("s_waitcnt vmcnt(14)" ::: "memory");
            const u32x4 ru = *(const LAS u32x4*)(ring + (e & 7) * 2048 + lane * 16), rv = *(const LAS u32x4*)(ring + (e & 7) * 2048 + 1024 + lane * 16);
            use_rows4(ru, rv, xf, EGT(e), out);
        }
        asm volatile("s_waitcnt vmcnt(0)" ::: "memory");
#undef RING_ISSUE
#undef SB
#undef EID
#undef EGT
        const int sq = seq_of_row(m); const float* g2 = mod + ((size_t)layer * NSEQ + sq) * 12288 + 5 * 2048; float* xr = X + (size_t)m * DM;
        float ss = 0.f;
#pragma unroll
        for (int b = 0; b < 8; ++b) { const int c = 256 * b + 4 * lane; const f32x4 xo = *(const f32x4*)(xr + c), gg = *(const f32x4*)(g2 + c);
#pragma unroll
            for (int j = 0; j < 4; ++j) { const float v = xo[j] + gg[j] * out[4 * b + j]; out[4 * b + j] = v; ss += v * v; } }
        const float rstd = __builtin_amdgcn_rsqf(wave_sum(ss) * (1.0f / DM) + RMS_EPS);
        if (layer == 0) {
            const float* n1g = C.in[11] + 2048; const float* mp = mod + ((size_t)1 * NSEQ + sq) * 12288;
#pragma unroll
            for (int b = 0; b < 8; ++b) { const int c = 256 * b + 4 * lane; const f32x4 gv = *(const f32x4*)(n1g + c), sh = *(const f32x4*)(mp + c), sc = *(const f32x4*)(mp + 2048 + c);
                const f32x4 xs = {out[4 * b], out[4 * b + 1], out[4 * b + 2], out[4 * b + 3]}; const f32x4 y = xs * rstd * gv * (sc + 1.0f) + sh;
                *(f32x4*)(xr + c) = xs; u32x2 w; w.x = cvt_pk_bf16(y[0], y[1]); w.y = cvt_pk_bf16(y[2], y[3]); *(u32x2*)(HN + (size_t)m * DM + c) = w; }
        } else {
            const float* fg = C.in[35];
#pragma unroll
            for (int b = 0; b < 8; ++b) { const int c = 256 * b + 4 * lane; const f32x4 gv = *(const f32x4*)(fg + c); const f32x4 xs = {out[4 * b], out[4 * b + 1], out[4 * b + 2], out[4 * b + 3]};
                *(f32x4*)(xr + c) = xs * rstd * gv; }
        }
    }
}
namespace att {
constexpr int SHM_K = 64 * 384, SHM_V = 64 * 256;
constexpr int OFF_K = 0, OFF_V = 2 * SHM_K, OFF_WS = 2 * SHM_K + 3 * SHM_V;
constexpr float SCALE = 0.07216878364870322f;
constexpr float THR = 8.f;
__device__ __forceinline__ int crow(int r, int hi) { return (r & 3) + 8 * (r >> 2) + 4 * hi; }
constexpr float THR2 = THR * 1.4426950408889634f;
__device__ __forceinline__ void partialSM(f32x16& p0, f32x16& p1, float& mref, f32x16& negm, float& alpha, bool first) {
    float pmax = p0[0];
#pragma unroll
    for (int r = 1; r < 16; ++r) pmax = fmaxf(pmax, p0[r]);
#pragma unroll
    for (int r = 0; r < 16; ++r) pmax = fmaxf(pmax, p1[r]);
    { auto rr = __builtin_amdgcn_permlane32_swap(__float_as_uint(pmax), __float_as_uint(pmax), false, false);
      pmax = fmaxf(__uint_as_float(rr[0]), __uint_as_float(rr[1])); }
    if (__builtin_expect(!first && __all(pmax <= THR2), 1)) { alpha = 1.f; }
    else { const float dl = first ? pmax : fmaxf(pmax, 0.f); alpha = first ? 1.f : __builtin_amdgcn_exp2f(-dl); mref += dl;
#pragma unroll
        for (int r = 0; r < 16; ++r) { negm[r] = -mref; p0[r] -= dl; p1[r] -= dl; }
        asm volatile("" : "+v"(negm)); }
#pragma unroll
    for (int r = 0; r < 16; ++r) p0[r] = __builtin_amdgcn_exp2f(p0[r]);
#pragma unroll
    for (int r = 0; r < 16; ++r) p1[r] = __builtin_amdgcn_exp2f(p1[r]);
}
__device__ __forceinline__ void finishSM(const f32x16& p0, const f32x16& p1, float alpha, float& l_reg, bf16x8& pa0, bf16x8& pa1, bf16x8& pa2, bf16x8& pa3) {
    float ps = 0;
#pragma unroll
    for (int r = 0; r < 16; ++r) ps += p0[r];
#pragma unroll
    for (int r = 0; r < 16; ++r) ps += p1[r];
    { auto rr = __builtin_amdgcn_permlane32_swap(__float_as_uint(ps), __float_as_uint(ps), false, false);
      ps = __uint_as_float(rr[0]) + __uint_as_float(rr[1]); }
    l_reg = l_reg * alpha + ps;
#define PK4(P, BASE, OUT) do { unsigned a0 = cvt_pk_bf16(P[BASE + 0], P[BASE + 1]), a1 = cvt_pk_bf16(P[BASE + 2], P[BASE + 3]);   \
    unsigned b0 = cvt_pk_bf16(P[BASE + 4], P[BASE + 5]), b1 = cvt_pk_bf16(P[BASE + 6], P[BASE + 7]);                              \
    auto r0 = __builtin_amdgcn_permlane32_swap(a0, b0, false, false); auto r1 = __builtin_amdgcn_permlane32_swap(a1, b1, false, false); \
    u32x4 w = {r0[0], r1[0], r0[1], r1[1]}; OUT = __builtin_bit_cast(bf16x8, w); } while (0)
    PK4(p0, 0, pa0); PK4(p0, 8, pa1); PK4(p1, 0, pa2); PK4(p1, 8, pa3);
#undef PK4
}
template <int OFF> __device__ __forceinline__ bf16x8 k_read(int addr) { bf16x8 r; asm volatile("ds_read_b128 %0, %1 offset:%2" : "=v"(r) : "v"(addr), "i"(OFF) : "memory"); return r; }
template <int I> __device__ __forceinline__ bf16x8 kfrag(const int (&kad)[4]) { constexpr int d0 = I >> 1, half = I & 1; return k_read<(d0 >> 2) * 128 + half * 12288>(kad[d0 & 3]); }
__device__ __forceinline__ int v_rd_base(int lane) { return ((lane & 3) << 3) | (((lane >> 2) & 3) << 6) | (((lane >> 4) & 1) << 5) | (((lane >> 5) & 1) << 8); }
constexpr int v_rd_off(int d0, int ks, int half) { return d0 * 512 + ks * 4096 + half * 2048; }
template <int OFF> __device__ __forceinline__ s16x4 tr_read(int vb) {
    s16x4 r; asm volatile("ds_read_b64_tr_b16 %0, %1 offset:%2" : "=&v"(r) : "v"(vb), "i"(OFF) : "memory"); return r;
}
template <int D0> __device__ __forceinline__ void pv_one(f32x16& od, int vb, bf16x8 pa0, bf16x8 pa1, bf16x8 pa2, bf16x8 pa3) {
    const s16x4 l0 = tr_read<v_rd_off(D0, 0, 0)>(vb), h0 = tr_read<v_rd_off(D0, 0, 1)>(vb), l1 = tr_read<v_rd_off(D0, 1, 0)>(vb), h1 = tr_read<v_rd_off(D0, 1, 1)>(vb);
    const s16x4 l2 = tr_read<v_rd_off(D0, 2, 0)>(vb), h2 = tr_read<v_rd_off(D0, 2, 1)>(vb), l3 = tr_read<v_rd_off(D0, 3, 0)>(vb), h3 = tr_read<v_rd_off(D0, 3, 1)>(vb);
    asm volatile("s_waitcnt lgkmcnt(0)" ::: "memory"); __builtin_amdgcn_sched_barrier(0);
#define PKV(L, H) (bf16x8){L[0], L[1], L[2], L[3], H[0], H[1], H[2], H[3]}
    od = __builtin_amdgcn_mfma_f32_32x32x16_bf16(pa0, PKV(l0, h0), od, 0, 0, 0);
    od = __builtin_amdgcn_mfma_f32_32x32x16_bf16(pa1, PKV(l1, h1), od, 0, 0, 0);
    od = __builtin_amdgcn_mfma_f32_32x32x16_bf16(pa2, PKV(l2, h2), od, 0, 0, 0);
    od = __builtin_amdgcn_mfma_f32_32x32x16_bf16(pa3, PKV(l3, h3), od, 0, 0, 0);
#undef PKV
}
struct AUnit { int qrow0, kvrow0, ntiles, head, vis0, nact; };

__device__ __forceinline__ bool next_unit(int i, int vcu, int G, AUnit& u) {
    int flat;
    if (G == 256) {
        if (i >= 10) return false;
        if (i < 8) { const int bh = vcu >> 3, s = vcu & 7, base = 16 * (i >> 1); const int qb = (i & 1) ? base + 15 - s : base + s; flat = bh * 64 + qb; }
        else flat = 2048 + vcu * 2 + (i - 8);
    } else { flat = i * G + vcu; if (flat >= 2560) return false; }
    if (flat < 2048) { const int bh = flat >> 6, qb = flat & 63, b = bh >> 4; u.head = bh & 15; u.qrow0 = b * 16384 + qb * 256; u.kvrow0 = b * 16384; u.ntiles = 4 * qb + 4; u.vis0 = 4 * qb; u.nact = 8; }
    else { const int f = flat - 2048, b = f >> 4; u.head = f & 15; u.qrow0 = MP + b * 64; u.kvrow0 = MP + b * 1088; u.ntiles = 17; u.vis0 = 1 << 20; u.nact = 2; }
    return true;
}

__device__ __forceinline__ void attn_phase(const Ctx& C) {
    bf16_t* Qn = (bf16_t*)(C.ws + A_HN); const bf16_t* Qp = (const bf16_t*)(C.ws + A_GG);
    const bf16_t* Kn = (const bf16_t*)(C.ws + A_KN); const bf16_t* Kp = (const bf16_t*)(C.ws + A_KP); const bf16_t* Vv = (const bf16_t*)(C.ws + A_VV);
    LAS unsigned char* lds = C.lds; const int wid = C.wave, lane = C.lane, r32 = lane & 31, hi = lane >> 5;
    LAS float* wsp = (LAS float*)(lds + OFF_WS) + wid * 64; LAS float* li_l = wsp; LAS float* al_l = wsp + 32;
    unsigned ka[3], kst[3]; bool kisn[3];
#pragma unroll
    for (int i = 0; i < 3; ++i) { const int Uq = (wid * 3 + i) * 64 + lane, row = Uq / 24, cp = Uq % 24, c = cp ^ ((row >> 1) & 7);
        kisn[i] = c < 16; ka[i] = kisn[i] ? (unsigned)(row * 4096 + c * 16) : (unsigned)(A_KP - A_KN) + (unsigned)(row * 128 + (c - 16) * 16); kst[i] = kisn[i] ? 64u * 4096u : 64u * 128u; }
    unsigned va[2];
#pragma unroll
    for (int i = 0; i < 2; ++i) { const int by = ((wid * 2 + i) * 64 + lane) * 16, sub = by >> 9, within = by & 511, kk = (sub >> 2) * 8 + (within >> 6), cc = (sub & 3) * 32 + ((within & 63) >> 1);
        const int k = (kk & ~0xC) | ((kk & 4) << 1) | ((kk & 8) >> 1); va[i] = (unsigned)(k * 4096 + cc * 2); }
    int kl0[4];
#pragma unroll
    for (int q = 0; q < 4; ++q) kl0[q] = (int)(uintptr_t)(lds + OFF_K) + r32 * 384 + ((((2 * q + hi) ^ ((r32 >> 1) & 7))) << 4);
    const int vb0 = (int)(uintptr_t)(lds + OFF_V) + v_rd_base(lane);
#define ATT_BAR() __builtin_amdgcn_s_barrier()
#define ATT_ISSUE(j, kb, vbi) do { _Pragma("unroll") for (int _i = 0; _i < 3; ++_i) { \
        __builtin_amdgcn_global_load_lds((const unsigned*)((const char*)Kn + kc[_i]), (LAS unsigned*)(lds + OFF_K + (kb) * SHM_K + (wid * 3 + _i) * 1024), 16, 0, 0); kc[_i] += kst[_i]; } \
      _Pragma("unroll") for (int _i = 0; _i < 2; ++_i) { \
        __builtin_amdgcn_global_load_lds((const unsigned*)((const char*)Vv + vc[_i]), (LAS unsigned*)(lds + OFF_V + (vbi) * SHM_V + (wid * 2 + _i) * 1024), 16, 0, 0); vc[_i] += 64u * 4096u; } } while (0)
#define PV_STEP(I, PA, L, H, WN) do { asm volatile("s_waitcnt lgkmcnt(" #WN ")" : "+v"(L), "+v"(H) :: "memory"); \
        o[(I) >> 2] = __builtin_amdgcn_mfma_f32_32x32x16_bf16(PA, ((bf16x8){L[0], L[1], L[2], L[3], H[0], H[1], H[2], H[3]}), o[(I) >> 2], 0, 0, 0); \
        if ((I) + 4 < 16) { L = tr_read<v_rd_off((((I) + 4) & 15) >> 2, (I) & 3, 0)>(vb); H = tr_read<v_rd_off((((I) + 4) & 15) >> 2, (I) & 3, 1)>(vb); } \
        __builtin_amdgcn_sched_barrier(0); } while (0)
#define ATT_PV(VBI) do { const int vb = vb0 + (VBI) * SHM_V; \
      s16x4 l0 = tr_read<v_rd_off(0, 0, 0)>(vb), h0 = tr_read<v_rd_off(0, 0, 1)>(vb), l1 = tr_read<v_rd_off(0, 1, 0)>(vb), h1 = tr_read<v_rd_off(0, 1, 1)>(vb); \
      s16x4 l2 = tr_read<v_rd_off(0, 2, 0)>(vb), h2 = tr_read<v_rd_off(0, 2, 1)>(vb), l3 = tr_read<v_rd_off(0, 3, 0)>(vb), h3 = tr_read<v_rd_off(0, 3, 1)>(vb); \
      PV_STEP(0, pa0, l0, h0, 6);  PV_STEP(1, pa1, l1, h1, 6);  PV_STEP(2, pa2, l2, h2, 6);  PV_STEP(3, pa3, l3, h3, 6); \
      PV_STEP(4, pa0, l0, h0, 6);  PV_STEP(5, pa1, l1, h1, 6);  PV_STEP(6, pa2, l2, h2, 6);  PV_STEP(7, pa3, l3, h3, 6); \
      PV_STEP(8, pa0, l0, h0, 6);  PV_STEP(9, pa1, l1, h1, 6);  PV_STEP(10, pa2, l2, h2, 6); PV_STEP(11, pa3, l3, h3, 6); \
      PV_STEP(12, pa0, l0, h0, 6); PV_STEP(13, pa1, l1, h1, 4); PV_STEP(14, pa2, l2, h2, 2); PV_STEP(15, pa3, l3, h3, 0); } while (0)
    const bool grpY = wid >= 4;
    AUnit u;
    for (int ui = 0; next_unit(ui, C.vcu, C.G, u); ++ui) {
        const bool active = wid < u.nact; const int vis = u.vis0 + (wid >> 1);
        const int qrow = u.qrow0 + wid * 32 + r32;
        bf16x8 qr[12];
        if (active) {
#pragma unroll
            for (int d0 = 0; d0 < 8; ++d0) qr[d0] = *(const bf16x8*)(Qn + (size_t)qrow * 2048 + u.head * 128 + d0 * 16 + hi * 8);
#pragma unroll
            for (int d0 = 0; d0 < 4; ++d0) qr[8 + d0] = *(const bf16x8*)(Qp + (size_t)qrow * 1024 + u.head * 64 + d0 * 16 + hi * 8);
        } else {
#pragma unroll
            for (int d0 = 0; d0 < 12; ++d0) qr[d0] = (bf16x8){0, 0, 0, 0, 0, 0, 0, 0};
        }
#pragma unroll
        for (int d0 = 0; d0 < 12; ++d0) asm volatile("" : "+v"(qr[d0]));
        float mref = 0.f, l_reg = 0.f; f32x16 o[4]; f32x16 negm;
#pragma unroll
        for (int r = 0; r < 16; ++r) negm[r] = 0.f;
        asm volatile("" : "+v"(negm));
#pragma unroll
        for (int d = 0; d < 4; ++d)
#pragma unroll
            for (int r = 0; r < 16; ++r) o[d][r] = 0.f;
        bf16x8 pa0 = (bf16x8){0, 0, 0, 0, 0, 0, 0, 0}, pa1 = pa0, pa2 = pa0, pa3 = pa0;
        const int NT = u.ntiles;
        int vprev = 2, vcur = 0, vnext = 1;
        unsigned kc[3], vc[2];
#pragma unroll
        for (int i = 0; i < 3; ++i) kc[i] = ka[i] + (kisn[i] ? (unsigned)u.kvrow0 * 4096u + (unsigned)u.head * 256u : (unsigned)u.kvrow0 * 128u);
#pragma unroll
        for (int i = 0; i < 2; ++i) vc[i] = va[i] + (unsigned)u.kvrow0 * 4096u + (unsigned)u.head * 256u;
        ATT_ISSUE(0, 0, 0);
        for (int j = 0; j < NT; ++j) {
            const int buf = j & 1;
            if (j + 1 < NT) { ATT_ISSUE(j + 1, buf ^ 1, vnext); asm volatile("s_waitcnt vmcnt(5)" ::: "memory"); }
            else asm volatile("s_waitcnt vmcnt(0)" ::: "memory");
            ATT_BAR();
            if (active) {
                if (grpY && j >= 1 && j - 1 <= vis) ATT_PV(vprev);
                if (j <= vis) {
                    f32x16 p0, p1;
                    int kad[4];
#pragma unroll
                    for (int q = 0; q < 4; ++q) kad[q] = kl0[q] + buf * SHM_K;
                    bf16x8 f0 = kfrag<0>(kad), f1 = kfrag<1>(kad), f2 = kfrag<2>(kad), f3 = kfrag<3>(kad);
#define QK_STEP(I, F, WN) do { asm volatile("s_waitcnt lgkmcnt(" #WN ")" : "+v"(F) :: "memory"); \
        if ((I) == 0) p0 = __builtin_amdgcn_mfma_f32_32x32x16_bf16(F, qr[0], negm, 0, 0, 0); \
        else if ((I) == 1) p1 = __builtin_amdgcn_mfma_f32_32x32x16_bf16(F, qr[0], negm, 0, 0, 0); \
        else if ((I) & 1) p1 = __builtin_amdgcn_mfma_f32_32x32x16_bf16(F, qr[(I) >> 1], p1, 0, 0, 0); \
        else p0 = __builtin_amdgcn_mfma_f32_32x32x16_bf16(F, qr[(I) >> 1], p0, 0, 0, 0); \
        if ((I) + 4 < 24) F = kfrag<((I) + 4 < 24 ? (I) + 4 : 0)>(kad); __builtin_amdgcn_sched_barrier(0); } while (0)
                    QK_STEP(0, f0, 3);  QK_STEP(1, f1, 3);  QK_STEP(2, f2, 3);  QK_STEP(3, f3, 3);
                    QK_STEP(4, f0, 3);  QK_STEP(5, f1, 3);  QK_STEP(6, f2, 3);  QK_STEP(7, f3, 3);
                    QK_STEP(8, f0, 3);  QK_STEP(9, f1, 3);  QK_STEP(10, f2, 3); QK_STEP(11, f3, 3);
                    QK_STEP(12, f0, 3); QK_STEP(13, f1, 3); QK_STEP(14, f2, 3); QK_STEP(15, f3, 3);
                    QK_STEP(16, f0, 3); QK_STEP(17, f1, 3); QK_STEP(18, f2, 3); QK_STEP(19, f3, 3);
                    QK_STEP(20, f0, 3); QK_STEP(21, f1, 2); QK_STEP(22, f2, 1); QK_STEP(23, f3, 0);
#undef QK_STEP
                    float alpha; partialSM(p0, p1, mref, negm, alpha, j == 0);
                    if (__any(alpha < 1.f)) { if (hi == 0) al_l[r32] = alpha; asm volatile("s_waitcnt lgkmcnt(0)" ::: "memory");
#pragma unroll
                        for (int r = 0; r < 16; ++r) { const float al = al_l[crow(r, hi)];
#pragma unroll
                            for (int d = 0; d < 4; ++d) o[d][r] *= al; } }
                    finishSM(p0, p1, alpha, l_reg, pa0, pa1, pa2, pa3);
                    if (!grpY) ATT_PV(vcur);
                }
            }
            asm volatile("s_waitcnt lgkmcnt(0)" ::: "memory");
            ATT_BAR();
            { const int t_ = vprev; vprev = vcur; vcur = vnext; vnext = t_; }
        }
        if (active && grpY && NT - 1 <= vis) ATT_PV(vprev);
        asm volatile("s_waitcnt lgkmcnt(0)" ::: "memory");
        ATT_BAR();
        if (active) {
            if (hi == 0) li_l[r32] = l_reg; asm volatile("s_waitcnt lgkmcnt(0)" ::: "memory");
            bf16_t* Ow = Qn + (size_t)(u.qrow0 + wid * 32) * 2048 + u.head * 128;
#pragma unroll
            for (int r = 0; r < 16; ++r) { const int orow = crow(r, hi); const float rl = __builtin_amdgcn_rcpf(li_l[orow]);
#pragma unroll
                for (int d0 = 0; d0 < 4; ++d0) { const unsigned w = cvt_pk_bf16(o[d0][r] * rl, 0.f); Ow[(size_t)orow * 2048 + d0 * 32 + r32] = (bf16_t)(w & 0xffffu); } }
        }
    }
#undef ATT_BAR
#undef ATT_ISSUE
#undef ATT_PV
#undef PV_STEP
}
}
#ifndef MK_SPLIT
#define MK_SPLIT 0
#endif
constexpr int N_PHASES = 22;

__global__ void __launch_bounds__(512, 2) mega_fwd(Args args) {
    extern __shared__ __attribute__((aligned(16))) unsigned char lds_raw[];
    Ctx C;
    C.lds = (LAS unsigned char*)lds_raw;
    C.tid = threadIdx.x; C.lane = C.tid & 63; C.wave = __builtin_amdgcn_readfirstlane(C.tid >> 6);
    C.G = gridDim.x; { const int bx = blockIdx.x; C.vcu = (C.G % 8 == 0) ? (bx % 8) * (C.G / 8) + bx / 8 : bx; }
    C.gw = C.vcu * 8 + C.wave; C.NGW = C.G * 8;
    C.in = args.in; C.out = args.out; C.ws = args.ws;
    volatile LAS unsigned* misc = (volatile LAS unsigned*)(C.lds + LDS_MISC);
    if (C.tid < 4) misc[C.tid] = 0u;
    __syncthreads();
    const int lo = args.ph_lo, hi = args.ph_hi;
    XcdBarrier bar; bar.bar = (unsigned*)(C.ws + WS_CTL) + CW_BAR; bar.x = 0; bar.st = misc;
    if (hi - lo > 1) bar = xcd_barrier_post((unsigned*)(C.ws + WS_CTL) + CW_BAR, misc);
#ifdef PH_ONLY
#define IN(k) ((k) == PH_ONLY)
#else
#define IN(k) (lo <= (k) && (k) < hi)
#endif
#define SEAM(k) do { if (IN(k) && IN((k) + 1)) xcd_barrier(bar); } while (0)
    unsigned char* ws = C.ws;
    const float* mod = (const float*)(ws + WS_MOD);
    float* X = C.out + O_Y;
    LAS unsigned char* glds = C.lds;

    if (IN(0)) { phase_prologue(C); } SEAM(0);
    if (IN(1)) { phase_norm(C, C.in[0], C.in[1], C.in[11], mod, 0, (bf16_t*)(ws + A_HN)); } SEAM(1);
    if (IN(2)) {
        pg8::Gemm g{(const bf16_t*)(ws + A_HN), (const bf16_t*)(ws + WS_WIN), MT, 3072, 2048, 2048, 2048, 0, 0}; pg8::StaticOrder S; S.init(MT, 3072, C.G, (int)blockIdx.x);
        pg8::EpiZ E{(bf16_t*)(ws + A_GG), (bf16_t*)(ws + A_B2), (bf16_t*)(ws + A_B2) + (size_t)MT * 1024};
        pg8::gemm_phase<pg8::EpiZ>(glds, g, S, E); } SEAM(2);
    if (IN(3)) { phase_convpool(C); } SEAM(3);
    if (IN(4)) {
        { pg8::Gemm g{(const bf16_t*)(ws + A_B3), (const bf16_t*)(ws + WS_WGATE), MT, 2048, 256, 1024, 256, 1, 256}; pg8::StaticOrder S; S.init(MT, 2048, C.G, (int)blockIdx.x);
          pg8::EpiGate E{(const bf16_t*)(ws + A_B3), (const float*)(ws + WS_SP), (float*)(ws + A_B4)};
          pg8::gemm_phase<pg8::EpiGate>(glds, g, S, E); }
 } SEAM(4);
    if (IN(5)) {
        { pg8::Gemm g{(const bf16_t*)(ws + A_B3) + (size_t)MT * 1024, (const bf16_t*)(ws + WS_WPOOL), MT, 1024, 256, 1024, 256, 0, 256}; pg8::StaticOrder S; S.init(MT, 1024, C.G, (int)blockIdx.x);
          pg8::EpiPool E{(bf16_t*)(ws + A_HN), C.in[22]};
          pg8::gemm_phase<pg8::EpiPool>(glds, g, S, E); }
        phase_scanA(C); } SEAM(5);
    if (IN(6)) { phase_scanB(C); } SEAM(6);
    if (IN(7)) { phase_scanC(C); } SEAM(7);
    if (IN(8)) {
        pg8::Gemm g{(const bf16_t*)(ws + A_HN), (const bf16_t*)(ws + WS_WOUTR), MT, 2048, 2048, 2048, 2048, 0, 0}; pg8::StaticOrder S; S.init(MT, 2048, C.G, (int)blockIdx.x);
        pg8::EpiBf16 E{(bf16_t*)(ws + A_B3), 2048};
        pg8::gemm_phase<pg8::EpiBf16>(glds, g, S, E); } SEAM(8);
#define PEER_BLOCK(P0, L) \
    if (IN(P0)) { phase_resid_norm(C, (L) == 0 ? C.in[0] : X, (L) == 0 ? C.in[1] : X + (size_t)MP * DM, (const bf16_t*)(ws + A_B3), X, C.in[12] + (L) * 2048, mod + (size_t)(L) * NSEQ * 12288, (bf16_t*)(ws + A_B2)); } SEAM(P0); \
    if (IN(P0 + 1)) { pg8::Gemm g{(const bf16_t*)(ws + A_B2), (const bf16_t*)(ws + WS_WQ) + (size_t)(L) * 2048 * 2048, MT, 2048, 2048, 2048, 2048, 0, 0}; pg8::StaticOrder S; S.init(MT, 2048, C.G, (int)blockIdx.x); \
        pg8::EpiBf16 E{(bf16_t*)(ws + A_B3), 2048}; pg8::gemm_phase<pg8::EpiBf16>(glds, g, S, E); } SEAM(P0 + 1); \
    if (IN(P0 + 2)) { phase_topk(C, L); } SEAM(P0 + 2); \
    if (IN(P0 + 3)) { phase_gather(C, L); }
    PEER_BLOCK(9, 0) SEAM(12);
    if (IN(13)) {
        pg8::Gemm g{(const bf16_t*)(ws + A_HN), (const bf16_t*)(ws + WS_WDQKV), MT, 1024, 2048, 2048, 2048, 0, 0}; pg8::StaticOrder S; S.init(MT, 1024, C.G, (int)blockIdx.x);
        pg8::EpiF32 E{(float*)(ws + A_B3), 1024};
        pg8::gemm_phase<pg8::EpiF32>(glds, g, S, E); } SEAM(13);
    if (IN(14)) { phase_latent(C); } SEAM(14);
    if (IN(15)) {
        { pg8::Gemm g{(const bf16_t*)(ws + A_CQ), (const bf16_t*)(ws + WS_WUQ), MT, 3072, 512, 512, 512, 0, 0}; pg8::StaticOrder S; S.init(MT, 3072, C.G, (int)blockIdx.x);
          pg8::EpiQ E{(bf16_t*)(ws + A_HN), (bf16_t*)(ws + A_GG), (const float*)(ws + WS_ROPE)};
          pg8::gemm_phase<pg8::EpiQ>(glds, g, S, E); }
        { pg8::Gemm g{(const bf16_t*)(ws + A_CKV), (const bf16_t*)(ws + WS_WUKV), KVROWS, 4096, 256, 256, 256, 0, 0}; pg8::StaticOrder S; S.init(KVROWS, 4096, C.G, (int)blockIdx.x);
          pg8::EpiKV E{(bf16_t*)(ws + A_KN), (bf16_t*)(ws + A_VV)};
          pg8::gemm_phase<pg8::EpiKV>(glds, g, S, E); } } SEAM(15);
    if (IN(16)) { att::attn_phase(C); } SEAM(16);
    if (IN(17)) {
        pg8::Gemm g{(const bf16_t*)(ws + A_HN), (const bf16_t*)(ws + WS_WOUTA), MT, 2048, 2048, 2048, 2048, 0, 0}; pg8::StaticOrder S; S.init(MT, 2048, C.G, (int)blockIdx.x);
        pg8::EpiBf16 E{(bf16_t*)(ws + A_B3), 2048};
        pg8::gemm_phase<pg8::EpiBf16>(glds, g, S, E); } SEAM(17);
    PEER_BLOCK(18, 1)
#undef PEER_BLOCK
#undef IN
#undef SEAM
}

extern "C" void kernel_launch(void* const* d_in, const int* in_sizes, int n_in, void* d_out, int out_size, void* d_ws, size_t ws_size, hipStream_t stream) {
    static int grid = 0;
    if (grid == 0) {
        if (n_in != 36 || out_size != (int)O_TOTAL || ws_size < WS_END) { fprintf(stderr, "kernel_launch: built for 36 inputs, %zu outputs, >= %zu B workspace; got n_in %d out %d ws %zu\n", (size_t)O_TOTAL, (size_t)WS_END, n_in, out_size, ws_size); grid = -1; return; }
        int dev = 0, cus = 0, per_cu = 0;
        if (hipGetDevice(&dev) != hipSuccess || hipDeviceGetAttribute(&cus, hipDeviceAttributeMultiprocessorCount, dev) != hipSuccess) { fprintf(stderr, "kernel_launch: device query failed\n"); grid = -1; return; }
        if (hipFuncSetAttribute((const void*)mega_fwd, hipFuncAttributeMaxDynamicSharedMemorySize, LDS_BYTES) != hipSuccess) { fprintf(stderr, "kernel_launch: hipFuncSetAttribute failed\n"); grid = -1; return; }
        if (hipOccupancyMaxActiveBlocksPerMultiprocessor(&per_cu, (const void*)mega_fwd, 512, LDS_BYTES) != hipSuccess || per_cu < 1) { fprintf(stderr, "kernel_launch: occupancy query says %d blocks per CU\n", per_cu); }
        (void)hipGetLastError();
        grid = cus;
    }
    if (grid < 0) return;
    (void)hipMemsetAsync(d_ws, 0, WS_ZERO_BYTES, stream);
    Args a{};
    for (int i = 0; i < 36; ++i) a.in[i] = (const float*)d_in[i];
    a.out = (float*)d_out; a.ws = (unsigned char*)d_ws;
#if MK_SPLIT
    for (int p = 0; p < N_PHASES; ++p) { a.ph_lo = p; a.ph_hi = p + 1; hipLaunchKernelGGL(mega_fwd, dim3(grid), dim3(512), LDS_BYTES, stream, a); }
#elif defined(PROBE_RANGES)
    { const int rg[][2] = {PROBE_RANGES};
      for (unsigned i = 0; i < sizeof(rg) / sizeof(rg[0]); ++i) { if (i) (void)hipMemsetAsync(d_ws, 0, 1 * MiB, stream); a.ph_lo = rg[i][0]; a.ph_hi = rg[i][1]; hipLaunchKernelGGL(mega_fwd, dim3(grid), dim3(512), LDS_BYTES, stream, a); } }
#else
    a.ph_lo = 0; a.ph_hi = N_PHASES; hipLaunchKernelGGL(mega_fwd, dim3(grid), dim3(512), LDS_BYTES, stream, a);
#endif
    const hipError_t le = hipPeekAtLastError();
    if (le != hipSuccess) fprintf(stderr, "kernel_launch: launch failed: %s\n", hipGetErrorName(le));
}
```

```cpp
#include <hip/hip_runtime.h>
#include <cstdio>
#include <cstdint>

#define LAS __attribute__((address_space(3)))
#define GAS __attribute__((address_space(1)))
typedef unsigned short bf16_t;
typedef short bf16x8 __attribute__((ext_vector_type(8)));
typedef short s16x4 __attribute__((ext_vector_type(4)));
typedef float f32x2 __attribute__((ext_vector_type(2)));
typedef float f32x4 __attribute__((ext_vector_type(4)));
typedef float f32x16 __attribute__((ext_vector_type(16)));
typedef unsigned u32x2 __attribute__((ext_vector_type(2)));
typedef unsigned u32x4 __attribute__((ext_vector_type(4)));

constexpr int DM = 2048;
constexpr int MP = 32768, MS = 2048, MT = MP + MS;
constexpr int NSEQ = 34;
constexpr int KVROWS = MP + 32 * 1088;
constexpr float RMS_EPS = 1e-6f;

__device__ __forceinline__ int seq_of_row(int m) { return m < MP ? (m >> 14) : 2 + ((m - MP) >> 6); }
__device__ __forceinline__ int pos_of_row(int m) { return m < MP ? (m & 16383) : 1024 + ((m - MP) & 63); }
__device__ __forceinline__ int kvrow_of_row(int m) { return m < MP ? m : MP + ((m - MP) >> 6) * 1088 + 1024 + ((m - MP) & 63); }

__device__ __forceinline__ unsigned cvt_pk_bf16(float lo, float hi) { unsigned r; asm volatile("v_cvt_pk_bf16_f32 %0, %1, %2" : "=v"(r) : "v"(lo), "v"(hi)); return r; }
__device__ __forceinline__ float bf_lo(unsigned w) { return __uint_as_float(w << 16); }
__device__ __forceinline__ float bf_hi(unsigned w) { return __uint_as_float(w & 0xffff0000u); }
__device__ __forceinline__ float fexp(float x) { return __builtin_amdgcn_exp2f(x * 1.4426950408889634f); }
__device__ __forceinline__ float fsigmoid(float x) { return __builtin_amdgcn_rcpf(1.0f + __builtin_amdgcn_exp2f(-1.4426950408889634f * x)); }
__device__ __forceinline__ float gelu_tanh(float x) { const float u = x * (1.0f + 0.044715f * x * x); return x * __builtin_amdgcn_rcpf(1.0f + __builtin_amdgcn_exp2f(-2.302208198f * u)); }
__device__ __forceinline__ float gelu_erf(float v) {
    const float av = __builtin_fabsf(v), t = __builtin_amdgcn_rcpf(av * 0.2316418882f + 1.0f);
    float q = t * 0.5307027145f + (-0.7265760135f); q = q * t + 0.7107068705f; q = q * t + (-0.142248368f); q = q * t + 0.127414796f; q = q * t;
    const float e = __builtin_amdgcn_exp2f((v * v) * (-0.72134752044f));
    const float m = v * (q * e); return v < 0.f ? m : v - m;
}
__device__ __forceinline__ float wave_sum(float v) {
#pragma unroll
    for (int o = 32; o >= 1; o >>= 1) v += __shfl_xor(v, o);
    return v;
}

namespace pg8 {
constexpr int BM = 256, BK = 64, HALF = 128, HTB = HALF * BK * 2, STAGE_BYTES = 8 * HTB, NXCD = 8, WGM = 8;
__host__ __device__ __forceinline__ int lds_byte(int r, int c) { const int st = (r >> 4) * 2 + (c >> 5), rr = r & 15, cc = c & 31, ob = rr * 64 + cc * 2; return st * 1024 + (ob ^ (((ob >> 9) & 1) << 5)); }
__host__ __device__ __forceinline__ void stage_rc(int b, int& R, int& C) { const int st = b / 1024, sb = b % 1024, swz = sb ^ (((sb >> 9) & 1) << 5); R = (st >> 1) * 16 + swz / 64; C = (st & 1) * 32 + (swz % 64) / 2; }
__host__ __device__ __forceinline__ int perm32(int rho) { const int n = rho >> 4, i = rho & 15; return 8 * (i >> 2) + 4 * n + (i & 3); }

struct Unit { int pm, pn; };
struct Gemm { const bf16_t* A; const bf16_t* Bt; int M, N, K, lda, ldb, kshift, kmul; };

struct StaticOrder {
    int nM, nN, nwg, G, c;
    __host__ __device__ void init(int M, int N, int G_, int c_) { nM = M / BM; nN = N / BM; nwg = nM * nN; G = G_; c = c_; }
    __host__ __device__ bool next(int i, Unit& u) const {
        const long L = (long)i * G + c; if (L >= nwg) return false;
        int wgid = (int)L; { const int q = nwg / NXCD, r = nwg % NXCD, xcd = wgid % NXCD, off = wgid / NXCD; wgid = (xcd < r ? xcd * (q + 1) : r * (q + 1) + (xcd - r) * q) + off; }
        const int nig = WGM * nN, gid = wgid / nig, fm = gid * WGM, gsz = (nM - fm) < WGM ? (nM - fm) : WGM;
        u.pm = fm + ((wgid % nig) % gsz); u.pn = (wgid % nig) / gsz; return true;
    }
};

template <class Epi>
__device__ __forceinline__ void gemm_phase(LAS unsigned char* lds, const Gemm g, const StaticOrder& S, const Epi& E) {
    const int tid = threadIdx.x, wid = __builtin_amdgcn_readfirstlane(tid >> 6), lane = tid & 63, wr = wid >> 2, wc = wid & 3, fr = lane & 15, fq = lane >> 4;
    int Kq = g.K; asm volatile("" : "+s"(Kq));
    const int K = Kq, nt = K / BK;
    unsigned voffA[2], voffB[2];
#pragma unroll
    for (int i = 0; i < 2; ++i) { int R, C; stage_rc(tid * 16 + i * 8192, R, C); const int Rb = Epi::PERM ? ((R & ~31) + perm32(R & 31)) : R;
        voffA[i] = (unsigned)(R * g.lda + C) * 2u; voffB[i] = (unsigned)(Rb * g.ldb + C) * 2u; }
    const size_t kstep = (size_t)(BK * 2);
    const size_t hstepA = (size_t)HALF * g.lda * 2, hstepB = (size_t)HALF * g.ldb * 2;
    const unsigned ldsw = (unsigned)wid * 1024u;
    const int aoff = lds_byte(wr * 64 + fr, fq * 8), boff = lds_byte(wc * 32 + fr, fq * 8);
#define PG8_SA(b, h) (((b) * 2 + (h)) * HTB)
#define PG8_SB(b, h) ((4 + (b) * 2 + (h)) * HTB)
#define PG8_STAGE(bufoff, gbase, voff) do { _Pragma("unroll") for (int _i = 0; _i < 2; ++_i) \
        __builtin_amdgcn_global_load_lds((const unsigned*)((const char*)(gbase) + (voff)[_i]), (LAS unsigned*)(lds + (bufoff) + ldsw + _i * 8192), 16, 0, 0); } while (0)
#define PG8_LDA(dst, b, h) do { _Pragma("unroll") for (int m = 0; m < 4; ++m) _Pragma("unroll") for (int k = 0; k < 2; ++k) dst[m][k] = *(const LAS bf16x8*)(lds + PG8_SA(b, h) + aoff + m * 2048 + k * 1024); } while (0)
#define PG8_LDB(dst, b, h) do { _Pragma("unroll") for (int n = 0; n < 2; ++n) _Pragma("unroll") for (int k = 0; k < 2; ++k) dst[n][k] = *(const LAS bf16x8*)(lds + PG8_SB(b, h) + boff + n * 2048 + k * 1024); } while (0)
#define PG8_MMA(ai, bj, At, Bt) do { __builtin_amdgcn_s_setprio(1); _Pragma("unroll") for (int m = 0; m < 4; ++m) _Pragma("unroll") for (int n = 0; n < 2; ++n) _Pragma("unroll") for (int k = 0; k < 2; ++k) \
        acc[ai][bj][m][n] = __builtin_amdgcn_mfma_f32_16x16x32_bf16(Bt[n][k], At[m][k], acc[ai][bj][m][n], 0, 0, 0); __builtin_amdgcn_s_setprio(0); } while (0)
#define PG8_WAIT_V(n) asm volatile("s_waitcnt vmcnt(" #n ")" ::: "memory")
#define PG8_WAIT_L(n) asm volatile("s_waitcnt lgkmcnt(" #n ")" ::: "memory")
#define PG8_BAR __builtin_amdgcn_s_barrier()
#define PG8_SCHED __builtin_amdgcn_sched_barrier(0)
#define PG8_ABASE(u) ((const char*)g.A + (size_t)(u).pm * (2 * hstepA) + (size_t)(((u).pn >> g.kshift) * g.kmul) * 2)
#define PG8_BBASE(u) ((const char*)g.Bt + (size_t)(u).pn * (2 * hstepB))
    Unit cur, nxt; int ui = 0;
    if (!S.next(0, cur)) return;
    f32x4 acc[2][2][4][2];
#pragma unroll
    for (int a = 0; a < 2; ++a)
#pragma unroll
        for (int b = 0; b < 2; ++b)
#pragma unroll
            for (int m = 0; m < 4; ++m)
#pragma unroll
                for (int n = 0; n < 2; ++n) acc[a][b][m][n] = (f32x4){0.f, 0.f, 0.f, 0.f};
    bf16x8 At[4][2], B0[2][2], B1[2][2];
    const char* cA = PG8_ABASE(cur); const char* cB = PG8_BBASE(cur);
    PG8_STAGE(PG8_SB(0, 0), cB, voffB); PG8_STAGE(PG8_SB(0, 1), cB + hstepB, voffB); PG8_STAGE(PG8_SA(0, 0), cA, voffA); PG8_STAGE(PG8_SA(0, 1), cA + hstepA, voffA);
    if (wr == 1) PG8_BAR;
    PG8_WAIT_V(2); PG8_BAR;
    PG8_STAGE(PG8_SB(1, 0), cB + kstep, voffB); PG8_STAGE(PG8_SA(1, 0), cA + kstep, voffA); PG8_STAGE(PG8_SB(1, 1), cB + hstepB + kstep, voffB);
    PG8_WAIT_V(6); PG8_BAR;
    for (;;) {
        const bool has_next = S.next(ui + 1, nxt);
        const char* nA = has_next ? PG8_ABASE(nxt) : cA; const char* nB = has_next ? PG8_BBASE(nxt) : cB;
        for (int t = 0; t < nt; t += 2) {
            const bool last = (t == nt - 2);
            const char* a1 = cA + (size_t)(t + 1) * kstep;
            const char* a2 = last ? nA : cA + (size_t)(t + 2) * kstep; const char* b2 = last ? nB : cB + (size_t)(t + 2) * kstep;
            const char* a3 = a2 + kstep; const char* b3 = b2 + kstep;
            PG8_LDB(B0, 0, 0); PG8_LDB(B1, 0, 1); PG8_SCHED; PG8_LDA(At, 0, 0); PG8_STAGE(PG8_SA(1, 1), a1 + hstepA, voffA);
            PG8_WAIT_V(8); PG8_WAIT_L(0); PG8_BAR; PG8_MMA(0, 0, At, B0); PG8_MMA(0, 1, At, B1); PG8_BAR; PG8_SCHED;
            PG8_LDA(At, 0, 1); PG8_STAGE(PG8_SB(0, 0), b2, voffB); PG8_STAGE(PG8_SB(0, 1), b2 + hstepB, voffB); PG8_STAGE(PG8_SA(0, 0), a2, voffA);
            PG8_WAIT_V(8); PG8_WAIT_L(0); PG8_BAR; PG8_MMA(1, 0, At, B0); PG8_MMA(1, 1, At, B1); PG8_BAR; PG8_SCHED;
            PG8_LDB(B0, 1, 0); PG8_LDB(B1, 1, 1); PG8_SCHED; PG8_LDA(At, 1, 0); PG8_STAGE(PG8_SA(0, 1), a2 + hstepA, voffA);
            PG8_WAIT_V(8); PG8_WAIT_L(0); PG8_BAR; PG8_MMA(0, 0, At, B0); PG8_MMA(0, 1, At, B1); PG8_BAR; PG8_SCHED;
            PG8_LDA(At, 1, 1); PG8_STAGE(PG8_SB(1, 0), b3, voffB); PG8_STAGE(PG8_SB(1, 1), b3 + hstepB, voffB); PG8_STAGE(PG8_SA(1, 0), a3, voffA);
            PG8_WAIT_V(8); PG8_WAIT_L(0); PG8_BAR; PG8_MMA(1, 0, At, B0); PG8_MMA(1, 1, At, B1); PG8_BAR; PG8_SCHED;
        }
        if (wr == 0) PG8_BAR;
        E(acc, cur, wr, wc, fr, fq);
        if (!has_next) break;
#pragma unroll
        for (int a = 0; a < 2; ++a)
#pragma unroll
            for (int b = 0; b < 2; ++b)
#pragma unroll
                for (int m = 0; m < 4; ++m)
#pragma unroll
                    for (int n = 0; n < 2; ++n) acc[a][b][m][n] = (f32x4){0.f, 0.f, 0.f, 0.f};
        cur = nxt; cA = nA; cB = nB; ++ui;
        if (wr == 1) PG8_BAR;
    }
    PG8_WAIT_V(0);
    PG8_BAR;
#undef PG8_SA
#undef PG8_SB
#undef PG8_STAGE
#undef PG8_LDA
#undef PG8_LDB
#undef PG8_MMA
#undef PG8_WAIT_V
#undef PG8_WAIT_L
#undef PG8_BAR
#undef PG8_SCHED
#undef PG8_ABASE
#undef PG8_BBASE
}
}
namespace pg8 {
#define EPI_ROWS(expr_row) for (int ai = 0; ai < 2; ++ai) for (int m = 0; m < 4; ++m)
struct EpiBf16 {
    static constexpr bool PERM = true;
    bf16_t* O; int ldc;
    __device__ __forceinline__ void operator()(const f32x4 (&acc)[2][2][4][2], const Unit& u, int wr, int wc, int fr, int fq) const {
        const int row0 = u.pm * BM + wr * 64 + fr, col0 = u.pn * BM + wc * 32 + 8 * fq;
#pragma unroll
        for (int ai = 0; ai < 2; ++ai)
#pragma unroll
            for (int m = 0; m < 4; ++m) { bf16_t* rowp = O + (size_t)(row0 + ai * HALF + m * 16) * ldc + col0;
#pragma unroll
                for (int bj = 0; bj < 2; ++bj) { const f32x4 v0 = acc[ai][bj][m][0], v1 = acc[ai][bj][m][1];
                    u32x4 w; w.x = cvt_pk_bf16(v0[0], v0[1]); w.y = cvt_pk_bf16(v0[2], v0[3]); w.z = cvt_pk_bf16(v1[0], v1[1]); w.w = cvt_pk_bf16(v1[2], v1[3]);
                    *(u32x4*)(rowp + bj * HALF) = w; } }
    }
};
struct EpiZ {
    static constexpr bool PERM = true;
    bf16_t* GG; bf16_t* REC; bf16_t* POOL;
    __device__ __forceinline__ void operator()(const f32x4 (&acc)[2][2][4][2], const Unit& u, int wr, int wc, int fr, int fq) const {
        const int t = u.pn >> 2; bf16_t* base = GG + (size_t)t * ((size_t)MT * 1024);
        const int row0 = u.pm * BM + wr * 64 + fr, col0 = (u.pn & 3) * BM + wc * 32 + 8 * fq;
#pragma unroll
        for (int ai = 0; ai < 2; ++ai)
#pragma unroll
            for (int m = 0; m < 4; ++m) { bf16_t* rowp = base + (size_t)(row0 + ai * HALF + m * 16) * 1024 + col0;
#pragma unroll
                for (int bj = 0; bj < 2; ++bj) { f32x4 v0 = acc[ai][bj][m][0], v1 = acc[ai][bj][m][1];
                    if (t == 0) {
#pragma unroll
                        for (int j = 0; j < 4; ++j) { v0[j] = gelu_tanh(v0[j]); v1[j] = gelu_tanh(v1[j]); } }
                    u32x4 w; w.x = cvt_pk_bf16(v0[0], v0[1]); w.y = cvt_pk_bf16(v0[2], v0[3]); w.z = cvt_pk_bf16(v1[0], v1[1]); w.w = cvt_pk_bf16(v1[2], v1[3]);
                    *(u32x4*)(rowp + bj * HALF) = w; } }
    }
};
struct EpiGate {
    static constexpr bool PERM = false;
    const bf16_t* XC; const float* gp; float* Aout;
    __device__ __forceinline__ void operator()(const f32x4 (&acc)[2][2][4][2], const Unit& u, int wr, int wc, int fr, int fq) const {
        const int row0 = u.pm * BM + wr * 64 + fr, ch0 = u.pn * 128 + wc * 32 + 4 * fq;
#pragma unroll
        for (int n = 0; n < 2; ++n) {
            const f32x4 bav = *(const f32x4*)(gp + ch0 + 16 * n), bxv = *(const f32x4*)(gp + 1024 + ch0 + 16 * n), spv = *(const f32x4*)(gp + 2048 + ch0 + 16 * n);
#pragma unroll
            for (int ai = 0; ai < 2; ++ai)
#pragma unroll
                for (int m = 0; m < 4; ++m) { const int row = row0 + ai * HALF + m * 16; const bool pos0 = (row < MP) && ((row & 16383) == 0);
                    const size_t off = (size_t)row * 1024 + ch0 + 16 * n;
                    const u32x2 xw = *(const u32x2*)(XC + off); const float xc[4] = {bf_lo(xw.x), bf_hi(xw.x), bf_lo(xw.y), bf_hi(xw.y)};
                    f32x4 av, uv;
#pragma unroll
                    for (int j = 0; j < 4; ++j) { const float r = fsigmoid(acc[ai][0][m][n][j] + bav[j]), ig = fsigmoid(acc[ai][1][m][n][j] + bxv[j]);
                        const float log_a = -8.0f * r * spv[j]; const float a = fexp(log_a); const float mult = pos0 ? 1.0f : __builtin_sqrtf(fmaxf(1.0f - a * a, 0.0f));
                        av[j] = a; uv[j] = mult * ig * xc[j]; }
                    *(f32x4*)(Aout + off) = av; { u32x2 uw; uw.x = cvt_pk_bf16(uv[0], uv[1]); uw.y = cvt_pk_bf16(uv[2], uv[3]); *(u32x2*)((bf16_t*)(Aout + (size_t)MT * 1024) + off) = uw; } asm volatile("" ::: "memory"); }
        }
    }
};
struct EpiPool {
    static constexpr bool PERM = true;
    bf16_t* CAT; const float* spool;
    __device__ __forceinline__ void operator()(const f32x4 (&acc)[2][2][4][2], const Unit& u, int wr, int wc, int fr, int fq) const {
        const int row0 = u.pm * BM + wr * 64 + fr, col0 = u.pn * BM + wc * 32 + 8 * fq;
        f32x4 s0[2], s1[2];
#pragma unroll
        for (int bj = 0; bj < 2; ++bj) { s0[bj] = *(const f32x4*)(spool + col0 + bj * HALF); s1[bj] = *(const f32x4*)(spool + col0 + bj * HALF + 4); }
#pragma unroll
        for (int ai = 0; ai < 2; ++ai)
#pragma unroll
            for (int m = 0; m < 4; ++m) { bf16_t* rowp = CAT + (size_t)(row0 + ai * HALF + m * 16) * 2048 + 1024 + col0;
#pragma unroll
                for (int bj = 0; bj < 2; ++bj) { const f32x4 v0 = acc[ai][bj][m][0] * s0[bj], v1 = acc[ai][bj][m][1] * s1[bj];
                    u32x4 w; w.x = cvt_pk_bf16(v0[0], v0[1]); w.y = cvt_pk_bf16(v0[2], v0[3]); w.z = cvt_pk_bf16(v1[0], v1[1]); w.w = cvt_pk_bf16(v1[2], v1[3]);
                    *(u32x4*)(rowp + bj * HALF) = w; } }
    }
};
struct EpiResid {
    static constexpr bool PERM = false;
    const float* xinP; const float* xinS; float* xout; const float* gate;
    __device__ __forceinline__ void operator()(const f32x4 (&acc)[2][2][4][2], const Unit& u, int wr, int wc, int fr, int fq) const {
        const int row0 = u.pm * BM + wr * 64 + fr, col0 = u.pn * BM + wc * 32 + 4 * fq;
#pragma unroll
        for (int ai = 0; ai < 2; ++ai)
#pragma unroll
            for (int m = 0; m < 4; ++m) { const int row = row0 + ai * HALF + m * 16; const float* gp = gate + (size_t)seq_of_row(row) * 12288 + col0;
                const float* xi = (row < MP ? xinP + (size_t)row * DM : xinS + (size_t)(row - MP) * DM) + col0; float* xo = xout + (size_t)row * DM + col0;
#pragma unroll
                for (int bj = 0; bj < 2; ++bj)
#pragma unroll
                    for (int n = 0; n < 2; ++n) { const int o = bj * HALF + n * 16; *(f32x4*)(xo + o) = *(const f32x4*)(xi + o) + *(const f32x4*)(gp + o) * acc[ai][bj][m][n]; }
                asm volatile("" ::: "memory"); }
    }
};
struct EpiF32 {
    static constexpr bool PERM = false;
    float* C; int ldc;
    __device__ __forceinline__ void operator()(const f32x4 (&acc)[2][2][4][2], const Unit& u, int wr, int wc, int fr, int fq) const {
        const int row0 = u.pm * BM + wr * 64 + fr, col0 = u.pn * BM + wc * 32 + 4 * fq;
#pragma unroll
        for (int ai = 0; ai < 2; ++ai)
#pragma unroll
            for (int m = 0; m < 4; ++m) { float* rowp = C + (size_t)(row0 + ai * HALF + m * 16) * ldc + col0;
#pragma unroll
                for (int bj = 0; bj < 2; ++bj)
#pragma unroll
                    for (int n = 0; n < 2; ++n) *(f32x4*)(rowp + bj * HALF + n * 16) = acc[ai][bj][m][n]; }
    }
};
struct EpiQ {
    static constexpr bool PERM = true;
    static constexpr float QS = 0.07216878364870322f * 1.4426950408889634f;
    bf16_t* Qn; bf16_t* Qp; const float* rope;
    __device__ __forceinline__ void operator()(const f32x4 (&acc)[2][2][4][2], const Unit& u, int wr, int wc, int fr, int fq) const {
        const int row0 = u.pm * BM + wr * 64 + fr;
        if (u.pn < 8) {
            const int col0 = u.pn * BM + wc * 32 + 8 * fq;
#pragma unroll
            for (int ai = 0; ai < 2; ++ai)
#pragma unroll
                for (int m = 0; m < 4; ++m) { bf16_t* rowp = Qn + (size_t)(row0 + ai * HALF + m * 16) * 2048 + col0;
#pragma unroll
                    for (int bj = 0; bj < 2; ++bj) { const f32x4 v0 = acc[ai][bj][m][0] * QS, v1 = acc[ai][bj][m][1] * QS;
                        u32x4 w; w.x = cvt_pk_bf16(v0[0], v0[1]); w.y = cvt_pk_bf16(v0[2], v0[3]); w.z = cvt_pk_bf16(v1[0], v1[1]); w.w = cvt_pk_bf16(v1[2], v1[3]);
                        *(u32x4*)(rowp + bj * HALF) = w; } }
        } else {
            const int head = (u.pn - 8) * 4 + wc, j0 = 8 * fq;
#pragma unroll
            for (int ai = 0; ai < 2; ++ai)
#pragma unroll
                for (int m = 0; m < 4; ++m) { const int row = row0 + ai * HALF + m * 16; const float* rp = rope + (size_t)pos_of_row(row) * 64 + j0;
                    const f32x4 c0 = *(const f32x4*)(rp), c1 = *(const f32x4*)(rp + 4), s0 = *(const f32x4*)(rp + 32), s1 = *(const f32x4*)(rp + 36);
                    const f32x4 x10 = acc[ai][0][m][0] * QS, x11 = acc[ai][0][m][1] * QS, x20 = acc[ai][1][m][0] * QS, x21 = acc[ai][1][m][1] * QS;
                    const f32x4 a0 = x10 * c0 - x20 * s0, a1 = x11 * c1 - x21 * s1, b0 = x10 * s0 + x20 * c0, b1 = x11 * s1 + x21 * c1;
                    bf16_t* qp = Qp + (size_t)row * 1024 + head * 64 + j0;
                    u32x4 w; w.x = cvt_pk_bf16(a0[0], a0[1]); w.y = cvt_pk_bf16(a0[2], a0[3]); w.z = cvt_pk_bf16(a1[0], a1[1]); w.w = cvt_pk_bf16(a1[2], a1[3]); *(u32x4*)qp = w;
                    w.x = cvt_pk_bf16(b0[0], b0[1]); w.y = cvt_pk_bf16(b0[2], b0[3]); w.z = cvt_pk_bf16(b1[0], b1[1]); w.w = cvt_pk_bf16(b1[2], b1[3]); *(u32x4*)(qp + 32) = w; }
        }
    }
};
struct EpiKV {
    static constexpr bool PERM = true;
    bf16_t* Kn; bf16_t* V;
    __device__ __forceinline__ void operator()(const f32x4 (&acc)[2][2][4][2], const Unit& u, int wr, int wc, int fr, int fq) const {
        const int row0 = u.pm * BM + wr * 64 + fr, col0 = u.pn * 128 + wc * 32 + 8 * fq;
#pragma unroll
        for (int ai = 0; ai < 2; ++ai)
#pragma unroll
            for (int m = 0; m < 4; ++m) { const size_t off = (size_t)(row0 + ai * HALF + m * 16) * 2048 + col0;
#pragma unroll
                for (int bj = 0; bj < 2; ++bj) { const f32x4 v0 = acc[ai][bj][m][0], v1 = acc[ai][bj][m][1];
                    u32x4 w; w.x = cvt_pk_bf16(v0[0], v0[1]); w.y = cvt_pk_bf16(v0[2], v0[3]); w.z = cvt_pk_bf16(v1[0], v1[1]); w.w = cvt_pk_bf16(v1[2], v1[3]);
                    *(u32x4*)((bj ? V : Kn) + off) = w; } }
    }
};
#undef EPI_ROWS
}

#define XB_TMO      128
#define XB_XCNT(j)  (256  + 64 * (j))
#define XB_XSUB(j)  (1280 + 64 * (j))
#define XB_XGEN(j)  (2304 + 64 * (j))
#define XB_TOP      3328
#define XB_TOPGEN   3392
#define XCD_BAR_WORDS 3456
#define XB_SPIN_CAP (1u << 18)
__device__ __forceinline__ unsigned xb_ld(unsigned* p)              { return __hip_atomic_load(p, __ATOMIC_RELAXED, __HIP_MEMORY_SCOPE_AGENT); }
__device__ __forceinline__ unsigned xb_add(unsigned* p, unsigned v) { return __hip_atomic_fetch_add(p, v, __ATOMIC_RELAXED, __HIP_MEMORY_SCOPE_AGENT); }
__device__ __forceinline__ unsigned xb_xcc_id() { return (unsigned)__builtin_amdgcn_s_getreg((3 << 11) | 20) & 0xFu; }
#define XB_SPIN(cond, bar) do { unsigned _sp = 0; while (cond) { __builtin_amdgcn_s_sleep(1); \
    if ((++_sp & 255u) == 0u) { if (xb_ld(&(bar)[XB_TMO])) break; if (_sp > XB_SPIN_CAP) { atomicAdd(&(bar)[XB_TMO], 1u); break; } } } } while (0)
struct XcdBarrier { unsigned* bar; unsigned x; volatile LAS unsigned* st; };
__device__ __forceinline__ XcdBarrier xcd_barrier_post(unsigned* bar, volatile LAS unsigned* st) {
    XcdBarrier b; b.bar = bar; b.x = xb_xcc_id(); b.st = st;
    if (threadIdx.x == 0) (void)xb_add(&bar[XB_XCNT(b.x)], 1u);
    return b;
}
__device__ __forceinline__ void xcd_barrier_complete(unsigned* bar, unsigned x, unsigned& nloc, unsigned& nx) {
    const unsigned G = gridDim.x * gridDim.y * gridDim.z;
    unsigned sum, cnt, mine, sp = 0u;
    for (;;) {
        sum = 0u; cnt = 0u; mine = 0u;
#pragma unroll
        for (unsigned j = 0; j < 16; ++j) { const unsigned c = xb_ld(&bar[XB_XCNT(j)]); sum += c; cnt += (c > 0u) ? 1u : 0u; mine = (j == x) ? c : mine; }
        if (sum == G) break;
        __builtin_amdgcn_s_sleep(1);
        if ((++sp & 255u) == 0u) { if (xb_ld(&bar[XB_TMO])) break; if (sp > XB_SPIN_CAP) { atomicAdd(&bar[XB_TMO], 1u); break; } }
    }
    nloc = mine > 0u ? mine : 1u; nx = cnt > 0u ? cnt : 1u;
}
__device__ __forceinline__ void xcd_barrier(const XcdBarrier& b) {
    asm volatile("s_waitcnt vmcnt(0)" ::: "memory");
    __syncthreads();
    if (threadIdx.x == 0) {
        unsigned* bar = b.bar;
        __builtin_amdgcn_s_waitcnt(0);
        unsigned nloc = b.st[0], nx = b.st[1];
        if (nloc == 0u) { xcd_barrier_complete(bar, b.x, nloc, nx); b.st[0] = nloc; b.st[1] = nx; }
        const unsigned old = xb_add(&bar[XB_XSUB(b.x)], 1u);
        const unsigned gen = old / nloc;
        if (old + 1u == (gen + 1u) * nloc) {
            __builtin_amdgcn_fence(__ATOMIC_RELEASE, "agent");
            asm volatile("s_waitcnt vmcnt(0)" ::: "memory");
            const unsigned og = xb_add(&bar[XB_TOP], 1u);
            const unsigned tg = og / nx;
            if (og + 1u == (tg + 1u) * nx) xb_add(&bar[XB_TOPGEN], 1u);
            else XB_SPIN(xb_ld(&bar[XB_TOPGEN]) == tg, bar);
            __builtin_amdgcn_fence(__ATOMIC_ACQUIRE, "agent");
            xb_add(&bar[XB_XGEN(b.x)], 1u);
            asm volatile("s_waitcnt vmcnt(0)" ::: "memory");
        } else {
            XB_SPIN(xb_ld(&bar[XB_XGEN(b.x)]) == gen, bar);
            __builtin_amdgcn_fence(__ATOMIC_ACQUIRE, "agent");
            asm volatile("s_waitcnt vmcnt(0)" ::: "memory");
        }
    }
    __syncthreads();
}
constexpr float U8_SCALE = 256.0f, V8_SCALE = 16.0f;
__device__ __forceinline__ void convert_fp8_range(const float* src, unsigned char* dst, float scale, size_t n16, size_t i0, size_t stride) {
    for (size_t i = i0; i < n16; i += stride) { u32x4 w;
#pragma unroll
        for (int q = 0; q < 4; ++q) { f32x4 a = *(const f32x4*)(src + i * 16 + 4 * q) * scale;
#pragma unroll
            for (int j = 0; j < 4; ++j) a[j] = fminf(fmaxf(a[j], -448.0f), 448.0f);
            int t = 0; t = __builtin_amdgcn_cvt_pk_fp8_f32(a[0], a[1], t, false); t = __builtin_amdgcn_cvt_pk_fp8_f32(a[2], a[3], t, true); w[q] = (unsigned)t; }
        *(u32x4*)(dst + i * 16) = w; }
}
constexpr float U4_SCALE = 90.50966799f, V4_SCALE = 8.0f;
__device__ __forceinline__ void convert_fp4_rows(const float* src, unsigned char* dst, float scale, int nrows, int w0, int wstride, int lane) {
    for (int r = w0; r < nrows; r += wstride) { const float* sr = src + (size_t)r * 2048 + 4 * lane; u32x4 w;
        f32x4 a[8];
#pragma unroll
        for (int b = 0; b < 8; ++b) a[b] = *(const f32x4*)(sr + 256 * b) * scale;
#pragma unroll
        for (int q = 0; q < 4; ++q) { float e[8] = {a[2 * q][0], a[2 * q][1], a[2 * q][2], a[2 * q][3], a[2 * q + 1][0], a[2 * q + 1][1], a[2 * q + 1][2], a[2 * q + 1][3]};
#pragma unroll
            for (int j = 0; j < 8; ++j) e[j] = fminf(fmaxf(e[j], -6.0f), 6.0f);
            unsigned t = 0u; t = __builtin_amdgcn_cvt_scalef32_pk_fp4_f32(t, e[0], e[1], 1.0f, 0); t = __builtin_amdgcn_cvt_scalef32_pk_fp4_f32(t, e[2], e[3], 1.0f, 1);
            t = __builtin_amdgcn_cvt_scalef32_pk_fp4_f32(t, e[4], e[5], 1.0f, 2); t = __builtin_amdgcn_cvt_scalef32_pk_fp4_f32(t, e[6], e[7], 1.0f, 3); w[q] = t; }
        *(u32x4*)(dst + (size_t)r * 1024 + 16 * lane) = w; }
}
constexpr size_t MiB = (size_t)1 << 20;
constexpr size_t WS_CTL = 0, WS_WGATE = 1 * MiB, WS_WDQKV = 2 * MiB, WS_ZERO_BYTES = 6 * MiB;
constexpr size_t WS_WIN = 6 * MiB, WS_WOUTR = 18 * MiB, WS_WQ = 26 * MiB, WS_WUQ = 42 * MiB, WS_WUKV = 45 * MiB, WS_WOUTA = 47 * MiB;
constexpr size_t WS_WPOOL = 55 * MiB, WS_KEYS = 56 * MiB, WS_MOD = 57 * MiB, WS_ROPE = 61 * MiB, WS_SP = 65 * MiB, WS_SCAN = 66 * MiB;
constexpr size_t WS_U = 73 * MiB, WS_V = 137 * MiB;
constexpr size_t A_HN = 201 * MiB, A_GG = 337 * MiB, A_B2 = 405 * MiB, A_B3 = 541 * MiB, A_B4 = 677 * MiB;
constexpr size_t A_KN = 405 * MiB, A_VV = 669 * MiB, A_KP = 933 * MiB, A_CQ = 942 * MiB, A_CKV = 976 * MiB, WS_END = 1009 * MiB;
constexpr int CW_BAR = 4096;
constexpr size_t SCAN_WORDS = (size_t)544 * 1024;
constexpr size_t O_Y = 0, O_CONV_P = 71303168, O_CONV_S = 71309312, O_H_P = 71407616, O_H_S = 71409664, O_POOL_P = 71442432, O_POOL_S = 71473152,
                 O_CKV = 71964672, O_KPE = 80877568, O_TOTAL = 83105792;
constexpr int LDS_BYTES = 147456, LDS_MISC = 147200;

struct Args { const float* in[36]; float* out; unsigned char* ws; int ph_lo, ph_hi; };

struct Ctx {
    LAS unsigned char* lds; int tid, lane, wave, vcu, G, gw, NGW;
    const float* const* in; float* out; unsigned char* ws;
};

__device__ __forceinline__ void transpose_item(const float* W, int N, int k0, int n0, bf16_t* WT, int dld, int drow0, int dcol0, LAS float* scr, int lane) {
#pragma unroll 8
    for (int i = 0; i < 32; ++i) { const int kk = 2 * i + (lane >> 5); scr[kk * 33 + (lane & 31)] = W[(size_t)(k0 + kk) * N + n0 + (lane & 31)]; }
    asm volatile("s_waitcnt lgkmcnt(0)" ::: "memory");
    const int c = lane & 7;
#pragma unroll
    for (int j = 0; j < 4; ++j) { const int n = (lane >> 3) + 8 * j; const LAS float* s = scr + (8 * c) * 33 + n;
        u32x4 o; o.x = cvt_pk_bf16(s[0 * 33], s[1 * 33]); o.y = cvt_pk_bf16(s[2 * 33], s[3 * 33]); o.z = cvt_pk_bf16(s[4 * 33], s[5 * 33]); o.w = cvt_pk_bf16(s[6 * 33], s[7 * 33]);
        *(u32x4*)(WT + (size_t)(drow0 + n) * dld + dcol0 + 8 * c) = o; }
    asm volatile("s_waitcnt lgkmcnt(0)" ::: "memory");
}
__device__ __forceinline__ void transpose_mat_item(const float* W, int K, int N, bf16_t* WT, int dld, int drow_base, int dcol_base, int item, LAS float* scr, int lane) {
    const int nblk = N / 32, kb = item / nblk, nb = item % nblk;
    transpose_item(W, N, 64 * kb, 32 * nb, WT, dld, drow_base + 32 * nb, dcol_base + 64 * kb, scr, lane);
}
__device__ __forceinline__ void convert_range(const float* src, bf16_t* dst, size_t n8, size_t i0, size_t stride) {
    for (size_t i = i0; i < n8; i += stride) { const f32x4 a = *(const f32x4*)(src + i * 8), b = *(const f32x4*)(src + i * 8 + 4);
        u32x4 w; w.x = cvt_pk_bf16(a[0], a[1]); w.y = cvt_pk_bf16(a[2], a[3]); w.z = cvt_pk_bf16(b[0], b[1]); w.w = cvt_pk_bf16(b[2], b[3]);
        *(u32x4*)(dst + i * 8) = w; }
}

__device__ __forceinline__ void ada_item(const Ctx& C, int item) {
    const int l = item / 96, nb = item % 96, n0 = nb * 128, w = C.wave, lane = C.lane;
    const float* cP = C.in[2]; const float* cS = C.in[3]; const float* W = C.in[9] + (size_t)l * 2048 * 12288 + n0 + 2 * lane; const float* bias = C.in[10] + (size_t)l * 12288 + n0;
    LAS float* scr = (LAS float*)(C.lds + w * 4608);
    LAS float* sum = (LAS float*)(C.lds + 36864);
    f32x2 acc[34];
#pragma unroll
    for (int s = 0; s < 34; ++s) acc[s] = (f32x2){0.f, 0.f};
    for (int sub = 0; sub < 8; ++sub) {
        const int k0 = 256 * w + 32 * sub;
#pragma unroll
        for (int i = 0; i < 17; ++i) { const int idx = lane + 64 * i, s = idx >> 5, kk = idx & 31;
            const float cv = (s < 2) ? cP[s * 2048 + k0 + kk] : cS[(s - 2) * 2048 + k0 + kk];
            scr[kk * 36 + s] = cv * fsigmoid(cv); }
        asm volatile("s_waitcnt lgkmcnt(0)" ::: "memory");
#pragma unroll 1
        for (int kq = 0; kq < 2; ++kq) {
            f32x2 wv[16];
#pragma unroll
            for (int kk = 0; kk < 16; ++kk) wv[kk] = *(const f32x2*)(W + (size_t)(k0 + 16 * kq + kk) * 12288);
#pragma unroll
            for (int kk = 0; kk < 16; ++kk) {
#pragma unroll
                for (int s4 = 0; s4 < 9; ++s4) { const f32x4 sv = *(const LAS f32x4*)(scr + (16 * kq + kk) * 36 + 4 * s4);
#pragma unroll
                    for (int i = 0; i < 4; ++i) if (4 * s4 + i < 34) acc[4 * s4 + i] += wv[kk] * sv[i]; }
                asm volatile("" ::: "memory");
            }
        }
        asm volatile("s_waitcnt lgkmcnt(0)" ::: "memory");
    }
    for (int ww = 0; ww < 8; ++ww) {
        if (w == ww) {
#pragma unroll
            for (int s = 0; s < 34; ++s) { LAS f32x2* p = (LAS f32x2*)(sum + s * 128) + lane; if (ww == 0) *p = acc[s]; else *p = *p + acc[s]; }
        }
        __syncthreads();
    }
    float* mod = (float*)(C.ws + WS_MOD);
    for (int s = w; s < 34; s += 8) { const f32x2 v = *((LAS f32x2*)(sum + s * 128) + lane) + *(const f32x2*)(bias + 2 * lane);
        *(f32x2*)(mod + ((size_t)l * NSEQ + s) * 12288 + n0 + 2 * lane) = v; }
    __syncthreads();
}

namespace bq {
constexpr int I_IN = 32 * 96, I_GATE = 16 * 8, I_POOL = 4 * 32, I_OUTR = 32 * 64, I_Q = 32 * 64, I_KEYS = 256, I_TAB = 16384  , I_DQ = 32 * 16, I_DKV = 32 * 10,
              I_ROPE = 1024, I_UQ = 8 * 96, I_UKV = 4 * 128, I_OUTA = 32 * 64;
constexpr int E_IN = I_IN, E_GATE = E_IN + I_GATE, E_POOL = E_GATE + I_POOL, E_OUTR = E_POOL + I_OUTR, E_Q0 = E_OUTR + I_Q, E_KEYS = E_Q0 + I_KEYS, E_TAB0 = E_KEYS + I_TAB, E_DQ = E_TAB0 + I_DQ,
              E_DKV = E_DQ + I_DKV, E_ROPE = E_DKV + I_ROPE, E_UQ = E_ROPE + I_UQ, E_UKV = E_UQ + I_UKV, E_OUTA = E_UKV + I_OUTA, E_Q1 = E_OUTA + I_Q, E_TAB1 = E_Q1 + I_TAB, NTOT = E_TAB1;
static_assert(NTOT % 8 == 0 && E_IN % 8 == 0 && E_POOL % 8 == 0 && E_OUTR % 8 == 0 && E_Q0 % 8 == 0 && E_KEYS % 8 == 0 && E_TAB0 % 8 == 0 && E_DKV % 8 == 0 && E_ROPE % 8 == 0 && E_UKV % 8 == 0 && E_OUTA % 8 == 0 && E_Q1 % 8 == 0, "queue segments are whole workgroup items");
constexpr int CW_QHEAD = 64, CW_DONE = 128;
constexpr int LDS_SLOT = LDS_MISC + 32;
constexpr size_t TAB_L1 = 16 * MiB;

__device__ __forceinline__ void fp4_row_pair(const float* src, unsigned char* dst, float scale, int r0, int lane) {
    f32x4 a[16];
#pragma unroll
    for (int b = 0; b < 16; ++b) a[b] = *(const f32x4*)(src + (size_t)(r0 + (b >> 3)) * 2048 + 4 * lane + 256 * (b & 7)) * scale;
#pragma unroll
    for (int rr = 0; rr < 2; ++rr) { u32x4 w;
#pragma unroll
        for (int q = 0; q < 4; ++q) { float e[8] = {a[8 * rr + 2 * q][0], a[8 * rr + 2 * q][1], a[8 * rr + 2 * q][2], a[8 * rr + 2 * q][3], a[8 * rr + 2 * q + 1][0], a[8 * rr + 2 * q + 1][1], a[8 * rr + 2 * q + 1][2], a[8 * rr + 2 * q + 1][3]};
#pragma unroll
            for (int j = 0; j < 8; ++j) e[j] = fminf(fmaxf(e[j], -6.0f), 6.0f);
            unsigned t = 0u; t = __builtin_amdgcn_cvt_scalef32_pk_fp4_f32(t, e[0], e[1], 1.0f, 0); t = __builtin_amdgcn_cvt_scalef32_pk_fp4_f32(t, e[2], e[3], 1.0f, 1);
            t = __builtin_amdgcn_cvt_scalef32_pk_fp4_f32(t, e[4], e[5], 1.0f, 2); t = __builtin_amdgcn_cvt_scalef32_pk_fp4_f32(t, e[6], e[7], 1.0f, 3); w[q] = t; }
        *(u32x4*)(dst + (size_t)(r0 + rr) * 1024 + 16 * lane) = w; }
}
__device__ __forceinline__ void table_item(const Ctx& C, int layer, int r, int lane) {
    const int t = r >> 13, rp = r & 8191;
    const float* src = (t ? C.in[34] : C.in[33]) + (size_t)layer * 16384 * 2048; unsigned char* dst = C.ws + (t ? WS_V : WS_U) + (size_t)layer * TAB_L1;
    fp4_row_pair(src, dst, t ? V4_SCALE : U4_SCALE, 2 * rp, lane);
}
__device__ __forceinline__ void wave_item(const Ctx& C, int it, LAS float* scr, int lane) {
    bf16_t* w_in = (bf16_t*)(C.ws + WS_WIN); bf16_t* w_outr = (bf16_t*)(C.ws + WS_WOUTR); bf16_t* w_q = (bf16_t*)(C.ws + WS_WQ);
    bf16_t* w_dqkv = (bf16_t*)(C.ws + WS_WDQKV); bf16_t* w_uq = (bf16_t*)(C.ws + WS_WUQ); bf16_t* w_ukv = (bf16_t*)(C.ws + WS_WUKV);
    bf16_t* w_outa = (bf16_t*)(C.ws + WS_WOUTA); bf16_t* w_gate = (bf16_t*)(C.ws + WS_WGATE); bf16_t* w_pool = (bf16_t*)(C.ws + WS_WPOOL);
    int r = it;
    if (r < I_IN) { transpose_mat_item(C.in[13], 2048, 3072, w_in, 2048, 0, 0, r, scr, lane); return; } r -= I_IN;
    if (r < I_GATE) {
        const int q = r / 8, sub = r % 8, h = q >> 1, gsel = q & 1;
        const float* src = (gsel ? C.in[18] : C.in[16]) + (size_t)h * 128 * 128;
        transpose_mat_item(src, 128, 128, w_gate, 256, h * 256 + gsel * 128, (h & 1) * 128, sub, scr, lane); return; } r -= I_GATE;
    if (r < I_POOL) { const int gq = r / 32, sub = r % 32;
        transpose_mat_item(C.in[21] + (size_t)gq * 256 * 256, 256, 256, w_pool, 256, gq * 256, 0, sub, scr, lane); return; } r -= I_POOL;
    if (r < I_OUTR) { transpose_mat_item(C.in[23], 2048, 2048, w_outr, 2048, 0, 0, r, scr, lane); return; } r -= I_OUTR;
    if (r < I_Q) { transpose_mat_item(C.in[31], 2048, 2048, w_q, 2048, 0, 0, r, scr, lane); return; } r -= I_Q;
    if (r < I_KEYS) { convert_range(C.in[32] + (size_t)r * 2048, (bf16_t*)(C.ws + WS_KEYS) + (size_t)r * 2048, 256, (size_t)lane, 64); return; } r -= I_KEYS;
    if (r < I_TAB) { table_item(C, 0, r, lane); return; } r -= I_TAB;
    if (r < I_DQ) { transpose_mat_item(C.in[24], 2048, 512, w_dqkv, 2048, 0, 0, r, scr, lane); return; } r -= I_DQ;
    if (r < I_DKV) { transpose_mat_item(C.in[27], 2048, 320, w_dqkv, 2048, 512, 0, r, scr, lane); return; } r -= I_DKV;
    if (r < I_ROPE) {
        float* rope = (float*)(C.ws + WS_ROPE);
        for (int q = 0; q < 8; ++q) { const int i = r * 512 + q * 64 + lane, pos = i >> 5, j = i & 31;
            double inv = 1.0; for (int qq = 0; qq < j; ++qq) inv *= 0.7498942093324559;
            const double rev = (double)pos * inv * 0.15915494309189535; const float fr = (float)(rev - __builtin_floor(rev));
            rope[(size_t)pos * 64 + j] = __builtin_amdgcn_cosf(fr); rope[(size_t)pos * 64 + 32 + j] = __builtin_amdgcn_sinf(fr); }
        return; } r -= I_ROPE;
    if (r < I_UQ) {
        const int kb = r / 96, nb = r % 96, n0 = 32 * nb, h = n0 / 192, d = n0 % 192;
        const int drow = (d < 128) ? h * 128 + d : 2048 + (h >> 2) * 256 + ((d - 128) >> 5) * 128 + (h & 3) * 32;
        transpose_item(C.in[26], 3072, 64 * kb, n0, w_uq, 512, drow, 64 * kb, scr, lane); return; } r -= I_UQ;
    if (r < I_UKV) { transpose_mat_item(C.in[29], 256, 4096, w_ukv, 256, 0, 0, r, scr, lane); return; } r -= I_UKV;
    if (r < I_OUTA) { transpose_mat_item(C.in[30], 2048, 2048, w_outa, 2048, 0, 0, r, scr, lane); return; } r -= I_OUTA;
    if (r < I_Q) { transpose_mat_item(C.in[31] + (size_t)2048 * 2048, 2048, 2048, w_q + (size_t)2048 * 2048, 2048, 0, 0, r, scr, lane); return; } r -= I_Q;
    table_item(C, 1, r, lane);
}
__device__ __forceinline__ void service(const Ctx& C, bool fill, int slot, int limit, bool signal = true) {
    unsigned* ctl = (unsigned*)(C.ws + WS_CTL); unsigned* qhead = ctl + CW_QHEAD; unsigned* done = ctl + CW_DONE + slot;
    volatile LAS int* lslot = (volatile LAS int*)(C.lds + LDS_SLOT);
    LAS float* scr = (LAS float*)(C.lds + 72704 + C.wave * 8448);
    __syncthreads();
    if (fill && signal && C.tid == 0) __hip_atomic_fetch_add(done, 1u, __ATOMIC_RELAXED, __HIP_MEMORY_SCOPE_AGENT);
    const unsigned lim = fill ? (unsigned)(NTOT / 8) : (unsigned)(limit / 8);
    for (;;) {
        if (C.tid == 0) { int it = -1;
            const unsigned h = __hip_atomic_load(qhead, __ATOMIC_RELAXED, __HIP_MEMORY_SCOPE_AGENT);
            bool go = h < lim;
            if (go && fill) go = __hip_atomic_load(done, __ATOMIC_RELAXED, __HIP_MEMORY_SCOPE_AGENT) < (unsigned)C.G;
            if (go) { const unsigned t = __hip_atomic_fetch_add(qhead, 1u, __ATOMIC_RELAXED, __HIP_MEMORY_SCOPE_AGENT); if (t < (unsigned)(NTOT / 8)) it = (int)t; }
            *lslot = it; }
        __syncthreads();
        const int it = *lslot;
        __syncthreads();
        if (it < 0) break;
        { Ctx D = C; int ln = C.lane; asm volatile("" : "+v"(ln)); D.lane = ln;
          wave_item(D, it * 8 + C.wave, scr, ln); }
    }
}
}

__device__ __forceinline__ void phase_prologue(const Ctx& C) {
    const int lane = C.lane;
    constexpr int NADA = 192;
    for (int it = C.vcu; it < NADA; it += C.G) ada_item(C, it);
    bq::service(C, true, 0, 0);
    const size_t gt = (size_t)C.vcu * 512 + C.tid, GT = (size_t)C.G * 512;
    { float* sp = (float*)(C.ws + WS_SP);
      for (size_t i = gt; i < 1024; i += GT) { sp[i] = C.in[17][i]; sp[1024 + i] = C.in[19][i]; const float y = fexp(-C.in[20][i]); sp[2048 + i] = (y < 0.03f) ? y * (1.0f - y * (0.5f - y * (0.33333333f - y * (0.25f - 0.2f * y)))) : 0.6931471805599453f * __builtin_amdgcn_logf(1.0f + y); } }
}
__device__ __forceinline__ void norm_mod_row(const float* xrow, const float* g, const float* shift, const float* scale, bf16_t* orow, int lane) {
    f32x4 v[8]; float ss = 0.f;
#pragma unroll
    for (int j = 0; j < 8; ++j) { v[j] = *((const f32x4*)xrow + lane + 64 * j); ss += (v[j].x * v[j].x + v[j].y * v[j].y) + (v[j].z * v[j].z + v[j].w * v[j].w); }
    const float rstd = __builtin_amdgcn_rsqf(wave_sum(ss) * (1.0f / DM) + RMS_EPS);
#pragma unroll
    for (int j = 0; j < 8; ++j) { const int q = lane + 64 * j; const f32x4 gv = *((const f32x4*)g + q), sc = *((const f32x4*)scale + q), sh = *((const f32x4*)shift + q);
        const f32x4 y = v[j] * rstd * gv * (sc + 1.0f) + sh;
        u32x2 w; w.x = cvt_pk_bf16(y.x, y.y); w.y = cvt_pk_bf16(y.z, y.w); *((u32x2*)orow + q) = w; }
}
__device__ __forceinline__ void phase_norm(const Ctx& C, const float* xP, const float* xS, const float* g, const float* modl, int part, bf16_t* hn) {
    const int lane = C.lane; int m = C.gw; if (m >= MT) return;
    f32x4 gv[8];
#pragma unroll
    for (int j = 0; j < 8; ++j) gv[j] = *((const f32x4*)g + lane + 64 * j);
    f32x4 nv[8];
    { const float* xr = (m < MP) ? xP + (size_t)m * DM : xS + (size_t)(m - MP) * DM;
#pragma unroll
      for (int j = 0; j < 8; ++j) nv[j] = *((const f32x4*)xr + lane + 64 * j); }
    for (; m < MT; m += C.NGW) {
        f32x4 v[8];
#pragma unroll
        for (int j = 0; j < 8; ++j) v[j] = nv[j];
        const int mn = m + C.NGW;
        if (mn < MT) { const float* xr = (mn < MP) ? xP + (size_t)mn * DM : xS + (size_t)(mn - MP) * DM;
#pragma unroll
            for (int j = 0; j < 8; ++j) nv[j] = *((const f32x4*)xr + lane + 64 * j); }
        const float* mp = modl + (size_t)seq_of_row(m) * 12288 + part * 2048;
        f32x4 sc[8], sh[8];
#pragma unroll
        for (int j = 0; j < 8; ++j) { const int q = lane + 64 * j; sh[j] = *((const f32x4*)mp + q); sc[j] = *((const f32x4*)(mp + 2048) + q); }
        float ss = 0.f;
#pragma unroll
        for (int j = 0; j < 8; ++j) ss += (v[j].x * v[j].x + v[j].y * v[j].y) + (v[j].z * v[j].z + v[j].w * v[j].w);
        const float rstd = __builtin_amdgcn_rsqf(wave_sum(ss) * (1.0f / DM) + RMS_EPS);
#pragma unroll
        for (int j = 0; j < 8; ++j) { const int q = lane + 64 * j; const f32x4 y = v[j] * rstd * gv[j] * (sc[j] + 1.0f) + sh[j];
            u32x2 w; w.x = cvt_pk_bf16(y.x, y.y); w.y = cvt_pk_bf16(y.z, y.w); *((u32x2*)(hn + (size_t)m * DM) + q) = w; }
    }
}
__device__ __forceinline__ void phase_resid_norm(const Ctx& C, const float* xP, const float* xS, const bf16_t* mix, float* X, const float* g, const float* modl, bf16_t* hn) {
    const int lane = C.lane; int m = C.gw; if (m >= MT) return;
    f32x4 gv[8];
#pragma unroll
    for (int j = 0; j < 8; ++j) gv[j] = *((const f32x4*)g + lane + 64 * j);
    f32x4 nx[8]; u32x2 nm[8];
    { const float* xr = (m < MP) ? xP + (size_t)m * DM : xS + (size_t)(m - MP) * DM;
#pragma unroll
      for (int j = 0; j < 8; ++j) { const int q = lane + 64 * j; nx[j] = *((const f32x4*)xr + q); nm[j] = *((const u32x2*)(mix + (size_t)m * DM) + q); } }
    for (; m < MT; m += C.NGW) {
        f32x4 v[8]; u32x2 mw[8];
#pragma unroll
        for (int j = 0; j < 8; ++j) { v[j] = nx[j]; mw[j] = nm[j]; }
        const int mn = m + C.NGW;
        if (mn < MT) { const float* xr = (mn < MP) ? xP + (size_t)mn * DM : xS + (size_t)(mn - MP) * DM;
#pragma unroll
            for (int j = 0; j < 8; ++j) { const int q = lane + 64 * j; nx[j] = *((const f32x4*)xr + q); nm[j] = *((const u32x2*)(mix + (size_t)mn * DM) + q); } }
        const float* mp = modl + (size_t)seq_of_row(m) * 12288;
        float ss = 0.f;
#pragma unroll
        for (int j = 0; j < 8; ++j) { const int q = lane + 64 * j; const f32x4 g1 = *((const f32x4*)(mp + 2 * 2048) + q);
            v[j] = v[j] + g1 * (f32x4){bf_lo(mw[j].x), bf_hi(mw[j].x), bf_lo(mw[j].y), bf_hi(mw[j].y)}; ss += (v[j].x * v[j].x + v[j].y * v[j].y) + (v[j].z * v[j].z + v[j].w * v[j].w);
            *((f32x4*)(X + (size_t)m * DM) + q) = v[j]; }
        const float rstd = __builtin_amdgcn_rsqf(wave_sum(ss) * (1.0f / DM) + RMS_EPS);
#pragma unroll
        for (int j = 0; j < 8; ++j) { const int q = lane + 64 * j; const f32x4 sh = *((const f32x4*)(mp + 3 * 2048) + q), sc = *((const f32x4*)(mp + 4 * 2048) + q);
            const f32x4 y = v[j] * rstd * gv[j] * (sc + 1.0f) + sh;
            u32x2 w; w.x = cvt_pk_bf16(y.x, y.y); w.y = cvt_pk_bf16(y.z, y.w); *((u32x2*)(hn + (size_t)m * DM) + q) = w; }
    }
}

__device__ __forceinline__ void ld8bf(const bf16_t* p, float (&v)[8]) { const u32x4 w = *(const u32x4*)p; v[0] = bf_lo(w.x); v[1] = bf_hi(w.x); v[2] = bf_lo(w.y); v[3] = bf_hi(w.y); v[4] = bf_lo(w.z); v[5] = bf_hi(w.z); v[6] = bf_lo(w.w); v[7] = bf_hi(w.w); }
__device__ __forceinline__ void ld8f(const float* p, float (&v)[8]) { const f32x4 a = *(const f32x4*)p, b = *(const f32x4*)(p + 4); v[0] = a.x; v[1] = a.y; v[2] = a.z; v[3] = a.w; v[4] = b.x; v[5] = b.y; v[6] = b.z; v[7] = b.w; }
__device__ __forceinline__ void st8bf(bf16_t* p, const float (&v)[8]) { u32x4 w; w.x = cvt_pk_bf16(v[0], v[1]); w.y = cvt_pk_bf16(v[2], v[3]); w.z = cvt_pk_bf16(v[4], v[5]); w.w = cvt_pk_bf16(v[6], v[7]); *(u32x4*)p = w; }
__device__ __forceinline__ void st8f(float* p, const float (&v)[8]) { *(f32x4*)p = (f32x4){v[0], v[1], v[2], v[3]}; *(f32x4*)(p + 4) = (f32x4){v[4], v[5], v[6], v[7]}; }

__device__ __forceinline__ void phase_convpool(const Ctx& C) {
    const bf16_t* __restrict__ REC = (const bf16_t*)(C.ws + A_B2); const bf16_t* __restrict__ PIN = REC + (size_t)MT * 1024;
    bf16_t* __restrict__ XC = (bf16_t*)(C.ws + A_B3); bf16_t* __restrict__ POOLED = XC + (size_t)MT * 1024;
    const float* convw = C.in[14]; const float* convb = C.in[15]; const float* st_conv = C.in[4]; const float* st_pool = C.in[6];
    const int NITEM = 2 * 544 * 128;
    for (int it0 = C.vcu * 512 + C.tid; it0 < NITEM; it0 += C.G * 512) {
        const bool is_pool = it0 >= 544 * 128; const int it = is_pool ? it0 - 544 * 128 : it0;
        const int chunk = it >> 7, ch0 = (it & 127) * 8;
        const bool samp = chunk >= 512; const int sb = chunk - 512;
        const int row0 = samp ? MP + sb * 64 : chunk * 64;
        const int t0 = samp ? 0 : (chunk & 255) * 64;
        const bool lastc = samp || ((chunk & 255) == 255);
        if (!is_pool) {
            float w0[8], w1[8], w2[8], w3[8], bb[8], p0[8], p1[8], p2[8];
            ld8f(convw + ch0, w0); ld8f(convw + 1024 + ch0, w1); ld8f(convw + 2048 + ch0, w2); ld8f(convw + 3072 + ch0, w3); ld8f(convb + ch0, bb);
            if (samp) { ld8f(st_conv + ((size_t)sb * 3 + 0) * 1024 + ch0, p0); ld8f(st_conv + ((size_t)sb * 3 + 1) * 1024 + ch0, p1); ld8f(st_conv + ((size_t)sb * 3 + 2) * 1024 + ch0, p2); }
            else if (t0 > 0) { ld8bf(REC + (size_t)(row0 - 3) * 1024 + ch0, p0); ld8bf(REC + (size_t)(row0 - 2) * 1024 + ch0, p1); ld8bf(REC + (size_t)(row0 - 1) * 1024 + ch0, p2); }
            else {
#pragma unroll
                for (int j = 0; j < 8; ++j) { p0[j] = 0.f; p1[j] = 0.f; p2[j] = 0.f; } }
            for (int tb = 0; tb < 64; tb += 8) {
                u32x4 raw[8];
#pragma unroll
                for (int q = 0; q < 8; ++q) raw[q] = *(const u32x4*)(REC + (size_t)(row0 + tb + q) * 1024 + ch0);
#pragma unroll
                for (int q = 0; q < 8; ++q) { const u32x4 w = raw[q]; const float cur[8] = {bf_lo(w.x), bf_hi(w.x), bf_lo(w.y), bf_hi(w.y), bf_lo(w.z), bf_hi(w.z), bf_lo(w.w), bf_hi(w.w)}; float o[8];
#pragma unroll
                    for (int j = 0; j < 8; ++j) { o[j] = bb[j] + w0[j] * p0[j] + w1[j] * p1[j] + w2[j] * p2[j] + w3[j] * cur[j]; p0[j] = p1[j]; p1[j] = p2[j]; p2[j] = cur[j]; }
                    st8bf(XC + (size_t)(row0 + tb + q) * 1024 + ch0, o); } }
            if (lastc) { float* dst = samp ? C.out + O_CONV_S + (size_t)sb * 3 * 1024 : C.out + O_CONV_P + (size_t)(chunk >> 8) * 3 * 1024;
                st8f(dst + ch0, p0); st8f(dst + 1024 + ch0, p1); st8f(dst + 2048 + ch0, p2); }
        } else {
            const int gsel = ch0 >> 8, w = 2 << gsel;
            float S[8];
#pragma unroll
            for (int j = 0; j < 8; ++j) S[j] = 0.f;
            for (int tt = 1 - w; tt < 0; ++tt) { float v[8];
                if (samp) ld8f(st_pool + ((size_t)sb * 15 + 15 + tt) * 1024 + ch0, v);
                else if (t0 + tt >= 0) ld8bf(PIN + (size_t)(row0 + tt) * 1024 + ch0, v);
                else {
#pragma unroll
                    for (int j = 0; j < 8; ++j) v[j] = 0.f; }
#pragma unroll
                for (int j = 0; j < 8; ++j) S[j] += v[j]; }
            for (int tb = 0; tb < 64; tb += 8) {
                u32x4 rawc[8]; float oldv[8][8];
#pragma unroll
                for (int q = 0; q < 8; ++q) rawc[q] = *(const u32x4*)(PIN + (size_t)(row0 + tb + q) * 1024 + ch0);
#pragma unroll
                for (int q = 0; q < 8; ++q) { const int tt = tb + q - w + 1;
                    if (tt >= 0 || (!samp && t0 + tt >= 0)) ld8bf(PIN + (size_t)(row0 + tt) * 1024 + ch0, oldv[q]);
                    else if (samp) ld8f(st_pool + ((size_t)sb * 15 + 15 + tt) * 1024 + ch0, oldv[q]);
                    else {
#pragma unroll
                        for (int j = 0; j < 8; ++j) oldv[q][j] = 0.f; } }
#pragma unroll
                for (int q = 0; q < 8; ++q) { const u32x4 wv = rawc[q]; const float cur[8] = {bf_lo(wv.x), bf_hi(wv.x), bf_lo(wv.y), bf_hi(wv.y), bf_lo(wv.z), bf_hi(wv.z), bf_lo(wv.w), bf_hi(wv.w)}; float o[8];
                    const int pos = samp ? 1024 + tb + q : t0 + tb + q; const float rc = 1.0f / (float)((pos + 1 < w) ? pos + 1 : w);
#pragma unroll
                    for (int j = 0; j < 8; ++j) { S[j] += cur[j]; o[j] = S[j] * rc - cur[j]; S[j] -= oldv[q][j]; }
                    st8bf(POOLED + (size_t)(row0 + tb + q) * 1024 + ch0, o); } }
            if (lastc) { float* dst = samp ? C.out + O_POOL_S + (size_t)sb * 15 * 1024 : C.out + O_POOL_P + (size_t)(chunk >> 8) * 15 * 1024;
                for (int i = 0; i < 15; ++i) { float v[8]; ld8bf(PIN + (size_t)(row0 + 49 + i) * 1024 + ch0, v); st8f(dst + (size_t)i * 1024 + ch0, v); } }
        }
    }
}

__device__ __forceinline__ void phase_scanA(const Ctx& C) {
    const float* __restrict__ A = (const float*)(C.ws + A_B4); const bf16_t* __restrict__ U = (const bf16_t*)(A + (size_t)MT * 1024);
    float* __restrict__ cP = (float*)(C.ws + WS_SCAN); float* __restrict__ cH = cP + SCAN_WORDS;
    for (int it = C.vcu * 512 + C.tid; it < 544 * 256; it += C.G * 512) {
        const int chunk = it >> 8, ch = (it & 255) * 4; const int row0 = chunk * 64;
        f32x4 P = {1.f, 1.f, 1.f, 1.f}, H = {0.f, 0.f, 0.f, 0.f};
        for (int tb = 0; tb < 64; tb += 8) { f32x4 av[8], uv[8];
#pragma unroll
            for (int q = 0; q < 8; ++q) { av[q] = *(const f32x4*)(A + (size_t)(row0 + tb + q) * 1024 + ch); const u32x2 uw = *(const u32x2*)(U + (size_t)(row0 + tb + q) * 1024 + ch); uv[q] = (f32x4){bf_lo(uw.x), bf_hi(uw.x), bf_lo(uw.y), bf_hi(uw.y)}; }
#pragma unroll
            for (int q = 0; q < 8; ++q) { H = av[q] * H + uv[q]; P = P * av[q]; } }
        *(f32x4*)(cP + (size_t)chunk * 1024 + ch) = P; *(f32x4*)(cH + (size_t)chunk * 1024 + ch) = H;
    }
}
__device__ __forceinline__ void phase_scanB(const Ctx& C) {
    const float* __restrict__ cP = (const float*)(C.ws + WS_SCAN); const float* __restrict__ cH = cP + SCAN_WORDS; float* __restrict__ cI = (float*)(C.ws + WS_SCAN) + 2 * SCAN_WORDS;
    const int it = C.vcu * 512 + C.tid;
    if (it < 2048) { const int s = it >> 10, ch = it & 1023; float carry = 0.f;
        for (int cb = 0; cb < 256; cb += 16) { float pv[16], hv[16];
#pragma unroll
            for (int q = 0; q < 16; ++q) { const size_t o = (size_t)(s * 256 + cb + q) * 1024 + ch; pv[q] = cP[o]; hv[q] = cH[o]; }
#pragma unroll
            for (int q = 0; q < 16; ++q) { cI[(size_t)(s * 256 + cb + q) * 1024 + ch] = carry; carry = pv[q] * carry + hv[q]; } } }
}
__device__ __forceinline__ void phase_scanC(const Ctx& C) {
    const float* __restrict__ A = (const float*)(C.ws + A_B4); const bf16_t* __restrict__ U = (const bf16_t*)(A + (size_t)MT * 1024); const float* __restrict__ cI = (const float*)(C.ws + WS_SCAN) + 2 * SCAN_WORDS;
    const bf16_t* __restrict__ GG = (const bf16_t*)(C.ws + A_GG); bf16_t* __restrict__ CAT = (bf16_t*)(C.ws + A_HN); const float* hprev = C.in[5];
    for (int it = C.vcu * 512 + C.tid; it < 544 * 256; it += C.G * 512) {
        const int chunk = it >> 8, ch = (it & 255) * 4; const int row0 = chunk * 64; const bool samp = chunk >= 512;
        f32x4 h = samp ? *(const f32x4*)(hprev + (size_t)(chunk - 512) * 1024 + ch) : *(const f32x4*)(cI + (size_t)chunk * 1024 + ch);
        for (int tb = 0; tb < 64; tb += 8) { f32x4 av[8], uv[8]; u32x2 gv[8];
#pragma unroll
            for (int q = 0; q < 8; ++q) { const size_t o = (size_t)(row0 + tb + q) * 1024 + ch; av[q] = *(const f32x4*)(A + o); { const u32x2 uw = *(const u32x2*)(U + o); uv[q] = (f32x4){bf_lo(uw.x), bf_hi(uw.x), bf_lo(uw.y), bf_hi(uw.y)}; } gv[q] = *(const u32x2*)(GG + o); }
#pragma unroll
            for (int q = 0; q < 8; ++q) { h = av[q] * h + uv[q];
                u32x2 w; w.x = cvt_pk_bf16(bf_lo(gv[q].x) * h.x, bf_hi(gv[q].x) * h.y); w.y = cvt_pk_bf16(bf_lo(gv[q].y) * h.z, bf_hi(gv[q].y) * h.w);
                *(u32x2*)(CAT + (size_t)(row0 + tb + q) * 2048 + ch) = w; } }
        if (samp) *(f32x4*)(C.out + O_H_S + (size_t)(chunk - 512) * 1024 + ch) = h;
        else if ((chunk & 255) == 255) *(f32x4*)(C.out + O_H_P + (size_t)(chunk >> 8) * 1024 + ch) = h;
    }
}

__device__ __forceinline__ void phase_latent(const Ctx& C) {
    const float* CQKV = (const float*)(C.ws + A_B3); bf16_t* CQ = (bf16_t*)(C.ws + A_CQ); bf16_t* CKV = (bf16_t*)(C.ws + A_CKV); bf16_t* KP = (bf16_t*)(C.ws + A_KP);
    const float* gq = C.in[25]; const float* gkv = C.in[28]; const float* rope = (const float*)(C.ws + WS_ROPE); const int lane = C.lane;
    for (int m = C.gw; m < MT; m += C.NGW) {
        const float* r = CQKV + (size_t)m * 1024; const int kvr = kvrow_of_row(m);
        { float v[8]; ld8f(r + lane * 8, v); float ss = 0.f;
#pragma unroll
          for (int j = 0; j < 8; ++j) ss += v[j] * v[j];
          const float rstd = __builtin_amdgcn_rsqf(wave_sum(ss) * (1.0f / 512) + RMS_EPS); float g[8]; ld8f(gq + lane * 8, g);
#pragma unroll
          for (int j = 0; j < 8; ++j) v[j] = v[j] * rstd * g[j];
          st8bf(CQ + (size_t)m * 512 + lane * 8, v); }
        { const f32x4 v = *(const f32x4*)(r + 512 + lane * 4); const float ss = (v.x * v.x + v.y * v.y) + (v.z * v.z + v.w * v.w);
          const float rstd = __builtin_amdgcn_rsqf(wave_sum(ss) * (1.0f / 256) + RMS_EPS); const f32x4 y = v * rstd * *(const f32x4*)(gkv + lane * 4);
          *(f32x4*)(C.out + O_CKV + (size_t)m * 256 + lane * 4) = y;
          u32x2 w; w.x = cvt_pk_bf16(y.x, y.y); w.y = cvt_pk_bf16(y.z, y.w); *(u32x2*)(CKV + (size_t)kvr * 256 + lane * 4) = w; }
        { const float x = r[768 + lane]; const float xo = __shfl_xor(x, 32); const int j = lane & 31; const float* rp = rope + (size_t)pos_of_row(m) * 64;
          const float c = rp[j], s = rp[32 + j]; const float y = (lane < 32) ? x * c - xo * s : xo * s + x * c;
          C.out[O_KPE + (size_t)m * 64 + lane] = y; const unsigned yb = cvt_pk_bf16(y, y); KP[(size_t)kvr * 64 + lane] = (bf16_t)(yb & 0xffffu); }
    }
    const size_t gt = (size_t)C.vcu * 512 + C.tid, GT = (size_t)C.G * 512;
    for (size_t i = gt; i < (size_t)32 * 1024 * 256 / 8; i += GT) { const size_t e = i * 8, rowc = e / 256, col = e % 256, b = rowc / 1024, p = rowc % 1024;
        float v[8]; ld8f(C.in[7] + e, v); st8bf(CKV + ((size_t)MP + b * 1088 + p) * 256 + col, v); }
    for (size_t i = gt; i < (size_t)32 * 1024 * 64 / 8; i += GT) { const size_t e = i * 8, rowc = e / 64, col = e % 64, b = rowc / 1024, p = rowc % 1024;
        float v[8]; ld8f(C.in[8] + e, v); st8bf(KP + ((size_t)MP + b * 1088 + p) * 64 + col, v); }
}
typedef __bf16 bf2_t __attribute__((ext_vector_type(2)));
__device__ __forceinline__ unsigned ford(float f) { const unsigned u = __float_as_uint(f); return (u & 0x80000000u) ? ~u : (u | 0x80000000u); }
__device__ __forceinline__ float funord(unsigned o) { return __uint_as_float((o & 0x80000000u) ? (o & 0x7fffffffu) : ~o); }
__device__ __forceinline__ unsigned umax(unsigned a, unsigned b) { return a > b ? a : b; }
__device__ __forceinline__ unsigned umin(unsigned a, unsigned b) { return a < b ? a : b; }
__device__ __forceinline__ void ins16(unsigned (&L)[16], unsigned x) {
#pragma unroll
    for (int i = 0; i < 16; ++i) { const unsigned t = umax(L[i], x); x = umin(L[i], x); L[i] = t; }
}
__device__ __forceinline__ void ins16p(unsigned (&K)[16], unsigned (&P)[16], unsigned key, unsigned pay) {
#pragma unroll
    for (int i = 0; i < 16; ++i) { const bool c = key > K[i]; const unsigned tk = c ? key : K[i], nk = c ? K[i] : key, tp = c ? pay : P[i], np = c ? P[i] : pay; K[i] = tk; P[i] = tp; key = nk; pay = np; }
}
__device__ __forceinline__ void sort16_desc(unsigned (&v)[16]) {
#pragma unroll
    for (int k = 2; k <= 16; k <<= 1)
#pragma unroll
        for (int j = k >> 1; j >= 1; j >>= 1)
#pragma unroll
            for (int i = 0; i < 16; ++i) { const int l = i ^ j; if (l > i) { const bool desc = ((i & k) == 0); const unsigned a = v[i], b = v[l], hi = umax(a, b), lo = umin(a, b); v[i] = desc ? hi : lo; v[l] = desc ? lo : hi; } }
}
__device__ __forceinline__ void merge16_desc(unsigned (&A)[16], const unsigned (&B)[16]) {
#pragma unroll
    for (int i = 0; i < 16; ++i) A[i] = umax(A[i], B[15 - i]);
#pragma unroll
    for (int st = 8; st >= 1; st >>= 1)
#pragma unroll
        for (int i = 0; i < 16; ++i) if ((i & st) == 0) { const unsigned a = A[i], b = A[i + st]; A[i] = umax(a, b); A[i + st] = umin(a, b); }
}
__device__ __forceinline__ void subkey_top16(const bf16_t* qrow  , const bf16_t* krow  , int hh, unsigned (&S)[16]) {
    bf16x8 qf[8];
#pragma unroll
    for (int s = 0; s < 8; ++s) qf[s] = *(const bf16x8*)(qrow + 16 * s);
    unsigned L[16];
#pragma unroll
    for (int i = 0; i < 16; ++i) L[i] = 0u;
#pragma unroll 1
    for (int kb = 0; kb < 4; ++kb) {
        bf16x8 kf[8];
#pragma unroll
        for (int s = 0; s < 8; ++s) kf[s] = *(const bf16x8*)(krow + (size_t)kb * 32 * 128 + 16 * s);
        f32x16 a = {0.f, 0.f, 0.f, 0.f, 0.f, 0.f, 0.f, 0.f, 0.f, 0.f, 0.f, 0.f, 0.f, 0.f, 0.f, 0.f};
#pragma unroll
        for (int s = 0; s < 8; ++s) a = __builtin_amdgcn_mfma_f32_32x32x16_bf16(kf[s], qf[s], a, 0, 0, 0);
        unsigned N[16];
#pragma unroll
        for (int r = 0; r < 16; ++r) { const unsigned idx = (unsigned)(32 * kb + (r & 3) + 8 * (r >> 2) + 4 * hh); N[r] = (ford(a[r]) & ~0x7fu) | idx; }
        sort16_desc(N); merge16_desc(L, N);
        asm volatile("" ::: "memory");
    }
    unsigned P[16];
#pragma unroll
    for (int i = 0; i < 16; ++i) P[i] = (unsigned)__shfl_xor((int)L[i], 32);
#pragma unroll
    for (int i = 0; i < 16; ++i) S[i] = L[i];
    merge16_desc(S, P);
}
__device__ __forceinline__ void phase_topk(const Ctx& C, int layer) {
    const bf16_t* Q = (const bf16_t*)(C.ws + A_B3); const bf16_t* KEYS = (const bf16_t*)(C.ws + WS_KEYS) + (size_t)layer * 8 * 2 * 128 * 128;
    int* IDX = (int*)(C.ws + A_B4); float* GATE = (float*)(C.ws + A_B4) + (size_t)MT * 128;
    const int lane = C.lane, r = lane & 31, hh = lane >> 5;
    for (int task = C.gw; task < (MT / 32) * 8; task += C.NGW) {
        const int tg = task >> 3, h = task & 7, m = tg * 32 + r;
        unsigned S1[16], S2[16];
        subkey_top16(Q + (size_t)m * 2048 + h * 256 + 8 * hh, KEYS + ((size_t)(h * 2 + 0) * 128 + r) * 128 + 8 * hh, hh, S1);
        subkey_top16(Q + (size_t)m * 2048 + h * 256 + 128 + 8 * hh, KEYS + ((size_t)(h * 2 + 1) * 128 + r) * 128 + 8 * hh, hh, S2);
#define CKEY(a, b) ((ford(funord(S1[a] & ~0x7fu) + funord(S2[b] & ~0x7fu)) & ~0xffu) | (unsigned)((a) << 4 | (b)))
        unsigned FK[16], G[16];
#pragma unroll
        for (int b = 0; b < 16; ++b) FK[b] = CKEY(0, b);
#pragma unroll
        for (int b = 0; b < 8; ++b) G[b] = CKEY(1, b);
#pragma unroll
        for (int b = 0; b < 5; ++b) G[8 + b] = CKEY(2, b);
#pragma unroll
        for (int b = 0; b < 3; ++b) G[13 + b] = CKEY(4, b);
        sort16_desc(G); merge16_desc(FK, G);
#pragma unroll
        for (int b = 0; b < 4; ++b) G[b] = CKEY(3, b);
#pragma unroll
        for (int b = 0; b < 2; ++b) { G[4 + b] = CKEY(5, b); G[6 + b] = CKEY(6, b); G[8 + b] = CKEY(7, b); }
#pragma unroll
        for (int a = 8; a < 14; ++a) G[2 + a] = CKEY(a, 0);
        sort16_desc(G); merge16_desc(FK, G);
        ins16(FK, CKEY(14, 0)); ins16(FK, CKEY(15, 0));
#undef CKEY
        unsigned I1p[4], I2p[4];
#pragma unroll
        for (int w = 0; w < 4; ++w) { I1p[w] = (S1[4 * w] & 0x7fu) | ((S1[4 * w + 1] & 0x7fu) << 8) | ((S1[4 * w + 2] & 0x7fu) << 16) | ((S1[4 * w + 3] & 0x7fu) << 24);
                                      I2p[w] = (S2[4 * w] & 0x7fu) | ((S2[4 * w + 1] & 0x7fu) << 8) | ((S2[4 * w + 2] & 0x7fu) << 16) | ((S2[4 * w + 3] & 0x7fu) << 24); }
        const float mx = funord(FK[0] & ~0xffu); float sum = 0.f;
#pragma unroll
        for (int i = 0; i < 16; ++i) sum += fexp(funord(FK[i] & ~0xffu) - mx);
        const float rs = 1.0f / sum;
        int oi[8]; float og[8];
#pragma unroll
        for (int i = 0; i < 8; ++i) { const unsigned key = hh ? FK[8 + i] : FK[i]; const unsigned a = (key >> 4) & 15u, b = key & 15u;
            const unsigned w1 = (a >> 2) == 0u ? I1p[0] : ((a >> 2) == 1u ? I1p[1] : ((a >> 2) == 2u ? I1p[2] : I1p[3]));
            const unsigned w2 = (b >> 2) == 0u ? I2p[0] : ((b >> 2) == 1u ? I2p[1] : ((b >> 2) == 2u ? I2p[2] : I2p[3]));
            oi[i] = (int)((((w1 >> ((a & 3u) * 8u)) & 0x7fu) << 7) | ((w2 >> ((b & 3u) * 8u)) & 0x7fu));
            og[i] = fexp(funord(key & ~0xffu) - mx) * rs; }
        const size_t o = (size_t)m * 128 + h * 16 + 8 * hh;
        *(u32x4*)(IDX + o) = (u32x4){(unsigned)oi[0], (unsigned)oi[1], (unsigned)oi[2], (unsigned)oi[3]}; *(u32x4*)(IDX + o + 4) = (u32x4){(unsigned)oi[4], (unsigned)oi[5], (unsigned)oi[6], (unsigned)oi[7]};
        *(f32x4*)(GATE + o) = (f32x4){og[0], og[1], og[2], og[3]}; *(f32x4*)(GATE + o + 4) = (f32x4){og[4], og[5], og[6], og[7]};
    }
}

template <int CTRL, int ROWMASK> __device__ __forceinline__ float dppf(float v) { return __builtin_bit_cast(float, __builtin_amdgcn_update_dpp(0, __builtin_bit_cast(int, v), CTRL, ROWMASK, 0xF, false)); }
__device__ __forceinline__ float wave_sum_u(float v) {
    v += dppf<0xB1, 0xF>(v); v += dppf<0x4E, 0xF>(v); v += dppf<0x141, 0xF>(v); v += dppf<0x140, 0xF>(v);
    v += dppf<0x142, 0xA>(v); v += dppf<0x143, 0xC>(v);
    return __builtin_bit_cast(float, __builtin_amdgcn_readlane(__builtin_bit_cast(int, v), 63));
}
struct RowSet4 { u32x4 u, v; };
__device__ __forceinline__ void load_rows4(RowSet4& R, const unsigned char* U4, const unsigned char* V4, int eid, int lane) {
    const size_t o = (size_t)eid * 1024 + lane * 16; R.u = *(const u32x4*)(U4 + o); R.v = *(const u32x4*)(V4 + o);
}
__device__ __forceinline__ void use_rows4(const u32x4 Ru, const u32x4 Rv, const float (&xf)[32], float gate, float (&out)[32]) {
    float d0 = 0.f, d1 = 0.f;
#define U4_STEP(w, b) { const f32x2 t = __builtin_amdgcn_cvt_scalef32_pk_f32_fp4(Ru[w], 1.0f, b); d0 = fmaf(xf[8 * (w) + 2 * (b)], t.x, d0); d1 = fmaf(xf[8 * (w) + 2 * (b) + 1], t.y, d1); }
#define U4_WORD(w) U4_STEP(w, 0) U4_STEP(w, 1) U4_STEP(w, 2) U4_STEP(w, 3)
    U4_WORD(0) U4_WORD(1) U4_WORD(2) U4_WORD(3)
#undef U4_WORD
#undef U4_STEP
    const float d = wave_sum_u(d0 + d1) * (1.0f / U4_SCALE);
    const float a = gelu_erf(d) * gate * (1.0f / V4_SCALE);
#define V4_STEP(w, b) { const f32x2 t = __builtin_amdgcn_cvt_scalef32_pk_f32_fp4(Rv[w], 1.0f, b); out[8 * (w) + 2 * (b)] = fmaf(a, t.x, out[8 * (w) + 2 * (b)]); out[8 * (w) + 2 * (b) + 1] = fmaf(a, t.y, out[8 * (w) + 2 * (b) + 1]); }
#define V4_WORD(w) V4_STEP(w, 0) V4_STEP(w, 1) V4_STEP(w, 2) V4_STEP(w, 3)
    V4_WORD(0) V4_WORD(1) V4_WORD(2) V4_WORD(3)
#undef V4_WORD
#undef V4_STEP
}
typedef _Float16 h16x2 __attribute__((ext_vector_type(2)));
__device__ __forceinline__ float dot_row4(const u32x4 Ru, const h16x2 (&xh)[16]) {
    float d0 = 0.f, d1 = 0.f;
#define U4_STEP(w, b, D) { const h16x2 t = __builtin_amdgcn_cvt_scalef32_pk_f16_fp4(Ru[w], 1.0f, b); D = __builtin_amdgcn_fdot2(xh[4 * (w) + (b)], t, D, false); }
#define U4_WORD(w) U4_STEP(w, 0, d0) U4_STEP(w, 1, d1) U4_STEP(w, 2, d0) U4_STEP(w, 3, d1)
    U4_WORD(0) U4_WORD(1) U4_WORD(2) U4_WORD(3)
#undef U4_WORD
#undef U4_STEP
    return wave_sum_u(d0 + d1);
}
__device__ __forceinline__ void axpy_row4(const u32x4 Rv, float a, float (&out)[32]) {
#define V4_STEP(w, b) { const f32x2 t = __builtin_amdgcn_cvt_scalef32_pk_f32_fp4(Rv[w], 1.0f, b); out[8 * (w) + 2 * (b)] = fmaf(a, t.x, out[8 * (w) + 2 * (b)]); out[8 * (w) + 2 * (b) + 1] = fmaf(a, t.y, out[8 * (w) + 2 * (b) + 1]); }
#define V4_WORD(w) V4_STEP(w, 0) V4_STEP(w, 1) V4_STEP(w, 2) V4_STEP(w, 3)
    V4_WORD(0) V4_WORD(1) V4_WORD(2) V4_WORD(3)
#undef V4_WORD
#undef V4_STEP
}
__device__ __forceinline__ void phase_gather(const Ctx& C, int layer) {
    const bf16_t* HN2 = (const bf16_t*)(C.ws + A_B2); const unsigned char* U4 = C.ws + WS_U + (size_t)layer * bq::TAB_L1; const unsigned char* V4 = C.ws + WS_V + (size_t)layer * bq::TAB_L1;
    const int* IDX = (const int*)(C.ws + A_B4); const float* GATE = (const float*)(C.ws + A_B4) + (size_t)MT * 128;
    const float* mod = (const float*)(C.ws + WS_MOD); float* X = C.out + O_Y; bf16_t* HN = (bf16_t*)(C.ws + A_HN);
    const int lane = C.lane;
    int m = C.gw; if (m >= MT) return;
    LAS unsigned char* ring = C.lds + C.wave * 16384;
    int i0 = IDX[(size_t)m * 128 + lane], i1 = IDX[(size_t)m * 128 + 64 + lane];
    float g0 = GATE[(size_t)m * 128 + lane], g1 = GATE[(size_t)m * 128 + 64 + lane];
    u32x2 xw[8];
#pragma unroll
    for (int b = 0; b < 8; ++b) xw[b] = *(const u32x2*)(HN2 + (size_t)m * 2048 + 256 * b + 4 * lane);
#pragma unroll
    for (int b = 0; b < 8; ++b) asm volatile("" : "+v"(xw[b]));
    asm volatile("" : "+v"(i0), "+v"(i1), "+v"(g0), "+v"(g1));
    asm volatile("s_waitcnt vmcnt(0)" ::: "memory");
#define SB() __builtin_amdgcn_sched_barrier(0)
    const unsigned lo16 = (unsigned)lane * 16u;
#define ROW_DMA(T, eid_, s_) __builtin_amdgcn_global_load_lds((const unsigned*)((const char*)((T) + (size_t)(eid_) * 1024) + lo16), (LAS unsigned*)(ring + ((s_) & 15) * 1024), 16, 0, 0)
#define EIDC(j) __builtin_amdgcn_readlane(((j) < 64) ? i0 : i1, (j) & 63)
#pragma unroll
    for (int j = 0; j < 14; ++j) ROW_DMA(U4, __builtin_amdgcn_readlane(i0, j), j);
    for (;;) {
        const int mn = m + C.NGW; const bool has_next = mn < MT; const int mq = has_next ? mn : m;
        int ni0, ni1; float ng0, ng1; u32x2 nx[8];
        int lt = lane; asm volatile("" : "+v"(lt));
        { const int* ip = IDX + (size_t)mq * 128 + lt; const float* gp = GATE + (size_t)mq * 128 + lt; const bf16_t* xp = HN2 + (size_t)mq * 2048 + 4 * lt;
          asm volatile("global_load_dword %0, %1, off" : "=v"(ni0) : "v"(ip) : "memory");
          asm volatile("global_load_dword %0, %1, off offset:256" : "=v"(ni1) : "v"(ip) : "memory");
          asm volatile("global_load_dword %0, %1, off" : "=v"(ng0) : "v"(gp) : "memory");
          asm volatile("global_load_dword %0, %1, off offset:256" : "=v"(ng1) : "v"(gp) : "memory");
          asm volatile("global_load_dwordx2 %0, %1, off" : "=v"(nx[0]) : "v"(xp) : "memory");
          asm volatile("global_load_dwordx2 %0, %1, off offset:512" : "=v"(nx[1]) : "v"(xp) : "memory");
          asm volatile("global_load_dwordx2 %0, %1, off offset:1024" : "=v"(nx[2]) : "v"(xp) : "memory");
          asm volatile("global_load_dwordx2 %0, %1, off offset:1536" : "=v"(nx[3]) : "v"(xp) : "memory");
          asm volatile("global_load_dwordx2 %0, %1, off offset:2048" : "=v"(nx[4]) : "v"(xp) : "memory");
          asm volatile("global_load_dwordx2 %0, %1, off offset:2560" : "=v"(nx[5]) : "v"(xp) : "memory");
          asm volatile("global_load_dwordx2 %0, %1, off offset:3072" : "=v"(nx[6]) : "v"(xp) : "memory");
          asm volatile("global_load_dwordx2 %0, %1, off offset:3584" : "=v"(nx[7]) : "v"(xp) : "memory"); }
        h16x2 xf[16];
#pragma unroll
        for (int b = 0; b < 8; ++b) { xf[2 * b] = __builtin_bit_cast(h16x2, __builtin_amdgcn_cvt_pkrtz(bf_lo(xw[b].x), bf_hi(xw[b].x))); xf[2 * b + 1] = __builtin_bit_cast(h16x2, __builtin_amdgcn_cvt_pkrtz(bf_lo(xw[b].y), bf_hi(xw[b].y))); }
        float dv0 = 0.f, dv1 = 0.f;
#define U_ITER2(e, VMN, DV, NEXT_T, NEXT_E0, NEXT_E1) do { ROW_DMA(NEXT_T, NEXT_E0, (e) + 14); ROW_DMA(NEXT_T, NEXT_E1, (e) + 15); asm volatile("s_waitcnt vmcnt(" #VMN ")" ::: "memory"); \
            const u32x4 ru0 = *(const LAS u32x4*)(ring + ((e) & 15) * 1024 + lo16), ru1 = *(const LAS u32x4*)(ring + (((e) + 1) & 15) * 1024 + lo16); \
            const float da = dot_row4(ru0, xf), db = dot_row4(ru1, xf); \
            DV = (lane == ((e) & 63)) ? da : DV; DV = (lane == (((e) + 1) & 63)) ? db : DV; } while (0)
#pragma unroll 1
        for (int e = 0; e < 14; e += 2) U_ITER2(e, 26, dv0, U4, EIDC(e + 14), EIDC(e + 15));
#pragma unroll 1
        for (int e = 14; e < 64; e += 2) U_ITER2(e, 14, dv0, U4, EIDC(e + 14), EIDC(e + 15));
#pragma unroll 1
        for (int e = 64; e < 114; e += 2) U_ITER2(e, 14, dv1, U4, EIDC(e + 14), EIDC(e + 15));
#pragma unroll 1
        for (int e = 114; e < 128; e += 2) U_ITER2(e, 14, dv1, V4, EIDC(e - 114), EIDC(e - 113));
#undef U_ITER2
        asm volatile("" : "+v"(ni0), "+v"(ni1), "+v"(ng0), "+v"(ng1));
#pragma unroll
        for (int b = 0; b < 8; ++b) asm volatile("" : "+v"(nx[b]));
        const float av0 = gelu_erf(dv0 * (1.0f / U4_SCALE)) * g0 * (1.0f / V4_SCALE), av1 = gelu_erf(dv1 * (1.0f / U4_SCALE)) * g1 * (1.0f / V4_SCALE);
        float out[32];
#pragma unroll
        for (int i = 0; i < 32; ++i) out[i] = 0.f;
#define V_ITER2(e, AV, NEXT_T, NEXT_E0, NEXT_E1) do { ROW_DMA(NEXT_T, NEXT_E0, (e) + 14); ROW_DMA(NEXT_T, NEXT_E1, (e) + 15); asm volatile("s_waitcnt vmcnt(14)" ::: "memory"); \
            const u32x4 rv0 = *(const LAS u32x4*)(ring + ((e) & 15) * 1024 + lo16), rv1 = *(const LAS u32x4*)(ring + (((e) + 1) & 15) * 1024 + lo16); \
            const float a0 = __builtin_bit_cast(float, __builtin_amdgcn_readlane(__builtin_bit_cast(int, AV), (e) & 63)), a1 = __builtin_bit_cast(float, __builtin_amdgcn_readlane(__builtin_bit_cast(int, AV), ((e) + 1) & 63)); \
            axpy_row4(rv0, a0, out); axpy_row4(rv1, a1, out); } while (0)
#pragma unroll 1
        for (int e = 0; e < 64; e += 2) V_ITER2(e, av0, V4, EIDC(e + 14), EIDC(e + 15));
#pragma unroll 1
        for (int e = 64; e < 114; e += 2) V_ITER2(e, av1, V4, EIDC(e + 14), EIDC(e + 15));
#pragma unroll 1
        for (int e = 114; e < 128; e += 2) V_ITER2(e, av1, U4, __builtin_amdgcn_readlane(ni0, e - 114), __builtin_amdgcn_readlane(ni0, e - 113));
#undef V_ITER2
        int le = lane; asm volatile("" : "+v"(le));
        const int sq = seq_of_row(m); const float* g2 = mod + ((size_t)layer * NSEQ + sq) * 12288 + 5 * 2048; float* xr = X + (size_t)m * DM;
        float ss = 0.f;
#pragma unroll
        for (int hb = 0; hb < 2; ++hb) {
            f32x4 xo[4], gg[4];
#pragma unroll
            for (int b = 0; b < 4; ++b) { const int c = 256 * (4 * hb + b) + 4 * le; xo[b] = *(const f32x4*)(xr + c); gg[b] = *(const f32x4*)(g2 + c); }
            SB();
#pragma unroll
            for (int b = 0; b < 4; ++b) {
#pragma unroll
                for (int j = 0; j < 4; ++j) { const float v = xo[b][j] + gg[b][j] * out[4 * (4 * hb + b) + j]; out[4 * (4 * hb + b) + j] = v; ss += v * v; } }
            SB();
        }
        const float rstd = __builtin_amdgcn_rsqf(wave_sum(ss) * (1.0f / DM) + RMS_EPS);
        if (layer == 0) {
            const float* n1g = C.in[11] + 2048; const float* mp = mod + ((size_t)1 * NSEQ + sq) * 12288;
#pragma unroll
            for (int hb = 0; hb < 2; ++hb) {
                f32x4 gv[4], sh[4], sc[4];
#pragma unroll
                for (int b = 0; b < 4; ++b) { const int c = 256 * (4 * hb + b) + 4 * le; gv[b] = *(const f32x4*)(n1g + c); sh[b] = *(const f32x4*)(mp + c); sc[b] = *(const f32x4*)(mp + 2048 + c); }
                SB();
#pragma unroll
                for (int b = 0; b < 4; ++b) { const int bb = 4 * hb + b, c = 256 * bb + 4 * le;
                    const f32x4 xs = {out[4 * bb], out[4 * bb + 1], out[4 * bb + 2], out[4 * bb + 3]}; const f32x4 y = xs * rstd * gv[b] * (sc[b] + 1.0f) + sh[b];
                    *(f32x4*)(xr + c) = xs; u32x2 w; w.x = cvt_pk_bf16(y[0], y[1]); w.y = cvt_pk_bf16(y[2], y[3]); *(u32x2*)(HN + (size_t)m * DM + c) = w; }
                SB();
            }
        } else {
            const float* fg = C.in[35];
            f32x4 gv[8];
#pragma unroll
            for (int b = 0; b < 8; ++b) gv[b] = *(const f32x4*)(fg + 256 * b + 4 * le);
            SB();
#pragma unroll
            for (int b = 0; b < 8; ++b) { const int c = 256 * b + 4 * le; const f32x4 xs = {out[4 * b], out[4 * b + 1], out[4 * b + 2], out[4 * b + 3]};
                *(f32x4*)(xr + c) = xs * rstd * gv[b]; }
        }
        if (!has_next) break;
        m = mn; i0 = ni0; i1 = ni1; g0 = ng0; g1 = ng1;
#pragma unroll
        for (int b = 0; b < 8; ++b) xw[b] = nx[b];
    }
    asm volatile("s_waitcnt vmcnt(0)" ::: "memory");
#undef ROW_DMA
#undef EIDC
#undef SB
}
namespace att {
constexpr int SHM_K = 64 * 384, SHM_V = 64 * 256;
constexpr int OFF_K = 0, OFF_V = 2 * SHM_K, OFF_WS = 2 * SHM_K + 2 * SHM_V;
constexpr float SCALE = 0.07216878364870322f;
constexpr float THR = 8.f;
__device__ __forceinline__ int crow(int r, int hi) { return (r & 3) + 8 * (r >> 2) + 4 * hi; }
constexpr float THR2 = THR * 1.4426950408889634f;
__device__ __forceinline__ void partialSM(f32x16& p0, f32x16& p1, float& mref, f32x16& negm, float& alpha, bool first) {
    float pmax = p0[0];
#pragma unroll
    for (int r = 1; r < 16; ++r) pmax = fmaxf(pmax, p0[r]);
#pragma unroll
    for (int r = 0; r < 16; ++r) pmax = fmaxf(pmax, p1[r]);
    { auto rr = __builtin_amdgcn_permlane32_swap(__float_as_uint(pmax), __float_as_uint(pmax), false, false);
      pmax = fmaxf(__uint_as_float(rr[0]), __uint_as_float(rr[1])); }
    if (__builtin_expect(!first && __all(pmax <= THR2), 1)) { alpha = 1.f; }
    else { const float dl = first ? pmax : fmaxf(pmax, 0.f); alpha = first ? 1.f : __builtin_amdgcn_exp2f(-dl); mref += dl;
#pragma unroll
        for (int r = 0; r < 16; ++r) { negm[r] = -mref; p0[r] -= dl; p1[r] -= dl; }
        asm volatile("" : "+v"(negm)); }
#pragma unroll
    for (int r = 0; r < 16; ++r) p0[r] = __builtin_amdgcn_exp2f(p0[r]);
#pragma unroll
    for (int r = 0; r < 16; ++r) p1[r] = __builtin_amdgcn_exp2f(p1[r]);
}
__device__ __forceinline__ void finishSM(const f32x16& p0, const f32x16& p1, float alpha, float& l_reg, bf16x8& pa0, bf16x8& pa1, bf16x8& pa2, bf16x8& pa3) {
    float ps = 0;
#pragma unroll
    for (int r = 0; r < 16; ++r) ps += p0[r];
#pragma unroll
    for (int r = 0; r < 16; ++r) ps += p1[r];
    { auto rr = __builtin_amdgcn_permlane32_swap(__float_as_uint(ps), __float_as_uint(ps), false, false);
      ps = __uint_as_float(rr[0]) + __uint_as_float(rr[1]); }
    l_reg = l_reg * alpha + ps;
#define PK4(P, BASE, OUT) do { unsigned a0 = cvt_pk_bf16(P[BASE + 0], P[BASE + 1]), a1 = cvt_pk_bf16(P[BASE + 2], P[BASE + 3]);   \
    unsigned b0 = cvt_pk_bf16(P[BASE + 4], P[BASE + 5]), b1 = cvt_pk_bf16(P[BASE + 6], P[BASE + 7]);                              \
    auto r0 = __builtin_amdgcn_permlane32_swap(a0, b0, false, false); auto r1 = __builtin_amdgcn_permlane32_swap(a1, b1, false, false); \
    u32x4 w = {r0[0], r1[0], r0[1], r1[1]}; OUT = __builtin_bit_cast(bf16x8, w); } while (0)
    PK4(p0, 0, pa0); PK4(p0, 8, pa1); PK4(p1, 0, pa2); PK4(p1, 8, pa3);
#undef PK4
}
template <int OFF> __device__ __forceinline__ bf16x8 k_read(int addr) { bf16x8 r; asm volatile("ds_read_b128 %0, %1 offset:%2" : "=v"(r) : "v"(addr), "i"(OFF) : "memory"); return r; }
template <int I> __device__ __forceinline__ bf16x8 kfrag(const int (&kad)[4]) { constexpr int d0 = I >> 1, half = I & 1; return k_read<(d0 >> 2) * 128 + half * 12288>(kad[d0 & 3]); }
__device__ __forceinline__ void packSM(const f32x16& p0, const f32x16& p1, bf16x8& pa0, bf16x8& pa1, bf16x8& pa2, bf16x8& pa3) {
#define PK4(P, BASE, OUT) do { unsigned a0 = cvt_pk_bf16(P[BASE + 0], P[BASE + 1]), a1 = cvt_pk_bf16(P[BASE + 2], P[BASE + 3]);   \
    unsigned b0 = cvt_pk_bf16(P[BASE + 4], P[BASE + 5]), b1 = cvt_pk_bf16(P[BASE + 6], P[BASE + 7]);                              \
    auto r0 = __builtin_amdgcn_permlane32_swap(a0, b0, false, false); auto r1 = __builtin_amdgcn_permlane32_swap(a1, b1, false, false); \
    u32x4 w = {r0[0], r1[0], r0[1], r1[1]}; OUT = __builtin_bit_cast(bf16x8, w); } while (0)
    PK4(p0, 0, pa0); PK4(p0, 8, pa1); PK4(p1, 0, pa2); PK4(p1, 8, pa3);
#undef PK4
}
__device__ __forceinline__ int v_rd_base(int lane) { return ((lane & 3) << 3) | (((lane >> 2) & 3) << 6) | (((lane >> 4) & 1) << 5) | (((lane >> 5) & 1) << 8); }
constexpr int v_rd_off(int d0, int ks, int half) { return d0 * 512 + ks * 4096 + half * 2048; }
template <int OFF> __device__ __forceinline__ s16x4 tr_read(int vb) {
    s16x4 r; asm volatile("ds_read_b64_tr_b16 %0, %1 offset:%2" : "=&v"(r) : "v"(vb), "i"(OFF) : "memory"); return r;
}
template <int D0> __device__ __forceinline__ void pv_one(f32x16& od, int vb, bf16x8 pa0, bf16x8 pa1, bf16x8 pa2, bf16x8 pa3) {
    const s16x4 l0 = tr_read<v_rd_off(D0, 0, 0)>(vb), h0 = tr_read<v_rd_off(D0, 0, 1)>(vb), l1 = tr_read<v_rd_off(D0, 1, 0)>(vb), h1 = tr_read<v_rd_off(D0, 1, 1)>(vb);
    const s16x4 l2 = tr_read<v_rd_off(D0, 2, 0)>(vb), h2 = tr_read<v_rd_off(D0, 2, 1)>(vb), l3 = tr_read<v_rd_off(D0, 3, 0)>(vb), h3 = tr_read<v_rd_off(D0, 3, 1)>(vb);
    asm volatile("s_waitcnt lgkmcnt(0)" ::: "memory"); __builtin_amdgcn_sched_barrier(0);
#define PKV(L, H) (bf16x8){L[0], L[1], L[2], L[3], H[0], H[1], H[2], H[3]}
    od = __builtin_amdgcn_mfma_f32_32x32x16_bf16(pa0, PKV(l0, h0), od, 0, 0, 0);
    od = __builtin_amdgcn_mfma_f32_32x32x16_bf16(pa1, PKV(l1, h1), od, 0, 0, 0);
    od = __builtin_amdgcn_mfma_f32_32x32x16_bf16(pa2, PKV(l2, h2), od, 0, 0, 0);
    od = __builtin_amdgcn_mfma_f32_32x32x16_bf16(pa3, PKV(l3, h3), od, 0, 0, 0);
#undef PKV
}
struct AUnit { int qrow0, kvrow0, ntiles, head, vis0, nact; };

__device__ __forceinline__ bool next_unit(int i, int vcu, int G, AUnit& u) {
    int flat;
    if (G == 256) {
        if (i >= 10) return false;
        if (i < 8) { const int bh = vcu >> 3, s = vcu & 7, base = 16 * (i >> 1); const int qb = (i & 1) ? base + 15 - s : base + s; flat = bh * 64 + qb; }
        else flat = 2048 + vcu * 2 + (i - 8);
    } else { flat = i * G + vcu; if (flat >= 2560) return false; }
    if (flat < 2048) { const int bh = flat >> 6, qb = flat & 63, b = bh >> 4; u.head = bh & 15; u.qrow0 = b * 16384 + qb * 256; u.kvrow0 = b * 16384; u.ntiles = 4 * qb + 4; u.vis0 = 4 * qb; u.nact = 8; }
    else { const int f = flat - 2048, b = f >> 4; u.head = f & 15; u.qrow0 = MP + b * 64; u.kvrow0 = MP + b * 1088; u.ntiles = 17; u.vis0 = 1 << 20; u.nact = 2; }
    return true;
}

__device__ __forceinline__ void attn_phase(const Ctx& C) {
    bf16_t* Qn = (bf16_t*)(C.ws + A_HN); const bf16_t* Qp = (const bf16_t*)(C.ws + A_GG);
    const bf16_t* Kn = (const bf16_t*)(C.ws + A_KN); const bf16_t* Kp = (const bf16_t*)(C.ws + A_KP); const bf16_t* Vv = (const bf16_t*)(C.ws + A_VV);
    LAS unsigned char* lds = C.lds; const int wid = C.wave, lane = C.lane, r32 = lane & 31, hi = lane >> 5;
    LAS float* wsp = (LAS float*)(lds + OFF_WS) + wid * 64; LAS float* li_l = wsp; LAS float* al_l = wsp + 32;
    unsigned ka[3], kst[3]; bool kisn[3];
#pragma unroll
    for (int i = 0; i < 3; ++i) { const int Uq = (wid * 3 + i) * 64 + lane, row = Uq / 24, cp = Uq % 24, c = cp ^ ((row >> 1) & 7);
        kisn[i] = c < 16; ka[i] = kisn[i] ? (unsigned)(row * 4096 + c * 16) : (unsigned)(A_KP - A_KN) + (unsigned)(row * 128 + (c - 16) * 16); kst[i] = kisn[i] ? 64u * 4096u : 64u * 128u; }
    unsigned va[2];
#pragma unroll
    for (int i = 0; i < 2; ++i) { const int by = ((wid * 2 + i) * 64 + lane) * 16, sub = by >> 9, within = by & 511, kk = (sub >> 2) * 8 + (within >> 6), cc = (sub & 3) * 32 + ((within & 63) >> 1);
        const int k = (kk & ~0xC) | ((kk & 4) << 1) | ((kk & 8) >> 1); va[i] = (unsigned)(k * 4096 + cc * 2); }
    int kl0[4];
#pragma unroll
    for (int q = 0; q < 4; ++q) kl0[q] = (int)(uintptr_t)(lds + OFF_K) + r32 * 384 + ((((2 * q + hi) ^ ((r32 >> 1) & 7))) << 4);
    const int vb0 = (int)(uintptr_t)(lds + OFF_V) + v_rd_base(lane);
#define ATT_BAR() __builtin_amdgcn_s_barrier()
#define ATT_ISSUE(j, kb, vbi) do { _Pragma("unroll") for (int _i = 0; _i < 3; ++_i) { \
        __builtin_amdgcn_global_load_lds((const unsigned*)((const char*)Kn + kc[_i]), (LAS unsigned*)(lds + OFF_K + (kb) * SHM_K + (wid * 3 + _i) * 1024), 16, 0, 0); kc[_i] += kst[_i]; } \
      _Pragma("unroll") for (int _i = 0; _i < 2; ++_i) { \
        __builtin_amdgcn_global_load_lds((const unsigned*)((const char*)Vv + vc[_i]), (LAS unsigned*)(lds + OFF_V + (vbi) * SHM_V + (wid * 2 + _i) * 1024), 16, 0, 0); vc[_i] += 64u * 4096u; } } while (0)
#define PV_STEP(I, PA, L, H, WN) do { asm volatile("s_waitcnt lgkmcnt(" #WN ")" : "+v"(L), "+v"(H) :: "memory"); \
        o[(I) >> 2] = __builtin_amdgcn_mfma_f32_32x32x16_bf16(PA, ((bf16x8){L[0], L[1], L[2], L[3], H[0], H[1], H[2], H[3]}), o[(I) >> 2], 0, 0, 0); \
        if ((I) + 4 < 16) { L = tr_read<v_rd_off((((I) + 4) & 15) >> 2, (I) & 3, 0)>(vb); H = tr_read<v_rd_off((((I) + 4) & 15) >> 2, (I) & 3, 1)>(vb); } \
        __builtin_amdgcn_sched_barrier(0); } while (0)
#define PV_HEAD(VBI) do { vb = vb0 + (VBI) * SHM_V; \
      l0 = tr_read<v_rd_off(0, 0, 0)>(vb); h0 = tr_read<v_rd_off(0, 0, 1)>(vb); l1 = tr_read<v_rd_off(0, 1, 0)>(vb); h1 = tr_read<v_rd_off(0, 1, 1)>(vb); \
      l2 = tr_read<v_rd_off(0, 2, 0)>(vb); h2 = tr_read<v_rd_off(0, 2, 1)>(vb); l3 = tr_read<v_rd_off(0, 3, 0)>(vb); h3 = tr_read<v_rd_off(0, 3, 1)>(vb); } while (0)
#define PV_BODY() do { \
      __builtin_amdgcn_s_setprio(1); PV_STEP(0, pa0, l0, h0, 6);  PV_STEP(1, pa1, l1, h1, 6);  PV_STEP(2, pa2, l2, h2, 6);  PV_STEP(3, pa3, l3, h3, 6); \
      PV_STEP(4, pa0, l0, h0, 6);  PV_STEP(5, pa1, l1, h1, 6);  PV_STEP(6, pa2, l2, h2, 6);  PV_STEP(7, pa3, l3, h3, 6); \
      PV_STEP(8, pa0, l0, h0, 6);  PV_STEP(9, pa1, l1, h1, 6);  PV_STEP(10, pa2, l2, h2, 6); PV_STEP(11, pa3, l3, h3, 6); \
      PV_STEP(12, pa0, l0, h0, 6); PV_STEP(13, pa1, l1, h1, 4); PV_STEP(14, pa2, l2, h2, 2); PV_STEP(15, pa3, l3, h3, 0); __builtin_amdgcn_s_setprio(0); } while (0)
#define ATT_PV(VBI) do { PV_HEAD(VBI); PV_BODY(); } while (0)
    AUnit u;
#ifndef PROBE_ATT
#define PROBE_ATT 0
#endif
#if PROBE_ATT
    for (int ui2 = 0; next_unit(ui2 >> 1, C.vcu, C.G, u); ++ui2) { const bool dummy = !(ui2 & 1);
#else
    for (int ui = 0; next_unit(ui, C.vcu, C.G, u); ++ui) { const bool dummy = false;
#endif
        const bool active = wid < u.nact; const int vis = u.vis0 + (wid >> 1);
        const int qrow = u.qrow0 + wid * 32 + r32;
        bf16x8 qr[12];
        if (active) {
#pragma unroll
            for (int d0 = 0; d0 < 8; ++d0) qr[d0] = *(const bf16x8*)(Qn + (size_t)qrow * 2048 + u.head * 128 + d0 * 16 + hi * 8);
#pragma unroll
            for (int d0 = 0; d0 < 4; ++d0) qr[8 + d0] = *(const bf16x8*)(Qp + (size_t)qrow * 1024 + u.head * 64 + d0 * 16 + hi * 8);
        } else {
#pragma unroll
            for (int d0 = 0; d0 < 12; ++d0) qr[d0] = (bf16x8){0, 0, 0, 0, 0, 0, 0, 0};
        }
#pragma unroll
        for (int d0 = 0; d0 < 12; ++d0) asm volatile("" : "+v"(qr[d0]));
        float mref = 0.f, l_reg = 0.f; f32x16 o[4]; f32x16 negm;
#pragma unroll
        for (int r = 0; r < 16; ++r) negm[r] = 0.f;
        asm volatile("" : "+v"(negm));
#pragma unroll
        for (int d = 0; d < 4; ++d)
#pragma unroll
            for (int r = 0; r < 16; ++r) o[d][r] = 0.f;
        bf16x8 pa0, pa1, pa2, pa3;
        const int NT = u.ntiles;
        unsigned kc[3], vc[2];
#pragma unroll
        for (int i = 0; i < 3; ++i) kc[i] = ka[i] + (kisn[i] ? (unsigned)u.kvrow0 * 4096u + (unsigned)u.head * 256u : (unsigned)u.kvrow0 * 128u);
#pragma unroll
        for (int i = 0; i < 2; ++i) vc[i] = va[i] + (unsigned)u.kvrow0 * 4096u + (unsigned)u.head * 256u;
        ATT_ISSUE(0, 0, 0);
        asm volatile("s_waitcnt vmcnt(0)" ::: "memory");
        ATT_BAR();
        int vb; s16x4 l0, h0, l1, h1, l2, h2, l3, h3; bf16x8 f0, f1, f2, f3; int kad[4];
#define QK_HEAD() do { _Pragma("unroll") for (int q = 0; q < 4; ++q) kad[q] = kl0[q] + buf * SHM_K; f0 = kfrag<0>(kad); f1 = kfrag<1>(kad); f2 = kfrag<2>(kad); f3 = kfrag<3>(kad); } while (0)
#define QK_STEP(I, F, WN) do { asm volatile("s_waitcnt lgkmcnt(" #WN ")" : "+v"(F) :: "memory"); \
        if ((I) == 0) p0 = __builtin_amdgcn_mfma_f32_32x32x16_bf16(F, qr[0], negm, 0, 0, 0); \
        else if ((I) == 1) p1 = __builtin_amdgcn_mfma_f32_32x32x16_bf16(F, qr[0], negm, 0, 0, 0); \
        else if ((I) & 1) p1 = __builtin_amdgcn_mfma_f32_32x32x16_bf16(F, qr[(I) >> 1], p1, 0, 0, 0); \
        else p0 = __builtin_amdgcn_mfma_f32_32x32x16_bf16(F, qr[(I) >> 1], p0, 0, 0, 0); \
        if ((I) + 4 < 24) F = kfrag<((I) + 4 < 24 ? (I) + 4 : 0)>(kad); __builtin_amdgcn_sched_barrier(0); } while (0)
        for (int j = 0; j < NT; ++j) {
            const int buf = j & 1;
            const bool doQK = active && j <= vis;
            if (j + 1 < NT) ATT_ISSUE(j + 1, buf ^ 1, buf ^ 1);
            if (doQK) {
                f32x16 p0, p1;
                if ((PROBE_ATT == 3 || PROBE_ATT == 5) && dummy) { p0 = negm; p1 = negm; } else {
                QK_HEAD();
                __builtin_amdgcn_s_setprio(1);
                QK_STEP(0, f0, 3);  QK_STEP(1, f1, 3);  QK_STEP(2, f2, 3);  QK_STEP(3, f3, 3);
                QK_STEP(4, f0, 3);  QK_STEP(5, f1, 3);  QK_STEP(6, f2, 3);  QK_STEP(7, f3, 3);
                QK_STEP(8, f0, 3);  QK_STEP(9, f1, 3);  QK_STEP(10, f2, 3); QK_STEP(11, f3, 3);
                QK_STEP(12, f0, 3); QK_STEP(13, f1, 3); QK_STEP(14, f2, 3); QK_STEP(15, f3, 3);
                QK_STEP(16, f0, 3); QK_STEP(17, f1, 3); QK_STEP(18, f2, 3); QK_STEP(19, f3, 3);
                QK_STEP(20, f0, 3); QK_STEP(21, f1, 2); QK_STEP(22, f2, 1); QK_STEP(23, f3, 0);
                __builtin_amdgcn_s_setprio(0);
                }
                if ((PROBE_ATT == 2 || PROBE_ATT == 5) && dummy) { packSM(p0, p1, pa0, pa1, pa2, pa3); } else {
                float alpha; partialSM(p0, p1, mref, negm, alpha, j == 0);
                if (__any(alpha < 1.f)) { if (hi == 0) al_l[r32] = alpha; asm volatile("s_waitcnt lgkmcnt(0)" ::: "memory");
#pragma unroll
                    for (int r = 0; r < 16; ++r) { const float al = al_l[crow(r, hi)];
#pragma unroll
                        for (int d = 0; d < 4; ++d) o[d][r] *= al; } }
                finishSM(p0, p1, alpha, l_reg, pa0, pa1, pa2, pa3);
                }
                if (!((PROBE_ATT == 4 || PROBE_ATT == 5) && dummy)) ATT_PV(buf);
            }
            asm volatile("s_waitcnt vmcnt(0) lgkmcnt(0)" ::: "memory");
            ATT_BAR();
        }
#undef QK_STEP
#undef QK_HEAD
        if (active && !dummy) {
            if (hi == 0) li_l[r32] = l_reg; asm volatile("s_waitcnt lgkmcnt(0)" ::: "memory");
            bf16_t* Ow = Qn + (size_t)(u.qrow0 + wid * 32) * 2048 + u.head * 128;
#pragma unroll
            for (int r = 0; r < 16; ++r) { const int orow = crow(r, hi); const float rl = __builtin_amdgcn_rcpf(li_l[orow]);
#pragma unroll
                for (int d0 = 0; d0 < 4; ++d0) { const unsigned w = cvt_pk_bf16(o[d0][r] * rl, 0.f); Ow[(size_t)orow * 2048 + d0 * 32 + r32] = (bf16_t)(w & 0xffffu); } }
        }
    }
#undef ATT_BAR
#undef ATT_ISSUE
#undef ATT_PV
#undef PV_STEP
#undef PV_HEAD
#undef PV_BODY
}
}
#ifndef MK_SPLIT
#define MK_SPLIT 0
#endif
constexpr int N_PHASES = 22;

__global__ void __launch_bounds__(512, 2) mega_fwd(Args args) {
    extern __shared__ __attribute__((aligned(16))) unsigned char lds_raw[];
    Ctx C;
    C.lds = (LAS unsigned char*)lds_raw;
    C.tid = threadIdx.x; C.lane = C.tid & 63; C.wave = __builtin_amdgcn_readfirstlane(C.tid >> 6);
    C.G = gridDim.x; { const int bx = blockIdx.x; C.vcu = (C.G % 8 == 0) ? (bx % 8) * (C.G / 8) + bx / 8 : bx; }
    C.gw = C.vcu * 8 + C.wave; C.NGW = C.G * 8;
    C.in = args.in; C.out = args.out; C.ws = args.ws;
    volatile LAS unsigned* misc = (volatile LAS unsigned*)(C.lds + LDS_MISC);
    if (C.tid < 4) misc[C.tid] = 0u;
    __syncthreads();
    const int lo = args.ph_lo, hi = args.ph_hi;
    XcdBarrier bar; bar.bar = (unsigned*)(C.ws + WS_CTL) + CW_BAR; bar.x = 0; bar.st = misc;
    if (hi - lo > 1) bar = xcd_barrier_post((unsigned*)(C.ws + WS_CTL) + CW_BAR, misc);
#ifdef PH_ONLY
#define IN(k) ((k) == PH_ONLY)
#else
#define IN(k) (lo <= (k) && (k) < hi)
#endif
#define FILL(k) bq::service(C, true, (k), 0)
#define NEED(k, limit) do { if (IN(k) && (limit) > 0) bq::service(C, false, 0, (limit)); } while (0)
#define SEAM(k) do { if (IN(k) && IN((k) + 1)) xcd_barrier(bar); } while (0)
    unsigned char* ws = C.ws;
    const float* mod = (const float*)(ws + WS_MOD);
    float* X = C.out + O_Y;
    LAS unsigned char* glds = C.lds;

#ifdef PROBE_CLK
#define CLK_BEGIN(k) unsigned long long _t0 = 0, _r0 = 0; if ((k) == PROBE_CLK) { _t0 = __builtin_amdgcn_s_memtime(); _r0 = __builtin_amdgcn_s_memrealtime(); }
#define CLK_END(k) if ((k) == PROBE_CLK && blockIdx.x == 0 && threadIdx.x == 0) { const unsigned long long t1 = __builtin_amdgcn_s_memtime(), r1 = __builtin_amdgcn_s_memrealtime(); \
        const unsigned long long ticks = (t1 - _t0) * 1000ull / (r1 - _r0); while (__builtin_amdgcn_s_memrealtime() - r1 < ticks) __builtin_amdgcn_s_sleep(8); }
#else
#define CLK_BEGIN(k)
#define CLK_END(k)
#endif
    if (IN(0)) { phase_prologue(C); } SEAM(0);
    if (IN(1)) { phase_norm(C, C.in[0], C.in[1], C.in[11], mod, 0, (bf16_t*)(ws + A_HN)); } NEED(1, bq::E_IN); SEAM(1);
    if (IN(2)) {
        pg8::Gemm g{(const bf16_t*)(ws + A_HN), (const bf16_t*)(ws + WS_WIN), MT, 3072, 2048, 2048, 2048, 0, 0}; pg8::StaticOrder S; S.init(MT, 3072, C.G, (int)blockIdx.x);
        pg8::EpiZ E{(bf16_t*)(ws + A_GG), (bf16_t*)(ws + A_B2), (bf16_t*)(ws + A_B2) + (size_t)MT * 1024};
        CLK_BEGIN(2) pg8::gemm_phase<pg8::EpiZ>(glds, g, S, E); CLK_END(2) FILL(2); } SEAM(2);
    if (IN(3)) { phase_convpool(C); } NEED(3, bq::E_POOL); SEAM(3);
    if (IN(4)) {
        { pg8::Gemm g{(const bf16_t*)(ws + A_B3), (const bf16_t*)(ws + WS_WGATE), MT, 2048, 256, 1024, 256, 1, 256}; pg8::StaticOrder S; S.init(MT, 2048, C.G, (int)blockIdx.x);
          pg8::EpiGate E{(const bf16_t*)(ws + A_B3), (const float*)(ws + WS_SP), (float*)(ws + A_B4)};
          pg8::gemm_phase<pg8::EpiGate>(glds, g, S, E); }
        FILL(4); } SEAM(4);
    if (IN(5)) {
        { pg8::Gemm g{(const bf16_t*)(ws + A_B3) + (size_t)MT * 1024, (const bf16_t*)(ws + WS_WPOOL), MT, 1024, 256, 1024, 256, 0, 256}; pg8::StaticOrder S; S.init(MT, 1024, C.G, (int)blockIdx.x);
          pg8::EpiPool E{(bf16_t*)(ws + A_HN), C.in[22]};
          pg8::gemm_phase<pg8::EpiPool>(glds, g, S, E); }
        phase_scanA(C); FILL(5); } SEAM(5);
    if (IN(6)) { phase_scanB(C); } SEAM(6);
    if (IN(7)) { phase_scanC(C); } NEED(7, bq::E_OUTR); SEAM(7);
    if (IN(8)) {
        pg8::Gemm g{(const bf16_t*)(ws + A_HN), (const bf16_t*)(ws + WS_WOUTR), MT, 2048, 2048, 2048, 2048, 0, 0}; pg8::StaticOrder S; S.init(MT, 2048, C.G, (int)blockIdx.x);
        pg8::EpiBf16 E{(bf16_t*)(ws + A_B3), 2048};
        pg8::gemm_phase<pg8::EpiBf16>(glds, g, S, E); FILL(8); } SEAM(8);
#define PEER_BLOCK(P0, L) \
    if (IN(P0)) { phase_resid_norm(C, (L) == 0 ? C.in[0] : X, (L) == 0 ? C.in[1] : X + (size_t)MP * DM, (const bf16_t*)(ws + A_B3), X, C.in[12] + (L) * 2048, mod + (size_t)(L) * NSEQ * 12288, (bf16_t*)(ws + A_B2)); } NEED(P0, (L) == 0 ? bq::E_Q0 : bq::E_Q1); SEAM(P0); \
    if (IN(P0 + 1)) { pg8::Gemm g{(const bf16_t*)(ws + A_B2), (const bf16_t*)(ws + WS_WQ) + (size_t)(L) * 2048 * 2048, MT, 2048, 2048, 2048, 2048, 0, 0}; pg8::StaticOrder S; S.init(MT, 2048, C.G, (int)blockIdx.x); \
        pg8::EpiBf16 E{(bf16_t*)(ws + A_B3), 2048}; pg8::gemm_phase<pg8::EpiBf16>(glds, g, S, E); FILL(P0 + 1); } NEED(P0 + 1, (L) == 0 ? bq::E_KEYS : 0); SEAM(P0 + 1); \
    if (IN(P0 + 2)) { phase_topk(C, L); } NEED(P0 + 2, (L) == 0 ? bq::E_TAB0 : bq::NTOT); SEAM(P0 + 2); \
    if (IN(P0 + 3)) { CLK_BEGIN(P0 + 3) phase_gather(C, L); CLK_END(P0 + 3) }
    PEER_BLOCK(9, 0) NEED(12, bq::E_DKV); SEAM(12);
    if (IN(13)) {
        pg8::Gemm g{(const bf16_t*)(ws + A_HN), (const bf16_t*)(ws + WS_WDQKV), MT, 1024, 2048, 2048, 2048, 0, 0}; pg8::StaticOrder S; S.init(MT, 1024, C.G, (int)blockIdx.x);
        pg8::EpiF32 E{(float*)(ws + A_B3), 1024};
        pg8::gemm_phase<pg8::EpiF32>(glds, g, S, E); FILL(13); } NEED(13, bq::E_ROPE); SEAM(13);
    if (IN(14)) { phase_latent(C); } NEED(14, bq::E_UKV); SEAM(14);
    if (IN(15)) {
        { pg8::Gemm g{(const bf16_t*)(ws + A_CQ), (const bf16_t*)(ws + WS_WUQ), MT, 3072, 512, 512, 512, 0, 0}; pg8::StaticOrder S; S.init(MT, 3072, C.G, (int)blockIdx.x);
          pg8::EpiQ E{(bf16_t*)(ws + A_HN), (bf16_t*)(ws + A_GG), (const float*)(ws + WS_ROPE)};
          pg8::gemm_phase<pg8::EpiQ>(glds, g, S, E); }
        { pg8::Gemm g{(const bf16_t*)(ws + A_CKV), (const bf16_t*)(ws + WS_WUKV), KVROWS, 4096, 256, 256, 256, 0, 0}; pg8::StaticOrder S; S.init(KVROWS, 4096, C.G, (int)blockIdx.x);
          pg8::EpiKV E{(bf16_t*)(ws + A_KN), (bf16_t*)(ws + A_VV)};
          pg8::gemm_phase<pg8::EpiKV>(glds, g, S, E); } FILL(15); } SEAM(15);
    if (IN(16)) { CLK_BEGIN(16) att::attn_phase(C); CLK_END(16) } NEED(16, bq::E_OUTA); SEAM(16);
    if (IN(17)) {
        pg8::Gemm g{(const bf16_t*)(ws + A_HN), (const bf16_t*)(ws + WS_WOUTA), MT, 2048, 2048, 2048, 2048, 0, 0}; pg8::StaticOrder S; S.init(MT, 2048, C.G, (int)blockIdx.x);
        pg8::EpiBf16 E{(bf16_t*)(ws + A_B3), 2048};
        pg8::gemm_phase<pg8::EpiBf16>(glds, g, S, E); FILL(17); } SEAM(17);
    PEER_BLOCK(18, 1)
#undef PEER_BLOCK
#undef IN
#undef SEAM
#undef FILL
#undef NEED
}

extern "C" void kernel_launch(void* const* d_in, const int* in_sizes, int n_in, void* d_out, int out_size, void* d_ws, size_t ws_size, hipStream_t stream) {
    static int grid = 0;
    if (grid == 0) {
        if (n_in != 36 || out_size != (int)O_TOTAL || ws_size < WS_END) { fprintf(stderr, "kernel_launch: built for 36 inputs, %zu outputs, >= %zu B workspace; got n_in %d out %d ws %zu\n", (size_t)O_TOTAL, (size_t)WS_END, n_in, out_size, ws_size); grid = -1; return; }
        int dev = 0, cus = 0, per_cu = 0;
        if (hipGetDevice(&dev) != hipSuccess || hipDeviceGetAttribute(&cus, hipDeviceAttributeMultiprocessorCount, dev) != hipSuccess) { fprintf(stderr, "kernel_launch: device query failed\n"); grid = -1; return; }
        if (hipFuncSetAttribute((const void*)mega_fwd, hipFuncAttributeMaxDynamicSharedMemorySize, LDS_BYTES) != hipSuccess) { fprintf(stderr, "kernel_launch: hipFuncSetAttribute failed\n"); grid = -1; return; }
        if (hipOccupancyMaxActiveBlocksPerMultiprocessor(&per_cu, (const void*)mega_fwd, 512, LDS_BYTES) != hipSuccess || per_cu < 1) { fprintf(stderr, "kernel_launch: occupancy query says %d blocks per CU\n", per_cu); }
        (void)hipGetLastError();
        grid = cus;
    }
    if (grid < 0) return;
    (void)hipMemsetAsync(d_ws, 0, WS_ZERO_BYTES, stream);
    Args a{};
    for (int i = 0; i < 36; ++i) a.in[i] = (const float*)d_in[i];
    a.out = (float*)d_out; a.ws = (unsigned char*)d_ws;
#if MK_SPLIT
    for (int p = 0; p < N_PHASES; ++p) { a.ph_lo = p; a.ph_hi = p + 1; hipLaunchKernelGGL(mega_fwd, dim3(grid), dim3(512), LDS_BYTES, stream, a); }
#elif defined(PROBE_RANGES)
    { const int rg[][2] = {PROBE_RANGES};
      for (unsigned i = 0; i < sizeof(rg) / sizeof(rg[0]); ++i) { if (i) (void)hipMemsetAsync(d_ws, 0, 1 * MiB, stream); a.ph_lo = rg[i][0]; a.ph_hi = rg[i][1]; hipLaunchKernelGGL(mega_fwd, dim3(grid), dim3(512), LDS_BYTES, stream, a); } }
#else
    a.ph_lo = 0; a.ph_hi = N_PHASES; hipLaunchKernelGGL(mega_fwd, dim3(grid), dim3(512), LDS_BYTES, stream, a);
#endif
    const hipError_t le = hipPeekAtLastError();
    if (le != hipSuccess) fprintf(stderr, "kernel_launch: launch failed: %s\n", hipGetErrorName(le));
}
```

```cpp
#include <hip/hip_runtime.h>
#include <cstdio>
#include <cstdint>

#define LAS __attribute__((address_space(3)))
#define GAS __attribute__((address_space(1)))
typedef unsigned short bf16_t;
typedef short bf16x8 __attribute__((ext_vector_type(8)));
typedef short s16x4 __attribute__((ext_vector_type(4)));
typedef float f32x2 __attribute__((ext_vector_type(2)));
typedef float f32x4 __attribute__((ext_vector_type(4)));
typedef float f32x16 __attribute__((ext_vector_type(16)));
typedef unsigned u32x2 __attribute__((ext_vector_type(2)));
typedef unsigned u32x4 __attribute__((ext_vector_type(4)));

constexpr int DM = 2048;
constexpr int MP = 32768, MS = 2048, MT = MP + MS;
constexpr int NSEQ = 34;
constexpr int KVROWS = MP + 32 * 1088;
constexpr float RMS_EPS = 1e-6f;

__device__ __forceinline__ int seq_of_row(int m) { return m < MP ? (m >> 14) : 2 + ((m - MP) >> 6); }
__device__ __forceinline__ int pos_of_row(int m) { return m < MP ? (m & 16383) : 1024 + ((m - MP) & 63); }
__device__ __forceinline__ int kvrow_of_row(int m) { return m < MP ? m : MP + ((m - MP) >> 6) * 1088 + 1024 + ((m - MP) & 63); }

__device__ __forceinline__ unsigned cvt_pk_bf16(float lo, float hi) { unsigned r; asm volatile("v_cvt_pk_bf16_f32 %0, %1, %2" : "=v"(r) : "v"(lo), "v"(hi)); return r; }
__device__ __forceinline__ float bf_lo(unsigned w) { return __uint_as_float(w << 16); }
__device__ __forceinline__ float bf_hi(unsigned w) { return __uint_as_float(w & 0xffff0000u); }
__device__ __forceinline__ float fexp(float x) { return __builtin_amdgcn_exp2f(x * 1.4426950408889634f); }
__device__ __forceinline__ float fsigmoid(float x) { return __builtin_amdgcn_rcpf(1.0f + __builtin_amdgcn_exp2f(-1.4426950408889634f * x)); }
__device__ __forceinline__ float gelu_tanh(float x) { const float u = x * (1.0f + 0.044715f * x * x); return x * __builtin_amdgcn_rcpf(1.0f + __builtin_amdgcn_exp2f(-2.302208198f * u)); }
__device__ __forceinline__ float gelu_erf(float v) {
    const float av = __builtin_fabsf(v), t = __builtin_amdgcn_rcpf(av * 0.2316418882f + 1.0f);
    float q = t * 0.5307027145f + (-0.7265760135f); q = q * t + 0.7107068705f; q = q * t + (-0.142248368f); q = q * t + 0.127414796f; q = q * t;
    const float e = __builtin_amdgcn_exp2f((v * v) * (-0.72134752044f));
    const float m = v * (q * e); return v < 0.f ? m : v - m;
}
__device__ __forceinline__ float wave_sum(float v) {
#pragma unroll
    for (int o = 32; o >= 1; o >>= 1) v += __shfl_xor(v, o);
    return v;
}

namespace pg8 {
constexpr int BM = 256, BK = 64, HALF = 128, HTB = HALF * BK * 2, STAGE_BYTES = 8 * HTB, NXCD = 8, WGM = 8;
__host__ __device__ __forceinline__ int lds_byte(int r, int c) { const int st = (r >> 4) * 2 + (c >> 5), rr = r & 15, cc = c & 31, ob = rr * 64 + cc * 2; return st * 1024 + (ob ^ (((ob >> 9) & 1) << 5)); }
__host__ __device__ __forceinline__ void stage_rc(int b, int& R, int& C) { const int st = b / 1024, sb = b % 1024, swz = sb ^ (((sb >> 9) & 1) << 5); R = (st >> 1) * 16 + swz / 64; C = (st & 1) * 32 + (swz % 64) / 2; }
__host__ __device__ __forceinline__ int perm32(int rho) { const int n = rho >> 4, i = rho & 15; return 8 * (i >> 2) + 4 * n + (i & 3); }

struct Unit { int pm, pn; };
struct Gemm { const bf16_t* A; const bf16_t* Bt; int M, N, K, lda, ldb, kshift, kmul; };

struct StaticOrder {
    int nM, nN, nwg, G, c;
    __host__ __device__ void init(int M, int N, int G_, int c_) { nM = M / BM; nN = N / BM; nwg = nM * nN; G = G_; c = c_; }
    __host__ __device__ bool next(int i, Unit& u) const {
        const long L = (long)i * G + c; if (L >= nwg) return false;
        int wgid = (int)L; { const int q = nwg / NXCD, r = nwg % NXCD, xcd = wgid % NXCD, off = wgid / NXCD; wgid = (xcd < r ? xcd * (q + 1) : r * (q + 1) + (xcd - r) * q) + off; }
        const int nig = WGM * nN, gid = wgid / nig, fm = gid * WGM, gsz = (nM - fm) < WGM ? (nM - fm) : WGM;
        u.pm = fm + ((wgid % nig) % gsz); u.pn = (wgid % nig) / gsz; return true;
    }
};

template <class Epi>
__device__ __forceinline__ void gemm_phase(LAS unsigned char* lds, const Gemm g, const StaticOrder& S, const Epi& E) {
    const int tid = threadIdx.x, wid = __builtin_amdgcn_readfirstlane(tid >> 6), lane = tid & 63, wr = wid >> 2, wc = wid & 3, fr = lane & 15, fq = lane >> 4;
    int Kq = g.K; asm volatile("" : "+s"(Kq));
    const int K = Kq, nt = K / BK;
    unsigned voffA[2], voffB[2];
#pragma unroll
    for (int i = 0; i < 2; ++i) { int R, C; stage_rc(tid * 16 + i * 8192, R, C); const int Rb = Epi::PERM ? ((R & ~31) + perm32(R & 31)) : R;
        voffA[i] = (unsigned)(R * g.lda + C) * 2u; voffB[i] = (unsigned)(Rb * g.ldb + C) * 2u; }
    const size_t kstep = (size_t)(BK * 2);
    const size_t hstepA = (size_t)HALF * g.lda * 2, hstepB = (size_t)HALF * g.ldb * 2;
    const unsigned ldsw = (unsigned)wid * 1024u;
    const int aoff = lds_byte(wr * 64 + fr, fq * 8), boff = lds_byte(wc * 32 + fr, fq * 8);
#define PG8_SA(b, h) (((b) * 2 + (h)) * HTB)
#define PG8_SB(b, h) ((4 + (b) * 2 + (h)) * HTB)
#define PG8_STAGE(bufoff, gbase, voff) do { _Pragma("unroll") for (int _i = 0; _i < 2; ++_i) \
        __builtin_amdgcn_global_load_lds((const unsigned*)((const char*)(gbase) + (voff)[_i]), (LAS unsigned*)(lds + (bufoff) + ldsw + _i * 8192), 16, 0, 0); } while (0)
#define PG8_LDA(dst, b, h) do { _Pragma("unroll") for (int m = 0; m < 4; ++m) _Pragma("unroll") for (int k = 0; k < 2; ++k) dst[m][k] = *(const LAS bf16x8*)(lds + PG8_SA(b, h) + aoff + m * 2048 + k * 1024); } while (0)
#define PG8_LDB(dst, b, h) do { _Pragma("unroll") for (int n = 0; n < 2; ++n) _Pragma("unroll") for (int k = 0; k < 2; ++k) dst[n][k] = *(const LAS bf16x8*)(lds + PG8_SB(b, h) + boff + n * 2048 + k * 1024); } while (0)
#define PG8_MMA(ai, bj, At, Bt) do { __builtin_amdgcn_s_setprio(1); _Pragma("unroll") for (int m = 0; m < 4; ++m) _Pragma("unroll") for (int n = 0; n < 2; ++n) _Pragma("unroll") for (int k = 0; k < 2; ++k) \
        acc[ai][bj][m][n] = __builtin_amdgcn_mfma_f32_16x16x32_bf16(Bt[n][k], At[m][k], acc[ai][bj][m][n], 0, 0, 0); __builtin_amdgcn_s_setprio(0); } while (0)
#define PG8_WAIT_V(n) asm volatile("s_waitcnt vmcnt(" #n ")" ::: "memory")
#define PG8_WAIT_L(n) asm volatile("s_waitcnt lgkmcnt(" #n ")" ::: "memory")
#define PG8_BAR __builtin_amdgcn_s_barrier()
#define PG8_SCHED __builtin_amdgcn_sched_barrier(0)
#define PG8_ABASE(u) ((const char*)g.A + (size_t)(u).pm * (2 * hstepA) + (size_t)(((u).pn >> g.kshift) * g.kmul) * 2)
#define PG8_BBASE(u) ((const char*)g.Bt + (size_t)(u).pn * (2 * hstepB))
    Unit cur, nxt; int ui = 0;
    if (!S.next(0, cur)) return;
    f32x4 acc[2][2][4][2];
#pragma unroll
    for (int a = 0; a < 2; ++a)
#pragma unroll
        for (int b = 0; b < 2; ++b)
#pragma unroll
            for (int m = 0; m < 4; ++m)
#pragma unroll
                for (int n = 0; n < 2; ++n) acc[a][b][m][n] = (f32x4){0.f, 0.f, 0.f, 0.f};
    bf16x8 At[4][2], B0[2][2], B1[2][2];
    const char* cA = PG8_ABASE(cur); const char* cB = PG8_BBASE(cur);
    PG8_STAGE(PG8_SB(0, 0), cB, voffB); PG8_STAGE(PG8_SB(0, 1), cB + hstepB, voffB); PG8_STAGE(PG8_SA(0, 0), cA, voffA); PG8_STAGE(PG8_SA(0, 1), cA + hstepA, voffA);
    if (wr == 1) PG8_BAR;
    PG8_WAIT_V(2); PG8_BAR;
    PG8_STAGE(PG8_SB(1, 0), cB + kstep, voffB); PG8_STAGE(PG8_SA(1, 0), cA + kstep, voffA); PG8_STAGE(PG8_SB(1, 1), cB + hstepB + kstep, voffB);
    PG8_WAIT_V(6); PG8_BAR;
    for (;;) {
        const bool has_next = S.next(ui + 1, nxt);
        const char* nA = has_next ? PG8_ABASE(nxt) : cA; const char* nB = has_next ? PG8_BBASE(nxt) : cB;
        for (int t = 0; t < nt; t += 2) {
            const bool last = (t == nt - 2);
            const char* a1 = cA + (size_t)(t + 1) * kstep;
            const char* a2 = last ? nA : cA + (size_t)(t + 2) * kstep; const char* b2 = last ? nB : cB + (size_t)(t + 2) * kstep;
            const char* a3 = a2 + kstep; const char* b3 = b2 + kstep;
            PG8_LDB(B0, 0, 0); PG8_LDB(B1, 0, 1); PG8_SCHED; PG8_LDA(At, 0, 0); PG8_STAGE(PG8_SA(1, 1), a1 + hstepA, voffA);
            PG8_WAIT_V(8); PG8_WAIT_L(0); PG8_BAR; PG8_MMA(0, 0, At, B0); PG8_MMA(0, 1, At, B1); PG8_BAR; PG8_SCHED;
            PG8_LDA(At, 0, 1); PG8_STAGE(PG8_SB(0, 0), b2, voffB); PG8_STAGE(PG8_SB(0, 1), b2 + hstepB, voffB); PG8_STAGE(PG8_SA(0, 0), a2, voffA);
            PG8_WAIT_V(8); PG8_WAIT_L(0); PG8_BAR; PG8_MMA(1, 0, At, B0); PG8_MMA(1, 1, At, B1); PG8_BAR; PG8_SCHED;
            PG8_LDB(B0, 1, 0); PG8_LDB(B1, 1, 1); PG8_SCHED; PG8_LDA(At, 1, 0); PG8_STAGE(PG8_SA(0, 1), a2 + hstepA, voffA);
            PG8_WAIT_V(8); PG8_WAIT_L(0); PG8_BAR; PG8_MMA(0, 0, At, B0); PG8_MMA(0, 1, At, B1); PG8_BAR; PG8_SCHED;
            PG8_LDA(At, 1, 1); PG8_STAGE(PG8_SB(1, 0), b3, voffB); PG8_STAGE(PG8_SB(1, 1), b3 + hstepB, voffB); PG8_STAGE(PG8_SA(1, 0), a3, voffA);
            PG8_WAIT_V(8); PG8_WAIT_L(0); PG8_BAR; PG8_MMA(1, 0, At, B0); PG8_MMA(1, 1, At, B1); PG8_BAR; PG8_SCHED;
        }
        if (wr == 0) PG8_BAR;
        E(acc, cur, wr, wc, fr, fq);
        if (!has_next) break;
#pragma unroll
        for (int a = 0; a < 2; ++a)
#pragma unroll
            for (int b = 0; b < 2; ++b)
#pragma unroll
                for (int m = 0; m < 4; ++m)
#pragma unroll
                    for (int n = 0; n < 2; ++n) acc[a][b][m][n] = (f32x4){0.f, 0.f, 0.f, 0.f};
        cur = nxt; cA = nA; cB = nB; ++ui;
        if (wr == 1) PG8_BAR;
    }
    PG8_WAIT_V(0);
    PG8_BAR;
#undef PG8_SA
#undef PG8_SB
#undef PG8_STAGE
#undef PG8_LDA
#undef PG8_LDB
#undef PG8_MMA
#undef PG8_WAIT_V
#undef PG8_WAIT_L
#undef PG8_BAR
#undef PG8_SCHED
#undef PG8_ABASE
#undef PG8_BBASE
}
}
namespace pg8 {
#define EPI_ROWS(expr_row) for (int ai = 0; ai < 2; ++ai) for (int m = 0; m < 4; ++m)
struct EpiBf16 {
    static constexpr bool PERM = true;
    bf16_t* O; int ldc;
    __device__ __forceinline__ void operator()(const f32x4 (&acc)[2][2][4][2], const Unit& u, int wr, int wc, int fr, int fq) const {
        const int row0 = u.pm * BM + wr * 64 + fr, col0 = u.pn * BM + wc * 32 + 8 * fq;
#pragma unroll
        for (int ai = 0; ai < 2; ++ai)
#pragma unroll
            for (int m = 0; m < 4; ++m) { bf16_t* rowp = O + (size_t)(row0 + ai * HALF + m * 16) * ldc + col0;
#pragma unroll
                for (int bj = 0; bj < 2; ++bj) { const f32x4 v0 = acc[ai][bj][m][0], v1 = acc[ai][bj][m][1];
                    u32x4 w; w.x = cvt_pk_bf16(v0[0], v0[1]); w.y = cvt_pk_bf16(v0[2], v0[3]); w.z = cvt_pk_bf16(v1[0], v1[1]); w.w = cvt_pk_bf16(v1[2], v1[3]);
                    *(u32x4*)(rowp + bj * HALF) = w; } }
    }
};
struct EpiZ {
    static constexpr bool PERM = true;
    bf16_t* GG; bf16_t* REC; bf16_t* POOL;
    __device__ __forceinline__ void operator()(const f32x4 (&acc)[2][2][4][2], const Unit& u, int wr, int wc, int fr, int fq) const {
        const int t = u.pn >> 2; bf16_t* base = GG + (size_t)t * ((size_t)MT * 1024);
        const int row0 = u.pm * BM + wr * 64 + fr, col0 = (u.pn & 3) * BM + wc * 32 + 8 * fq;
#pragma unroll
        for (int ai = 0; ai < 2; ++ai)
#pragma unroll
            for (int m = 0; m < 4; ++m) { bf16_t* rowp = base + (size_t)(row0 + ai * HALF + m * 16) * 1024 + col0;
#pragma unroll
                for (int bj = 0; bj < 2; ++bj) { f32x4 v0 = acc[ai][bj][m][0], v1 = acc[ai][bj][m][1];
                    if (t == 0) {
#pragma unroll
                        for (int j = 0; j < 4; ++j) { v0[j] = gelu_tanh(v0[j]); v1[j] = gelu_tanh(v1[j]); } }
                    u32x4 w; w.x = cvt_pk_bf16(v0[0], v0[1]); w.y = cvt_pk_bf16(v0[2], v0[3]); w.z = cvt_pk_bf16(v1[0], v1[1]); w.w = cvt_pk_bf16(v1[2], v1[3]);
                    *(u32x4*)(rowp + bj * HALF) = w; } }
    }
};
struct EpiGate {
    static constexpr bool PERM = false;
    const bf16_t* XC; const float* gp; float* Aout;
    __device__ __forceinline__ void operator()(const f32x4 (&acc)[2][2][4][2], const Unit& u, int wr, int wc, int fr, int fq) const {
        const int row0 = u.pm * BM + wr * 64 + fr, ch0 = u.pn * 128 + wc * 32 + 4 * fq;
#pragma unroll
        for (int n = 0; n < 2; ++n) {
            const f32x4 bav = *(const f32x4*)(gp + ch0 + 16 * n), bxv = *(const f32x4*)(gp + 1024 + ch0 + 16 * n), spv = *(const f32x4*)(gp + 2048 + ch0 + 16 * n);
#pragma unroll
            for (int ai = 0; ai < 2; ++ai)
#pragma unroll
                for (int m = 0; m < 4; ++m) { const int row = row0 + ai * HALF + m * 16; const bool pos0 = (row < MP) && ((row & 16383) == 0);
                    const size_t off = (size_t)row * 1024 + ch0 + 16 * n;
                    const u32x2 xw = *(const u32x2*)(XC + off); const float xc[4] = {bf_lo(xw.x), bf_hi(xw.x), bf_lo(xw.y), bf_hi(xw.y)};
                    f32x4 av, uv;
#pragma unroll
                    for (int j = 0; j < 4; ++j) { const float r = fsigmoid(acc[ai][0][m][n][j] + bav[j]), ig = fsigmoid(acc[ai][1][m][n][j] + bxv[j]);
                        const float log_a = -8.0f * r * spv[j]; const float a = fexp(log_a); const float mult = pos0 ? 1.0f : __builtin_sqrtf(fmaxf(1.0f - a * a, 0.0f));
                        av[j] = a; uv[j] = mult * ig * xc[j]; }
                    *(f32x4*)(Aout + off) = av; { u32x2 uw; uw.x = cvt_pk_bf16(uv[0], uv[1]); uw.y = cvt_pk_bf16(uv[2], uv[3]); *(u32x2*)((bf16_t*)(Aout + (size_t)MT * 1024) + off) = uw; } asm volatile("" ::: "memory"); }
        }
    }
};
struct EpiPool {
    static constexpr bool PERM = true;
    bf16_t* CAT; const float* spool;
    __device__ __forceinline__ void operator()(const f32x4 (&acc)[2][2][4][2], const Unit& u, int wr, int wc, int fr, int fq) const {
        const int row0 = u.pm * BM + wr * 64 + fr, col0 = u.pn * BM + wc * 32 + 8 * fq;
        f32x4 s0[2], s1[2];
#pragma unroll
        for (int bj = 0; bj < 2; ++bj) { s0[bj] = *(const f32x4*)(spool + col0 + bj * HALF); s1[bj] = *(const f32x4*)(spool + col0 + bj * HALF + 4); }
#pragma unroll
        for (int ai = 0; ai < 2; ++ai)
#pragma unroll
            for (int m = 0; m < 4; ++m) { bf16_t* rowp = CAT + (size_t)(row0 + ai * HALF + m * 16) * 2048 + 1024 + col0;
#pragma unroll
                for (int bj = 0; bj < 2; ++bj) { const f32x4 v0 = acc[ai][bj][m][0] * s0[bj], v1 = acc[ai][bj][m][1] * s1[bj];
                    u32x4 w; w.x = cvt_pk_bf16(v0[0], v0[1]); w.y = cvt_pk_bf16(v0[2], v0[3]); w.z = cvt_pk_bf16(v1[0], v1[1]); w.w = cvt_pk_bf16(v1[2], v1[3]);
                    *(u32x4*)(rowp + bj * HALF) = w; } }
    }
};
struct EpiResid {
    static constexpr bool PERM = false;
    const float* xinP; const float* xinS; float* xout; const float* gate;
    __device__ __forceinline__ void operator()(const f32x4 (&acc)[2][2][4][2], const Unit& u, int wr, int wc, int fr, int fq) const {
        const int row0 = u.pm * BM + wr * 64 + fr, col0 = u.pn * BM + wc * 32 + 4 * fq;
#pragma unroll
        for (int ai = 0; ai < 2; ++ai)
#pragma unroll
            for (int m = 0; m < 4; ++m) { const int row = row0 + ai * HALF + m * 16; const float* gp = gate + (size_t)seq_of_row(row) * 12288 + col0;
                const float* xi = (row < MP ? xinP + (size_t)row * DM : xinS + (size_t)(row - MP) * DM) + col0; float* xo = xout + (size_t)row * DM + col0;
#pragma unroll
                for (int bj = 0; bj < 2; ++bj)
#pragma unroll
                    for (int n = 0; n < 2; ++n) { const int o = bj * HALF + n * 16; *(f32x4*)(xo + o) = *(const f32x4*)(xi + o) + *(const f32x4*)(gp + o) * acc[ai][bj][m][n]; }
                asm volatile("" ::: "memory"); }
    }
};
struct EpiF32 {
    static constexpr bool PERM = false;
    float* C; int ldc;
    __device__ __forceinline__ void operator()(const f32x4 (&acc)[2][2][4][2], const Unit& u, int wr, int wc, int fr, int fq) const {
        const int row0 = u.pm * BM + wr * 64 + fr, col0 = u.pn * BM + wc * 32 + 4 * fq;
#pragma unroll
        for (int ai = 0; ai < 2; ++ai)
#pragma unroll
            for (int m = 0; m < 4; ++m) { float* rowp = C + (size_t)(row0 + ai * HALF + m * 16) * ldc + col0;
#pragma unroll
                for (int bj = 0; bj < 2; ++bj)
#pragma unroll
                    for (int n = 0; n < 2; ++n) *(f32x4*)(rowp + bj * HALF + n * 16) = acc[ai][bj][m][n]; }
    }
};
struct EpiQ {
    static constexpr bool PERM = true;
    static constexpr float QS = 0.07216878364870322f * 1.4426950408889634f;
    bf16_t* Qn; bf16_t* Qp; const float* rope;
    __device__ __forceinline__ void operator()(const f32x4 (&acc)[2][2][4][2], const Unit& u, int wr, int wc, int fr, int fq) const {
        const int row0 = u.pm * BM + wr * 64 + fr;
        if (u.pn < 8) {
            const int col0 = u.pn * BM + wc * 32 + 8 * fq;
#pragma unroll
            for (int ai = 0; ai < 2; ++ai)
#pragma unroll
                for (int m = 0; m < 4; ++m) { bf16_t* rowp = Qn + (size_t)(row0 + ai * HALF + m * 16) * 2048 + col0;
#pragma unroll
                    for (int bj = 0; bj < 2; ++bj) { const f32x4 v0 = acc[ai][bj][m][0] * QS, v1 = acc[ai][bj][m][1] * QS;
                        u32x4 w; w.x = cvt_pk_bf16(v0[0], v0[1]); w.y = cvt_pk_bf16(v0[2], v0[3]); w.z = cvt_pk_bf16(v1[0], v1[1]); w.w = cvt_pk_bf16(v1[2], v1[3]);
                        *(u32x4*)(rowp + bj * HALF) = w; } }
        } else {
            const int head = (u.pn - 8) * 4 + wc, j0 = 8 * fq;
#pragma unroll
            for (int ai = 0; ai < 2; ++ai)
#pragma unroll
                for (int m = 0; m < 4; ++m) { const int row = row0 + ai * HALF + m * 16; const float* rp = rope + (size_t)pos_of_row(row) * 64 + j0;
                    const f32x4 c0 = *(const f32x4*)(rp), c1 = *(const f32x4*)(rp + 4), s0 = *(const f32x4*)(rp + 32), s1 = *(const f32x4*)(rp + 36);
                    const f32x4 x10 = acc[ai][0][m][0] * QS, x11 = acc[ai][0][m][1] * QS, x20 = acc[ai][1][m][0] * QS, x21 = acc[ai][1][m][1] * QS;
                    const f32x4 a0 = x10 * c0 - x20 * s0, a1 = x11 * c1 - x21 * s1, b0 = x10 * s0 + x20 * c0, b1 = x11 * s1 + x21 * c1;
                    bf16_t* qp = Qp + (size_t)row * 1024 + head * 64 + j0;
                    u32x4 w; w.x = cvt_pk_bf16(a0[0], a0[1]); w.y = cvt_pk_bf16(a0[2], a0[3]); w.z = cvt_pk_bf16(a1[0], a1[1]); w.w = cvt_pk_bf16(a1[2], a1[3]); *(u32x4*)qp = w;
                    w.x = cvt_pk_bf16(b0[0], b0[1]); w.y = cvt_pk_bf16(b0[2], b0[3]); w.z = cvt_pk_bf16(b1[0], b1[1]); w.w = cvt_pk_bf16(b1[2], b1[3]); *(u32x4*)(qp + 32) = w; }
        }
    }
};
struct EpiKV {
    static constexpr bool PERM = true;
    bf16_t* Kn; bf16_t* V;
    __device__ __forceinline__ void operator()(const f32x4 (&acc)[2][2][4][2], const Unit& u, int wr, int wc, int fr, int fq) const {
        const int row0 = u.pm * BM + wr * 64 + fr, col0 = u.pn * 128 + wc * 32 + 8 * fq;
#pragma unroll
        for (int ai = 0; ai < 2; ++ai)
#pragma unroll
            for (int m = 0; m < 4; ++m) { const size_t off = (size_t)(row0 + ai * HALF + m * 16) * 2048 + col0;
#pragma unroll
                for (int bj = 0; bj < 2; ++bj) { const f32x4 v0 = acc[ai][bj][m][0], v1 = acc[ai][bj][m][1];
                    u32x4 w; w.x = cvt_pk_bf16(v0[0], v0[1]); w.y = cvt_pk_bf16(v0[2], v0[3]); w.z = cvt_pk_bf16(v1[0], v1[1]); w.w = cvt_pk_bf16(v1[2], v1[3]);
                    *(u32x4*)((bj ? V : Kn) + off) = w; } }
    }
};
#undef EPI_ROWS
}

#define XB_TMO      128
#define XB_XCNT(j)  (256  + 64 * (j))
#define XB_XSUB(j)  (1280 + 64 * (j))
#define XB_XGEN(j)  (2304 + 64 * (j))
#define XB_TOP      3328
#define XB_TOPGEN   3392
#define XCD_BAR_WORDS 3456
#define XB_SPIN_CAP (1u << 18)
__device__ __forceinline__ unsigned xb_ld(unsigned* p)              { return __hip_atomic_load(p, __ATOMIC_RELAXED, __HIP_MEMORY_SCOPE_AGENT); }
__device__ __forceinline__ unsigned xb_add(unsigned* p, unsigned v) { return __hip_atomic_fetch_add(p, v, __ATOMIC_RELAXED, __HIP_MEMORY_SCOPE_AGENT); }
__device__ __forceinline__ unsigned xb_xcc_id() { return (unsigned)__builtin_amdgcn_s_getreg((3 << 11) | 20) & 0xFu; }
#define XB_SPIN(cond, bar) do { unsigned _sp = 0; while (cond) { __builtin_amdgcn_s_sleep(1); \
    if ((++_sp & 255u) == 0u) { if (xb_ld(&(bar)[XB_TMO])) break; if (_sp > XB_SPIN_CAP) { atomicAdd(&(bar)[XB_TMO], 1u); break; } } } } while (0)
struct XcdBarrier { unsigned* bar; unsigned x; volatile LAS unsigned* st; };
__device__ __forceinline__ XcdBarrier xcd_barrier_post(unsigned* bar, volatile LAS unsigned* st) {
    XcdBarrier b; b.bar = bar; b.x = xb_xcc_id(); b.st = st;
    if (threadIdx.x == 0) (void)xb_add(&bar[XB_XCNT(b.x)], 1u);
    return b;
}
__device__ __forceinline__ void xcd_barrier_complete(unsigned* bar, unsigned x, unsigned& nloc, unsigned& nx) {
    const unsigned G = gridDim.x * gridDim.y * gridDim.z;
    unsigned sum, cnt, mine, sp = 0u;
    for (;;) {
        sum = 0u; cnt = 0u; mine = 0u;
#pragma unroll
        for (unsigned j = 0; j < 16; ++j) { const unsigned c = xb_ld(&bar[XB_XCNT(j)]); sum += c; cnt += (c > 0u) ? 1u : 0u; mine = (j == x) ? c : mine; }
        if (sum == G) break;
        __builtin_amdgcn_s_sleep(1);
        if ((++sp & 255u) == 0u) { if (xb_ld(&bar[XB_TMO])) break; if (sp > XB_SPIN_CAP) { atomicAdd(&bar[XB_TMO], 1u); break; } }
    }
    nloc = mine > 0u ? mine : 1u; nx = cnt > 0u ? cnt : 1u;
}
__device__ __forceinline__ void xcd_barrier(const XcdBarrier& b) {
    asm volatile("s_waitcnt vmcnt(0)" ::: "memory");
    __syncthreads();
    if (threadIdx.x == 0) {
        unsigned* bar = b.bar;
        __builtin_amdgcn_s_waitcnt(0);
        unsigned nloc = b.st[0], nx = b.st[1];
        if (nloc == 0u) { xcd_barrier_complete(bar, b.x, nloc, nx); b.st[0] = nloc; b.st[1] = nx; }
        const unsigned old = xb_add(&bar[XB_XSUB(b.x)], 1u);
        const unsigned gen = old / nloc;
        if (old + 1u == (gen + 1u) * nloc) {
            __builtin_amdgcn_fence(__ATOMIC_RELEASE, "agent");
            asm volatile("s_waitcnt vmcnt(0)" ::: "memory");
            const unsigned og = xb_add(&bar[XB_TOP], 1u);
            const unsigned tg = og / nx;
            if (og + 1u == (tg + 1u) * nx) xb_add(&bar[XB_TOPGEN], 1u);
            else XB_SPIN(xb_ld(&bar[XB_TOPGEN]) == tg, bar);
            __builtin_amdgcn_fence(__ATOMIC_ACQUIRE, "agent");
            xb_add(&bar[XB_XGEN(b.x)], 1u);
            asm volatile("s_waitcnt vmcnt(0)" ::: "memory");
        } else {
            XB_SPIN(xb_ld(&bar[XB_XGEN(b.x)]) == gen, bar);
            __builtin_amdgcn_fence(__ATOMIC_ACQUIRE, "agent");
            asm volatile("s_waitcnt vmcnt(0)" ::: "memory");
        }
    }
    __syncthreads();
}
constexpr float U8_SCALE = 256.0f, V8_SCALE = 16.0f;
__device__ __forceinline__ void convert_fp8_range(const float* src, unsigned char* dst, float scale, size_t n16, size_t i0, size_t stride) {
    for (size_t i = i0; i < n16; i += stride) { u32x4 w;
#pragma unroll
        for (int q = 0; q < 4; ++q) { f32x4 a = *(const f32x4*)(src + i * 16 + 4 * q) * scale;
#pragma unroll
            for (int j = 0; j < 4; ++j) a[j] = fminf(fmaxf(a[j], -448.0f), 448.0f);
            int t = 0; t = __builtin_amdgcn_cvt_pk_fp8_f32(a[0], a[1], t, false); t = __builtin_amdgcn_cvt_pk_fp8_f32(a[2], a[3], t, true); w[q] = (unsigned)t; }
        *(u32x4*)(dst + i * 16) = w; }
}
constexpr float U4_SCALE = 90.50966799f, V4_SCALE = 8.0f;
__device__ __forceinline__ void convert_fp4_rows(const float* src, unsigned char* dst, float scale, int nrows, int w0, int wstride, int lane) {
    for (int r = w0; r < nrows; r += wstride) { const float* sr = src + (size_t)r * 2048 + 4 * lane; u32x4 w;
        f32x4 a[8];
#pragma unroll
        for (int b = 0; b < 8; ++b) a[b] = *(const f32x4*)(sr + 256 * b) * scale;
#pragma unroll
        for (int q = 0; q < 4; ++q) { float e[8] = {a[2 * q][0], a[2 * q][1], a[2 * q][2], a[2 * q][3], a[2 * q + 1][0], a[2 * q + 1][1], a[2 * q + 1][2], a[2 * q + 1][3]};
#pragma unroll
            for (int j = 0; j < 8; ++j) e[j] = fminf(fmaxf(e[j], -6.0f), 6.0f);
            unsigned t = 0u; t = __builtin_amdgcn_cvt_scalef32_pk_fp4_f32(t, e[0], e[1], 1.0f, 0); t = __builtin_amdgcn_cvt_scalef32_pk_fp4_f32(t, e[2], e[3], 1.0f, 1);
            t = __builtin_amdgcn_cvt_scalef32_pk_fp4_f32(t, e[4], e[5], 1.0f, 2); t = __builtin_amdgcn_cvt_scalef32_pk_fp4_f32(t, e[6], e[7], 1.0f, 3); w[q] = t; }
        *(u32x4*)(dst + (size_t)r * 1024 + 16 * lane) = w; }
}
constexpr size_t MiB = (size_t)1 << 20;
constexpr size_t WS_CTL = 0, WS_WGATE = 1 * MiB, WS_WDQKV = 2 * MiB, WS_ZERO_BYTES = 6 * MiB;
constexpr size_t WS_WIN = 6 * MiB, WS_WOUTR = 18 * MiB, WS_WQ = 26 * MiB, WS_WUQ = 42 * MiB, WS_WUKV = 45 * MiB, WS_WOUTA = 47 * MiB;
constexpr size_t WS_WPOOL = 55 * MiB, WS_KEYS = 56 * MiB, WS_MOD = 57 * MiB, WS_ROPE = 61 * MiB, WS_SP = 65 * MiB, WS_SCAN = 66 * MiB;
constexpr size_t WS_U = 73 * MiB, WS_V = 137 * MiB;
constexpr size_t A_HN = 201 * MiB, A_GG = 337 * MiB, A_B2 = 405 * MiB, A_B3 = 541 * MiB, A_B4 = 677 * MiB;
constexpr size_t A_KN = 405 * MiB, A_VV = 669 * MiB, A_KP = 933 * MiB, A_CQ = 942 * MiB, A_CKV = 976 * MiB, WS_END = 1009 * MiB;
constexpr int CW_BAR = 4096;
constexpr size_t SCAN_WORDS = (size_t)544 * 1024;
constexpr size_t O_Y = 0, O_CONV_P = 71303168, O_CONV_S = 71309312, O_H_P = 71407616, O_H_S = 71409664, O_POOL_P = 71442432, O_POOL_S = 71473152,
                 O_CKV = 71964672, O_KPE = 80877568, O_TOTAL = 83105792;
constexpr int LDS_BYTES = 147456, LDS_MISC = 147200;

struct Args { const float* in[36]; float* out; unsigned char* ws; int ph_lo, ph_hi; };

struct Ctx {
    LAS unsigned char* lds; int tid, lane, wave, vcu, G, gw, NGW;
    const float* const* in; float* out; unsigned char* ws;
};

__device__ __forceinline__ void transpose_item(const float* W, int N, int k0, int n0, bf16_t* WT, int dld, int drow0, int dcol0, LAS float* scr, int lane) {
#pragma unroll 8
    for (int i = 0; i < 32; ++i) { const int kk = 2 * i + (lane >> 5); scr[kk * 33 + (lane & 31)] = W[(size_t)(k0 + kk) * N + n0 + (lane & 31)]; }
    asm volatile("s_waitcnt lgkmcnt(0)" ::: "memory");
    const int c = lane & 7;
#pragma unroll
    for (int j = 0; j < 4; ++j) { const int n = (lane >> 3) + 8 * j; const LAS float* s = scr + (8 * c) * 33 + n;
        u32x4 o; o.x = cvt_pk_bf16(s[0 * 33], s[1 * 33]); o.y = cvt_pk_bf16(s[2 * 33], s[3 * 33]); o.z = cvt_pk_bf16(s[4 * 33], s[5 * 33]); o.w = cvt_pk_bf16(s[6 * 33], s[7 * 33]);
        *(u32x4*)(WT + (size_t)(drow0 + n) * dld + dcol0 + 8 * c) = o; }
    asm volatile("s_waitcnt lgkmcnt(0)" ::: "memory");
}
__device__ __forceinline__ void transpose_mat_item(const float* W, int K, int N, bf16_t* WT, int dld, int drow_base, int dcol_base, int item, LAS float* scr, int lane) {
    const int nblk = N / 32, kb = item / nblk, nb = item % nblk;
    transpose_item(W, N, 64 * kb, 32 * nb, WT, dld, drow_base + 32 * nb, dcol_base + 64 * kb, scr, lane);
}
__device__ __forceinline__ void convert_range(const float* src, bf16_t* dst, size_t n8, size_t i0, size_t stride) {
    for (size_t i = i0; i < n8; i += stride) { const f32x4 a = *(const f32x4*)(src + i * 8), b = *(const f32x4*)(src + i * 8 + 4);
        u32x4 w; w.x = cvt_pk_bf16(a[0], a[1]); w.y = cvt_pk_bf16(a[2], a[3]); w.z = cvt_pk_bf16(b[0], b[1]); w.w = cvt_pk_bf16(b[2], b[3]);
        *(u32x4*)(dst + i * 8) = w; }
}

__device__ __forceinline__ void ada_item(const Ctx& C, int item) {
    const int l = item / 96, nb = item % 96, n0 = nb * 128, w = C.wave, lane = C.lane;
    const float* cP = C.in[2]; const float* cS = C.in[3]; const float* W = C.in[9] + (size_t)l * 2048 * 12288 + n0 + 2 * lane; const float* bias = C.in[10] + (size_t)l * 12288 + n0;
    LAS float* scr = (LAS float*)(C.lds + w * 4608);
    LAS float* sum = (LAS float*)(C.lds + 36864);
    f32x2 acc[34];
#pragma unroll
    for (int s = 0; s < 34; ++s) acc[s] = (f32x2){0.f, 0.f};
    for (int sub = 0; sub < 8; ++sub) {
        const int k0 = 256 * w + 32 * sub;
#pragma unroll
        for (int i = 0; i < 17; ++i) { const int idx = lane + 64 * i, s = idx >> 5, kk = idx & 31;
            const float cv = (s < 2) ? cP[s * 2048 + k0 + kk] : cS[(s - 2) * 2048 + k0 + kk];
            scr[kk * 36 + s] = cv * fsigmoid(cv); }
        asm volatile("s_waitcnt lgkmcnt(0)" ::: "memory");
#pragma unroll 1
        for (int kq = 0; kq < 2; ++kq) {
            f32x2 wv[16];
#pragma unroll
            for (int kk = 0; kk < 16; ++kk) wv[kk] = *(const f32x2*)(W + (size_t)(k0 + 16 * kq + kk) * 12288);
#pragma unroll
            for (int kk = 0; kk < 16; ++kk) {
#pragma unroll
                for (int s4 = 0; s4 < 9; ++s4) { const f32x4 sv = *(const LAS f32x4*)(scr + (16 * kq + kk) * 36 + 4 * s4);
#pragma unroll
                    for (int i = 0; i < 4; ++i) if (4 * s4 + i < 34) acc[4 * s4 + i] += wv[kk] * sv[i]; }
                asm volatile("" ::: "memory");
            }
        }
        asm volatile("s_waitcnt lgkmcnt(0)" ::: "memory");
    }
    for (int ww = 0; ww < 8; ++ww) {
        if (w == ww) {
#pragma unroll
            for (int s = 0; s < 34; ++s) { LAS f32x2* p = (LAS f32x2*)(sum + s * 128) + lane; if (ww == 0) *p = acc[s]; else *p = *p + acc[s]; }
        }
        __syncthreads();
    }
    float* mod = (float*)(C.ws + WS_MOD);
    for (int s = w; s < 34; s += 8) { const f32x2 v = *((LAS f32x2*)(sum + s * 128) + lane) + *(const f32x2*)(bias + 2 * lane);
        *(f32x2*)(mod + ((size_t)l * NSEQ + s) * 12288 + n0 + 2 * lane) = v; }
    __syncthreads();
}

namespace bq {
constexpr int I_IN = 32 * 96, I_GATE = 16 * 8, I_POOL = 4 * 32, I_OUTR = 32 * 64, I_Q = 32 * 64, I_KEYS = 256, I_TAB = 16384  , I_DQ = 32 * 16, I_DKV = 32 * 10,
              I_ROPE = 1024, I_UQ = 8 * 96, I_UKV = 4 * 128, I_OUTA = 32 * 64;
constexpr int E_IN = I_IN, E_GATE = E_IN + I_GATE, E_POOL = E_GATE + I_POOL, E_OUTR = E_POOL + I_OUTR, E_Q0 = E_OUTR + I_Q, E_KEYS = E_Q0 + I_KEYS, E_TAB0 = E_KEYS + I_TAB, E_DQ = E_TAB0 + I_DQ,
              E_DKV = E_DQ + I_DKV, E_ROPE = E_DKV + I_ROPE, E_UQ = E_ROPE + I_UQ, E_UKV = E_UQ + I_UKV, E_OUTA = E_UKV + I_OUTA, E_Q1 = E_OUTA + I_Q, E_TAB1 = E_Q1 + I_TAB, NTOT = E_TAB1;
static_assert(NTOT % 8 == 0 && E_IN % 8 == 0 && E_POOL % 8 == 0 && E_OUTR % 8 == 0 && E_Q0 % 8 == 0 && E_KEYS % 8 == 0 && E_TAB0 % 8 == 0 && E_DKV % 8 == 0 && E_ROPE % 8 == 0 && E_UKV % 8 == 0 && E_OUTA % 8 == 0 && E_Q1 % 8 == 0, "queue segments are whole workgroup items");
constexpr int CW_QHEAD = 64, CW_DONE = 128;
constexpr int LDS_SLOT = LDS_MISC + 32;
constexpr size_t TAB_L1 = 16 * MiB;

__device__ __forceinline__ void fp4_row_pair(const float* src, unsigned char* dst, float scale, int r0, int lane) {
    f32x4 a[16];
#pragma unroll
    for (int b = 0; b < 16; ++b) a[b] = *(const f32x4*)(src + (size_t)(r0 + (b >> 3)) * 2048 + 4 * lane + 256 * (b & 7)) * scale;
#pragma unroll
    for (int rr = 0; rr < 2; ++rr) { u32x4 w;
#pragma unroll
        for (int q = 0; q < 4; ++q) { float e[8] = {a[8 * rr + 2 * q][0], a[8 * rr + 2 * q][1], a[8 * rr + 2 * q][2], a[8 * rr + 2 * q][3], a[8 * rr + 2 * q + 1][0], a[8 * rr + 2 * q + 1][1], a[8 * rr + 2 * q + 1][2], a[8 * rr + 2 * q + 1][3]};
#pragma unroll
            for (int j = 0; j < 8; ++j) e[j] = fminf(fmaxf(e[j], -6.0f), 6.0f);
            unsigned t = 0u; t = __builtin_amdgcn_cvt_scalef32_pk_fp4_f32(t, e[0], e[1], 1.0f, 0); t = __builtin_amdgcn_cvt_scalef32_pk_fp4_f32(t, e[2], e[3], 1.0f, 1);
            t = __builtin_amdgcn_cvt_scalef32_pk_fp4_f32(t, e[4], e[5], 1.0f, 2); t = __builtin_amdgcn_cvt_scalef32_pk_fp4_f32(t, e[6], e[7], 1.0f, 3); w[q] = t; }
        *(u32x4*)(dst + (size_t)(r0 + rr) * 1024 + 16 * lane) = w; }
}
__device__ __forceinline__ void table_item(const Ctx& C, int layer, int r, int lane) {
    const int t = r >> 13, rp = r & 8191;
    const float* src = (t ? C.in[34] : C.in[33]) + (size_t)layer * 16384 * 2048; unsigned char* dst = C.ws + (t ? WS_V : WS_U) + (size_t)layer * TAB_L1;
    fp4_row_pair(src, dst, t ? V4_SCALE : U4_SCALE, 2 * rp, lane);
}
__device__ __forceinline__ void wave_item(const Ctx& C, int it, LAS float* scr, int lane) {
    bf16_t* w_in = (bf16_t*)(C.ws + WS_WIN); bf16_t* w_outr = (bf16_t*)(C.ws + WS_WOUTR); bf16_t* w_q = (bf16_t*)(C.ws + WS_WQ);
    bf16_t* w_dqkv = (bf16_t*)(C.ws + WS_WDQKV); bf16_t* w_uq = (bf16_t*)(C.ws + WS_WUQ); bf16_t* w_ukv = (bf16_t*)(C.ws + WS_WUKV);
    bf16_t* w_outa = (bf16_t*)(C.ws + WS_WOUTA); bf16_t* w_gate = (bf16_t*)(C.ws + WS_WGATE); bf16_t* w_pool = (bf16_t*)(C.ws + WS_WPOOL);
    int r = it;
    if (r < I_IN) { transpose_mat_item(C.in[13], 2048, 3072, w_in, 2048, 0, 0, r, scr, lane); return; } r -= I_IN;
    if (r < I_GATE) {
        const int q = r / 8, sub = r % 8, h = q >> 1, gsel = q & 1;
        const float* src = (gsel ? C.in[18] : C.in[16]) + (size_t)h * 128 * 128;
        transpose_mat_item(src, 128, 128, w_gate, 256, h * 256 + gsel * 128, (h & 1) * 128, sub, scr, lane); return; } r -= I_GATE;
    if (r < I_POOL) { const int gq = r / 32, sub = r % 32;
        transpose_mat_item(C.in[21] + (size_t)gq * 256 * 256, 256, 256, w_pool, 256, gq * 256, 0, sub, scr, lane); return; } r -= I_POOL;
    if (r < I_OUTR) { transpose_mat_item(C.in[23], 2048, 2048, w_outr, 2048, 0, 0, r, scr, lane); return; } r -= I_OUTR;
    if (r < I_Q) { transpose_mat_item(C.in[31], 2048, 2048, w_q, 2048, 0, 0, r, scr, lane); return; } r -= I_Q;
    if (r < I_KEYS) { convert_range(C.in[32] + (size_t)r * 2048, (bf16_t*)(C.ws + WS_KEYS) + (size_t)r * 2048, 256, (size_t)lane, 64); return; } r -= I_KEYS;
    if (r < I_TAB) { table_item(C, 0, r, lane); return; } r -= I_TAB;
    if (r < I_DQ) { transpose_mat_item(C.in[24], 2048, 512, w_dqkv, 2048, 0, 0, r, scr, lane); return; } r -= I_DQ;
    if (r < I_DKV) { transpose_mat_item(C.in[27], 2048, 320, w_dqkv, 2048, 512, 0, r, scr, lane); return; } r -= I_DKV;
    if (r < I_ROPE) {
        float* rope = (float*)(C.ws + WS_ROPE);
        for (int q = 0; q < 8; ++q) { const int i = r * 512 + q * 64 + lane, pos = i >> 5, j = i & 31;
            double inv = 1.0; for (int qq = 0; qq < j; ++qq) inv *= 0.7498942093324559;
            const double rev = (double)pos * inv * 0.15915494309189535; const float fr = (float)(rev - __builtin_floor(rev));
            rope[(size_t)pos * 64 + j] = __builtin_amdgcn_cosf(fr); rope[(size_t)pos * 64 + 32 + j] = __builtin_amdgcn_sinf(fr); }
        return; } r -= I_ROPE;
    if (r < I_UQ) {
        const int kb = r / 96, nb = r % 96, n0 = 32 * nb, h = n0 / 192, d = n0 % 192;
        const int drow = (d < 128) ? h * 128 + d : 2048 + (h >> 2) * 256 + ((d - 128) >> 5) * 128 + (h & 3) * 32;
        transpose_item(C.in[26], 3072, 64 * kb, n0, w_uq, 512, drow, 64 * kb, scr, lane); return; } r -= I_UQ;
    if (r < I_UKV) { transpose_mat_item(C.in[29], 256, 4096, w_ukv, 256, 0, 0, r, scr, lane); return; } r -= I_UKV;
    if (r < I_OUTA) { transpose_mat_item(C.in[30], 2048, 2048, w_outa, 2048, 0, 0, r, scr, lane); return; } r -= I_OUTA;
    if (r < I_Q) { transpose_mat_item(C.in[31] + (size_t)2048 * 2048, 2048, 2048, w_q + (size_t)2048 * 2048, 2048, 0, 0, r, scr, lane); return; } r -= I_Q;
    table_item(C, 1, r, lane);
}
__device__ __forceinline__ void service(const Ctx& C, bool fill, int slot, int limit, bool signal = true) {
    unsigned* ctl = (unsigned*)(C.ws + WS_CTL); unsigned* qhead = ctl + CW_QHEAD; unsigned* done = ctl + CW_DONE + slot;
    volatile LAS int* lslot = (volatile LAS int*)(C.lds + LDS_SLOT);
    LAS float* scr = (LAS float*)(C.lds + 72704 + C.wave * 8448);
    __syncthreads();
    if (fill && signal && C.tid == 0) __hip_atomic_fetch_add(done, 1u, __ATOMIC_RELAXED, __HIP_MEMORY_SCOPE_AGENT);
    const unsigned lim = fill ? (unsigned)(NTOT / 8) : (unsigned)(limit / 8);
    for (;;) {
        if (C.tid == 0) { int it = -1;
            const unsigned h = __hip_atomic_load(qhead, __ATOMIC_RELAXED, __HIP_MEMORY_SCOPE_AGENT);
            bool go = h < lim;
            if (go && fill) go = __hip_atomic_load(done, __ATOMIC_RELAXED, __HIP_MEMORY_SCOPE_AGENT) < (unsigned)C.G;
            if (go) { const unsigned t = __hip_atomic_fetch_add(qhead, 1u, __ATOMIC_RELAXED, __HIP_MEMORY_SCOPE_AGENT); if (t < (unsigned)(NTOT / 8)) it = (int)t; }
            *lslot = it; }
        __syncthreads();
        const int it = *lslot;
        __syncthreads();
        if (it < 0) break;
        { Ctx D = C; int ln = C.lane; asm volatile("" : "+v"(ln)); D.lane = ln;
          wave_item(D, it * 8 + C.wave, scr, ln); }
    }
}
}

__device__ __forceinline__ void phase_prologue(const Ctx& C) {
    const int lane = C.lane;
    constexpr int NADA = 192;
    for (int it = C.vcu; it < NADA; it += C.G) ada_item(C, it);
    bq::service(C, true, 0, 0);
    const size_t gt = (size_t)C.vcu * 512 + C.tid, GT = (size_t)C.G * 512;
    { float* sp = (float*)(C.ws + WS_SP);
      for (size_t i = gt; i < 1024; i += GT) { sp[i] = C.in[17][i]; sp[1024 + i] = C.in[19][i]; const float y = fexp(-C.in[20][i]); sp[2048 + i] = (y < 0.03f) ? y * (1.0f - y * (0.5f - y * (0.33333333f - y * (0.25f - 0.2f * y)))) : 0.6931471805599453f * __builtin_amdgcn_logf(1.0f + y); } }
}
__device__ __forceinline__ void norm_mod_row(const float* xrow, const float* g, const float* shift, const float* scale, bf16_t* orow, int lane) {
    f32x4 v[8]; float ss = 0.f;
#pragma unroll
    for (int j = 0; j < 8; ++j) { v[j] = *((const f32x4*)xrow + lane + 64 * j); ss += (v[j].x * v[j].x + v[j].y * v[j].y) + (v[j].z * v[j].z + v[j].w * v[j].w); }
    const float rstd = __builtin_amdgcn_rsqf(wave_sum(ss) * (1.0f / DM) + RMS_EPS);
#pragma unroll
    for (int j = 0; j < 8; ++j) { const int q = lane + 64 * j; const f32x4 gv = *((const f32x4*)g + q), sc = *((const f32x4*)scale + q), sh = *((const f32x4*)shift + q);
        const f32x4 y = v[j] * rstd * gv * (sc + 1.0f) + sh;
        u32x2 w; w.x = cvt_pk_bf16(y.x, y.y); w.y = cvt_pk_bf16(y.z, y.w); *((u32x2*)orow + q) = w; }
}
__device__ __forceinline__ void phase_norm(const Ctx& C, const float* xP, const float* xS, const float* g, const float* modl, int part, bf16_t* hn) {
    const int lane = C.lane; int m = C.gw; if (m >= MT) return;
    f32x4 gv[8];
#pragma unroll
    for (int j = 0; j < 8; ++j) gv[j] = *((const f32x4*)g + lane + 64 * j);
    f32x4 nv[8];
    { const float* xr = (m < MP) ? xP + (size_t)m * DM : xS + (size_t)(m - MP) * DM;
#pragma unroll
      for (int j = 0; j < 8; ++j) nv[j] = *((const f32x4*)xr + lane + 64 * j); }
    for (; m < MT; m += C.NGW) {
        f32x4 v[8];
#pragma unroll
        for (int j = 0; j < 8; ++j) v[j] = nv[j];
        const int mn = m + C.NGW;
        if (mn < MT) { const float* xr = (mn < MP) ? xP + (size_t)mn * DM : xS + (size_t)(mn - MP) * DM;
#pragma unroll
            for (int j = 0; j < 8; ++j) nv[j] = *((const f32x4*)xr + lane + 64 * j); }
        const float* mp = modl + (size_t)seq_of_row(m) * 12288 + part * 2048;
        f32x4 sc[8], sh[8];
#pragma unroll
        for (int j = 0; j < 8; ++j) { const int q = lane + 64 * j; sh[j] = *((const f32x4*)mp + q); sc[j] = *((const f32x4*)(mp + 2048) + q); }
        float ss = 0.f;
#pragma unroll
        for (int j = 0; j < 8; ++j) ss += (v[j].x * v[j].x + v[j].y * v[j].y) + (v[j].z * v[j].z + v[j].w * v[j].w);
        const float rstd = __builtin_amdgcn_rsqf(wave_sum(ss) * (1.0f / DM) + RMS_EPS);
#pragma unroll
        for (int j = 0; j < 8; ++j) { const int q = lane + 64 * j; const f32x4 y = v[j] * rstd * gv[j] * (sc[j] + 1.0f) + sh[j];
            u32x2 w; w.x = cvt_pk_bf16(y.x, y.y); w.y = cvt_pk_bf16(y.z, y.w); *((u32x2*)(hn + (size_t)m * DM) + q) = w; }
    }
}
__device__ __forceinline__ void phase_resid_norm(const Ctx& C, const float* xP, const float* xS, const bf16_t* mix, float* X, const float* g, const float* modl, bf16_t* hn) {
    const int lane = C.lane; int m = C.gw; if (m >= MT) return;
    f32x4 gv[8];
#pragma unroll
    for (int j = 0; j < 8; ++j) gv[j] = *((const f32x4*)g + lane + 64 * j);
    f32x4 nx[8]; u32x2 nm[8];
    { const float* xr = (m < MP) ? xP + (size_t)m * DM : xS + (size_t)(m - MP) * DM;
#pragma unroll
      for (int j = 0; j < 8; ++j) { const int q = lane + 64 * j; nx[j] = *((const f32x4*)xr + q); nm[j] = *((const u32x2*)(mix + (size_t)m * DM) + q); } }
    for (; m < MT; m += C.NGW) {
        f32x4 v[8]; u32x2 mw[8];
#pragma unroll
        for (int j = 0; j < 8; ++j) { v[j] = nx[j]; mw[j] = nm[j]; }
        const int mn = m + C.NGW;
        if (mn < MT) { const float* xr = (mn < MP) ? xP + (size_t)mn * DM : xS + (size_t)(mn - MP) * DM;
#pragma unroll
            for (int j = 0; j < 8; ++j) { const int q = lane + 64 * j; nx[j] = *((const f32x4*)xr + q); nm[j] = *((const u32x2*)(mix + (size_t)mn * DM) + q); } }
        const float* mp = modl + (size_t)seq_of_row(m) * 12288;
        float ss = 0.f;
#pragma unroll
        for (int j = 0; j < 8; ++j) { const int q = lane + 64 * j; const f32x4 g1 = *((const f32x4*)(mp + 2 * 2048) + q);
            v[j] = v[j] + g1 * (f32x4){bf_lo(mw[j].x), bf_hi(mw[j].x), bf_lo(mw[j].y), bf_hi(mw[j].y)}; ss += (v[j].x * v[j].x + v[j].y * v[j].y) + (v[j].z * v[j].z + v[j].w * v[j].w);
            *((f32x4*)(X + (size_t)m * DM) + q) = v[j]; }
        const float rstd = __builtin_amdgcn_rsqf(wave_sum(ss) * (1.0f / DM) + RMS_EPS);
#pragma unroll
        for (int j = 0; j < 8; ++j) { const int q = lane + 64 * j; const f32x4 sh = *((const f32x4*)(mp + 3 * 2048) + q), sc = *((const f32x4*)(mp + 4 * 2048) + q);
            const f32x4 y = v[j] * rstd * gv[j] * (sc + 1.0f) + sh;
            u32x2 w; w.x = cvt_pk_bf16(y.x, y.y); w.y = cvt_pk_bf16(y.z, y.w); *((u32x2*)(hn + (size_t)m * DM) + q) = w; }
    }
}

__device__ __forceinline__ void ld8bf(const bf16_t* p, float (&v)[8]) { const u32x4 w = *(const u32x4*)p; v[0] = bf_lo(w.x); v[1] = bf_hi(w.x); v[2] = bf_lo(w.y); v[3] = bf_hi(w.y); v[4] = bf_lo(w.z); v[5] = bf_hi(w.z); v[6] = bf_lo(w.w); v[7] = bf_hi(w.w); }
__device__ __forceinline__ void ld8f(const float* p, float (&v)[8]) { const f32x4 a = *(const f32x4*)p, b = *(const f32x4*)(p + 4); v[0] = a.x; v[1] = a.y; v[2] = a.z; v[3] = a.w; v[4] = b.x; v[5] = b.y; v[6] = b.z; v[7] = b.w; }
__device__ __forceinline__ void st8bf(bf16_t* p, const float (&v)[8]) { u32x4 w; w.x = cvt_pk_bf16(v[0], v[1]); w.y = cvt_pk_bf16(v[2], v[3]); w.z = cvt_pk_bf16(v[4], v[5]); w.w = cvt_pk_bf16(v[6], v[7]); *(u32x4*)p = w; }
__device__ __forceinline__ void st8f(float* p, const float (&v)[8]) { *(f32x4*)p = (f32x4){v[0], v[1], v[2], v[3]}; *(f32x4*)(p + 4) = (f32x4){v[4], v[5], v[6], v[7]}; }

__device__ __forceinline__ void phase_convpool(const Ctx& C) {
    const bf16_t* __restrict__ REC = (const bf16_t*)(C.ws + A_B2); const bf16_t* __restrict__ PIN = REC + (size_t)MT * 1024;
    bf16_t* __restrict__ XC = (bf16_t*)(C.ws + A_B3); bf16_t* __restrict__ POOLED = XC + (size_t)MT * 1024;
    const float* convw = C.in[14]; const float* convb = C.in[15]; const float* st_conv = C.in[4]; const float* st_pool = C.in[6];
    const int NITEM = 2 * 544 * 128;
    for (int it0 = C.vcu * 512 + C.tid; it0 < NITEM; it0 += C.G * 512) {
        const bool is_pool = it0 >= 544 * 128; const int it = is_pool ? it0 - 544 * 128 : it0;
        const int chunk = it >> 7, ch0 = (it & 127) * 8;
        const bool samp = chunk >= 512; const int sb = chunk - 512;
        const int row0 = samp ? MP + sb * 64 : chunk * 64;
        const int t0 = samp ? 0 : (chunk & 255) * 64;
        const bool lastc = samp || ((chunk & 255) == 255);
        if (!is_pool) {
            float w0[8], w1[8], w2[8], w3[8], bb[8], p0[8], p1[8], p2[8];
            ld8f(convw + ch0, w0); ld8f(convw + 1024 + ch0, w1); ld8f(convw + 2048 + ch0, w2); ld8f(convw + 3072 + ch0, w3); ld8f(convb + ch0, bb);
            if (samp) { ld8f(st_conv + ((size_t)sb * 3 + 0) * 1024 + ch0, p0); ld8f(st_conv + ((size_t)sb * 3 + 1) * 1024 + ch0, p1); ld8f(st_conv + ((size_t)sb * 3 + 2) * 1024 + ch0, p2); }
            else if (t0 > 0) { ld8bf(REC + (size_t)(row0 - 3) * 1024 + ch0, p0); ld8bf(REC + (size_t)(row0 - 2) * 1024 + ch0, p1); ld8bf(REC + (size_t)(row0 - 1) * 1024 + ch0, p2); }
            else {
#pragma unroll
                for (int j = 0; j < 8; ++j) { p0[j] = 0.f; p1[j] = 0.f; p2[j] = 0.f; } }
            for (int tb = 0; tb < 64; tb += 8) {
                u32x4 raw[8];
#pragma unroll
                for (int q = 0; q < 8; ++q) raw[q] = *(const u32x4*)(REC + (size_t)(row0 + tb + q) * 1024 + ch0);
#pragma unroll
                for (int q = 0; q < 8; ++q) { const u32x4 w = raw[q]; const float cur[8] = {bf_lo(w.x), bf_hi(w.x), bf_lo(w.y), bf_hi(w.y), bf_lo(w.z), bf_hi(w.z), bf_lo(w.w), bf_hi(w.w)}; float o[8];
#pragma unroll
                    for (int j = 0; j < 8; ++j) { o[j] = bb[j] + w0[j] * p0[j] + w1[j] * p1[j] + w2[j] * p2[j] + w3[j] * cur[j]; p0[j] = p1[j]; p1[j] = p2[j]; p2[j] = cur[j]; }
                    st8bf(XC + (size_t)(row0 + tb + q) * 1024 + ch0, o); } }
            if (lastc) { float* dst = samp ? C.out + O_CONV_S + (size_t)sb * 3 * 1024 : C.out + O_CONV_P + (size_t)(chunk >> 8) * 3 * 1024;
                st8f(dst + ch0, p0); st8f(dst + 1024 + ch0, p1); st8f(dst + 2048 + ch0, p2); }
        } else {
            const int gsel = ch0 >> 8, w = 2 << gsel;
            float S[8];
#pragma unroll
            for (int j = 0; j < 8; ++j) S[j] = 0.f;
            for (int tt = 1 - w; tt < 0; ++tt) { float v[8];
                if (samp) ld8f(st_pool + ((size_t)sb * 15 + 15 + tt) * 1024 + ch0, v);
                else if (t0 + tt >= 0) ld8bf(PIN + (size_t)(row0 + tt) * 1024 + ch0, v);
                else {
#pragma unroll
                    for (int j = 0; j < 8; ++j) v[j] = 0.f; }
#pragma unroll
                for (int j = 0; j < 8; ++j) S[j] += v[j]; }
            for (int tb = 0; tb < 64; tb += 8) {
                u32x4 rawc[8]; float oldv[8][8];
#pragma unroll
                for (int q = 0; q < 8; ++q) rawc[q] = *(const u32x4*)(PIN + (size_t)(row0 + tb + q) * 1024 + ch0);
#pragma unroll
                for (int q = 0; q < 8; ++q) { const int tt = tb + q - w + 1;
                    if (tt >= 0 || (!samp && t0 + tt >= 0)) ld8bf(PIN + (size_t)(row0 + tt) * 1024 + ch0, oldv[q]);
                    else if (samp) ld8f(st_pool + ((size_t)sb * 15 + 15 + tt) * 1024 + ch0, oldv[q]);
                    else {
#pragma unroll
                        for (int j = 0; j < 8; ++j) oldv[q][j] = 0.f; } }
#pragma unroll
                for (int q = 0; q < 8; ++q) { const u32x4 wv = rawc[q]; const float cur[8] = {bf_lo(wv.x), bf_hi(wv.x), bf_lo(wv.y), bf_hi(wv.y), bf_lo(wv.z), bf_hi(wv.z), bf_lo(wv.w), bf_hi(wv.w)}; float o[8];
                    const int pos = samp ? 1024 + tb + q : t0 + tb + q; const float rc = 1.0f / (float)((pos + 1 < w) ? pos + 1 : w);
#pragma unroll
                    for (int j = 0; j < 8; ++j) { S[j] += cur[j]; o[j] = S[j] * rc - cur[j]; S[j] -= oldv[q][j]; }
                    st8bf(POOLED + (size_t)(row0 + tb + q) * 1024 + ch0, o); } }
            if (lastc) { float* dst = samp ? C.out + O_POOL_S + (size_t)sb * 15 * 1024 : C.out + O_POOL_P + (size_t)(chunk >> 8) * 15 * 1024;
                for (int i = 0; i < 15; ++i) { float v[8]; ld8bf(PIN + (size_t)(row0 + 49 + i) * 1024 + ch0, v); st8f(dst + (size_t)i * 1024 + ch0, v); } }
        }
    }
}

__device__ __forceinline__ void phase_scanA(const Ctx& C) {
    const float* __restrict__ A = (const float*)(C.ws + A_B4); const bf16_t* __restrict__ U = (const bf16_t*)(A + (size_t)MT * 1024);
    float* __restrict__ cP = (float*)(C.ws + WS_SCAN); float* __restrict__ cH = cP + SCAN_WORDS;
    for (int it = C.vcu * 512 + C.tid; it < 544 * 256; it += C.G * 512) {
        const int chunk = it >> 8, ch = (it & 255) * 4; const int row0 = chunk * 64;
        f32x4 P = {1.f, 1.f, 1.f, 1.f}, H = {0.f, 0.f, 0.f, 0.f};
        for (int tb = 0; tb < 64; tb += 8) { f32x4 av[8], uv[8];
#pragma unroll
            for (int q = 0; q < 8; ++q) { av[q] = *(const f32x4*)(A + (size_t)(row0 + tb + q) * 1024 + ch); const u32x2 uw = *(const u32x2*)(U + (size_t)(row0 + tb + q) * 1024 + ch); uv[q] = (f32x4){bf_lo(uw.x), bf_hi(uw.x), bf_lo(uw.y), bf_hi(uw.y)}; }
#pragma unroll
            for (int q = 0; q < 8; ++q) { H = av[q] * H + uv[q]; P = P * av[q]; } }
        *(f32x4*)(cP + (size_t)chunk * 1024 + ch) = P; *(f32x4*)(cH + (size_t)chunk * 1024 + ch) = H;
    }
}
__device__ __forceinline__ void phase_scanB(const Ctx& C) {
    const float* __restrict__ cP = (const float*)(C.ws + WS_SCAN); const float* __restrict__ cH = cP + SCAN_WORDS; float* __restrict__ cI = (float*)(C.ws + WS_SCAN) + 2 * SCAN_WORDS;
    const int it = C.vcu * 512 + C.tid;
    if (it < 2048) { const int s = it >> 10, ch = it & 1023; float carry = 0.f;
        for (int cb = 0; cb < 256; cb += 16) { float pv[16], hv[16];
#pragma unroll
            for (int q = 0; q < 16; ++q) { const size_t o = (size_t)(s * 256 + cb + q) * 1024 + ch; pv[q] = cP[o]; hv[q] = cH[o]; }
#pragma unroll
            for (int q = 0; q < 16; ++q) { cI[(size_t)(s * 256 + cb + q) * 1024 + ch] = carry; carry = pv[q] * carry + hv[q]; } } }
}
__device__ __forceinline__ void phase_scanC(const Ctx& C) {
    const float* __restrict__ A = (const float*)(C.ws + A_B4); const bf16_t* __restrict__ U = (const bf16_t*)(A + (size_t)MT * 1024); const float* __restrict__ cI = (const float*)(C.ws + WS_SCAN) + 2 * SCAN_WORDS;
    const bf16_t* __restrict__ GG = (const bf16_t*)(C.ws + A_GG); bf16_t* __restrict__ CAT = (bf16_t*)(C.ws + A_HN); const float* hprev = C.in[5];
    for (int it = C.vcu * 512 + C.tid; it < 544 * 256; it += C.G * 512) {
        const int chunk = it >> 8, ch = (it & 255) * 4; const int row0 = chunk * 64; const bool samp = chunk >= 512;
        f32x4 h = samp ? *(const f32x4*)(hprev + (size_t)(chunk - 512) * 1024 + ch) : *(const f32x4*)(cI + (size_t)chunk * 1024 + ch);
        for (int tb = 0; tb < 64; tb += 8) { f32x4 av[8], uv[8]; u32x2 gv[8];
#pragma unroll
            for (int q = 0; q < 8; ++q) { const size_t o = (size_t)(row0 + tb + q) * 1024 + ch; av[q] = *(const f32x4*)(A + o); { const u32x2 uw = *(const u32x2*)(U + o); uv[q] = (f32x4){bf_lo(uw.x), bf_hi(uw.x), bf_lo(uw.y), bf_hi(uw.y)}; } gv[q] = *(const u32x2*)(GG + o); }
#pragma unroll
            for (int q = 0; q < 8; ++q) { h = av[q] * h + uv[q];
                u32x2 w; w.x = cvt_pk_bf16(bf_lo(gv[q].x) * h.x, bf_hi(gv[q].x) * h.y); w.y = cvt_pk_bf16(bf_lo(gv[q].y) * h.z, bf_hi(gv[q].y) * h.w);
                *(u32x2*)(CAT + (size_t)(row0 + tb + q) * 2048 + ch) = w; } }
        if (samp) *(f32x4*)(C.out + O_H_S + (size_t)(chunk - 512) * 1024 + ch) = h;
        else if ((chunk & 255) == 255) *(f32x4*)(C.out + O_H_P + (size_t)(chunk >> 8) * 1024 + ch) = h;
    }
}

__device__ __forceinline__ void phase_latent(const Ctx& C) {
    const float* CQKV = (const float*)(C.ws + A_B3); bf16_t* CQ = (bf16_t*)(C.ws + A_CQ); bf16_t* CKV = (bf16_t*)(C.ws + A_CKV); bf16_t* KP = (bf16_t*)(C.ws + A_KP);
    const float* gq = C.in[25]; const float* gkv = C.in[28]; const float* rope = (const float*)(C.ws + WS_ROPE); const int lane = C.lane;
    for (int m = C.gw; m < MT; m += C.NGW) {
        const float* r = CQKV + (size_t)m * 1024; const int kvr = kvrow_of_row(m);
        { float v[8]; ld8f(r + lane * 8, v); float ss = 0.f;
#pragma unroll
          for (int j = 0; j < 8; ++j) ss += v[j] * v[j];
          const float rstd = __builtin_amdgcn_rsqf(wave_sum(ss) * (1.0f / 512) + RMS_EPS); float g[8]; ld8f(gq + lane * 8, g);
#pragma unroll
          for (int j = 0; j < 8; ++j) v[j] = v[j] * rstd * g[j];
          st8bf(CQ + (size_t)m * 512 + lane * 8, v); }
        { const f32x4 v = *(const f32x4*)(r + 512 + lane * 4); const float ss = (v.x * v.x + v.y * v.y) + (v.z * v.z + v.w * v.w);
          const float rstd = __builtin_amdgcn_rsqf(wave_sum(ss) * (1.0f / 256) + RMS_EPS); const f32x4 y = v * rstd * *(const f32x4*)(gkv + lane * 4);
          *(f32x4*)(C.out + O_CKV + (size_t)m * 256 + lane * 4) = y;
          u32x2 w; w.x = cvt_pk_bf16(y.x, y.y); w.y = cvt_pk_bf16(y.z, y.w); *(u32x2*)(CKV + (size_t)kvr * 256 + lane * 4) = w; }
        { const float x = r[768 + lane]; const float xo = __shfl_xor(x, 32); const int j = lane & 31; const float* rp = rope + (size_t)pos_of_row(m) * 64;
          const float c = rp[j], s = rp[32 + j]; const float y = (lane < 32) ? x * c - xo * s : xo * s + x * c;
          C.out[O_KPE + (size_t)m * 64 + lane] = y; const unsigned yb = cvt_pk_bf16(y, y); KP[(size_t)kvr * 64 + lane] = (bf16_t)(yb & 0xffffu); }
    }
    const size_t gt = (size_t)C.vcu * 512 + C.tid, GT = (size_t)C.G * 512;
    for (size_t i = gt; i < (size_t)32 * 1024 * 256 / 8; i += GT) { const size_t e = i * 8, rowc = e / 256, col = e % 256, b = rowc / 1024, p = rowc % 1024;
        float v[8]; ld8f(C.in[7] + e, v); st8bf(CKV + ((size_t)MP + b * 1088 + p) * 256 + col, v); }
    for (size_t i = gt; i < (size_t)32 * 1024 * 64 / 8; i += GT) { const size_t e = i * 8, rowc = e / 64, col = e % 64, b = rowc / 1024, p = rowc % 1024;
        float v[8]; ld8f(C.in[8] + e, v); st8bf(KP + ((size_t)MP + b * 1088 + p) * 64 + col, v); }
}
typedef __bf16 bf2_t __attribute__((ext_vector_type(2)));
__device__ __forceinline__ unsigned ford(float f) { const unsigned u = __float_as_uint(f); return (u & 0x80000000u) ? ~u : (u | 0x80000000u); }
__device__ __forceinline__ float funord(unsigned o) { return __uint_as_float((o & 0x80000000u) ? (o & 0x7fffffffu) : ~o); }
__device__ __forceinline__ unsigned umax(unsigned a, unsigned b) { return a > b ? a : b; }
__device__ __forceinline__ unsigned umin(unsigned a, unsigned b) { return a < b ? a : b; }
__device__ __forceinline__ void ins16(unsigned (&L)[16], unsigned x) {
#pragma unroll
    for (int i = 0; i < 16; ++i) { const unsigned t = umax(L[i], x); x = umin(L[i], x); L[i] = t; }
}
__device__ __forceinline__ void ins16p(unsigned (&K)[16], unsigned (&P)[16], unsigned key, unsigned pay) {
#pragma unroll
    for (int i = 0; i < 16; ++i) { const bool c = key > K[i]; const unsigned tk = c ? key : K[i], nk = c ? K[i] : key, tp = c ? pay : P[i], np = c ? P[i] : pay; K[i] = tk; P[i] = tp; key = nk; pay = np; }
}
__device__ __forceinline__ void sort16_desc(unsigned (&v)[16]) {
#pragma unroll
    for (int k = 2; k <= 16; k <<= 1)
#pragma unroll
        for (int j = k >> 1; j >= 1; j >>= 1)
#pragma unroll
            for (int i = 0; i < 16; ++i) { const int l = i ^ j; if (l > i) { const bool desc = ((i & k) == 0); const unsigned a = v[i], b = v[l], hi = umax(a, b), lo = umin(a, b); v[i] = desc ? hi : lo; v[l] = desc ? lo : hi; } }
}
__device__ __forceinline__ void merge16_desc(unsigned (&A)[16], const unsigned (&B)[16]) {
#pragma unroll
    for (int i = 0; i < 16; ++i) A[i] = umax(A[i], B[15 - i]);
#pragma unroll
    for (int st = 8; st >= 1; st >>= 1)
#pragma unroll
        for (int i = 0; i < 16; ++i) if ((i & st) == 0) { const unsigned a = A[i], b = A[i + st]; A[i] = umax(a, b); A[i + st] = umin(a, b); }
}
__device__ __forceinline__ void subkey_top16(const bf16_t* qrow  , const bf16_t* krow  , int hh, unsigned (&S)[16]) {
    bf16x8 qf[8];
#pragma unroll
    for (int s = 0; s < 8; ++s) qf[s] = *(const bf16x8*)(qrow + 16 * s);
    unsigned L[16];
#pragma unroll
    for (int i = 0; i < 16; ++i) L[i] = 0u;
#pragma unroll 1
    for (int kb = 0; kb < 4; ++kb) {
        bf16x8 kf[8];
#pragma unroll
        for (int s = 0; s < 8; ++s) kf[s] = *(const bf16x8*)(krow + (size_t)kb * 32 * 128 + 16 * s);
        f32x16 a = {0.f, 0.f, 0.f, 0.f, 0.f, 0.f, 0.f, 0.f, 0.f, 0.f, 0.f, 0.f, 0.f, 0.f, 0.f, 0.f};
#pragma unroll
        for (int s = 0; s < 8; ++s) a = __builtin_amdgcn_mfma_f32_32x32x16_bf16(kf[s], qf[s], a, 0, 0, 0);
        unsigned N[16];
#pragma unroll
        for (int r = 0; r < 16; ++r) { const unsigned idx = (unsigned)(32 * kb + (r & 3) + 8 * (r >> 2) + 4 * hh); N[r] = (ford(a[r]) & ~0x7fu) | idx; }
        sort16_desc(N); merge16_desc(L, N);
        asm volatile("" ::: "memory");
    }
    unsigned P[16];
#pragma unroll
    for (int i = 0; i < 16; ++i) P[i] = (unsigned)__shfl_xor((int)L[i], 32);
#pragma unroll
    for (int i = 0; i < 16; ++i) S[i] = L[i];
    merge16_desc(S, P);
}
__device__ __forceinline__ void phase_topk(const Ctx& C, int layer) {
    const bf16_t* Q = (const bf16_t*)(C.ws + A_B3); const bf16_t* KEYS = (const bf16_t*)(C.ws + WS_KEYS) + (size_t)layer * 8 * 2 * 128 * 128;
    int* IDX = (int*)(C.ws + A_B4); float* GATE = (float*)(C.ws + A_B4) + (size_t)MT * 128;
    const int lane = C.lane, r = lane & 31, hh = lane >> 5;
    for (int task = C.gw; task < (MT / 32) * 8; task += C.NGW) {
        const int tg = task >> 3, h = task & 7, m = tg * 32 + r;
        unsigned S1[16], S2[16];
        subkey_top16(Q + (size_t)m * 2048 + h * 256 + 8 * hh, KEYS + ((size_t)(h * 2 + 0) * 128 + r) * 128 + 8 * hh, hh, S1);
        subkey_top16(Q + (size_t)m * 2048 + h * 256 + 128 + 8 * hh, KEYS + ((size_t)(h * 2 + 1) * 128 + r) * 128 + 8 * hh, hh, S2);
#define CKEY(a, b) ((ford(funord(S1[a] & ~0x7fu) + funord(S2[b] & ~0x7fu)) & ~0xffu) | (unsigned)((a) << 4 | (b)))
        unsigned FK[16], G[16];
#pragma unroll
        for (int b = 0; b < 16; ++b) FK[b] = CKEY(0, b);
#pragma unroll
        for (int b = 0; b < 8; ++b) G[b] = CKEY(1, b);
#pragma unroll
        for (int b = 0; b < 5; ++b) G[8 + b] = CKEY(2, b);
#pragma unroll
        for (int b = 0; b < 3; ++b) G[13 + b] = CKEY(4, b);
        sort16_desc(G); merge16_desc(FK, G);
#pragma unroll
        for (int b = 0; b < 4; ++b) G[b] = CKEY(3, b);
#pragma unroll
        for (int b = 0; b < 2; ++b) { G[4 + b] = CKEY(5, b); G[6 + b] = CKEY(6, b); G[8 + b] = CKEY(7, b); }
#pragma unroll
        for (int a = 8; a < 14; ++a) G[2 + a] = CKEY(a, 0);
        sort16_desc(G); merge16_desc(FK, G);
        ins16(FK, CKEY(14, 0)); ins16(FK, CKEY(15, 0));
#undef CKEY
        unsigned I1p[4], I2p[4];
#pragma unroll
        for (int w = 0; w < 4; ++w) { I1p[w] = (S1[4 * w] & 0x7fu) | ((S1[4 * w + 1] & 0x7fu) << 8) | ((S1[4 * w + 2] & 0x7fu) << 16) | ((S1[4 * w + 3] & 0x7fu) << 24);
                                      I2p[w] = (S2[4 * w] & 0x7fu) | ((S2[4 * w + 1] & 0x7fu) << 8) | ((S2[4 * w + 2] & 0x7fu) << 16) | ((S2[4 * w + 3] & 0x7fu) << 24); }
        const float mx = funord(FK[0] & ~0xffu); float sum = 0.f;
#pragma unroll
        for (int i = 0; i < 16; ++i) sum += fexp(funord(FK[i] & ~0xffu) - mx);
        const float rs = 1.0f / sum;
        int oi[8]; float og[8];
#pragma unroll
        for (int i = 0; i < 8; ++i) { const unsigned key = hh ? FK[8 + i] : FK[i]; const unsigned a = (key >> 4) & 15u, b = key & 15u;
            const unsigned w1 = (a >> 2) == 0u ? I1p[0] : ((a >> 2) == 1u ? I1p[1] : ((a >> 2) == 2u ? I1p[2] : I1p[3]));
            const unsigned w2 = (b >> 2) == 0u ? I2p[0] : ((b >> 2) == 1u ? I2p[1] : ((b >> 2) == 2u ? I2p[2] : I2p[3]));
            oi[i] = (int)((((w1 >> ((a & 3u) * 8u)) & 0x7fu) << 7) | ((w2 >> ((b & 3u) * 8u)) & 0x7fu));
            og[i] = fexp(funord(key & ~0xffu) - mx) * rs; }
        const size_t o = (size_t)m * 128 + h * 16 + 8 * hh;
        *(u32x4*)(IDX + o) = (u32x4){(unsigned)oi[0], (unsigned)oi[1], (unsigned)oi[2], (unsigned)oi[3]}; *(u32x4*)(IDX + o + 4) = (u32x4){(unsigned)oi[4], (unsigned)oi[5], (unsigned)oi[6], (unsigned)oi[7]};
        *(f32x4*)(GATE + o) = (f32x4){og[0], og[1], og[2], og[3]}; *(f32x4*)(GATE + o + 4) = (f32x4){og[4], og[5], og[6], og[7]};
    }
}

template <int CTRL, int ROWMASK> __device__ __forceinline__ float dppf(float v) { return __builtin_bit_cast(float, __builtin_amdgcn_update_dpp(0, __builtin_bit_cast(int, v), CTRL, ROWMASK, 0xF, false)); }
__device__ __forceinline__ float wave_sum_u(float v) {
    v += dppf<0xB1, 0xF>(v); v += dppf<0x4E, 0xF>(v); v += dppf<0x141, 0xF>(v); v += dppf<0x140, 0xF>(v);
    v += dppf<0x142, 0xA>(v); v += dppf<0x143, 0xC>(v);
    return __builtin_bit_cast(float, __builtin_amdgcn_readlane(__builtin_bit_cast(int, v), 63));
}
struct RowSet4 { u32x4 u, v; };
__device__ __forceinline__ void load_rows4(RowSet4& R, const unsigned char* U4, const unsigned char* V4, int eid, int lane) {
    const size_t o = (size_t)eid * 1024 + lane * 16; R.u = *(const u32x4*)(U4 + o); R.v = *(const u32x4*)(V4 + o);
}
__device__ __forceinline__ void use_rows4(const u32x4 Ru, const u32x4 Rv, const float (&xf)[32], float gate, float (&out)[32]) {
    float d0 = 0.f, d1 = 0.f;
#define U4_STEP(w, b) { const f32x2 t = __builtin_amdgcn_cvt_scalef32_pk_f32_fp4(Ru[w], 1.0f, b); d0 = fmaf(xf[8 * (w) + 2 * (b)], t.x, d0); d1 = fmaf(xf[8 * (w) + 2 * (b) + 1], t.y, d1); }
#define U4_WORD(w) U4_STEP(w, 0) U4_STEP(w, 1) U4_STEP(w, 2) U4_STEP(w, 3)
    U4_WORD(0) U4_WORD(1) U4_WORD(2) U4_WORD(3)
#undef U4_WORD
#undef U4_STEP
    const float d = wave_sum_u(d0 + d1) * (1.0f / U4_SCALE);
    const float a = gelu_erf(d) * gate * (1.0f / V4_SCALE);
#define V4_STEP(w, b) { const f32x2 t = __builtin_amdgcn_cvt_scalef32_pk_f32_fp4(Rv[w], 1.0f, b); out[8 * (w) + 2 * (b)] = fmaf(a, t.x, out[8 * (w) + 2 * (b)]); out[8 * (w) + 2 * (b) + 1] = fmaf(a, t.y, out[8 * (w) + 2 * (b) + 1]); }
#define V4_WORD(w) V4_STEP(w, 0) V4_STEP(w, 1) V4_STEP(w, 2) V4_STEP(w, 3)
    V4_WORD(0) V4_WORD(1) V4_WORD(2) V4_WORD(3)
#undef V4_WORD
#undef V4_STEP
}
typedef _Float16 h16x2 __attribute__((ext_vector_type(2)));
__device__ __forceinline__ float dot_row4(const u32x4 Ru, const h16x2 (&xh)[16]) {
    float d0 = 0.f, d1 = 0.f;
#define U4_STEP(w, b, D) { const h16x2 t = __builtin_amdgcn_cvt_scalef32_pk_f16_fp4(Ru[w], 1.0f, b); D = __builtin_amdgcn_fdot2(xh[4 * (w) + (b)], t, D, false); }
#define U4_WORD(w) U4_STEP(w, 0, d0) U4_STEP(w, 1, d1) U4_STEP(w, 2, d0) U4_STEP(w, 3, d1)
    U4_WORD(0) U4_WORD(1) U4_WORD(2) U4_WORD(3)
#undef U4_WORD
#undef U4_STEP
    return wave_sum_u(d0 + d1);
}
__device__ __forceinline__ void axpy_row4(const u32x4 Rv, float a, float (&out)[32]) {
#define V4_STEP(w, b) { const f32x2 t = __builtin_amdgcn_cvt_scalef32_pk_f32_fp4(Rv[w], 1.0f, b); out[8 * (w) + 2 * (b)] = fmaf(a, t.x, out[8 * (w) + 2 * (b)]); out[8 * (w) + 2 * (b) + 1] = fmaf(a, t.y, out[8 * (w) + 2 * (b) + 1]); }
#define V4_WORD(w) V4_STEP(w, 0) V4_STEP(w, 1) V4_STEP(w, 2) V4_STEP(w, 3)
    V4_WORD(0) V4_WORD(1) V4_WORD(2) V4_WORD(3)
#undef V4_WORD
#undef V4_STEP
}
__device__ __forceinline__ void phase_gather(const Ctx& C, int layer) {
    const bf16_t* HN2 = (const bf16_t*)(C.ws + A_B2); const unsigned char* U4 = C.ws + WS_U + (size_t)layer * bq::TAB_L1; const unsigned char* V4 = C.ws + WS_V + (size_t)layer * bq::TAB_L1;
    const int* IDX = (const int*)(C.ws + A_B4); const float* GATE = (const float*)(C.ws + A_B4) + (size_t)MT * 128;
    const float* mod = (const float*)(C.ws + WS_MOD); float* X = C.out + O_Y; bf16_t* HN = (bf16_t*)(C.ws + A_HN);
    const int lane = C.lane;
    int m = C.gw; if (m >= MT) return;
    LAS unsigned char* ring = C.lds + C.wave * 16384;
    int i0 = IDX[(size_t)m * 128 + lane], i1 = IDX[(size_t)m * 128 + 64 + lane];
    float g0 = GATE[(size_t)m * 128 + lane], g1 = GATE[(size_t)m * 128 + 64 + lane];
    u32x2 xw[8];
#pragma unroll
    for (int b = 0; b < 8; ++b) xw[b] = *(const u32x2*)(HN2 + (size_t)m * 2048 + 256 * b + 4 * lane);
#pragma unroll
    for (int b = 0; b < 8; ++b) asm volatile("" : "+v"(xw[b]));
    asm volatile("" : "+v"(i0), "+v"(i1), "+v"(g0), "+v"(g1));
    asm volatile("s_waitcnt vmcnt(0)" ::: "memory");
#define SB() __builtin_amdgcn_sched_barrier(0)
    const unsigned lo16 = (unsigned)lane * 16u;
#define ROW_DMA(T, eid_, s_) __builtin_amdgcn_global_load_lds((const unsigned*)((const char*)((T) + (size_t)(eid_) * 1024) + lo16), (LAS unsigned*)(ring + ((s_) & 15) * 1024), 16, 0, 0)
#define EIDC(j) __builtin_amdgcn_readlane(((j) < 64) ? i0 : i1, (j) & 63)
#pragma unroll
    for (int j = 0; j < 14; ++j) ROW_DMA(U4, __builtin_amdgcn_readlane(i0, j), j);
    for (;;) {
        const int mn = m + C.NGW; const bool has_next = mn < MT; const int mq = has_next ? mn : m;
        int ni0, ni1; float ng0, ng1; u32x2 nx[8];
        int lt = lane; asm volatile("" : "+v"(lt));
        { const int* ip = IDX + (size_t)mq * 128 + lt; const float* gp = GATE + (size_t)mq * 128 + lt; const bf16_t* xp = HN2 + (size_t)mq * 2048 + 4 * lt;
          asm volatile("global_load_dword %0, %1, off" : "=v"(ni0) : "v"(ip) : "memory");
          asm volatile("global_load_dword %0, %1, off offset:256" : "=v"(ni1) : "v"(ip) : "memory");
          asm volatile("global_load_dword %0, %1, off" : "=v"(ng0) : "v"(gp) : "memory");
          asm volatile("global_load_dword %0, %1, off offset:256" : "=v"(ng1) : "v"(gp) : "memory");
          asm volatile("global_load_dwordx2 %0, %1, off" : "=v"(nx[0]) : "v"(xp) : "memory");
          asm volatile("global_load_dwordx2 %0, %1, off offset:512" : "=v"(nx[1]) : "v"(xp) : "memory");
          asm volatile("global_load_dwordx2 %0, %1, off offset:1024" : "=v"(nx[2]) : "v"(xp) : "memory");
          asm volatile("global_load_dwordx2 %0, %1, off offset:1536" : "=v"(nx[3]) : "v"(xp) : "memory");
          asm volatile("global_load_dwordx2 %0, %1, off offset:2048" : "=v"(nx[4]) : "v"(xp) : "memory");
          asm volatile("global_load_dwordx2 %0, %1, off offset:2560" : "=v"(nx[5]) : "v"(xp) : "memory");
          asm volatile("global_load_dwordx2 %0, %1, off offset:3072" : "=v"(nx[6]) : "v"(xp) : "memory");
          asm volatile("global_load_dwordx2 %0, %1, off offset:3584" : "=v"(nx[7]) : "v"(xp) : "memory"); }
        h16x2 xf[16];
#pragma unroll
        for (int b = 0; b < 8; ++b) { xf[2 * b] = __builtin_bit_cast(h16x2, __builtin_amdgcn_cvt_pkrtz(bf_lo(xw[b].x), bf_hi(xw[b].x))); xf[2 * b + 1] = __builtin_bit_cast(h16x2, __builtin_amdgcn_cvt_pkrtz(bf_lo(xw[b].y), bf_hi(xw[b].y))); }
        float dv0 = 0.f, dv1 = 0.f;
#define U_ITER2(e, VMN, DV, NEXT_T, NEXT_E0, NEXT_E1) do { ROW_DMA(NEXT_T, NEXT_E0, (e) + 14); ROW_DMA(NEXT_T, NEXT_E1, (e) + 15); asm volatile("s_waitcnt vmcnt(" #VMN ")" ::: "memory"); \
            const u32x4 ru0 = *(const LAS u32x4*)(ring + ((e) & 15) * 1024 + lo16), ru1 = *(const LAS u32x4*)(ring + (((e) + 1) & 15) * 1024 + lo16); \
            const float da = dot_row4(ru0, xf), db = dot_row4(ru1, xf); \
            DV = (lane == ((e) & 63)) ? da : DV; DV = (lane == (((e) + 1) & 63)) ? db : DV; } while (0)
#pragma unroll 1
        for (int e = 0; e < 14; e += 2) U_ITER2(e, 26, dv0, U4, EIDC(e + 14), EIDC(e + 15));
#pragma unroll 1
        for (int e = 14; e < 64; e += 2) U_ITER2(e, 14, dv0, U4, EIDC(e + 14), EIDC(e + 15));
#pragma unroll 1
        for (int e = 64; e < 114; e += 2) U_ITER2(e, 14, dv1, U4, EIDC(e + 14), EIDC(e + 15));
#pragma unroll 1
        for (int e = 114; e < 128; e += 2) U_ITER2(e, 14, dv1, V4, EIDC(e - 114), EIDC(e - 113));
#undef U_ITER2
        asm volatile("" : "+v"(ni0), "+v"(ni1), "+v"(ng0), "+v"(ng1));
#pragma unroll
        for (int b = 0; b < 8; ++b) asm volatile("" : "+v"(nx[b]));
        const float av0 = gelu_erf(dv0 * (1.0f / U4_SCALE)) * g0 * (1.0f / V4_SCALE), av1 = gelu_erf(dv1 * (1.0f / U4_SCALE)) * g1 * (1.0f / V4_SCALE);
        float out[32];
#pragma unroll
        for (int i = 0; i < 32; ++i) out[i] = 0.f;
#define V_ITER2(e, AV, NEXT_T, NEXT_E0, NEXT_E1) do { ROW_DMA(NEXT_T, NEXT_E0, (e) + 14); ROW_DMA(NEXT_T, NEXT_E1, (e) + 15); asm volatile("s_waitcnt vmcnt(14)" ::: "memory"); \
            const u32x4 rv0 = *(const LAS u32x4*)(ring + ((e) & 15) * 1024 + lo16), rv1 = *(const LAS u32x4*)(ring + (((e) + 1) & 15) * 1024 + lo16); \
            const float a0 = __builtin_bit_cast(float, __builtin_amdgcn_readlane(__builtin_bit_cast(int, AV), (e) & 63)), a1 = __builtin_bit_cast(float, __builtin_amdgcn_readlane(__builtin_bit_cast(int, AV), ((e) + 1) & 63)); \
            axpy_row4(rv0, a0, out); axpy_row4(rv1, a1, out); } while (0)
#pragma unroll 1
        for (int e = 0; e < 64; e += 2) V_ITER2(e, av0, V4, EIDC(e + 14), EIDC(e + 15));
#pragma unroll 1
        for (int e = 64; e < 114; e += 2) V_ITER2(e, av1, V4, EIDC(e + 14), EIDC(e + 15));
#pragma unroll 1
        for (int e = 114; e < 128; e += 2) V_ITER2(e, av1, U4, __builtin_amdgcn_readlane(ni0, e - 114), __builtin_amdgcn_readlane(ni0, e - 113));
#undef V_ITER2
        int le = lane; asm volatile("" : "+v"(le));
        const int sq = seq_of_row(m); const float* g2 = mod + ((size_t)layer * NSEQ + sq) * 12288 + 5 * 2048; float* xr = X + (size_t)m * DM;
        float ss = 0.f;
#pragma unroll
        for (int hb = 0; hb < 2; ++hb) {
            f32x4 xo[4], gg[4];
#pragma unroll
            for (int b = 0; b < 4; ++b) { const int c = 256 * (4 * hb + b) + 4 * le; xo[b] = *(const f32x4*)(xr + c); gg[b] = *(const f32x4*)(g2 + c); }
            SB();
#pragma unroll
            for (int b = 0; b < 4; ++b) {
#pragma unroll
                for (int j = 0; j < 4; ++j) { const float v = xo[b][j] + gg[b][j] * out[4 * (4 * hb + b) + j]; out[4 * (4 * hb + b) + j] = v; ss += v * v; } }
            SB();
        }
        const float rstd = __builtin_amdgcn_rsqf(wave_sum(ss) * (1.0f / DM) + RMS_EPS);
        if (layer == 0) {
            const float* n1g = C.in[11] + 2048; const float* mp = mod + ((size_t)1 * NSEQ + sq) * 12288;
#pragma unroll
            for (int hb = 0; hb < 2; ++hb) {
                f32x4 gv[4], sh[4], sc[4];
#pragma unroll
                for (int b = 0; b < 4; ++b) { const int c = 256 * (4 * hb + b) + 4 * le; gv[b] = *(const f32x4*)(n1g + c); sh[b] = *(const f32x4*)(mp + c); sc[b] = *(const f32x4*)(mp + 2048 + c); }
                SB();
#pragma unroll
                for (int b = 0; b < 4; ++b) { const int bb = 4 * hb + b, c = 256 * bb + 4 * le;
                    const f32x4 xs = {out[4 * bb], out[4 * bb + 1], out[4 * bb + 2], out[4 * bb + 3]}; const f32x4 y = xs * rstd * gv[b] * (sc[b] + 1.0f) + sh[b];
                    *(f32x4*)(xr + c) = xs; u32x2 w; w.x = cvt_pk_bf16(y[0], y[1]); w.y = cvt_pk_bf16(y[2], y[3]); *(u32x2*)(HN + (size_t)m * DM + c) = w; }
                SB();
            }
        } else {
            const float* fg = C.in[35];
            f32x4 gv[8];
#pragma unroll
            for (int b = 0; b < 8; ++b) gv[b] = *(const f32x4*)(fg + 256 * b + 4 * le);
            SB();
#pragma unroll
            for (int b = 0; b < 8; ++b) { const int c = 256 * b + 4 * le; const f32x4 xs = {out[4 * b], out[4 * b + 1], out[4 * b + 2], out[4 * b + 3]};
                *(f32x4*)(xr + c) = xs * rstd * gv[b]; }
        }
        if (!has_next) break;
        m = mn; i0 = ni0; i1 = ni1; g0 = ng0; g1 = ng1;
#pragma unroll
        for (int b = 0; b < 8; ++b) xw[b] = nx[b];
    }
    asm volatile("s_waitcnt vmcnt(0)" ::: "memory");
#undef ROW_DMA
#undef EIDC
#undef SB
}
namespace att {
constexpr int SHM_K = 64 * 384, SHM_V = 64 * 256;
constexpr int OFF_K = 0, OFF_V = 2 * SHM_K, OFF_WS = 2 * SHM_K + 2 * SHM_V;
constexpr float SCALE = 0.07216878364870322f;
constexpr float THR = 8.f;
__device__ __forceinline__ int crow(int r, int hi) { return (r & 3) + 8 * (r >> 2) + 4 * hi; }
constexpr float THR2 = THR * 1.4426950408889634f;
__device__ __forceinline__ void partialSM(f32x16& p0, f32x16& p1, float& mref, f32x16& negm, float& alpha, bool first) {
    float pmax = p0[0];
#pragma unroll
    for (int r = 1; r < 16; ++r) pmax = fmaxf(pmax, p0[r]);
#pragma unroll
    for (int r = 0; r < 16; ++r) pmax = fmaxf(pmax, p1[r]);
    { auto rr = __builtin_amdgcn_permlane32_swap(__float_as_uint(pmax), __float_as_uint(pmax), false, false);
      pmax = fmaxf(__uint_as_float(rr[0]), __uint_as_float(rr[1])); }
    if (__builtin_expect(!first && __all(pmax <= THR2), 1)) { alpha = 1.f; }
    else { const float dl = first ? pmax : fmaxf(pmax, 0.f); alpha = first ? 1.f : __builtin_amdgcn_exp2f(-dl); mref += dl;
#pragma unroll
        for (int r = 0; r < 16; ++r) { negm[r] = -mref; p0[r] -= dl; p1[r] -= dl; }
        asm volatile("" : "+v"(negm)); }
#pragma unroll
    for (int r = 0; r < 16; ++r) p0[r] = __builtin_amdgcn_exp2f(p0[r]);
#pragma unroll
    for (int r = 0; r < 16; ++r) p1[r] = __builtin_amdgcn_exp2f(p1[r]);
}
__device__ __forceinline__ void finishSM(const f32x16& p0, const f32x16& p1, float alpha, float& l_reg, bf16x8& pa0, bf16x8& pa1, bf16x8& pa2, bf16x8& pa3) {
    float ps = 0;
#pragma unroll
    for (int r = 0; r < 16; ++r) ps += p0[r];
#pragma unroll
    for (int r = 0; r < 16; ++r) ps += p1[r];
    { auto rr = __builtin_amdgcn_permlane32_swap(__float_as_uint(ps), __float_as_uint(ps), false, false);
      ps = __uint_as_float(rr[0]) + __uint_as_float(rr[1]); }
    l_reg = l_reg * alpha + ps;
#define PK4(P, BASE, OUT) do { unsigned a0 = cvt_pk_bf16(P[BASE + 0], P[BASE + 1]), a1 = cvt_pk_bf16(P[BASE + 2], P[BASE + 3]);   \
    unsigned b0 = cvt_pk_bf16(P[BASE + 4], P[BASE + 5]), b1 = cvt_pk_bf16(P[BASE + 6], P[BASE + 7]);                              \
    auto r0 = __builtin_amdgcn_permlane32_swap(a0, b0, false, false); auto r1 = __builtin_amdgcn_permlane32_swap(a1, b1, false, false); \
    u32x4 w = {r0[0], r1[0], r0[1], r1[1]}; OUT = __builtin_bit_cast(bf16x8, w); } while (0)
    PK4(p0, 0, pa0); PK4(p0, 8, pa1); PK4(p1, 0, pa2); PK4(p1, 8, pa3);
#undef PK4
}
template <int OFF> __device__ __forceinline__ bf16x8 k_read(int addr) { bf16x8 r; asm volatile("ds_read_b128 %0, %1 offset:%2" : "=v"(r) : "v"(addr), "i"(OFF) : "memory"); return r; }
template <int I> __device__ __forceinline__ bf16x8 kfrag(const int (&kad)[4]) { constexpr int d0 = I >> 1, half = I & 1; return k_read<(d0 >> 2) * 128 + half * 12288>(kad[d0 & 3]); }
__device__ __forceinline__ void packSM(const f32x16& p0, const f32x16& p1, bf16x8& pa0, bf16x8& pa1, bf16x8& pa2, bf16x8& pa3) {
#define PK4(P, BASE, OUT) do { unsigned a0 = cvt_pk_bf16(P[BASE + 0], P[BASE + 1]), a1 = cvt_pk_bf16(P[BASE + 2], P[BASE + 3]);   \
    unsigned b0 = cvt_pk_bf16(P[BASE + 4], P[BASE + 5]), b1 = cvt_pk_bf16(P[BASE + 6], P[BASE + 7]);                              \
    auto r0 = __builtin_amdgcn_permlane32_swap(a0, b0, false, false); auto r1 = __builtin_amdgcn_permlane32_swap(a1, b1, false, false); \
    u32x4 w = {r0[0], r1[0], r0[1], r1[1]}; OUT = __builtin_bit_cast(bf16x8, w); } while (0)
    PK4(p0, 0, pa0); PK4(p0, 8, pa1); PK4(p1, 0, pa2); PK4(p1, 8, pa3);
#undef PK4
}
__device__ __forceinline__ int v_rd_base(int lane) { return ((lane & 3) << 3) | (((lane >> 2) & 3) << 6) | (((lane >> 4) & 1) << 5) | (((lane >> 5) & 1) << 8); }
constexpr int v_rd_off(int d0, int ks, int half) { return d0 * 512 + ks * 4096 + half * 2048; }
template <int OFF> __device__ __forceinline__ s16x4 tr_read(int vb) {
    s16x4 r; asm volatile("ds_read_b64_tr_b16 %0, %1 offset:%2" : "=&v"(r) : "v"(vb), "i"(OFF) : "memory"); return r;
}
template <int D0> __device__ __forceinline__ void pv_one(f32x16& od, int vb, bf16x8 pa0, bf16x8 pa1, bf16x8 pa2, bf16x8 pa3) {
    const s16x4 l0 = tr_read<v_rd_off(D0, 0, 0)>(vb), h0 = tr_read<v_rd_off(D0, 0, 1)>(vb), l1 = tr_read<v_rd_off(D0, 1, 0)>(vb), h1 = tr_read<v_rd_off(D0, 1, 1)>(vb);
    const s16x4 l2 = tr_read<v_rd_off(D0, 2, 0)>(vb), h2 = tr_read<v_rd_off(D0, 2, 1)>(vb), l3 = tr_read<v_rd_off(D0, 3, 0)>(vb), h3 = tr_read<v_rd_off(D0, 3, 1)>(vb);
    asm volatile("s_waitcnt lgkmcnt(0)" ::: "memory"); __builtin_amdgcn_sched_barrier(0);
#define PKV(L, H) (bf16x8){L[0], L[1], L[2], L[3], H[0], H[1], H[2], H[3]}
    od = __builtin_amdgcn_mfma_f32_32x32x16_bf16(pa0, PKV(l0, h0), od, 0, 0, 0);
    od = __builtin_amdgcn_mfma_f32_32x32x16_bf16(pa1, PKV(l1, h1), od, 0, 0, 0);
    od = __builtin_amdgcn_mfma_f32_32x32x16_bf16(pa2, PKV(l2, h2), od, 0, 0, 0);
    od = __builtin_amdgcn_mfma_f32_32x32x16_bf16(pa3, PKV(l3, h3), od, 0, 0, 0);
#undef PKV
}
struct AUnit { int qrow0, kvrow0, ntiles, head, vis0, nact, rev; };

__device__ __forceinline__ bool next_unit(int i, int vcu, int G, AUnit& u) {
    int flat;
    if (G == 256) {
        if (i >= 10) return false;
        if (i < 8) { const int bh = vcu >> 3, s = vcu & 7, base = 16 * (i >> 1); const int qb = (i & 1) ? base + 15 - s : base + s; flat = bh * 64 + qb; }
        else flat = 2048 + vcu * 2 + (i - 8);
    } else { flat = i * G + vcu; if (flat >= 2560) return false; }
    u.rev = (G == 256 && i < 8) ? (i & 1) : 0;
    if (flat < 2048) { const int bh = flat >> 6, qb = flat & 63, b = bh >> 4; u.head = bh & 15; u.qrow0 = b * 16384 + qb * 256; u.kvrow0 = b * 16384; u.ntiles = 4 * qb + 4; u.vis0 = 4 * qb; u.nact = 8; }
    else { const int f = flat - 2048, b = f >> 4; u.head = f & 15; u.qrow0 = MP + b * 64; u.kvrow0 = MP + b * 1088; u.ntiles = 17; u.vis0 = 1 << 20; u.nact = 2; }
    return true;
}

__device__ __forceinline__ void attn_phase(const Ctx& C) {
    bf16_t* Qn = (bf16_t*)(C.ws + A_HN); const bf16_t* Qp = (const bf16_t*)(C.ws + A_GG);
    const bf16_t* Kn = (const bf16_t*)(C.ws + A_KN); const bf16_t* Kp = (const bf16_t*)(C.ws + A_KP); const bf16_t* Vv = (const bf16_t*)(C.ws + A_VV);
    LAS unsigned char* lds = C.lds; const int wid = C.wave, lane = C.lane, r32 = lane & 31, hi = lane >> 5;
    LAS float* wsp = (LAS float*)(lds + OFF_WS) + wid * 64; LAS float* li_l = wsp; LAS float* al_l = wsp + 32;
    unsigned ka[3], kst[3]; bool kisn[3];
#pragma unroll
    for (int i = 0; i < 3; ++i) { const int Uq = (wid * 3 + i) * 64 + lane, row = Uq / 24, cp = Uq % 24, c = cp ^ ((row >> 1) & 7);
        kisn[i] = c < 16; ka[i] = kisn[i] ? (unsigned)(row * 4096 + c * 16) : (unsigned)(A_KP - A_KN) + (unsigned)(row * 128 + (c - 16) * 16); kst[i] = kisn[i] ? 64u * 4096u : 64u * 128u; }
    unsigned va[2];
#pragma unroll
    for (int i = 0; i < 2; ++i) { const int by = ((wid * 2 + i) * 64 + lane) * 16, sub = by >> 9, within = by & 511, kk = (sub >> 2) * 8 + (within >> 6), cc = (sub & 3) * 32 + ((within & 63) >> 1);
        const int k = (kk & ~0xC) | ((kk & 4) << 1) | ((kk & 8) >> 1); va[i] = (unsigned)(k * 4096 + cc * 2); }
    int kl0[4];
#pragma unroll
    for (int q = 0; q < 4; ++q) kl0[q] = (int)(uintptr_t)(lds + OFF_K) + r32 * 384 + ((((2 * q + hi) ^ ((r32 >> 1) & 7))) << 4);
    const int vb0 = (int)(uintptr_t)(lds + OFF_V) + v_rd_base(lane);
#define ATT_BAR() __builtin_amdgcn_s_barrier()
#define ATT_ISSUE(j, kb, vbi) do { _Pragma("unroll") for (int _i = 0; _i < 3; ++_i) { \
        __builtin_amdgcn_global_load_lds((const unsigned*)((const char*)Kn + kc[_i]), (LAS unsigned*)(lds + OFF_K + (kb) * SHM_K + (wid * 3 + _i) * 1024), 16, 0, 0); kc[_i] += kst[_i] * (unsigned)kdir; } \
      _Pragma("unroll") for (int _i = 0; _i < 2; ++_i) { \
        __builtin_amdgcn_global_load_lds((const unsigned*)((const char*)Vv + vc[_i]), (LAS unsigned*)(lds + OFF_V + (vbi) * SHM_V + (wid * 2 + _i) * 1024), 16, 0, 0); vc[_i] += (unsigned)(64 * 4096 * kdir); } } while (0)
#define PV_STEP(I, PA, L, H, WN) do { asm volatile("s_waitcnt lgkmcnt(" #WN ")" : "+v"(L), "+v"(H) :: "memory"); \
        o[(I) >> 2] = __builtin_amdgcn_mfma_f32_32x32x16_bf16(PA, ((bf16x8){L[0], L[1], L[2], L[3], H[0], H[1], H[2], H[3]}), o[(I) >> 2], 0, 0, 0); \
        if ((I) + 4 < 16) { L = tr_read<v_rd_off((((I) + 4) & 15) >> 2, (I) & 3, 0)>(vb); H = tr_read<v_rd_off((((I) + 4) & 15) >> 2, (I) & 3, 1)>(vb); } \
        __builtin_amdgcn_sched_barrier(0); } while (0)
#define PV_HEAD(VBI) do { vb = vb0 + (VBI) * SHM_V; \
      l0 = tr_read<v_rd_off(0, 0, 0)>(vb); h0 = tr_read<v_rd_off(0, 0, 1)>(vb); l1 = tr_read<v_rd_off(0, 1, 0)>(vb); h1 = tr_read<v_rd_off(0, 1, 1)>(vb); \
      l2 = tr_read<v_rd_off(0, 2, 0)>(vb); h2 = tr_read<v_rd_off(0, 2, 1)>(vb); l3 = tr_read<v_rd_off(0, 3, 0)>(vb); h3 = tr_read<v_rd_off(0, 3, 1)>(vb); } while (0)
#define PV_BODY() do { \
      __builtin_amdgcn_s_setprio(1); PV_STEP(0, pa0, l0, h0, 6);  PV_STEP(1, pa1, l1, h1, 6);  PV_STEP(2, pa2, l2, h2, 6);  PV_STEP(3, pa3, l3, h3, 6); \
      PV_STEP(4, pa0, l0, h0, 6);  PV_STEP(5, pa1, l1, h1, 6);  PV_STEP(6, pa2, l2, h2, 6);  PV_STEP(7, pa3, l3, h3, 6); \
      PV_STEP(8, pa0, l0, h0, 6);  PV_STEP(9, pa1, l1, h1, 6);  PV_STEP(10, pa2, l2, h2, 6); PV_STEP(11, pa3, l3, h3, 6); \
      PV_STEP(12, pa0, l0, h0, 6); PV_STEP(13, pa1, l1, h1, 4); PV_STEP(14, pa2, l2, h2, 2); PV_STEP(15, pa3, l3, h3, 0); __builtin_amdgcn_s_setprio(0); } while (0)
#define ATT_PV(VBI) do { PV_HEAD(VBI); PV_BODY(); } while (0)
    AUnit u;
#ifndef PROBE_ATT
#define PROBE_ATT 0
#endif
#if PROBE_ATT
    for (int ui2 = 0; next_unit(ui2 >> 1, C.vcu, C.G, u); ++ui2) { const bool dummy = !(ui2 & 1);
#else
    for (int ui = 0; next_unit(ui, C.vcu, C.G, u); ++ui) { const bool dummy = false;
#endif
        const bool active = wid < u.nact; const int vis = u.vis0 + (wid >> 1);
        const int qrow = u.qrow0 + wid * 32 + r32;
        bf16x8 qr[12];
        if (active) {
#pragma unroll
            for (int d0 = 0; d0 < 8; ++d0) qr[d0] = *(const bf16x8*)(Qn + (size_t)qrow * 2048 + u.head * 128 + d0 * 16 + hi * 8);
#pragma unroll
            for (int d0 = 0; d0 < 4; ++d0) qr[8 + d0] = *(const bf16x8*)(Qp + (size_t)qrow * 1024 + u.head * 64 + d0 * 16 + hi * 8);
        } else {
#pragma unroll
            for (int d0 = 0; d0 < 12; ++d0) qr[d0] = (bf16x8){0, 0, 0, 0, 0, 0, 0, 0};
        }
#pragma unroll
        for (int d0 = 0; d0 < 12; ++d0) asm volatile("" : "+v"(qr[d0]));
        float mref = 0.f, l_reg = 0.f; f32x16 o[4]; f32x16 negm;
#pragma unroll
        for (int r = 0; r < 16; ++r) negm[r] = 0.f;
        asm volatile("" : "+v"(negm));
#pragma unroll
        for (int d = 0; d < 4; ++d)
#pragma unroll
            for (int r = 0; r < 16; ++r) o[d][r] = 0.f;
        bf16x8 pa0, pa1, pa2, pa3;
        const int NT = u.ntiles;
        const int kdir = u.rev ? -1 : 1, t0 = u.rev ? u.ntiles - 1 : 0;
        bool started = false;
        unsigned kc[3], vc[2];
#pragma unroll
        for (int i = 0; i < 3; ++i) kc[i] = ka[i] + (kisn[i] ? (unsigned)u.kvrow0 * 4096u + (unsigned)u.head * 256u : (unsigned)u.kvrow0 * 128u) + kst[i] * (unsigned)t0;
#pragma unroll
        for (int i = 0; i < 2; ++i) vc[i] = va[i] + (unsigned)u.kvrow0 * 4096u + (unsigned)u.head * 256u + (unsigned)(64 * 4096) * (unsigned)t0;
        ATT_ISSUE(0, 0, 0);
        asm volatile("s_waitcnt vmcnt(0)" ::: "memory");
        ATT_BAR();
        int vb; s16x4 l0, h0, l1, h1, l2, h2, l3, h3; bf16x8 f0, f1, f2, f3; int kad[4];
#define QK_HEAD() do { _Pragma("unroll") for (int q = 0; q < 4; ++q) kad[q] = kl0[q] + buf * SHM_K; f0 = kfrag<0>(kad); f1 = kfrag<1>(kad); f2 = kfrag<2>(kad); f3 = kfrag<3>(kad); } while (0)
#define QK_STEP(I, F, WN) do { asm volatile("s_waitcnt lgkmcnt(" #WN ")" : "+v"(F) :: "memory"); \
        if ((I) == 0) p0 = __builtin_amdgcn_mfma_f32_32x32x16_bf16(F, qr[0], negm, 0, 0, 0); \
        else if ((I) == 1) p1 = __builtin_amdgcn_mfma_f32_32x32x16_bf16(F, qr[0], negm, 0, 0, 0); \
        else if ((I) & 1) p1 = __builtin_amdgcn_mfma_f32_32x32x16_bf16(F, qr[(I) >> 1], p1, 0, 0, 0); \
        else p0 = __builtin_amdgcn_mfma_f32_32x32x16_bf16(F, qr[(I) >> 1], p0, 0, 0, 0); \
        if ((I) + 4 < 24) F = kfrag<((I) + 4 < 24 ? (I) + 4 : 0)>(kad); __builtin_amdgcn_sched_barrier(0); } while (0)
        for (int j = 0; j < NT; ++j) {
            const int buf = j & 1;
            const int jt = u.rev ? NT - 1 - j : j;
            const bool doQK = active && jt <= vis;
            if (j + 1 < NT) ATT_ISSUE(j + 1, buf ^ 1, buf ^ 1);
            if (doQK) {
                f32x16 p0, p1;
                if ((PROBE_ATT == 3 || PROBE_ATT == 5) && dummy) { p0 = negm; p1 = negm; } else {
                QK_HEAD();
                __builtin_amdgcn_s_setprio(1);
                QK_STEP(0, f0, 3);  QK_STEP(1, f1, 3);  QK_STEP(2, f2, 3);  QK_STEP(3, f3, 3);
                QK_STEP(4, f0, 3);  QK_STEP(5, f1, 3);  QK_STEP(6, f2, 3);  QK_STEP(7, f3, 3);
                QK_STEP(8, f0, 3);  QK_STEP(9, f1, 3);  QK_STEP(10, f2, 3); QK_STEP(11, f3, 3);
                QK_STEP(12, f0, 3); QK_STEP(13, f1, 3); QK_STEP(14, f2, 3); QK_STEP(15, f3, 3);
                QK_STEP(16, f0, 3); QK_STEP(17, f1, 3); QK_STEP(18, f2, 3); QK_STEP(19, f3, 3);
                QK_STEP(20, f0, 3); QK_STEP(21, f1, 2); QK_STEP(22, f2, 1); QK_STEP(23, f3, 0);
                __builtin_amdgcn_s_setprio(0);
                }
                if ((PROBE_ATT == 2 || PROBE_ATT == 5) && dummy) { packSM(p0, p1, pa0, pa1, pa2, pa3); } else {
                float alpha; partialSM(p0, p1, mref, negm, alpha, !started); started = true;
                if (__any(alpha < 1.f)) { if (hi == 0) al_l[r32] = alpha; asm volatile("s_waitcnt lgkmcnt(0)" ::: "memory");
#pragma unroll
                    for (int r = 0; r < 16; ++r) { const float al = al_l[crow(r, hi)];
#pragma unroll
                        for (int d = 0; d < 4; ++d) o[d][r] *= al; } }
                finishSM(p0, p1, alpha, l_reg, pa0, pa1, pa2, pa3);
                }
                if (!((PROBE_ATT == 4 || PROBE_ATT == 5) && dummy)) ATT_PV(buf);
            }
            asm volatile("s_waitcnt vmcnt(0) lgkmcnt(0)" ::: "memory");
            ATT_BAR();
        }
#undef QK_STEP
#undef QK_HEAD
        if (active && !dummy) {
            if (hi == 0) li_l[r32] = l_reg; asm volatile("s_waitcnt lgkmcnt(0)" ::: "memory");
            bf16_t* Ow = Qn + (size_t)(u.qrow0 + wid * 32) * 2048 + u.head * 128;
#pragma unroll
            for (int r = 0; r < 16; ++r) { const int orow = crow(r, hi); const float rl = __builtin_amdgcn_rcpf(li_l[orow]);
#pragma unroll
                for (int d0 = 0; d0 < 4; ++d0) { const unsigned w = cvt_pk_bf16(o[d0][r] * rl, 0.f); Ow[(size_t)orow * 2048 + d0 * 32 + r32] = (bf16_t)(w & 0xffffu); } }
        }
    }
#undef ATT_BAR
#undef ATT_ISSUE
#undef ATT_PV
#undef PV_STEP
#undef PV_HEAD
#undef PV_BODY
}
}
#ifndef MK_SPLIT
#define MK_SPLIT 0
#endif
constexpr int N_PHASES = 22;

__global__ void __launch_bounds__(512, 2) mega_fwd(Args args) {
    extern __shared__ __attribute__((aligned(16))) unsigned char lds_raw[];
    Ctx C;
    C.lds = (LAS unsigned char*)lds_raw;
    C.tid = threadIdx.x; C.lane = C.tid & 63; C.wave = __builtin_amdgcn_readfirstlane(C.tid >> 6);
    C.G = gridDim.x; { const int bx = blockIdx.x; C.vcu = (C.G % 8 == 0) ? (bx % 8) * (C.G / 8) + bx / 8 : bx; }
    C.gw = C.vcu * 8 + C.wave; C.NGW = C.G * 8;
    C.in = args.in; C.out = args.out; C.ws = args.ws;
    volatile LAS unsigned* misc = (volatile LAS unsigned*)(C.lds + LDS_MISC);
    if (C.tid < 4) misc[C.tid] = 0u;
    __syncthreads();
    const int lo = args.ph_lo, hi = args.ph_hi;
    XcdBarrier bar; bar.bar = (unsigned*)(C.ws + WS_CTL) + CW_BAR; bar.x = 0; bar.st = misc;
    if (hi - lo > 1) bar = xcd_barrier_post((unsigned*)(C.ws + WS_CTL) + CW_BAR, misc);
#ifdef PH_ONLY
#define IN(k) ((k) == PH_ONLY)
#else
#define IN(k) (lo <= (k) && (k) < hi)
#endif
#define FILL(k) bq::service(C, true, (k), 0)
#define NEED(k, limit) do { if (IN(k) && (limit) > 0) bq::service(C, false, 0, (limit)); } while (0)
#define SEAM(k) do { if (IN(k) && IN((k) + 1)) xcd_barrier(bar); } while (0)
    unsigned char* ws = C.ws;
    const float* mod = (const float*)(ws + WS_MOD);
    float* X = C.out + O_Y;
    LAS unsigned char* glds = C.lds;

#ifdef PROBE_CLK
#define CLK_BEGIN(k) unsigned long long _t0 = 0, _r0 = 0; if ((k) == PROBE_CLK) { _t0 = __builtin_amdgcn_s_memtime(); _r0 = __builtin_amdgcn_s_memrealtime(); }
#define CLK_END(k) if ((k) == PROBE_CLK && blockIdx.x == 0 && threadIdx.x == 0) { const unsigned long long t1 = __builtin_amdgcn_s_memtime(), r1 = __builtin_amdgcn_s_memrealtime(); \
        const unsigned long long ticks = (t1 - _t0) * 1000ull / (r1 - _r0); while (__builtin_amdgcn_s_memrealtime() - r1 < ticks) __builtin_amdgcn_s_sleep(8); }
#else
#define CLK_BEGIN(k)
#define CLK_END(k)
#endif
    if (IN(0)) { phase_prologue(C); } SEAM(0);
    if (IN(1)) { phase_norm(C, C.in[0], C.in[1], C.in[11], mod, 0, (bf16_t*)(ws + A_HN)); } NEED(1, bq::E_IN); SEAM(1);
    if (IN(2)) {
        pg8::Gemm g{(const bf16_t*)(ws + A_HN), (const bf16_t*)(ws + WS_WIN), MT, 3072, 2048, 2048, 2048, 0, 0}; pg8::StaticOrder S; S.init(MT, 3072, C.G, (int)blockIdx.x);
        pg8::EpiZ E{(bf16_t*)(ws + A_GG), (bf16_t*)(ws + A_B2), (bf16_t*)(ws + A_B2) + (size_t)MT * 1024};
        CLK_BEGIN(2) pg8::gemm_phase<pg8::EpiZ>(glds, g, S, E); CLK_END(2) FILL(2); } SEAM(2);
    if (IN(3)) { phase_convpool(C); } NEED(3, bq::E_POOL); SEAM(3);
    if (IN(4)) {
        { pg8::Gemm g{(const bf16_t*)(ws + A_B3), (const bf16_t*)(ws + WS_WGATE), MT, 2048, 256, 1024, 256, 1, 256}; pg8::StaticOrder S; S.init(MT, 2048, C.G, (int)blockIdx.x);
          pg8::EpiGate E{(const bf16_t*)(ws + A_B3), (const float*)(ws + WS_SP), (float*)(ws + A_B4)};
          pg8::gemm_phase<pg8::EpiGate>(glds, g, S, E); }
        FILL(4); } SEAM(4);
    if (IN(5)) {
        { pg8::Gemm g{(const bf16_t*)(ws + A_B3) + (size_t)MT * 1024, (const bf16_t*)(ws + WS_WPOOL), MT, 1024, 256, 1024, 256, 0, 256}; pg8::StaticOrder S; S.init(MT, 1024, C.G, (int)blockIdx.x);
          pg8::EpiPool E{(bf16_t*)(ws + A_HN), C.in[22]};
          pg8::gemm_phase<pg8::EpiPool>(glds, g, S, E); }
        phase_scanA(C); FILL(5); } SEAM(5);
    if (IN(6)) { phase_scanB(C); } SEAM(6);
    if (IN(7)) { phase_scanC(C); } NEED(7, bq::E_OUTR); SEAM(7);
    if (IN(8)) {
        pg8::Gemm g{(const bf16_t*)(ws + A_HN), (const bf16_t*)(ws + WS_WOUTR), MT, 2048, 2048, 2048, 2048, 0, 0}; pg8::StaticOrder S; S.init(MT, 2048, C.G, (int)blockIdx.x);
        pg8::EpiBf16 E{(bf16_t*)(ws + A_B3), 2048};
        pg8::gemm_phase<pg8::EpiBf16>(glds, g, S, E); FILL(8); } SEAM(8);
#define PEER_BLOCK(P0, L) \
    if (IN(P0)) { phase_resid_norm(C, (L) == 0 ? C.in[0] : X, (L) == 0 ? C.in[1] : X + (size_t)MP * DM, (const bf16_t*)(ws + A_B3), X, C.in[12] + (L) * 2048, mod + (size_t)(L) * NSEQ * 12288, (bf16_t*)(ws + A_B2)); } NEED(P0, (L) == 0 ? bq::E_Q0 : bq::E_Q1); SEAM(P0); \
    if (IN(P0 + 1)) { pg8::Gemm g{(const bf16_t*)(ws + A_B2), (const bf16_t*)(ws + WS_WQ) + (size_t)(L) * 2048 * 2048, MT, 2048, 2048, 2048, 2048, 0, 0}; pg8::StaticOrder S; S.init(MT, 2048, C.G, (int)blockIdx.x); \
        pg8::EpiBf16 E{(bf16_t*)(ws + A_B3), 2048}; pg8::gemm_phase<pg8::EpiBf16>(glds, g, S, E); FILL(P0 + 1); } NEED(P0 + 1, (L) == 0 ? bq::E_KEYS : 0); SEAM(P0 + 1); \
    if (IN(P0 + 2)) { phase_topk(C, L); } NEED(P0 + 2, (L) == 0 ? bq::E_TAB0 : bq::NTOT); SEAM(P0 + 2); \
    if (IN(P0 + 3)) { CLK_BEGIN(P0 + 3) phase_gather(C, L); CLK_END(P0 + 3) }
    PEER_BLOCK(9, 0) NEED(12, bq::E_DKV); SEAM(12);
    if (IN(13)) {
        pg8::Gemm g{(const bf16_t*)(ws + A_HN), (const bf16_t*)(ws + WS_WDQKV), MT, 1024, 2048, 2048, 2048, 0, 0}; pg8::StaticOrder S; S.init(MT, 1024, C.G, (int)blockIdx.x);
        pg8::EpiF32 E{(float*)(ws + A_B3), 1024};
        pg8::gemm_phase<pg8::EpiF32>(glds, g, S, E); FILL(13); } NEED(13, bq::E_ROPE); SEAM(13);
    if (IN(14)) { phase_latent(C); } NEED(14, bq::E_UKV); SEAM(14);
    if (IN(15)) {
        { pg8::Gemm g{(const bf16_t*)(ws + A_CQ), (const bf16_t*)(ws + WS_WUQ), MT, 3072, 512, 512, 512, 0, 0}; pg8::StaticOrder S; S.init(MT, 3072, C.G, (int)blockIdx.x);
          pg8::EpiQ E{(bf16_t*)(ws + A_HN), (bf16_t*)(ws + A_GG), (const float*)(ws + WS_ROPE)};
          pg8::gemm_phase<pg8::EpiQ>(glds, g, S, E); }
        { pg8::Gemm g{(const bf16_t*)(ws + A_CKV), (const bf16_t*)(ws + WS_WUKV), KVROWS, 4096, 256, 256, 256, 0, 0}; pg8::StaticOrder S; S.init(KVROWS, 4096, C.G, (int)blockIdx.x);
          pg8::EpiKV E{(bf16_t*)(ws + A_KN), (bf16_t*)(ws + A_VV)};
          pg8::gemm_phase<pg8::EpiKV>(glds, g, S, E); } FILL(15); } SEAM(15);
    if (IN(16)) { CLK_BEGIN(16) att::attn_phase(C); CLK_END(16) } NEED(16, bq::E_OUTA); SEAM(16);
    if (IN(17)) {
        pg8::Gemm g{(const bf16_t*)(ws + A_HN), (const bf16_t*)(ws + WS_WOUTA), MT, 2048, 2048, 2048, 2048, 0, 0}; pg8::StaticOrder S; S.init(MT, 2048, C.G, (int)blockIdx.x);
        pg8::EpiBf16 E{(bf16_t*)(ws + A_B3), 2048};
        pg8::gemm_phase<pg8::EpiBf16>(glds, g, S, E); FILL(17); } SEAM(17);
    PEER_BLOCK(18, 1)
#undef PEER_BLOCK
#undef IN
#undef SEAM
#undef FILL
#undef NEED
}

extern "C" void kernel_launch(void* const* d_in, const int* in_sizes, int n_in, void* d_out, int out_size, void* d_ws, size_t ws_size, hipStream_t stream) {
    static int grid = 0;
    if (grid == 0) {
        if (n_in != 36 || out_size != (int)O_TOTAL || ws_size < WS_END) { fprintf(stderr, "kernel_launch: built for 36 inputs, %zu outputs, >= %zu B workspace; got n_in %d out %d ws %zu\n", (size_t)O_TOTAL, (size_t)WS_END, n_in, out_size, ws_size); grid = -1; return; }
        int dev = 0, cus = 0, per_cu = 0;
        if (hipGetDevice(&dev) != hipSuccess || hipDeviceGetAttribute(&cus, hipDeviceAttributeMultiprocessorCount, dev) != hipSuccess) { fprintf(stderr, "kernel_launch: device query failed\n"); grid = -1; return; }
        if (hipFuncSetAttribute((const void*)mega_fwd, hipFuncAttributeMaxDynamicSharedMemorySize, LDS_BYTES) != hipSuccess) { fprintf(stderr, "kernel_launch: hipFuncSetAttribute failed\n"); grid = -1; return; }
        if (hipOccupancyMaxActiveBlocksPerMultiprocessor(&per_cu, (const void*)mega_fwd, 512, LDS_BYTES) != hipSuccess || per_cu < 1) { fprintf(stderr, "kernel_launch: occupancy query says %d blocks per CU\n", per_cu); }
        (void)hipGetLastError();
        grid = cus;
    }
    if (grid < 0) return;
    (void)hipMemsetAsync(d_ws, 0, WS_ZERO_BYTES, stream);
    Args a{};
    for (int i = 0; i < 36; ++i) a.in[i] = (const float*)d_in[i];
    a.out = (float*)d_out; a.ws = (unsigned char*)d_ws;
#if MK_SPLIT
    for (int p = 0; p < N_PHASES; ++p) { a.ph_lo = p; a.ph_hi = p + 1; hipLaunchKernelGGL(mega_fwd, dim3(grid), dim3(512), LDS_BYTES, stream, a); }
#elif defined(PROBE_RANGES)
    { const int rg[][2] = {PROBE_RANGES};
      for (unsigned i = 0; i < sizeof(rg) / sizeof(rg[0]); ++i) { if (i) (void)hipMemsetAsync(d_ws, 0, 1 * MiB, stream); a.ph_lo = rg[i][0]; a.ph_hi = rg[i][1]; hipLaunchKernelGGL(mega_fwd, dim3(grid), dim3(512), LDS_BYTES, stream, a); } }
#else
    a.ph_lo = 0; a.ph_hi = N_PHASES; hipLaunchKernelGGL(mega_fwd, dim3(grid), dim3(512), LDS_BYTES, stream, a);
#endif
    const hipError_t le = hipPeekAtLastError();
    if (le != hipSuccess) fprintf(stderr, "kernel_launch: launch failed: %s\n", hipGetErrorName(le));
}
```

```cpp
#include <hip/hip_runtime.h>
#include <cstdio>
#include <cstdint>

#define LAS __attribute__((address_space(3)))
#define GAS __attribute__((address_space(1)))
typedef unsigned short bf16_t;
typedef short bf16x8 __attribute__((ext_vector_type(8)));
typedef short s16x4 __attribute__((ext_vector_type(4)));
typedef float f32x2 __attribute__((ext_vector_type(2)));
typedef float f32x4 __attribute__((ext_vector_type(4)));
typedef float f32x16 __attribute__((ext_vector_type(16)));
typedef unsigned u32x2 __attribute__((ext_vector_type(2)));
typedef unsigned u32x4 __attribute__((ext_vector_type(4)));

constexpr int DM = 2048;
constexpr int MP = 32768, MS = 2048, MT = MP + MS;
constexpr int NSEQ = 34;
constexpr int KVROWS = MP + 32 * 1088;
constexpr float RMS_EPS = 1e-6f;

__device__ __forceinline__ int seq_of_row(int m) { return m < MP ? (m >> 14) : 2 + ((m - MP) >> 6); }
__device__ __forceinline__ int pos_of_row(int m) { return m < MP ? (m & 16383) : 1024 + ((m - MP) & 63); }
__device__ __forceinline__ int kvrow_of_row(int m) { return m < MP ? m : MP + ((m - MP) >> 6) * 1088 + 1024 + ((m - MP) & 63); }

__device__ __forceinline__ unsigned cvt_pk_bf16(float lo, float hi) { unsigned r; asm volatile("v_cvt_pk_bf16_f32 %0, %1, %2" : "=v"(r) : "v"(lo), "v"(hi)); return r; }
__device__ __forceinline__ float bf_lo(unsigned w) { return __uint_as_float(w << 16); }
__device__ __forceinline__ float bf_hi(unsigned w) { return __uint_as_float(w & 0xffff0000u); }
__device__ __forceinline__ float fexp(float x) { return __builtin_amdgcn_exp2f(x * 1.4426950408889634f); }
__device__ __forceinline__ float fsigmoid(float x) { return __builtin_amdgcn_rcpf(1.0f + __builtin_amdgcn_exp2f(-1.4426950408889634f * x)); }
__device__ __forceinline__ float gelu_tanh(float x) { const float u = x * (1.0f + 0.044715f * x * x); return x * __builtin_amdgcn_rcpf(1.0f + __builtin_amdgcn_exp2f(-2.302208198f * u)); }
__device__ __forceinline__ float gelu_erf(float v) {
    const float av = __builtin_fabsf(v), t = __builtin_amdgcn_rcpf(av * 0.2316418882f + 1.0f);
    float q = t * 0.5307027145f + (-0.7265760135f); q = q * t + 0.7107068705f; q = q * t + (-0.142248368f); q = q * t + 0.127414796f; q = q * t;
    const float e = __builtin_amdgcn_exp2f((v * v) * (-0.72134752044f));
    const float m = v * (q * e); return v < 0.f ? m : v - m;
}
__device__ __forceinline__ float wave_sum(float v) {
#pragma unroll
    for (int o = 32; o >= 1; o >>= 1) v += __shfl_xor(v, o);
    return v;
}

namespace pg8 {
constexpr int BM = 256, BK = 64, HALF = 128, HTB = HALF * BK * 2, STAGE_BYTES = 8 * HTB, NXCD = 8, WGM = 8;
__host__ __device__ __forceinline__ int lds_byte(int r, int c) { const int st = (r >> 4) * 2 + (c >> 5), rr = r & 15, cc = c & 31, ob = rr * 64 + cc * 2; return st * 1024 + (ob ^ (((ob >> 9) & 1) << 5)); }
__host__ __device__ __forceinline__ void stage_rc(int b, int& R, int& C) { const int st = b / 1024, sb = b % 1024, swz = sb ^ (((sb >> 9) & 1) << 5); R = (st >> 1) * 16 + swz / 64; C = (st & 1) * 32 + (swz % 64) / 2; }
__host__ __device__ __forceinline__ int perm32(int rho) { const int n = rho >> 4, i = rho & 15; return 8 * (i >> 2) + 4 * n + (i & 3); }

struct Unit { int pm, pn; };
struct Gemm { const bf16_t* A; const bf16_t* Bt; int M, N, K, lda, ldb, kshift, kmul; };

struct StaticOrder {
    int nM, nN, nwg, G, c;
    __host__ __device__ void init(int M, int N, int G_, int c_) { nM = M / BM; nN = N / BM; nwg = nM * nN; G = G_; c = c_; }
    __host__ __device__ bool next(int i, Unit& u) const {
        const long L = (long)i * G + c; if (L >= nwg) return false;
        int wgid = (int)L; { const int q = nwg / NXCD, r = nwg % NXCD, xcd = wgid % NXCD, off = wgid / NXCD; wgid = (xcd < r ? xcd * (q + 1) : r * (q + 1) + (xcd - r) * q) + off; }
        const int nig = WGM * nN, gid = wgid / nig, fm = gid * WGM, gsz = (nM - fm) < WGM ? (nM - fm) : WGM;
        u.pm = fm + ((wgid % nig) % gsz); u.pn = (wgid % nig) / gsz; return true;
    }
};

template <class Epi>
__device__ __forceinline__ void gemm_phase(LAS unsigned char* lds, const Gemm g, const StaticOrder& S, const Epi& E) {
    const int tid = threadIdx.x, wid = __builtin_amdgcn_readfirstlane(tid >> 6), lane = tid & 63, wr = wid >> 2, wc = wid & 3, fr = lane & 15, fq = lane >> 4;
    int Kq = g.K; asm volatile("" : "+s"(Kq));
    const int K = Kq, nt = K / BK;
    unsigned voffA[2], voffB[2];
#pragma unroll
    for (int i = 0; i < 2; ++i) { int R, C; stage_rc(tid * 16 + i * 8192, R, C); const int Rb = Epi::PERM ? ((R & ~31) + perm32(R & 31)) : R;
        voffA[i] = (unsigned)(R * g.lda + C) * 2u; voffB[i] = (unsigned)(Rb * g.ldb + C) * 2u; }
    const size_t kstep = (size_t)(BK * 2);
    const size_t hstepA = (size_t)HALF * g.lda * 2, hstepB = (size_t)HALF * g.ldb * 2;
    const unsigned ldsw = (unsigned)wid * 1024u;
    const int aoff = lds_byte(wr * 64 + fr, fq * 8), boff = lds_byte(wc * 32 + fr, fq * 8);
#define PG8_SA(b, h) (((b) * 2 + (h)) * HTB)
#define PG8_SB(b, h) ((4 + (b) * 2 + (h)) * HTB)
#define PG8_STAGE(bufoff, gbase, voff) do { _Pragma("unroll") for (int _i = 0; _i < 2; ++_i) \
        __builtin_amdgcn_global_load_lds((const unsigned*)((const char*)(gbase) + (voff)[_i]), (LAS unsigned*)(lds + (bufoff) + ldsw + _i * 8192), 16, 0, 0); } while (0)
#define PG8_LDA(dst, b, h) do { _Pragma("unroll") for (int m = 0; m < 4; ++m) _Pragma("unroll") for (int k = 0; k < 2; ++k) dst[m][k] = *(const LAS bf16x8*)(lds + PG8_SA(b, h) + aoff + m * 2048 + k * 1024); } while (0)
#define PG8_LDB(dst, b, h) do { _Pragma("unroll") for (int n = 0; n < 2; ++n) _Pragma("unroll") for (int k = 0; k < 2; ++k) dst[n][k] = *(const LAS bf16x8*)(lds + PG8_SB(b, h) + boff + n * 2048 + k * 1024); } while (0)
#define PG8_MMA(ai, bj, At, Bt) do { __builtin_amdgcn_s_setprio(1); _Pragma("unroll") for (int m = 0; m < 4; ++m) _Pragma("unroll") for (int n = 0; n < 2; ++n) _Pragma("unroll") for (int k = 0; k < 2; ++k) \
        acc[ai][bj][m][n] = __builtin_amdgcn_mfma_f32_16x16x32_bf16(Bt[n][k], At[m][k], acc[ai][bj][m][n], 0, 0, 0); __builtin_amdgcn_s_setprio(0); } while (0)
#define PG8_WAIT_V(n) asm volatile("s_waitcnt vmcnt(" #n ")" ::: "memory")
#define PG8_WAIT_L(n) asm volatile("s_waitcnt lgkmcnt(" #n ")" ::: "memory")
#define PG8_BAR __builtin_amdgcn_s_barrier()
#define PG8_SCHED __builtin_amdgcn_sched_barrier(0)
#define PG8_ABASE(u) ((const char*)g.A + (size_t)(u).pm * (2 * hstepA) + (size_t)(((u).pn >> g.kshift) * g.kmul) * 2)
#define PG8_BBASE(u) ((const char*)g.Bt + (size_t)(u).pn * (2 * hstepB))
    Unit cur, nxt; int ui = 0;
    if (!S.next(0, cur)) return;
    f32x4 acc[2][2][4][2];
#pragma unroll
    for (int a = 0; a < 2; ++a)
#pragma unroll
        for (int b = 0; b < 2; ++b)
#pragma unroll
            for (int m = 0; m < 4; ++m)
#pragma unroll
                for (int n = 0; n < 2; ++n) acc[a][b][m][n] = (f32x4){0.f, 0.f, 0.f, 0.f};
    bf16x8 At[4][2], B0[2][2], B1[2][2];
    const char* cA = PG8_ABASE(cur); const char* cB = PG8_BBASE(cur);
    PG8_STAGE(PG8_SB(0, 0), cB, voffB); PG8_STAGE(PG8_SB(0, 1), cB + hstepB, voffB); PG8_STAGE(PG8_SA(0, 0), cA, voffA); PG8_STAGE(PG8_SA(0, 1), cA + hstepA, voffA);
    if (wr == 1) PG8_BAR;
    PG8_WAIT_V(2); PG8_BAR;
    PG8_STAGE(PG8_SB(1, 0), cB + kstep, voffB); PG8_STAGE(PG8_SA(1, 0), cA + kstep, voffA); PG8_STAGE(PG8_SB(1, 1), cB + hstepB + kstep, voffB);
    PG8_WAIT_V(6); PG8_BAR;
    for (;;) {
        const bool has_next = S.next(ui + 1, nxt);
        const char* nA = has_next ? PG8_ABASE(nxt) : cA; const char* nB = has_next ? PG8_BBASE(nxt) : cB;
        for (int t = 0; t < nt; t += 2) {
            const bool last = (t == nt - 2);
            const char* a1 = cA + (size_t)(t + 1) * kstep;
            const char* a2 = last ? nA : cA + (size_t)(t + 2) * kstep; const char* b2 = last ? nB : cB + (size_t)(t + 2) * kstep;
            const char* a3 = a2 + kstep; const char* b3 = b2 + kstep;
            PG8_LDB(B0, 0, 0); PG8_LDB(B1, 0, 1); PG8_SCHED; PG8_LDA(At, 0, 0); PG8_STAGE(PG8_SA(1, 1), a1 + hstepA, voffA);
            PG8_WAIT_V(8); PG8_WAIT_L(0); PG8_BAR; PG8_MMA(0, 0, At, B0); PG8_MMA(0, 1, At, B1); PG8_BAR; PG8_SCHED;
            PG8_LDA(At, 0, 1); PG8_STAGE(PG8_SB(0, 0), b2, voffB); PG8_STAGE(PG8_SB(0, 1), b2 + hstepB, voffB); PG8_STAGE(PG8_SA(0, 0), a2, voffA);
            PG8_WAIT_V(8); PG8_WAIT_L(0); PG8_BAR; PG8_MMA(1, 0, At, B0); PG8_MMA(1, 1, At, B1); PG8_BAR; PG8_SCHED;
            PG8_LDB(B0, 1, 0); PG8_LDB(B1, 1, 1); PG8_SCHED; PG8_LDA(At, 1, 0); PG8_STAGE(PG8_SA(0, 1), a2 + hstepA, voffA);
            PG8_WAIT_V(8); PG8_WAIT_L(0); PG8_BAR; PG8_MMA(0, 0, At, B0); PG8_MMA(0, 1, At, B1); PG8_BAR; PG8_SCHED;
            PG8_LDA(At, 1, 1); PG8_STAGE(PG8_SB(1, 0), b3, voffB); PG8_STAGE(PG8_SB(1, 1), b3 + hstepB, voffB); PG8_STAGE(PG8_SA(1, 0), a3, voffA);
            PG8_WAIT_V(8); PG8_WAIT_L(0); PG8_BAR; PG8_MMA(1, 0, At, B0); PG8_MMA(1, 1, At, B1); PG8_BAR; PG8_SCHED;
        }
        if (wr == 0) PG8_BAR;
        E(acc, cur, wr, wc, fr, fq);
        if (!has_next) break;
#pragma unroll
        for (int a = 0; a < 2; ++a)
#pragma unroll
            for (int b = 0; b < 2; ++b)
#pragma unroll
                for (int m = 0; m < 4; ++m)
#pragma unroll
                    for (int n = 0; n < 2; ++n) acc[a][b][m][n] = (f32x4){0.f, 0.f, 0.f, 0.f};
        cur = nxt; cA = nA; cB = nB; ++ui;
        if (wr == 1) PG8_BAR;
    }
    PG8_WAIT_V(0);
    PG8_BAR;
#undef PG8_SA
#undef PG8_SB
#undef PG8_STAGE
#undef PG8_LDA
#undef PG8_LDB
#undef PG8_MMA
#undef PG8_WAIT_V
#undef PG8_WAIT_L
#undef PG8_BAR
#undef PG8_SCHED
#undef PG8_ABASE
#undef PG8_BBASE
}
}
namespace pg8 {
#define EPI_ROWS(expr_row) for (int ai = 0; ai < 2; ++ai) for (int m = 0; m < 4; ++m)
struct EpiBf16 {
    static constexpr bool PERM = true;
    bf16_t* O; int ldc;
    __device__ __forceinline__ void operator()(const f32x4 (&acc)[2][2][4][2], const Unit& u, int wr, int wc, int fr, int fq) const {
        const int row0 = u.pm * BM + wr * 64 + fr, col0 = u.pn * BM + wc * 32 + 8 * fq;
#pragma unroll
        for (int ai = 0; ai < 2; ++ai)
#pragma unroll
            for (int m = 0; m < 4; ++m) { bf16_t* rowp = O + (size_t)(row0 + ai * HALF + m * 16) * ldc + col0;
#pragma unroll
                for (int bj = 0; bj < 2; ++bj) { const f32x4 v0 = acc[ai][bj][m][0], v1 = acc[ai][bj][m][1];
                    u32x4 w; w.x = cvt_pk_bf16(v0[0], v0[1]); w.y = cvt_pk_bf16(v0[2], v0[3]); w.z = cvt_pk_bf16(v1[0], v1[1]); w.w = cvt_pk_bf16(v1[2], v1[3]);
                    *(u32x4*)(rowp + bj * HALF) = w; } }
    }
};
struct EpiZ {
    static constexpr bool PERM = true;
    bf16_t* GG; bf16_t* REC; bf16_t* POOL;
    __device__ __forceinline__ void operator()(const f32x4 (&acc)[2][2][4][2], const Unit& u, int wr, int wc, int fr, int fq) const {
        const int t = u.pn >> 2; bf16_t* base = GG + (size_t)t * ((size_t)MT * 1024);
        const int row0 = u.pm * BM + wr * 64 + fr, col0 = (u.pn & 3) * BM + wc * 32 + 8 * fq;
#pragma unroll
        for (int ai = 0; ai < 2; ++ai)
#pragma unroll
            for (int m = 0; m < 4; ++m) { bf16_t* rowp = base + (size_t)(row0 + ai * HALF + m * 16) * 1024 + col0;
#pragma unroll
                for (int bj = 0; bj < 2; ++bj) { f32x4 v0 = acc[ai][bj][m][0], v1 = acc[ai][bj][m][1];
                    if (t == 0) {
#pragma unroll
                        for (int j = 0; j < 4; ++j) { v0[j] = gelu_tanh(v0[j]); v1[j] = gelu_tanh(v1[j]); } }
                    u32x4 w; w.x = cvt_pk_bf16(v0[0], v0[1]); w.y = cvt_pk_bf16(v0[2], v0[3]); w.z = cvt_pk_bf16(v1[0], v1[1]); w.w = cvt_pk_bf16(v1[2], v1[3]);
                    *(u32x4*)(rowp + bj * HALF) = w; } }
    }
};
struct EpiGate {
    static constexpr bool PERM = false;
    const bf16_t* XC; const float* gp; float* Aout;
    __device__ __forceinline__ void operator()(const f32x4 (&acc)[2][2][4][2], const Unit& u, int wr, int wc, int fr, int fq) const {
        const int row0 = u.pm * BM + wr * 64 + fr, ch0 = u.pn * 128 + wc * 32 + 4 * fq;
#pragma unroll
        for (int n = 0; n < 2; ++n) {
            const f32x4 bav = *(const f32x4*)(gp + ch0 + 16 * n), bxv = *(const f32x4*)(gp + 1024 + ch0 + 16 * n), spv = *(const f32x4*)(gp + 2048 + ch0 + 16 * n);
#pragma unroll
            for (int ai = 0; ai < 2; ++ai)
#pragma unroll
                for (int m = 0; m < 4; ++m) { const int row = row0 + ai * HALF + m * 16; const bool pos0 = (row < MP) && ((row & 16383) == 0);
                    const size_t off = (size_t)row * 1024 + ch0 + 16 * n;
                    const u32x2 xw = *(const u32x2*)(XC + off); const float xc[4] = {bf_lo(xw.x), bf_hi(xw.x), bf_lo(xw.y), bf_hi(xw.y)};
                    f32x4 av, uv;
#pragma unroll
                    for (int j = 0; j < 4; ++j) { const float r = fsigmoid(acc[ai][0][m][n][j] + bav[j]), ig = fsigmoid(acc[ai][1][m][n][j] + bxv[j]);
                        const float log_a = -8.0f * r * spv[j]; const float a = fexp(log_a); const float mult = pos0 ? 1.0f : __builtin_sqrtf(fmaxf(1.0f - a * a, 0.0f));
                        av[j] = a; uv[j] = mult * ig * xc[j]; }
                    *(f32x4*)(Aout + off) = av; { u32x2 uw; uw.x = cvt_pk_bf16(uv[0], uv[1]); uw.y = cvt_pk_bf16(uv[2], uv[3]); *(u32x2*)((bf16_t*)(Aout + (size_t)MT * 1024) + off) = uw; } asm volatile("" ::: "memory"); }
        }
    }
};
struct EpiPool {
    static constexpr bool PERM = true;
    bf16_t* CAT; const float* spool;
    __device__ __forceinline__ void operator()(const f32x4 (&acc)[2][2][4][2], const Unit& u, int wr, int wc, int fr, int fq) const {
        const int row0 = u.pm * BM + wr * 64 + fr, col0 = u.pn * BM + wc * 32 + 8 * fq;
        f32x4 s0[2], s1[2];
#pragma unroll
        for (int bj = 0; bj < 2; ++bj) { s0[bj] = *(const f32x4*)(spool + col0 + bj * HALF); s1[bj] = *(const f32x4*)(spool + col0 + bj * HALF + 4); }
#pragma unroll
        for (int ai = 0; ai < 2; ++ai)
#pragma unroll
            for (int m = 0; m < 4; ++m) { bf16_t* rowp = CAT + (size_t)(row0 + ai * HALF + m * 16) * 2048 + 1024 + col0;
#pragma unroll
                for (int bj = 0; bj < 2; ++bj) { const f32x4 v0 = acc[ai][bj][m][0] * s0[bj], v1 = acc[ai][bj][m][1] * s1[bj];
                    u32x4 w; w.x = cvt_pk_bf16(v0[0], v0[1]); w.y = cvt_pk_bf16(v0[2], v0[3]); w.z = cvt_pk_bf16(v1[0], v1[1]); w.w = cvt_pk_bf16(v1[2], v1[3]);
                    *(u32x4*)(rowp + bj * HALF) = w; } }
    }
};
struct EpiResid {
    static constexpr bool PERM = false;
    const float* xinP; const float* xinS; float* xout; const float* gate;
    __device__ __forceinline__ void operator()(const f32x4 (&acc)[2][2][4][2], const Unit& u, int wr, int wc, int fr, int fq) const {
        const int row0 = u.pm * BM + wr * 64 + fr, col0 = u.pn * BM + wc * 32 + 4 * fq;
#pragma unroll
        for (int ai = 0; ai < 2; ++ai)
#pragma unroll
            for (int m = 0; m < 4; ++m) { const int row = row0 + ai * HALF + m * 16; const float* gp = gate + (size_t)seq_of_row(row) * 12288 + col0;
                const float* xi = (row < MP ? xinP + (size_t)row * DM : xinS + (size_t)(row - MP) * DM) + col0; float* xo = xout + (size_t)row * DM + col0;
#pragma unroll
                for (int bj = 0; bj < 2; ++bj)
#pragma unroll
                    for (int n = 0; n < 2; ++n) { const int o = bj * HALF + n * 16; *(f32x4*)(xo + o) = *(const f32x4*)(xi + o) + *(const f32x4*)(gp + o) * acc[ai][bj][m][n]; }
                asm volatile("" ::: "memory"); }
    }
};
struct EpiF32 {
    static constexpr bool PERM = false;
    float* C; int ldc;
    __device__ __forceinline__ void operator()(const f32x4 (&acc)[2][2][4][2], const Unit& u, int wr, int wc, int fr, int fq) const {
        const int row0 = u.pm * BM + wr * 64 + fr, col0 = u.pn * BM + wc * 32 + 4 * fq;
#pragma unroll
        for (int ai = 0; ai < 2; ++ai)
#pragma unroll
            for (int m = 0; m < 4; ++m) { float* rowp = C + (size_t)(row0 + ai * HALF + m * 16) * ldc + col0;
#pragma unroll
                for (int bj = 0; bj < 2; ++bj)
#pragma unroll
                    for (int n = 0; n < 2; ++n) *(f32x4*)(rowp + bj * HALF + n * 16) = acc[ai][bj][m][n]; }
    }
};
struct EpiQ {
    static constexpr bool PERM = true;
    static constexpr float QS = 0.07216878364870322f * 1.4426950408889634f;
    bf16_t* Qn; bf16_t* Qp; const float* rope;
    __device__ __forceinline__ void operator()(const f32x4 (&acc)[2][2][4][2], const Unit& u, int wr, int wc, int fr, int fq) const {
        const int row0 = u.pm * BM + wr * 64 + fr;
        if (u.pn < 8) {
            const int col0 = u.pn * BM + wc * 32 + 8 * fq;
#pragma unroll
            for (int ai = 0; ai < 2; ++ai)
#pragma unroll
                for (int m = 0; m < 4; ++m) { bf16_t* rowp = Qn + (size_t)(row0 + ai * HALF + m * 16) * 2048 + col0;
#pragma unroll
                    for (int bj = 0; bj < 2; ++bj) { const f32x4 v0 = acc[ai][bj][m][0] * QS, v1 = acc[ai][bj][m][1] * QS;
                        u32x4 w; w.x = cvt_pk_bf16(v0[0], v0[1]); w.y = cvt_pk_bf16(v0[2], v0[3]); w.z = cvt_pk_bf16(v1[0], v1[1]); w.w = cvt_pk_bf16(v1[2], v1[3]);
                        *(u32x4*)(rowp + bj * HALF) = w; } }
        } else {
            const int head = (u.pn - 8) * 4 + wc, j0 = 8 * fq;
#pragma unroll
            for (int ai = 0; ai < 2; ++ai)
#pragma unroll
                for (int m = 0; m < 4; ++m) { const int row = row0 + ai * HALF + m * 16; const float* rp = rope + (size_t)pos_of_row(row) * 64 + j0;
                    const f32x4 c0 = *(const f32x4*)(rp), c1 = *(const f32x4*)(rp + 4), s0 = *(const f32x4*)(rp + 32), s1 = *(const f32x4*)(rp + 36);
                    const f32x4 x10 = acc[ai][0][m][0] * QS, x11 = acc[ai][0][m][1] * QS, x20 = acc[ai][1][m][0] * QS, x21 = acc[ai][1][m][1] * QS;
                    const f32x4 a0 = x10 * c0 - x20 * s0, a1 = x11 * c1 - x21 * s1, b0 = x10 * s0 + x20 * c0, b1 = x11 * s1 + x21 * c1;
                    bf16_t* qp = Qp + (size_t)row * 1024 + head * 64 + j0;
                    u32x4 w; w.x = cvt_pk_bf16(a0[0], a0[1]); w.y = cvt_pk_bf16(a0[2], a0[3]); w.z = cvt_pk_bf16(a1[0], a1[1]); w.w = cvt_pk_bf16(a1[2], a1[3]); *(u32x4*)qp = w;
                    w.x = cvt_pk_bf16(b0[0], b0[1]); w.y = cvt_pk_bf16(b0[2], b0[3]); w.z = cvt_pk_bf16(b1[0], b1[1]); w.w = cvt_pk_bf16(b1[2], b1[3]); *(u32x4*)(qp + 32) = w; }
        }
    }
};
struct EpiKV {
    static constexpr bool PERM = true;
    bf16_t* Kn; bf16_t* V;
    __device__ __forceinline__ void operator()(const f32x4 (&acc)[2][2][4][2], const Unit& u, int wr, int wc, int fr, int fq) const {
        const int row0 = u.pm * BM + wr * 64 + fr, col0 = u.pn * 128 + wc * 32 + 8 * fq;
#pragma unroll
        for (int ai = 0; ai < 2; ++ai)
#pragma unroll
            for (int m = 0; m < 4; ++m) { const size_t off = (size_t)(row0 + ai * HALF + m * 16) * 2048 + col0;
#pragma unroll
                for (int bj = 0; bj < 2; ++bj) { const f32x4 v0 = acc[ai][bj][m][0], v1 = acc[ai][bj][m][1];
                    u32x4 w; w.x = cvt_pk_bf16(v0[0], v0[1]); w.y = cvt_pk_bf16(v0[2], v0[3]); w.z = cvt_pk_bf16(v1[0], v1[1]); w.w = cvt_pk_bf16(v1[2], v1[3]);
                    *(u32x4*)((bj ? V : Kn) + off) = w; } }
    }
};
#undef EPI_ROWS
}

#define XB_TMO      128
#define XB_XCNT(j)  (256  + 64 * (j))
#define XB_XSUB(j)  (1280 + 64 * (j))
#define XB_XGEN(j)  (2304 + 64 * (j))
#define XB_TOP      3328
#define XB_TOPGEN   3392
#define XCD_BAR_WORDS 3456
#define XB_SPIN_CAP (1u << 18)
__device__ __forceinline__ unsigned xb_ld(unsigned* p)              { return __hip_atomic_load(p, __ATOMIC_RELAXED, __HIP_MEMORY_SCOPE_AGENT); }
__device__ __forceinline__ unsigned xb_add(unsigned* p, unsigned v) { return __hip_atomic_fetch_add(p, v, __ATOMIC_RELAXED, __HIP_MEMORY_SCOPE_AGENT); }
__device__ __forceinline__ unsigned xb_xcc_id() { return (unsigned)__builtin_amdgcn_s_getreg((3 << 11) | 20) & 0xFu; }
#define XB_SPIN(cond, bar) do { unsigned _sp = 0; while (cond) { __builtin_amdgcn_s_sleep(1); \
    if ((++_sp & 255u) == 0u) { if (xb_ld(&(bar)[XB_TMO])) break; if (_sp > XB_SPIN_CAP) { atomicAdd(&(bar)[XB_TMO], 1u); break; } } } } while (0)
struct XcdBarrier { unsigned* bar; unsigned x; volatile LAS unsigned* st; };
__device__ __forceinline__ XcdBarrier xcd_barrier_post(unsigned* bar, volatile LAS unsigned* st) {
    XcdBarrier b; b.bar = bar; b.x = xb_xcc_id(); b.st = st;
    if (threadIdx.x == 0) (void)xb_add(&bar[XB_XCNT(b.x)], 1u);
    return b;
}
__device__ __forceinline__ void xcd_barrier_complete(unsigned* bar, unsigned x, unsigned& nloc, unsigned& nx) {
    const unsigned G = gridDim.x * gridDim.y * gridDim.z;
    unsigned sum, cnt, mine, sp = 0u;
    for (;;) {
        sum = 0u; cnt = 0u; mine = 0u;
#pragma unroll
        for (unsigned j = 0; j < 16; ++j) { const unsigned c = xb_ld(&bar[XB_XCNT(j)]); sum += c; cnt += (c > 0u) ? 1u : 0u; mine = (j == x) ? c : mine; }
        if (sum == G) break;
        __builtin_amdgcn_s_sleep(1);
        if ((++sp & 255u) == 0u) { if (xb_ld(&bar[XB_TMO])) break; if (sp > XB_SPIN_CAP) { atomicAdd(&bar[XB_TMO], 1u); break; } }
    }
    nloc = mine > 0u ? mine : 1u; nx = cnt > 0u ? cnt : 1u;
}
__device__ __forceinline__ void xcd_barrier(const XcdBarrier& b) {
    asm volatile("s_waitcnt vmcnt(0)" ::: "memory");
    __syncthreads();
    if (threadIdx.x == 0) {
        unsigned* bar = b.bar;
        __builtin_amdgcn_s_waitcnt(0);
        unsigned nloc = b.st[0], nx = b.st[1];
        if (nloc == 0u) { xcd_barrier_complete(bar, b.x, nloc, nx); b.st[0] = nloc; b.st[1] = nx; }
        const unsigned old = xb_add(&bar[XB_XSUB(b.x)], 1u);
        const unsigned gen = old / nloc;
        if (old + 1u == (gen + 1u) * nloc) {
            __builtin_amdgcn_fence(__ATOMIC_RELEASE, "agent");
            asm volatile("s_waitcnt vmcnt(0)" ::: "memory");
            const unsigned og = xb_add(&bar[XB_TOP], 1u);
            const unsigned tg = og / nx;
            if (og + 1u == (tg + 1u) * nx) xb_add(&bar[XB_TOPGEN], 1u);
            else XB_SPIN(xb_ld(&bar[XB_TOPGEN]) == tg, bar);
            __builtin_amdgcn_fence(__ATOMIC_ACQUIRE, "agent");
            xb_add(&bar[XB_XGEN(b.x)], 1u);
            asm volatile("s_waitcnt vmcnt(0)" ::: "memory");
        } else {
            XB_SPIN(xb_ld(&bar[XB_XGEN(b.x)]) == gen, bar);
            __builtin_amdgcn_fence(__ATOMIC_ACQUIRE, "agent");
            asm volatile("s_waitcnt vmcnt(0)" ::: "memory");
        }
    }
    __syncthreads();
}
constexpr float U8_SCALE = 256.0f, V8_SCALE = 16.0f;
__device__ __forceinline__ void convert_fp8_range(const float* src, unsigned char* dst, float scale, size_t n16, size_t i0, size_t stride) {
    for (size_t i = i0; i < n16; i += stride) { u32x4 w;
#pragma unroll
        for (int q = 0; q < 4; ++q) { f32x4 a = *(const f32x4*)(src + i * 16 + 4 * q) * scale;
#pragma unroll
            for (int j = 0; j < 4; ++j) a[j] = fminf(fmaxf(a[j], -448.0f), 448.0f);
            int t = 0; t = __builtin_amdgcn_cvt_pk_fp8_f32(a[0], a[1], t, false); t = __builtin_amdgcn_cvt_pk_fp8_f32(a[2], a[3], t, true); w[q] = (unsigned)t; }
        *(u32x4*)(dst + i * 16) = w; }
}
constexpr float U4_SCALE = 90.50966799f, V4_SCALE = 8.0f;
__device__ __forceinline__ void convert_fp4_rows(const float* src, unsigned char* dst, float scale, int nrows, int w0, int wstride, int lane) {
    for (int r = w0; r < nrows; r += wstride) { const float* sr = src + (size_t)r * 2048 + 4 * lane; u32x4 w;
        f32x4 a[8];
#pragma unroll
        for (int b = 0; b < 8; ++b) a[b] = *(const f32x4*)(sr + 256 * b) * scale;
#pragma unroll
        for (int q = 0; q < 4; ++q) { float e[8] = {a[2 * q][0], a[2 * q][1], a[2 * q][2], a[2 * q][3], a[2 * q + 1][0], a[2 * q + 1][1], a[2 * q + 1][2], a[2 * q + 1][3]};
#pragma unroll
            for (int j = 0; j < 8; ++j) e[j] = fminf(fmaxf(e[j], -6.0f), 6.0f);
            unsigned t = 0u; t = __builtin_amdgcn_cvt_scalef32_pk_fp4_f32(t, e[0], e[1], 1.0f, 0); t = __builtin_amdgcn_cvt_scalef32_pk_fp4_f32(t, e[2], e[3], 1.0f, 1);
            t = __builtin_amdgcn_cvt_scalef32_pk_fp4_f32(t, e[4], e[5], 1.0f, 2); t = __builtin_amdgcn_cvt_scalef32_pk_fp4_f32(t, e[6], e[7], 1.0f, 3); w[q] = t; }
        *(u32x4*)(dst + (size_t)r * 1024 + 16 * lane) = w; }
}
constexpr size_t MiB = (size_t)1 << 20;
constexpr size_t WS_CTL = 0, WS_WGATE = 1 * MiB, WS_WDQKV = 2 * MiB, WS_ZERO_BYTES = 6 * MiB;
constexpr size_t WS_WIN = 6 * MiB, WS_WOUTR = 18 * MiB, WS_WQ = 26 * MiB, WS_WUQ = 42 * MiB, WS_WUKV = 45 * MiB, WS_WOUTA = 47 * MiB;
constexpr size_t WS_WPOOL = 55 * MiB, WS_KEYS = 56 * MiB, WS_MOD = 57 * MiB, WS_ROPE = 61 * MiB, WS_SP = 65 * MiB, WS_SCAN = 66 * MiB;
constexpr size_t WS_U = 73 * MiB, WS_V = 137 * MiB;
constexpr size_t A_HN = 201 * MiB, A_GG = 337 * MiB, A_B2 = 405 * MiB, A_B3 = 541 * MiB, A_B4 = 677 * MiB;
constexpr size_t A_KN = 405 * MiB, A_VV = 669 * MiB, A_KP = 933 * MiB, A_CQ = 942 * MiB, A_CKV = 976 * MiB, WS_END = 1009 * MiB;
constexpr int CW_BAR = 4096;
constexpr size_t SCAN_WORDS = (size_t)544 * 1024;
constexpr size_t O_Y = 0, O_CONV_P = 71303168, O_CONV_S = 71309312, O_H_P = 71407616, O_H_S = 71409664, O_POOL_P = 71442432, O_POOL_S = 71473152,
                 O_CKV = 71964672, O_KPE = 80877568, O_TOTAL = 83105792;
constexpr int LDS_BYTES = 147456, LDS_MISC = 147200;

struct Args { const float* in[36]; float* out; unsigned char* ws; int ph_lo, ph_hi; };

struct Ctx {
    LAS unsigned char* lds; int tid, lane, wave, vcu, G, gw, NGW;
    const float* const* in; float* out; unsigned char* ws;
};

__device__ __forceinline__ void transpose_item(const float* W, int N, int k0, int n0, bf16_t* WT, int dld, int drow0, int dcol0, LAS float* scr, int lane) {
#pragma unroll 8
    for (int i = 0; i < 32; ++i) { const int kk = 2 * i + (lane >> 5); scr[kk * 33 + (lane & 31)] = W[(size_t)(k0 + kk) * N + n0 + (lane & 31)]; }
    asm volatile("s_waitcnt lgkmcnt(0)" ::: "memory");
    const int c = lane & 7;
#pragma unroll
    for (int j = 0; j < 4; ++j) { const int n = (lane >> 3) + 8 * j; const LAS float* s = scr + (8 * c) * 33 + n;
        u32x4 o; o.x = cvt_pk_bf16(s[0 * 33], s[1 * 33]); o.y = cvt_pk_bf16(s[2 * 33], s[3 * 33]); o.z = cvt_pk_bf16(s[4 * 33], s[5 * 33]); o.w = cvt_pk_bf16(s[6 * 33], s[7 * 33]);
        *(u32x4*)(WT + (size_t)(drow0 + n) * dld + dcol0 + 8 * c) = o; }
    asm volatile("s_waitcnt lgkmcnt(0)" ::: "memory");
}
__device__ __forceinline__ void transpose_mat_item(const float* W, int K, int N, bf16_t* WT, int dld, int drow_base, int dcol_base, int item, LAS float* scr, int lane) {
    const int nblk = N / 32, kb = item / nblk, nb = item % nblk;
    transpose_item(W, N, 64 * kb, 32 * nb, WT, dld, drow_base + 32 * nb, dcol_base + 64 * kb, scr, lane);
}
__device__ __forceinline__ void convert_range(const float* src, bf16_t* dst, size_t n8, size_t i0, size_t stride) {
    for (size_t i = i0; i < n8; i += stride) { const f32x4 a = *(const f32x4*)(src + i * 8), b = *(const f32x4*)(src + i * 8 + 4);
        u32x4 w; w.x = cvt_pk_bf16(a[0], a[1]); w.y = cvt_pk_bf16(a[2], a[3]); w.z = cvt_pk_bf16(b[0], b[1]); w.w = cvt_pk_bf16(b[2], b[3]);
        *(u32x4*)(dst + i * 8) = w; }
}

__device__ __forceinline__ void ada_item(const Ctx& C, int item) {
    const int l = item / 96, nb = item % 96, n0 = nb * 128, w = C.wave, lane = C.lane;
    const float* cP = C.in[2]; const float* cS = C.in[3]; const float* W = C.in[9] + (size_t)l * 2048 * 12288 + n0 + 2 * lane; const float* bias = C.in[10] + (size_t)l * 12288 + n0;
    LAS float* scr = (LAS float*)(C.lds + w * 4608);
    LAS float* sum = (LAS float*)(C.lds + 36864);
    f32x2 acc[34];
#pragma unroll
    for (int s = 0; s < 34; ++s) acc[s] = (f32x2){0.f, 0.f};
    for (int sub = 0; sub < 8; ++sub) {
        const int k0 = 256 * w + 32 * sub;
#pragma unroll
        for (int i = 0; i < 17; ++i) { const int idx = lane + 64 * i, s = idx >> 5, kk = idx & 31;
            const float cv = (s < 2) ? cP[s * 2048 + k0 + kk] : cS[(s - 2) * 2048 + k0 + kk];
            scr[kk * 36 + s] = cv * fsigmoid(cv); }
        asm volatile("s_waitcnt lgkmcnt(0)" ::: "memory");
#pragma unroll 1
        for (int kq = 0; kq < 2; ++kq) {
            f32x2 wv[16];
#pragma unroll
            for (int kk = 0; kk < 16; ++kk) wv[kk] = *(const f32x2*)(W + (size_t)(k0 + 16 * kq + kk) * 12288);
#pragma unroll
            for (int kk = 0; kk < 16; ++kk) {
#pragma unroll
                for (int s4 = 0; s4 < 9; ++s4) { const f32x4 sv = *(const LAS f32x4*)(scr + (16 * kq + kk) * 36 + 4 * s4);
#pragma unroll
                    for (int i = 0; i < 4; ++i) if (4 * s4 + i < 34) acc[4 * s4 + i] += wv[kk] * sv[i]; }
                asm volatile("" ::: "memory");
            }
        }
        asm volatile("s_waitcnt lgkmcnt(0)" ::: "memory");
    }
    for (int ww = 0; ww < 8; ++ww) {
        if (w == ww) {
#pragma unroll
            for (int s = 0; s < 34; ++s) { LAS f32x2* p = (LAS f32x2*)(sum + s * 128) + lane; if (ww == 0) *p = acc[s]; else *p = *p + acc[s]; }
        }
        __syncthreads();
    }
    float* mod = (float*)(C.ws + WS_MOD);
    for (int s = w; s < 34; s += 8) { const f32x2 v = *((LAS f32x2*)(sum + s * 128) + lane) + *(const f32x2*)(bias + 2 * lane);
        *(f32x2*)(mod + ((size_t)l * NSEQ + s) * 12288 + n0 + 2 * lane) = v; }
    __syncthreads();
}

namespace bq {
constexpr int I_IN = 32 * 96, I_GATE = 16 * 8, I_POOL = 4 * 32, I_OUTR = 32 * 64, I_Q = 32 * 64, I_KEYS = 256, I_TAB = 16384  , I_DQ = 32 * 16, I_DKV = 32 * 10,
              I_ROPE = 1024, I_UQ = 8 * 96, I_UKV = 4 * 128, I_OUTA = 32 * 64;
constexpr int E_IN = I_IN, E_GATE = E_IN + I_GATE, E_POOL = E_GATE + I_POOL, E_OUTR = E_POOL + I_OUTR, E_Q0 = E_OUTR + I_Q, E_KEYS = E_Q0 + I_KEYS, E_TAB0 = E_KEYS + I_TAB, E_DQ = E_TAB0 + I_DQ,
              E_DKV = E_DQ + I_DKV, E_ROPE = E_DKV + I_ROPE, E_UQ = E_ROPE + I_UQ, E_UKV = E_UQ + I_UKV, E_OUTA = E_UKV + I_OUTA, E_Q1 = E_OUTA + I_Q, E_TAB1 = E_Q1 + I_TAB, NTOT = E_TAB1;
static_assert(NTOT % 8 == 0 && E_IN % 8 == 0 && E_POOL % 8 == 0 && E_OUTR % 8 == 0 && E_Q0 % 8 == 0 && E_KEYS % 8 == 0 && E_TAB0 % 8 == 0 && E_DKV % 8 == 0 && E_ROPE % 8 == 0 && E_UKV % 8 == 0 && E_OUTA % 8 == 0 && E_Q1 % 8 == 0, "queue segments are whole workgroup items");
constexpr int CW_QHEAD = 64, CW_DONE = 128;
constexpr int LDS_SLOT = LDS_MISC + 32;
constexpr size_t TAB_L1 = 16 * MiB;

__device__ __forceinline__ void fp4_row_pair(const float* src, unsigned char* dst, float scale, int r0, int lane) {
    f32x4 a[16];
#pragma unroll
    for (int b = 0; b < 16; ++b) a[b] = *(const f32x4*)(src + (size_t)(r0 + (b >> 3)) * 2048 + 4 * lane + 256 * (b & 7)) * scale;
#pragma unroll
    for (int rr = 0; rr < 2; ++rr) { u32x4 w;
#pragma unroll
        for (int q = 0; q < 4; ++q) { float e[8] = {a[8 * rr + 2 * q][0], a[8 * rr + 2 * q][1], a[8 * rr + 2 * q][2], a[8 * rr + 2 * q][3], a[8 * rr + 2 * q + 1][0], a[8 * rr + 2 * q + 1][1], a[8 * rr + 2 * q + 1][2], a[8 * rr + 2 * q + 1][3]};
#pragma unroll
            for (int j = 0; j < 8; ++j) e[j] = fminf(fmaxf(e[j], -6.0f), 6.0f);
            unsigned t = 0u; t = __builtin_amdgcn_cvt_scalef32_pk_fp4_f32(t, e[0], e[1], 1.0f, 0); t = __builtin_amdgcn_cvt_scalef32_pk_fp4_f32(t, e[2], e[3], 1.0f, 1);
            t = __builtin_amdgcn_cvt_scalef32_pk_fp4_f32(t, e[4], e[5], 1.0f, 2); t = __builtin_amdgcn_cvt_scalef32_pk_fp4_f32(t, e[6], e[7], 1.0f, 3); w[q] = t; }
        *(u32x4*)(dst + (size_t)(r0 + rr) * 1024 + 16 * lane) = w; }
}
__device__ __forceinline__ void table_item(const Ctx& C, int layer, int r, int lane) {
    const int t = r >> 13, rp = r & 8191;
    const float* src = (t ? C.in[34] : C.in[33]) + (size_t)layer * 16384 * 2048; unsigned char* dst = C.ws + (t ? WS_V : WS_U) + (size_t)layer * TAB_L1;
    fp4_row_pair(src, dst, t ? V4_SCALE : U4_SCALE, 2 * rp, lane);
}
__device__ __forceinline__ void wave_item(const Ctx& C, int it, LAS float* scr, int lane) {
    bf16_t* w_in = (bf16_t*)(C.ws + WS_WIN); bf16_t* w_outr = (bf16_t*)(C.ws + WS_WOUTR); bf16_t* w_q = (bf16_t*)(C.ws + WS_WQ);
    bf16_t* w_dqkv = (bf16_t*)(C.ws + WS_WDQKV); bf16_t* w_uq = (bf16_t*)(C.ws + WS_WUQ); bf16_t* w_ukv = (bf16_t*)(C.ws + WS_WUKV);
    bf16_t* w_outa = (bf16_t*)(C.ws + WS_WOUTA); bf16_t* w_gate = (bf16_t*)(C.ws + WS_WGATE); bf16_t* w_pool = (bf16_t*)(C.ws + WS_WPOOL);
    int r = it;
    if (r < I_IN) { transpose_mat_item(C.in[13], 2048, 3072, w_in, 2048, 0, 0, r, scr, lane); return; } r -= I_IN;
    if (r < I_GATE) {
        const int q = r / 8, sub = r % 8, h = q >> 1, gsel = q & 1;
        const float* src = (gsel ? C.in[18] : C.in[16]) + (size_t)h * 128 * 128;
        transpose_mat_item(src, 128, 128, w_gate, 256, h * 256 + gsel * 128, (h & 1) * 128, sub, scr, lane); return; } r -= I_GATE;
    if (r < I_POOL) { const int gq = r / 32, sub = r % 32;
        transpose_mat_item(C.in[21] + (size_t)gq * 256 * 256, 256, 256, w_pool, 256, gq * 256, 0, sub, scr, lane); return; } r -= I_POOL;
    if (r < I_OUTR) { transpose_mat_item(C.in[23], 2048, 2048, w_outr, 2048, 0, 0, r, scr, lane); return; } r -= I_OUTR;
    if (r < I_Q) { transpose_mat_item(C.in[31], 2048, 2048, w_q, 2048, 0, 0, r, scr, lane); return; } r -= I_Q;
    if (r < I_KEYS) { convert_range(C.in[32] + (size_t)r * 2048, (bf16_t*)(C.ws + WS_KEYS) + (size_t)r * 2048, 256, (size_t)lane, 64); return; } r -= I_KEYS;
    if (r < I_TAB) { table_item(C, 0, r, lane); return; } r -= I_TAB;
    if (r < I_DQ) { transpose_mat_item(C.in[24], 2048, 512, w_dqkv, 2048, 0, 0, r, scr, lane); return; } r -= I_DQ;
    if (r < I_DKV) { transpose_mat_item(C.in[27], 2048, 320, w_dqkv, 2048, 512, 0, r, scr, lane); return; } r -= I_DKV;
    if (r < I_ROPE) {
        float* rope = (float*)(C.ws + WS_ROPE);
        for (int q = 0; q < 8; ++q) { const int i = r * 512 + q * 64 + lane, pos = i >> 5, j = i & 31;
            double inv = 1.0; for (int qq = 0; qq < j; ++qq) inv *= 0.7498942093324559;
            const double rev = (double)pos * inv * 0.15915494309189535; const float fr = (float)(rev - __builtin_floor(rev));
            rope[(size_t)pos * 64 + j] = __builtin_amdgcn_cosf(fr); rope[(size_t)pos * 64 + 32 + j] = __builtin_amdgcn_sinf(fr); }
        return; } r -= I_ROPE;
    if (r < I_UQ) {
        const int kb = r / 96, nb = r % 96, n0 = 32 * nb, h = n0 / 192, d = n0 % 192;
        const int drow = (d < 128) ? h * 128 + d : 2048 + (h >> 2) * 256 + ((d - 128) >> 5) * 128 + (h & 3) * 32;
        transpose_item(C.in[26], 3072, 64 * kb, n0, w_uq, 512, drow, 64 * kb, scr, lane); return; } r -= I_UQ;
    if (r < I_UKV) { transpose_mat_item(C.in[29], 256, 4096, w_ukv, 256, 0, 0, r, scr, lane); return; } r -= I_UKV;
    if (r < I_OUTA) { transpose_mat_item(C.in[30], 2048, 2048, w_outa, 2048, 0, 0, r, scr, lane); return; } r -= I_OUTA;
    if (r < I_Q) { transpose_mat_item(C.in[31] + (size_t)2048 * 2048, 2048, 2048, w_q + (size_t)2048 * 2048, 2048, 0, 0, r, scr, lane); return; } r -= I_Q;
    table_item(C, 1, r, lane);
}
__device__ __forceinline__ void service(const Ctx& C, bool fill, int slot, int limit, bool signal = true) {
    unsigned* ctl = (unsigned*)(C.ws + WS_CTL); unsigned* qhead = ctl + CW_QHEAD; unsigned* done = ctl + CW_DONE + slot;
    volatile LAS int* lslot = (volatile LAS int*)(C.lds + LDS_SLOT);
    LAS float* scr = (LAS float*)(C.lds + 72704 + C.wave * 8448);
    __syncthreads();
    if (fill && signal && C.tid == 0) __hip_atomic_fetch_add(done, 1u, __ATOMIC_RELAXED, __HIP_MEMORY_SCOPE_AGENT);
    const unsigned lim = fill ? (unsigned)(NTOT / 8) : (unsigned)(limit / 8);
    for (;;) {
        if (C.tid == 0) { int it = -1;
            const unsigned h = __hip_atomic_load(qhead, __ATOMIC_RELAXED, __HIP_MEMORY_SCOPE_AGENT);
            bool go = h < lim;
            if (go && fill) go = __hip_atomic_load(done, __ATOMIC_RELAXED, __HIP_MEMORY_SCOPE_AGENT) < (unsigned)C.G;
            if (go) { const unsigned t = __hip_atomic_fetch_add(qhead, 1u, __ATOMIC_RELAXED, __HIP_MEMORY_SCOPE_AGENT); if (t < (unsigned)(NTOT / 8)) it = (int)t; }
            *lslot = it; }
        __syncthreads();
        const int it = *lslot;
        __syncthreads();
        if (it < 0) break;
        { Ctx D = C; int ln = C.lane; asm volatile("" : "+v"(ln)); D.lane = ln;
          wave_item(D, it * 8 + C.wave, scr, ln); }
    }
}
}

__device__ __forceinline__ void phase_prologue(const Ctx& C) {
    const int lane = C.lane;
    constexpr int NADA = 192;
    for (int it = C.vcu; it < NADA; it += C.G) ada_item(C, it);
    bq::service(C, true, 0, 0);
    const size_t gt = (size_t)C.vcu * 512 + C.tid, GT = (size_t)C.G * 512;
    { float* sp = (float*)(C.ws + WS_SP);
      for (size_t i = gt; i < 1024; i += GT) { sp[i] = C.in[17][i]; sp[1024 + i] = C.in[19][i]; const float y = fexp(-C.in[20][i]); sp[2048 + i] = (y < 0.03f) ? y * (1.0f - y * (0.5f - y * (0.33333333f - y * (0.25f - 0.2f * y)))) : 0.6931471805599453f * __builtin_amdgcn_logf(1.0f + y); } }
}
__device__ __forceinline__ void norm_mod_row(const float* xrow, const float* g, const float* shift, const float* scale, bf16_t* orow, int lane) {
    f32x4 v[8]; float ss = 0.f;
#pragma unroll
    for (int j = 0; j < 8; ++j) { v[j] = *((const f32x4*)xrow + lane + 64 * j); ss += (v[j].x * v[j].x + v[j].y * v[j].y) + (v[j].z * v[j].z + v[j].w * v[j].w); }
    const float rstd = __builtin_amdgcn_rsqf(wave_sum(ss) * (1.0f / DM) + RMS_EPS);
#pragma unroll
    for (int j = 0; j < 8; ++j) { const int q = lane + 64 * j; const f32x4 gv = *((const f32x4*)g + q), sc = *((const f32x4*)scale + q), sh = *((const f32x4*)shift + q);
        const f32x4 y = v[j] * rstd * gv * (sc + 1.0f) + sh;
        u32x2 w; w.x = cvt_pk_bf16(y.x, y.y); w.y = cvt_pk_bf16(y.z, y.w); *((u32x2*)orow + q) = w; }
}
__device__ __forceinline__ void phase_norm(const Ctx& C, const float* xP, const float* xS, const float* g, const float* modl, int part, bf16_t* hn) {
    const int lane = C.lane; int m = C.gw; if (m >= MT) return;
    f32x4 gv[8];
#pragma unroll
    for (int j = 0; j < 8; ++j) gv[j] = *((const f32x4*)g + lane + 64 * j);
    f32x4 nv[8];
    { const float* xr = (m < MP) ? xP + (size_t)m * DM : xS + (size_t)(m - MP) * DM;
#pragma unroll
      for (int j = 0; j < 8; ++j) nv[j] = *((const f32x4*)xr + lane + 64 * j); }
    for (; m < MT; m += C.NGW) {
        f32x4 v[8];
#pragma unroll
        for (int j = 0; j < 8; ++j) v[j] = nv[j];
        const int mn = m + C.NGW;
        if (mn < MT) { const float* xr = (mn < MP) ? xP + (size_t)mn * DM : xS + (size_t)(mn - MP) * DM;
#pragma unroll
            for (int j = 0; j < 8; ++j) nv[j] = *((const f32x4*)xr + lane + 64 * j); }
        const float* mp = modl + (size_t)seq_of_row(m) * 12288 + part * 2048;
        f32x4 sc[8], sh[8];
#pragma unroll
        for (int j = 0; j < 8; ++j) { const int q = lane + 64 * j; sh[j] = *((const f32x4*)mp + q); sc[j] = *((const f32x4*)(mp + 2048) + q); }
        float ss = 0.f;
#pragma unroll
        for (int j = 0; j < 8; ++j) ss += (v[j].x * v[j].x + v[j].y * v[j].y) + (v[j].z * v[j].z + v[j].w * v[j].w);
        const float rstd = __builtin_amdgcn_rsqf(wave_sum(ss) * (1.0f / DM) + RMS_EPS);
#pragma unroll
        for (int j = 0; j < 8; ++j) { const int q = lane + 64 * j; const f32x4 y = v[j] * rstd * gv[j] * (sc[j] + 1.0f) + sh[j];
            u32x2 w; w.x = cvt_pk_bf16(y.x, y.y); w.y = cvt_pk_bf16(y.z, y.w); *((u32x2*)(hn + (size_t)m * DM) + q) = w; }
    }
}
__device__ __forceinline__ void phase_resid_norm(const Ctx& C, const float* xP, const float* xS, const bf16_t* mix, float* X, const float* g, const float* modl, bf16_t* hn) {
    const int lane = C.lane; int m = C.gw; if (m >= MT) return;
    f32x4 gv[8];
#pragma unroll
    for (int j = 0; j < 8; ++j) gv[j] = *((const f32x4*)g + lane + 64 * j);
    f32x4 nx[8]; u32x2 nm[8];
    { const float* xr = (m < MP) ? xP + (size_t)m * DM : xS + (size_t)(m - MP) * DM;
#pragma unroll
      for (int j = 0; j < 8; ++j) { const int q = lane + 64 * j; nx[j] = *((const f32x4*)xr + q); nm[j] = *((const u32x2*)(mix + (size_t)m * DM) + q); } }
    for (; m < MT; m += C.NGW) {
        f32x4 v[8]; u32x2 mw[8];
#pragma unroll
        for (int j = 0; j < 8; ++j) { v[j] = nx[j]; mw[j] = nm[j]; }
        const int mn = m + C.NGW;
        if (mn < MT) { const float* xr = (mn < MP) ? xP + (size_t)mn * DM : xS + (size_t)(mn - MP) * DM;
#pragma unroll
            for (int j = 0; j < 8; ++j) { const int q = lane + 64 * j; nx[j] = *((const f32x4*)xr + q); nm[j] = *((const u32x2*)(mix + (size_t)mn * DM) + q); } }
        const float* mp = modl + (size_t)seq_of_row(m) * 12288;
        float ss = 0.f;
#pragma unroll
        for (int j = 0; j < 8; ++j) { const int q = lane + 64 * j; const f32x4 g1 = *((const f32x4*)(mp + 2 * 2048) + q);
            v[j] = v[j] + g1 * (f32x4){bf_lo(mw[j].x), bf_hi(mw[j].x), bf_lo(mw[j].y), bf_hi(mw[j].y)}; ss += (v[j].x * v[j].x + v[j].y * v[j].y) + (v[j].z * v[j].z + v[j].w * v[j].w);
            *((f32x4*)(X + (size_t)m * DM) + q) = v[j]; }
        const float rstd = __builtin_amdgcn_rsqf(wave_sum(ss) * (1.0f / DM) + RMS_EPS);
#pragma unroll
        for (int j = 0; j < 8; ++j) { const int q = lane + 64 * j; const f32x4 sh = *((const f32x4*)(mp + 3 * 2048) + q), sc = *((const f32x4*)(mp + 4 * 2048) + q);
            const f32x4 y = v[j] * rstd * gv[j] * (sc + 1.0f) + sh;
            u32x2 w; w.x = cvt_pk_bf16(y.x, y.y); w.y = cvt_pk_bf16(y.z, y.w); *((u32x2*)(hn + (size_t)m * DM) + q) = w; }
    }
}

__device__ __forceinline__ void ld8bf(const bf16_t* p, float (&v)[8]) { const u32x4 w = *(const u32x4*)p; v[0] = bf_lo(w.x); v[1] = bf_hi(w.x); v[2] = bf_lo(w.y); v[3] = bf_hi(w.y); v[4] = bf_lo(w.z); v[5] = bf_hi(w.z); v[6] = bf_lo(w.w); v[7] = bf_hi(w.w); }
__device__ __forceinline__ void ld8f(const float* p, float (&v)[8]) { const f32x4 a = *(const f32x4*)p, b = *(const f32x4*)(p + 4); v[0] = a.x; v[1] = a.y; v[2] = a.z; v[3] = a.w; v[4] = b.x; v[5] = b.y; v[6] = b.z; v[7] = b.w; }
__device__ __forceinline__ void st8bf(bf16_t* p, const float (&v)[8]) { u32x4 w; w.x = cvt_pk_bf16(v[0], v[1]); w.y = cvt_pk_bf16(v[2], v[3]); w.z = cvt_pk_bf16(v[4], v[5]); w.w = cvt_pk_bf16(v[6], v[7]); *(u32x4*)p = w; }
__device__ __forceinline__ void st8f(float* p, const float (&v)[8]) { *(f32x4*)p = (f32x4){v[0], v[1], v[2], v[3]}; *(f32x4*)(p + 4) = (f32x4){v[4], v[5], v[6], v[7]}; }

__device__ __forceinline__ void phase_convpool(const Ctx& C) {
    const bf16_t* __restrict__ REC = (const bf16_t*)(C.ws + A_B2); const bf16_t* __restrict__ PIN = REC + (size_t)MT * 1024;
    bf16_t* __restrict__ XC = (bf16_t*)(C.ws + A_B3); bf16_t* __restrict__ POOLED = XC + (size_t)MT * 1024;
    const float* convw = C.in[14]; const float* convb = C.in[15]; const float* st_conv = C.in[4]; const float* st_pool = C.in[6];
    const int NITEM = 2 * 544 * 128;
    for (int it0 = C.vcu * 512 + C.tid; it0 < NITEM; it0 += C.G * 512) {
        const bool is_pool = it0 >= 544 * 128; const int it = is_pool ? it0 - 544 * 128 : it0;
        const int chunk = it >> 7, ch0 = (it & 127) * 8;
        const bool samp = chunk >= 512; const int sb = chunk - 512;
        const int row0 = samp ? MP + sb * 64 : chunk * 64;
        const int t0 = samp ? 0 : (chunk & 255) * 64;
        const bool lastc = samp || ((chunk & 255) == 255);
        if (!is_pool) {
            float w0[8], w1[8], w2[8], w3[8], bb[8], p0[8], p1[8], p2[8];
            ld8f(convw + ch0, w0); ld8f(convw + 1024 + ch0, w1); ld8f(convw + 2048 + ch0, w2); ld8f(convw + 3072 + ch0, w3); ld8f(convb + ch0, bb);
            if (samp) { ld8f(st_conv + ((size_t)sb * 3 + 0) * 1024 + ch0, p0); ld8f(st_conv + ((size_t)sb * 3 + 1) * 1024 + ch0, p1); ld8f(st_conv + ((size_t)sb * 3 + 2) * 1024 + ch0, p2); }
            else if (t0 > 0) { ld8bf(REC + (size_t)(row0 - 3) * 1024 + ch0, p0); ld8bf(REC + (size_t)(row0 - 2) * 1024 + ch0, p1); ld8bf(REC + (size_t)(row0 - 1) * 1024 + ch0, p2); }
            else {
#pragma unroll
                for (int j = 0; j < 8; ++j) { p0[j] = 0.f; p1[j] = 0.f; p2[j] = 0.f; } }
            for (int tb = 0; tb < 64; tb += 8) {
                u32x4 raw[8];
#pragma unroll
                for (int q = 0; q < 8; ++q) raw[q] = *(const u32x4*)(REC + (size_t)(row0 + tb + q) * 1024 + ch0);
#pragma unroll
                for (int q = 0; q < 8; ++q) { const u32x4 w = raw[q]; const float cur[8] = {bf_lo(w.x), bf_hi(w.x), bf_lo(w.y), bf_hi(w.y), bf_lo(w.z), bf_hi(w.z), bf_lo(w.w), bf_hi(w.w)}; float o[8];
#pragma unroll
                    for (int j = 0; j < 8; ++j) { o[j] = bb[j] + w0[j] * p0[j] + w1[j] * p1[j] + w2[j] * p2[j] + w3[j] * cur[j]; p0[j] = p1[j]; p1[j] = p2[j]; p2[j] = cur[j]; }
                    st8bf(XC + (size_t)(row0 + tb + q) * 1024 + ch0, o); } }
            if (lastc) { float* dst = samp ? C.out + O_CONV_S + (size_t)sb * 3 * 1024 : C.out + O_CONV_P + (size_t)(chunk >> 8) * 3 * 1024;
                st8f(dst + ch0, p0); st8f(dst + 1024 + ch0, p1); st8f(dst + 2048 + ch0, p2); }
        } else {
            const int gsel = ch0 >> 8, w = 2 << gsel;
            float S[8];
#pragma unroll
            for (int j = 0; j < 8; ++j) S[j] = 0.f;
            for (int tt = 1 - w; tt < 0; ++tt) { float v[8];
                if (samp) ld8f(st_pool + ((size_t)sb * 15 + 15 + tt) * 1024 + ch0, v);
                else if (t0 + tt >= 0) ld8bf(PIN + (size_t)(row0 + tt) * 1024 + ch0, v);
                else {
#pragma unroll
                    for (int j = 0; j < 8; ++j) v[j] = 0.f; }
#pragma unroll
                for (int j = 0; j < 8; ++j) S[j] += v[j]; }
            for (int tb = 0; tb < 64; tb += 8) {
                u32x4 rawc[8]; float oldv[8][8];
#pragma unroll
                for (int q = 0; q < 8; ++q) rawc[q] = *(const u32x4*)(PIN + (size_t)(row0 + tb + q) * 1024 + ch0);
#pragma unroll
                for (int q = 0; q < 8; ++q) { const int tt = tb + q - w + 1;
                    if (tt >= 0 || (!samp && t0 + tt >= 0)) ld8bf(PIN + (size_t)(row0 + tt) * 1024 + ch0, oldv[q]);
                    else if (samp) ld8f(st_pool + ((size_t)sb * 15 + 15 + tt) * 1024 + ch0, oldv[q]);
                    else {
#pragma unroll
                        for (int j = 0; j < 8; ++j) oldv[q][j] = 0.f; } }
#pragma unroll
                for (int q = 0; q < 8; ++q) { const u32x4 wv = rawc[q]; const float cur[8] = {bf_lo(wv.x), bf_hi(wv.x), bf_lo(wv.y), bf_hi(wv.y), bf_lo(wv.z), bf_hi(wv.z), bf_lo(wv.w), bf_hi(wv.w)}; float o[8];
                    const int pos = samp ? 1024 + tb + q : t0 + tb + q; const float rc = 1.0f / (float)((pos + 1 < w) ? pos + 1 : w);
#pragma unroll
                    for (int j = 0; j < 8; ++j) { S[j] += cur[j]; o[j] = S[j] * rc - cur[j]; S[j] -= oldv[q][j]; }
                    st8bf(POOLED + (size_t)(row0 + tb + q) * 1024 + ch0, o); } }
            if (lastc) { float* dst = samp ? C.out + O_POOL_S + (size_t)sb * 15 * 1024 : C.out + O_POOL_P + (size_t)(chunk >> 8) * 15 * 1024;
                for (int i = 0; i < 15; ++i) { float v[8]; ld8bf(PIN + (size_t)(row0 + 49 + i) * 1024 + ch0, v); st8f(dst + (size_t)i * 1024 + ch0, v); } }
        }
    }
}

__device__ __forceinline__ void phase_scanA(const Ctx& C) {
    const float* __restrict__ A = (const float*)(C.ws + A_B4); const bf16_t* __restrict__ U = (const bf16_t*)(A + (size_t)MT * 1024);
    float* __restrict__ cP = (float*)(C.ws + WS_SCAN); float* __restrict__ cH = cP + SCAN_WORDS;
    for (int it = C.vcu * 512 + C.tid; it < 544 * 256; it += C.G * 512) {
        const int chunk = it >> 8, ch = (it & 255) * 4; const int row0 = chunk * 64;
        f32x4 P = {1.f, 1.f, 1.f, 1.f}, H = {0.f, 0.f, 0.f, 0.f};
        for (int tb = 0; tb < 64; tb += 8) { f32x4 av[8], uv[8];
#pragma unroll
            for (int q = 0; q < 8; ++q) { av[q] = *(const f32x4*)(A + (size_t)(row0 + tb + q) * 1024 + ch); const u32x2 uw = *(const u32x2*)(U + (size_t)(row0 + tb + q) * 1024 + ch); uv[q] = (f32x4){bf_lo(uw.x), bf_hi(uw.x), bf_lo(uw.y), bf_hi(uw.y)}; }
#pragma unroll
            for (int q = 0; q < 8; ++q) { H = av[q] * H + uv[q]; P = P * av[q]; } }
        *(f32x4*)(cP + (size_t)chunk * 1024 + ch) = P; *(f32x4*)(cH + (size_t)chunk * 1024 + ch) = H;
    }
}
__device__ __forceinline__ void phase_scanB(const Ctx& C) {
    const float* __restrict__ cP = (const float*)(C.ws + WS_SCAN); const float* __restrict__ cH = cP + SCAN_WORDS; float* __restrict__ cI = (float*)(C.ws + WS_SCAN) + 2 * SCAN_WORDS;
    const int it = C.vcu * 512 + C.tid;
    if (it < 2048) { const int s = it >> 10, ch = it & 1023; float carry = 0.f;
        for (int cb = 0; cb < 256; cb += 16) { float pv[16], hv[16];
#pragma unroll
            for (int q = 0; q < 16; ++q) { const size_t o = (size_t)(s * 256 + cb + q) * 1024 + ch; pv[q] = cP[o]; hv[q] = cH[o]; }
#pragma unroll
            for (int q = 0; q < 16; ++q) { cI[(size_t)(s * 256 + cb + q) * 1024 + ch] = carry; carry = pv[q] * carry + hv[q]; } } }
}
__device__ __forceinline__ void phase_scanC(const Ctx& C) {
    const float* __restrict__ A = (const float*)(C.ws + A_B4); const bf16_t* __restrict__ U = (const bf16_t*)(A + (size_t)MT * 1024); const float* __restrict__ cI = (const float*)(C.ws + WS_SCAN) + 2 * SCAN_WORDS;
    const bf16_t* __restrict__ GG = (const bf16_t*)(C.ws + A_GG); bf16_t* __restrict__ CAT = (bf16_t*)(C.ws + A_HN); const float* hprev = C.in[5];
    for (int it = C.vcu * 512 + C.tid; it < 544 * 256; it += C.G * 512) {
        const int chunk = it >> 8, ch = (it & 255) * 4; const int row0 = chunk * 64; const bool samp = chunk >= 512;
        f32x4 h = samp ? *(const f32x4*)(hprev + (size_t)(chunk - 512) * 1024 + ch) : *(const f32x4*)(cI + (size_t)chunk * 1024 + ch);
        for (int tb = 0; tb < 64; tb += 8) { f32x4 av[8], uv[8]; u32x2 gv[8];
#pragma unroll
            for (int q = 0; q < 8; ++q) { const size_t o = (size_t)(row0 + tb + q) * 1024 + ch; av[q] = *(const f32x4*)(A + o); { const u32x2 uw = *(const u32x2*)(U + o); uv[q] = (f32x4){bf_lo(uw.x), bf_hi(uw.x), bf_lo(uw.y), bf_hi(uw.y)}; } gv[q] = *(const u32x2*)(GG + o); }
#pragma unroll
            for (int q = 0; q < 8; ++q) { h = av[q] * h + uv[q];
                u32x2 w; w.x = cvt_pk_bf16(bf_lo(gv[q].x) * h.x, bf_hi(gv[q].x) * h.y); w.y = cvt_pk_bf16(bf_lo(gv[q].y) * h.z, bf_hi(gv[q].y) * h.w);
                *(u32x2*)(CAT + (size_t)(row0 + tb + q) * 2048 + ch) = w; } }
        if (samp) *(f32x4*)(C.out + O_H_S + (size_t)(chunk - 512) * 1024 + ch) = h;
        else if ((chunk & 255) == 255) *(f32x4*)(C.out + O_H_P + (size_t)(chunk >> 8) * 1024 + ch) = h;
    }
}

__device__ __forceinline__ void phase_latent(const Ctx& C) {
    const float* CQKV = (const float*)(C.ws + A_B3); bf16_t* CQ = (bf16_t*)(C.ws + A_CQ); bf16_t* CKV = (bf16_t*)(C.ws + A_CKV); bf16_t* KP = (bf16_t*)(C.ws + A_KP);
    const float* gq = C.in[25]; const float* gkv = C.in[28]; const float* rope = (const float*)(C.ws + WS_ROPE); const int lane = C.lane;
    for (int m = C.gw; m < MT; m += C.NGW) {
        const float* r = CQKV + (size_t)m * 1024; const int kvr = kvrow_of_row(m);
        { float v[8]; ld8f(r + lane * 8, v); float ss = 0.f;
#pragma unroll
          for (int j = 0; j < 8; ++j) ss += v[j] * v[j];
          const float rstd = __builtin_amdgcn_rsqf(wave_sum(ss) * (1.0f / 512) + RMS_EPS); float g[8]; ld8f(gq + lane * 8, g);
#pragma unroll
          for (int j = 0; j < 8; ++j) v[j] = v[j] * rstd * g[j];
          st8bf(CQ + (size_t)m * 512 + lane * 8, v); }
        { const f32x4 v = *(const f32x4*)(r + 512 + lane * 4); const float ss = (v.x * v.x + v.y * v.y) + (v.z * v.z + v.w * v.w);
          const float rstd = __builtin_amdgcn_rsqf(wave_sum(ss) * (1.0f / 256) + RMS_EPS); const f32x4 y = v * rstd * *(const f32x4*)(gkv + lane * 4);
          *(f32x4*)(C.out + O_CKV + (size_t)m * 256 + lane * 4) = y;
          u32x2 w; w.x = cvt_pk_bf16(y.x, y.y); w.y = cvt_pk_bf16(y.z, y.w); *(u32x2*)(CKV + (size_t)kvr * 256 + lane * 4) = w; }
        { const float x = r[768 + lane]; const float xo = __shfl_xor(x, 32); const int j = lane & 31; const float* rp = rope + (size_t)pos_of_row(m) * 64;
          const float c = rp[j], s = rp[32 + j]; const float y = (lane < 32) ? x * c - xo * s : xo * s + x * c;
          C.out[O_KPE + (size_t)m * 64 + lane] = y; const unsigned yb = cvt_pk_bf16(y, y); KP[(size_t)kvr * 64 + lane] = (bf16_t)(yb & 0xffffu); }
    }
    const size_t gt = (size_t)C.vcu * 512 + C.tid, GT = (size_t)C.G * 512;
    for (size_t i = gt; i < (size_t)32 * 1024 * 256 / 8; i += GT) { const size_t e = i * 8, rowc = e / 256, col = e % 256, b = rowc / 1024, p = rowc % 1024;
        float v[8]; ld8f(C.in[7] + e, v); st8bf(CKV + ((size_t)MP + b * 1088 + p) * 256 + col, v); }
    for (size_t i = gt; i < (size_t)32 * 1024 * 64 / 8; i += GT) { const size_t e = i * 8, rowc = e / 64, col = e % 64, b = rowc / 1024, p = rowc % 1024;
        float v[8]; ld8f(C.in[8] + e, v); st8bf(KP + ((size_t)MP + b * 1088 + p) * 64 + col, v); }
}
typedef __bf16 bf2_t __attribute__((ext_vector_type(2)));
__device__ __forceinline__ unsigned ford(float f) { const unsigned u = __float_as_uint(f); return (u & 0x80000000u) ? ~u : (u | 0x80000000u); }
__device__ __forceinline__ float funord(unsigned o) { return __uint_as_float((o & 0x80000000u) ? (o & 0x7fffffffu) : ~o); }
__device__ __forceinline__ unsigned umax(unsigned a, unsigned b) { return a > b ? a : b; }
__device__ __forceinline__ unsigned umin(unsigned a, unsigned b) { return a < b ? a : b; }
__device__ __forceinline__ void ins16(unsigned (&L)[16], unsigned x) {
#pragma unroll
    for (int i = 0; i < 16; ++i) { const unsigned t = umax(L[i], x); x = umin(L[i], x); L[i] = t; }
}
__device__ __forceinline__ void ins16p(unsigned (&K)[16], unsigned (&P)[16], unsigned key, unsigned pay) {
#pragma unroll
    for (int i = 0; i < 16; ++i) { const bool c = key > K[i]; const unsigned tk = c ? key : K[i], nk = c ? K[i] : key, tp = c ? pay : P[i], np = c ? P[i] : pay; K[i] = tk; P[i] = tp; key = nk; pay = np; }
}
__device__ __forceinline__ void sort16_desc(unsigned (&v)[16]) {
#pragma unroll
    for (int k = 2; k <= 16; k <<= 1)
#pragma unroll
        for (int j = k >> 1; j >= 1; j >>= 1)
#pragma unroll
            for (int i = 0; i < 16; ++i) { const int l = i ^ j; if (l > i) { const bool desc = ((i & k) == 0); const unsigned a = v[i], b = v[l], hi = umax(a, b), lo = umin(a, b); v[i] = desc ? hi : lo; v[l] = desc ? lo : hi; } }
}
__device__ __forceinline__ void merge16_desc(unsigned (&A)[16], const unsigned (&B)[16]) {
#pragma unroll
    for (int i = 0; i < 16; ++i) A[i] = umax(A[i], B[15 - i]);
#pragma unroll
    for (int st = 8; st >= 1; st >>= 1)
#pragma unroll
        for (int i = 0; i < 16; ++i) if ((i & st) == 0) { const unsigned a = A[i], b = A[i + st]; A[i] = umax(a, b); A[i + st] = umin(a, b); }
}
__device__ __forceinline__ void subkey_top16(const bf16_t* qrow  , const bf16_t* krow  , int hh, unsigned (&S)[16]) {
    bf16x8 qf[8];
#pragma unroll
    for (int s = 0; s < 8; ++s) qf[s] = *(const bf16x8*)(qrow + 16 * s);
    unsigned L[16];
#pragma unroll
    for (int i = 0; i < 16; ++i) L[i] = 0u;
#pragma unroll 1
    for (int kb = 0; kb < 4; ++kb) {
        bf16x8 kf[8];
#pragma unroll
        for (int s = 0; s < 8; ++s) kf[s] = *(const bf16x8*)(krow + (size_t)kb * 32 * 128 + 16 * s);
        f32x16 a = {0.f, 0.f, 0.f, 0.f, 0.f, 0.f, 0.f, 0.f, 0.f, 0.f, 0.f, 0.f, 0.f, 0.f, 0.f, 0.f};
#pragma unroll
        for (int s = 0; s < 8; ++s) a = __builtin_amdgcn_mfma_f32_32x32x16_bf16(kf[s], qf[s], a, 0, 0, 0);
        unsigned N[16];
#pragma unroll
        for (int r = 0; r < 16; ++r) { const unsigned idx = (unsigned)(32 * kb + (r & 3) + 8 * (r >> 2) + 4 * hh); N[r] = (ford(a[r]) & ~0x7fu) | idx; }
        sort16_desc(N); merge16_desc(L, N);
        asm volatile("" ::: "memory");
    }
    unsigned P[16];
#pragma unroll
    for (int i = 0; i < 16; ++i) P[i] = (unsigned)__shfl_xor((int)L[i], 32);
#pragma unroll
    for (int i = 0; i < 16; ++i) S[i] = L[i];
    merge16_desc(S, P);
}
__device__ __forceinline__ void phase_topk(const Ctx& C, int layer) {
    const bf16_t* Q = (const bf16_t*)(C.ws + A_B3); const bf16_t* KEYS = (const bf16_t*)(C.ws + WS_KEYS) + (size_t)layer * 8 * 2 * 128 * 128;
    int* IDX = (int*)(C.ws + A_B4); float* GATE = (float*)(C.ws + A_B4) + (size_t)MT * 128;
    const int lane = C.lane, r = lane & 31, hh = lane >> 5;
    for (int task = C.gw; task < (MT / 32) * 8; task += C.NGW) {
        const int tg = task >> 3, h = task & 7, m = tg * 32 + r;
        unsigned S1[16], S2[16];
        subkey_top16(Q + (size_t)m * 2048 + h * 256 + 8 * hh, KEYS + ((size_t)(h * 2 + 0) * 128 + r) * 128 + 8 * hh, hh, S1);
        subkey_top16(Q + (size_t)m * 2048 + h * 256 + 128 + 8 * hh, KEYS + ((size_t)(h * 2 + 1) * 128 + r) * 128 + 8 * hh, hh, S2);
#define CKEY(a, b) ((ford(funord(S1[a] & ~0x7fu) + funord(S2[b] & ~0x7fu)) & ~0xffu) | (unsigned)((a) << 4 | (b)))
        unsigned FK[16], G[16];
#pragma unroll
        for (int b = 0; b < 16; ++b) FK[b] = CKEY(0, b);
#pragma unroll
        for (int b = 0; b < 8; ++b) G[b] = CKEY(1, b);
#pragma unroll
        for (int b = 0; b < 5; ++b) G[8 + b] = CKEY(2, b);
#pragma unroll
        for (int b = 0; b < 3; ++b) G[13 + b] = CKEY(4, b);
        sort16_desc(G); merge16_desc(FK, G);
#pragma unroll
        for (int b = 0; b < 4; ++b) G[b] = CKEY(3, b);
#pragma unroll
        for (int b = 0; b < 2; ++b) { G[4 + b] = CKEY(5, b); G[6 + b] = CKEY(6, b); G[8 + b] = CKEY(7, b); }
#pragma unroll
        for (int a = 8; a < 14; ++a) G[2 + a] = CKEY(a, 0);
        sort16_desc(G); merge16_desc(FK, G);
        ins16(FK, CKEY(14, 0)); ins16(FK, CKEY(15, 0));
#undef CKEY
        unsigned I1p[4], I2p[4];
#pragma unroll
        for (int w = 0; w < 4; ++w) { I1p[w] = (S1[4 * w] & 0x7fu) | ((S1[4 * w + 1] & 0x7fu) << 8) | ((S1[4 * w + 2] & 0x7fu) << 16) | ((S1[4 * w + 3] & 0x7fu) << 24);
                                      I2p[w] = (S2[4 * w] & 0x7fu) | ((S2[4 * w + 1] & 0x7fu) << 8) | ((S2[4 * w + 2] & 0x7fu) << 16) | ((S2[4 * w + 3] & 0x7fu) << 24); }
        const float mx = funord(FK[0] & ~0xffu); float sum = 0.f;
#pragma unroll
        for (int i = 0; i < 16; ++i) sum += fexp(funord(FK[i] & ~0xffu) - mx);
        const float rs = 1.0f / sum;
        int oi[8]; float og[8];
#pragma unroll
        for (int i = 0; i < 8; ++i) { const unsigned key = hh ? FK[8 + i] : FK[i]; const unsigned a = (key >> 4) & 15u, b = key & 15u;
            const unsigned w1 = (a >> 2) == 0u ? I1p[0] : ((a >> 2) == 1u ? I1p[1] : ((a >> 2) == 2u ? I1p[2] : I1p[3]));
            const unsigned w2 = (b >> 2) == 0u ? I2p[0] : ((b >> 2) == 1u ? I2p[1] : ((b >> 2) == 2u ? I2p[2] : I2p[3]));
            oi[i] = (int)((((w1 >> ((a & 3u) * 8u)) & 0x7fu) << 7) | ((w2 >> ((b & 3u) * 8u)) & 0x7fu));
            og[i] = fexp(funord(key & ~0xffu) - mx) * rs; }
        const size_t o = (size_t)m * 128 + h * 16 + 8 * hh;
        *(u32x4*)(IDX + o) = (u32x4){(unsigned)oi[0], (unsigned)oi[1], (unsigned)oi[2], (unsigned)oi[3]}; *(u32x4*)(IDX + o + 4) = (u32x4){(unsigned)oi[4], (unsigned)oi[5], (unsigned)oi[6], (unsigned)oi[7]};
        *(f32x4*)(GATE + o) = (f32x4){og[0], og[1], og[2], og[3]}; *(f32x4*)(GATE + o + 4) = (f32x4){og[4], og[5], og[6], og[7]};
    }
}

template <int CTRL, int ROWMASK> __device__ __forceinline__ float dppf(float v) { return __builtin_bit_cast(float, __builtin_amdgcn_update_dpp(0, __builtin_bit_cast(int, v), CTRL, ROWMASK, 0xF, false)); }
__device__ __forceinline__ float wave_sum_u(float v) {
    v += dppf<0xB1, 0xF>(v); v += dppf<0x4E, 0xF>(v); v += dppf<0x141, 0xF>(v); v += dppf<0x140, 0xF>(v);
    v += dppf<0x142, 0xA>(v); v += dppf<0x143, 0xC>(v);
    return __builtin_bit_cast(float, __builtin_amdgcn_readlane(__builtin_bit_cast(int, v), 63));
}
struct RowSet4 { u32x4 u, v; };
__device__ __forceinline__ void load_rows4(RowSet4& R, const unsigned char* U4, const unsigned char* V4, int eid, int lane) {
    const size_t o = (size_t)eid * 1024 + lane * 16; R.u = *(const u32x4*)(U4 + o); R.v = *(const u32x4*)(V4 + o);
}
__device__ __forceinline__ void use_rows4(const u32x4 Ru, const u32x4 Rv, const float (&xf)[32], float gate, float (&out)[32]) {
    float d0 = 0.f, d1 = 0.f;
#define U4_STEP(w, b) { const f32x2 t = __builtin_amdgcn_cvt_scalef32_pk_f32_fp4(Ru[w], 1.0f, b); d0 = fmaf(xf[8 * (w) + 2 * (b)], t.x, d0); d1 = fmaf(xf[8 * (w) + 2 * (b) + 1], t.y, d1); }
#define U4_WORD(w) U4_STEP(w, 0) U4_STEP(w, 1) U4_STEP(w, 2) U4_STEP(w, 3)
    U4_WORD(0) U4_WORD(1) U4_WORD(2) U4_WORD(3)
#undef U4_WORD
#undef U4_STEP
    const float d = wave_sum_u(d0 + d1) * (1.0f / U4_SCALE);
    const float a = gelu_erf(d) * gate * (1.0f / V4_SCALE);
#define V4_STEP(w, b) { const f32x2 t = __builtin_amdgcn_cvt_scalef32_pk_f32_fp4(Rv[w], 1.0f, b); out[8 * (w) + 2 * (b)] = fmaf(a, t.x, out[8 * (w) + 2 * (b)]); out[8 * (w) + 2 * (b) + 1] = fmaf(a, t.y, out[8 * (w) + 2 * (b) + 1]); }
#define V4_WORD(w) V4_STEP(w, 0) V4_STEP(w, 1) V4_STEP(w, 2) V4_STEP(w, 3)
    V4_WORD(0) V4_WORD(1) V4_WORD(2) V4_WORD(3)
#undef V4_WORD
#undef V4_STEP
}
typedef _Float16 h16x2 __attribute__((ext_vector_type(2)));
__device__ __forceinline__ float dot_row4(const u32x4 Ru, const h16x2 (&xh)[16]) {
    float d0 = 0.f, d1 = 0.f;
#define U4_STEP(w, b, D) { const h16x2 t = __builtin_amdgcn_cvt_scalef32_pk_f16_fp4(Ru[w], 1.0f, b); D = __builtin_amdgcn_fdot2(xh[4 * (w) + (b)], t, D, false); }
#define U4_WORD(w) U4_STEP(w, 0, d0) U4_STEP(w, 1, d1) U4_STEP(w, 2, d0) U4_STEP(w, 3, d1)
    U4_WORD(0) U4_WORD(1) U4_WORD(2) U4_WORD(3)
#undef U4_WORD
#undef U4_STEP
    return wave_sum_u(d0 + d1);
}
typedef int i32x8 __attribute__((ext_vector_type(8)));
__device__ __forceinline__ float dot_row4_mfma(const u32x4 Ru, const i32x8& xhi, const i32x8& xlo, int dsel, bool dval) {
    const i32x8 a = {(int)Ru.x, (int)Ru.y, (int)Ru.z, (int)Ru.w, 0, 0, 0, 0};
    f32x4 d = {0.f, 0.f, 0.f, 0.f};
    d = __builtin_amdgcn_mfma_scale_f32_16x16x128_f8f6f4(a, xhi, d, 4, 0, 0, 127, 0, 127);
    d = __builtin_amdgcn_mfma_scale_f32_16x16x128_f8f6f4(a, xlo, d, 4, 0, 0, 127, 0, 123);
    float v = dsel == 0 ? d[0] : (dsel == 1 ? d[1] : (dsel == 2 ? d[2] : d[3]));
    v = dval ? v : 0.f;
    return wave_sum_u(v);
}
__device__ __forceinline__ void axpy_row4(const u32x4 Rv, float a, float (&out)[32]) {
#define V4_STEP(w, b) { const f32x2 t = __builtin_amdgcn_cvt_scalef32_pk_f32_fp4(Rv[w], 1.0f, b); out[8 * (w) + 2 * (b)] = fmaf(a, t.x, out[8 * (w) + 2 * (b)]); out[8 * (w) + 2 * (b) + 1] = fmaf(a, t.y, out[8 * (w) + 2 * (b) + 1]); }
#define V4_WORD(w) V4_STEP(w, 0) V4_STEP(w, 1) V4_STEP(w, 2) V4_STEP(w, 3)
    V4_WORD(0) V4_WORD(1) V4_WORD(2) V4_WORD(3)
#undef V4_WORD
#undef V4_STEP
}
__device__ __forceinline__ void phase_gather(const Ctx& C, int layer) {
    const bf16_t* HN2 = (const bf16_t*)(C.ws + A_B2); const unsigned char* U4 = C.ws + WS_U + (size_t)layer * bq::TAB_L1; const unsigned char* V4 = C.ws + WS_V + (size_t)layer * bq::TAB_L1;
    const int* IDX = (const int*)(C.ws + A_B4); const float* GATE = (const float*)(C.ws + A_B4) + (size_t)MT * 128;
    const float* mod = (const float*)(C.ws + WS_MOD); float* X = C.out + O_Y; bf16_t* HN = (bf16_t*)(C.ws + A_HN);
    const int lane = C.lane;
    int m = C.gw; if (m >= MT) return;
    LAS unsigned char* ring = C.lds + C.wave * 16384;
    int i0 = IDX[(size_t)m * 128 + lane], i1 = IDX[(size_t)m * 128 + 64 + lane];
    float g0 = GATE[(size_t)m * 128 + lane], g1 = GATE[(size_t)m * 128 + 64 + lane];
    u32x2 xw[8];
#pragma unroll
    for (int b = 0; b < 8; ++b) xw[b] = *(const u32x2*)(HN2 + (size_t)m * 2048 + 256 * b + 4 * lane);
#pragma unroll
    for (int b = 0; b < 8; ++b) asm volatile("" : "+v"(xw[b]));
    asm volatile("" : "+v"(i0), "+v"(i1), "+v"(g0), "+v"(g1));
    asm volatile("s_waitcnt vmcnt(0)" ::: "memory");
#define SB() __builtin_amdgcn_sched_barrier(0)
    const unsigned lo16 = (unsigned)lane * 16u;
#define ROW_DMA(T, eid_, s_) __builtin_amdgcn_global_load_lds((const unsigned*)((const char*)((T) + (size_t)(eid_) * 1024) + lo16), (LAS unsigned*)(ring + ((s_) & 15) * 1024), 16, 0, 0)
#define EIDC(j) __builtin_amdgcn_readlane(((j) < 64) ? i0 : i1, (j) & 63)
#pragma unroll
    for (int j = 0; j < 14; ++j) ROW_DMA(U4, __builtin_amdgcn_readlane(i0, j), j);
    for (;;) {
        const int mn = m + C.NGW; const bool has_next = mn < MT; const int mq = has_next ? mn : m;
        int ni0, ni1; float ng0, ng1; u32x2 nx[8];
        int lt = lane; asm volatile("" : "+v"(lt));
        { const int* ip = IDX + (size_t)mq * 128 + lt; const float* gp = GATE + (size_t)mq * 128 + lt; const bf16_t* xp = HN2 + (size_t)mq * 2048 + 4 * lt;
          asm volatile("global_load_dword %0, %1, off" : "=v"(ni0) : "v"(ip) : "memory");
          asm volatile("global_load_dword %0, %1, off offset:256" : "=v"(ni1) : "v"(ip) : "memory");
          asm volatile("global_load_dword %0, %1, off" : "=v"(ng0) : "v"(gp) : "memory");
          asm volatile("global_load_dword %0, %1, off offset:256" : "=v"(ng1) : "v"(gp) : "memory");
          asm volatile("global_load_dwordx2 %0, %1, off" : "=v"(nx[0]) : "v"(xp) : "memory");
          asm volatile("global_load_dwordx2 %0, %1, off offset:512" : "=v"(nx[1]) : "v"(xp) : "memory");
          asm volatile("global_load_dwordx2 %0, %1, off offset:1024" : "=v"(nx[2]) : "v"(xp) : "memory");
          asm volatile("global_load_dwordx2 %0, %1, off offset:1536" : "=v"(nx[3]) : "v"(xp) : "memory");
          asm volatile("global_load_dwordx2 %0, %1, off offset:2048" : "=v"(nx[4]) : "v"(xp) : "memory");
          asm volatile("global_load_dwordx2 %0, %1, off offset:2560" : "=v"(nx[5]) : "v"(xp) : "memory");
          asm volatile("global_load_dwordx2 %0, %1, off offset:3072" : "=v"(nx[6]) : "v"(xp) : "memory");
          asm volatile("global_load_dwordx2 %0, %1, off offset:3584" : "=v"(nx[7]) : "v"(xp) : "memory"); }
        i32x8 xhi, xlo;
#pragma unroll
        for (int b = 0; b < 8; ++b) { const float x0 = bf_lo(xw[b].x), x1 = bf_hi(xw[b].x), x2 = bf_lo(xw[b].y), x3 = bf_hi(xw[b].y);
            const float c0 = fminf(fmaxf(x0, -448.f), 448.f), c1 = fminf(fmaxf(x1, -448.f), 448.f), c2 = fminf(fmaxf(x2, -448.f), 448.f), c3 = fminf(fmaxf(x3, -448.f), 448.f);
            int th = 0; th = __builtin_amdgcn_cvt_pk_fp8_f32(c0, c1, th, false); th = __builtin_amdgcn_cvt_pk_fp8_f32(c2, c3, th, true);
            const f32x2 h01 = __builtin_amdgcn_cvt_pk_f32_fp8(th, false), h23 = __builtin_amdgcn_cvt_pk_f32_fp8(th, true);
            int tl = 0; tl = __builtin_amdgcn_cvt_pk_fp8_f32((c0 - h01.x) * 16.f, (c1 - h01.y) * 16.f, tl, false); tl = __builtin_amdgcn_cvt_pk_fp8_f32((c2 - h23.x) * 16.f, (c3 - h23.y) * 16.f, tl, true);
            xhi[b] = th; xlo[b] = tl; }
        const int dsel = lane & 3; const bool dval = ((lane & 15) >> 2) == (lane >> 4);
        { const int jj = lane & 15, gg = lane >> 4, srcA = (jj + 16 * (gg >> 1)) << 2, srcB = (jj + 16 * (2 + (gg >> 1))) << 2; const bool odd = gg & 1;
          i32x8 nh, nl;
#pragma unroll
          for (int d = 0; d < 4; ++d) {
              const int a0 = __builtin_amdgcn_ds_bpermute(srcA, xhi[d]), a1 = __builtin_amdgcn_ds_bpermute(srcA, xhi[4 + d]), b0 = __builtin_amdgcn_ds_bpermute(srcB, xhi[d]), b1 = __builtin_amdgcn_ds_bpermute(srcB, xhi[4 + d]);
              nh[d] = odd ? a1 : a0; nh[4 + d] = odd ? b1 : b0;
              const int c0 = __builtin_amdgcn_ds_bpermute(srcA, xlo[d]), c1 = __builtin_amdgcn_ds_bpermute(srcA, xlo[4 + d]), e0 = __builtin_amdgcn_ds_bpermute(srcB, xlo[d]), e1 = __builtin_amdgcn_ds_bpermute(srcB, xlo[4 + d]);
              nl[d] = odd ? c1 : c0; nl[4 + d] = odd ? e1 : e0; }
          xhi = nh; xlo = nl; }
        float dv0 = 0.f, dv1 = 0.f;
#define U_ITER2(e, VMN, DV, NEXT_T, NEXT_E0, NEXT_E1) do { ROW_DMA(NEXT_T, NEXT_E0, (e) + 14); ROW_DMA(NEXT_T, NEXT_E1, (e) + 15); asm volatile("s_waitcnt vmcnt(" #VMN ")" ::: "memory"); \
            const u32x4 ru0 = *(const LAS u32x4*)(ring + ((e) & 15) * 1024 + lo16), ru1 = *(const LAS u32x4*)(ring + (((e) + 1) & 15) * 1024 + lo16); \
            const float da = dot_row4_mfma(ru0, xhi, xlo, dsel, dval), db = dot_row4_mfma(ru1, xhi, xlo, dsel, dval); \
            DV = (lane == ((e) & 63)) ? da : DV; DV = (lane == (((e) + 1) & 63)) ? db : DV; } while (0)
#pragma unroll 1
        for (int e = 0; e < 14; e += 2) U_ITER2(e, 26, dv0, U4, EIDC(e + 14), EIDC(e + 15));
#pragma unroll 1
        for (int e = 14; e < 64; e += 2) U_ITER2(e, 14, dv0, U4, EIDC(e + 14), EIDC(e + 15));
#pragma unroll 1
        for (int e = 64; e < 114; e += 2) U_ITER2(e, 14, dv1, U4, EIDC(e + 14), EIDC(e + 15));
#pragma unroll 1
        for (int e = 114; e < 128; e += 2) U_ITER2(e, 14, dv1, V4, EIDC(e - 114), EIDC(e - 113));
#undef U_ITER2
        asm volatile("" : "+v"(ni0), "+v"(ni1), "+v"(ng0), "+v"(ng1));
#pragma unroll
        for (int b = 0; b < 8; ++b) asm volatile("" : "+v"(nx[b]));
        const float av0 = gelu_erf(dv0 * (1.0f / U4_SCALE)) * g0 * (1.0f / V4_SCALE), av1 = gelu_erf(dv1 * (1.0f / U4_SCALE)) * g1 * (1.0f / V4_SCALE);
        float out[32];
#pragma unroll
        for (int i = 0; i < 32; ++i) out[i] = 0.f;
#define V_ITER2(e, AV, NEXT_T, NEXT_E0, NEXT_E1) do { ROW_DMA(NEXT_T, NEXT_E0, (e) + 14); ROW_DMA(NEXT_T, NEXT_E1, (e) + 15); asm volatile("s_waitcnt vmcnt(14)" ::: "memory"); \
            const u32x4 rv0 = *(const LAS u32x4*)(ring + ((e) & 15) * 1024 + lo16), rv1 = *(const LAS u32x4*)(ring + (((e) + 1) & 15) * 1024 + lo16); \
            const float a0 = __builtin_bit_cast(float, __builtin_amdgcn_readlane(__builtin_bit_cast(int, AV), (e) & 63)), a1 = __builtin_bit_cast(float, __builtin_amdgcn_readlane(__builtin_bit_cast(int, AV), ((e) + 1) & 63)); \
            axpy_row4(rv0, a0, out); axpy_row4(rv1, a1, out); } while (0)
#pragma unroll 1
        for (int e = 0; e < 64; e += 2) V_ITER2(e, av0, V4, EIDC(e + 14), EIDC(e + 15));
#pragma unroll 1
        for (int e = 64; e < 114; e += 2) V_ITER2(e, av1, V4, EIDC(e + 14), EIDC(e + 15));
#pragma unroll 1
        for (int e = 114; e < 128; e += 2) V_ITER2(e, av1, U4, __builtin_amdgcn_readlane(ni0, e - 114), __builtin_amdgcn_readlane(ni0, e - 113));
#undef V_ITER2
        int le = lane; asm volatile("" : "+v"(le));
        const int sq = seq_of_row(m); const float* g2 = mod + ((size_t)layer * NSEQ + sq) * 12288 + 5 * 2048; float* xr = X + (size_t)m * DM;
        float ss = 0.f;
#pragma unroll
        for (int hb = 0; hb < 2; ++hb) {
            f32x4 xo[4], gg[4];
#pragma unroll
            for (int b = 0; b < 4; ++b) { const int c = 256 * (4 * hb + b) + 4 * le; xo[b] = *(const f32x4*)(xr + c); gg[b] = *(const f32x4*)(g2 + c); }
            SB();
#pragma unroll
            for (int b = 0; b < 4; ++b) {
#pragma unroll
                for (int j = 0; j < 4; ++j) { const float v = xo[b][j] + gg[b][j] * out[4 * (4 * hb + b) + j]; out[4 * (4 * hb + b) + j] = v; ss += v * v; } }
            SB();
        }
        const float rstd = __builtin_amdgcn_rsqf(wave_sum(ss) * (1.0f / DM) + RMS_EPS);
        if (layer == 0) {
            const float* n1g = C.in[11] + 2048; const float* mp = mod + ((size_t)1 * NSEQ + sq) * 12288;
#pragma unroll
            for (int hb = 0; hb < 2; ++hb) {
                f32x4 gv[4], sh[4], sc[4];
#pragma unroll
                for (int b = 0; b < 4; ++b) { const int c = 256 * (4 * hb + b) + 4 * le; gv[b] = *(const f32x4*)(n1g + c); sh[b] = *(const f32x4*)(mp + c); sc[b] = *(const f32x4*)(mp + 2048 + c); }
                SB();
#pragma unroll
                for (int b = 0; b < 4; ++b) { const int bb = 4 * hb + b, c = 256 * bb + 4 * le;
                    const f32x4 xs = {out[4 * bb], out[4 * bb + 1], out[4 * bb + 2], out[4 * bb + 3]}; const f32x4 y = xs * rstd * gv[b] * (sc[b] + 1.0f) + sh[b];
                    *(f32x4*)(xr + c) = xs; u32x2 w; w.x = cvt_pk_bf16(y[0], y[1]); w.y = cvt_pk_bf16(y[2], y[3]); *(u32x2*)(HN + (size_t)m * DM + c) = w; }
                SB();
            }
        } else {
            const float* fg = C.in[35];
            f32x4 gv[8];
#pragma unroll
            for (int b = 0; b < 8; ++b) gv[b] = *(const f32x4*)(fg + 256 * b + 4 * le);
            SB();
#pragma unroll
            for (int b = 0; b < 8; ++b) { const int c = 256 * b + 4 * le; const f32x4 xs = {out[4 * b], out[4 * b + 1], out[4 * b + 2], out[4 * b + 3]};
                *(f32x4*)(xr + c) = xs * rstd * gv[b]; }
        }
        if (!has_next) break;
        m = mn; i0 = ni0; i1 = ni1; g0 = ng0; g1 = ng1;
#pragma unroll
        for (int b = 0; b < 8; ++b) xw[b] = nx[b];
    }
    asm volatile("s_waitcnt vmcnt(0)" ::: "memory");
#undef ROW_DMA
#undef EIDC
#undef SB
}
namespace att {
constexpr int SHM_K = 64 * 384, SHM_V = 64 * 256;
constexpr int OFF_K = 0, OFF_V = 2 * SHM_K, OFF_WS = 2 * SHM_K + 2 * SHM_V;
constexpr float SCALE = 0.07216878364870322f;
constexpr float THR = 8.f;
__device__ __forceinline__ int crow(int r, int hi) { return (r & 3) + 8 * (r >> 2) + 4 * hi; }
constexpr float THR2 = THR * 1.4426950408889634f;
__device__ __forceinline__ void partialSM(f32x16& p0, f32x16& p1, float& mref, f32x16& negm, float& alpha, bool first) {
    float pmax = p0[0];
#pragma unroll
    for (int r = 1; r < 16; ++r) pmax = fmaxf(pmax, p0[r]);
#pragma unroll
    for (int r = 0; r < 16; ++r) pmax = fmaxf(pmax, p1[r]);
    { auto rr = __builtin_amdgcn_permlane32_swap(__float_as_uint(pmax), __float_as_uint(pmax), false, false);
      pmax = fmaxf(__uint_as_float(rr[0]), __uint_as_float(rr[1])); }
    if (__builtin_expect(!first && __all(pmax <= THR2), 1)) { alpha = 1.f; }
    else { const float dl = first ? pmax : fmaxf(pmax, 0.f); alpha = first ? 1.f : __builtin_amdgcn_exp2f(-dl); mref += dl;
#pragma unroll
        for (int r = 0; r < 16; ++r) { negm[r] = -mref; p0[r] -= dl; p1[r] -= dl; }
        asm volatile("" : "+v"(negm)); }
#pragma unroll
    for (int r = 0; r < 16; ++r) p0[r] = __builtin_amdgcn_exp2f(p0[r]);
#pragma unroll
    for (int r = 0; r < 16; ++r) p1[r] = __builtin_amdgcn_exp2f(p1[r]);
}
__device__ __forceinline__ void finishSM(const f32x16& p0, const f32x16& p1, float alpha, float& l_reg, bf16x8& pa0, bf16x8& pa1, bf16x8& pa2, bf16x8& pa3) {
    float ps = 0;
#pragma unroll
    for (int r = 0; r < 16; ++r) ps += p0[r];
#pragma unroll
    for (int r = 0; r < 16; ++r) ps += p1[r];
    { auto rr = __builtin_amdgcn_permlane32_swap(__float_as_uint(ps), __float_as_uint(ps), false, false);
      ps = __uint_as_float(rr[0]) + __uint_as_float(rr[1]); }
    l_reg = l_reg * alpha + ps;
#define PK4(P, BASE, OUT) do { unsigned a0 = cvt_pk_bf16(P[BASE + 0], P[BASE + 1]), a1 = cvt_pk_bf16(P[BASE + 2], P[BASE + 3]);   \
    unsigned b0 = cvt_pk_bf16(P[BASE + 4], P[BASE + 5]), b1 = cvt_pk_bf16(P[BASE + 6], P[BASE + 7]);                              \
    auto r0 = __builtin_amdgcn_permlane32_swap(a0, b0, false, false); auto r1 = __builtin_amdgcn_permlane32_swap(a1, b1, false, false); \
    u32x4 w = {r0[0], r1[0], r0[1], r1[1]}; OUT = __builtin_bit_cast(bf16x8, w); } while (0)
    PK4(p0, 0, pa0); PK4(p0, 8, pa1); PK4(p1, 0, pa2); PK4(p1, 8, pa3);
#undef PK4
}
template <int OFF> __device__ __forceinline__ bf16x8 k_read(int addr) { bf16x8 r; asm volatile("ds_read_b128 %0, %1 offset:%2" : "=v"(r) : "v"(addr), "i"(OFF) : "memory"); return r; }
template <int I> __device__ __forceinline__ bf16x8 kfrag(const int (&kad)[4]) { constexpr int d0 = I >> 1, half = I & 1; return k_read<(d0 >> 2) * 128 + half * 12288>(kad[d0 & 3]); }
__device__ __forceinline__ void packSM(const f32x16& p0, const f32x16& p1, bf16x8& pa0, bf16x8& pa1, bf16x8& pa2, bf16x8& pa3) {
#define PK4(P, BASE, OUT) do { unsigned a0 = cvt_pk_bf16(P[BASE + 0], P[BASE + 1]), a1 = cvt_pk_bf16(P[BASE + 2], P[BASE + 3]);   \
    unsigned b0 = cvt_pk_bf16(P[BASE + 4], P[BASE + 5]), b1 = cvt_pk_bf16(P[BASE + 6], P[BASE + 7]);                              \
    auto r0 = __builtin_amdgcn_permlane32_swap(a0, b0, false, false); auto r1 = __builtin_amdgcn_permlane32_swap(a1, b1, false, false); \
    u32x4 w = {r0[0], r1[0], r0[1], r1[1]}; OUT = __builtin_bit_cast(bf16x8, w); } while (0)
    PK4(p0, 0, pa0); PK4(p0, 8, pa1); PK4(p1, 0, pa2); PK4(p1, 8, pa3);
#undef PK4
}
__device__ __forceinline__ int v_rd_base(int lane) { return ((lane & 3) << 3) | (((lane >> 2) & 3) << 6) | (((lane >> 4) & 1) << 5) | (((lane >> 5) & 1) << 8); }
constexpr int v_rd_off(int d0, int ks, int half) { return d0 * 512 + ks * 4096 + half * 2048; }
template <int OFF> __device__ __forceinline__ s16x4 tr_read(int vb) {
    s16x4 r; asm volatile("ds_read_b64_tr_b16 %0, %1 offset:%2" : "=&v"(r) : "v"(vb), "i"(OFF) : "memory"); return r;
}
template <int D0> __device__ __forceinline__ void pv_one(f32x16& od, int vb, bf16x8 pa0, bf16x8 pa1, bf16x8 pa2, bf16x8 pa3) {
    const s16x4 l0 = tr_read<v_rd_off(D0, 0, 0)>(vb), h0 = tr_read<v_rd_off(D0, 0, 1)>(vb), l1 = tr_read<v_rd_off(D0, 1, 0)>(vb), h1 = tr_read<v_rd_off(D0, 1, 1)>(vb);
    const s16x4 l2 = tr_read<v_rd_off(D0, 2, 0)>(vb), h2 = tr_read<v_rd_off(D0, 2, 1)>(vb), l3 = tr_read<v_rd_off(D0, 3, 0)>(vb), h3 = tr_read<v_rd_off(D0, 3, 1)>(vb);
    asm volatile("s_waitcnt lgkmcnt(0)" ::: "memory"); __builtin_amdgcn_sched_barrier(0);
#define PKV(L, H) (bf16x8){L[0], L[1], L[2], L[3], H[0], H[1], H[2], H[3]}
    od = __builtin_amdgcn_mfma_f32_32x32x16_bf16(pa0, PKV(l0, h0), od, 0, 0, 0);
    od = __builtin_amdgcn_mfma_f32_32x32x16_bf16(pa1, PKV(l1, h1), od, 0, 0, 0);
    od = __builtin_amdgcn_mfma_f32_32x32x16_bf16(pa2, PKV(l2, h2), od, 0, 0, 0);
    od = __builtin_amdgcn_mfma_f32_32x32x16_bf16(pa3, PKV(l3, h3), od, 0, 0, 0);
#undef PKV
}
struct AUnit { int qrow0, kvrow0, ntiles, head, vis0, nact, rev; };

__device__ __forceinline__ bool next_unit(int i, int vcu, int G, AUnit& u) {
    int flat;
    if (G == 256) {
        if (i >= 10) return false;
        if (i < 8) { const int bh = vcu >> 3, s = vcu & 7, base = 16 * (i >> 1); const int qb = (i & 1) ? base + 15 - s : base + s; flat = bh * 64 + qb; }
        else flat = 2048 + vcu * 2 + (i - 8);
    } else { flat = i * G + vcu; if (flat >= 2560) return false; }
    u.rev = (G == 256 && i < 8) ? (i & 1) : 0;
    if (flat < 2048) { const int bh = flat >> 6, qb = flat & 63, b = bh >> 4; u.head = bh & 15; u.qrow0 = b * 16384 + qb * 256; u.kvrow0 = b * 16384; u.ntiles = 4 * qb + 4; u.vis0 = 4 * qb; u.nact = 8; }
    else { const int f = flat - 2048, b = f >> 4; u.head = f & 15; u.qrow0 = MP + b * 64; u.kvrow0 = MP + b * 1088; u.ntiles = 17; u.vis0 = 1 << 20; u.nact = 2; }
    return true;
}

__device__ __forceinline__ void attn_phase(const Ctx& C) {
    bf16_t* Qn = (bf16_t*)(C.ws + A_HN); const bf16_t* Qp = (const bf16_t*)(C.ws + A_GG);
    const bf16_t* Kn = (const bf16_t*)(C.ws + A_KN); const bf16_t* Kp = (const bf16_t*)(C.ws + A_KP); const bf16_t* Vv = (const bf16_t*)(C.ws + A_VV);
    LAS unsigned char* lds = C.lds; const int wid = C.wave, lane = C.lane, r32 = lane & 31, hi = lane >> 5;
    LAS float* wsp = (LAS float*)(lds + OFF_WS) + wid * 64; LAS float* li_l = wsp; LAS float* al_l = wsp + 32;
    unsigned ka[3], kst[3]; bool kisn[3];
#pragma unroll
    for (int i = 0; i < 3; ++i) { const int Uq = (wid * 3 + i) * 64 + lane, row = Uq / 24, cp = Uq % 24, c = cp ^ ((row >> 1) & 7);
        kisn[i] = c < 16; ka[i] = kisn[i] ? (unsigned)(row * 4096 + c * 16) : (unsigned)(A_KP - A_KN) + (unsigned)(row * 128 + (c - 16) * 16); kst[i] = kisn[i] ? 64u * 4096u : 64u * 128u; }
    unsigned va[2];
#pragma unroll
    for (int i = 0; i < 2; ++i) { const int by = ((wid * 2 + i) * 64 + lane) * 16, sub = by >> 9, within = by & 511, kk = (sub >> 2) * 8 + (within >> 6), cc = (sub & 3) * 32 + ((within & 63) >> 1);
        const int k = (kk & ~0xC) | ((kk & 4) << 1) | ((kk & 8) >> 1); va[i] = (unsigned)(k * 4096 + cc * 2); }
    int kl0[4];
#pragma unroll
    for (int q = 0; q < 4; ++q) kl0[q] = (int)(uintptr_t)(lds + OFF_K) + r32 * 384 + ((((2 * q + hi) ^ ((r32 >> 1) & 7))) << 4);
    const int vb0 = (int)(uintptr_t)(lds + OFF_V) + v_rd_base(lane);
#define ATT_BAR() __builtin_amdgcn_s_barrier()
#define ATT_ISSUE(j, kb, vbi) do { _Pragma("unroll") for (int _i = 0; _i < 3; ++_i) { \
        __builtin_amdgcn_global_load_lds((const unsigned*)((const char*)Kn + kc[_i]), (LAS unsigned*)(lds + OFF_K + (kb) * SHM_K + (wid * 3 + _i) * 1024), 16, 0, 0); kc[_i] += kst[_i] * (unsigned)kdir; } \
      _Pragma("unroll") for (int _i = 0; _i < 2; ++_i) { \
        __builtin_amdgcn_global_load_lds((const unsigned*)((const char*)Vv + vc[_i]), (LAS unsigned*)(lds + OFF_V + (vbi) * SHM_V + (wid * 2 + _i) * 1024), 16, 0, 0); vc[_i] += (unsigned)(64 * 4096 * kdir); } } while (0)
#define PV_STEP(I, PA, L, H, WN) do { asm volatile("s_waitcnt lgkmcnt(" #WN ")" : "+v"(L), "+v"(H) :: "memory"); \
        o[(I) >> 2] = __builtin_amdgcn_mfma_f32_32x32x16_bf16(PA, ((bf16x8){L[0], L[1], L[2], L[3], H[0], H[1], H[2], H[3]}), o[(I) >> 2], 0, 0, 0); \
        if ((I) + 4 < 16) { L = tr_read<v_rd_off((((I) + 4) & 15) >> 2, (I) & 3, 0)>(vb); H = tr_read<v_rd_off((((I) + 4) & 15) >> 2, (I) & 3, 1)>(vb); } \
        __builtin_amdgcn_sched_barrier(0); } while (0)
#define PV_HEAD(VBI) do { vb = vb0 + (VBI) * SHM_V; \
      l0 = tr_read<v_rd_off(0, 0, 0)>(vb); h0 = tr_read<v_rd_off(0, 0, 1)>(vb); l1 = tr_read<v_rd_off(0, 1, 0)>(vb); h1 = tr_read<v_rd_off(0, 1, 1)>(vb); \
      l2 = tr_read<v_rd_off(0, 2, 0)>(vb); h2 = tr_read<v_rd_off(0, 2, 1)>(vb); l3 = tr_read<v_rd_off(0, 3, 0)>(vb); h3 = tr_read<v_rd_off(0, 3, 1)>(vb); } while (0)
#define PV_BODY() do { \
      __builtin_amdgcn_s_setprio(1); PV_STEP(0, pa0, l0, h0, 6);  PV_STEP(1, pa1, l1, h1, 6);  PV_STEP(2, pa2, l2, h2, 6);  PV_STEP(3, pa3, l3, h3, 6); \
      PV_STEP(4, pa0, l0, h0, 6);  PV_STEP(5, pa1, l1, h1, 6);  PV_STEP(6, pa2, l2, h2, 6);  PV_STEP(7, pa3, l3, h3, 6); \
      PV_STEP(8, pa0, l0, h0, 6);  PV_STEP(9, pa1, l1, h1, 6);  PV_STEP(10, pa2, l2, h2, 6); PV_STEP(11, pa3, l3, h3, 6); \
      PV_STEP(12, pa0, l0, h0, 6); PV_STEP(13, pa1, l1, h1, 4); PV_STEP(14, pa2, l2, h2, 2); PV_STEP(15, pa3, l3, h3, 0); __builtin_amdgcn_s_setprio(0); } while (0)
#define ATT_PV(VBI) do { PV_HEAD(VBI); PV_BODY(); } while (0)
    AUnit u;
#ifndef PROBE_ATT
#define PROBE_ATT 0
#endif
#if PROBE_ATT
    for (int ui2 = 0; next_unit(ui2 >> 1, C.vcu, C.G, u); ++ui2) { const bool dummy = !(ui2 & 1);
#else
    for (int ui = 0; next_unit(ui, C.vcu, C.G, u); ++ui) { const bool dummy = false;
#endif
        const bool active = wid < u.nact; const int vis = u.vis0 + (wid >> 1);
        const int qrow = u.qrow0 + wid * 32 + r32;
        bf16x8 qr[12];
        if (active) {
#pragma unroll
            for (int d0 = 0; d0 < 8; ++d0) qr[d0] = *(const bf16x8*)(Qn + (size_t)qrow * 2048 + u.head * 128 + d0 * 16 + hi * 8);
#pragma unroll
            for (int d0 = 0; d0 < 4; ++d0) qr[8 + d0] = *(const bf16x8*)(Qp + (size_t)qrow * 1024 + u.head * 64 + d0 * 16 + hi * 8);
        } else {
#pragma unroll
            for (int d0 = 0; d0 < 12; ++d0) qr[d0] = (bf16x8){0, 0, 0, 0, 0, 0, 0, 0};
        }
#pragma unroll
        for (int d0 = 0; d0 < 12; ++d0) asm volatile("" : "+v"(qr[d0]));
        float mref = 0.f, l_reg = 0.f; f32x16 o[4]; f32x16 negm;
#pragma unroll
        for (int r = 0; r < 16; ++r) negm[r] = 0.f;
        asm volatile("" : "+v"(negm));
#pragma unroll
        for (int d = 0; d < 4; ++d)
#pragma unroll
            for (int r = 0; r < 16; ++r) o[d][r] = 0.f;
        bf16x8 pa0, pa1, pa2, pa3;
        const int NT = u.ntiles;
        const int kdir = u.rev ? -1 : 1, t0 = u.rev ? u.ntiles - 1 : 0;
        bool started = false;
        unsigned kc[3], vc[2];
#pragma unroll
        for (int i = 0; i < 3; ++i) kc[i] = ka[i] + (kisn[i] ? (unsigned)u.kvrow0 * 4096u + (unsigned)u.head * 256u : (unsigned)u.kvrow0 * 128u) + kst[i] * (unsigned)t0;
#pragma unroll
        for (int i = 0; i < 2; ++i) vc[i] = va[i] + (unsigned)u.kvrow0 * 4096u + (unsigned)u.head * 256u + (unsigned)(64 * 4096) * (unsigned)t0;
        ATT_ISSUE(0, 0, 0);
        asm volatile("s_waitcnt vmcnt(0)" ::: "memory");
        ATT_BAR();
        int vb; s16x4 l0, h0, l1, h1, l2, h2, l3, h3; bf16x8 f0, f1, f2, f3; int kad[4];
#define QK_HEAD() do { _Pragma("unroll") for (int q = 0; q < 4; ++q) kad[q] = kl0[q] + buf * SHM_K; f0 = kfrag<0>(kad); f1 = kfrag<1>(kad); f2 = kfrag<2>(kad); f3 = kfrag<3>(kad); } while (0)
#define QK_STEP(I, F, WN) do { asm volatile("s_waitcnt lgkmcnt(" #WN ")" : "+v"(F) :: "memory"); \
        if ((I) == 0) p0 = __builtin_amdgcn_mfma_f32_32x32x16_bf16(F, qr[0], negm, 0, 0, 0); \
        else if ((I) == 1) p1 = __builtin_amdgcn_mfma_f32_32x32x16_bf16(F, qr[0], negm, 0, 0, 0); \
        else if ((I) & 1) p1 = __builtin_amdgcn_mfma_f32_32x32x16_bf16(F, qr[(I) >> 1], p1, 0, 0, 0); \
        else p0 = __builtin_amdgcn_mfma_f32_32x32x16_bf16(F, qr[(I) >> 1], p0, 0, 0, 0); \
        if ((I) + 4 < 24) F = kfrag<((I) + 4 < 24 ? (I) + 4 : 0)>(kad); __builtin_amdgcn_sched_barrier(0); } while (0)
        for (int j = 0; j < NT; ++j) {
            const int buf = j & 1;
            const int jt = u.rev ? NT - 1 - j : j;
            const bool doQK = active && jt <= vis;
            if (j + 1 < NT) ATT_ISSUE(j + 1, buf ^ 1, buf ^ 1);
            if (doQK) {
                f32x16 p0, p1;
                if ((PROBE_ATT == 3 || PROBE_ATT == 5) && dummy) { p0 = negm; p1 = negm; } else {
                QK_HEAD();
                __builtin_amdgcn_s_setprio(1);
                QK_STEP(0, f0, 3);  QK_STEP(1, f1, 3);  QK_STEP(2, f2, 3);  QK_STEP(3, f3, 3);
                QK_STEP(4, f0, 3);  QK_STEP(5, f1, 3);  QK_STEP(6, f2, 3);  QK_STEP(7, f3, 3);
                QK_STEP(8, f0, 3);  QK_STEP(9, f1, 3);  QK_STEP(10, f2, 3); QK_STEP(11, f3, 3);
                QK_STEP(12, f0, 3); QK_STEP(13, f1, 3); QK_STEP(14, f2, 3); QK_STEP(15, f3, 3);
                QK_STEP(16, f0, 3); QK_STEP(17, f1, 3); QK_STEP(18, f2, 3); QK_STEP(19, f3, 3);
                QK_STEP(20, f0, 3); QK_STEP(21, f1, 2); QK_STEP(22, f2, 1); QK_STEP(23, f3, 0);
                __builtin_amdgcn_s_setprio(0);
                }
                if ((PROBE_ATT == 2 || PROBE_ATT == 5) && dummy) { packSM(p0, p1, pa0, pa1, pa2, pa3); } else {
                float alpha; partialSM(p0, p1, mref, negm, alpha, !started); started = true;
                if (__any(alpha < 1.f)) { if (hi == 0) al_l[r32] = alpha; asm volatile("s_waitcnt lgkmcnt(0)" ::: "memory");
#pragma unroll
                    for (int r = 0; r < 16; ++r) { const float al = al_l[crow(r, hi)];
#pragma unroll
                        for (int d = 0; d < 4; ++d) o[d][r] *= al; } }
                finishSM(p0, p1, alpha, l_reg, pa0, pa1, pa2, pa3);
                }
                if (!((PROBE_ATT == 4 || PROBE_ATT == 5) && dummy)) ATT_PV(buf);
            }
            asm volatile("s_waitcnt vmcnt(0) lgkmcnt(0)" ::: "memory");
            ATT_BAR();
        }
#undef QK_STEP
#undef QK_HEAD
        if (active && !dummy) {
            if (hi == 0) li_l[r32] = l_reg; asm volatile("s_waitcnt lgkmcnt(0)" ::: "memory");
            bf16_t* Ow = Qn + (size_t)(u.qrow0 + wid * 32) * 2048 + u.head * 128;
#pragma unroll
            for (int r = 0; r < 16; ++r) { const int orow = crow(r, hi); const float rl = __builtin_amdgcn_rcpf(li_l[orow]);
#pragma unroll
                for (int d0 = 0; d0 < 4; ++d0) { const unsigned w = cvt_pk_bf16(o[d0][r] * rl, 0.f); Ow[(size_t)orow * 2048 + d0 * 32 + r32] = (bf16_t)(w & 0xffffu); } }
        }
    }
#undef ATT_BAR
#undef ATT_ISSUE
#undef ATT_PV
#undef PV_STEP
#undef PV_HEAD
#undef PV_BODY
}
}
#ifndef MK_SPLIT
#define MK_SPLIT 0
#endif
constexpr int N_PHASES = 22;

__global__ void __launch_bounds__(512, 2) mega_fwd(Args args) {
    extern __shared__ __attribute__((aligned(16))) unsigned char lds_raw[];
    Ctx C;
    C.lds = (LAS unsigned char*)lds_raw;
    C.tid = threadIdx.x; C.lane = C.tid & 63; C.wave = __builtin_amdgcn_readfirstlane(C.tid >> 6);
    C.G = gridDim.x; { const int bx = blockIdx.x; C.vcu = (C.G % 8 == 0) ? (bx % 8) * (C.G / 8) + bx / 8 : bx; }
    C.gw = C.vcu * 8 + C.wave; C.NGW = C.G * 8;
    C.in = args.in; C.out = args.out; C.ws = args.ws;
    volatile LAS unsigned* misc = (volatile LAS unsigned*)(C.lds + LDS_MISC);
    if (C.tid < 4) misc[C.tid] = 0u;
    __syncthreads();
    const int lo = args.ph_lo, hi = args.ph_hi;
    XcdBarrier bar; bar.bar = (unsigned*)(C.ws + WS_CTL) + CW_BAR; bar.x = 0; bar.st = misc;
    if (hi - lo > 1) bar = xcd_barrier_post((unsigned*)(C.ws + WS_CTL) + CW_BAR, misc);
#ifdef PH_ONLY
#define IN(k) ((k) == PH_ONLY)
#else
#define IN(k) (lo <= (k) && (k) < hi)
#endif
#define FILL(k) bq::service(C, true, (k), 0)
#define NEED(k, limit) do { if (IN(k) && (limit) > 0) bq::service(C, false, 0, (limit)); } while (0)
#define SEAM(k) do { if (IN(k) && IN((k) + 1)) xcd_barrier(bar); } while (0)
    unsigned char* ws = C.ws;
    const float* mod = (const float*)(ws + WS_MOD);
    float* X = C.out + O_Y;
    LAS unsigned char* glds = C.lds;

#ifdef PROBE_CLK
#define CLK_BEGIN(k) unsigned long long _t0 = 0, _r0 = 0; if ((k) == PROBE_CLK) { _t0 = __builtin_amdgcn_s_memtime(); _r0 = __builtin_amdgcn_s_memrealtime(); }
#define CLK_END(k) if ((k) == PROBE_CLK && blockIdx.x == 0 && threadIdx.x == 0) { const unsigned long long t1 = __builtin_amdgcn_s_memtime(), r1 = __builtin_amdgcn_s_memrealtime(); \
        const unsigned long long ticks = (t1 - _t0) * 1000ull / (r1 - _r0); while (__builtin_amdgcn_s_memrealtime() - r1 < ticks) __builtin_amdgcn_s_sleep(8); }
#else
#define CLK_BEGIN(k)
#define CLK_END(k)
#endif
    if (IN(0)) { phase_prologue(C); } SEAM(0);
    if (IN(1)) { phase_norm(C, C.in[0], C.in[1], C.in[11], mod, 0, (bf16_t*)(ws + A_HN)); } NEED(1, bq::E_IN); SEAM(1);
    if (IN(2)) {
        pg8::Gemm g{(const bf16_t*)(ws + A_HN), (const bf16_t*)(ws + WS_WIN), MT, 3072, 2048, 2048, 2048, 0, 0}; pg8::StaticOrder S; S.init(MT, 3072, C.G, (int)blockIdx.x);
        pg8::EpiZ E{(bf16_t*)(ws + A_GG), (bf16_t*)(ws + A_B2), (bf16_t*)(ws + A_B2) + (size_t)MT * 1024};
        CLK_BEGIN(2) pg8::gemm_phase<pg8::EpiZ>(glds, g, S, E); CLK_END(2) FILL(2); } SEAM(2);
    if (IN(3)) { phase_convpool(C); } NEED(3, bq::E_POOL); SEAM(3);
    if (IN(4)) {
        { pg8::Gemm g{(const bf16_t*)(ws + A_B3), (const bf16_t*)(ws + WS_WGATE), MT, 2048, 256, 1024, 256, 1, 256}; pg8::StaticOrder S; S.init(MT, 2048, C.G, (int)blockIdx.x);
          pg8::EpiGate E{(const bf16_t*)(ws + A_B3), (const float*)(ws + WS_SP), (float*)(ws + A_B4)};
          pg8::gemm_phase<pg8::EpiGate>(glds, g, S, E); }
        FILL(4); } SEAM(4);
    if (IN(5)) {
        { pg8::Gemm g{(const bf16_t*)(ws + A_B3) + (size_t)MT * 1024, (const bf16_t*)(ws + WS_WPOOL), MT, 1024, 256, 1024, 256, 0, 256}; pg8::StaticOrder S; S.init(MT, 1024, C.G, (int)blockIdx.x);
          pg8::EpiPool E{(bf16_t*)(ws + A_HN), C.in[22]};
          pg8::gemm_phase<pg8::EpiPool>(glds, g, S, E); }
        phase_scanA(C); FILL(5); } SEAM(5);
    if (IN(6)) { phase_scanB(C); } SEAM(6);
    if (IN(7)) { phase_scanC(C); } NEED(7, bq::E_OUTR); SEAM(7);
    if (IN(8)) {
        pg8::Gemm g{(const bf16_t*)(ws + A_HN), (const bf16_t*)(ws + WS_WOUTR), MT, 2048, 2048, 2048, 2048, 0, 0}; pg8::StaticOrder S; S.init(MT, 2048, C.G, (int)blockIdx.x);
        pg8::EpiBf16 E{(bf16_t*)(ws + A_B3), 2048};
        pg8::gemm_phase<pg8::EpiBf16>(glds, g, S, E); FILL(8); } SEAM(8);
#define PEER_BLOCK(P0, L) \
    if (IN(P0)) { phase_resid_norm(C, (L) == 0 ? C.in[0] : X, (L) == 0 ? C.in[1] : X + (size_t)MP * DM, (const bf16_t*)(ws + A_B3), X, C.in[12] + (L) * 2048, mod + (size_t)(L) * NSEQ * 12288, (bf16_t*)(ws + A_B2)); } NEED(P0, (L) == 0 ? bq::E_Q0 : bq::E_Q1); SEAM(P0); \
    if (IN(P0 + 1)) { pg8::Gemm g{(const bf16_t*)(ws + A_B2), (const bf16_t*)(ws + WS_WQ) + (size_t)(L) * 2048 * 2048, MT, 2048, 2048, 2048, 2048, 0, 0}; pg8::StaticOrder S; S.init(MT, 2048, C.G, (int)blockIdx.x); \
        pg8::EpiBf16 E{(bf16_t*)(ws + A_B3), 2048}; pg8::gemm_phase<pg8::EpiBf16>(glds, g, S, E); FILL(P0 + 1); } NEED(P0 + 1, (L) == 0 ? bq::E_KEYS : 0); SEAM(P0 + 1); \
    if (IN(P0 + 2)) { phase_topk(C, L); } NEED(P0 + 2, (L) == 0 ? bq::E_TAB0 : bq::NTOT); SEAM(P0 + 2); \
    if (IN(P0 + 3)) { CLK_BEGIN(P0 + 3) phase_gather(C, L); CLK_END(P0 + 3) }
    PEER_BLOCK(9, 0) NEED(12, bq::E_DKV); SEAM(12);
    if (IN(13)) {
        pg8::Gemm g{(const bf16_t*)(ws + A_HN), (const bf16_t*)(ws + WS_WDQKV), MT, 1024, 2048, 2048, 2048, 0, 0}; pg8::StaticOrder S; S.init(MT, 1024, C.G, (int)blockIdx.x);
        pg8::EpiF32 E{(float*)(ws + A_B3), 1024};
        pg8::gemm_phase<pg8::EpiF32>(glds, g, S, E); FILL(13); } NEED(13, bq::E_ROPE); SEAM(13);
    if (IN(14)) { phase_latent(C); } NEED(14, bq::E_UKV); SEAM(14);
    if (IN(15)) {
        { pg8::Gemm g{(const bf16_t*)(ws + A_CQ), (const bf16_t*)(ws + WS_WUQ), MT, 3072, 512, 512, 512, 0, 0}; pg8::StaticOrder S; S.init(MT, 3072, C.G, (int)blockIdx.x);
          pg8::EpiQ E{(bf16_t*)(ws + A_HN), (bf16_t*)(ws + A_GG), (const float*)(ws + WS_ROPE)};
          pg8::gemm_phase<pg8::EpiQ>(glds, g, S, E); }
        { pg8::Gemm g{(const bf16_t*)(ws + A_CKV), (const bf16_t*)(ws + WS_WUKV), KVROWS, 4096, 256, 256, 256, 0, 0}; pg8::StaticOrder S; S.init(KVROWS, 4096, C.G, (int)blockIdx.x);
          pg8::EpiKV E{(bf16_t*)(ws + A_KN), (bf16_t*)(ws + A_VV)};
          pg8::gemm_phase<pg8::EpiKV>(glds, g, S, E); } FILL(15); } SEAM(15);
    if (IN(16)) { CLK_BEGIN(16) att::attn_phase(C); CLK_END(16) } NEED(16, bq::E_OUTA); SEAM(16);
    if (IN(17)) {
        pg8::Gemm g{(const bf16_t*)(ws + A_HN), (const bf16_t*)(ws + WS_WOUTA), MT, 2048, 2048, 2048, 2048, 0, 0}; pg8::StaticOrder S; S.init(MT, 2048, C.G, (int)blockIdx.x);
        pg8::EpiBf16 E{(bf16_t*)(ws + A_B3), 2048};
        pg8::gemm_phase<pg8::EpiBf16>(glds, g, S, E); FILL(17); } SEAM(17);
    PEER_BLOCK(18, 1)
#undef PEER_BLOCK
#undef IN
#undef SEAM
#undef FILL
#undef NEED
}

extern "C" void kernel_launch(void* const* d_in, const int* in_sizes, int n_in, void* d_out, int out_size, void* d_ws, size_t ws_size, hipStream_t stream) {
    static int grid = 0;
    if (grid == 0) {
        if (n_in != 36 || out_size != (int)O_TOTAL || ws_size < WS_END) { fprintf(stderr, "kernel_launch: built for 36 inputs, %zu outputs, >= %zu B workspace; got n_in %d out %d ws %zu\n", (size_t)O_TOTAL, (size_t)WS_END, n_in, out_size, ws_size); grid = -1; return; }
        int dev = 0, cus = 0, per_cu = 0;
        if (hipGetDevice(&dev) != hipSuccess || hipDeviceGetAttribute(&cus, hipDeviceAttributeMultiprocessorCount, dev) != hipSuccess) { fprintf(stderr, "kernel_launch: device query failed\n"); grid = -1; return; }
        if (hipFuncSetAttribute((const void*)mega_fwd, hipFuncAttributeMaxDynamicSharedMemorySize, LDS_BYTES) != hipSuccess) { fprintf(stderr, "kernel_launch: hipFuncSetAttribute failed\n"); grid = -1; return; }
        if (hipOccupancyMaxActiveBlocksPerMultiprocessor(&per_cu, (const void*)mega_fwd, 512, LDS_BYTES) != hipSuccess || per_cu < 1) { fprintf(stderr, "kernel_launch: occupancy query says %d blocks per CU\n", per_cu); }
        (void)hipGetLastError();
        grid = cus;
    }
    if (grid < 0) return;
    (void)hipMemsetAsync(d_ws, 0, WS_ZERO_BYTES, stream);
    Args a{};
    for (int i = 0; i < 36; ++i) a.in[i] = (const float*)d_in[i];
    a.out = (float*)d_out; a.ws = (unsigned char*)d_ws;
#if MK_SPLIT
    for (int p = 0; p < N_PHASES; ++p) { a.ph_lo = p; a.ph_hi = p + 1; hipLaunchKernelGGL(mega_fwd, dim3(grid), dim3(512), LDS_BYTES, stream, a); }
#elif defined(PROBE_RANGES)
    { const int rg[][2] = {PROBE_RANGES};
      for (unsigned i = 0; i < sizeof(rg) / sizeof(rg[0]); ++i) { if (i) (void)hipMemsetAsync(d_ws, 0, 1 * MiB, stream); a.ph_lo = rg[i][0]; a.ph_hi = rg[i][1]; hipLaunchKernelGGL(mega_fwd, dim3(grid), dim3(512), LDS_BYTES, stream, a); } }
#else
    a.ph_lo = 0; a.ph_hi = N_PHASES; hipLaunchKernelGGL(mega_fwd, dim3(grid), dim3(512), LDS_BYTES, stream, a);
#endif
    const hipError_t le = hipPeekAtLastError();
    if (le != hipSuccess) fprintf(stderr, "kernel_launch: launch failed: %s\n", hipGetErrorName(le));
}
```

```cpp
#include <hip/hip_runtime.h>
#include <cstdio>
#include <cstdint>

#define LAS __attribute__((address_space(3)))
#define GAS __attribute__((address_space(1)))
typedef unsigned short bf16_t;
typedef short bf16x8 __attribute__((ext_vector_type(8)));
typedef short s16x4 __attribute__((ext_vector_type(4)));
typedef float f32x2 __attribute__((ext_vector_type(2)));
typedef float f32x4 __attribute__((ext_vector_type(4)));
typedef float f32x16 __attribute__((ext_vector_type(16)));
typedef unsigned u32x2 __attribute__((ext_vector_type(2)));
typedef unsigned u32x4 __attribute__((ext_vector_type(4)));

constexpr int DM = 2048;
constexpr int MP = 32768, MS = 2048, MT = MP + MS;
constexpr int NSEQ = 34;
constexpr int KVROWS = MP + 32 * 1088;
constexpr float RMS_EPS = 1e-6f;

__device__ __forceinline__ int seq_of_row(int m) { return m < MP ? (m >> 14) : 2 + ((m - MP) >> 6); }
__device__ __forceinline__ int pos_of_row(int m) { return m < MP ? (m & 16383) : 1024 + ((m - MP) & 63); }
__device__ __forceinline__ int kvrow_of_row(int m) { return m < MP ? m : MP + ((m - MP) >> 6) * 1088 + 1024 + ((m - MP) & 63); }

__device__ __forceinline__ unsigned cvt_pk_bf16(float lo, float hi) { unsigned r; asm volatile("v_cvt_pk_bf16_f32 %0, %1, %2" : "=v"(r) : "v"(lo), "v"(hi)); return r; }
__device__ __forceinline__ unsigned cvt4_fp8(float a, float b, float c, float d) { int t = 0;
    t = __builtin_amdgcn_cvt_pk_fp8_f32(fminf(fmaxf(a, -448.f), 448.f), fminf(fmaxf(b, -448.f), 448.f), t, false);
    t = __builtin_amdgcn_cvt_pk_fp8_f32(fminf(fmaxf(c, -448.f), 448.f), fminf(fmaxf(d, -448.f), 448.f), t, true); return (unsigned)t; }
__device__ __forceinline__ float bf_lo(unsigned w) { return __uint_as_float(w << 16); }
__device__ __forceinline__ float bf_hi(unsigned w) { return __uint_as_float(w & 0xffff0000u); }
__device__ __forceinline__ float fexp(float x) { return __builtin_amdgcn_exp2f(x * 1.4426950408889634f); }
__device__ __forceinline__ float fsigmoid(float x) { return __builtin_amdgcn_rcpf(1.0f + __builtin_amdgcn_exp2f(-1.4426950408889634f * x)); }
__device__ __forceinline__ float gelu_tanh(float x) { const float u = x * (1.0f + 0.044715f * x * x); return x * __builtin_amdgcn_rcpf(1.0f + __builtin_amdgcn_exp2f(-2.302208198f * u)); }
__device__ __forceinline__ float gelu_erf(float v) {
    const float av = __builtin_fabsf(v), t = __builtin_amdgcn_rcpf(av * 0.2316418882f + 1.0f);
    float q = t * 0.5307027145f + (-0.7265760135f); q = q * t + 0.7107068705f; q = q * t + (-0.142248368f); q = q * t + 0.127414796f; q = q * t;
    const float e = __builtin_amdgcn_exp2f((v * v) * (-0.72134752044f));
    const float m = v * (q * e); return v < 0.f ? m : v - m;
}
__device__ __forceinline__ float wave_sum(float v) {
#pragma unroll
    for (int o = 32; o >= 1; o >>= 1) v += __shfl_xor(v, o);
    return v;
}

namespace pg8 {
constexpr int BM = 256, BK = 64, HALF = 128, HTB = HALF * BK * 2, STAGE_BYTES = 8 * HTB, NXCD = 8, WGM = 8;
__host__ __device__ __forceinline__ int lds_byte(int r, int c) { const int st = (r >> 4) * 2 + (c >> 5), rr = r & 15, cc = c & 31, ob = rr * 64 + cc * 2; return st * 1024 + (ob ^ (((ob >> 9) & 1) << 5)); }
__host__ __device__ __forceinline__ void stage_rc(int b, int& R, int& C) { const int st = b / 1024, sb = b % 1024, swz = sb ^ (((sb >> 9) & 1) << 5); R = (st >> 1) * 16 + swz / 64; C = (st & 1) * 32 + (swz % 64) / 2; }
__host__ __device__ __forceinline__ int perm32(int rho) { const int n = rho >> 4, i = rho & 15; return 8 * (i >> 2) + 4 * n + (i & 3); }

struct Unit { int pm, pn; };
struct Gemm { const bf16_t* A; const bf16_t* Bt; int M, N, K, lda, ldb, kshift, kmul; };

struct StaticOrder {
    int nM, nN, nwg, G, c;
    __host__ __device__ void init(int M, int N, int G_, int c_) { nM = M / BM; nN = N / BM; nwg = nM * nN; G = G_; c = c_; }
    __host__ __device__ bool next(int i, Unit& u) const {
        const long L = (long)i * G + c; if (L >= nwg) return false;
        int wgid = (int)L; { const int q = nwg / NXCD, r = nwg % NXCD, xcd = wgid % NXCD, off = wgid / NXCD; wgid = (xcd < r ? xcd * (q + 1) : r * (q + 1) + (xcd - r) * q) + off; }
        const int nig = WGM * nN, gid = wgid / nig, fm = gid * WGM, gsz = (nM - fm) < WGM ? (nM - fm) : WGM;
        u.pm = fm + ((wgid % nig) % gsz); u.pn = (wgid % nig) / gsz; return true;
    }
};

template <class Epi>
__device__ __forceinline__ void gemm_phase(LAS unsigned char* lds, const Gemm g, const StaticOrder& S, const Epi& E) {
    const int tid = threadIdx.x, wid = __builtin_amdgcn_readfirstlane(tid >> 6), lane = tid & 63, wr = wid >> 2, wc = wid & 3, fr = lane & 15, fq = lane >> 4;
    int Kq = g.K; asm volatile("" : "+s"(Kq));
    const int K = Kq, nt = K / BK;
    unsigned voffA[2], voffB[2];
#pragma unroll
    for (int i = 0; i < 2; ++i) { int R, C; stage_rc(tid * 16 + i * 8192, R, C); const int Rb = Epi::PERM ? ((R & ~31) + perm32(R & 31)) : R;
        voffA[i] = (unsigned)(R * g.lda + C) * 2u; voffB[i] = (unsigned)(Rb * g.ldb + C) * 2u; }
    const size_t kstep = (size_t)(BK * 2);
    const size_t hstepA = (size_t)HALF * g.lda * 2, hstepB = (size_t)HALF * g.ldb * 2;
    const unsigned ldsw = (unsigned)wid * 1024u;
    const int aoff = lds_byte(wr * 64 + fr, fq * 8), boff = lds_byte(wc * 32 + fr, fq * 8);
#define PG8_SA(b, h) (((b) * 2 + (h)) * HTB)
#define PG8_SB(b, h) ((4 + (b) * 2 + (h)) * HTB)
#define PG8_STAGE(bufoff, gbase, voff) do { _Pragma("unroll") for (int _i = 0; _i < 2; ++_i) \
        __builtin_amdgcn_global_load_lds((const unsigned*)((const char*)(gbase) + (voff)[_i]), (LAS unsigned*)(lds + (bufoff) + ldsw + _i * 8192), 16, 0, 0); } while (0)
#define PG8_LDA(dst, b, h) do { _Pragma("unroll") for (int m = 0; m < 4; ++m) _Pragma("unroll") for (int k = 0; k < 2; ++k) dst[m][k] = *(const LAS bf16x8*)(lds + PG8_SA(b, h) + aoff + m * 2048 + k * 1024); } while (0)
#define PG8_LDB(dst, b, h) do { _Pragma("unroll") for (int n = 0; n < 2; ++n) _Pragma("unroll") for (int k = 0; k < 2; ++k) dst[n][k] = *(const LAS bf16x8*)(lds + PG8_SB(b, h) + boff + n * 2048 + k * 1024); } while (0)
#define PG8_MMA(ai, bj, At, Bt) do { __builtin_amdgcn_s_setprio(1); _Pragma("unroll") for (int m = 0; m < 4; ++m) _Pragma("unroll") for (int n = 0; n < 2; ++n) _Pragma("unroll") for (int k = 0; k < 2; ++k) \
        acc[ai][bj][m][n] = __builtin_amdgcn_mfma_f32_16x16x32_bf16(Bt[n][k], At[m][k], acc[ai][bj][m][n], 0, 0, 0); __builtin_amdgcn_s_setprio(0); } while (0)
#define PG8_WAIT_V(n) asm volatile("s_waitcnt vmcnt(" #n ")" ::: "memory")
#define PG8_WAIT_L(n) asm volatile("s_waitcnt lgkmcnt(" #n ")" ::: "memory")
#define PG8_BAR __builtin_amdgcn_s_barrier()
#define PG8_SCHED __builtin_amdgcn_sched_barrier(0)
#define PG8_ABASE(u) ((const char*)g.A + (size_t)(u).pm * (2 * hstepA) + (size_t)(((u).pn >> g.kshift) * g.kmul) * 2)
#define PG8_BBASE(u) ((const char*)g.Bt + (size_t)(u).pn * (2 * hstepB))
    Unit cur, nxt; int ui = 0;
    if (!S.next(0, cur)) return;
    f32x4 acc[2][2][4][2];
#pragma unroll
    for (int a = 0; a < 2; ++a)
#pragma unroll
        for (int b = 0; b < 2; ++b)
#pragma unroll
            for (int m = 0; m < 4; ++m)
#pragma unroll
                for (int n = 0; n < 2; ++n) acc[a][b][m][n] = (f32x4){0.f, 0.f, 0.f, 0.f};
    bf16x8 At[4][2], B0[2][2], B1[2][2];
    const char* cA = PG8_ABASE(cur); const char* cB = PG8_BBASE(cur);
    PG8_STAGE(PG8_SB(0, 0), cB, voffB); PG8_STAGE(PG8_SB(0, 1), cB + hstepB, voffB); PG8_STAGE(PG8_SA(0, 0), cA, voffA); PG8_STAGE(PG8_SA(0, 1), cA + hstepA, voffA);
    if (wr == 1) PG8_BAR;
    PG8_WAIT_V(2); PG8_BAR;
    PG8_STAGE(PG8_SB(1, 0), cB + kstep, voffB); PG8_STAGE(PG8_SA(1, 0), cA + kstep, voffA); PG8_STAGE(PG8_SB(1, 1), cB + hstepB + kstep, voffB);
    PG8_WAIT_V(6); PG8_BAR;
    for (;;) {
        const bool has_next = S.next(ui + 1, nxt);
        const char* nA = has_next ? PG8_ABASE(nxt) : cA; const char* nB = has_next ? PG8_BBASE(nxt) : cB;
        for (int t = 0; t < nt; t += 2) {
            const bool last = (t == nt - 2);
            const char* a1 = cA + (size_t)(t + 1) * kstep;
            const char* a2 = last ? nA : cA + (size_t)(t + 2) * kstep; const char* b2 = last ? nB : cB + (size_t)(t + 2) * kstep;
            const char* a3 = a2 + kstep; const char* b3 = b2 + kstep;
            PG8_LDB(B0, 0, 0); PG8_LDB(B1, 0, 1); PG8_SCHED; PG8_LDA(At, 0, 0); PG8_STAGE(PG8_SA(1, 1), a1 + hstepA, voffA);
            PG8_WAIT_V(8); PG8_WAIT_L(0); PG8_BAR; PG8_MMA(0, 0, At, B0); PG8_MMA(0, 1, At, B1); PG8_BAR; PG8_SCHED;
            PG8_LDA(At, 0, 1); PG8_STAGE(PG8_SB(0, 0), b2, voffB); PG8_STAGE(PG8_SB(0, 1), b2 + hstepB, voffB); PG8_STAGE(PG8_SA(0, 0), a2, voffA);
            PG8_WAIT_V(8); PG8_WAIT_L(0); PG8_BAR; PG8_MMA(1, 0, At, B0); PG8_MMA(1, 1, At, B1); PG8_BAR; PG8_SCHED;
            PG8_LDB(B0, 1, 0); PG8_LDB(B1, 1, 1); PG8_SCHED; PG8_LDA(At, 1, 0); PG8_STAGE(PG8_SA(0, 1), a2 + hstepA, voffA);
            PG8_WAIT_V(8); PG8_WAIT_L(0); PG8_BAR; PG8_MMA(0, 0, At, B0); PG8_MMA(0, 1, At, B1); PG8_BAR; PG8_SCHED;
            PG8_LDA(At, 1, 1); PG8_STAGE(PG8_SB(1, 0), b3, voffB); PG8_STAGE(PG8_SB(1, 1), b3 + hstepB, voffB); PG8_STAGE(PG8_SA(1, 0), a3, voffA);
            PG8_WAIT_V(8); PG8_WAIT_L(0); PG8_BAR; PG8_MMA(1, 0, At, B0); PG8_MMA(1, 1, At, B1); PG8_BAR; PG8_SCHED;
        }
        if (wr == 0) PG8_BAR;
        E(acc, cur, wr, wc, fr, fq);
        if (!has_next) break;
#pragma unroll
        for (int a = 0; a < 2; ++a)
#pragma unroll
            for (int b = 0; b < 2; ++b)
#pragma unroll
                for (int m = 0; m < 4; ++m)
#pragma unroll
                    for (int n = 0; n < 2; ++n) acc[a][b][m][n] = (f32x4){0.f, 0.f, 0.f, 0.f};
        cur = nxt; cA = nA; cB = nB; ++ui;
        if (wr == 1) PG8_BAR;
    }
    PG8_WAIT_V(0);
    PG8_BAR;
#undef PG8_SA
#undef PG8_SB
#undef PG8_STAGE
#undef PG8_LDA
#undef PG8_LDB
#undef PG8_MMA
#undef PG8_WAIT_V
#undef PG8_WAIT_L
#undef PG8_BAR
#undef PG8_SCHED
#undef PG8_ABASE
#undef PG8_BBASE
}
}
namespace pg8 {
#define EPI_ROWS(expr_row) for (int ai = 0; ai < 2; ++ai) for (int m = 0; m < 4; ++m)
struct EpiBf16 {
    static constexpr bool PERM = true;
    bf16_t* O; int ldc;
    __device__ __forceinline__ void operator()(const f32x4 (&acc)[2][2][4][2], const Unit& u, int wr, int wc, int fr, int fq) const {
        const int row0 = u.pm * BM + wr * 64 + fr, col0 = u.pn * BM + wc * 32 + 8 * fq;
#pragma unroll
        for (int ai = 0; ai < 2; ++ai)
#pragma unroll
            for (int m = 0; m < 4; ++m) { bf16_t* rowp = O + (size_t)(row0 + ai * HALF + m * 16) * ldc + col0;
#pragma unroll
                for (int bj = 0; bj < 2; ++bj) { const f32x4 v0 = acc[ai][bj][m][0], v1 = acc[ai][bj][m][1];
                    u32x4 w; w.x = cvt_pk_bf16(v0[0], v0[1]); w.y = cvt_pk_bf16(v0[2], v0[3]); w.z = cvt_pk_bf16(v1[0], v1[1]); w.w = cvt_pk_bf16(v1[2], v1[3]);
                    *(u32x4*)(rowp + bj * HALF) = w; } }
    }
};
struct EpiZ {
    static constexpr bool PERM = true;
    bf16_t* GG; bf16_t* REC; bf16_t* POOL;
    __device__ __forceinline__ void operator()(const f32x4 (&acc)[2][2][4][2], const Unit& u, int wr, int wc, int fr, int fq) const {
        const int t = u.pn >> 2; bf16_t* base = GG + (size_t)t * ((size_t)MT * 1024);
        const int row0 = u.pm * BM + wr * 64 + fr, col0 = (u.pn & 3) * BM + wc * 32 + 8 * fq;
#pragma unroll
        for (int ai = 0; ai < 2; ++ai)
#pragma unroll
            for (int m = 0; m < 4; ++m) { bf16_t* rowp = base + (size_t)(row0 + ai * HALF + m * 16) * 1024 + col0;
#pragma unroll
                for (int bj = 0; bj < 2; ++bj) { f32x4 v0 = acc[ai][bj][m][0], v1 = acc[ai][bj][m][1];
                    if (t == 0) {
#pragma unroll
                        for (int j = 0; j < 4; ++j) { v0[j] = gelu_tanh(v0[j]); v1[j] = gelu_tanh(v1[j]); } }
                    u32x4 w; w.x = cvt_pk_bf16(v0[0], v0[1]); w.y = cvt_pk_bf16(v0[2], v0[3]); w.z = cvt_pk_bf16(v1[0], v1[1]); w.w = cvt_pk_bf16(v1[2], v1[3]);
                    *(u32x4*)(rowp + bj * HALF) = w; } }
    }
};
struct EpiGate {
    static constexpr bool PERM = false;
    const bf16_t* XC; const float* gp; float* Aout;
    __device__ __forceinline__ void operator()(const f32x4 (&acc)[2][2][4][2], const Unit& u, int wr, int wc, int fr, int fq) const {
        const int row0 = u.pm * BM + wr * 64 + fr, ch0 = u.pn * 128 + wc * 32 + 4 * fq;
#pragma unroll
        for (int n = 0; n < 2; ++n) {
            const f32x4 bav = *(const f32x4*)(gp + ch0 + 16 * n), bxv = *(const f32x4*)(gp + 1024 + ch0 + 16 * n), spv = *(const f32x4*)(gp + 2048 + ch0 + 16 * n);
#pragma unroll
            for (int ai = 0; ai < 2; ++ai)
#pragma unroll
                for (int m = 0; m < 4; ++m) { const int row = row0 + ai * HALF + m * 16; const bool pos0 = (row < MP) && ((row & 16383) == 0);
                    const size_t off = (size_t)row * 1024 + ch0 + 16 * n;
                    const u32x2 xw = *(const u32x2*)(XC + off); const float xc[4] = {bf_lo(xw.x), bf_hi(xw.x), bf_lo(xw.y), bf_hi(xw.y)};
                    f32x4 av, uv;
#pragma unroll
                    for (int j = 0; j < 4; ++j) { const float r = fsigmoid(acc[ai][0][m][n][j] + bav[j]), ig = fsigmoid(acc[ai][1][m][n][j] + bxv[j]);
                        const float log_a = -8.0f * r * spv[j]; const float a = fexp(log_a); const float mult = pos0 ? 1.0f : __builtin_sqrtf(fmaxf(1.0f - a * a, 0.0f));
                        av[j] = a; uv[j] = mult * ig * xc[j]; }
                    *(f32x4*)(Aout + off) = av; { u32x2 uw; uw.x = cvt_pk_bf16(uv[0], uv[1]); uw.y = cvt_pk_bf16(uv[2], uv[3]); *(u32x2*)((bf16_t*)(Aout + (size_t)MT * 1024) + off) = uw; } asm volatile("" ::: "memory"); }
        }
    }
};
struct EpiPool {
    static constexpr bool PERM = true;
    bf16_t* CAT; const float* spool;
    __device__ __forceinline__ void operator()(const f32x4 (&acc)[2][2][4][2], const Unit& u, int wr, int wc, int fr, int fq) const {
        const int row0 = u.pm * BM + wr * 64 + fr, col0 = u.pn * BM + wc * 32 + 8 * fq;
        f32x4 s0[2], s1[2];
#pragma unroll
        for (int bj = 0; bj < 2; ++bj) { s0[bj] = *(const f32x4*)(spool + col0 + bj * HALF); s1[bj] = *(const f32x4*)(spool + col0 + bj * HALF + 4); }
#pragma unroll
        for (int ai = 0; ai < 2; ++ai)
#pragma unroll
            for (int m = 0; m < 4; ++m) { bf16_t* rowp = CAT + (size_t)(row0 + ai * HALF + m * 16) * 2048 + 1024 + col0;
#pragma unroll
                for (int bj = 0; bj < 2; ++bj) { const f32x4 v0 = acc[ai][bj][m][0] * s0[bj], v1 = acc[ai][bj][m][1] * s1[bj];
                    u32x4 w; w.x = cvt_pk_bf16(v0[0], v0[1]); w.y = cvt_pk_bf16(v0[2], v0[3]); w.z = cvt_pk_bf16(v1[0], v1[1]); w.w = cvt_pk_bf16(v1[2], v1[3]);
                    *(u32x4*)(rowp + bj * HALF) = w; } }
    }
};
struct EpiResid {
    static constexpr bool PERM = false;
    const float* xinP; const float* xinS; float* xout; const float* gate;
    __device__ __forceinline__ void operator()(const f32x4 (&acc)[2][2][4][2], const Unit& u, int wr, int wc, int fr, int fq) const {
        const int row0 = u.pm * BM + wr * 64 + fr, col0 = u.pn * BM + wc * 32 + 4 * fq;
#pragma unroll
        for (int ai = 0; ai < 2; ++ai)
#pragma unroll
            for (int m = 0; m < 4; ++m) { const int row = row0 + ai * HALF + m * 16; const float* gp = gate + (size_t)seq_of_row(row) * 12288 + col0;
                const float* xi = (row < MP ? xinP + (size_t)row * DM : xinS + (size_t)(row - MP) * DM) + col0; float* xo = xout + (size_t)row * DM + col0;
#pragma unroll
                for (int bj = 0; bj < 2; ++bj)
#pragma unroll
                    for (int n = 0; n < 2; ++n) { const int o = bj * HALF + n * 16; *(f32x4*)(xo + o) = *(const f32x4*)(xi + o) + *(const f32x4*)(gp + o) * acc[ai][bj][m][n]; }
                asm volatile("" ::: "memory"); }
    }
};
struct EpiF32 {
    static constexpr bool PERM = false;
    float* C; int ldc;
    __device__ __forceinline__ void operator()(const f32x4 (&acc)[2][2][4][2], const Unit& u, int wr, int wc, int fr, int fq) const {
        const int row0 = u.pm * BM + wr * 64 + fr, col0 = u.pn * BM + wc * 32 + 4 * fq;
#pragma unroll
        for (int ai = 0; ai < 2; ++ai)
#pragma unroll
            for (int m = 0; m < 4; ++m) { float* rowp = C + (size_t)(row0 + ai * HALF + m * 16) * ldc + col0;
#pragma unroll
                for (int bj = 0; bj < 2; ++bj)
#pragma unroll
                    for (int n = 0; n < 2; ++n) *(f32x4*)(rowp + bj * HALF + n * 16) = acc[ai][bj][m][n]; }
    }
};
struct EpiQ {
    static constexpr bool PERM = true;
    static constexpr float QS = 0.07216878364870322f * 1.4426950408889634f;
    unsigned char* Q8; const float* rope;
    __device__ __forceinline__ void operator()(const f32x4 (&acc)[2][2][4][2], const Unit& u, int wr, int wc, int fr, int fq) const {
        const int row0 = u.pm * BM + wr * 64 + fr;
        if (u.pn < 8) {
            const int col0 = u.pn * BM + wc * 32 + 8 * fq;
#pragma unroll
            for (int ai = 0; ai < 2; ++ai)
#pragma unroll
                for (int m = 0; m < 4; ++m) { unsigned char* rowp = Q8 + (size_t)(row0 + ai * HALF + m * 16) * 3072;
#pragma unroll
                    for (int bj = 0; bj < 2; ++bj) { const f32x4 v0 = acc[ai][bj][m][0] * QS, v1 = acc[ai][bj][m][1] * QS; const int col = col0 + bj * HALF;
                        u32x2 w; w.x = cvt4_fp8(v0[0], v0[1], v0[2], v0[3]); w.y = cvt4_fp8(v1[0], v1[1], v1[2], v1[3]);
                        *(u32x2*)(rowp + (col >> 7) * 192 + (col & 127)) = w; } }
        } else {
            const int head = (u.pn - 8) * 4 + wc, j0 = 8 * fq;
#pragma unroll
            for (int ai = 0; ai < 2; ++ai)
#pragma unroll
                for (int m = 0; m < 4; ++m) { const int row = row0 + ai * HALF + m * 16; const float* rp = rope + (size_t)pos_of_row(row) * 64 + j0;
                    const f32x4 c0 = *(const f32x4*)(rp), c1 = *(const f32x4*)(rp + 4), s0 = *(const f32x4*)(rp + 32), s1 = *(const f32x4*)(rp + 36);
                    const f32x4 x10 = acc[ai][0][m][0] * QS, x11 = acc[ai][0][m][1] * QS, x20 = acc[ai][1][m][0] * QS, x21 = acc[ai][1][m][1] * QS;
                    const f32x4 a0 = x10 * c0 - x20 * s0, a1 = x11 * c1 - x21 * s1, b0 = x10 * s0 + x20 * c0, b1 = x11 * s1 + x21 * c1;
                    unsigned char* qp = Q8 + (size_t)row * 3072 + head * 192 + 128 + j0;
                    u32x2 w; w.x = cvt4_fp8(a0[0], a0[1], a0[2], a0[3]); w.y = cvt4_fp8(a1[0], a1[1], a1[2], a1[3]); *(u32x2*)qp = w;
                    w.x = cvt4_fp8(b0[0], b0[1], b0[2], b0[3]); w.y = cvt4_fp8(b1[0], b1[1], b1[2], b1[3]); *(u32x2*)(qp + 32) = w; }
        }
    }
};
struct EpiKV {
    static constexpr bool PERM = true;
    unsigned char* Kn8; bf16_t* V;
    __device__ __forceinline__ void operator()(const f32x4 (&acc)[2][2][4][2], const Unit& u, int wr, int wc, int fr, int fq) const {
        const int row0 = u.pm * BM + wr * 64 + fr, col0 = u.pn * 128 + wc * 32 + 8 * fq;
#pragma unroll
        for (int ai = 0; ai < 2; ++ai)
#pragma unroll
            for (int m = 0; m < 4; ++m) { const size_t off = (size_t)(row0 + ai * HALF + m * 16) * 2048 + col0;
                { const f32x4 v0 = acc[ai][0][m][0], v1 = acc[ai][0][m][1]; u32x2 w; w.x = cvt4_fp8(v0[0], v0[1], v0[2], v0[3]); w.y = cvt4_fp8(v1[0], v1[1], v1[2], v1[3]); *(u32x2*)(Kn8 + off) = w; }
                { const f32x4 v0 = acc[ai][1][m][0], v1 = acc[ai][1][m][1];
                  u32x4 w; w.x = cvt_pk_bf16(v0[0], v0[1]); w.y = cvt_pk_bf16(v0[2], v0[3]); w.z = cvt_pk_bf16(v1[0], v1[1]); w.w = cvt_pk_bf16(v1[2], v1[3]); *(u32x4*)(V + off) = w; } }
    }
};
#undef EPI_ROWS
}

#define XB_TMO      128
#define XB_XCNT(j)  (256  + 64 * (j))
#define XB_XSUB(j)  (1280 + 64 * (j))
#define XB_XGEN(j)  (2304 + 64 * (j))
#define XB_TOP      3328
#define XB_TOPGEN   3392
#define XCD_BAR_WORDS 3456
#define XB_SPIN_CAP (1u << 18)
__device__ __forceinline__ unsigned xb_ld(unsigned* p)              { return __hip_atomic_load(p, __ATOMIC_RELAXED, __HIP_MEMORY_SCOPE_AGENT); }
__device__ __forceinline__ unsigned xb_add(unsigned* p, unsigned v) { return __hip_atomic_fetch_add(p, v, __ATOMIC_RELAXED, __HIP_MEMORY_SCOPE_AGENT); }
__device__ __forceinline__ unsigned xb_xcc_id() { return (unsigned)__builtin_amdgcn_s_getreg((3 << 11) | 20) & 0xFu; }
#define XB_SPIN(cond, bar) do { unsigned _sp = 0; while (cond) { __builtin_amdgcn_s_sleep(1); \
    if ((++_sp & 255u) == 0u) { if (xb_ld(&(bar)[XB_TMO])) break; if (_sp > XB_SPIN_CAP) { atomicAdd(&(bar)[XB_TMO], 1u); break; } } } } while (0)
struct XcdBarrier { unsigned* bar; unsigned x; volatile LAS unsigned* st; };
__device__ __forceinline__ XcdBarrier xcd_barrier_post(unsigned* bar, volatile LAS unsigned* st) {
    XcdBarrier b; b.bar = bar; b.x = xb_xcc_id(); b.st = st;
    if (threadIdx.x == 0) (void)xb_add(&bar[XB_XCNT(b.x)], 1u);
    return b;
}
__device__ __forceinline__ void xcd_barrier_complete(unsigned* bar, unsigned x, unsigned& nloc, unsigned& nx) {
    const unsigned G = gridDim.x * gridDim.y * gridDim.z;
    unsigned sum, cnt, mine, sp = 0u;
    for (;;) {
        sum = 0u; cnt = 0u; mine = 0u;
#pragma unroll
        for (unsigned j = 0; j < 16; ++j) { const unsigned c = xb_ld(&bar[XB_XCNT(j)]); sum += c; cnt += (c > 0u) ? 1u : 0u; mine = (j == x) ? c : mine; }
        if (sum == G) break;
        __builtin_amdgcn_s_sleep(1);
        if ((++sp & 255u) == 0u) { if (xb_ld(&bar[XB_TMO])) break; if (sp > XB_SPIN_CAP) { atomicAdd(&bar[XB_TMO], 1u); break; } }
    }
    nloc = mine > 0u ? mine : 1u; nx = cnt > 0u ? cnt : 1u;
}
__device__ __forceinline__ void xcd_barrier(const XcdBarrier& b) {
    asm volatile("s_waitcnt vmcnt(0)" ::: "memory");
    __syncthreads();
    if (threadIdx.x == 0) {
        unsigned* bar = b.bar;
        __builtin_amdgcn_s_waitcnt(0);
        unsigned nloc = b.st[0], nx = b.st[1];
        if (nloc == 0u) { xcd_barrier_complete(bar, b.x, nloc, nx); b.st[0] = nloc; b.st[1] = nx; }
        const unsigned old = xb_add(&bar[XB_XSUB(b.x)], 1u);
        const unsigned gen = old / nloc;
        if (old + 1u == (gen + 1u) * nloc) {
            __builtin_amdgcn_fence(__ATOMIC_RELEASE, "agent");
            asm volatile("s_waitcnt vmcnt(0)" ::: "memory");
            const unsigned og = xb_add(&bar[XB_TOP], 1u);
            const unsigned tg = og / nx;
            if (og + 1u == (tg + 1u) * nx) xb_add(&bar[XB_TOPGEN], 1u);
            else XB_SPIN(xb_ld(&bar[XB_TOPGEN]) == tg, bar);
            __builtin_amdgcn_fence(__ATOMIC_ACQUIRE, "agent");
            xb_add(&bar[XB_XGEN(b.x)], 1u);
            asm volatile("s_waitcnt vmcnt(0)" ::: "memory");
        } else {
            XB_SPIN(xb_ld(&bar[XB_XGEN(b.x)]) == gen, bar);
            __builtin_amdgcn_fence(__ATOMIC_ACQUIRE, "agent");
            asm volatile("s_waitcnt vmcnt(0)" ::: "memory");
        }
    }
    __syncthreads();
}
constexpr float U8_SCALE = 256.0f, V8_SCALE = 16.0f;
__device__ __forceinline__ void convert_fp8_range(const float* src, unsigned char* dst, float scale, size_t n16, size_t i0, size_t stride) {
    for (size_t i = i0; i < n16; i += stride) { u32x4 w;
#pragma unroll
        for (int q = 0; q < 4; ++q) { f32x4 a = *(const f32x4*)(src + i * 16 + 4 * q) * scale;
#pragma unroll
            for (int j = 0; j < 4; ++j) a[j] = fminf(fmaxf(a[j], -448.0f), 448.0f);
            int t = 0; t = __builtin_amdgcn_cvt_pk_fp8_f32(a[0], a[1], t, false); t = __builtin_amdgcn_cvt_pk_fp8_f32(a[2], a[3], t, true); w[q] = (unsigned)t; }
        *(u32x4*)(dst + i * 16) = w; }
}
constexpr float U4_SCALE = 90.50966799f, V4_SCALE = 8.0f;
__device__ __forceinline__ void convert_fp4_rows(const float* src, unsigned char* dst, float scale, int nrows, int w0, int wstride, int lane) {
    for (int r = w0; r < nrows; r += wstride) { const float* sr = src + (size_t)r * 2048 + 4 * lane; u32x4 w;
        f32x4 a[8];
#pragma unroll
        for (int b = 0; b < 8; ++b) a[b] = *(const f32x4*)(sr + 256 * b) * scale;
#pragma unroll
        for (int q = 0; q < 4; ++q) { float e[8] = {a[2 * q][0], a[2 * q][1], a[2 * q][2], a[2 * q][3], a[2 * q + 1][0], a[2 * q + 1][1], a[2 * q + 1][2], a[2 * q + 1][3]};
#pragma unroll
            for (int j = 0; j < 8; ++j) e[j] = fminf(fmaxf(e[j], -6.0f), 6.0f);
            unsigned t = 0u; t = __builtin_amdgcn_cvt_scalef32_pk_fp4_f32(t, e[0], e[1], 1.0f, 0); t = __builtin_amdgcn_cvt_scalef32_pk_fp4_f32(t, e[2], e[3], 1.0f, 1);
            t = __builtin_amdgcn_cvt_scalef32_pk_fp4_f32(t, e[4], e[5], 1.0f, 2); t = __builtin_amdgcn_cvt_scalef32_pk_fp4_f32(t, e[6], e[7], 1.0f, 3); w[q] = t; }
        *(u32x4*)(dst + (size_t)r * 1024 + 16 * lane) = w; }
}
constexpr size_t MiB = (size_t)1 << 20;
constexpr size_t WS_CTL = 0, WS_WGATE = 1 * MiB, WS_WDQKV = 2 * MiB, WS_ZERO_BYTES = 6 * MiB;
constexpr size_t WS_WIN = 6 * MiB, WS_WOUTR = 18 * MiB, WS_WQ = 26 * MiB, WS_WUQ = 42 * MiB, WS_WUKV = 45 * MiB, WS_WOUTA = 47 * MiB;
constexpr size_t WS_WPOOL = 55 * MiB, WS_KEYS = 56 * MiB, WS_MOD = 57 * MiB, WS_ROPE = 61 * MiB, WS_SP = 65 * MiB, WS_SCAN = 66 * MiB;
constexpr size_t WS_U = 73 * MiB, WS_V = 137 * MiB;
constexpr size_t A_HN = 201 * MiB, A_GG = 337 * MiB, A_B2 = 405 * MiB, A_B3 = 541 * MiB, A_B4 = 677 * MiB;
constexpr size_t A_KN = 405 * MiB  , A_Q8 = 537 * MiB  , A_VV = 669 * MiB, A_KP = 933 * MiB, A_CQ = 942 * MiB, A_CKV = 976 * MiB, WS_END = 1009 * MiB;
constexpr int CW_BAR = 4096;
constexpr size_t SCAN_WORDS = (size_t)544 * 1024;
constexpr size_t O_Y = 0, O_CONV_P = 71303168, O_CONV_S = 71309312, O_H_P = 71407616, O_H_S = 71409664, O_POOL_P = 71442432, O_POOL_S = 71473152,
                 O_CKV = 71964672, O_KPE = 80877568, O_TOTAL = 83105792;
constexpr int LDS_BYTES = 147456, LDS_MISC = 147200;

struct Args { const float* in[36]; float* out; unsigned char* ws; int ph_lo, ph_hi; };

struct Ctx {
    LAS unsigned char* lds; int tid, lane, wave, vcu, G, gw, NGW;
    const float* const* in; float* out; unsigned char* ws;
};

__device__ __forceinline__ void transpose_item(const float* W, int N, int k0, int n0, bf16_t* WT, int dld, int drow0, int dcol0, LAS float* scr, int lane) {
#pragma unroll 8
    for (int i = 0; i < 32; ++i) { const int kk = 2 * i + (lane >> 5); scr[kk * 33 + (lane & 31)] = W[(size_t)(k0 + kk) * N + n0 + (lane & 31)]; }
    asm volatile("s_waitcnt lgkmcnt(0)" ::: "memory");
    const int c = lane & 7;
#pragma unroll
    for (int j = 0; j < 4; ++j) { const int n = (lane >> 3) + 8 * j; const LAS float* s = scr + (8 * c) * 33 + n;
        u32x4 o; o.x = cvt_pk_bf16(s[0 * 33], s[1 * 33]); o.y = cvt_pk_bf16(s[2 * 33], s[3 * 33]); o.z = cvt_pk_bf16(s[4 * 33], s[5 * 33]); o.w = cvt_pk_bf16(s[6 * 33], s[7 * 33]);
        *(u32x4*)(WT + (size_t)(drow0 + n) * dld + dcol0 + 8 * c) = o; }
    asm volatile("s_waitcnt lgkmcnt(0)" ::: "memory");
}
__device__ __forceinline__ void transpose_mat_item(const float* W, int K, int N, bf16_t* WT, int dld, int drow_base, int dcol_base, int item, LAS float* scr, int lane) {
    const int nblk = N / 32, kb = item / nblk, nb = item % nblk;
    transpose_item(W, N, 64 * kb, 32 * nb, WT, dld, drow_base + 32 * nb, dcol_base + 64 * kb, scr, lane);
}
__device__ __forceinline__ void convert_range(const float* src, bf16_t* dst, size_t n8, size_t i0, size_t stride) {
    for (size_t i = i0; i < n8; i += stride) { const f32x4 a = *(const f32x4*)(src + i * 8), b = *(const f32x4*)(src + i * 8 + 4);
        u32x4 w; w.x = cvt_pk_bf16(a[0], a[1]); w.y = cvt_pk_bf16(a[2], a[3]); w.z = cvt_pk_bf16(b[0], b[1]); w.w = cvt_pk_bf16(b[2], b[3]);
        *(u32x4*)(dst + i * 8) = w; }
}

__device__ __forceinline__ void ada_item(const Ctx& C, int item) {
    const int l = item / 96, nb = item % 96, n0 = nb * 128, w = C.wave, lane = C.lane;
    const float* cP = C.in[2]; const float* cS = C.in[3]; const float* W = C.in[9] + (size_t)l * 2048 * 12288 + n0 + 2 * lane; const float* bias = C.in[10] + (size_t)l * 12288 + n0;
    LAS float* scr = (LAS float*)(C.lds + w * 4608);
    LAS float* sum = (LAS float*)(C.lds + 36864);
    f32x2 acc[34];
#pragma unroll
    for (int s = 0; s < 34; ++s) acc[s] = (f32x2){0.f, 0.f};
    for (int sub = 0; sub < 8; ++sub) {
        const int k0 = 256 * w + 32 * sub;
#pragma unroll
        for (int i = 0; i < 17; ++i) { const int idx = lane + 64 * i, s = idx >> 5, kk = idx & 31;
            const float cv = (s < 2) ? cP[s * 2048 + k0 + kk] : cS[(s - 2) * 2048 + k0 + kk];
            scr[kk * 36 + s] = cv * fsigmoid(cv); }
        asm volatile("s_waitcnt lgkmcnt(0)" ::: "memory");
#pragma unroll 1
        for (int kq = 0; kq < 2; ++kq) {
            f32x2 wv[16];
#pragma unroll
            for (int kk = 0; kk < 16; ++kk) wv[kk] = *(const f32x2*)(W + (size_t)(k0 + 16 * kq + kk) * 12288);
#pragma unroll
            for (int kk = 0; kk < 16; ++kk) {
#pragma unroll
                for (int s4 = 0; s4 < 9; ++s4) { const f32x4 sv = *(const LAS f32x4*)(scr + (16 * kq + kk) * 36 + 4 * s4);
#pragma unroll
                    for (int i = 0; i < 4; ++i) if (4 * s4 + i < 34) acc[4 * s4 + i] += wv[kk] * sv[i]; }
                asm volatile("" ::: "memory");
            }
        }
        asm volatile("s_waitcnt lgkmcnt(0)" ::: "memory");
    }
    for (int ww = 0; ww < 8; ++ww) {
        if (w == ww) {
#pragma unroll
            for (int s = 0; s < 34; ++s) { LAS f32x2* p = (LAS f32x2*)(sum + s * 128) + lane; if (ww == 0) *p = acc[s]; else *p = *p + acc[s]; }
        }
        __syncthreads();
    }
    float* mod = (float*)(C.ws + WS_MOD);
    for (int s = w; s < 34; s += 8) { const f32x2 v = *((LAS f32x2*)(sum + s * 128) + lane) + *(const f32x2*)(bias + 2 * lane);
        *(f32x2*)(mod + ((size_t)l * NSEQ + s) * 12288 + n0 + 2 * lane) = v; }
    __syncthreads();
}

namespace bq {
constexpr int I_IN = 32 * 96, I_GATE = 16 * 8, I_POOL = 4 * 32, I_OUTR = 32 * 64, I_Q = 32 * 64, I_KEYS = 256, I_TAB = 16384  , I_DQ = 32 * 16, I_DKV = 32 * 10,
              I_ROPE = 1024, I_UQ = 8 * 96, I_UKV = 4 * 128, I_OUTA = 32 * 64;
constexpr int E_IN = I_IN, E_GATE = E_IN + I_GATE, E_POOL = E_GATE + I_POOL, E_OUTR = E_POOL + I_OUTR, E_Q0 = E_OUTR + I_Q, E_KEYS = E_Q0 + I_KEYS, E_TAB0 = E_KEYS + I_TAB, E_DQ = E_TAB0 + I_DQ,
              E_DKV = E_DQ + I_DKV, E_ROPE = E_DKV + I_ROPE, E_UQ = E_ROPE + I_UQ, E_UKV = E_UQ + I_UKV, E_OUTA = E_UKV + I_OUTA, E_Q1 = E_OUTA + I_Q, E_TAB1 = E_Q1 + I_TAB, NTOT = E_TAB1;
static_assert(NTOT % 8 == 0 && E_IN % 8 == 0 && E_POOL % 8 == 0 && E_OUTR % 8 == 0 && E_Q0 % 8 == 0 && E_KEYS % 8 == 0 && E_TAB0 % 8 == 0 && E_DKV % 8 == 0 && E_ROPE % 8 == 0 && E_UKV % 8 == 0 && E_OUTA % 8 == 0 && E_Q1 % 8 == 0, "queue segments are whole workgroup items");
constexpr int CW_QHEAD = 64, CW_DONE = 128;
constexpr int LDS_SLOT = LDS_MISC + 32;
constexpr size_t TAB_L1 = 16 * MiB;

__device__ __forceinline__ void fp4_row_pair(const float* src, unsigned char* dst, float scale, int r0, int lane) {
    f32x4 a[16];
#pragma unroll
    for (int b = 0; b < 16; ++b) a[b] = *(const f32x4*)(src + (size_t)(r0 + (b >> 3)) * 2048 + 4 * lane + 256 * (b & 7)) * scale;
#pragma unroll
    for (int rr = 0; rr < 2; ++rr) { u32x4 w;
#pragma unroll
        for (int q = 0; q < 4; ++q) { float e[8] = {a[8 * rr + 2 * q][0], a[8 * rr + 2 * q][1], a[8 * rr + 2 * q][2], a[8 * rr + 2 * q][3], a[8 * rr + 2 * q + 1][0], a[8 * rr + 2 * q + 1][1], a[8 * rr + 2 * q + 1][2], a[8 * rr + 2 * q + 1][3]};
#pragma unroll
            for (int j = 0; j < 8; ++j) e[j] = fminf(fmaxf(e[j], -6.0f), 6.0f);
            unsigned t = 0u; t = __builtin_amdgcn_cvt_scalef32_pk_fp4_f32(t, e[0], e[1], 1.0f, 0); t = __builtin_amdgcn_cvt_scalef32_pk_fp4_f32(t, e[2], e[3], 1.0f, 1);
            t = __builtin_amdgcn_cvt_scalef32_pk_fp4_f32(t, e[4], e[5], 1.0f, 2); t = __builtin_amdgcn_cvt_scalef32_pk_fp4_f32(t, e[6], e[7], 1.0f, 3); w[q] = t; }
        *(u32x4*)(dst + (size_t)(r0 + rr) * 1024 + 16 * lane) = w; }
}
__device__ __forceinline__ void table_item(const Ctx& C, int layer, int r, int lane) {
    const int t = r >> 13, rp = r & 8191;
    const float* src = (t ? C.in[34] : C.in[33]) + (size_t)layer * 16384 * 2048; unsigned char* dst = C.ws + (t ? WS_V : WS_U) + (size_t)layer * TAB_L1;
    fp4_row_pair(src, dst, t ? V4_SCALE : U4_SCALE, 2 * rp, lane);
}
__device__ __forceinline__ void wave_item(const Ctx& C, int it, LAS float* scr, int lane) {
    bf16_t* w_in = (bf16_t*)(C.ws + WS_WIN); bf16_t* w_outr = (bf16_t*)(C.ws + WS_WOUTR); bf16_t* w_q = (bf16_t*)(C.ws + WS_WQ);
    bf16_t* w_dqkv = (bf16_t*)(C.ws + WS_WDQKV); bf16_t* w_uq = (bf16_t*)(C.ws + WS_WUQ); bf16_t* w_ukv = (bf16_t*)(C.ws + WS_WUKV);
    bf16_t* w_outa = (bf16_t*)(C.ws + WS_WOUTA); bf16_t* w_gate = (bf16_t*)(C.ws + WS_WGATE); bf16_t* w_pool = (bf16_t*)(C.ws + WS_WPOOL);
    int r = it;
    if (r < I_IN) { transpose_mat_item(C.in[13], 2048, 3072, w_in, 2048, 0, 0, r, scr, lane); return; } r -= I_IN;
    if (r < I_GATE) {
        const int q = r / 8, sub = r % 8, h = q >> 1, gsel = q & 1;
        const float* src = (gsel ? C.in[18] : C.in[16]) + (size_t)h * 128 * 128;
        transpose_mat_item(src, 128, 128, w_gate, 256, h * 256 + gsel * 128, (h & 1) * 128, sub, scr, lane); return; } r -= I_GATE;
    if (r < I_POOL) { const int gq = r / 32, sub = r % 32;
        transpose_mat_item(C.in[21] + (size_t)gq * 256 * 256, 256, 256, w_pool, 256, gq * 256, 0, sub, scr, lane); return; } r -= I_POOL;
    if (r < I_OUTR) { transpose_mat_item(C.in[23], 2048, 2048, w_outr, 2048, 0, 0, r, scr, lane); return; } r -= I_OUTR;
    if (r < I_Q) { transpose_mat_item(C.in[31], 2048, 2048, w_q, 2048, 0, 0, r, scr, lane); return; } r -= I_Q;
    if (r < I_KEYS) { convert_range(C.in[32] + (size_t)r * 2048, (bf16_t*)(C.ws + WS_KEYS) + (size_t)r * 2048, 256, (size_t)lane, 64); return; } r -= I_KEYS;
    if (r < I_TAB) { table_item(C, 0, r, lane); return; } r -= I_TAB;
    if (r < I_DQ) { transpose_mat_item(C.in[24], 2048, 512, w_dqkv, 2048, 0, 0, r, scr, lane); return; } r -= I_DQ;
    if (r < I_DKV) { transpose_mat_item(C.in[27], 2048, 320, w_dqkv, 2048, 512, 0, r, scr, lane); return; } r -= I_DKV;
    if (r < I_ROPE) {
        float* rope = (float*)(C.ws + WS_ROPE);
        for (int q = 0; q < 8; ++q) { const int i = r * 512 + q * 64 + lane, pos = i >> 5, j = i & 31;
            double inv = 1.0; for (int qq = 0; qq < j; ++qq) inv *= 0.7498942093324559;
            const double rev = (double)pos * inv * 0.15915494309189535; const float fr = (float)(rev - __builtin_floor(rev));
            rope[(size_t)pos * 64 + j] = __builtin_amdgcn_cosf(fr); rope[(size_t)pos * 64 + 32 + j] = __builtin_amdgcn_sinf(fr); }
        return; } r -= I_ROPE;
    if (r < I_UQ) {
        const int kb = r / 96, nb = r % 96, n0 = 32 * nb, h = n0 / 192, d = n0 % 192;
        const int drow = (d < 128) ? h * 128 + d : 2048 + (h >> 2) * 256 + ((d - 128) >> 5) * 128 + (h & 3) * 32;
        transpose_item(C.in[26], 3072, 64 * kb, n0, w_uq, 512, drow, 64 * kb, scr, lane); return; } r -= I_UQ;
    if (r < I_UKV) { transpose_mat_item(C.in[29], 256, 4096, w_ukv, 256, 0, 0, r, scr, lane); return; } r -= I_UKV;
    if (r < I_OUTA) { transpose_mat_item(C.in[30], 2048, 2048, w_outa, 2048, 0, 0, r, scr, lane); return; } r -= I_OUTA;
    if (r < I_Q) { transpose_mat_item(C.in[31] + (size_t)2048 * 2048, 2048, 2048, w_q + (size_t)2048 * 2048, 2048, 0, 0, r, scr, lane); return; } r -= I_Q;
    table_item(C, 1, r, lane);
}
__device__ __forceinline__ void service(const Ctx& C, bool fill, int slot, int limit, bool signal = true) {
    unsigned* ctl = (unsigned*)(C.ws + WS_CTL); unsigned* qhead = ctl + CW_QHEAD; unsigned* done = ctl + CW_DONE + slot;
    volatile LAS int* lslot = (volatile LAS int*)(C.lds + LDS_SLOT);
    LAS float* scr = (LAS float*)(C.lds + 72704 + C.wave * 8448);
    __syncthreads();
    if (fill && signal && C.tid == 0) __hip_atomic_fetch_add(done, 1u, __ATOMIC_RELAXED, __HIP_MEMORY_SCOPE_AGENT);
    const unsigned lim = fill ? (unsigned)(NTOT / 8) : (unsigned)(limit / 8);
    for (;;) {
        if (C.tid == 0) { int it = -1;
            const unsigned h = __hip_atomic_load(qhead, __ATOMIC_RELAXED, __HIP_MEMORY_SCOPE_AGENT);
            bool go = h < lim;
            if (go && fill) go = __hip_atomic_load(done, __ATOMIC_RELAXED, __HIP_MEMORY_SCOPE_AGENT) < (unsigned)C.G;
            if (go) { const unsigned t = __hip_atomic_fetch_add(qhead, 1u, __ATOMIC_RELAXED, __HIP_MEMORY_SCOPE_AGENT); if (t < (unsigned)(NTOT / 8)) it = (int)t; }
            *lslot = it; }
        __syncthreads();
        const int it = *lslot;
        __syncthreads();
        if (it < 0) break;
        { Ctx D = C; int ln = C.lane; asm volatile("" : "+v"(ln)); D.lane = ln;
          wave_item(D, it * 8 + C.wave, scr, ln); }
    }
}
}

__device__ __forceinline__ void phase_prologue(const Ctx& C) {
    const int lane = C.lane;
    constexpr int NADA = 192;
    for (int it = C.vcu; it < NADA; it += C.G) ada_item(C, it);
    bq::service(C, true, 0, 0);
    const size_t gt = (size_t)C.vcu * 512 + C.tid, GT = (size_t)C.G * 512;
    { float* sp = (float*)(C.ws + WS_SP);
      for (size_t i = gt; i < 1024; i += GT) { sp[i] = C.in[17][i]; sp[1024 + i] = C.in[19][i]; const float y = fexp(-C.in[20][i]); sp[2048 + i] = (y < 0.03f) ? y * (1.0f - y * (0.5f - y * (0.33333333f - y * (0.25f - 0.2f * y)))) : 0.6931471805599453f * __builtin_amdgcn_logf(1.0f + y); } }
}
__device__ __forceinline__ void norm_mod_row(const float* xrow, const float* g, const float* shift, const float* scale, bf16_t* orow, int lane) {
    f32x4 v[8]; float ss = 0.f;
#pragma unroll
    for (int j = 0; j < 8; ++j) { v[j] = *((const f32x4*)xrow + lane + 64 * j); ss += (v[j].x * v[j].x + v[j].y * v[j].y) + (v[j].z * v[j].z + v[j].w * v[j].w); }
    const float rstd = __builtin_amdgcn_rsqf(wave_sum(ss) * (1.0f / DM) + RMS_EPS);
#pragma unroll
    for (int j = 0; j < 8; ++j) { const int q = lane + 64 * j; const f32x4 gv = *((const f32x4*)g + q), sc = *((const f32x4*)scale + q), sh = *((const f32x4*)shift + q);
        const f32x4 y = v[j] * rstd * gv * (sc + 1.0f) + sh;
        u32x2 w; w.x = cvt_pk_bf16(y.x, y.y); w.y = cvt_pk_bf16(y.z, y.w); *((u32x2*)orow + q) = w; }
}
__device__ __forceinline__ void phase_norm(const Ctx& C, const float* xP, const float* xS, const float* g, const float* modl, int part, bf16_t* hn) {
    const int lane = C.lane; int m = C.gw; if (m >= MT) return;
    f32x4 gv[8];
#pragma unroll
    for (int j = 0; j < 8; ++j) gv[j] = *((const f32x4*)g + lane + 64 * j);
    f32x4 nv[8];
    { const float* xr = (m < MP) ? xP + (size_t)m * DM : xS + (size_t)(m - MP) * DM;
#pragma unroll
      for (int j = 0; j < 8; ++j) nv[j] = *((const f32x4*)xr + lane + 64 * j); }
    for (; m < MT; m += C.NGW) {
        f32x4 v[8];
#pragma unroll
        for (int j = 0; j < 8; ++j) v[j] = nv[j];
        const int mn = m + C.NGW;
        if (mn < MT) { const float* xr = (mn < MP) ? xP + (size_t)mn * DM : xS + (size_t)(mn - MP) * DM;
#pragma unroll
            for (int j = 0; j < 8; ++j) nv[j] = *((const f32x4*)xr + lane + 64 * j); }
        const float* mp = modl + (size_t)seq_of_row(m) * 12288 + part * 2048;
        f32x4 sc[8], sh[8];
#pragma unroll
        for (int j = 0; j < 8; ++j) { const int q = lane + 64 * j; sh[j] = *((const f32x4*)mp + q); sc[j] = *((const f32x4*)(mp + 2048) + q); }
        float ss = 0.f;
#pragma unroll
        for (int j = 0; j < 8; ++j) ss += (v[j].x * v[j].x + v[j].y * v[j].y) + (v[j].z * v[j].z + v[j].w * v[j].w);
        const float rstd = __builtin_amdgcn_rsqf(wave_sum(ss) * (1.0f / DM) + RMS_EPS);
#pragma unroll
        for (int j = 0; j < 8; ++j) { const int q = lane + 64 * j; const f32x4 y = v[j] * rstd * gv[j] * (sc[j] + 1.0f) + sh[j];
            u32x2 w; w.x = cvt_pk_bf16(y.x, y.y); w.y = cvt_pk_bf16(y.z, y.w); *((u32x2*)(hn + (size_t)m * DM) + q) = w; }
    }
}
__device__ __forceinline__ void phase_resid_norm(const Ctx& C, const float* xP, const float* xS, const bf16_t* mix, float* X, const float* g, const float* modl, bf16_t* hn) {
    const int lane = C.lane; int m = C.gw; if (m >= MT) return;
    f32x4 gv[8];
#pragma unroll
    for (int j = 0; j < 8; ++j) gv[j] = *((const f32x4*)g + lane + 64 * j);
    f32x4 nx[8]; u32x2 nm[8];
    { const float* xr = (m < MP) ? xP + (size_t)m * DM : xS + (size_t)(m - MP) * DM;
#pragma unroll
      for (int j = 0; j < 8; ++j) { const int q = lane + 64 * j; nx[j] = *((const f32x4*)xr + q); nm[j] = *((const u32x2*)(mix + (size_t)m * DM) + q); } }
    for (; m < MT; m += C.NGW) {
        f32x4 v[8]; u32x2 mw[8];
#pragma unroll
        for (int j = 0; j < 8; ++j) { v[j] = nx[j]; mw[j] = nm[j]; }
        const int mn = m + C.NGW;
        if (mn < MT) { const float* xr = (mn < MP) ? xP + (size_t)mn * DM : xS + (size_t)(mn - MP) * DM;
#pragma unroll
            for (int j = 0; j < 8; ++j) { const int q = lane + 64 * j; nx[j] = *((const f32x4*)xr + q); nm[j] = *((const u32x2*)(mix + (size_t)mn * DM) + q); } }
        const float* mp = modl + (size_t)seq_of_row(m) * 12288;
        float ss = 0.f;
#pragma unroll
        for (int j = 0; j < 8; ++j) { const int q = lane + 64 * j; const f32x4 g1 = *((const f32x4*)(mp + 2 * 2048) + q);
            v[j] = v[j] + g1 * (f32x4){bf_lo(mw[j].x), bf_hi(mw[j].x), bf_lo(mw[j].y), bf_hi(mw[j].y)}; ss += (v[j].x * v[j].x + v[j].y * v[j].y) + (v[j].z * v[j].z + v[j].w * v[j].w);
            *((f32x4*)(X + (size_t)m * DM) + q) = v[j]; }
        const float rstd = __builtin_amdgcn_rsqf(wave_sum(ss) * (1.0f / DM) + RMS_EPS);
#pragma unroll
        for (int j = 0; j < 8; ++j) { const int q = lane + 64 * j; const f32x4 sh = *((const f32x4*)(mp + 3 * 2048) + q), sc = *((const f32x4*)(mp + 4 * 2048) + q);
            const f32x4 y = v[j] * rstd * gv[j] * (sc + 1.0f) + sh;
            u32x2 w; w.x = cvt_pk_bf16(y.x, y.y); w.y = cvt_pk_bf16(y.z, y.w); *((u32x2*)(hn + (size_t)m * DM) + q) = w; }
    }
}

__device__ __forceinline__ void ld8bf(const bf16_t* p, float (&v)[8]) { const u32x4 w = *(const u32x4*)p; v[0] = bf_lo(w.x); v[1] = bf_hi(w.x); v[2] = bf_lo(w.y); v[3] = bf_hi(w.y); v[4] = bf_lo(w.z); v[5] = bf_hi(w.z); v[6] = bf_lo(w.w); v[7] = bf_hi(w.w); }
__device__ __forceinline__ void ld8f(const float* p, float (&v)[8]) { const f32x4 a = *(const f32x4*)p, b = *(const f32x4*)(p + 4); v[0] = a.x; v[1] = a.y; v[2] = a.z; v[3] = a.w; v[4] = b.x; v[5] = b.y; v[6] = b.z; v[7] = b.w; }
__device__ __forceinline__ void st8bf(bf16_t* p, const float (&v)[8]) { u32x4 w; w.x = cvt_pk_bf16(v[0], v[1]); w.y = cvt_pk_bf16(v[2], v[3]); w.z = cvt_pk_bf16(v[4], v[5]); w.w = cvt_pk_bf16(v[6], v[7]); *(u32x4*)p = w; }
__device__ __forceinline__ void st8f(float* p, const float (&v)[8]) { *(f32x4*)p = (f32x4){v[0], v[1], v[2], v[3]}; *(f32x4*)(p + 4) = (f32x4){v[4], v[5], v[6], v[7]}; }

__device__ __forceinline__ void phase_convpool(const Ctx& C) {
    const bf16_t* __restrict__ REC = (const bf16_t*)(C.ws + A_B2); const bf16_t* __restrict__ PIN = REC + (size_t)MT * 1024;
    bf16_t* __restrict__ XC = (bf16_t*)(C.ws + A_B3); bf16_t* __restrict__ POOLED = XC + (size_t)MT * 1024;
    const float* convw = C.in[14]; const float* convb = C.in[15]; const float* st_conv = C.in[4]; const float* st_pool = C.in[6];
    const int NITEM = 2 * 544 * 128;
    for (int it0 = C.vcu * 512 + C.tid; it0 < NITEM; it0 += C.G * 512) {
        const bool is_pool = it0 >= 544 * 128; const int it = is_pool ? it0 - 544 * 128 : it0;
        const int chunk = it >> 7, ch0 = (it & 127) * 8;
        const bool samp = chunk >= 512; const int sb = chunk - 512;
        const int row0 = samp ? MP + sb * 64 : chunk * 64;
        const int t0 = samp ? 0 : (chunk & 255) * 64;
        const bool lastc = samp || ((chunk & 255) == 255);
        if (!is_pool) {
            float w0[8], w1[8], w2[8], w3[8], bb[8], p0[8], p1[8], p2[8];
            ld8f(convw + ch0, w0); ld8f(convw + 1024 + ch0, w1); ld8f(convw + 2048 + ch0, w2); ld8f(convw + 3072 + ch0, w3); ld8f(convb + ch0, bb);
            if (samp) { ld8f(st_conv + ((size_t)sb * 3 + 0) * 1024 + ch0, p0); ld8f(st_conv + ((size_t)sb * 3 + 1) * 1024 + ch0, p1); ld8f(st_conv + ((size_t)sb * 3 + 2) * 1024 + ch0, p2); }
            else if (t0 > 0) { ld8bf(REC + (size_t)(row0 - 3) * 1024 + ch0, p0); ld8bf(REC + (size_t)(row0 - 2) * 1024 + ch0, p1); ld8bf(REC + (size_t)(row0 - 1) * 1024 + ch0, p2); }
            else {
#pragma unroll
                for (int j = 0; j < 8; ++j) { p0[j] = 0.f; p1[j] = 0.f; p2[j] = 0.f; } }
            for (int tb = 0; tb < 64; tb += 8) {
                u32x4 raw[8];
#pragma unroll
                for (int q = 0; q < 8; ++q) raw[q] = *(const u32x4*)(REC + (size_t)(row0 + tb + q) * 1024 + ch0);
#pragma unroll
                for (int q = 0; q < 8; ++q) { const u32x4 w = raw[q]; const float cur[8] = {bf_lo(w.x), bf_hi(w.x), bf_lo(w.y), bf_hi(w.y), bf_lo(w.z), bf_hi(w.z), bf_lo(w.w), bf_hi(w.w)}; float o[8];
#pragma unroll
                    for (int j = 0; j < 8; ++j) { o[j] = bb[j] + w0[j] * p0[j] + w1[j] * p1[j] + w2[j] * p2[j] + w3[j] * cur[j]; p0[j] = p1[j]; p1[j] = p2[j]; p2[j] = cur[j]; }
                    st8bf(XC + (size_t)(row0 + tb + q) * 1024 + ch0, o); } }
            if (lastc) { float* dst = samp ? C.out + O_CONV_S + (size_t)sb * 3 * 1024 : C.out + O_CONV_P + (size_t)(chunk >> 8) * 3 * 1024;
                st8f(dst + ch0, p0); st8f(dst + 1024 + ch0, p1); st8f(dst + 2048 + ch0, p2); }
        } else {
            const int gsel = ch0 >> 8, w = 2 << gsel;
            float S[8];
#pragma unroll
            for (int j = 0; j < 8; ++j) S[j] = 0.f;
            for (int tt = 1 - w; tt < 0; ++tt) { float v[8];
                if (samp) ld8f(st_pool + ((size_t)sb * 15 + 15 + tt) * 1024 + ch0, v);
                else if (t0 + tt >= 0) ld8bf(PIN + (size_t)(row0 + tt) * 1024 + ch0, v);
                else {
#pragma unroll
                    for (int j = 0; j < 8; ++j) v[j] = 0.f; }
#pragma unroll
                for (int j = 0; j < 8; ++j) S[j] += v[j]; }
            for (int tb = 0; tb < 64; tb += 8) {
                u32x4 rawc[8]; float oldv[8][8];
#pragma unroll
                for (int q = 0; q < 8; ++q) rawc[q] = *(const u32x4*)(PIN + (size_t)(row0 + tb + q) * 1024 + ch0);
#pragma unroll
                for (int q = 0; q < 8; ++q) { const int tt = tb + q - w + 1;
                    if (tt >= 0 || (!samp && t0 + tt >= 0)) ld8bf(PIN + (size_t)(row0 + tt) * 1024 + ch0, oldv[q]);
                    else if (samp) ld8f(st_pool + ((size_t)sb * 15 + 15 + tt) * 1024 + ch0, oldv[q]);
                    else {
#pragma unroll
                        for (int j = 0; j < 8; ++j) oldv[q][j] = 0.f; } }
#pragma unroll
                for (int q = 0; q < 8; ++q) { const u32x4 wv = rawc[q]; const float cur[8] = {bf_lo(wv.x), bf_hi(wv.x), bf_lo(wv.y), bf_hi(wv.y), bf_lo(wv.z), bf_hi(wv.z), bf_lo(wv.w), bf_hi(wv.w)}; float o[8];
                    const int pos = samp ? 1024 + tb + q : t0 + tb + q; const float rc = 1.0f / (float)((pos + 1 < w) ? pos + 1 : w);
#pragma unroll
                    for (int j = 0; j < 8; ++j) { S[j] += cur[j]; o[j] = S[j] * rc - cur[j]; S[j] -= oldv[q][j]; }
                    st8bf(POOLED + (size_t)(row0 + tb + q) * 1024 + ch0, o); } }
            if (lastc) { float* dst = samp ? C.out + O_POOL_S + (size_t)sb * 15 * 1024 : C.out + O_POOL_P + (size_t)(chunk >> 8) * 15 * 1024;
                for (int i = 0; i < 15; ++i) { float v[8]; ld8bf(PIN + (size_t)(row0 + 49 + i) * 1024 + ch0, v); st8f(dst + (size_t)i * 1024 + ch0, v); } }
        }
    }
}

__device__ __forceinline__ void phase_scanA(const Ctx& C) {
    const float* __restrict__ A = (const float*)(C.ws + A_B4); const bf16_t* __restrict__ U = (const bf16_t*)(A + (size_t)MT * 1024);
    float* __restrict__ cP = (float*)(C.ws + WS_SCAN); float* __restrict__ cH = cP + SCAN_WORDS;
    for (int it = C.vcu * 512 + C.tid; it < 544 * 256; it += C.G * 512) {
        const int chunk = it >> 8, ch = (it & 255) * 4; const int row0 = chunk * 64;
        f32x4 P = {1.f, 1.f, 1.f, 1.f}, H = {0.f, 0.f, 0.f, 0.f};
        for (int tb = 0; tb < 64; tb += 8) { f32x4 av[8], uv[8];
#pragma unroll
            for (int q = 0; q < 8; ++q) { av[q] = *(const f32x4*)(A + (size_t)(row0 + tb + q) * 1024 + ch); const u32x2 uw = *(const u32x2*)(U + (size_t)(row0 + tb + q) * 1024 + ch); uv[q] = (f32x4){bf_lo(uw.x), bf_hi(uw.x), bf_lo(uw.y), bf_hi(uw.y)}; }
#pragma unroll
            for (int q = 0; q < 8; ++q) { H = av[q] * H + uv[q]; P = P * av[q]; } }
        *(f32x4*)(cP + (size_t)chunk * 1024 + ch) = P; *(f32x4*)(cH + (size_t)chunk * 1024 + ch) = H;
    }
}
__device__ __forceinline__ void phase_scanB(const Ctx& C) {
    const float* __restrict__ cP = (const float*)(C.ws + WS_SCAN); const float* __restrict__ cH = cP + SCAN_WORDS; float* __restrict__ cI = (float*)(C.ws + WS_SCAN) + 2 * SCAN_WORDS;
    const int it = C.vcu * 512 + C.tid;
    if (it < 2048) { const int s = it >> 10, ch = it & 1023; float carry = 0.f;
        for (int cb = 0; cb < 256; cb += 16) { float pv[16], hv[16];
#pragma unroll
            for (int q = 0; q < 16; ++q) { const size_t o = (size_t)(s * 256 + cb + q) * 1024 + ch; pv[q] = cP[o]; hv[q] = cH[o]; }
#pragma unroll
            for (int q = 0; q < 16; ++q) { cI[(size_t)(s * 256 + cb + q) * 1024 + ch] = carry; carry = pv[q] * carry + hv[q]; } } }
}
__device__ __forceinline__ void phase_scanC(const Ctx& C) {
    const float* __restrict__ A = (const float*)(C.ws + A_B4); const bf16_t* __restrict__ U = (const bf16_t*)(A + (size_t)MT * 1024); const float* __restrict__ cI = (const float*)(C.ws + WS_SCAN) + 2 * SCAN_WORDS;
    const bf16_t* __restrict__ GG = (const bf16_t*)(C.ws + A_GG); bf16_t* __restrict__ CAT = (bf16_t*)(C.ws + A_HN); const float* hprev = C.in[5];
    for (int it = C.vcu * 512 + C.tid; it < 544 * 256; it += C.G * 512) {
        const int chunk = it >> 8, ch = (it & 255) * 4; const int row0 = chunk * 64; const bool samp = chunk >= 512;
        f32x4 h = samp ? *(const f32x4*)(hprev + (size_t)(chunk - 512) * 1024 + ch) : *(const f32x4*)(cI + (size_t)chunk * 1024 + ch);
        for (int tb = 0; tb < 64; tb += 8) { f32x4 av[8], uv[8]; u32x2 gv[8];
#pragma unroll
            for (int q = 0; q < 8; ++q) { const size_t o = (size_t)(row0 + tb + q) * 1024 + ch; av[q] = *(const f32x4*)(A + o); { const u32x2 uw = *(const u32x2*)(U + o); uv[q] = (f32x4){bf_lo(uw.x), bf_hi(uw.x), bf_lo(uw.y), bf_hi(uw.y)}; } gv[q] = *(const u32x2*)(GG + o); }
#pragma unroll
            for (int q = 0; q < 8; ++q) { h = av[q] * h + uv[q];
                u32x2 w; w.x = cvt_pk_bf16(bf_lo(gv[q].x) * h.x, bf_hi(gv[q].x) * h.y); w.y = cvt_pk_bf16(bf_lo(gv[q].y) * h.z, bf_hi(gv[q].y) * h.w);
                *(u32x2*)(CAT + (size_t)(row0 + tb + q) * 2048 + ch) = w; } }
        if (samp) *(f32x4*)(C.out + O_H_S + (size_t)(chunk - 512) * 1024 + ch) = h;
        else if ((chunk & 255) == 255) *(f32x4*)(C.out + O_H_P + (size_t)(chunk >> 8) * 1024 + ch) = h;
    }
}

__device__ __forceinline__ void phase_latent(const Ctx& C) {
    const float* CQKV = (const float*)(C.ws + A_B3); bf16_t* CQ = (bf16_t*)(C.ws + A_CQ); bf16_t* CKV = (bf16_t*)(C.ws + A_CKV); unsigned char* KP = C.ws + A_KP;
    const float* gq = C.in[25]; const float* gkv = C.in[28]; const float* rope = (const float*)(C.ws + WS_ROPE); const int lane = C.lane;
    for (int m = C.gw; m < MT; m += C.NGW) {
        const float* r = CQKV + (size_t)m * 1024; const int kvr = kvrow_of_row(m);
        { float v[8]; ld8f(r + lane * 8, v); float ss = 0.f;
#pragma unroll
          for (int j = 0; j < 8; ++j) ss += v[j] * v[j];
          const float rstd = __builtin_amdgcn_rsqf(wave_sum(ss) * (1.0f / 512) + RMS_EPS); float g[8]; ld8f(gq + lane * 8, g);
#pragma unroll
          for (int j = 0; j < 8; ++j) v[j] = v[j] * rstd * g[j];
          st8bf(CQ + (size_t)m * 512 + lane * 8, v); }
        { const f32x4 v = *(const f32x4*)(r + 512 + lane * 4); const float ss = (v.x * v.x + v.y * v.y) + (v.z * v.z + v.w * v.w);
          const float rstd = __builtin_amdgcn_rsqf(wave_sum(ss) * (1.0f / 256) + RMS_EPS); const f32x4 y = v * rstd * *(const f32x4*)(gkv + lane * 4);
          *(f32x4*)(C.out + O_CKV + (size_t)m * 256 + lane * 4) = y;
          u32x2 w; w.x = cvt_pk_bf16(y.x, y.y); w.y = cvt_pk_bf16(y.z, y.w); *(u32x2*)(CKV + (size_t)kvr * 256 + lane * 4) = w; }
        { const float x = r[768 + lane]; const float xo = __shfl_xor(x, 32); const int j = lane & 31; const float* rp = rope + (size_t)pos_of_row(m) * 64;
          const float c = rp[j], s = rp[32 + j]; const float y = (lane < 32) ? x * c - xo * s : xo * s + x * c;
          C.out[O_KPE + (size_t)m * 64 + lane] = y; KP[(size_t)kvr * 64 + lane] = (unsigned char)(cvt4_fp8(y, 0.f, 0.f, 0.f) & 0xffu); }
    }
    const size_t gt = (size_t)C.vcu * 512 + C.tid, GT = (size_t)C.G * 512;
    for (size_t i = gt; i < (size_t)32 * 1024 * 256 / 8; i += GT) { const size_t e = i * 8, rowc = e / 256, col = e % 256, b = rowc / 1024, p = rowc % 1024;
        float v[8]; ld8f(C.in[7] + e, v); st8bf(CKV + ((size_t)MP + b * 1088 + p) * 256 + col, v); }
    for (size_t i = gt; i < (size_t)32 * 1024 * 64 / 8; i += GT) { const size_t e = i * 8, rowc = e / 64, col = e % 64, b = rowc / 1024, p = rowc % 1024;
        float v[8]; ld8f(C.in[8] + e, v); u32x2 w8; w8.x = cvt4_fp8(v[0], v[1], v[2], v[3]); w8.y = cvt4_fp8(v[4], v[5], v[6], v[7]); *(u32x2*)(KP + ((size_t)MP + b * 1088 + p) * 64 + col) = w8; }
}
typedef __bf16 bf2_t __attribute__((ext_vector_type(2)));
__device__ __forceinline__ unsigned ford(float f) { const unsigned u = __float_as_uint(f); return (u & 0x80000000u) ? ~u : (u | 0x80000000u); }
__device__ __forceinline__ float funord(unsigned o) { return __uint_as_float((o & 0x80000000u) ? (o & 0x7fffffffu) : ~o); }
__device__ __forceinline__ unsigned umax(unsigned a, unsigned b) { return a > b ? a : b; }
__device__ __forceinline__ unsigned umin(unsigned a, unsigned b) { return a < b ? a : b; }
__device__ __forceinline__ void ins16(unsigned (&L)[16], unsigned x) {
#pragma unroll
    for (int i = 0; i < 16; ++i) { const unsigned t = umax(L[i], x); x = umin(L[i], x); L[i] = t; }
}
__device__ __forceinline__ void ins16p(unsigned (&K)[16], unsigned (&P)[16], unsigned key, unsigned pay) {
#pragma unroll
    for (int i = 0; i < 16; ++i) { const bool c = key > K[i]; const unsigned tk = c ? key : K[i], nk = c ? K[i] : key, tp = c ? pay : P[i], np = c ? P[i] : pay; K[i] = tk; P[i] = tp; key = nk; pay = np; }
}
__device__ __forceinline__ void sort16_desc(unsigned (&v)[16]) {
#pragma unroll
    for (int k = 2; k <= 16; k <<= 1)
#pragma unroll
        for (int j = k >> 1; j >= 1; j >>= 1)
#pragma unroll
            for (int i = 0; i < 16; ++i) { const int l = i ^ j; if (l > i) { const bool desc = ((i & k) == 0); const unsigned a = v[i], b = v[l], hi = umax(a, b), lo = umin(a, b); v[i] = desc ? hi : lo; v[l] = desc ? lo : hi; } }
}
__device__ __forceinline__ void merge16_desc(unsigned (&A)[16], const unsigned (&B)[16]) {
#pragma unroll
    for (int i = 0; i < 16; ++i) A[i] = umax(A[i], B[15 - i]);
#pragma unroll
    for (int st = 8; st >= 1; st >>= 1)
#pragma unroll
        for (int i = 0; i < 16; ++i) if ((i & st) == 0) { const unsigned a = A[i], b = A[i + st]; A[i] = umax(a, b); A[i + st] = umin(a, b); }
}
__device__ __forceinline__ void subkey_top16(const bf16_t* qrow  , const bf16_t* krow  , int hh, unsigned (&S)[16]) {
    bf16x8 qf[8];
#pragma unroll
    for (int s = 0; s < 8; ++s) qf[s] = *(const bf16x8*)(qrow + 16 * s);
    unsigned L[16];
#pragma unroll
    for (int i = 0; i < 16; ++i) L[i] = 0u;
#pragma unroll 1
    for (int kb = 0; kb < 4; ++kb) {
        bf16x8 kf[8];
#pragma unroll
        for (int s = 0; s < 8; ++s) kf[s] = *(const bf16x8*)(krow + (size_t)kb * 32 * 128 + 16 * s);
        f32x16 a = {0.f, 0.f, 0.f, 0.f, 0.f, 0.f, 0.f, 0.f, 0.f, 0.f, 0.f, 0.f, 0.f, 0.f, 0.f, 0.f};
#pragma unroll
        for (int s = 0; s < 8; ++s) a = __builtin_amdgcn_mfma_f32_32x32x16_bf16(kf[s], qf[s], a, 0, 0, 0);
        unsigned N[16];
#pragma unroll
        for (int r = 0; r < 16; ++r) { const unsigned idx = (unsigned)(32 * kb + (r & 3) + 8 * (r >> 2) + 4 * hh); N[r] = (ford(a[r]) & ~0x7fu) | idx; }
        sort16_desc(N); merge16_desc(L, N);
        asm volatile("" ::: "memory");
    }
    unsigned P[16];
#pragma unroll
    for (int i = 0; i < 16; ++i) P[i] = (unsigned)__shfl_xor((int)L[i], 32);
#pragma unroll
    for (int i = 0; i < 16; ++i) S[i] = L[i];
    merge16_desc(S, P);
}
__device__ __forceinline__ void phase_topk(const Ctx& C, int layer) {
    const bf16_t* Q = (const bf16_t*)(C.ws + A_B3); const bf16_t* KEYS = (const bf16_t*)(C.ws + WS_KEYS) + (size_t)layer * 8 * 2 * 128 * 128;
    int* IDX = (int*)(C.ws + A_B4); float* GATE = (float*)(C.ws + A_B4) + (size_t)MT * 128;
    const int lane = C.lane, r = lane & 31, hh = lane >> 5;
    for (int task = C.gw; task < (MT / 32) * 8; task += C.NGW) {
        const int tg = task >> 3, h = task & 7, m = tg * 32 + r;
        unsigned S1[16], S2[16];
        subkey_top16(Q + (size_t)m * 2048 + h * 256 + 8 * hh, KEYS + ((size_t)(h * 2 + 0) * 128 + r) * 128 + 8 * hh, hh, S1);
        subkey_top16(Q + (size_t)m * 2048 + h * 256 + 128 + 8 * hh, KEYS + ((size_t)(h * 2 + 1) * 128 + r) * 128 + 8 * hh, hh, S2);
#define CKEY(a, b) ((ford(funord(S1[a] & ~0x7fu) + funord(S2[b] & ~0x7fu)) & ~0xffu) | (unsigned)((a) << 4 | (b)))
        unsigned FK[16], G[16];
#pragma unroll
        for (int b = 0; b < 16; ++b) FK[b] = CKEY(0, b);
#pragma unroll
        for (int b = 0; b < 8; ++b) G[b] = CKEY(1, b);
#pragma unroll
        for (int b = 0; b < 5; ++b) G[8 + b] = CKEY(2, b);
#pragma unroll
        for (int b = 0; b < 3; ++b) G[13 + b] = CKEY(4, b);
        sort16_desc(G); merge16_desc(FK, G);
#pragma unroll
        for (int b = 0; b < 4; ++b) G[b] = CKEY(3, b);
#pragma unroll
        for (int b = 0; b < 2; ++b) { G[4 + b] = CKEY(5, b); G[6 + b] = CKEY(6, b); G[8 + b] = CKEY(7, b); }
#pragma unroll
        for (int a = 8; a < 14; ++a) G[2 + a] = CKEY(a, 0);
        sort16_desc(G); merge16_desc(FK, G);
        ins16(FK, CKEY(14, 0)); ins16(FK, CKEY(15, 0));
#undef CKEY
        unsigned I1p[4], I2p[4];
#pragma unroll
        for (int w = 0; w < 4; ++w) { I1p[w] = (S1[4 * w] & 0x7fu) | ((S1[4 * w + 1] & 0x7fu) << 8) | ((S1[4 * w + 2] & 0x7fu) << 16) | ((S1[4 * w + 3] & 0x7fu) << 24);
                                      I2p[w] = (S2[4 * w] & 0x7fu) | ((S2[4 * w + 1] & 0x7fu) << 8) | ((S2[4 * w + 2] & 0x7fu) << 16) | ((S2[4 * w + 3] & 0x7fu) << 24); }
        const float mx = funord(FK[0] & ~0xffu); float sum = 0.f;
#pragma unroll
        for (int i = 0; i < 16; ++i) sum += fexp(funord(FK[i] & ~0xffu) - mx);
        const float rs = 1.0f / sum;
        int oi[8]; float og[8];
#pragma unroll
        for (int i = 0; i < 8; ++i) { const unsigned key = hh ? FK[8 + i] : FK[i]; const unsigned a = (key >> 4) & 15u, b = key & 15u;
            const unsigned w1 = (a >> 2) == 0u ? I1p[0] : ((a >> 2) == 1u ? I1p[1] : ((a >> 2) == 2u ? I1p[2] : I1p[3]));
            const unsigned w2 = (b >> 2) == 0u ? I2p[0] : ((b >> 2) == 1u ? I2p[1] : ((b >> 2) == 2u ? I2p[2] : I2p[3]));
            oi[i] = (int)((((w1 >> ((a & 3u) * 8u)) & 0x7fu) << 7) | ((w2 >> ((b & 3u) * 8u)) & 0x7fu));
            og[i] = fexp(funord(key & ~0xffu) - mx) * rs; }
        const size_t o = (size_t)m * 128 + h * 16 + 8 * hh;
        *(u32x4*)(IDX + o) = (u32x4){(unsigned)oi[0], (unsigned)oi[1], (unsigned)oi[2], (unsigned)oi[3]}; *(u32x4*)(IDX + o + 4) = (u32x4){(unsigned)oi[4], (unsigned)oi[5], (unsigned)oi[6], (unsigned)oi[7]};
        *(f32x4*)(GATE + o) = (f32x4){og[0], og[1], og[2], og[3]}; *(f32x4*)(GATE + o + 4) = (f32x4){og[4], og[5], og[6], og[7]};
    }
}

template <int CTRL, int ROWMASK> __device__ __forceinline__ float dppf(float v) { return __builtin_bit_cast(float, __builtin_amdgcn_update_dpp(0, __builtin_bit_cast(int, v), CTRL, ROWMASK, 0xF, false)); }
__device__ __forceinline__ float wave_sum_u(float v) {
    v += dppf<0xB1, 0xF>(v); v += dppf<0x4E, 0xF>(v); v += dppf<0x141, 0xF>(v); v += dppf<0x140, 0xF>(v);
    v += dppf<0x142, 0xA>(v); v += dppf<0x143, 0xC>(v);
    return __builtin_bit_cast(float, __builtin_amdgcn_readlane(__builtin_bit_cast(int, v), 63));
}
struct RowSet4 { u32x4 u, v; };
__device__ __forceinline__ void load_rows4(RowSet4& R, const unsigned char* U4, const unsigned char* V4, int eid, int lane) {
    const size_t o = (size_t)eid * 1024 + lane * 16; R.u = *(const u32x4*)(U4 + o); R.v = *(const u32x4*)(V4 + o);
}
__device__ __forceinline__ void use_rows4(const u32x4 Ru, const u32x4 Rv, const float (&xf)[32], float gate, float (&out)[32]) {
    float d0 = 0.f, d1 = 0.f;
#define U4_STEP(w, b) { const f32x2 t = __builtin_amdgcn_cvt_scalef32_pk_f32_fp4(Ru[w], 1.0f, b); d0 = fmaf(xf[8 * (w) + 2 * (b)], t.x, d0); d1 = fmaf(xf[8 * (w) + 2 * (b) + 1], t.y, d1); }
#define U4_WORD(w) U4_STEP(w, 0) U4_STEP(w, 1) U4_STEP(w, 2) U4_STEP(w, 3)
    U4_WORD(0) U4_WORD(1) U4_WORD(2) U4_WORD(3)
#undef U4_WORD
#undef U4_STEP
    const float d = wave_sum_u(d0 + d1) * (1.0f / U4_SCALE);
    const float a = gelu_erf(d) * gate * (1.0f / V4_SCALE);
#define V4_STEP(w, b) { const f32x2 t = __builtin_amdgcn_cvt_scalef32_pk_f32_fp4(Rv[w], 1.0f, b); out[8 * (w) + 2 * (b)] = fmaf(a, t.x, out[8 * (w) + 2 * (b)]); out[8 * (w) + 2 * (b) + 1] = fmaf(a, t.y, out[8 * (w) + 2 * (b) + 1]); }
#define V4_WORD(w) V4_STEP(w, 0) V4_STEP(w, 1) V4_STEP(w, 2) V4_STEP(w, 3)
    V4_WORD(0) V4_WORD(1) V4_WORD(2) V4_WORD(3)
#undef V4_WORD
#undef V4_STEP
}
typedef _Float16 h16x2 __attribute__((ext_vector_type(2)));
__device__ __forceinline__ float dot_row4(const u32x4 Ru, const h16x2 (&xh)[16]) {
    float d0 = 0.f, d1 = 0.f;
#define U4_STEP(w, b, D) { const h16x2 t = __builtin_amdgcn_cvt_scalef32_pk_f16_fp4(Ru[w], 1.0f, b); D = __builtin_amdgcn_fdot2(xh[4 * (w) + (b)], t, D, false); }
#define U4_WORD(w) U4_STEP(w, 0, d0) U4_STEP(w, 1, d1) U4_STEP(w, 2, d0) U4_STEP(w, 3, d1)
    U4_WORD(0) U4_WORD(1) U4_WORD(2) U4_WORD(3)
#undef U4_WORD
#undef U4_STEP
    return wave_sum_u(d0 + d1);
}
typedef int i32x8 __attribute__((ext_vector_type(8)));
__device__ __forceinline__ float dot_row4_mfma(const u32x4 Ru, const i32x8& xhi, const i32x8& xlo, int dsel, bool dval) {
    const i32x8 a = {(int)Ru.x, (int)Ru.y, (int)Ru.z, (int)Ru.w, 0, 0, 0, 0};
    f32x4 d = {0.f, 0.f, 0.f, 0.f};
    d = __builtin_amdgcn_mfma_scale_f32_16x16x128_f8f6f4(a, xhi, d, 4, 0, 0, 127, 0, 127);
    d = __builtin_amdgcn_mfma_scale_f32_16x16x128_f8f6f4(a, xlo, d, 4, 0, 0, 127, 0, 123);
    float v = dsel == 0 ? d[0] : (dsel == 1 ? d[1] : (dsel == 2 ? d[2] : d[3]));
    v = dval ? v : 0.f;
    return wave_sum_u(v);
}
__device__ __forceinline__ void axpy_row4(const u32x4 Rv, float a, float (&out)[32]) {
#define V4_STEP(w, b) { const f32x2 t = __builtin_amdgcn_cvt_scalef32_pk_f32_fp4(Rv[w], 1.0f, b); out[8 * (w) + 2 * (b)] = fmaf(a, t.x, out[8 * (w) + 2 * (b)]); out[8 * (w) + 2 * (b) + 1] = fmaf(a, t.y, out[8 * (w) + 2 * (b) + 1]); }
#define V4_WORD(w) V4_STEP(w, 0) V4_STEP(w, 1) V4_STEP(w, 2) V4_STEP(w, 3)
    V4_WORD(0) V4_WORD(1) V4_WORD(2) V4_WORD(3)
#undef V4_WORD
#undef V4_STEP
}
__device__ __forceinline__ void phase_gather(const Ctx& C, int layer) {
    const bf16_t* HN2 = (const bf16_t*)(C.ws + A_B2); const unsigned char* U4 = C.ws + WS_U + (size_t)layer * bq::TAB_L1; const unsigned char* V4 = C.ws + WS_V + (size_t)layer * bq::TAB_L1;
    const int* IDX = (const int*)(C.ws + A_B4); const float* GATE = (const float*)(C.ws + A_B4) + (size_t)MT * 128;
    const float* mod = (const float*)(C.ws + WS_MOD); float* X = C.out + O_Y; bf16_t* HN = (bf16_t*)(C.ws + A_HN);
    const int lane = C.lane;
    int m = C.gw; if (m >= MT) return;
    LAS unsigned char* ring = C.lds + C.wave * 16384;
    int i0 = IDX[(size_t)m * 128 + lane], i1 = IDX[(size_t)m * 128 + 64 + lane];
    float g0 = GATE[(size_t)m * 128 + lane], g1 = GATE[(size_t)m * 128 + 64 + lane];
    u32x2 xw[8];
#pragma unroll
    for (int b = 0; b < 8; ++b) xw[b] = *(const u32x2*)(HN2 + (size_t)m * 2048 + 256 * b + 4 * lane);
#pragma unroll
    for (int b = 0; b < 8; ++b) asm volatile("" : "+v"(xw[b]));
    asm volatile("" : "+v"(i0), "+v"(i1), "+v"(g0), "+v"(g1));
    asm volatile("s_waitcnt vmcnt(0)" ::: "memory");
#define SB() __builtin_amdgcn_sched_barrier(0)
    const unsigned lo16 = (unsigned)lane * 16u;
#define ROW_DMA(T, eid_, s_) __builtin_amdgcn_global_load_lds((const unsigned*)((const char*)((T) + (size_t)(eid_) * 1024) + lo16), (LAS unsigned*)(ring + ((s_) & 15) * 1024), 16, 0, 0)
#define EIDC(j) __builtin_amdgcn_readlane(((j) < 64) ? i0 : i1, (j) & 63)
#pragma unroll
    for (int j = 0; j < 14; ++j) ROW_DMA(U4, __builtin_amdgcn_readlane(i0, j), j);
    for (;;) {
        const int mn = m + C.NGW; const bool has_next = mn < MT; const int mq = has_next ? mn : m;
        int ni0, ni1; float ng0, ng1; u32x2 nx[8];
        int lt = lane; asm volatile("" : "+v"(lt));
        { const int* ip = IDX + (size_t)mq * 128 + lt; const float* gp = GATE + (size_t)mq * 128 + lt; const bf16_t* xp = HN2 + (size_t)mq * 2048 + 4 * lt;
          asm volatile("global_load_dword %0, %1, off" : "=v"(ni0) : "v"(ip) : "memory");
          asm volatile("global_load_dword %0, %1, off offset:256" : "=v"(ni1) : "v"(ip) : "memory");
          asm volatile("global_load_dword %0, %1, off" : "=v"(ng0) : "v"(gp) : "memory");
          asm volatile("global_load_dword %0, %1, off offset:256" : "=v"(ng1) : "v"(gp) : "memory");
          asm volatile("global_load_dwordx2 %0, %1, off" : "=v"(nx[0]) : "v"(xp) : "memory");
          asm volatile("global_load_dwordx2 %0, %1, off offset:512" : "=v"(nx[1]) : "v"(xp) : "memory");
          asm volatile("global_load_dwordx2 %0, %1, off offset:1024" : "=v"(nx[2]) : "v"(xp) : "memory");
          asm volatile("global_load_dwordx2 %0, %1, off offset:1536" : "=v"(nx[3]) : "v"(xp) : "memory");
          asm volatile("global_load_dwordx2 %0, %1, off offset:2048" : "=v"(nx[4]) : "v"(xp) : "memory");
          asm volatile("global_load_dwordx2 %0, %1, off offset:2560" : "=v"(nx[5]) : "v"(xp) : "memory");
          asm volatile("global_load_dwordx2 %0, %1, off offset:3072" : "=v"(nx[6]) : "v"(xp) : "memory");
          asm volatile("global_load_dwordx2 %0, %1, off offset:3584" : "=v"(nx[7]) : "v"(xp) : "memory"); }
        i32x8 xhi, xlo;
#pragma unroll
        for (int b = 0; b < 8; ++b) { const float x0 = bf_lo(xw[b].x), x1 = bf_hi(xw[b].x), x2 = bf_lo(xw[b].y), x3 = bf_hi(xw[b].y);
            const float c0 = fminf(fmaxf(x0, -448.f), 448.f), c1 = fminf(fmaxf(x1, -448.f), 448.f), c2 = fminf(fmaxf(x2, -448.f), 448.f), c3 = fminf(fmaxf(x3, -448.f), 448.f);
            int th = 0; th = __builtin_amdgcn_cvt_pk_fp8_f32(c0, c1, th, false); th = __builtin_amdgcn_cvt_pk_fp8_f32(c2, c3, th, true);
            const f32x2 h01 = __builtin_amdgcn_cvt_pk_f32_fp8(th, false), h23 = __builtin_amdgcn_cvt_pk_f32_fp8(th, true);
            int tl = 0; tl = __builtin_amdgcn_cvt_pk_fp8_f32((c0 - h01.x) * 16.f, (c1 - h01.y) * 16.f, tl, false); tl = __builtin_amdgcn_cvt_pk_fp8_f32((c2 - h23.x) * 16.f, (c3 - h23.y) * 16.f, tl, true);
            xhi[b] = th; xlo[b] = tl; }
        const int dsel = lane & 3; const bool dval = ((lane & 15) >> 2) == (lane >> 4);
        { const int jj = lane & 15, gg = lane >> 4, srcA = (jj + 16 * (gg >> 1)) << 2, srcB = (jj + 16 * (2 + (gg >> 1))) << 2; const bool odd = gg & 1;
          i32x8 nh, nl;
#pragma unroll
          for (int d = 0; d < 4; ++d) {
              const int a0 = __builtin_amdgcn_ds_bpermute(srcA, xhi[d]), a1 = __builtin_amdgcn_ds_bpermute(srcA, xhi[4 + d]), b0 = __builtin_amdgcn_ds_bpermute(srcB, xhi[d]), b1 = __builtin_amdgcn_ds_bpermute(srcB, xhi[4 + d]);
              nh[d] = odd ? a1 : a0; nh[4 + d] = odd ? b1 : b0;
              const int c0 = __builtin_amdgcn_ds_bpermute(srcA, xlo[d]), c1 = __builtin_amdgcn_ds_bpermute(srcA, xlo[4 + d]), e0 = __builtin_amdgcn_ds_bpermute(srcB, xlo[d]), e1 = __builtin_amdgcn_ds_bpermute(srcB, xlo[4 + d]);
              nl[d] = odd ? c1 : c0; nl[4 + d] = odd ? e1 : e0; }
          xhi = nh; xlo = nl; }
        float dv0 = 0.f, dv1 = 0.f;
#define U_ITER2(e, VMN, DV, NEXT_T, NEXT_E0, NEXT_E1) do { ROW_DMA(NEXT_T, NEXT_E0, (e) + 14); ROW_DMA(NEXT_T, NEXT_E1, (e) + 15); asm volatile("s_waitcnt vmcnt(" #VMN ")" ::: "memory"); \
            const u32x4 ru0 = *(const LAS u32x4*)(ring + ((e) & 15) * 1024 + lo16), ru1 = *(const LAS u32x4*)(ring + (((e) + 1) & 15) * 1024 + lo16); \
            const float da = dot_row4_mfma(ru0, xhi, xlo, dsel, dval), db = dot_row4_mfma(ru1, xhi, xlo, dsel, dval); \
            DV = (lane == ((e) & 63)) ? da : DV; DV = (lane == (((e) + 1) & 63)) ? db : DV; } while (0)
#pragma unroll 1
        for (int e = 0; e < 14; e += 2) U_ITER2(e, 26, dv0, U4, EIDC(e + 14), EIDC(e + 15));
#pragma unroll 1
        for (int e = 14; e < 64; e += 2) U_ITER2(e, 14, dv0, U4, EIDC(e + 14), EIDC(e + 15));
#pragma unroll 1
        for (int e = 64; e < 114; e += 2) U_ITER2(e, 14, dv1, U4, EIDC(e + 14), EIDC(e + 15));
#pragma unroll 1
        for (int e = 114; e < 128; e += 2) U_ITER2(e, 14, dv1, V4, EIDC(e - 114), EIDC(e - 113));
#undef U_ITER2
        asm volatile("" : "+v"(ni0), "+v"(ni1), "+v"(ng0), "+v"(ng1));
#pragma unroll
        for (int b = 0; b < 8; ++b) asm volatile("" : "+v"(nx[b]));
        const float av0 = gelu_erf(dv0 * (1.0f / U4_SCALE)) * g0 * (1.0f / V4_SCALE), av1 = gelu_erf(dv1 * (1.0f / U4_SCALE)) * g1 * (1.0f / V4_SCALE);
        float out[32];
#pragma unroll
        for (int i = 0; i < 32; ++i) out[i] = 0.f;
#define V_ITER2(e, AV, NEXT_T, NEXT_E0, NEXT_E1) do { ROW_DMA(NEXT_T, NEXT_E0, (e) + 14); ROW_DMA(NEXT_T, NEXT_E1, (e) + 15); asm volatile("s_waitcnt vmcnt(14)" ::: "memory"); \
            const u32x4 rv0 = *(const LAS u32x4*)(ring + ((e) & 15) * 1024 + lo16), rv1 = *(const LAS u32x4*)(ring + (((e) + 1) & 15) * 1024 + lo16); \
            const float a0 = __builtin_bit_cast(float, __builtin_amdgcn_readlane(__builtin_bit_cast(int, AV), (e) & 63)), a1 = __builtin_bit_cast(float, __builtin_amdgcn_readlane(__builtin_bit_cast(int, AV), ((e) + 1) & 63)); \
            axpy_row4(rv0, a0, out); axpy_row4(rv1, a1, out); } while (0)
#pragma unroll 1
        for (int e = 0; e < 64; e += 2) V_ITER2(e, av0, V4, EIDC(e + 14), EIDC(e + 15));
#pragma unroll 1
        for (int e = 64; e < 114; e += 2) V_ITER2(e, av1, V4, EIDC(e + 14), EIDC(e + 15));
#pragma unroll 1
        for (int e = 114; e < 128; e += 2) V_ITER2(e, av1, U4, __builtin_amdgcn_readlane(ni0, e - 114), __builtin_amdgcn_readlane(ni0, e - 113));
#undef V_ITER2
        int le = lane; asm volatile("" : "+v"(le));
        const int sq = seq_of_row(m); const float* g2 = mod + ((size_t)layer * NSEQ + sq) * 12288 + 5 * 2048; float* xr = X + (size_t)m * DM;
        float ss = 0.f;
#pragma unroll
        for (int hb = 0; hb < 2; ++hb) {
            f32x4 xo[4], gg[4];
#pragma unroll
            for (int b = 0; b < 4; ++b) { const int c = 256 * (4 * hb + b) + 4 * le; xo[b] = *(const f32x4*)(xr + c); gg[b] = *(const f32x4*)(g2 + c); }
            SB();
#pragma unroll
            for (int b = 0; b < 4; ++b) {
#pragma unroll
                for (int j = 0; j < 4; ++j) { const float v = xo[b][j] + gg[b][j] * out[4 * (4 * hb + b) + j]; out[4 * (4 * hb + b) + j] = v; ss += v * v; } }
            SB();
        }
        const float rstd = __builtin_amdgcn_rsqf(wave_sum(ss) * (1.0f / DM) + RMS_EPS);
        if (layer == 0) {
            const float* n1g = C.in[11] + 2048; const float* mp = mod + ((size_t)1 * NSEQ + sq) * 12288;
#pragma unroll
            for (int hb = 0; hb < 2; ++hb) {
                f32x4 gv[4], sh[4], sc[4];
#pragma unroll
                for (int b = 0; b < 4; ++b) { const int c = 256 * (4 * hb + b) + 4 * le; gv[b] = *(const f32x4*)(n1g + c); sh[b] = *(const f32x4*)(mp + c); sc[b] = *(const f32x4*)(mp + 2048 + c); }
                SB();
#pragma unroll
                for (int b = 0; b < 4; ++b) { const int bb = 4 * hb + b, c = 256 * bb + 4 * le;
                    const f32x4 xs = {out[4 * bb], out[4 * bb + 1], out[4 * bb + 2], out[4 * bb + 3]}; const f32x4 y = xs * rstd * gv[b] * (sc[b] + 1.0f) + sh[b];
                    *(f32x4*)(xr + c) = xs; u32x2 w; w.x = cvt_pk_bf16(y[0], y[1]); w.y = cvt_pk_bf16(y[2], y[3]); *(u32x2*)(HN + (size_t)m * DM + c) = w; }
                SB();
            }
        } else {
            const float* fg = C.in[35];
            f32x4 gv[8];
#pragma unroll
            for (int b = 0; b < 8; ++b) gv[b] = *(const f32x4*)(fg + 256 * b + 4 * le);
            SB();
#pragma unroll
            for (int b = 0; b < 8; ++b) { const int c = 256 * b + 4 * le; const f32x4 xs = {out[4 * b], out[4 * b + 1], out[4 * b + 2], out[4 * b + 3]};
                *(f32x4*)(xr + c) = xs * rstd * gv[b]; }
        }
        if (!has_next) break;
        m = mn; i0 = ni0; i1 = ni1; g0 = ng0; g1 = ng1;
#pragma unroll
        for (int b = 0; b < 8; ++b) xw[b] = nx[b];
    }
    asm volatile("s_waitcnt vmcnt(0)" ::: "memory");
#undef ROW_DMA
#undef EIDC
#undef SB
}
namespace att {
constexpr int SHM_K = 64 * 208, SHM_V = 64 * 256;
constexpr int OFF_K = 0, OFF_V = 2 * SHM_K, OFF_WS = 2 * SHM_K + 2 * SHM_V;
constexpr float SCALE = 0.07216878364870322f;
constexpr float THR = 8.f;
__device__ __forceinline__ int crow(int r, int hi) { return (r & 3) + 8 * (r >> 2) + 4 * hi; }
constexpr float THR2 = THR * 1.4426950408889634f;
__device__ __forceinline__ void partialSM(f32x16& p0, f32x16& p1, float& mref, f32x16& negm, float& alpha, bool first) {
    float pmax = p0[0];
#pragma unroll
    for (int r = 1; r < 16; ++r) pmax = fmaxf(pmax, p0[r]);
#pragma unroll
    for (int r = 0; r < 16; ++r) pmax = fmaxf(pmax, p1[r]);
    { auto rr = __builtin_amdgcn_permlane32_swap(__float_as_uint(pmax), __float_as_uint(pmax), false, false);
      pmax = fmaxf(__uint_as_float(rr[0]), __uint_as_float(rr[1])); }
    if (__builtin_expect(!first && __all(pmax <= THR2), 1)) { alpha = 1.f; }
    else { const float dl = first ? pmax : fmaxf(pmax, 0.f); alpha = first ? 1.f : __builtin_amdgcn_exp2f(-dl); mref += dl;
#pragma unroll
        for (int r = 0; r < 16; ++r) { negm[r] = -mref; p0[r] -= dl; p1[r] -= dl; }
        asm volatile("" : "+v"(negm)); }
#pragma unroll
    for (int r = 0; r < 16; ++r) p0[r] = __builtin_amdgcn_exp2f(p0[r]);
#pragma unroll
    for (int r = 0; r < 16; ++r) p1[r] = __builtin_amdgcn_exp2f(p1[r]);
}
__device__ __forceinline__ void finishSM(const f32x16& p0, const f32x16& p1, float alpha, float& l_reg, bf16x8& pa0, bf16x8& pa1, bf16x8& pa2, bf16x8& pa3) {
    float ps = 0;
#pragma unroll
    for (int r = 0; r < 16; ++r) ps += p0[r];
#pragma unroll
    for (int r = 0; r < 16; ++r) ps += p1[r];
    { auto rr = __builtin_amdgcn_permlane32_swap(__float_as_uint(ps), __float_as_uint(ps), false, false);
      ps = __uint_as_float(rr[0]) + __uint_as_float(rr[1]); }
    l_reg = l_reg * alpha + ps;
#define PK4(P, BASE, OUT) do { unsigned a0 = cvt_pk_bf16(P[BASE + 0], P[BASE + 1]), a1 = cvt_pk_bf16(P[BASE + 2], P[BASE + 3]);   \
    unsigned b0 = cvt_pk_bf16(P[BASE + 4], P[BASE + 5]), b1 = cvt_pk_bf16(P[BASE + 6], P[BASE + 7]);                              \
    auto r0 = __builtin_amdgcn_permlane32_swap(a0, b0, false, false); auto r1 = __builtin_amdgcn_permlane32_swap(a1, b1, false, false); \
    u32x4 w = {r0[0], r1[0], r0[1], r1[1]}; OUT = __builtin_bit_cast(bf16x8, w); } while (0)
    PK4(p0, 0, pa0); PK4(p0, 8, pa1); PK4(p1, 0, pa2); PK4(p1, 8, pa3);
#undef PK4
}
template <int OFF> __device__ __forceinline__ bf16x8 k_read(int addr) { bf16x8 r; asm volatile("ds_read_b128 %0, %1 offset:%2" : "=v"(r) : "v"(addr), "i"(OFF) : "memory"); return r; }
template <int I> __device__ __forceinline__ bf16x8 kfrag(const int (&kad)[4]) { constexpr int d0 = I >> 1, half = I & 1; return k_read<(d0 >> 2) * 128 + half * 12288>(kad[d0 & 3]); }
__device__ __forceinline__ void packSM(const f32x16& p0, const f32x16& p1, bf16x8& pa0, bf16x8& pa1, bf16x8& pa2, bf16x8& pa3) {
#define PK4(P, BASE, OUT) do { unsigned a0 = cvt_pk_bf16(P[BASE + 0], P[BASE + 1]), a1 = cvt_pk_bf16(P[BASE + 2], P[BASE + 3]);   \
    unsigned b0 = cvt_pk_bf16(P[BASE + 4], P[BASE + 5]), b1 = cvt_pk_bf16(P[BASE + 6], P[BASE + 7]);                              \
    auto r0 = __builtin_amdgcn_permlane32_swap(a0, b0, false, false); auto r1 = __builtin_amdgcn_permlane32_swap(a1, b1, false, false); \
    u32x4 w = {r0[0], r1[0], r0[1], r1[1]}; OUT = __builtin_bit_cast(bf16x8, w); } while (0)
    PK4(p0, 0, pa0); PK4(p0, 8, pa1); PK4(p1, 0, pa2); PK4(p1, 8, pa3);
#undef PK4
}
__device__ __forceinline__ int v_rd_base(int lane) { return ((lane & 3) << 3) | (((lane >> 2) & 3) << 6) | (((lane >> 4) & 1) << 5) | (((lane >> 5) & 1) << 8); }
constexpr int v_rd_off(int d0, int ks, int half) { return d0 * 512 + ks * 4096 + half * 2048; }
template <int OFF> __device__ __forceinline__ s16x4 tr_read(int vb) {
    s16x4 r; asm volatile("ds_read_b64_tr_b16 %0, %1 offset:%2" : "=&v"(r) : "v"(vb), "i"(OFF) : "memory"); return r;
}
template <int D0> __device__ __forceinline__ void pv_one(f32x16& od, int vb, bf16x8 pa0, bf16x8 pa1, bf16x8 pa2, bf16x8 pa3) {
    const s16x4 l0 = tr_read<v_rd_off(D0, 0, 0)>(vb), h0 = tr_read<v_rd_off(D0, 0, 1)>(vb), l1 = tr_read<v_rd_off(D0, 1, 0)>(vb), h1 = tr_read<v_rd_off(D0, 1, 1)>(vb);
    const s16x4 l2 = tr_read<v_rd_off(D0, 2, 0)>(vb), h2 = tr_read<v_rd_off(D0, 2, 1)>(vb), l3 = tr_read<v_rd_off(D0, 3, 0)>(vb), h3 = tr_read<v_rd_off(D0, 3, 1)>(vb);
    asm volatile("s_waitcnt lgkmcnt(0)" ::: "memory"); __builtin_amdgcn_sched_barrier(0);
#define PKV(L, H) (bf16x8){L[0], L[1], L[2], L[3], H[0], H[1], H[2], H[3]}
    od = __builtin_amdgcn_mfma_f32_32x32x16_bf16(pa0, PKV(l0, h0), od, 0, 0, 0);
    od = __builtin_amdgcn_mfma_f32_32x32x16_bf16(pa1, PKV(l1, h1), od, 0, 0, 0);
    od = __builtin_amdgcn_mfma_f32_32x32x16_bf16(pa2, PKV(l2, h2), od, 0, 0, 0);
    od = __builtin_amdgcn_mfma_f32_32x32x16_bf16(pa3, PKV(l3, h3), od, 0, 0, 0);
#undef PKV
}
struct AUnit { int qrow0, kvrow0, ntiles, head, vis0, nact, rev; };

__device__ __forceinline__ bool next_unit(int i, int vcu, int G, AUnit& u) {
    int flat;
    if (G == 256) {
        if (i >= 10) return false;
        if (i < 8) { const int bh = vcu >> 3, s = vcu & 7, base = 16 * (i >> 1); const int qb = (i & 1) ? base + 15 - s : base + s; flat = bh * 64 + qb; }
        else flat = 2048 + vcu * 2 + (i - 8);
    } else { flat = i * G + vcu; if (flat >= 2560) return false; }
    u.rev = (G == 256 && i < 8) ? (i & 1) : 0;
    if (flat < 2048) { const int bh = flat >> 6, qb = flat & 63, b = bh >> 4; u.head = bh & 15; u.qrow0 = b * 16384 + qb * 256; u.kvrow0 = b * 16384; u.ntiles = 4 * qb + 4; u.vis0 = 4 * qb; u.nact = 8; }
    else { const int f = flat - 2048, b = f >> 4; u.head = f & 15; u.qrow0 = MP + b * 64; u.kvrow0 = MP + b * 1088; u.ntiles = 17; u.vis0 = 1 << 20; u.nact = 2; }
    return true;
}

__device__ __forceinline__ void attn_phase(const Ctx& C) {
    bf16_t* Qn = (bf16_t*)(C.ws + A_HN);
    const unsigned char* Q8 = C.ws + A_Q8; const unsigned char* Kn = C.ws + A_KN; const bf16_t* Vv = (const bf16_t*)(C.ws + A_VV);
    LAS unsigned char* lds = C.lds; const int wid = C.wave, lane = C.lane, r32 = lane & 31, hi = lane >> 5;
    LAS float* wsp = (LAS float*)(lds + OFF_WS) + wid * 64; LAS float* li_l = wsp; LAS float* al_l = wsp + 32;
    unsigned ka[2], kst[2]; bool kisn[2];
#pragma unroll
    for (int i = 0; i < 2; ++i) { const int o = ((wid + 8 * i) * 64 + lane) * 16, row = (o / 208) & 63, c = (o % 208) >> 4;
        kisn[i] = !(c >= 8 && c < 12); ka[i] = kisn[i] ? (unsigned)(row * 2048 + (c < 8 ? c : 0) * 16) : (unsigned)(A_KP - A_KN) + (unsigned)(row * 64 + (c - 8) * 16); kst[i] = kisn[i] ? 64u * 2048u : 64u * 64u; }
    const bool kp2 = wid < 5;
    unsigned va[2];
#pragma unroll
    for (int i = 0; i < 2; ++i) { const int by = ((wid * 2 + i) * 64 + lane) * 16, sub = by >> 9, within = by & 511, kk = (sub >> 2) * 8 + (within >> 6), cc = (sub & 3) * 32 + ((within & 63) >> 1);
        const int k = (kk & ~0xC) | ((kk & 4) << 1) | ((kk & 8) >> 1); va[i] = (unsigned)(k * 4096 + cc * 2); }
    const LAS unsigned char* kfr0 = lds + OFF_K + r32 * 208 + 32 * hi;
    const int vb0 = (int)(uintptr_t)(lds + OFF_V) + v_rd_base(lane);
#define ATT_BAR() __builtin_amdgcn_s_barrier()
#define ATT_ISSUE(j, kb, vbi) do { \
        __builtin_amdgcn_global_load_lds((const unsigned*)((const char*)Kn + kc[0]), (LAS unsigned*)(lds + OFF_K + (kb) * SHM_K + wid * 1024), 16, 0, 0); kc[0] += kst[0] * (unsigned)kdir; \
        if (kp2) { __builtin_amdgcn_global_load_lds((const unsigned*)((const char*)Kn + kc[1]), (LAS unsigned*)(lds + OFF_K + (kb) * SHM_K + (wid + 8) * 1024), 16, 0, 0); kc[1] += kst[1] * (unsigned)kdir; } \
      _Pragma("unroll") for (int _i = 0; _i < 2; ++_i) { \
        __builtin_amdgcn_global_load_lds((const unsigned*)((const char*)Vv + vc[_i]), (LAS unsigned*)(lds + OFF_V + (vbi) * SHM_V + (wid * 2 + _i) * 1024), 16, 0, 0); vc[_i] += (unsigned)(64 * 4096 * kdir); } } while (0)
#define PV_STEP(I, PA, L, H, WN) do { asm volatile("s_waitcnt lgkmcnt(" #WN ")" : "+v"(L), "+v"(H) :: "memory"); \
        o[(I) >> 2] = __builtin_amdgcn_mfma_f32_32x32x16_bf16(PA, ((bf16x8){L[0], L[1], L[2], L[3], H[0], H[1], H[2], H[3]}), o[(I) >> 2], 0, 0, 0); \
        if ((I) + 4 < 16) { L = tr_read<v_rd_off((((I) + 4) & 15) >> 2, (I) & 3, 0)>(vb); H = tr_read<v_rd_off((((I) + 4) & 15) >> 2, (I) & 3, 1)>(vb); } \
        __builtin_amdgcn_sched_barrier(0); } while (0)
#define PV_HEAD(VBI) do { vb = vb0 + (VBI) * SHM_V; \
      l0 = tr_read<v_rd_off(0, 0, 0)>(vb); h0 = tr_read<v_rd_off(0, 0, 1)>(vb); l1 = tr_read<v_rd_off(0, 1, 0)>(vb); h1 = tr_read<v_rd_off(0, 1, 1)>(vb); \
      l2 = tr_read<v_rd_off(0, 2, 0)>(vb); h2 = tr_read<v_rd_off(0, 2, 1)>(vb); l3 = tr_read<v_rd_off(0, 3, 0)>(vb); h3 = tr_read<v_rd_off(0, 3, 1)>(vb); } while (0)
#define PV_BODY() do { \
      __builtin_amdgcn_s_setprio(1); PV_STEP(0, pa0, l0, h0, 6);  PV_STEP(1, pa1, l1, h1, 6);  PV_STEP(2, pa2, l2, h2, 6);  PV_STEP(3, pa3, l3, h3, 6); \
      PV_STEP(4, pa0, l0, h0, 6);  PV_STEP(5, pa1, l1, h1, 6);  PV_STEP(6, pa2, l2, h2, 6);  PV_STEP(7, pa3, l3, h3, 6); \
      PV_STEP(8, pa0, l0, h0, 6);  PV_STEP(9, pa1, l1, h1, 6);  PV_STEP(10, pa2, l2, h2, 6); PV_STEP(11, pa3, l3, h3, 6); \
      PV_STEP(12, pa0, l0, h0, 6); PV_STEP(13, pa1, l1, h1, 4); PV_STEP(14, pa2, l2, h2, 2); PV_STEP(15, pa3, l3, h3, 0); __builtin_amdgcn_s_setprio(0); } while (0)
#define ATT_PV(VBI) do { PV_HEAD(VBI); PV_BODY(); } while (0)
    AUnit u;
#ifndef PROBE_ATT
#define PROBE_ATT 0
#endif
#if PROBE_ATT
    for (int ui2 = 0; next_unit(ui2 >> 1, C.vcu, C.G, u); ++ui2) { const bool dummy = !(ui2 & 1);
#else
    for (int ui = 0; next_unit(ui, C.vcu, C.G, u); ++ui) { const bool dummy = false;
#endif
        const bool active = wid < u.nact; const int vis = u.vis0 + (wid >> 1);
        const int qrow = u.qrow0 + wid * 32 + r32;
        i32x8 qf[3];
        if (active) { const unsigned char* qp = Q8 + (size_t)qrow * 3072 + u.head * 192 + 32 * hi;
#pragma unroll
            for (int s = 0; s < 3; ++s) { const u32x4 a = *(const u32x4*)(qp + 64 * s), b = *(const u32x4*)(qp + 64 * s + 16);
                qf[s] = (i32x8){(int)a.x, (int)a.y, (int)a.z, (int)a.w, (int)b.x, (int)b.y, (int)b.z, (int)b.w}; }
        } else {
#pragma unroll
            for (int s = 0; s < 3; ++s) qf[s] = (i32x8){0, 0, 0, 0, 0, 0, 0, 0};
        }
#pragma unroll
        for (int s = 0; s < 3; ++s) asm volatile("" : "+v"(qf[s]));
        float mref = 0.f, l_reg = 0.f; f32x16 o[4]; f32x16 negm;
#pragma unroll
        for (int r = 0; r < 16; ++r) negm[r] = 0.f;
        asm volatile("" : "+v"(negm));
#pragma unroll
        for (int d = 0; d < 4; ++d)
#pragma unroll
            for (int r = 0; r < 16; ++r) o[d][r] = 0.f;
        bf16x8 pa0, pa1, pa2, pa3;
        const int NT = u.ntiles;
        const int kdir = u.rev ? -1 : 1, t0 = u.rev ? u.ntiles - 1 : 0;
        bool started = false;
        unsigned kc[2], vc[2];
#pragma unroll
        for (int i = 0; i < 2; ++i) kc[i] = ka[i] + (kisn[i] ? (unsigned)u.kvrow0 * 2048u + (unsigned)u.head * 128u : (unsigned)u.kvrow0 * 64u) + kst[i] * (unsigned)t0;
#pragma unroll
        for (int i = 0; i < 2; ++i) vc[i] = va[i] + (unsigned)u.kvrow0 * 4096u + (unsigned)u.head * 256u + (unsigned)(64 * 4096) * (unsigned)t0;
        ATT_ISSUE(0, 0, 0);
        asm volatile("s_waitcnt vmcnt(0)" ::: "memory");
        ATT_BAR();
        int vb; s16x4 l0, h0, l1, h1, l2, h2, l3, h3;
        for (int j = 0; j < NT; ++j) {
            const int buf = j & 1;
            const int jt = u.rev ? NT - 1 - j : j;
            const bool doQK = active && jt <= vis;
            if (j + 1 < NT) ATT_ISSUE(j + 1, buf ^ 1, buf ^ 1);
            if (doQK) {
                f32x16 p0, p1;
                {
                    const LAS unsigned char* kf = kfr0 + buf * SHM_K;
                    i32x8 ka0[3], ka1[3];
#pragma unroll
                    for (int s = 0; s < 3; ++s) { const u32x4 a = *(const LAS u32x4*)(kf + 64 * s), b = *(const LAS u32x4*)(kf + 64 * s + 16), c = *(const LAS u32x4*)(kf + 32 * 208 + 64 * s), d = *(const LAS u32x4*)(kf + 32 * 208 + 64 * s + 16);
                        ka0[s] = (i32x8){(int)a.x, (int)a.y, (int)a.z, (int)a.w, (int)b.x, (int)b.y, (int)b.z, (int)b.w}; ka1[s] = (i32x8){(int)c.x, (int)c.y, (int)c.z, (int)c.w, (int)d.x, (int)d.y, (int)d.z, (int)d.w}; }
                    __builtin_amdgcn_s_setprio(1);
                    p0 = __builtin_amdgcn_mfma_scale_f32_32x32x64_f8f6f4(ka0[0], qf[0], negm, 0, 0, 0, 127, 0, 127);
                    p1 = __builtin_amdgcn_mfma_scale_f32_32x32x64_f8f6f4(ka1[0], qf[0], negm, 0, 0, 0, 127, 0, 127);
                    p0 = __builtin_amdgcn_mfma_scale_f32_32x32x64_f8f6f4(ka0[1], qf[1], p0, 0, 0, 0, 127, 0, 127);
                    p1 = __builtin_amdgcn_mfma_scale_f32_32x32x64_f8f6f4(ka1[1], qf[1], p1, 0, 0, 0, 127, 0, 127);
                    p0 = __builtin_amdgcn_mfma_scale_f32_32x32x64_f8f6f4(ka0[2], qf[2], p0, 0, 0, 0, 127, 0, 127);
                    p1 = __builtin_amdgcn_mfma_scale_f32_32x32x64_f8f6f4(ka1[2], qf[2], p1, 0, 0, 0, 127, 0, 127);
                    __builtin_amdgcn_s_setprio(0);
                }
                if ((PROBE_ATT == 2 || PROBE_ATT == 5) && dummy) { packSM(p0, p1, pa0, pa1, pa2, pa3); } else {
                float alpha; partialSM(p0, p1, mref, negm, alpha, !started); started = true;
                if (__any(alpha < 1.f)) { if (hi == 0) al_l[r32] = alpha; asm volatile("s_waitcnt lgkmcnt(0)" ::: "memory");
#pragma unroll
                    for (int r = 0; r < 16; ++r) { const float al = al_l[crow(r, hi)];
#pragma unroll
                        for (int d = 0; d < 4; ++d) o[d][r] *= al; } }
                finishSM(p0, p1, alpha, l_reg, pa0, pa1, pa2, pa3);
                }
                if (!((PROBE_ATT == 4 || PROBE_ATT == 5) && dummy)) ATT_PV(buf);
            }
            asm volatile("s_waitcnt vmcnt(0) lgkmcnt(0)" ::: "memory");
            ATT_BAR();
        }
        if (active && !dummy) {
            if (hi == 0) li_l[r32] = l_reg; asm volatile("s_waitcnt lgkmcnt(0)" ::: "memory");
            bf16_t* Ow = Qn + (size_t)(u.qrow0 + wid * 32) * 2048 + u.head * 128;
#pragma unroll
            for (int r = 0; r < 16; ++r) { const int orow = crow(r, hi); const float rl = __builtin_amdgcn_rcpf(li_l[orow]);
#pragma unroll
                for (int d0 = 0; d0 < 4; ++d0) { const unsigned w = cvt_pk_bf16(o[d0][r] * rl, 0.f); Ow[(size_t)orow * 2048 + d0 * 32 + r32] = (bf16_t)(w & 0xffffu); } }
        }
    }
#undef ATT_BAR
#undef ATT_ISSUE
#undef ATT_PV
#undef PV_STEP
#undef PV_HEAD
#undef PV_BODY
}
}
#ifndef MK_SPLIT
#define MK_SPLIT 0
#endif
constexpr int N_PHASES = 22;

__global__ void __launch_bounds__(512, 2) mega_fwd(Args args) {
    extern __shared__ __attribute__((aligned(16))) unsigned char lds_raw[];
    Ctx C;
    C.lds = (LAS unsigned char*)lds_raw;
    C.tid = threadIdx.x; C.lane = C.tid & 63; C.wave = __builtin_amdgcn_readfirstlane(C.tid >> 6);
    C.G = gridDim.x; { const int bx = blockIdx.x; C.vcu = (C.G % 8 == 0) ? (bx % 8) * (C.G / 8) + bx / 8 : bx; }
    C.gw = C.vcu * 8 + C.wave; C.NGW = C.G * 8;
    C.in = args.in; C.out = args.out; C.ws = args.ws;
    volatile LAS unsigned* misc = (volatile LAS unsigned*)(C.lds + LDS_MISC);
    if (C.tid < 4) misc[C.tid] = 0u;
    __syncthreads();
    const int lo = args.ph_lo, hi = args.ph_hi;
    XcdBarrier bar; bar.bar = (unsigned*)(C.ws + WS_CTL) + CW_BAR; bar.x = 0; bar.st = misc;
    if (hi - lo > 1) bar = xcd_barrier_post((unsigned*)(C.ws + WS_CTL) + CW_BAR, misc);
#ifdef PH_ONLY
#define IN(k) ((k) == PH_ONLY)
#else
#define IN(k) (lo <= (k) && (k) < hi)
#endif
#define FILL(k) bq::service(C, true, (k), 0)
#define NEED(k, limit) do { if (IN(k) && (limit) > 0) bq::service(C, false, 0, (limit)); } while (0)
#define SEAM(k) do { if (IN(k) && IN((k) + 1)) xcd_barrier(bar); } while (0)
    unsigned char* ws = C.ws;
    const float* mod = (const float*)(ws + WS_MOD);
    float* X = C.out + O_Y;
    LAS unsigned char* glds = C.lds;

#ifdef PROBE_CLK
#define CLK_BEGIN(k) unsigned long long _t0 = 0, _r0 = 0; if ((k) == PROBE_CLK) { _t0 = __builtin_amdgcn_s_memtime(); _r0 = __builtin_amdgcn_s_memrealtime(); }
#define CLK_END(k) if ((k) == PROBE_CLK && blockIdx.x == 0 && threadIdx.x == 0) { const unsigned long long t1 = __builtin_amdgcn_s_memtime(), r1 = __builtin_amdgcn_s_memrealtime(); \
        const unsigned long long ticks = (t1 - _t0) * 1000ull / (r1 - _r0); while (__builtin_amdgcn_s_memrealtime() - r1 < ticks) __builtin_amdgcn_s_sleep(8); }
#else
#define CLK_BEGIN(k)
#define CLK_END(k)
#endif
    if (IN(0)) { phase_prologue(C); } SEAM(0);
    if (IN(1)) { phase_norm(C, C.in[0], C.in[1], C.in[11], mod, 0, (bf16_t*)(ws + A_HN)); } NEED(1, bq::E_IN); SEAM(1);
    if (IN(2)) {
        pg8::Gemm g{(const bf16_t*)(ws + A_HN), (const bf16_t*)(ws + WS_WIN), MT, 3072, 2048, 2048, 2048, 0, 0}; pg8::StaticOrder S; S.init(MT, 3072, C.G, (int)blockIdx.x);
        pg8::EpiZ E{(bf16_t*)(ws + A_GG), (bf16_t*)(ws + A_B2), (bf16_t*)(ws + A_B2) + (size_t)MT * 1024};
        CLK_BEGIN(2) pg8::gemm_phase<pg8::EpiZ>(glds, g, S, E); CLK_END(2) FILL(2); } SEAM(2);
    if (IN(3)) { phase_convpool(C); } NEED(3, bq::E_POOL); SEAM(3);
    if (IN(4)) {
        { pg8::Gemm g{(const bf16_t*)(ws + A_B3), (const bf16_t*)(ws + WS_WGATE), MT, 2048, 256, 1024, 256, 1, 256}; pg8::StaticOrder S; S.init(MT, 2048, C.G, (int)blockIdx.x);
          pg8::EpiGate E{(const bf16_t*)(ws + A_B3), (const float*)(ws + WS_SP), (float*)(ws + A_B4)};
          pg8::gemm_phase<pg8::EpiGate>(glds, g, S, E); }
        FILL(4); } SEAM(4);
    if (IN(5)) {
        { pg8::Gemm g{(const bf16_t*)(ws + A_B3) + (size_t)MT * 1024, (const bf16_t*)(ws + WS_WPOOL), MT, 1024, 256, 1024, 256, 0, 256}; pg8::StaticOrder S; S.init(MT, 1024, C.G, (int)blockIdx.x);
          pg8::EpiPool E{(bf16_t*)(ws + A_HN), C.in[22]};
          pg8::gemm_phase<pg8::EpiPool>(glds, g, S, E); }
        phase_scanA(C); FILL(5); } SEAM(5);
    if (IN(6)) { phase_scanB(C); } SEAM(6);
    if (IN(7)) { phase_scanC(C); } NEED(7, bq::E_OUTR); SEAM(7);
    if (IN(8)) {
        pg8::Gemm g{(const bf16_t*)(ws + A_HN), (const bf16_t*)(ws + WS_WOUTR), MT, 2048, 2048, 2048, 2048, 0, 0}; pg8::StaticOrder S; S.init(MT, 2048, C.G, (int)blockIdx.x);
        pg8::EpiBf16 E{(bf16_t*)(ws + A_B3), 2048};
        pg8::gemm_phase<pg8::EpiBf16>(glds, g, S, E); FILL(8); } SEAM(8);
#define PEER_BLOCK(P0, L) \
    if (IN(P0)) { phase_resid_norm(C, (L) == 0 ? C.in[0] : X, (L) == 0 ? C.in[1] : X + (size_t)MP * DM, (const bf16_t*)(ws + A_B3), X, C.in[12] + (L) * 2048, mod + (size_t)(L) * NSEQ * 12288, (bf16_t*)(ws + A_B2)); } NEED(P0, (L) == 0 ? bq::E_Q0 : bq::E_Q1); SEAM(P0); \
    if (IN(P0 + 1)) { pg8::Gemm g{(const bf16_t*)(ws + A_B2), (const bf16_t*)(ws + WS_WQ) + (size_t)(L) * 2048 * 2048, MT, 2048, 2048, 2048, 2048, 0, 0}; pg8::StaticOrder S; S.init(MT, 2048, C.G, (int)blockIdx.x); \
        pg8::EpiBf16 E{(bf16_t*)(ws + A_B3), 2048}; pg8::gemm_phase<pg8::EpiBf16>(glds, g, S, E); FILL(P0 + 1); } NEED(P0 + 1, (L) == 0 ? bq::E_KEYS : 0); SEAM(P0 + 1); \
    if (IN(P0 + 2)) { phase_topk(C, L); } NEED(P0 + 2, (L) == 0 ? bq::E_TAB0 : bq::NTOT); SEAM(P0 + 2); \
    if (IN(P0 + 3)) { CLK_BEGIN(P0 + 3) phase_gather(C, L); CLK_END(P0 + 3) }
    PEER_BLOCK(9, 0) NEED(12, bq::E_DKV); SEAM(12);
    if (IN(13)) {
        pg8::Gemm g{(const bf16_t*)(ws + A_HN), (const bf16_t*)(ws + WS_WDQKV), MT, 1024, 2048, 2048, 2048, 0, 0}; pg8::StaticOrder S; S.init(MT, 1024, C.G, (int)blockIdx.x);
        pg8::EpiF32 E{(float*)(ws + A_B3), 1024};
        pg8::gemm_phase<pg8::EpiF32>(glds, g, S, E); FILL(13); } NEED(13, bq::E_ROPE); SEAM(13);
    if (IN(14)) { phase_latent(C); } NEED(14, bq::E_UKV); SEAM(14);
    if (IN(15)) {
        { pg8::Gemm g{(const bf16_t*)(ws + A_CQ), (const bf16_t*)(ws + WS_WUQ), MT, 3072, 512, 512, 512, 0, 0}; pg8::StaticOrder S; S.init(MT, 3072, C.G, (int)blockIdx.x);
          pg8::EpiQ E{ws + A_Q8, (const float*)(ws + WS_ROPE)};
          pg8::gemm_phase<pg8::EpiQ>(glds, g, S, E); }
        { pg8::Gemm g{(const bf16_t*)(ws + A_CKV), (const bf16_t*)(ws + WS_WUKV), KVROWS, 4096, 256, 256, 256, 0, 0}; pg8::StaticOrder S; S.init(KVROWS, 4096, C.G, (int)blockIdx.x);
          pg8::EpiKV E{ws + A_KN, (bf16_t*)(ws + A_VV)};
          pg8::gemm_phase<pg8::EpiKV>(glds, g, S, E); } FILL(15); } SEAM(15);
    if (IN(16)) { CLK_BEGIN(16) att::attn_phase(C); CLK_END(16) } NEED(16, bq::E_OUTA); SEAM(16);
    if (IN(17)) {
        pg8::Gemm g{(const bf16_t*)(ws + A_HN), (const bf16_t*)(ws + WS_WOUTA), MT, 2048, 2048, 2048, 2048, 0, 0}; pg8::StaticOrder S; S.init(MT, 2048, C.G, (int)blockIdx.x);
        pg8::EpiBf16 E{(bf16_t*)(ws + A_B3), 2048};
        pg8::gemm_phase<pg8::EpiBf16>(glds, g, S, E); FILL(17); } SEAM(17);
    PEER_BLOCK(18, 1)
#undef PEER_BLOCK
#undef IN
#undef SEAM
#undef FILL
#undef NEED
}

extern "C" void kernel_launch(void* const* d_in, const int* in_sizes, int n_in, void* d_out, int out_size, void* d_ws, size_t ws_size, hipStream_t stream) {
    static int grid = 0;
    if (grid == 0) {
        if (n_in != 36 || out_size != (int)O_TOTAL || ws_size < WS_END) { fprintf(stderr, "kernel_launch: built for 36 inputs, %zu outputs, >= %zu B workspace; got n_in %d out %d ws %zu\n", (size_t)O_TOTAL, (size_t)WS_END, n_in, out_size, ws_size); grid = -1; return; }
        int dev = 0, cus = 0, per_cu = 0;
        if (hipGetDevice(&dev) != hipSuccess || hipDeviceGetAttribute(&cus, hipDeviceAttributeMultiprocessorCount, dev) != hipSuccess) { fprintf(stderr, "kernel_launch: device query failed\n"); grid = -1; return; }
        if (hipFuncSetAttribute((const void*)mega_fwd, hipFuncAttributeMaxDynamicSharedMemorySize, LDS_BYTES) != hipSuccess) { fprintf(stderr, "kernel_launch: hipFuncSetAttribute failed\n"); grid = -1; return; }
        if (hipOccupancyMaxActiveBlocksPerMultiprocessor(&per_cu, (const void*)mega_fwd, 512, LDS_BYTES) != hipSuccess || per_cu < 1) { fprintf(stderr, "kernel_launch: occupancy query says %d blocks per CU\n", per_cu); }
        (void)hipGetLastError();
        grid = cus;
    }
    if (grid < 0) return;
    (void)hipMemsetAsync(d_ws, 0, WS_ZERO_BYTES, stream);
    Args a{};
    for (int i = 0; i < 36; ++i) a.in[i] = (const float*)d_in[i];
    a.out = (float*)d_out; a.ws = (unsigned char*)d_ws;
#if MK_SPLIT
    for (int p = 0; p < N_PHASES; ++p) { a.ph_lo = p; a.ph_hi = p + 1; hipLaunchKernelGGL(mega_fwd, dim3(grid), dim3(512), LDS_BYTES, stream, a); }
#elif defined(PROBE_RANGES)
    { const int rg[][2] = {PROBE_RANGES};
      for (unsigned i = 0; i < sizeof(rg) / sizeof(rg[0]); ++i) { if (i) (void)hipMemsetAsync(d_ws, 0, 1 * MiB, stream); a.ph_lo = rg[i][0]; a.ph_hi = rg[i][1]; hipLaunchKernelGGL(mega_fwd, dim3(grid), dim3(512), LDS_BYTES, stream, a); } }
#else
    a.ph_lo = 0; a.ph_hi = N_PHASES; hipLaunchKernelGGL(mega_fwd, dim3(grid), dim3(512), LDS_BYTES, stream, a);
#endif
    const hipError_t le = hipPeekAtLastError();
    if (le != hipSuccess) fprintf(stderr, "kernel_launch: launch failed: %s\n", hipGetErrorName(le));
}
```

```cpp
#include <hip/hip_runtime.h>
#include <cstdio>
#include <cstdint>

#define LAS __attribute__((address_space(3)))
#define GAS __attribute__((address_space(1)))
typedef unsigned short bf16_t;
typedef short bf16x8 __attribute__((ext_vector_type(8)));
typedef short s16x4 __attribute__((ext_vector_type(4)));
typedef float f32x2 __attribute__((ext_vector_type(2)));
typedef float f32x4 __attribute__((ext_vector_type(4)));
typedef float f32x16 __attribute__((ext_vector_type(16)));
typedef unsigned u32x2 __attribute__((ext_vector_type(2)));
typedef unsigned u32x4 __attribute__((ext_vector_type(4)));
typedef int i32x4_t __attribute__((ext_vector_type(4)));
typedef int i32x8_t __attribute__((ext_vector_type(8)));

constexpr int DM = 2048;
constexpr int MP = 32768, MS = 2048, MT = MP + MS;
constexpr int NSEQ = 34;
constexpr int KVROWS = MP + 32 * 1088;
constexpr float RMS_EPS = 1e-6f;

__device__ __forceinline__ int seq_of_row(int m) { return m < MP ? (m >> 14) : 2 + ((m - MP) >> 6); }
__device__ __forceinline__ int pos_of_row(int m) { return m < MP ? (m & 16383) : 1024 + ((m - MP) & 63); }
__device__ __forceinline__ int kvrow_of_row(int m) { return m < MP ? m : MP + ((m - MP) >> 6) * 1088 + 1024 + ((m - MP) & 63); }

__device__ __forceinline__ unsigned cvt_pk_bf16(float lo, float hi) { unsigned r; asm volatile("v_cvt_pk_bf16_f32 %0, %1, %2" : "=v"(r) : "v"(lo), "v"(hi)); return r; }
__device__ __forceinline__ unsigned cvt4_fp8(float a, float b, float c, float d) { int t = 0;
    t = __builtin_amdgcn_cvt_pk_fp8_f32(fminf(fmaxf(a, -448.f), 448.f), fminf(fmaxf(b, -448.f), 448.f), t, false);
    t = __builtin_amdgcn_cvt_pk_fp8_f32(fminf(fmaxf(c, -448.f), 448.f), fminf(fmaxf(d, -448.f), 448.f), t, true); return (unsigned)t; }
__device__ __forceinline__ float bf_lo(unsigned w) { return __uint_as_float(w << 16); }
__device__ __forceinline__ float bf_hi(unsigned w) { return __uint_as_float(w & 0xffff0000u); }
__device__ __forceinline__ float fexp(float x) { return __builtin_amdgcn_exp2f(x * 1.4426950408889634f); }
__device__ __forceinline__ float fsigmoid(float x) { return __builtin_amdgcn_rcpf(1.0f + __builtin_amdgcn_exp2f(-1.4426950408889634f * x)); }
__device__ __forceinline__ float gelu_tanh(float x) { const float u = x * (1.0f + 0.044715f * x * x); return x * __builtin_amdgcn_rcpf(1.0f + __builtin_amdgcn_exp2f(-2.302208198f * u)); }
__device__ __forceinline__ float gelu_erf(float v) {
    const float av = __builtin_fabsf(v), t = __builtin_amdgcn_rcpf(av * 0.2316418882f + 1.0f);
    float q = t * 0.5307027145f + (-0.7265760135f); q = q * t + 0.7107068705f; q = q * t + (-0.142248368f); q = q * t + 0.127414796f; q = q * t;
    const float e = __builtin_amdgcn_exp2f((v * v) * (-0.72134752044f));
    const float m = v * (q * e); return v < 0.f ? m : v - m;
}
__device__ __forceinline__ float wave_sum(float v) {
#pragma unroll
    for (int o = 32; o >= 1; o >>= 1) v += __shfl_xor(v, o);
    return v;
}

namespace pg8 {
constexpr int BM = 256, BK = 64, HALF = 128, HTB = HALF * BK * 2, STAGE_BYTES = 8 * HTB, NXCD = 8, WGM = 8;
__host__ __device__ __forceinline__ int lds_byte(int r, int c) { const int st = (r >> 4) * 2 + (c >> 5), rr = r & 15, cc = c & 31, ob = rr * 64 + cc * 2; return st * 1024 + (ob ^ (((ob >> 9) & 1) << 5)); }
__host__ __device__ __forceinline__ void stage_rc(int b, int& R, int& C) { const int st = b / 1024, sb = b % 1024, swz = sb ^ (((sb >> 9) & 1) << 5); R = (st >> 1) * 16 + swz / 64; C = (st & 1) * 32 + (swz % 64) / 2; }
__host__ __device__ __forceinline__ int perm32(int rho) { const int n = rho >> 4, i = rho & 15; return 8 * (i >> 2) + 4 * n + (i & 3); }

struct Unit { int pm, pn; };
struct Gemm { const bf16_t* A; const bf16_t* Bt; int M, N, K, lda, ldb, kshift, kmul; };

struct StaticOrder {
    int nM, nN, nwg, G, c;
    __host__ __device__ void init(int M, int N, int G_, int c_) { nM = M / BM; nN = N / BM; nwg = nM * nN; G = G_; c = c_; }
    __host__ __device__ bool next(int i, Unit& u) const {
        const long L = (long)i * G + c; if (L >= nwg) return false;
        int wgid = (int)L; { const int q = nwg / NXCD, r = nwg % NXCD, xcd = wgid % NXCD, off = wgid / NXCD; wgid = (xcd < r ? xcd * (q + 1) : r * (q + 1) + (xcd - r) * q) + off; }
        const int nig = WGM * nN, gid = wgid / nig, fm = gid * WGM, gsz = (nM - fm) < WGM ? (nM - fm) : WGM;
        u.pm = fm + ((wgid % nig) % gsz); u.pn = (wgid % nig) / gsz; return true;
    }
};

template <class Epi, bool F8 = false>
__device__ __forceinline__ void gemm_phase(LAS unsigned char* lds, const Gemm g, const StaticOrder& S, const Epi& E) {
    const int tid = threadIdx.x, wid = __builtin_amdgcn_readfirstlane(tid >> 6), lane = tid & 63, wr = wid >> 2, wc = wid & 3, fr = lane & 15, fq = lane >> 4;
    int Kq = g.K; asm volatile("" : "+s"(Kq));
    const int K = Kq, nt = K / BK;
    unsigned voffA[2], voffB[2];
#pragma unroll
    for (int i = 0; i < 2; ++i) { int R, C; stage_rc(tid * 16 + i * 8192, R, C); const int Rb = Epi::PERM ? ((R & ~31) + perm32(R & 31)) : R;
        voffA[i] = (unsigned)(R * g.lda + C) * 2u; voffB[i] = (unsigned)(Rb * g.ldb + C) * 2u; }
    const size_t kstep = (size_t)(BK * 2);
    const size_t hstepA = (size_t)HALF * g.lda * 2, hstepB = (size_t)HALF * g.ldb * 2;
    const unsigned ldsw = (unsigned)wid * 1024u;
    const int aoff = lds_byte(wr * 64 + fr, fq * 8), boff = lds_byte(wc * 32 + fr, fq * 8);
#define PG8_SA(b, h) (((b) * 2 + (h)) * HTB)
#define PG8_SB(b, h) ((4 + (b) * 2 + (h)) * HTB)
#define PG8_STAGE(bufoff, gbase, voff) do { _Pragma("unroll") for (int _i = 0; _i < 2; ++_i) \
        __builtin_amdgcn_global_load_lds((const unsigned*)((const char*)(gbase) + (voff)[_i]), (LAS unsigned*)(lds + (bufoff) + ldsw + _i * 8192), 16, 0, 0); } while (0)
#define PG8_CAT(F) __builtin_shufflevector(__builtin_bit_cast(i32x4_t, (F)[0]), __builtin_bit_cast(i32x4_t, (F)[1]), 0, 1, 2, 3, 4, 5, 6, 7)
#define PG8_LDA(dst, b, h) do { _Pragma("unroll") for (int m = 0; m < 4; ++m) { _Pragma("unroll") for (int k = 0; k < 2; ++k) dst[m][k] = *(const LAS bf16x8*)(lds + PG8_SA(b, h) + aoff + m * 2048 + k * 1024); \
        if (F8) dst##8[m] = PG8_CAT(dst[m]); } } while (0)
#define PG8_LDB(dst, b, h) do { _Pragma("unroll") for (int n = 0; n < 2; ++n) { _Pragma("unroll") for (int k = 0; k < 2; ++k) dst[n][k] = *(const LAS bf16x8*)(lds + PG8_SB(b, h) + boff + n * 2048 + k * 1024); \
        if (F8) dst##8[n] = PG8_CAT(dst[n]); } } while (0)
#define PG8_MMA(ai, bj, At, Bt) do { __builtin_amdgcn_s_setprio(1); \
        if (F8) { _Pragma("unroll") for (int m = 0; m < 4; ++m) _Pragma("unroll") for (int n = 0; n < 2; ++n) \
            asm volatile("v_mfma_scale_f32_16x16x128_f8f6f4 %0, %1, %2, %0, %3, %3 op_sel_hi:[0,0,0]" : "+v"(acc[ai][bj][m][n]) : "v"(Bt##8[n]), "v"(At##8[m]), "v"(f8one)); } \
        else { _Pragma("unroll") for (int m = 0; m < 4; ++m) _Pragma("unroll") for (int n = 0; n < 2; ++n) _Pragma("unroll") for (int k = 0; k < 2; ++k) \
            acc[ai][bj][m][n] = __builtin_amdgcn_mfma_f32_16x16x32_bf16(Bt[n][k], At[m][k], acc[ai][bj][m][n], 0, 0, 0); } \
        __builtin_amdgcn_s_setprio(0); } while (0)
#define PG8_WAIT_V(n) asm volatile("s_waitcnt vmcnt(" #n ")" ::: "memory")
#define PG8_WAIT_L(n) asm volatile("s_waitcnt lgkmcnt(" #n ")" ::: "memory")
#define PG8_BAR __builtin_amdgcn_s_barrier()
#define PG8_SCHED __builtin_amdgcn_sched_barrier(0)
#define PG8_ABASE(u) ((const char*)g.A + (size_t)(u).pm * (2 * hstepA) + (size_t)(((u).pn >> g.kshift) * g.kmul) * 2)
#define PG8_BBASE(u) ((const char*)g.Bt + (size_t)(u).pn * (2 * hstepB))
    Unit cur, nxt; int ui = 0;
    if (!S.next(0, cur)) return;
    f32x4 acc[2][2][4][2];
#pragma unroll
    for (int a = 0; a < 2; ++a)
#pragma unroll
        for (int b = 0; b < 2; ++b)
#pragma unroll
            for (int m = 0; m < 4; ++m)
#pragma unroll
                for (int n = 0; n < 2; ++n) acc[a][b][m][n] = (f32x4){0.f, 0.f, 0.f, 0.f};
    bf16x8 At[4][2], B0[2][2], B1[2][2];
    i32x8_t At8[4], B08[2], B18[2]; int f8one = 127; asm volatile("" : "+v"(f8one));
    const char* cA = PG8_ABASE(cur); const char* cB = PG8_BBASE(cur);
    PG8_STAGE(PG8_SB(0, 0), cB, voffB); PG8_STAGE(PG8_SB(0, 1), cB + hstepB, voffB); PG8_STAGE(PG8_SA(0, 0), cA, voffA); PG8_STAGE(PG8_SA(0, 1), cA + hstepA, voffA);
    if (wr == 1) PG8_BAR;
    PG8_WAIT_V(2); PG8_BAR;
    PG8_STAGE(PG8_SB(1, 0), cB + kstep, voffB); PG8_STAGE(PG8_SA(1, 0), cA + kstep, voffA); PG8_STAGE(PG8_SB(1, 1), cB + hstepB + kstep, voffB);
    PG8_WAIT_V(6); PG8_BAR;
    for (;;) {
        const bool has_next = S.next(ui + 1, nxt);
        const char* nA = has_next ? PG8_ABASE(nxt) : cA; const char* nB = has_next ? PG8_BBASE(nxt) : cB;
        for (int t = 0; t < nt; t += 2) {
            const bool last = (t == nt - 2);
            const char* a1 = cA + (size_t)(t + 1) * kstep;
            const char* a2 = last ? nA : cA + (size_t)(t + 2) * kstep; const char* b2 = last ? nB : cB + (size_t)(t + 2) * kstep;
            const char* a3 = a2 + kstep; const char* b3 = b2 + kstep;
            PG8_LDB(B0, 0, 0); PG8_LDB(B1, 0, 1); PG8_SCHED; PG8_LDA(At, 0, 0); PG8_STAGE(PG8_SA(1, 1), a1 + hstepA, voffA);
            PG8_WAIT_V(8); PG8_WAIT_L(0); PG8_BAR; PG8_MMA(0, 0, At, B0); PG8_MMA(0, 1, At, B1); PG8_BAR; PG8_SCHED;
            PG8_LDA(At, 0, 1); PG8_STAGE(PG8_SB(0, 0), b2, voffB); PG8_STAGE(PG8_SB(0, 1), b2 + hstepB, voffB); PG8_STAGE(PG8_SA(0, 0), a2, voffA);
            PG8_WAIT_V(8); PG8_WAIT_L(0); PG8_BAR; PG8_MMA(1, 0, At, B0); PG8_MMA(1, 1, At, B1); PG8_BAR; PG8_SCHED;
            PG8_LDB(B0, 1, 0); PG8_LDB(B1, 1, 1); PG8_SCHED; PG8_LDA(At, 1, 0); PG8_STAGE(PG8_SA(0, 1), a2 + hstepA, voffA);
            PG8_WAIT_V(8); PG8_WAIT_L(0); PG8_BAR; PG8_MMA(0, 0, At, B0); PG8_MMA(0, 1, At, B1); PG8_BAR; PG8_SCHED;
            PG8_LDA(At, 1, 1); PG8_STAGE(PG8_SB(1, 0), b3, voffB); PG8_STAGE(PG8_SB(1, 1), b3 + hstepB, voffB); PG8_STAGE(PG8_SA(1, 0), a3, voffA);
            PG8_WAIT_V(8); PG8_WAIT_L(0); PG8_BAR; PG8_MMA(1, 0, At, B0); PG8_MMA(1, 1, At, B1); PG8_BAR; PG8_SCHED;
        }
        if (wr == 0) PG8_BAR;
        E(acc, cur, wr, wc, fr, fq);
        if (!has_next) break;
#pragma unroll
        for (int a = 0; a < 2; ++a)
#pragma unroll
            for (int b = 0; b < 2; ++b)
#pragma unroll
                for (int m = 0; m < 4; ++m)
#pragma unroll
                    for (int n = 0; n < 2; ++n) acc[a][b][m][n] = (f32x4){0.f, 0.f, 0.f, 0.f};
        cur = nxt; cA = nA; cB = nB; ++ui;
        if (wr == 1) PG8_BAR;
    }
    PG8_WAIT_V(0);
    PG8_BAR;
#undef PG8_SA
#undef PG8_SB
#undef PG8_STAGE
#undef PG8_LDA
#undef PG8_LDB
#undef PG8_MMA
#undef PG8_CAT
#undef PG8_WAIT_V
#undef PG8_WAIT_L
#undef PG8_BAR
#undef PG8_SCHED
#undef PG8_ABASE
#undef PG8_BBASE
}
}
namespace pg8 {
#define EPI_ROWS(expr_row) for (int ai = 0; ai < 2; ++ai) for (int m = 0; m < 4; ++m)
struct EpiBf16 {
    static constexpr bool PERM = true;
    bf16_t* O; int ldc;
    __device__ __forceinline__ void operator()(const f32x4 (&acc)[2][2][4][2], const Unit& u, int wr, int wc, int fr, int fq) const {
        const int row0 = u.pm * BM + wr * 64 + fr, col0 = u.pn * BM + wc * 32 + 8 * fq;
#pragma unroll
        for (int ai = 0; ai < 2; ++ai)
#pragma unroll
            for (int m = 0; m < 4; ++m) { bf16_t* rowp = O + (size_t)(row0 + ai * HALF + m * 16) * ldc + col0;
#pragma unroll
                for (int bj = 0; bj < 2; ++bj) { const f32x4 v0 = acc[ai][bj][m][0], v1 = acc[ai][bj][m][1];
                    u32x4 w; w.x = cvt_pk_bf16(v0[0], v0[1]); w.y = cvt_pk_bf16(v0[2], v0[3]); w.z = cvt_pk_bf16(v1[0], v1[1]); w.w = cvt_pk_bf16(v1[2], v1[3]);
                    *(u32x4*)(rowp + bj * HALF) = w; } }
    }
};
struct EpiZ {
    static constexpr bool PERM = true;
    bf16_t* GG; bf16_t* REC; bf16_t* POOL;
    __device__ __forceinline__ void operator()(const f32x4 (&acc)[2][2][4][2], const Unit& u, int wr, int wc, int fr, int fq) const {
        const int t = u.pn >> 2; bf16_t* base = GG + (size_t)t * ((size_t)MT * 1024);
        const int row0 = u.pm * BM + wr * 64 + fr, col0 = (u.pn & 3) * BM + wc * 32 + 8 * fq;
#pragma unroll
        for (int ai = 0; ai < 2; ++ai)
#pragma unroll
            for (int m = 0; m < 4; ++m) { bf16_t* rowp = base + (size_t)(row0 + ai * HALF + m * 16) * 1024 + col0;
#pragma unroll
                for (int bj = 0; bj < 2; ++bj) { f32x4 v0 = acc[ai][bj][m][0], v1 = acc[ai][bj][m][1];
                    if (t == 0) {
#pragma unroll
                        for (int j = 0; j < 4; ++j) { v0[j] = gelu_tanh(v0[j]); v1[j] = gelu_tanh(v1[j]); } }
                    u32x4 w; w.x = cvt_pk_bf16(v0[0], v0[1]); w.y = cvt_pk_bf16(v0[2], v0[3]); w.z = cvt_pk_bf16(v1[0], v1[1]); w.w = cvt_pk_bf16(v1[2], v1[3]);
                    *(u32x4*)(rowp + bj * HALF) = w; } }
    }
};
struct EpiGate {
    static constexpr bool PERM = false;
    const bf16_t* XC; const float* gp; float* Aout;
    __device__ __forceinline__ void operator()(const f32x4 (&acc)[2][2][4][2], const Unit& u, int wr, int wc, int fr, int fq) const {
        const int row0 = u.pm * BM + wr * 64 + fr, ch0 = u.pn * 128 + wc * 32 + 4 * fq;
#pragma unroll
        for (int n = 0; n < 2; ++n) {
            const f32x4 bav = *(const f32x4*)(gp + ch0 + 16 * n), bxv = *(const f32x4*)(gp + 1024 + ch0 + 16 * n), spv = *(const f32x4*)(gp + 2048 + ch0 + 16 * n);
#pragma unroll
            for (int ai = 0; ai < 2; ++ai)
#pragma unroll
                for (int m = 0; m < 4; ++m) { const int row = row0 + ai * HALF + m * 16; const bool pos0 = (row < MP) && ((row & 16383) == 0);
                    const size_t off = (size_t)row * 1024 + ch0 + 16 * n;
                    const u32x2 xw = *(const u32x2*)(XC + off); const float xc[4] = {bf_lo(xw.x), bf_hi(xw.x), bf_lo(xw.y), bf_hi(xw.y)};
                    f32x4 av, uv;
#pragma unroll
                    for (int j = 0; j < 4; ++j) { const float r = fsigmoid(acc[ai][0][m][n][j] + bav[j]), ig = fsigmoid(acc[ai][1][m][n][j] + bxv[j]);
                        const float log_a = -8.0f * r * spv[j]; const float a = fexp(log_a); const float mult = pos0 ? 1.0f : __builtin_sqrtf(fmaxf(1.0f - a * a, 0.0f));
                        av[j] = a; uv[j] = mult * ig * xc[j]; }
                    *(f32x4*)(Aout + off) = av; { u32x2 uw; uw.x = cvt_pk_bf16(uv[0], uv[1]); uw.y = cvt_pk_bf16(uv[2], uv[3]); *(u32x2*)((bf16_t*)(Aout + (size_t)MT * 1024) + off) = uw; } asm volatile("" ::: "memory"); }
        }
    }
};
struct EpiPool {
    static constexpr bool PERM = true;
    bf16_t* CAT; const float* spool;
    __device__ __forceinline__ void operator()(const f32x4 (&acc)[2][2][4][2], const Unit& u, int wr, int wc, int fr, int fq) const {
        const int row0 = u.pm * BM + wr * 64 + fr, col0 = u.pn * BM + wc * 32 + 8 * fq;
        f32x4 s0[2], s1[2];
#pragma unroll
        for (int bj = 0; bj < 2; ++bj) { s0[bj] = *(const f32x4*)(spool + col0 + bj * HALF); s1[bj] = *(const f32x4*)(spool + col0 + bj * HALF + 4); }
#pragma unroll
        for (int ai = 0; ai < 2; ++ai)
#pragma unroll
            for (int m = 0; m < 4; ++m) { bf16_t* rowp = CAT + (size_t)(row0 + ai * HALF + m * 16) * 2048 + 1024 + col0;
#pragma unroll
                for (int bj = 0; bj < 2; ++bj) { const f32x4 v0 = acc[ai][bj][m][0] * s0[bj], v1 = acc[ai][bj][m][1] * s1[bj];
                    u32x4 w; w.x = cvt_pk_bf16(v0[0], v0[1]); w.y = cvt_pk_bf16(v0[2], v0[3]); w.z = cvt_pk_bf16(v1[0], v1[1]); w.w = cvt_pk_bf16(v1[2], v1[3]);
                    *(u32x4*)(rowp + bj * HALF) = w; } }
    }
};
struct EpiResid {
    static constexpr bool PERM = false;
    const float* xinP; const float* xinS; float* xout; const float* gate;
    __device__ __forceinline__ void operator()(const f32x4 (&acc)[2][2][4][2], const Unit& u, int wr, int wc, int fr, int fq) const {
        const int row0 = u.pm * BM + wr * 64 + fr, col0 = u.pn * BM + wc * 32 + 4 * fq;
#pragma unroll
        for (int ai = 0; ai < 2; ++ai)
#pragma unroll
            for (int m = 0; m < 4; ++m) { const int row = row0 + ai * HALF + m * 16; const float* gp = gate + (size_t)seq_of_row(row) * 12288 + col0;
                const float* xi = (row < MP ? xinP + (size_t)row * DM : xinS + (size_t)(row - MP) * DM) + col0; float* xo = xout + (size_t)row * DM + col0;
#pragma unroll
                for (int bj = 0; bj < 2; ++bj)
#pragma unroll
                    for (int n = 0; n < 2; ++n) { const int o = bj * HALF + n * 16; *(f32x4*)(xo + o) = *(const f32x4*)(xi + o) + *(const f32x4*)(gp + o) * acc[ai][bj][m][n]; }
                asm volatile("" ::: "memory"); }
    }
};
struct EpiF32 {
    static constexpr bool PERM = false;
    float* C; int ldc;
    __device__ __forceinline__ void operator()(const f32x4 (&acc)[2][2][4][2], const Unit& u, int wr, int wc, int fr, int fq) const {
        const int row0 = u.pm * BM + wr * 64 + fr, col0 = u.pn * BM + wc * 32 + 4 * fq;
#pragma unroll
        for (int ai = 0; ai < 2; ++ai)
#pragma unroll
            for (int m = 0; m < 4; ++m) { float* rowp = C + (size_t)(row0 + ai * HALF + m * 16) * ldc + col0;
#pragma unroll
                for (int bj = 0; bj < 2; ++bj)
#pragma unroll
                    for (int n = 0; n < 2; ++n) *(f32x4*)(rowp + bj * HALF + n * 16) = acc[ai][bj][m][n]; }
    }
};
struct EpiQ {
    static constexpr bool PERM = true;
    static constexpr float QS = 0.07216878364870322f * 1.4426950408889634f;
    unsigned char* Q8; const float* rope;
    __device__ __forceinline__ void operator()(const f32x4 (&acc)[2][2][4][2], const Unit& u, int wr, int wc, int fr, int fq) const {
        const int row0 = u.pm * BM + wr * 64 + fr;
        if (u.pn < 8) {
            const int col0 = u.pn * BM + wc * 32 + 8 * fq;
#pragma unroll
            for (int ai = 0; ai < 2; ++ai)
#pragma unroll
                for (int m = 0; m < 4; ++m) { unsigned char* rowp = Q8 + (size_t)(row0 + ai * HALF + m * 16) * 3072;
#pragma unroll
                    for (int bj = 0; bj < 2; ++bj) { const f32x4 v0 = acc[ai][bj][m][0] * QS, v1 = acc[ai][bj][m][1] * QS; const int col = col0 + bj * HALF;
                        u32x2 w; w.x = cvt4_fp8(v0[0], v0[1], v0[2], v0[3]); w.y = cvt4_fp8(v1[0], v1[1], v1[2], v1[3]);
                        *(u32x2*)(rowp + (col >> 7) * 192 + (col & 127)) = w; } }
        } else {
            const int head = (u.pn - 8) * 4 + wc, j0 = 8 * fq;
#pragma unroll
            for (int ai = 0; ai < 2; ++ai)
#pragma unroll
                for (int m = 0; m < 4; ++m) { const int row = row0 + ai * HALF + m * 16; const float* rp = rope + (size_t)pos_of_row(row) * 64 + j0;
                    const f32x4 c0 = *(const f32x4*)(rp), c1 = *(const f32x4*)(rp + 4), s0 = *(const f32x4*)(rp + 32), s1 = *(const f32x4*)(rp + 36);
                    const f32x4 x10 = acc[ai][0][m][0] * QS, x11 = acc[ai][0][m][1] * QS, x20 = acc[ai][1][m][0] * QS, x21 = acc[ai][1][m][1] * QS;
                    const f32x4 a0 = x10 * c0 - x20 * s0, a1 = x11 * c1 - x21 * s1, b0 = x10 * s0 + x20 * c0, b1 = x11 * s1 + x21 * c1;
                    unsigned char* qp = Q8 + (size_t)row * 3072 + head * 192 + 128 + j0;
                    u32x2 w; w.x = cvt4_fp8(a0[0], a0[1], a0[2], a0[3]); w.y = cvt4_fp8(a1[0], a1[1], a1[2], a1[3]); *(u32x2*)qp = w;
                    w.x = cvt4_fp8(b0[0], b0[1], b0[2], b0[3]); w.y = cvt4_fp8(b1[0], b1[1], b1[2], b1[3]); *(u32x2*)(qp + 32) = w; }
        }
    }
};
struct EpiKV {
    static constexpr bool PERM = true;
    unsigned char* Kn8; bf16_t* V;
    __device__ __forceinline__ void operator()(const f32x4 (&acc)[2][2][4][2], const Unit& u, int wr, int wc, int fr, int fq) const {
        const int row0 = u.pm * BM + wr * 64 + fr, col0 = u.pn * 128 + wc * 32 + 8 * fq;
#pragma unroll
        for (int ai = 0; ai < 2; ++ai)
#pragma unroll
            for (int m = 0; m < 4; ++m) { const size_t off = (size_t)(row0 + ai * HALF + m * 16) * 2048 + col0;
                { const f32x4 v0 = acc[ai][0][m][0], v1 = acc[ai][0][m][1]; u32x2 w; w.x = cvt4_fp8(v0[0], v0[1], v0[2], v0[3]); w.y = cvt4_fp8(v1[0], v1[1], v1[2], v1[3]); *(u32x2*)(Kn8 + off) = w; }
                { const f32x4 v0 = acc[ai][1][m][0], v1 = acc[ai][1][m][1];
                  u32x4 w; w.x = cvt_pk_bf16(v0[0], v0[1]); w.y = cvt_pk_bf16(v0[2], v0[3]); w.z = cvt_pk_bf16(v1[0], v1[1]); w.w = cvt_pk_bf16(v1[2], v1[3]); *(u32x4*)(V + off) = w; } }
    }
};
#undef EPI_ROWS
}

#define XB_TMO      128
#define XB_XCNT(j)  (256  + 64 * (j))
#define XB_XSUB(j)  (1280 + 64 * (j))
#define XB_XGEN(j)  (2304 + 64 * (j))
#define XB_TOP      3328
#define XB_TOPGEN   3392
#define XCD_BAR_WORDS 3456
#define XB_SPIN_CAP (1u << 18)
__device__ __forceinline__ unsigned xb_ld(unsigned* p)              { return __hip_atomic_load(p, __ATOMIC_RELAXED, __HIP_MEMORY_SCOPE_AGENT); }
__device__ __forceinline__ unsigned xb_add(unsigned* p, unsigned v) { return __hip_atomic_fetch_add(p, v, __ATOMIC_RELAXED, __HIP_MEMORY_SCOPE_AGENT); }
__device__ __forceinline__ unsigned xb_xcc_id() { return (unsigned)__builtin_amdgcn_s_getreg((3 << 11) | 20) & 0xFu; }
#define XB_SPIN(cond, bar) do { unsigned _sp = 0; while (cond) { __builtin_amdgcn_s_sleep(1); \
    if ((++_sp & 255u) == 0u) { if (xb_ld(&(bar)[XB_TMO])) break; if (_sp > XB_SPIN_CAP) { atomicAdd(&(bar)[XB_TMO], 1u); break; } } } } while (0)
struct XcdBarrier { unsigned* bar; unsigned x; volatile LAS unsigned* st; };
__device__ __forceinline__ XcdBarrier xcd_barrier_post(unsigned* bar, volatile LAS unsigned* st) {
    XcdBarrier b; b.bar = bar; b.x = xb_xcc_id(); b.st = st;
    if (threadIdx.x == 0) (void)xb_add(&bar[XB_XCNT(b.x)], 1u);
    return b;
}
__device__ __forceinline__ void xcd_barrier_complete(unsigned* bar, unsigned x, unsigned& nloc, unsigned& nx) {
    const unsigned G = gridDim.x * gridDim.y * gridDim.z;
    unsigned sum, cnt, mine, sp = 0u;
    for (;;) {
        sum = 0u; cnt = 0u; mine = 0u;
#pragma unroll
        for (unsigned j = 0; j < 16; ++j) { const unsigned c = xb_ld(&bar[XB_XCNT(j)]); sum += c; cnt += (c > 0u) ? 1u : 0u; mine = (j == x) ? c : mine; }
        if (sum == G) break;
        __builtin_amdgcn_s_sleep(1);
        if ((++sp & 255u) == 0u) { if (xb_ld(&bar[XB_TMO])) break; if (sp > XB_SPIN_CAP) { atomicAdd(&bar[XB_TMO], 1u); break; } }
    }
    nloc = mine > 0u ? mine : 1u; nx = cnt > 0u ? cnt : 1u;
}
__device__ __forceinline__ void xcd_barrier(const XcdBarrier& b) {
    asm volatile("s_waitcnt vmcnt(0)" ::: "memory");
    __syncthreads();
    if (threadIdx.x == 0) {
        unsigned* bar = b.bar;
        __builtin_amdgcn_s_waitcnt(0);
        unsigned nloc = b.st[0], nx = b.st[1];
        if (nloc == 0u) { xcd_barrier_complete(bar, b.x, nloc, nx); b.st[0] = nloc; b.st[1] = nx; }
        const unsigned old = xb_add(&bar[XB_XSUB(b.x)], 1u);
        const unsigned gen = old / nloc;
        if (old + 1u == (gen + 1u) * nloc) {
            __builtin_amdgcn_fence(__ATOMIC_RELEASE, "agent");
            asm volatile("s_waitcnt vmcnt(0)" ::: "memory");
            const unsigned og = xb_add(&bar[XB_TOP], 1u);
            const unsigned tg = og / nx;
            if (og + 1u == (tg + 1u) * nx) xb_add(&bar[XB_TOPGEN], 1u);
            else XB_SPIN(xb_ld(&bar[XB_TOPGEN]) == tg, bar);
            __builtin_amdgcn_fence(__ATOMIC_ACQUIRE, "agent");
            xb_add(&bar[XB_XGEN(b.x)], 1u);
            asm volatile("s_waitcnt vmcnt(0)" ::: "memory");
        } else {
            XB_SPIN(xb_ld(&bar[XB_XGEN(b.x)]) == gen, bar);
            __builtin_amdgcn_fence(__ATOMIC_ACQUIRE, "agent");
            asm volatile("s_waitcnt vmcnt(0)" ::: "memory");
        }
    }
    __syncthreads();
}
constexpr float U8_SCALE = 256.0f, V8_SCALE = 16.0f;
__device__ __forceinline__ void convert_fp8_range(const float* src, unsigned char* dst, float scale, size_t n16, size_t i0, size_t stride) {
    for (size_t i = i0; i < n16; i += stride) { u32x4 w;
#pragma unroll
        for (int q = 0; q < 4; ++q) { f32x4 a = *(const f32x4*)(src + i * 16 + 4 * q) * scale;
#pragma unroll
            for (int j = 0; j < 4; ++j) a[j] = fminf(fmaxf(a[j], -448.0f), 448.0f);
            int t = 0; t = __builtin_amdgcn_cvt_pk_fp8_f32(a[0], a[1], t, false); t = __builtin_amdgcn_cvt_pk_fp8_f32(a[2], a[3], t, true); w[q] = (unsigned)t; }
        *(u32x4*)(dst + i * 16) = w; }
}
constexpr float U4_SCALE = 90.50966799f, V4_SCALE = 8.0f;
__device__ __forceinline__ void convert_fp4_rows(const float* src, unsigned char* dst, float scale, int nrows, int w0, int wstride, int lane) {
    for (int r = w0; r < nrows; r += wstride) { const float* sr = src + (size_t)r * 2048 + 4 * lane; u32x4 w;
        f32x4 a[8];
#pragma unroll
        for (int b = 0; b < 8; ++b) a[b] = *(const f32x4*)(sr + 256 * b) * scale;
#pragma unroll
        for (int q = 0; q < 4; ++q) { float e[8] = {a[2 * q][0], a[2 * q][1], a[2 * q][2], a[2 * q][3], a[2 * q + 1][0], a[2 * q + 1][1], a[2 * q + 1][2], a[2 * q + 1][3]};
#pragma unroll
            for (int j = 0; j < 8; ++j) e[j] = fminf(fmaxf(e[j], -6.0f), 6.0f);
            unsigned t = 0u; t = __builtin_amdgcn_cvt_scalef32_pk_fp4_f32(t, e[0], e[1], 1.0f, 0); t = __builtin_amdgcn_cvt_scalef32_pk_fp4_f32(t, e[2], e[3], 1.0f, 1);
            t = __builtin_amdgcn_cvt_scalef32_pk_fp4_f32(t, e[4], e[5], 1.0f, 2); t = __builtin_amdgcn_cvt_scalef32_pk_fp4_f32(t, e[6], e[7], 1.0f, 3); w[q] = t; }
        *(u32x4*)(dst + (size_t)r * 1024 + 16 * lane) = w; }
}
constexpr size_t MiB = (size_t)1 << 20;
constexpr size_t WS_CTL = 0, WS_WGATE = 1 * MiB, WS_WDQKV = 2 * MiB, WS_ZERO_BYTES = 6 * MiB;
constexpr size_t WS_WIN = 6 * MiB, WS_WOUTR = 18 * MiB, WS_WQ = 26 * MiB, WS_WUQ = 42 * MiB, WS_WUKV = 45 * MiB, WS_WOUTA = 47 * MiB;
constexpr size_t WS_WPOOL = 55 * MiB, WS_KEYS = 56 * MiB, WS_MOD = 57 * MiB, WS_ROPE = 61 * MiB, WS_SP = 65 * MiB, WS_SCAN = 66 * MiB;
constexpr size_t WS_U = 73 * MiB, WS_V = 137 * MiB;
constexpr size_t A_HN = 201 * MiB, A_GG = 337 * MiB, A_B2 = 405 * MiB, A_B3 = 541 * MiB, A_B4 = 677 * MiB;
constexpr size_t A_KN = 405 * MiB  , A_Q8 = 537 * MiB  , A_VV = 669 * MiB, A_KP = 933 * MiB, A_CQ = 942 * MiB, A_CKV = 976 * MiB, WS_END = 1009 * MiB;
constexpr int CW_BAR = 4096;
constexpr size_t SCAN_WORDS = (size_t)544 * 1024;
constexpr size_t O_Y = 0, O_CONV_P = 71303168, O_CONV_S = 71309312, O_H_P = 71407616, O_H_S = 71409664, O_POOL_P = 71442432, O_POOL_S = 71473152,
                 O_CKV = 71964672, O_KPE = 80877568, O_TOTAL = 83105792;
constexpr int LDS_BYTES = 147456, LDS_MISC = 147200;

struct Args { const float* in[36]; float* out; unsigned char* ws; int ph_lo, ph_hi; };

struct Ctx {
    LAS unsigned char* lds; int tid, lane, wave, vcu, G, gw, NGW;
    const float* const* in; float* out; unsigned char* ws;
};

__device__ __forceinline__ void transpose_item(const float* W, int N, int k0, int n0, bf16_t* WT, int dld, int drow0, int dcol0, LAS float* scr, int lane) {
#pragma unroll 8
    for (int i = 0; i < 32; ++i) { const int kk = 2 * i + (lane >> 5); scr[kk * 33 + (lane & 31)] = W[(size_t)(k0 + kk) * N + n0 + (lane & 31)]; }
    asm volatile("s_waitcnt lgkmcnt(0)" ::: "memory");
    const int c = lane & 7;
#pragma unroll
    for (int j = 0; j < 4; ++j) { const int n = (lane >> 3) + 8 * j; const LAS float* s = scr + (8 * c) * 33 + n;
        u32x4 o; o.x = cvt_pk_bf16(s[0 * 33], s[1 * 33]); o.y = cvt_pk_bf16(s[2 * 33], s[3 * 33]); o.z = cvt_pk_bf16(s[4 * 33], s[5 * 33]); o.w = cvt_pk_bf16(s[6 * 33], s[7 * 33]);
        *(u32x4*)(WT + (size_t)(drow0 + n) * dld + dcol0 + 8 * c) = o; }
    asm volatile("s_waitcnt lgkmcnt(0)" ::: "memory");
}
__device__ __forceinline__ void transpose_item_f8(const float* W, int N, int k0, int n0, unsigned char* WT, int dld, int drow0, int dcol0, LAS float* scr, int lane) {
#pragma unroll 8
    for (int i = 0; i < 32; ++i) { const int kk = 2 * i + (lane >> 5); scr[kk * 33 + (lane & 31)] = W[(size_t)(k0 + kk) * N + n0 + (lane & 31)]; }
    asm volatile("s_waitcnt lgkmcnt(0)" ::: "memory");
    const int c = lane & 7;
#pragma unroll
    for (int j = 0; j < 4; ++j) { const int n = (lane >> 3) + 8 * j; const LAS float* s = scr + (8 * c) * 33 + n;
        u32x2 o; o.x = cvt4_fp8(s[0 * 33], s[1 * 33], s[2 * 33], s[3 * 33]); o.y = cvt4_fp8(s[4 * 33], s[5 * 33], s[6 * 33], s[7 * 33]);
        *(u32x2*)(WT + (size_t)(drow0 + n) * dld + dcol0 + 8 * c) = o; }
    asm volatile("s_waitcnt lgkmcnt(0)" ::: "memory");
}
__device__ __forceinline__ void transpose_mat_item(const float* W, int K, int N, bf16_t* WT, int dld, int drow_base, int dcol_base, int item, LAS float* scr, int lane) {
    const int nblk = N / 32, kb = item / nblk, nb = item % nblk;
    transpose_item(W, N, 64 * kb, 32 * nb, WT, dld, drow_base + 32 * nb, dcol_base + 64 * kb, scr, lane);
}
__device__ __forceinline__ void convert_range(const float* src, bf16_t* dst, size_t n8, size_t i0, size_t stride) {
    for (size_t i = i0; i < n8; i += stride) { const f32x4 a = *(const f32x4*)(src + i * 8), b = *(const f32x4*)(src + i * 8 + 4);
        u32x4 w; w.x = cvt_pk_bf16(a[0], a[1]); w.y = cvt_pk_bf16(a[2], a[3]); w.z = cvt_pk_bf16(b[0], b[1]); w.w = cvt_pk_bf16(b[2], b[3]);
        *(u32x4*)(dst + i * 8) = w; }
}

__device__ __forceinline__ void ada_item(const Ctx& C, int item) {
    const int l = item / 96, nb = item % 96, n0 = nb * 128, w = C.wave, lane = C.lane;
    const float* cP = C.in[2]; const float* cS = C.in[3]; const float* W = C.in[9] + (size_t)l * 2048 * 12288 + n0 + 2 * lane; const float* bias = C.in[10] + (size_t)l * 12288 + n0;
    LAS float* scr = (LAS float*)(C.lds + w * 4608);
    LAS float* sum = (LAS float*)(C.lds + 36864);
    f32x2 acc[34];
#pragma unroll
    for (int s = 0; s < 34; ++s) acc[s] = (f32x2){0.f, 0.f};
    for (int sub = 0; sub < 8; ++sub) {
        const int k0 = 256 * w + 32 * sub;
#pragma unroll
        for (int i = 0; i < 17; ++i) { const int idx = lane + 64 * i, s = idx >> 5, kk = idx & 31;
            const float cv = (s < 2) ? cP[s * 2048 + k0 + kk] : cS[(s - 2) * 2048 + k0 + kk];
            scr[kk * 36 + s] = cv * fsigmoid(cv); }
        asm volatile("s_waitcnt lgkmcnt(0)" ::: "memory");
#pragma unroll 1
        for (int kq = 0; kq < 2; ++kq) {
            f32x2 wv[16];
#pragma unroll
            for (int kk = 0; kk < 16; ++kk) wv[kk] = *(const f32x2*)(W + (size_t)(k0 + 16 * kq + kk) * 12288);
#pragma unroll
            for (int kk = 0; kk < 16; ++kk) {
#pragma unroll
                for (int s4 = 0; s4 < 9; ++s4) { const f32x4 sv = *(const LAS f32x4*)(scr + (16 * kq + kk) * 36 + 4 * s4);
#pragma unroll
                    for (int i = 0; i < 4; ++i) if (4 * s4 + i < 34) acc[4 * s4 + i] += wv[kk] * sv[i]; }
                asm volatile("" ::: "memory");
            }
        }
        asm volatile("s_waitcnt lgkmcnt(0)" ::: "memory");
    }
    for (int ww = 0; ww < 8; ++ww) {
        if (w == ww) {
#pragma unroll
            for (int s = 0; s < 34; ++s) { LAS f32x2* p = (LAS f32x2*)(sum + s * 128) + lane; if (ww == 0) *p = acc[s]; else *p = *p + acc[s]; }
        }
        __syncthreads();
    }
    float* mod = (float*)(C.ws + WS_MOD);
    for (int s = w; s < 34; s += 8) { const f32x2 v = *((LAS f32x2*)(sum + s * 128) + lane) + *(const f32x2*)(bias + 2 * lane);
        *(f32x2*)(mod + ((size_t)l * NSEQ + s) * 12288 + n0 + 2 * lane) = v; }
    __syncthreads();
}

namespace bq {
constexpr int I_IN = 32 * 96, I_GATE = 16 * 8, I_POOL = 4 * 32, I_OUTR = 32 * 64, I_Q = 32 * 64, I_KEYS = 256, I_TAB = 16384  , I_DQ = 32 * 16, I_DKV = 32 * 10,
              I_ROPE = 1024, I_UQ = 8 * 96, I_UKV = 4 * 128, I_OUTA = 32 * 64;
constexpr int E_IN = I_IN, E_GATE = E_IN + I_GATE, E_POOL = E_GATE + I_POOL, E_OUTR = E_POOL + I_OUTR, E_Q0 = E_OUTR + I_Q, E_KEYS = E_Q0 + I_KEYS, E_TAB0 = E_KEYS + I_TAB, E_DQ = E_TAB0 + I_DQ,
              E_DKV = E_DQ + I_DKV, E_ROPE = E_DKV + I_ROPE, E_UQ = E_ROPE + I_UQ, E_UKV = E_UQ + I_UKV, E_OUTA = E_UKV + I_OUTA, E_Q1 = E_OUTA + I_Q, E_TAB1 = E_Q1 + I_TAB, NTOT = E_TAB1;
static_assert(NTOT % 8 == 0 && E_IN % 8 == 0 && E_POOL % 8 == 0 && E_OUTR % 8 == 0 && E_Q0 % 8 == 0 && E_KEYS % 8 == 0 && E_TAB0 % 8 == 0 && E_DKV % 8 == 0 && E_ROPE % 8 == 0 && E_UKV % 8 == 0 && E_OUTA % 8 == 0 && E_Q1 % 8 == 0, "queue segments are whole workgroup items");
constexpr int CW_QHEAD = 64, CW_DONE = 128;
constexpr int LDS_SLOT = LDS_MISC + 32;
constexpr size_t TAB_L1 = 16 * MiB;

__device__ __forceinline__ void fp4_row_pair(const float* src, unsigned char* dst, float scale, int r0, int lane) {
    f32x4 a[16];
#pragma unroll
    for (int b = 0; b < 16; ++b) a[b] = *(const f32x4*)(src + (size_t)(r0 + (b >> 3)) * 2048 + 4 * lane + 256 * (b & 7)) * scale;
#pragma unroll
    for (int rr = 0; rr < 2; ++rr) { u32x4 w;
#pragma unroll
        for (int q = 0; q < 4; ++q) { float e[8] = {a[8 * rr + 2 * q][0], a[8 * rr + 2 * q][1], a[8 * rr + 2 * q][2], a[8 * rr + 2 * q][3], a[8 * rr + 2 * q + 1][0], a[8 * rr + 2 * q + 1][1], a[8 * rr + 2 * q + 1][2], a[8 * rr + 2 * q + 1][3]};
#pragma unroll
            for (int j = 0; j < 8; ++j) e[j] = fminf(fmaxf(e[j], -6.0f), 6.0f);
            unsigned t = 0u; t = __builtin_amdgcn_cvt_scalef32_pk_fp4_f32(t, e[0], e[1], 1.0f, 0); t = __builtin_amdgcn_cvt_scalef32_pk_fp4_f32(t, e[2], e[3], 1.0f, 1);
            t = __builtin_amdgcn_cvt_scalef32_pk_fp4_f32(t, e[4], e[5], 1.0f, 2); t = __builtin_amdgcn_cvt_scalef32_pk_fp4_f32(t, e[6], e[7], 1.0f, 3); w[q] = t; }
        *(u32x4*)(dst + (size_t)(r0 + rr) * 1024 + 16 * lane) = w; }
}
__device__ __forceinline__ void table_item(const Ctx& C, int layer, int r, int lane) {
    const int t = r >> 13, rp = r & 8191;
    const float* src = (t ? C.in[34] : C.in[33]) + (size_t)layer * 16384 * 2048; unsigned char* dst = C.ws + (t ? WS_V : WS_U) + (size_t)layer * TAB_L1;
    fp4_row_pair(src, dst, t ? V4_SCALE : U4_SCALE, 2 * rp, lane);
}
__device__ __forceinline__ void wave_item(const Ctx& C, int it, LAS float* scr, int lane) {
    bf16_t* w_in = (bf16_t*)(C.ws + WS_WIN); bf16_t* w_outr = (bf16_t*)(C.ws + WS_WOUTR); bf16_t* w_q = (bf16_t*)(C.ws + WS_WQ);
    bf16_t* w_dqkv = (bf16_t*)(C.ws + WS_WDQKV); bf16_t* w_uq = (bf16_t*)(C.ws + WS_WUQ); bf16_t* w_ukv = (bf16_t*)(C.ws + WS_WUKV);
    bf16_t* w_outa = (bf16_t*)(C.ws + WS_WOUTA); bf16_t* w_gate = (bf16_t*)(C.ws + WS_WGATE); bf16_t* w_pool = (bf16_t*)(C.ws + WS_WPOOL);
    int r = it;
    if (r < I_IN) { transpose_mat_item(C.in[13], 2048, 3072, w_in, 2048, 0, 0, r, scr, lane); return; } r -= I_IN;
    if (r < I_GATE) {
        const int q = r / 8, sub = r % 8, h = q >> 1, gsel = q & 1;
        const float* src = (gsel ? C.in[18] : C.in[16]) + (size_t)h * 128 * 128;
        transpose_mat_item(src, 128, 128, w_gate, 256, h * 256 + gsel * 128, (h & 1) * 128, sub, scr, lane); return; } r -= I_GATE;
    if (r < I_POOL) { const int gq = r / 32, sub = r % 32;
        transpose_mat_item(C.in[21] + (size_t)gq * 256 * 256, 256, 256, w_pool, 256, gq * 256, 0, sub, scr, lane); return; } r -= I_POOL;
    if (r < I_OUTR) { transpose_mat_item(C.in[23], 2048, 2048, w_outr, 2048, 0, 0, r, scr, lane); return; } r -= I_OUTR;
    if (r < I_Q) { transpose_mat_item(C.in[31], 2048, 2048, w_q, 2048, 0, 0, r, scr, lane); return; } r -= I_Q;
    if (r < I_KEYS) { convert_range(C.in[32] + (size_t)r * 2048, (bf16_t*)(C.ws + WS_KEYS) + (size_t)r * 2048, 256, (size_t)lane, 64); return; } r -= I_KEYS;
    if (r < I_TAB) { table_item(C, 0, r, lane); return; } r -= I_TAB;
    if (r < I_DQ) { transpose_mat_item(C.in[24], 2048, 512, w_dqkv, 2048, 0, 0, r, scr, lane); return; } r -= I_DQ;
    if (r < I_DKV) { transpose_mat_item(C.in[27], 2048, 320, w_dqkv, 2048, 512, 0, r, scr, lane); return; } r -= I_DKV;
    if (r < I_ROPE) {
        float* rope = (float*)(C.ws + WS_ROPE);
        for (int q = 0; q < 8; ++q) { const int i = r * 512 + q * 64 + lane, pos = i >> 5, j = i & 31;
            double inv = 1.0; for (int qq = 0; qq < j; ++qq) inv *= 0.7498942093324559;
            const double rev = (double)pos * inv * 0.15915494309189535; const float fr = (float)(rev - __builtin_floor(rev));
            rope[(size_t)pos * 64 + j] = __builtin_amdgcn_cosf(fr); rope[(size_t)pos * 64 + 32 + j] = __builtin_amdgcn_sinf(fr); }
        return; } r -= I_ROPE;
    if (r < I_UQ) {
        const int kb = r / 96, nb = r % 96, n0 = 32 * nb, h = n0 / 192, d = n0 % 192;
        const int drow = (d < 128) ? h * 128 + d : 2048 + (h >> 2) * 256 + ((d - 128) >> 5) * 128 + (h & 3) * 32;
        transpose_item(C.in[26], 3072, 64 * kb, n0, w_uq, 512, drow, 64 * kb, scr, lane); return; } r -= I_UQ;
    if (r < I_UKV) { transpose_mat_item(C.in[29], 256, 4096, w_ukv, 256, 0, 0, r, scr, lane); return; } r -= I_UKV;
    if (r < I_OUTA) { const int nblk = 2048 / 32, kb = r / nblk, nb = r % nblk;
        transpose_item_f8(C.in[30], 2048, 64 * kb, 32 * nb, (unsigned char*)w_outa, 2048, 32 * nb, 64 * kb, scr, lane); return; } r -= I_OUTA;
    if (r < I_Q) { transpose_mat_item(C.in[31] + (size_t)2048 * 2048, 2048, 2048, w_q + (size_t)2048 * 2048, 2048, 0, 0, r, scr, lane); return; } r -= I_Q;
    table_item(C, 1, r, lane);
}
__device__ __forceinline__ void service(const Ctx& C, bool fill, int slot, int limit, bool signal = true) {
    unsigned* ctl = (unsigned*)(C.ws + WS_CTL); unsigned* qhead = ctl + CW_QHEAD; unsigned* done = ctl + CW_DONE + slot;
    volatile LAS int* lslot = (volatile LAS int*)(C.lds + LDS_SLOT);
    LAS float* scr = (LAS float*)(C.lds + 72704 + C.wave * 8448);
    __syncthreads();
    if (fill && signal && C.tid == 0) __hip_atomic_fetch_add(done, 1u, __ATOMIC_RELAXED, __HIP_MEMORY_SCOPE_AGENT);
    const unsigned lim = fill ? (unsigned)(NTOT / 8) : (unsigned)(limit / 8);
    for (;;) {
        if (C.tid == 0) { int it = -1;
            const unsigned h = __hip_atomic_load(qhead, __ATOMIC_RELAXED, __HIP_MEMORY_SCOPE_AGENT);
            bool go = h < lim;
            if (go && fill) go = __hip_atomic_load(done, __ATOMIC_RELAXED, __HIP_MEMORY_SCOPE_AGENT) < (unsigned)C.G;
            if (go) { const unsigned t = __hip_atomic_fetch_add(qhead, 1u, __ATOMIC_RELAXED, __HIP_MEMORY_SCOPE_AGENT); if (t < (unsigned)(NTOT / 8)) it = (int)t; }
            *lslot = it; }
        __syncthreads();
        const int it = *lslot;
        __syncthreads();
        if (it < 0) break;
        { Ctx D = C; int ln = C.lane; asm volatile("" : "+v"(ln)); D.lane = ln;
          wave_item(D, it * 8 + C.wave, scr, ln); }
    }
}
}

__device__ __forceinline__ void phase_prologue(const Ctx& C) {
    const int lane = C.lane;
    constexpr int NADA = 192;
    for (int it = C.vcu; it < NADA; it += C.G) ada_item(C, it);
    bq::service(C, true, 0, 0);
    const size_t gt = (size_t)C.vcu * 512 + C.tid, GT = (size_t)C.G * 512;
    { float* sp = (float*)(C.ws + WS_SP);
      for (size_t i = gt; i < 1024; i += GT) { sp[i] = C.in[17][i]; sp[1024 + i] = C.in[19][i]; const float y = fexp(-C.in[20][i]); sp[2048 + i] = (y < 0.03f) ? y * (1.0f - y * (0.5f - y * (0.33333333f - y * (0.25f - 0.2f * y)))) : 0.6931471805599453f * __builtin_amdgcn_logf(1.0f + y); } }
}
__device__ __forceinline__ void norm_mod_row(const float* xrow, const float* g, const float* shift, const float* scale, bf16_t* orow, int lane) {
    f32x4 v[8]; float ss = 0.f;
#pragma unroll
    for (int j = 0; j < 8; ++j) { v[j] = *((const f32x4*)xrow + lane + 64 * j); ss += (v[j].x * v[j].x + v[j].y * v[j].y) + (v[j].z * v[j].z + v[j].w * v[j].w); }
    const float rstd = __builtin_amdgcn_rsqf(wave_sum(ss) * (1.0f / DM) + RMS_EPS);
#pragma unroll
    for (int j = 0; j < 8; ++j) { const int q = lane + 64 * j; const f32x4 gv = *((const f32x4*)g + q), sc = *((const f32x4*)scale + q), sh = *((const f32x4*)shift + q);
        const f32x4 y = v[j] * rstd * gv * (sc + 1.0f) + sh;
        u32x2 w; w.x = cvt_pk_bf16(y.x, y.y); w.y = cvt_pk_bf16(y.z, y.w); *((u32x2*)orow + q) = w; }
}
__device__ __forceinline__ void phase_norm(const Ctx& C, const float* xP, const float* xS, const float* g, const float* modl, int part, bf16_t* hn) {
    const int lane = C.lane; int m = C.gw; if (m >= MT) return;
    f32x4 gv[8];
#pragma unroll
    for (int j = 0; j < 8; ++j) gv[j] = *((const f32x4*)g + lane + 64 * j);
    f32x4 nv[8];
    { const float* xr = (m < MP) ? xP + (size_t)m * DM : xS + (size_t)(m - MP) * DM;
#pragma unroll
      for (int j = 0; j < 8; ++j) nv[j] = *((const f32x4*)xr + lane + 64 * j); }
    for (; m < MT; m += C.NGW) {
        f32x4 v[8];
#pragma unroll
        for (int j = 0; j < 8; ++j) v[j] = nv[j];
        const int mn = m + C.NGW;
        if (mn < MT) { const float* xr = (mn < MP) ? xP + (size_t)mn * DM : xS + (size_t)(mn - MP) * DM;
#pragma unroll
            for (int j = 0; j < 8; ++j) nv[j] = *((const f32x4*)xr + lane + 64 * j); }
        const float* mp = modl + (size_t)seq_of_row(m) * 12288 + part * 2048;
        f32x4 sc[8], sh[8];
#pragma unroll
        for (int j = 0; j < 8; ++j) { const int q = lane + 64 * j; sh[j] = *((const f32x4*)mp + q); sc[j] = *((const f32x4*)(mp + 2048) + q); }
        float ss = 0.f;
#pragma unroll
        for (int j = 0; j < 8; ++j) ss += (v[j].x * v[j].x + v[j].y * v[j].y) + (v[j].z * v[j].z + v[j].w * v[j].w);
        const float rstd = __builtin_amdgcn_rsqf(wave_sum(ss) * (1.0f / DM) + RMS_EPS);
#pragma unroll
        for (int j = 0; j < 8; ++j) { const int q = lane + 64 * j; const f32x4 y = v[j] * rstd * gv[j] * (sc[j] + 1.0f) + sh[j];
            u32x2 w; w.x = cvt_pk_bf16(y.x, y.y); w.y = cvt_pk_bf16(y.z, y.w); *((u32x2*)(hn + (size_t)m * DM) + q) = w; }
    }
}
__device__ __forceinline__ void phase_resid_norm(const Ctx& C, const float* xP, const float* xS, const bf16_t* mix, float* X, const float* g, const float* modl, bf16_t* hn) {
    const int lane = C.lane; int m = C.gw; if (m >= MT) return;
    f32x4 gv[8];
#pragma unroll
    for (int j = 0; j < 8; ++j) gv[j] = *((const f32x4*)g + lane + 64 * j);
    f32x4 nx[8]; u32x2 nm[8];
    { const float* xr = (m < MP) ? xP + (size_t)m * DM : xS + (size_t)(m - MP) * DM;
#pragma unroll
      for (int j = 0; j < 8; ++j) { const int q = lane + 64 * j; nx[j] = *((const f32x4*)xr + q); nm[j] = *((const u32x2*)(mix + (size_t)m * DM) + q); } }
    for (; m < MT; m += C.NGW) {
        f32x4 v[8]; u32x2 mw[8];
#pragma unroll
        for (int j = 0; j < 8; ++j) { v[j] = nx[j]; mw[j] = nm[j]; }
        const int mn = m + C.NGW;
        if (mn < MT) { const float* xr = (mn < MP) ? xP + (size_t)mn * DM : xS + (size_t)(mn - MP) * DM;
#pragma unroll
            for (int j = 0; j < 8; ++j) { const int q = lane + 64 * j; nx[j] = *((const f32x4*)xr + q); nm[j] = *((const u32x2*)(mix + (size_t)mn * DM) + q); } }
        const float* mp = modl + (size_t)seq_of_row(m) * 12288;
        float ss = 0.f;
#pragma unroll
        for (int j = 0; j < 8; ++j) { const int q = lane + 64 * j; const f32x4 g1 = *((const f32x4*)(mp + 2 * 2048) + q);
            v[j] = v[j] + g1 * (f32x4){bf_lo(mw[j].x), bf_hi(mw[j].x), bf_lo(mw[j].y), bf_hi(mw[j].y)}; ss += (v[j].x * v[j].x + v[j].y * v[j].y) + (v[j].z * v[j].z + v[j].w * v[j].w);
            *((f32x4*)(X + (size_t)m * DM) + q) = v[j]; }
        const float rstd = __builtin_amdgcn_rsqf(wave_sum(ss) * (1.0f / DM) + RMS_EPS);
#pragma unroll
        for (int j = 0; j < 8; ++j) { const int q = lane + 64 * j; const f32x4 sh = *((const f32x4*)(mp + 3 * 2048) + q), sc = *((const f32x4*)(mp + 4 * 2048) + q);
            const f32x4 y = v[j] * rstd * gv[j] * (sc + 1.0f) + sh;
            u32x2 w; w.x = cvt_pk_bf16(y.x, y.y); w.y = cvt_pk_bf16(y.z, y.w); *((u32x2*)(hn + (size_t)m * DM) + q) = w; }
    }
}

__device__ __forceinline__ void ld8bf(const bf16_t* p, float (&v)[8]) { const u32x4 w = *(const u32x4*)p; v[0] = bf_lo(w.x); v[1] = bf_hi(w.x); v[2] = bf_lo(w.y); v[3] = bf_hi(w.y); v[4] = bf_lo(w.z); v[5] = bf_hi(w.z); v[6] = bf_lo(w.w); v[7] = bf_hi(w.w); }
__device__ __forceinline__ void ld8f(const float* p, float (&v)[8]) { const f32x4 a = *(const f32x4*)p, b = *(const f32x4*)(p + 4); v[0] = a.x; v[1] = a.y; v[2] = a.z; v[3] = a.w; v[4] = b.x; v[5] = b.y; v[6] = b.z; v[7] = b.w; }
__device__ __forceinline__ void st8bf(bf16_t* p, const float (&v)[8]) { u32x4 w; w.x = cvt_pk_bf16(v[0], v[1]); w.y = cvt_pk_bf16(v[2], v[3]); w.z = cvt_pk_bf16(v[4], v[5]); w.w = cvt_pk_bf16(v[6], v[7]); *(u32x4*)p = w; }
__device__ __forceinline__ void st8f(float* p, const float (&v)[8]) { *(f32x4*)p = (f32x4){v[0], v[1], v[2], v[3]}; *(f32x4*)(p + 4) = (f32x4){v[4], v[5], v[6], v[7]}; }

__device__ __forceinline__ void phase_convpool(const Ctx& C) {
    const bf16_t* __restrict__ REC = (const bf16_t*)(C.ws + A_B2); const bf16_t* __restrict__ PIN = REC + (size_t)MT * 1024;
    bf16_t* __restrict__ XC = (bf16_t*)(C.ws + A_B3); bf16_t* __restrict__ POOLED = XC + (size_t)MT * 1024;
    const float* convw = C.in[14]; const float* convb = C.in[15]; const float* st_conv = C.in[4]; const float* st_pool = C.in[6];
    const int NITEM = 2 * 544 * 128;
    for (int it0 = C.vcu * 512 + C.tid; it0 < NITEM; it0 += C.G * 512) {
        const bool is_pool = it0 >= 544 * 128; const int it = is_pool ? it0 - 544 * 128 : it0;
        const int chunk = it >> 7, ch0 = (it & 127) * 8;
        const bool samp = chunk >= 512; const int sb = chunk - 512;
        const int row0 = samp ? MP + sb * 64 : chunk * 64;
        const int t0 = samp ? 0 : (chunk & 255) * 64;
        const bool lastc = samp || ((chunk & 255) == 255);
        if (!is_pool) {
            float w0[8], w1[8], w2[8], w3[8], bb[8], p0[8], p1[8], p2[8];
            ld8f(convw + ch0, w0); ld8f(convw + 1024 + ch0, w1); ld8f(convw + 2048 + ch0, w2); ld8f(convw + 3072 + ch0, w3); ld8f(convb + ch0, bb);
            if (samp) { ld8f(st_conv + ((size_t)sb * 3 + 0) * 1024 + ch0, p0); ld8f(st_conv + ((size_t)sb * 3 + 1) * 1024 + ch0, p1); ld8f(st_conv + ((size_t)sb * 3 + 2) * 1024 + ch0, p2); }
            else if (t0 > 0) { ld8bf(REC + (size_t)(row0 - 3) * 1024 + ch0, p0); ld8bf(REC + (size_t)(row0 - 2) * 1024 + ch0, p1); ld8bf(REC + (size_t)(row0 - 1) * 1024 + ch0, p2); }
            else {
#pragma unroll
                for (int j = 0; j < 8; ++j) { p0[j] = 0.f; p1[j] = 0.f; p2[j] = 0.f; } }
            for (int tb = 0; tb < 64; tb += 8) {
                u32x4 raw[8];
#pragma unroll
                for (int q = 0; q < 8; ++q) raw[q] = *(const u32x4*)(REC + (size_t)(row0 + tb + q) * 1024 + ch0);
#pragma unroll
                for (int q = 0; q < 8; ++q) { const u32x4 w = raw[q]; const float cur[8] = {bf_lo(w.x), bf_hi(w.x), bf_lo(w.y), bf_hi(w.y), bf_lo(w.z), bf_hi(w.z), bf_lo(w.w), bf_hi(w.w)}; float o[8];
#pragma unroll
                    for (int j = 0; j < 8; ++j) { o[j] = bb[j] + w0[j] * p0[j] + w1[j] * p1[j] + w2[j] * p2[j] + w3[j] * cur[j]; p0[j] = p1[j]; p1[j] = p2[j]; p2[j] = cur[j]; }
                    st8bf(XC + (size_t)(row0 + tb + q) * 1024 + ch0, o); } }
            if (lastc) { float* dst = samp ? C.out + O_CONV_S + (size_t)sb * 3 * 1024 : C.out + O_CONV_P + (size_t)(chunk >> 8) * 3 * 1024;
                st8f(dst + ch0, p0); st8f(dst + 1024 + ch0, p1); st8f(dst + 2048 + ch0, p2); }
        } else {
            const int gsel = ch0 >> 8, w = 2 << gsel;
            float S[8];
#pragma unroll
            for (int j = 0; j < 8; ++j) S[j] = 0.f;
            for (int tt = 1 - w; tt < 0; ++tt) { float v[8];
                if (samp) ld8f(st_pool + ((size_t)sb * 15 + 15 + tt) * 1024 + ch0, v);
                else if (t0 + tt >= 0) ld8bf(PIN + (size_t)(row0 + tt) * 1024 + ch0, v);
                else {
#pragma unroll
                    for (int j = 0; j < 8; ++j) v[j] = 0.f; }
#pragma unroll
                for (int j = 0; j < 8; ++j) S[j] += v[j]; }
            for (int tb = 0; tb < 64; tb += 8) {
                u32x4 rawc[8]; float oldv[8][8];
#pragma unroll
                for (int q = 0; q < 8; ++q) rawc[q] = *(const u32x4*)(PIN + (size_t)(row0 + tb + q) * 1024 + ch0);
#pragma unroll
                for (int q = 0; q < 8; ++q) { const int tt = tb + q - w + 1;
                    if (tt >= 0 || (!samp && t0 + tt >= 0)) ld8bf(PIN + (size_t)(row0 + tt) * 1024 + ch0, oldv[q]);
                    else if (samp) ld8f(st_pool + ((size_t)sb * 15 + 15 + tt) * 1024 + ch0, oldv[q]);
                    else {
#pragma unroll
                        for (int j = 0; j < 8; ++j) oldv[q][j] = 0.f; } }
#pragma unroll
                for (int q = 0; q < 8; ++q) { const u32x4 wv = rawc[q]; const float cur[8] = {bf_lo(wv.x), bf_hi(wv.x), bf_lo(wv.y), bf_hi(wv.y), bf_lo(wv.z), bf_hi(wv.z), bf_lo(wv.w), bf_hi(wv.w)}; float o[8];
                    const int pos = samp ? 1024 + tb + q : t0 + tb + q; const float rc = 1.0f / (float)((pos + 1 < w) ? pos + 1 : w);
#pragma unroll
                    for (int j = 0; j < 8; ++j) { S[j] += cur[j]; o[j] = S[j] * rc - cur[j]; S[j] -= oldv[q][j]; }
                    st8bf(POOLED + (size_t)(row0 + tb + q) * 1024 + ch0, o); } }
            if (lastc) { float* dst = samp ? C.out + O_POOL_S + (size_t)sb * 15 * 1024 : C.out + O_POOL_P + (size_t)(chunk >> 8) * 15 * 1024;
                for (int i = 0; i < 15; ++i) { float v[8]; ld8bf(PIN + (size_t)(row0 + 49 + i) * 1024 + ch0, v); st8f(dst + (size_t)i * 1024 + ch0, v); } }
        }
    }
}

__device__ __forceinline__ void phase_scanA(const Ctx& C) {
    const float* __restrict__ A = (const float*)(C.ws + A_B4); const bf16_t* __restrict__ U = (const bf16_t*)(A + (size_t)MT * 1024);
    float* __restrict__ cP = (float*)(C.ws + WS_SCAN); float* __restrict__ cH = cP + SCAN_WORDS;
    for (int it = C.vcu * 512 + C.tid; it < 544 * 256; it += C.G * 512) {
        const int chunk = it >> 8, ch = (it & 255) * 4; const int row0 = chunk * 64;
        f32x4 P = {1.f, 1.f, 1.f, 1.f}, H = {0.f, 0.f, 0.f, 0.f};
        for (int tb = 0; tb < 64; tb += 8) { f32x4 av[8], uv[8];
#pragma unroll
            for (int q = 0; q < 8; ++q) { av[q] = *(const f32x4*)(A + (size_t)(row0 + tb + q) * 1024 + ch); const u32x2 uw = *(const u32x2*)(U + (size_t)(row0 + tb + q) * 1024 + ch); uv[q] = (f32x4){bf_lo(uw.x), bf_hi(uw.x), bf_lo(uw.y), bf_hi(uw.y)}; }
#pragma unroll
            for (int q = 0; q < 8; ++q) { H = av[q] * H + uv[q]; P = P * av[q]; } }
        *(f32x4*)(cP + (size_t)chunk * 1024 + ch) = P; *(f32x4*)(cH + (size_t)chunk * 1024 + ch) = H;
    }
}
__device__ __forceinline__ void phase_scanB(const Ctx& C) {
    const float* __restrict__ cP = (const float*)(C.ws + WS_SCAN); const float* __restrict__ cH = cP + SCAN_WORDS; float* __restrict__ cI = (float*)(C.ws + WS_SCAN) + 2 * SCAN_WORDS;
    const int it = C.vcu * 512 + C.tid;
    if (it < 2048) { const int s = it >> 10, ch = it & 1023; float carry = 0.f;
        for (int cb = 0; cb < 256; cb += 16) { float pv[16], hv[16];
#pragma unroll
            for (int q = 0; q < 16; ++q) { const size_t o = (size_t)(s * 256 + cb + q) * 1024 + ch; pv[q] = cP[o]; hv[q] = cH[o]; }
#pragma unroll
            for (int q = 0; q < 16; ++q) { cI[(size_t)(s * 256 + cb + q) * 1024 + ch] = carry; carry = pv[q] * carry + hv[q]; } } }
}
__device__ __forceinline__ void phase_scanC(const Ctx& C) {
    const float* __restrict__ A = (const float*)(C.ws + A_B4); const bf16_t* __restrict__ U = (const bf16_t*)(A + (size_t)MT * 1024); const float* __restrict__ cI = (const float*)(C.ws + WS_SCAN) + 2 * SCAN_WORDS;
    const bf16_t* __restrict__ GG = (const bf16_t*)(C.ws + A_GG); bf16_t* __restrict__ CAT = (bf16_t*)(C.ws + A_HN); const float* hprev = C.in[5];
    for (int it = C.vcu * 512 + C.tid; it < 544 * 256; it += C.G * 512) {
        const int chunk = it >> 8, ch = (it & 255) * 4; const int row0 = chunk * 64; const bool samp = chunk >= 512;
        f32x4 h = samp ? *(const f32x4*)(hprev + (size_t)(chunk - 512) * 1024 + ch) : *(const f32x4*)(cI + (size_t)chunk * 1024 + ch);
        for (int tb = 0; tb < 64; tb += 8) { f32x4 av[8], uv[8]; u32x2 gv[8];
#pragma unroll
            for (int q = 0; q < 8; ++q) { const size_t o = (size_t)(row0 + tb + q) * 1024 + ch; av[q] = *(const f32x4*)(A + o); { const u32x2 uw = *(const u32x2*)(U + o); uv[q] = (f32x4){bf_lo(uw.x), bf_hi(uw.x), bf_lo(uw.y), bf_hi(uw.y)}; } gv[q] = *(const u32x2*)(GG + o); }
#pragma unroll
            for (int q = 0; q < 8; ++q) { h = av[q] * h + uv[q];
                u32x2 w; w.x = cvt_pk_bf16(bf_lo(gv[q].x) * h.x, bf_hi(gv[q].x) * h.y); w.y = cvt_pk_bf16(bf_lo(gv[q].y) * h.z, bf_hi(gv[q].y) * h.w);
                *(u32x2*)(CAT + (size_t)(row0 + tb + q) * 2048 + ch) = w; } }
        if (samp) *(f32x4*)(C.out + O_H_S + (size_t)(chunk - 512) * 1024 + ch) = h;
        else if ((chunk & 255) == 255) *(f32x4*)(C.out + O_H_P + (size_t)(chunk >> 8) * 1024 + ch) = h;
    }
}

__device__ __forceinline__ void phase_latent(const Ctx& C) {
    const float* CQKV = (const float*)(C.ws + A_B3); bf16_t* CQ = (bf16_t*)(C.ws + A_CQ); bf16_t* CKV = (bf16_t*)(C.ws + A_CKV); unsigned char* KP = C.ws + A_KP;
    const float* gq = C.in[25]; const float* gkv = C.in[28]; const float* rope = (const float*)(C.ws + WS_ROPE); const int lane = C.lane;
    for (int m = C.gw; m < MT; m += C.NGW) {
        const float* r = CQKV + (size_t)m * 1024; const int kvr = kvrow_of_row(m);
        { float v[8]; ld8f(r + lane * 8, v); float ss = 0.f;
#pragma unroll
          for (int j = 0; j < 8; ++j) ss += v[j] * v[j];
          const float rstd = __builtin_amdgcn_rsqf(wave_sum(ss) * (1.0f / 512) + RMS_EPS); float g[8]; ld8f(gq + lane * 8, g);
#pragma unroll
          for (int j = 0; j < 8; ++j) v[j] = v[j] * rstd * g[j];
          st8bf(CQ + (size_t)m * 512 + lane * 8, v); }
        { const f32x4 v = *(const f32x4*)(r + 512 + lane * 4); const float ss = (v.x * v.x + v.y * v.y) + (v.z * v.z + v.w * v.w);
          const float rstd = __builtin_amdgcn_rsqf(wave_sum(ss) * (1.0f / 256) + RMS_EPS); const f32x4 y = v * rstd * *(const f32x4*)(gkv + lane * 4);
          *(f32x4*)(C.out + O_CKV + (size_t)m * 256 + lane * 4) = y;
          u32x2 w; w.x = cvt_pk_bf16(y.x, y.y); w.y = cvt_pk_bf16(y.z, y.w); *(u32x2*)(CKV + (size_t)kvr * 256 + lane * 4) = w; }
        { const float x = r[768 + lane]; const float xo = __shfl_xor(x, 32); const int j = lane & 31; const float* rp = rope + (size_t)pos_of_row(m) * 64;
          const float c = rp[j], s = rp[32 + j]; const float y = (lane < 32) ? x * c - xo * s : xo * s + x * c;
          C.out[O_KPE + (size_t)m * 64 + lane] = y; KP[(size_t)kvr * 64 + lane] = (unsigned char)(cvt4_fp8(y, 0.f, 0.f, 0.f) & 0xffu); }
    }
    const size_t gt = (size_t)C.vcu * 512 + C.tid, GT = (size_t)C.G * 512;
    for (size_t i = gt; i < (size_t)32 * 1024 * 256 / 8; i += GT) { const size_t e = i * 8, rowc = e / 256, col = e % 256, b = rowc / 1024, p = rowc % 1024;
        float v[8]; ld8f(C.in[7] + e, v); st8bf(CKV + ((size_t)MP + b * 1088 + p) * 256 + col, v); }
    for (size_t i = gt; i < (size_t)32 * 1024 * 64 / 8; i += GT) { const size_t e = i * 8, rowc = e / 64, col = e % 64, b = rowc / 1024, p = rowc % 1024;
        float v[8]; ld8f(C.in[8] + e, v); u32x2 w8; w8.x = cvt4_fp8(v[0], v[1], v[2], v[3]); w8.y = cvt4_fp8(v[4], v[5], v[6], v[7]); *(u32x2*)(KP + ((size_t)MP + b * 1088 + p) * 64 + col) = w8; }
}
typedef __bf16 bf2_t __attribute__((ext_vector_type(2)));
__device__ __forceinline__ unsigned ford(float f) { const unsigned u = __float_as_uint(f); return (u & 0x80000000u) ? ~u : (u | 0x80000000u); }
__device__ __forceinline__ float funord(unsigned o) { return __uint_as_float((o & 0x80000000u) ? (o & 0x7fffffffu) : ~o); }
__device__ __forceinline__ unsigned umax(unsigned a, unsigned b) { return a > b ? a : b; }
__device__ __forceinline__ unsigned umin(unsigned a, unsigned b) { return a < b ? a : b; }
__device__ __forceinline__ void ins16(unsigned (&L)[16], unsigned x) {
#pragma unroll
    for (int i = 0; i < 16; ++i) { const unsigned t = umax(L[i], x); x = umin(L[i], x); L[i] = t; }
}
__device__ __forceinline__ void ins16p(unsigned (&K)[16], unsigned (&P)[16], unsigned key, unsigned pay) {
#pragma unroll
    for (int i = 0; i < 16; ++i) { const bool c = key > K[i]; const unsigned tk = c ? key : K[i], nk = c ? K[i] : key, tp = c ? pay : P[i], np = c ? P[i] : pay; K[i] = tk; P[i] = tp; key = nk; pay = np; }
}
__device__ __forceinline__ void sort16_desc(unsigned (&v)[16]) {
#pragma unroll
    for (int k = 2; k <= 16; k <<= 1)
#pragma unroll
        for (int j = k >> 1; j >= 1; j >>= 1)
#pragma unroll
            for (int i = 0; i < 16; ++i) { const int l = i ^ j; if (l > i) { const bool desc = ((i & k) == 0); const unsigned a = v[i], b = v[l], hi = umax(a, b), lo = umin(a, b); v[i] = desc ? hi : lo; v[l] = desc ? lo : hi; } }
}
__device__ __forceinline__ void merge16_desc(unsigned (&A)[16], const unsigned (&B)[16]) {
#pragma unroll
    for (int i = 0; i < 16; ++i) A[i] = umax(A[i], B[15 - i]);
#pragma unroll
    for (int st = 8; st >= 1; st >>= 1)
#pragma unroll
        for (int i = 0; i < 16; ++i) if ((i & st) == 0) { const unsigned a = A[i], b = A[i + st]; A[i] = umax(a, b); A[i + st] = umin(a, b); }
}
__device__ __forceinline__ void subkey_top16(const bf16_t* qrow  , const bf16_t* krow  , int hh, unsigned (&S)[16]) {
    bf16x8 qf[8];
#pragma unroll
    for (int s = 0; s < 8; ++s) qf[s] = *(const bf16x8*)(qrow + 16 * s);
    unsigned L[16];
#pragma unroll
    for (int i = 0; i < 16; ++i) L[i] = 0u;
#pragma unroll 1
    for (int kb = 0; kb < 4; ++kb) {
        bf16x8 kf[8];
#pragma unroll
        for (int s = 0; s < 8; ++s) kf[s] = *(const bf16x8*)(krow + (size_t)kb * 32 * 128 + 16 * s);
        f32x16 a = {0.f, 0.f, 0.f, 0.f, 0.f, 0.f, 0.f, 0.f, 0.f, 0.f, 0.f, 0.f, 0.f, 0.f, 0.f, 0.f};
#pragma unroll
        for (int s = 0; s < 8; ++s) a = __builtin_amdgcn_mfma_f32_32x32x16_bf16(kf[s], qf[s], a, 0, 0, 0);
        unsigned N[16];
#pragma unroll
        for (int r = 0; r < 16; ++r) { const unsigned idx = (unsigned)(32 * kb + (r & 3) + 8 * (r >> 2) + 4 * hh); N[r] = (ford(a[r]) & ~0x7fu) | idx; }
        sort16_desc(N); merge16_desc(L, N);
        asm volatile("" ::: "memory");
    }
    unsigned P[16];
#pragma unroll
    for (int i = 0; i < 16; ++i) P[i] = (unsigned)__shfl_xor((int)L[i], 32);
#pragma unroll
    for (int i = 0; i < 16; ++i) S[i] = L[i];
    merge16_desc(S, P);
}
__device__ __forceinline__ void phase_topk(const Ctx& C, int layer) {
    const bf16_t* Q = (const bf16_t*)(C.ws + A_B3); const bf16_t* KEYS = (const bf16_t*)(C.ws + WS_KEYS) + (size_t)layer * 8 * 2 * 128 * 128;
    int* IDX = (int*)(C.ws + A_B4); float* GATE = (float*)(C.ws + A_B4) + (size_t)MT * 128;
    const int lane = C.lane, r = lane & 31, hh = lane >> 5;
    for (int task = C.gw; task < (MT / 32) * 8; task += C.NGW) {
        const int tg = task >> 3, h = task & 7, m = tg * 32 + r;
        unsigned S1[16], S2[16];
        subkey_top16(Q + (size_t)m * 2048 + h * 256 + 8 * hh, KEYS + ((size_t)(h * 2 + 0) * 128 + r) * 128 + 8 * hh, hh, S1);
        subkey_top16(Q + (size_t)m * 2048 + h * 256 + 128 + 8 * hh, KEYS + ((size_t)(h * 2 + 1) * 128 + r) * 128 + 8 * hh, hh, S2);
#define CKEY(a, b) ((ford(funord(S1[a] & ~0x7fu) + funord(S2[b] & ~0x7fu)) & ~0xffu) | (unsigned)((a) << 4 | (b)))
        unsigned FK[16], G[16];
#pragma unroll
        for (int b = 0; b < 16; ++b) FK[b] = CKEY(0, b);
#pragma unroll
        for (int b = 0; b < 8; ++b) G[b] = CKEY(1, b);
#pragma unroll
        for (int b = 0; b < 5; ++b) G[8 + b] = CKEY(2, b);
#pragma unroll
        for (int b = 0; b < 3; ++b) G[13 + b] = CKEY(4, b);
        sort16_desc(G); merge16_desc(FK, G);
#pragma unroll
        for (int b = 0; b < 4; ++b) G[b] = CKEY(3, b);
#pragma unroll
        for (int b = 0; b < 2; ++b) { G[4 + b] = CKEY(5, b); G[6 + b] = CKEY(6, b); G[8 + b] = CKEY(7, b); }
#pragma unroll
        for (int a = 8; a < 14; ++a) G[2 + a] = CKEY(a, 0);
        sort16_desc(G); merge16_desc(FK, G);
        ins16(FK, CKEY(14, 0)); ins16(FK, CKEY(15, 0));
#undef CKEY
        unsigned I1p[4], I2p[4];
#pragma unroll
        for (int w = 0; w < 4; ++w) { I1p[w] = (S1[4 * w] & 0x7fu) | ((S1[4 * w + 1] & 0x7fu) << 8) | ((S1[4 * w + 2] & 0x7fu) << 16) | ((S1[4 * w + 3] & 0x7fu) << 24);
                                      I2p[w] = (S2[4 * w] & 0x7fu) | ((S2[4 * w + 1] & 0x7fu) << 8) | ((S2[4 * w + 2] & 0x7fu) << 16) | ((S2[4 * w + 3] & 0x7fu) << 24); }
        const float mx = funord(FK[0] & ~0xffu); float sum = 0.f;
#pragma unroll
        for (int i = 0; i < 16; ++i) sum += fexp(funord(FK[i] & ~0xffu) - mx);
        const float rs = 1.0f / sum;
        int oi[8]; float og[8];
#pragma unroll
        for (int i = 0; i < 8; ++i) { const unsigned key = hh ? FK[8 + i] : FK[i]; const unsigned a = (key >> 4) & 15u, b = key & 15u;
            const unsigned w1 = (a >> 2) == 0u ? I1p[0] : ((a >> 2) == 1u ? I1p[1] : ((a >> 2) == 2u ? I1p[2] : I1p[3]));
            const unsigned w2 = (b >> 2) == 0u ? I2p[0] : ((b >> 2) == 1u ? I2p[1] : ((b >> 2) == 2u ? I2p[2] : I2p[3]));
            oi[i] = (int)((((w1 >> ((a & 3u) * 8u)) & 0x7fu) << 7) | ((w2 >> ((b & 3u) * 8u)) & 0x7fu));
            og[i] = fexp(funord(key & ~0xffu) - mx) * rs; }
        const size_t o = (size_t)m * 128 + h * 16 + 8 * hh;
        *(u32x4*)(IDX + o) = (u32x4){(unsigned)oi[0], (unsigned)oi[1], (unsigned)oi[2], (unsigned)oi[3]}; *(u32x4*)(IDX + o + 4) = (u32x4){(unsigned)oi[4], (unsigned)oi[5], (unsigned)oi[6], (unsigned)oi[7]};
        *(f32x4*)(GATE + o) = (f32x4){og[0], og[1], og[2], og[3]}; *(f32x4*)(GATE + o + 4) = (f32x4){og[4], og[5], og[6], og[7]};
    }
}

template <int CTRL, int ROWMASK> __device__ __forceinline__ float dppf(float v) { return __builtin_bit_cast(float, __builtin_amdgcn_update_dpp(0, __builtin_bit_cast(int, v), CTRL, ROWMASK, 0xF, false)); }
__device__ __forceinline__ float wave_sum_u(float v) {
    v += dppf<0xB1, 0xF>(v); v += dppf<0x4E, 0xF>(v); v += dppf<0x141, 0xF>(v); v += dppf<0x140, 0xF>(v);
    v += dppf<0x142, 0xA>(v); v += dppf<0x143, 0xC>(v);
    return __builtin_bit_cast(float, __builtin_amdgcn_readlane(__builtin_bit_cast(int, v), 63));
}
struct RowSet4 { u32x4 u, v; };
__device__ __forceinline__ void load_rows4(RowSet4& R, const unsigned char* U4, const unsigned char* V4, int eid, int lane) {
    const size_t o = (size_t)eid * 1024 + lane * 16; R.u = *(const u32x4*)(U4 + o); R.v = *(const u32x4*)(V4 + o);
}
__device__ __forceinline__ void use_rows4(const u32x4 Ru, const u32x4 Rv, const float (&xf)[32], float gate, float (&out)[32]) {
    float d0 = 0.f, d1 = 0.f;
#define U4_STEP(w, b) { const f32x2 t = __builtin_amdgcn_cvt_scalef32_pk_f32_fp4(Ru[w], 1.0f, b); d0 = fmaf(xf[8 * (w) + 2 * (b)], t.x, d0); d1 = fmaf(xf[8 * (w) + 2 * (b) + 1], t.y, d1); }
#define U4_WORD(w) U4_STEP(w, 0) U4_STEP(w, 1) U4_STEP(w, 2) U4_STEP(w, 3)
    U4_WORD(0) U4_WORD(1) U4_WORD(2) U4_WORD(3)
#undef U4_WORD
#undef U4_STEP
    const float d = wave_sum_u(d0 + d1) * (1.0f / U4_SCALE);
    const float a = gelu_erf(d) * gate * (1.0f / V4_SCALE);
#define V4_STEP(w, b) { const f32x2 t = __builtin_amdgcn_cvt_scalef32_pk_f32_fp4(Rv[w], 1.0f, b); out[8 * (w) + 2 * (b)] = fmaf(a, t.x, out[8 * (w) + 2 * (b)]); out[8 * (w) + 2 * (b) + 1] = fmaf(a, t.y, out[8 * (w) + 2 * (b) + 1]); }
#define V4_WORD(w) V4_STEP(w, 0) V4_STEP(w, 1) V4_STEP(w, 2) V4_STEP(w, 3)
    V4_WORD(0) V4_WORD(1) V4_WORD(2) V4_WORD(3)
#undef V4_WORD
#undef V4_STEP
}
typedef _Float16 h16x2 __attribute__((ext_vector_type(2)));
__device__ __forceinline__ float dot_row4(const u32x4 Ru, const h16x2 (&xh)[16]) {
    float d0 = 0.f, d1 = 0.f;
#define U4_STEP(w, b, D) { const h16x2 t = __builtin_amdgcn_cvt_scalef32_pk_f16_fp4(Ru[w], 1.0f, b); D = __builtin_amdgcn_fdot2(xh[4 * (w) + (b)], t, D, false); }
#define U4_WORD(w) U4_STEP(w, 0, d0) U4_STEP(w, 1, d1) U4_STEP(w, 2, d0) U4_STEP(w, 3, d1)
    U4_WORD(0) U4_WORD(1) U4_WORD(2) U4_WORD(3)
#undef U4_WORD
#undef U4_STEP
    return wave_sum_u(d0 + d1);
}
typedef int i32x8 __attribute__((ext_vector_type(8)));
__device__ __forceinline__ float dot_row4_mfma(const u32x4 Ru, const i32x8& xhi, const i32x8& xlo, int dsel, bool dval) {
    const i32x8 a = {(int)Ru.x, (int)Ru.y, (int)Ru.z, (int)Ru.w, 0, 0, 0, 0};
    f32x4 d = {0.f, 0.f, 0.f, 0.f};
    d = __builtin_amdgcn_mfma_scale_f32_16x16x128_f8f6f4(a, xhi, d, 4, 0, 0, 127, 0, 127);
    d = __builtin_amdgcn_mfma_scale_f32_16x16x128_f8f6f4(a, xlo, d, 4, 0, 0, 127, 0, 123);
    float v = dsel == 0 ? d[0] : (dsel == 1 ? d[1] : (dsel == 2 ? d[2] : d[3]));
    v = dval ? v : 0.f;
    return wave_sum_u(v);
}
__device__ __forceinline__ void axpy_row4(const u32x4 Rv, float a, float (&out)[32]) {
#define V4_STEP(w, b) { const f32x2 t = __builtin_amdgcn_cvt_scalef32_pk_f32_fp4(Rv[w], 1.0f, b); out[8 * (w) + 2 * (b)] = fmaf(a, t.x, out[8 * (w) + 2 * (b)]); out[8 * (w) + 2 * (b) + 1] = fmaf(a, t.y, out[8 * (w) + 2 * (b) + 1]); }
#define V4_WORD(w) V4_STEP(w, 0) V4_STEP(w, 1) V4_STEP(w, 2) V4_STEP(w, 3)
    V4_WORD(0) V4_WORD(1) V4_WORD(2) V4_WORD(3)
#undef V4_WORD
#undef V4_STEP
}
__device__ __forceinline__ void phase_gather(const Ctx& C, int layer) {
    const bf16_t* HN2 = (const bf16_t*)(C.ws + A_B2); const unsigned char* U4 = C.ws + WS_U + (size_t)layer * bq::TAB_L1; const unsigned char* V4 = C.ws + WS_V + (size_t)layer * bq::TAB_L1;
    const int* IDX = (const int*)(C.ws + A_B4); const float* GATE = (const float*)(C.ws + A_B4) + (size_t)MT * 128;
    const float* mod = (const float*)(C.ws + WS_MOD); float* X = C.out + O_Y; bf16_t* HN = (bf16_t*)(C.ws + A_HN);
    const int lane = C.lane;
    int m = C.gw; if (m >= MT) return;
    LAS unsigned char* ring = C.lds + C.wave * 16384;
    int i0 = IDX[(size_t)m * 128 + lane], i1 = IDX[(size_t)m * 128 + 64 + lane];
    float g0 = GATE[(size_t)m * 128 + lane], g1 = GATE[(size_t)m * 128 + 64 + lane];
    u32x2 xw[8];
#pragma unroll
    for (int b = 0; b < 8; ++b) xw[b] = *(const u32x2*)(HN2 + (size_t)m * 2048 + 256 * b + 4 * lane);
#pragma unroll
    for (int b = 0; b < 8; ++b) asm volatile("" : "+v"(xw[b]));
    asm volatile("" : "+v"(i0), "+v"(i1), "+v"(g0), "+v"(g1));
    asm volatile("s_waitcnt vmcnt(0)" ::: "memory");
#define SB() __builtin_amdgcn_sched_barrier(0)
    const unsigned lo16 = (unsigned)lane * 16u;
#define ROW_DMA(T, eid_, s_) __builtin_amdgcn_global_load_lds((const unsigned*)((const char*)((T) + (size_t)(eid_) * 1024) + lo16), (LAS unsigned*)(ring + ((s_) & 15) * 1024), 16, 0, 0)
#define EIDC(j) __builtin_amdgcn_readlane(((j) < 64) ? i0 : i1, (j) & 63)
#pragma unroll
    for (int j = 0; j < 14; ++j) ROW_DMA(U4, __builtin_amdgcn_readlane(i0, j), j);
    for (;;) {
        const int mn = m + C.NGW; const bool has_next = mn < MT; const int mq = has_next ? mn : m;
        int ni0, ni1; float ng0, ng1; u32x2 nx[8];
        int lt = lane; asm volatile("" : "+v"(lt));
        { const int* ip = IDX + (size_t)mq * 128 + lt; const float* gp = GATE + (size_t)mq * 128 + lt; const bf16_t* xp = HN2 + (size_t)mq * 2048 + 4 * lt;
          asm volatile("global_load_dword %0, %1, off" : "=v"(ni0) : "v"(ip) : "memory");
          asm volatile("global_load_dword %0, %1, off offset:256" : "=v"(ni1) : "v"(ip) : "memory");
          asm volatile("global_load_dword %0, %1, off" : "=v"(ng0) : "v"(gp) : "memory");
          asm volatile("global_load_dword %0, %1, off offset:256" : "=v"(ng1) : "v"(gp) : "memory");
          asm volatile("global_load_dwordx2 %0, %1, off" : "=v"(nx[0]) : "v"(xp) : "memory");
          asm volatile("global_load_dwordx2 %0, %1, off offset:512" : "=v"(nx[1]) : "v"(xp) : "memory");
          asm volatile("global_load_dwordx2 %0, %1, off offset:1024" : "=v"(nx[2]) : "v"(xp) : "memory");
          asm volatile("global_load_dwordx2 %0, %1, off offset:1536" : "=v"(nx[3]) : "v"(xp) : "memory");
          asm volatile("global_load_dwordx2 %0, %1, off offset:2048" : "=v"(nx[4]) : "v"(xp) : "memory");
          asm volatile("global_load_dwordx2 %0, %1, off offset:2560" : "=v"(nx[5]) : "v"(xp) : "memory");
          asm volatile("global_load_dwordx2 %0, %1, off offset:3072" : "=v"(nx[6]) : "v"(xp) : "memory");
          asm volatile("global_load_dwordx2 %0, %1, off offset:3584" : "=v"(nx[7]) : "v"(xp) : "memory"); }
        i32x8 xhi, xlo;
#pragma unroll
        for (int b = 0; b < 8; ++b) { const float x0 = bf_lo(xw[b].x), x1 = bf_hi(xw[b].x), x2 = bf_lo(xw[b].y), x3 = bf_hi(xw[b].y);
            const float c0 = fminf(fmaxf(x0, -448.f), 448.f), c1 = fminf(fmaxf(x1, -448.f), 448.f), c2 = fminf(fmaxf(x2, -448.f), 448.f), c3 = fminf(fmaxf(x3, -448.f), 448.f);
            int th = 0; th = __builtin_amdgcn_cvt_pk_fp8_f32(c0, c1, th, false); th = __builtin_amdgcn_cvt_pk_fp8_f32(c2, c3, th, true);
            const f32x2 h01 = __builtin_amdgcn_cvt_pk_f32_fp8(th, false), h23 = __builtin_amdgcn_cvt_pk_f32_fp8(th, true);
            int tl = 0; tl = __builtin_amdgcn_cvt_pk_fp8_f32((c0 - h01.x) * 16.f, (c1 - h01.y) * 16.f, tl, false); tl = __builtin_amdgcn_cvt_pk_fp8_f32((c2 - h23.x) * 16.f, (c3 - h23.y) * 16.f, tl, true);
            xhi[b] = th; xlo[b] = tl; }
        const int dsel = lane & 3; const bool dval = ((lane & 15) >> 2) == (lane >> 4);
        { const int jj = lane & 15, gg = lane >> 4, srcA = (jj + 16 * (gg >> 1)) << 2, srcB = (jj + 16 * (2 + (gg >> 1))) << 2; const bool odd = gg & 1;
          i32x8 nh, nl;
#pragma unroll
          for (int d = 0; d < 4; ++d) {
              const int a0 = __builtin_amdgcn_ds_bpermute(srcA, xhi[d]), a1 = __builtin_amdgcn_ds_bpermute(srcA, xhi[4 + d]), b0 = __builtin_amdgcn_ds_bpermute(srcB, xhi[d]), b1 = __builtin_amdgcn_ds_bpermute(srcB, xhi[4 + d]);
              nh[d] = odd ? a1 : a0; nh[4 + d] = odd ? b1 : b0;
              const int c0 = __builtin_amdgcn_ds_bpermute(srcA, xlo[d]), c1 = __builtin_amdgcn_ds_bpermute(srcA, xlo[4 + d]), e0 = __builtin_amdgcn_ds_bpermute(srcB, xlo[d]), e1 = __builtin_amdgcn_ds_bpermute(srcB, xlo[4 + d]);
              nl[d] = odd ? c1 : c0; nl[4 + d] = odd ? e1 : e0; }
          xhi = nh; xlo = nl; }
        float dv0 = 0.f, dv1 = 0.f;
#define U_ITER2(e, VMN, DV, NEXT_T, NEXT_E0, NEXT_E1) do { ROW_DMA(NEXT_T, NEXT_E0, (e) + 14); ROW_DMA(NEXT_T, NEXT_E1, (e) + 15); asm volatile("s_waitcnt vmcnt(" #VMN ")" ::: "memory"); \
            const u32x4 ru0 = *(const LAS u32x4*)(ring + ((e) & 15) * 1024 + lo16), ru1 = *(const LAS u32x4*)(ring + (((e) + 1) & 15) * 1024 + lo16); \
            const float da = dot_row4_mfma(ru0, xhi, xlo, dsel, dval), db = dot_row4_mfma(ru1, xhi, xlo, dsel, dval); \
            DV = (lane == ((e) & 63)) ? da : DV; DV = (lane == (((e) + 1) & 63)) ? db : DV; } while (0)
#pragma unroll 1
        for (int e = 0; e < 14; e += 2) U_ITER2(e, 26, dv0, U4, EIDC(e + 14), EIDC(e + 15));
#pragma unroll 1
        for (int e = 14; e < 64; e += 2) U_ITER2(e, 14, dv0, U4, EIDC(e + 14), EIDC(e + 15));
#pragma unroll 1
        for (int e = 64; e < 114; e += 2) U_ITER2(e, 14, dv1, U4, EIDC(e + 14), EIDC(e + 15));
#pragma unroll 1
        for (int e = 114; e < 128; e += 2) U_ITER2(e, 14, dv1, V4, EIDC(e - 114), EIDC(e - 113));
#undef U_ITER2
        asm volatile("" : "+v"(ni0), "+v"(ni1), "+v"(ng0), "+v"(ng1));
#pragma unroll
        for (int b = 0; b < 8; ++b) asm volatile("" : "+v"(nx[b]));
        const float av0 = gelu_erf(dv0 * (1.0f / U4_SCALE)) * g0 * (1.0f / V4_SCALE), av1 = gelu_erf(dv1 * (1.0f / U4_SCALE)) * g1 * (1.0f / V4_SCALE);
        float out[32];
#pragma unroll
        for (int i = 0; i < 32; ++i) out[i] = 0.f;
#define V_ITER2(e, AV, NEXT_T, NEXT_E0, NEXT_E1) do { ROW_DMA(NEXT_T, NEXT_E0, (e) + 14); ROW_DMA(NEXT_T, NEXT_E1, (e) + 15); asm volatile("s_waitcnt vmcnt(14)" ::: "memory"); \
            const u32x4 rv0 = *(const LAS u32x4*)(ring + ((e) & 15) * 1024 + lo16), rv1 = *(const LAS u32x4*)(ring + (((e) + 1) & 15) * 1024 + lo16); \
            const float a0 = __builtin_bit_cast(float, __builtin_amdgcn_readlane(__builtin_bit_cast(int, AV), (e) & 63)), a1 = __builtin_bit_cast(float, __builtin_amdgcn_readlane(__builtin_bit_cast(int, AV), ((e) + 1) & 63)); \
            axpy_row4(rv0, a0, out); axpy_row4(rv1, a1, out); } while (0)
#pragma unroll 1
        for (int e = 0; e < 64; e += 2) V_ITER2(e, av0, V4, EIDC(e + 14), EIDC(e + 15));
#pragma unroll 1
        for (int e = 64; e < 114; e += 2) V_ITER2(e, av1, V4, EIDC(e + 14), EIDC(e + 15));
#pragma unroll 1
        for (int e = 114; e < 128; e += 2) V_ITER2(e, av1, U4, __builtin_amdgcn_readlane(ni0, e - 114), __builtin_amdgcn_readlane(ni0, e - 113));
#undef V_ITER2
        int le = lane; asm volatile("" : "+v"(le));
        const int sq = seq_of_row(m); const float* g2 = mod + ((size_t)layer * NSEQ + sq) * 12288 + 5 * 2048; float* xr = X + (size_t)m * DM;
        float ss = 0.f;
#pragma unroll
        for (int hb = 0; hb < 2; ++hb) {
            f32x4 xo[4], gg[4];
#pragma unroll
            for (int b = 0; b < 4; ++b) { const int c = 256 * (4 * hb + b) + 4 * le; xo[b] = *(const f32x4*)(xr + c); gg[b] = *(const f32x4*)(g2 + c); }
            SB();
#pragma unroll
            for (int b = 0; b < 4; ++b) {
#pragma unroll
                for (int j = 0; j < 4; ++j) { const float v = xo[b][j] + gg[b][j] * out[4 * (4 * hb + b) + j]; out[4 * (4 * hb + b) + j] = v; ss += v * v; } }
            SB();
        }
        const float rstd = __builtin_amdgcn_rsqf(wave_sum(ss) * (1.0f / DM) + RMS_EPS);
        if (layer == 0) {
            const float* n1g = C.in[11] + 2048; const float* mp = mod + ((size_t)1 * NSEQ + sq) * 12288;
#pragma unroll
            for (int hb = 0; hb < 2; ++hb) {
                f32x4 gv[4], sh[4], sc[4];
#pragma unroll
                for (int b = 0; b < 4; ++b) { const int c = 256 * (4 * hb + b) + 4 * le; gv[b] = *(const f32x4*)(n1g + c); sh[b] = *(const f32x4*)(mp + c); sc[b] = *(const f32x4*)(mp + 2048 + c); }
                SB();
#pragma unroll
                for (int b = 0; b < 4; ++b) { const int bb = 4 * hb + b, c = 256 * bb + 4 * le;
                    const f32x4 xs = {out[4 * bb], out[4 * bb + 1], out[4 * bb + 2], out[4 * bb + 3]}; const f32x4 y = xs * rstd * gv[b] * (sc[b] + 1.0f) + sh[b];
                    *(f32x4*)(xr + c) = xs; u32x2 w; w.x = cvt_pk_bf16(y[0], y[1]); w.y = cvt_pk_bf16(y[2], y[3]); *(u32x2*)(HN + (size_t)m * DM + c) = w; }
                SB();
            }
        } else {
            const float* fg = C.in[35];
            f32x4 gv[8];
#pragma unroll
            for (int b = 0; b < 8; ++b) gv[b] = *(const f32x4*)(fg + 256 * b + 4 * le);
            SB();
#pragma unroll
            for (int b = 0; b < 8; ++b) { const int c = 256 * b + 4 * le; const f32x4 xs = {out[4 * b], out[4 * b + 1], out[4 * b + 2], out[4 * b + 3]};
                *(f32x4*)(xr + c) = xs * rstd * gv[b]; }
        }
        if (!has_next) break;
        m = mn; i0 = ni0; i1 = ni1; g0 = ng0; g1 = ng1;
#pragma unroll
        for (int b = 0; b < 8; ++b) xw[b] = nx[b];
    }
    asm volatile("s_waitcnt vmcnt(0)" ::: "memory");
#undef ROW_DMA
#undef EIDC
#undef SB
}
namespace att {
constexpr int SHM_K = 64 * 208, SHM_V = 64 * 256;
constexpr int OFF_K = 0, OFF_V = 2 * SHM_K, OFF_WS = 2 * SHM_K + 2 * SHM_V;
constexpr float SCALE = 0.07216878364870322f;
constexpr float THR = 8.f;
__device__ __forceinline__ int crow(int r, int hi) { return (r & 3) + 8 * (r >> 2) + 4 * hi; }
constexpr float THR2 = THR * 1.4426950408889634f;
__device__ __forceinline__ void partialSM(f32x16& p0, f32x16& p1, float& mref, f32x16& negm, float& alpha, bool first) {
    float pmax = p0[0];
#pragma unroll
    for (int r = 1; r < 16; ++r) pmax = fmaxf(pmax, p0[r]);
#pragma unroll
    for (int r = 0; r < 16; ++r) pmax = fmaxf(pmax, p1[r]);
    { auto rr = __builtin_amdgcn_permlane32_swap(__float_as_uint(pmax), __float_as_uint(pmax), false, false);
      pmax = fmaxf(__uint_as_float(rr[0]), __uint_as_float(rr[1])); }
    if (__builtin_expect(!first && __all(pmax <= THR2), 1)) { alpha = 1.f; }
    else { const float dl = first ? pmax : fmaxf(pmax, 0.f); alpha = first ? 1.f : __builtin_amdgcn_exp2f(-dl); mref += dl;
#pragma unroll
        for (int r = 0; r < 16; ++r) { negm[r] = -mref; p0[r] -= dl; p1[r] -= dl; }
        asm volatile("" : "+v"(negm)); }
#pragma unroll
    for (int r = 0; r < 16; ++r) p0[r] = __builtin_amdgcn_exp2f(p0[r]);
#pragma unroll
    for (int r = 0; r < 16; ++r) p1[r] = __builtin_amdgcn_exp2f(p1[r]);
}
__device__ __forceinline__ void finishSM(const f32x16& p0, const f32x16& p1, float alpha, float& l_reg, bf16x8& pa0, bf16x8& pa1, bf16x8& pa2, bf16x8& pa3) {
    float ps = 0;
#pragma unroll
    for (int r = 0; r < 16; ++r) ps += p0[r];
#pragma unroll
    for (int r = 0; r < 16; ++r) ps += p1[r];
    { auto rr = __builtin_amdgcn_permlane32_swap(__float_as_uint(ps), __float_as_uint(ps), false, false);
      ps = __uint_as_float(rr[0]) + __uint_as_float(rr[1]); }
    l_reg = l_reg * alpha + ps;
#define PK4(P, BASE, OUT) do { unsigned a0 = cvt_pk_bf16(P[BASE + 0], P[BASE + 1]), a1 = cvt_pk_bf16(P[BASE + 2], P[BASE + 3]);   \
    unsigned b0 = cvt_pk_bf16(P[BASE + 4], P[BASE + 5]), b1 = cvt_pk_bf16(P[BASE + 6], P[BASE + 7]);                              \
    auto r0 = __builtin_amdgcn_permlane32_swap(a0, b0, false, false); auto r1 = __builtin_amdgcn_permlane32_swap(a1, b1, false, false); \
    u32x4 w = {r0[0], r1[0], r0[1], r1[1]}; OUT = __builtin_bit_cast(bf16x8, w); } while (0)
    PK4(p0, 0, pa0); PK4(p0, 8, pa1); PK4(p1, 0, pa2); PK4(p1, 8, pa3);
#undef PK4
}
template <int OFF> __device__ __forceinline__ bf16x8 k_read(int addr) { bf16x8 r; asm volatile("ds_read_b128 %0, %1 offset:%2" : "=v"(r) : "v"(addr), "i"(OFF) : "memory"); return r; }
template <int I> __device__ __forceinline__ bf16x8 kfrag(const int (&kad)[4]) { constexpr int d0 = I >> 1, half = I & 1; return k_read<(d0 >> 2) * 128 + half * 12288>(kad[d0 & 3]); }
__device__ __forceinline__ void packSM(const f32x16& p0, const f32x16& p1, bf16x8& pa0, bf16x8& pa1, bf16x8& pa2, bf16x8& pa3) {
#define PK4(P, BASE, OUT) do { unsigned a0 = cvt_pk_bf16(P[BASE + 0], P[BASE + 1]), a1 = cvt_pk_bf16(P[BASE + 2], P[BASE + 3]);   \
    unsigned b0 = cvt_pk_bf16(P[BASE + 4], P[BASE + 5]), b1 = cvt_pk_bf16(P[BASE + 6], P[BASE + 7]);                              \
    auto r0 = __builtin_amdgcn_permlane32_swap(a0, b0, false, false); auto r1 = __builtin_amdgcn_permlane32_swap(a1, b1, false, false); \
    u32x4 w = {r0[0], r1[0], r0[1], r1[1]}; OUT = __builtin_bit_cast(bf16x8, w); } while (0)
    PK4(p0, 0, pa0); PK4(p0, 8, pa1); PK4(p1, 0, pa2); PK4(p1, 8, pa3);
#undef PK4
}
__device__ __forceinline__ int v_rd_base(int lane) { return ((lane & 3) << 3) | (((lane >> 2) & 3) << 6) | (((lane >> 4) & 1) << 5) | (((lane >> 5) & 1) << 8); }
constexpr int v_rd_off(int d0, int ks, int half) { return d0 * 512 + ks * 4096 + half * 2048; }
template <int OFF> __device__ __forceinline__ s16x4 tr_read(int vb) {
    s16x4 r; asm volatile("ds_read_b64_tr_b16 %0, %1 offset:%2" : "=&v"(r) : "v"(vb), "i"(OFF) : "memory"); return r;
}
template <int D0> __device__ __forceinline__ void pv_one(f32x16& od, int vb, bf16x8 pa0, bf16x8 pa1, bf16x8 pa2, bf16x8 pa3) {
    const s16x4 l0 = tr_read<v_rd_off(D0, 0, 0)>(vb), h0 = tr_read<v_rd_off(D0, 0, 1)>(vb), l1 = tr_read<v_rd_off(D0, 1, 0)>(vb), h1 = tr_read<v_rd_off(D0, 1, 1)>(vb);
    const s16x4 l2 = tr_read<v_rd_off(D0, 2, 0)>(vb), h2 = tr_read<v_rd_off(D0, 2, 1)>(vb), l3 = tr_read<v_rd_off(D0, 3, 0)>(vb), h3 = tr_read<v_rd_off(D0, 3, 1)>(vb);
    asm volatile("s_waitcnt lgkmcnt(0)" ::: "memory"); __builtin_amdgcn_sched_barrier(0);
#define PKV(L, H) (bf16x8){L[0], L[1], L[2], L[3], H[0], H[1], H[2], H[3]}
    od = __builtin_amdgcn_mfma_f32_32x32x16_bf16(pa0, PKV(l0, h0), od, 0, 0, 0);
    od = __builtin_amdgcn_mfma_f32_32x32x16_bf16(pa1, PKV(l1, h1), od, 0, 0, 0);
    od = __builtin_amdgcn_mfma_f32_32x32x16_bf16(pa2, PKV(l2, h2), od, 0, 0, 0);
    od = __builtin_amdgcn_mfma_f32_32x32x16_bf16(pa3, PKV(l3, h3), od, 0, 0, 0);
#undef PKV
}
struct AUnit { int qrow0, kvrow0, ntiles, head, vis0, nact, rev; };

__device__ __forceinline__ bool next_unit(int i, int vcu, int G, AUnit& u) {
    int flat;
    if (G == 256) {
        if (i >= 10) return false;
        if (i < 8) { const int bh = vcu >> 3, s = vcu & 7, base = 16 * (i >> 1); const int qb = (i & 1) ? base + 15 - s : base + s; flat = bh * 64 + qb; }
        else flat = 2048 + vcu * 2 + (i - 8);
    } else { flat = i * G + vcu; if (flat >= 2560) return false; }
    u.rev = (G == 256 && i < 8) ? (i & 1) : 0;
    if (flat < 2048) { const int bh = flat >> 6, qb = flat & 63, b = bh >> 4; u.head = bh & 15; u.qrow0 = b * 16384 + qb * 256; u.kvrow0 = b * 16384; u.ntiles = 4 * qb + 4; u.vis0 = 4 * qb; u.nact = 8; }
    else { const int f = flat - 2048, b = f >> 4; u.head = f & 15; u.qrow0 = MP + b * 64; u.kvrow0 = MP + b * 1088; u.ntiles = 17; u.vis0 = 1 << 20; u.nact = 2; }
    return true;
}

__device__ __forceinline__ void attn_phase(const Ctx& C) {
    bf16_t* Qn = (bf16_t*)(C.ws + A_HN);
    const unsigned char* Q8 = C.ws + A_Q8; const unsigned char* Kn = C.ws + A_KN; const bf16_t* Vv = (const bf16_t*)(C.ws + A_VV);
    LAS unsigned char* lds = C.lds; const int wid = C.wave, lane = C.lane, r32 = lane & 31, hi = lane >> 5;
    LAS float* wsp = (LAS float*)(lds + OFF_WS) + wid * 64; LAS float* li_l = wsp; LAS float* al_l = wsp + 32;
    unsigned ka[2], kst[2]; bool kisn[2];
#pragma unroll
    for (int i = 0; i < 2; ++i) { const int o = ((wid + 8 * i) * 64 + lane) * 16, row = (o / 208) & 63, c = (o % 208) >> 4;
        kisn[i] = !(c >= 8 && c < 12); ka[i] = kisn[i] ? (unsigned)(row * 2048 + (c < 8 ? c : 0) * 16) : (unsigned)(A_KP - A_KN) + (unsigned)(row * 64 + (c - 8) * 16); kst[i] = kisn[i] ? 64u * 2048u : 64u * 64u; }
    const bool kp2 = wid < 5;
    unsigned va[2];
#pragma unroll
    for (int i = 0; i < 2; ++i) { const int by = ((wid * 2 + i) * 64 + lane) * 16, sub = by >> 9, within = by & 511, kk = (sub >> 2) * 8 + (within >> 6), cc = (sub & 3) * 32 + ((within & 63) >> 1);
        const int k = (kk & ~0xC) | ((kk & 4) << 1) | ((kk & 8) >> 1); va[i] = (unsigned)(k * 4096 + cc * 2); }
    const LAS unsigned char* kfr0 = lds + OFF_K + r32 * 208 + 32 * hi;
    const int vb0 = (int)(uintptr_t)(lds + OFF_V) + v_rd_base(lane);
#define ATT_BAR() __builtin_amdgcn_s_barrier()
#define ATT_ISSUE(j, kb, vbi) do { \
        __builtin_amdgcn_global_load_lds((const unsigned*)((const char*)Kn + kc[0]), (LAS unsigned*)(lds + OFF_K + (kb) * SHM_K + wid * 1024), 16, 0, 0); kc[0] += kst[0] * (unsigned)kdir; \
        if (kp2) { __builtin_amdgcn_global_load_lds((const unsigned*)((const char*)Kn + kc[1]), (LAS unsigned*)(lds + OFF_K + (kb) * SHM_K + (wid + 8) * 1024), 16, 0, 0); kc[1] += kst[1] * (unsigned)kdir; } \
      _Pragma("unroll") for (int _i = 0; _i < 2; ++_i) { \
        __builtin_amdgcn_global_load_lds((const unsigned*)((const char*)Vv + vc[_i]), (LAS unsigned*)(lds + OFF_V + (vbi) * SHM_V + (wid * 2 + _i) * 1024), 16, 0, 0); vc[_i] += (unsigned)(64 * 4096 * kdir); } } while (0)
#define PV_STEP(I, PA, L, H, WN) do { asm volatile("s_waitcnt lgkmcnt(" #WN ")" : "+v"(L), "+v"(H) :: "memory"); \
        o[(I) >> 2] = __builtin_amdgcn_mfma_f32_32x32x16_bf16(PA, ((bf16x8){L[0], L[1], L[2], L[3], H[0], H[1], H[2], H[3]}), o[(I) >> 2], 0, 0, 0); \
        if ((I) + 4 < 16) { L = tr_read<v_rd_off((((I) + 4) & 15) >> 2, (I) & 3, 0)>(vb); H = tr_read<v_rd_off((((I) + 4) & 15) >> 2, (I) & 3, 1)>(vb); } \
        __builtin_amdgcn_sched_barrier(0); } while (0)
#define PV_HEAD(VBI) do { vb = vb0 + (VBI) * SHM_V; \
      l0 = tr_read<v_rd_off(0, 0, 0)>(vb); h0 = tr_read<v_rd_off(0, 0, 1)>(vb); l1 = tr_read<v_rd_off(0, 1, 0)>(vb); h1 = tr_read<v_rd_off(0, 1, 1)>(vb); \
      l2 = tr_read<v_rd_off(0, 2, 0)>(vb); h2 = tr_read<v_rd_off(0, 2, 1)>(vb); l3 = tr_read<v_rd_off(0, 3, 0)>(vb); h3 = tr_read<v_rd_off(0, 3, 1)>(vb); } while (0)
#define PV_BODY() do { \
      __builtin_amdgcn_s_setprio(1); PV_STEP(0, pa0, l0, h0, 6);  PV_STEP(1, pa1, l1, h1, 6);  PV_STEP(2, pa2, l2, h2, 6);  PV_STEP(3, pa3, l3, h3, 6); \
      PV_STEP(4, pa0, l0, h0, 6);  PV_STEP(5, pa1, l1, h1, 6);  PV_STEP(6, pa2, l2, h2, 6);  PV_STEP(7, pa3, l3, h3, 6); \
      PV_STEP(8, pa0, l0, h0, 6);  PV_STEP(9, pa1, l1, h1, 6);  PV_STEP(10, pa2, l2, h2, 6); PV_STEP(11, pa3, l3, h3, 6); \
      PV_STEP(12, pa0, l0, h0, 6); PV_STEP(13, pa1, l1, h1, 4); PV_STEP(14, pa2, l2, h2, 2); PV_STEP(15, pa3, l3, h3, 0); __builtin_amdgcn_s_setprio(0); } while (0)
#define ATT_PV(VBI) do { PV_HEAD(VBI); PV_BODY(); } while (0)
    AUnit u;
#ifndef PROBE_ATT
#define PROBE_ATT 0
#endif
#if PROBE_ATT
    for (int ui2 = 0; next_unit(ui2 >> 1, C.vcu, C.G, u); ++ui2) { const bool dummy = !(ui2 & 1);
#else
    for (int ui = 0; next_unit(ui, C.vcu, C.G, u); ++ui) { const bool dummy = false;
#endif
        const bool active = wid < u.nact; const int vis = u.vis0 + (wid >> 1);
        const int qrow = u.qrow0 + wid * 32 + r32;
        i32x8 qf[3];
        if (active) { const unsigned char* qp = Q8 + (size_t)qrow * 3072 + u.head * 192 + 32 * hi;
#pragma unroll
            for (int s = 0; s < 3; ++s) { const u32x4 a = *(const u32x4*)(qp + 64 * s), b = *(const u32x4*)(qp + 64 * s + 16);
                qf[s] = (i32x8){(int)a.x, (int)a.y, (int)a.z, (int)a.w, (int)b.x, (int)b.y, (int)b.z, (int)b.w}; }
        } else {
#pragma unroll
            for (int s = 0; s < 3; ++s) qf[s] = (i32x8){0, 0, 0, 0, 0, 0, 0, 0};
        }
#pragma unroll
        for (int s = 0; s < 3; ++s) asm volatile("" : "+v"(qf[s]));
        float mref = 0.f, l_reg = 0.f; f32x16 o[4]; f32x16 negm;
#pragma unroll
        for (int r = 0; r < 16; ++r) negm[r] = 0.f;
        asm volatile("" : "+v"(negm));
#pragma unroll
        for (int d = 0; d < 4; ++d)
#pragma unroll
            for (int r = 0; r < 16; ++r) o[d][r] = 0.f;
        bf16x8 pa0, pa1, pa2, pa3;
        const int NT = u.ntiles;
        const int kdir = u.rev ? -1 : 1, t0 = u.rev ? u.ntiles - 1 : 0;
        bool started = false;
        unsigned kc[2], vc[2];
#pragma unroll
        for (int i = 0; i < 2; ++i) kc[i] = ka[i] + (kisn[i] ? (unsigned)u.kvrow0 * 2048u + (unsigned)u.head * 128u : (unsigned)u.kvrow0 * 64u) + kst[i] * (unsigned)t0;
#pragma unroll
        for (int i = 0; i < 2; ++i) vc[i] = va[i] + (unsigned)u.kvrow0 * 4096u + (unsigned)u.head * 256u + (unsigned)(64 * 4096) * (unsigned)t0;
        ATT_ISSUE(0, 0, 0);
        asm volatile("s_waitcnt vmcnt(0)" ::: "memory");
        ATT_BAR();
        int vb; s16x4 l0, h0, l1, h1, l2, h2, l3, h3;
        for (int j = 0; j < NT; ++j) {
            const int buf = j & 1;
            const int jt = u.rev ? NT - 1 - j : j;
            const bool doQK = active && jt <= vis;
            if (j + 1 < NT) ATT_ISSUE(j + 1, buf ^ 1, buf ^ 1);
            if (doQK) {
                f32x16 p0, p1;
                {
                    const LAS unsigned char* kf = kfr0 + buf * SHM_K;
                    i32x8 ka0[3], ka1[3];
#pragma unroll
                    for (int s = 0; s < 3; ++s) { const u32x4 a = *(const LAS u32x4*)(kf + 64 * s), b = *(const LAS u32x4*)(kf + 64 * s + 16), c = *(const LAS u32x4*)(kf + 32 * 208 + 64 * s), d = *(const LAS u32x4*)(kf + 32 * 208 + 64 * s + 16);
                        ka0[s] = (i32x8){(int)a.x, (int)a.y, (int)a.z, (int)a.w, (int)b.x, (int)b.y, (int)b.z, (int)b.w}; ka1[s] = (i32x8){(int)c.x, (int)c.y, (int)c.z, (int)c.w, (int)d.x, (int)d.y, (int)d.z, (int)d.w}; }
                    __builtin_amdgcn_s_setprio(1);
                    p0 = __builtin_amdgcn_mfma_scale_f32_32x32x64_f8f6f4(ka0[0], qf[0], negm, 0, 0, 0, 127, 0, 127);
                    p1 = __builtin_amdgcn_mfma_scale_f32_32x32x64_f8f6f4(ka1[0], qf[0], negm, 0, 0, 0, 127, 0, 127);
                    p0 = __builtin_amdgcn_mfma_scale_f32_32x32x64_f8f6f4(ka0[1], qf[1], p0, 0, 0, 0, 127, 0, 127);
                    p1 = __builtin_amdgcn_mfma_scale_f32_32x32x64_f8f6f4(ka1[1], qf[1], p1, 0, 0, 0, 127, 0, 127);
                    p0 = __builtin_amdgcn_mfma_scale_f32_32x32x64_f8f6f4(ka0[2], qf[2], p0, 0, 0, 0, 127, 0, 127);
                    p1 = __builtin_amdgcn_mfma_scale_f32_32x32x64_f8f6f4(ka1[2], qf[2], p1, 0, 0, 0, 127, 0, 127);
                    __builtin_amdgcn_s_setprio(0);
                }
                if ((PROBE_ATT == 2 || PROBE_ATT == 5) && dummy) { packSM(p0, p1, pa0, pa1, pa2, pa3); } else {
                float alpha; partialSM(p0, p1, mref, negm, alpha, !started); started = true;
                if (__any(alpha < 1.f)) { if (hi == 0) al_l[r32] = alpha; asm volatile("s_waitcnt lgkmcnt(0)" ::: "memory");
#pragma unroll
                    for (int r = 0; r < 16; ++r) { const float al = al_l[crow(r, hi)];
#pragma unroll
                        for (int d = 0; d < 4; ++d) o[d][r] *= al; } }
                finishSM(p0, p1, alpha, l_reg, pa0, pa1, pa2, pa3);
                }
                if (!((PROBE_ATT == 4 || PROBE_ATT == 5) && dummy)) ATT_PV(buf);
            }
            asm volatile("s_waitcnt vmcnt(0) lgkmcnt(0)" ::: "memory");
            ATT_BAR();
        }
        if (active && !dummy) {
            if (hi == 0) li_l[r32] = l_reg; asm volatile("s_waitcnt lgkmcnt(0)" ::: "memory");
            unsigned char* Ow = (unsigned char*)Qn + (size_t)(u.qrow0 + wid * 32) * 2048 + u.head * 128;
#pragma unroll
            for (int r = 0; r < 16; ++r) { const int orow = crow(r, hi); const float rl = __builtin_amdgcn_rcpf(li_l[orow]);
#pragma unroll
                for (int d0 = 0; d0 < 4; ++d0) { const unsigned w = cvt4_fp8(o[d0][r] * rl, 0.f, 0.f, 0.f); Ow[(size_t)orow * 2048 + d0 * 32 + r32] = (unsigned char)(w & 0xffu); } }
        }
    }
#undef ATT_BAR
#undef ATT_ISSUE
#undef ATT_PV
#undef PV_STEP
#undef PV_HEAD
#undef PV_BODY
}
}
#ifndef MK_SPLIT
#define MK_SPLIT 0
#endif
constexpr int N_PHASES = 22;

__global__ void __launch_bounds__(512, 2) mega_fwd(Args args) {
    extern __shared__ __attribute__((aligned(16))) unsigned char lds_raw[];
    Ctx C;
    C.lds = (LAS unsigned char*)lds_raw;
    C.tid = threadIdx.x; C.lane = C.tid & 63; C.wave = __builtin_amdgcn_readfirstlane(C.tid >> 6);
    C.G = gridDim.x; { const int bx = blockIdx.x; C.vcu = (C.G % 8 == 0) ? (bx % 8) * (C.G / 8) + bx / 8 : bx; }
    C.gw = C.vcu * 8 + C.wave; C.NGW = C.G * 8;
    C.in = args.in; C.out = args.out; C.ws = args.ws;
    volatile LAS unsigned* misc = (volatile LAS unsigned*)(C.lds + LDS_MISC);
    if (C.tid < 4) misc[C.tid] = 0u;
    __syncthreads();
    const int lo = args.ph_lo, hi = args.ph_hi;
    XcdBarrier bar; bar.bar = (unsigned*)(C.ws + WS_CTL) + CW_BAR; bar.x = 0; bar.st = misc;
    if (hi - lo > 1) bar = xcd_barrier_post((unsigned*)(C.ws + WS_CTL) + CW_BAR, misc);
#ifdef PH_ONLY
#define IN(k) ((k) == PH_ONLY)
#else
#define IN(k) (lo <= (k) && (k) < hi)
#endif
#define FILL(k) bq::service(C, true, (k), 0)
#define NEED(k, limit) do { if (IN(k) && (limit) > 0) bq::service(C, false, 0, (limit)); } while (0)
#define SEAM(k) do { if (IN(k) && IN((k) + 1)) xcd_barrier(bar); } while (0)
    unsigned char* ws = C.ws;
    const float* mod = (const float*)(ws + WS_MOD);
    float* X = C.out + O_Y;
    LAS unsigned char* glds = C.lds;

#ifdef PROBE_CLK
#define CLK_BEGIN(k) unsigned long long _t0 = 0, _r0 = 0; if ((k) == PROBE_CLK) { _t0 = __builtin_amdgcn_s_memtime(); _r0 = __builtin_amdgcn_s_memrealtime(); }
#define CLK_END(k) if ((k) == PROBE_CLK && blockIdx.x == 0 && threadIdx.x == 0) { const unsigned long long t1 = __builtin_amdgcn_s_memtime(), r1 = __builtin_amdgcn_s_memrealtime(); \
        const unsigned long long ticks = (t1 - _t0) * 1000ull / (r1 - _r0); while (__builtin_amdgcn_s_memrealtime() - r1 < ticks) __builtin_amdgcn_s_sleep(8); }
#else
#define CLK_BEGIN(k)
#define CLK_END(k)
#endif
    if (IN(0)) { phase_prologue(C); } SEAM(0);
    if (IN(1)) { phase_norm(C, C.in[0], C.in[1], C.in[11], mod, 0, (bf16_t*)(ws + A_HN)); } NEED(1, bq::E_IN); SEAM(1);
    if (IN(2)) {
        pg8::Gemm g{(const bf16_t*)(ws + A_HN), (const bf16_t*)(ws + WS_WIN), MT, 3072, 2048, 2048, 2048, 0, 0}; pg8::StaticOrder S; S.init(MT, 3072, C.G, (int)blockIdx.x);
        pg8::EpiZ E{(bf16_t*)(ws + A_GG), (bf16_t*)(ws + A_B2), (bf16_t*)(ws + A_B2) + (size_t)MT * 1024};
        CLK_BEGIN(2) pg8::gemm_phase<pg8::EpiZ>(glds, g, S, E); CLK_END(2) FILL(2); } SEAM(2);
    if (IN(3)) { phase_convpool(C); } NEED(3, bq::E_POOL); SEAM(3);
    if (IN(4)) {
        { pg8::Gemm g{(const bf16_t*)(ws + A_B3), (const bf16_t*)(ws + WS_WGATE), MT, 2048, 256, 1024, 256, 1, 256}; pg8::StaticOrder S; S.init(MT, 2048, C.G, (int)blockIdx.x);
          pg8::EpiGate E{(const bf16_t*)(ws + A_B3), (const float*)(ws + WS_SP), (float*)(ws + A_B4)};
          pg8::gemm_phase<pg8::EpiGate>(glds, g, S, E); }
        FILL(4); } SEAM(4);
    if (IN(5)) {
        { pg8::Gemm g{(const bf16_t*)(ws + A_B3) + (size_t)MT * 1024, (const bf16_t*)(ws + WS_WPOOL), MT, 1024, 256, 1024, 256, 0, 256}; pg8::StaticOrder S; S.init(MT, 1024, C.G, (int)blockIdx.x);
          pg8::EpiPool E{(bf16_t*)(ws + A_HN), C.in[22]};
          pg8::gemm_phase<pg8::EpiPool>(glds, g, S, E); }
        phase_scanA(C); FILL(5); } SEAM(5);
    if (IN(6)) { phase_scanB(C); } SEAM(6);
    if (IN(7)) { phase_scanC(C); } NEED(7, bq::E_OUTR); SEAM(7);
    if (IN(8)) {
        pg8::Gemm g{(const bf16_t*)(ws + A_HN), (const bf16_t*)(ws + WS_WOUTR), MT, 2048, 2048, 2048, 2048, 0, 0}; pg8::StaticOrder S; S.init(MT, 2048, C.G, (int)blockIdx.x);
        pg8::EpiBf16 E{(bf16_t*)(ws + A_B3), 2048};
        pg8::gemm_phase<pg8::EpiBf16>(glds, g, S, E); FILL(8); } SEAM(8);
#define PEER_BLOCK(P0, L) \
    if (IN(P0)) { phase_resid_norm(C, (L) == 0 ? C.in[0] : X, (L) == 0 ? C.in[1] : X + (size_t)MP * DM, (const bf16_t*)(ws + A_B3), X, C.in[12] + (L) * 2048, mod + (size_t)(L) * NSEQ * 12288, (bf16_t*)(ws + A_B2)); } NEED(P0, (L) == 0 ? bq::E_Q0 : bq::E_Q1); SEAM(P0); \
    if (IN(P0 + 1)) { pg8::Gemm g{(const bf16_t*)(ws + A_B2), (const bf16_t*)(ws + WS_WQ) + (size_t)(L) * 2048 * 2048, MT, 2048, 2048, 2048, 2048, 0, 0}; pg8::StaticOrder S; S.init(MT, 2048, C.G, (int)blockIdx.x); \
        pg8::EpiBf16 E{(bf16_t*)(ws + A_B3), 2048}; pg8::gemm_phase<pg8::EpiBf16>(glds, g, S, E); FILL(P0 + 1); } NEED(P0 + 1, (L) == 0 ? bq::E_KEYS : 0); SEAM(P0 + 1); \
    if (IN(P0 + 2)) { phase_topk(C, L); } NEED(P0 + 2, (L) == 0 ? bq::E_TAB0 : bq::NTOT); SEAM(P0 + 2); \
    if (IN(P0 + 3)) { CLK_BEGIN(P0 + 3) phase_gather(C, L); CLK_END(P0 + 3) }
    PEER_BLOCK(9, 0) NEED(12, bq::E_DKV); SEAM(12);
    if (IN(13)) {
        pg8::Gemm g{(const bf16_t*)(ws + A_HN), (const bf16_t*)(ws + WS_WDQKV), MT, 1024, 2048, 2048, 2048, 0, 0}; pg8::StaticOrder S; S.init(MT, 1024, C.G, (int)blockIdx.x);
        pg8::EpiF32 E{(float*)(ws + A_B3), 1024};
        pg8::gemm_phase<pg8::EpiF32>(glds, g, S, E); FILL(13); } NEED(13, bq::E_ROPE); SEAM(13);
    if (IN(14)) { phase_latent(C); } NEED(14, bq::E_UKV); SEAM(14);
    if (IN(15)) {
        { pg8::Gemm g{(const bf16_t*)(ws + A_CQ), (const bf16_t*)(ws + WS_WUQ), MT, 3072, 512, 512, 512, 0, 0}; pg8::StaticOrder S; S.init(MT, 3072, C.G, (int)blockIdx.x);
          pg8::EpiQ E{ws + A_Q8, (const float*)(ws + WS_ROPE)};
          pg8::gemm_phase<pg8::EpiQ>(glds, g, S, E); }
        { pg8::Gemm g{(const bf16_t*)(ws + A_CKV), (const bf16_t*)(ws + WS_WUKV), KVROWS, 4096, 256, 256, 256, 0, 0}; pg8::StaticOrder S; S.init(KVROWS, 4096, C.G, (int)blockIdx.x);
          pg8::EpiKV E{ws + A_KN, (bf16_t*)(ws + A_VV)};
          pg8::gemm_phase<pg8::EpiKV>(glds, g, S, E); } FILL(15); } SEAM(15);
    if (IN(16)) { CLK_BEGIN(16) att::attn_phase(C); CLK_END(16) } NEED(16, bq::E_OUTA); SEAM(16);
    if (IN(17)) {
        pg8::Gemm g{(const bf16_t*)(ws + A_HN), (const bf16_t*)(ws + WS_WOUTA), MT, 2048, 1024, 1024, 1024, 0, 0}; pg8::StaticOrder S; S.init(MT, 2048, C.G, (int)blockIdx.x);
        pg8::EpiBf16 E{(bf16_t*)(ws + A_B3), 2048};
        pg8::gemm_phase<pg8::EpiBf16, true>(glds, g, S, E); FILL(17); } SEAM(17);
    PEER_BLOCK(18, 1)
#undef PEER_BLOCK
#undef IN
#undef SEAM
#undef FILL
#undef NEED
}

extern "C" void kernel_launch(void* const* d_in, const int* in_sizes, int n_in, void* d_out, int out_size, void* d_ws, size_t ws_size, hipStream_t stream) {
    static int grid = 0;
    if (grid == 0) {
        if (n_in != 36 || out_size != (int)O_TOTAL || ws_size < WS_END) { fprintf(stderr, "kernel_launch: built for 36 inputs, %zu outputs, >= %zu B workspace; got n_in %d out %d ws %zu\n", (size_t)O_TOTAL, (size_t)WS_END, n_in, out_size, ws_size); grid = -1; return; }
        int dev = 0, cus = 0, per_cu = 0;
        if (hipGetDevice(&dev) != hipSuccess || hipDeviceGetAttribute(&cus, hipDeviceAttributeMultiprocessorCount, dev) != hipSuccess) { fprintf(stderr, "kernel_launch: device query failed\n"); grid = -1; return; }
        if (hipFuncSetAttribute((const void*)mega_fwd, hipFuncAttributeMaxDynamicSharedMemorySize, LDS_BYTES) != hipSuccess) { fprintf(stderr, "kernel_launch: hipFuncSetAttribute failed\n"); grid = -1; return; }
        if (hipOccupancyMaxActiveBlocksPerMultiprocessor(&per_cu, (const void*)mega_fwd, 512, LDS_BYTES) != hipSuccess || per_cu < 1) { fprintf(stderr, "kernel_launch: occupancy query says %d blocks per CU\n", per_cu); }
        (void)hipGetLastError();
        grid = cus;
    }
    if (grid < 0) return;
    (void)hipMemsetAsync(d_ws, 0, WS_ZERO_BYTES, stream);
    Args a{};
    for (int i = 0; i < 36; ++i) a.in[i] = (const float*)d_in[i];
    a.out = (float*)d_out; a.ws = (unsigned char*)d_ws;
#if MK_SPLIT
    for (int p = 0; p < N_PHASES; ++p) { a.ph_lo = p; a.ph_hi = p + 1; hipLaunchKernelGGL(mega_fwd, dim3(grid), dim3(512), LDS_BYTES, stream, a); }
#elif defined(PROBE_RANGES)
    { const int rg[][2] = {PROBE_RANGES};
      for (unsigned i = 0; i < sizeof(rg) / sizeof(rg[0]); ++i) { if (i) (void)hipMemsetAsync(d_ws, 0, 1 * MiB, stream); a.ph_lo = rg[i][0]; a.ph_hi = rg[i][1]; hipLaunchKernelGGL(mega_fwd, dim3(grid), dim3(512), LDS_BYTES, stream, a); } }
#else
    a.ph_lo = 0; a.ph_hi = N_PHASES; hipLaunchKernelGGL(mega_fwd, dim3(grid), dim3(512), LDS_BYTES, stream, a);
#endif
    const hipError_t le = hipPeekAtLastError();
    if (le != hipSuccess) fprintf(stderr, "kernel_launch: launch failed: %s\n", hipGetErrorName(le));
}
```

```cpp
#include <hip/hip_runtime.h>
#include <cstdio>
#include <cstdint>

#define LAS __attribute__((address_space(3)))
#define GAS __attribute__((address_space(1)))
typedef unsigned short bf16_t;
typedef short bf16x8 __attribute__((ext_vector_type(8)));
typedef short s16x4 __attribute__((ext_vector_type(4)));
typedef float f32x2 __attribute__((ext_vector_type(2)));
typedef float f32x4 __attribute__((ext_vector_type(4)));
typedef float f32x16 __attribute__((ext_vector_type(16)));
typedef unsigned u32x2 __attribute__((ext_vector_type(2)));
typedef unsigned u32x4 __attribute__((ext_vector_type(4)));
typedef int i32x4_t __attribute__((ext_vector_type(4)));
typedef int i32x8_t __attribute__((ext_vector_type(8)));

constexpr int DM = 2048;
constexpr int MP = 32768, MS = 2048, MT = MP + MS;
constexpr int NSEQ = 34;
constexpr int KVROWS = MP + 32 * 1088;
constexpr float RMS_EPS = 1e-6f;

__device__ __forceinline__ int seq_of_row(int m) { return m < MP ? (m >> 14) : 2 + ((m - MP) >> 6); }
__device__ __forceinline__ int pos_of_row(int m) { return m < MP ? (m & 16383) : 1024 + ((m - MP) & 63); }
__device__ __forceinline__ int kvrow_of_row(int m) { return m < MP ? m : MP + ((m - MP) >> 6) * 1088 + 1024 + ((m - MP) & 63); }

__device__ __forceinline__ unsigned cvt_pk_bf16(float lo, float hi) { unsigned r; asm volatile("v_cvt_pk_bf16_f32 %0, %1, %2" : "=v"(r) : "v"(lo), "v"(hi)); return r; }
__device__ __forceinline__ unsigned cvt4_fp8(float a, float b, float c, float d) { int t = 0;
    t = __builtin_amdgcn_cvt_pk_fp8_f32(fminf(fmaxf(a, -448.f), 448.f), fminf(fmaxf(b, -448.f), 448.f), t, false);
    t = __builtin_amdgcn_cvt_pk_fp8_f32(fminf(fmaxf(c, -448.f), 448.f), fminf(fmaxf(d, -448.f), 448.f), t, true); return (unsigned)t; }
__device__ __forceinline__ float bf_lo(unsigned w) { return __uint_as_float(w << 16); }
__device__ __forceinline__ float bf_hi(unsigned w) { return __uint_as_float(w & 0xffff0000u); }
__device__ __forceinline__ float fexp(float x) { return __builtin_amdgcn_exp2f(x * 1.4426950408889634f); }
__device__ __forceinline__ float fsigmoid(float x) { return __builtin_amdgcn_rcpf(1.0f + __builtin_amdgcn_exp2f(-1.4426950408889634f * x)); }
__device__ __forceinline__ float gelu_tanh(float x) { const float u = x * (1.0f + 0.044715f * x * x); return x * __builtin_amdgcn_rcpf(1.0f + __builtin_amdgcn_exp2f(-2.302208198f * u)); }
__device__ __forceinline__ float gelu_erf(float v) {
    const float av = __builtin_fabsf(v), t = __builtin_amdgcn_rcpf(av * 0.2316418882f + 1.0f);
    float q = t * 0.5307027145f + (-0.7265760135f); q = q * t + 0.7107068705f; q = q * t + (-0.142248368f); q = q * t + 0.127414796f; q = q * t;
    const float e = __builtin_amdgcn_exp2f((v * v) * (-0.72134752044f));
    const float m = v * (q * e); return v < 0.f ? m : v - m;
}
__device__ __forceinline__ float wave_sum(float v) {
#pragma unroll
    for (int o = 32; o >= 1; o >>= 1) v += __shfl_xor(v, o);
    return v;
}

namespace pg8 {
constexpr int BM = 256, BK = 64, HALF = 128, HTB = HALF * BK * 2, STAGE_BYTES = 8 * HTB, NXCD = 8, WGM = 8;
__host__ __device__ __forceinline__ int lds_byte(int r, int c) { const int st = (r >> 4) * 2 + (c >> 5), rr = r & 15, cc = c & 31, ob = rr * 64 + cc * 2; return st * 1024 + (ob ^ (((ob >> 9) & 1) << 5)); }
__host__ __device__ __forceinline__ void stage_rc(int b, int& R, int& C) { const int st = b / 1024, sb = b % 1024, swz = sb ^ (((sb >> 9) & 1) << 5); R = (st >> 1) * 16 + swz / 64; C = (st & 1) * 32 + (swz % 64) / 2; }
__host__ __device__ __forceinline__ int perm32(int rho) { const int n = rho >> 4, i = rho & 15; return 8 * (i >> 2) + 4 * n + (i & 3); }

struct Unit { int pm, pn; };
struct Gemm { const bf16_t* A; const bf16_t* Bt; int M, N, K, lda, ldb, kshift, kmul; };

struct StaticOrder {
    int nM, nN, nwg, G, c;
    __host__ __device__ void init(int M, int N, int G_, int c_) { nM = M / BM; nN = N / BM; nwg = nM * nN; G = G_; c = c_; }
    __host__ __device__ bool next(int i, Unit& u) const {
        const long L = (long)i * G + c; if (L >= nwg) return false;
        int wgid = (int)L; { const int q = nwg / NXCD, r = nwg % NXCD, xcd = wgid % NXCD, off = wgid / NXCD; wgid = (xcd < r ? xcd * (q + 1) : r * (q + 1) + (xcd - r) * q) + off; }
        const int nig = WGM * nN, gid = wgid / nig, fm = gid * WGM, gsz = (nM - fm) < WGM ? (nM - fm) : WGM;
        u.pm = fm + ((wgid % nig) % gsz); u.pn = (wgid % nig) / gsz; return true;
    }
};

template <class Epi, bool F8 = false>
__device__ __forceinline__ void gemm_phase(LAS unsigned char* lds, const Gemm g, const StaticOrder& S, const Epi& E) {
    const int tid = threadIdx.x, wid = __builtin_amdgcn_readfirstlane(tid >> 6), lane = tid & 63, wr = wid >> 2, wc = wid & 3, fr = lane & 15, fq = lane >> 4;
    int Kq = g.K; asm volatile("" : "+s"(Kq));
    const int K = Kq, nt = K / BK;
    unsigned voffA[2], voffB[2];
#pragma unroll
    for (int i = 0; i < 2; ++i) { int R, C; stage_rc(tid * 16 + i * 8192, R, C); const int Rb = Epi::PERM ? ((R & ~31) + perm32(R & 31)) : R;
        voffA[i] = (unsigned)(R * g.lda + C) * 2u; voffB[i] = (unsigned)(Rb * g.ldb + C) * 2u; }
    const size_t kstep = (size_t)(BK * 2);
    const size_t hstepA = (size_t)HALF * g.lda * 2, hstepB = (size_t)HALF * g.ldb * 2;
    const unsigned ldsw = (unsigned)wid * 1024u;
    const int aoff = lds_byte(wr * 64 + fr, fq * 8), boff = lds_byte(wc * 32 + fr, fq * 8);
#define PG8_SA(b, h) (((b) * 2 + (h)) * HTB)
#define PG8_SB(b, h) ((4 + (b) * 2 + (h)) * HTB)
#define PG8_STAGE(bufoff, gbase, voff) do { _Pragma("unroll") for (int _i = 0; _i < 2; ++_i) \
        __builtin_amdgcn_global_load_lds((const unsigned*)((const char*)(gbase) + (voff)[_i]), (LAS unsigned*)(lds + (bufoff) + ldsw + _i * 8192), 16, 0, 0); } while (0)
#define PG8_CAT(F) __builtin_shufflevector(__builtin_bit_cast(i32x4_t, (F)[0]), __builtin_bit_cast(i32x4_t, (F)[1]), 0, 1, 2, 3, 4, 5, 6, 7)
#define PG8_LDA(dst, b, h) do { _Pragma("unroll") for (int m = 0; m < 4; ++m) { _Pragma("unroll") for (int k = 0; k < 2; ++k) dst[m][k] = *(const LAS bf16x8*)(lds + PG8_SA(b, h) + aoff + m * 2048 + k * 1024); \
        if (F8) dst##8[m] = PG8_CAT(dst[m]); } } while (0)
#define PG8_LDB(dst, b, h) do { _Pragma("unroll") for (int n = 0; n < 2; ++n) { _Pragma("unroll") for (int k = 0; k < 2; ++k) dst[n][k] = *(const LAS bf16x8*)(lds + PG8_SB(b, h) + boff + n * 2048 + k * 1024); \
        if (F8) dst##8[n] = PG8_CAT(dst[n]); } } while (0)
#define PG8_MMA(ai, bj, At, Bt) do { __builtin_amdgcn_s_setprio(1); \
        if (F8) { _Pragma("unroll") for (int m = 0; m < 4; ++m) _Pragma("unroll") for (int n = 0; n < 2; ++n) \
            asm volatile("v_mfma_scale_f32_16x16x128_f8f6f4 %0, %1, %2, %0, %3, %3 op_sel_hi:[0,0,0]" : "+v"(acc[ai][bj][m][n]) : "v"(Bt##8[n]), "v"(At##8[m]), "v"(f8one)); } \
        else { _Pragma("unroll") for (int m = 0; m < 4; ++m) _Pragma("unroll") for (int n = 0; n < 2; ++n) _Pragma("unroll") for (int k = 0; k < 2; ++k) \
            acc[ai][bj][m][n] = __builtin_amdgcn_mfma_f32_16x16x32_bf16(Bt[n][k], At[m][k], acc[ai][bj][m][n], 0, 0, 0); } \
        __builtin_amdgcn_s_setprio(0); } while (0)
#define PG8_WAIT_V(n) asm volatile("s_waitcnt vmcnt(" #n ")" ::: "memory")
#define PG8_WAIT_L(n) asm volatile("s_waitcnt lgkmcnt(" #n ")" ::: "memory")
#define PG8_BAR __builtin_amdgcn_s_barrier()
#define PG8_SCHED __builtin_amdgcn_sched_barrier(0)
#define PG8_ABASE(u) ((const char*)g.A + (size_t)(u).pm * (2 * hstepA) + (size_t)(((u).pn >> g.kshift) * g.kmul) * 2)
#define PG8_BBASE(u) ((const char*)g.Bt + (size_t)(u).pn * (2 * hstepB))
    Unit cur, nxt; int ui = 0;
    if (!S.next(0, cur)) return;
    f32x4 acc[2][2][4][2];
#pragma unroll
    for (int a = 0; a < 2; ++a)
#pragma unroll
        for (int b = 0; b < 2; ++b)
#pragma unroll
            for (int m = 0; m < 4; ++m)
#pragma unroll
                for (int n = 0; n < 2; ++n) acc[a][b][m][n] = (f32x4){0.f, 0.f, 0.f, 0.f};
    bf16x8 At[4][2], B0[2][2], B1[2][2];
    i32x8_t At8[4], B08[2], B18[2]; int f8one = 127; asm volatile("" : "+v"(f8one));
    const char* cA = PG8_ABASE(cur); const char* cB = PG8_BBASE(cur);
    PG8_STAGE(PG8_SB(0, 0), cB, voffB); PG8_STAGE(PG8_SB(0, 1), cB + hstepB, voffB); PG8_STAGE(PG8_SA(0, 0), cA, voffA); PG8_STAGE(PG8_SA(0, 1), cA + hstepA, voffA);
    if (wr == 1) PG8_BAR;
    PG8_WAIT_V(2); PG8_BAR;
    PG8_STAGE(PG8_SB(1, 0), cB + kstep, voffB); PG8_STAGE(PG8_SA(1, 0), cA + kstep, voffA); PG8_STAGE(PG8_SB(1, 1), cB + hstepB + kstep, voffB);
    PG8_WAIT_V(6); PG8_BAR;
    for (;;) {
        const bool has_next = S.next(ui + 1, nxt);
        const char* nA = has_next ? PG8_ABASE(nxt) : cA; const char* nB = has_next ? PG8_BBASE(nxt) : cB;
        for (int t = 0; t < nt; t += 2) {
            const bool last = (t == nt - 2);
            const char* a1 = cA + (size_t)(t + 1) * kstep;
            const char* a2 = last ? nA : cA + (size_t)(t + 2) * kstep; const char* b2 = last ? nB : cB + (size_t)(t + 2) * kstep;
            const char* a3 = a2 + kstep; const char* b3 = b2 + kstep;
            PG8_LDB(B0, 0, 0); PG8_LDB(B1, 0, 1); PG8_SCHED; PG8_LDA(At, 0, 0); PG8_STAGE(PG8_SA(1, 1), a1 + hstepA, voffA);
            PG8_WAIT_V(8); PG8_WAIT_L(0); PG8_BAR; PG8_MMA(0, 0, At, B0); PG8_MMA(0, 1, At, B1); PG8_BAR; PG8_SCHED;
            PG8_LDA(At, 0, 1); PG8_STAGE(PG8_SB(0, 0), b2, voffB); PG8_STAGE(PG8_SB(0, 1), b2 + hstepB, voffB); PG8_STAGE(PG8_SA(0, 0), a2, voffA);
            PG8_WAIT_V(8); PG8_WAIT_L(0); PG8_BAR; PG8_MMA(1, 0, At, B0); PG8_MMA(1, 1, At, B1); PG8_BAR; PG8_SCHED;
            PG8_LDB(B0, 1, 0); PG8_LDB(B1, 1, 1); PG8_SCHED; PG8_LDA(At, 1, 0); PG8_STAGE(PG8_SA(0, 1), a2 + hstepA, voffA);
            PG8_WAIT_V(8); PG8_WAIT_L(0); PG8_BAR; PG8_MMA(0, 0, At, B0); PG8_MMA(0, 1, At, B1); PG8_BAR; PG8_SCHED;
            PG8_LDA(At, 1, 1); PG8_STAGE(PG8_SB(1, 0), b3, voffB); PG8_STAGE(PG8_SB(1, 1), b3 + hstepB, voffB); PG8_STAGE(PG8_SA(1, 0), a3, voffA);
            PG8_WAIT_V(8); PG8_WAIT_L(0); PG8_BAR; PG8_MMA(1, 0, At, B0); PG8_MMA(1, 1, At, B1); PG8_BAR; PG8_SCHED;
        }
        if (wr == 0) PG8_BAR;
        E(acc, cur, wr, wc, fr, fq);
        if (!has_next) break;
#pragma unroll
        for (int a = 0; a < 2; ++a)
#pragma unroll
            for (int b = 0; b < 2; ++b)
#pragma unroll
                for (int m = 0; m < 4; ++m)
#pragma unroll
                    for (int n = 0; n < 2; ++n) acc[a][b][m][n] = (f32x4){0.f, 0.f, 0.f, 0.f};
        cur = nxt; cA = nA; cB = nB; ++ui;
        if (wr == 1) PG8_BAR;
    }
    PG8_WAIT_V(0);
    PG8_BAR;
#undef PG8_SA
#undef PG8_SB
#undef PG8_STAGE
#undef PG8_LDA
#undef PG8_LDB
#undef PG8_MMA
#undef PG8_CAT
#undef PG8_WAIT_V
#undef PG8_WAIT_L
#undef PG8_BAR
#undef PG8_SCHED
#undef PG8_ABASE
#undef PG8_BBASE
}
}
namespace pg8 {
#define EPI_ROWS(expr_row) for (int ai = 0; ai < 2; ++ai) for (int m = 0; m < 4; ++m)
struct EpiBf16 {
    static constexpr bool PERM = true;
    bf16_t* O; int ldc;
    __device__ __forceinline__ void operator()(const f32x4 (&acc)[2][2][4][2], const Unit& u, int wr, int wc, int fr, int fq) const {
        const int row0 = u.pm * BM + wr * 64 + fr, col0 = u.pn * BM + wc * 32 + 8 * fq;
#pragma unroll
        for (int ai = 0; ai < 2; ++ai)
#pragma unroll
            for (int m = 0; m < 4; ++m) { bf16_t* rowp = O + (size_t)(row0 + ai * HALF + m * 16) * ldc + col0;
#pragma unroll
                for (int bj = 0; bj < 2; ++bj) { const f32x4 v0 = acc[ai][bj][m][0], v1 = acc[ai][bj][m][1];
                    u32x4 w; w.x = cvt_pk_bf16(v0[0], v0[1]); w.y = cvt_pk_bf16(v0[2], v0[3]); w.z = cvt_pk_bf16(v1[0], v1[1]); w.w = cvt_pk_bf16(v1[2], v1[3]);
                    *(u32x4*)(rowp + bj * HALF) = w; } }
    }
};
struct EpiZ {
    static constexpr bool PERM = true;
    bf16_t* GG; bf16_t* REC; bf16_t* POOL;
    __device__ __forceinline__ void operator()(const f32x4 (&acc)[2][2][4][2], const Unit& u, int wr, int wc, int fr, int fq) const {
        const int t = u.pn >> 2; bf16_t* base = GG + (size_t)t * ((size_t)MT * 1024);
        const int row0 = u.pm * BM + wr * 64 + fr, col0 = (u.pn & 3) * BM + wc * 32 + 8 * fq;
#pragma unroll
        for (int ai = 0; ai < 2; ++ai)
#pragma unroll
            for (int m = 0; m < 4; ++m) { bf16_t* rowp = base + (size_t)(row0 + ai * HALF + m * 16) * 1024 + col0;
#pragma unroll
                for (int bj = 0; bj < 2; ++bj) { f32x4 v0 = acc[ai][bj][m][0], v1 = acc[ai][bj][m][1];
                    if (t == 0) {
#pragma unroll
                        for (int j = 0; j < 4; ++j) { v0[j] = gelu_tanh(v0[j]); v1[j] = gelu_tanh(v1[j]); } }
                    u32x4 w; w.x = cvt_pk_bf16(v0[0], v0[1]); w.y = cvt_pk_bf16(v0[2], v0[3]); w.z = cvt_pk_bf16(v1[0], v1[1]); w.w = cvt_pk_bf16(v1[2], v1[3]);
                    *(u32x4*)(rowp + bj * HALF) = w; } }
    }
};
struct EpiGate {
    static constexpr bool PERM = false;
    const bf16_t* XC; const float* gp; float* Aout;
    __device__ __forceinline__ void operator()(const f32x4 (&acc)[2][2][4][2], const Unit& u, int wr, int wc, int fr, int fq) const {
        const int row0 = u.pm * BM + wr * 64 + fr, ch0 = u.pn * 128 + wc * 32 + 4 * fq;
#pragma unroll
        for (int n = 0; n < 2; ++n) {
            const f32x4 bav = *(const f32x4*)(gp + ch0 + 16 * n), bxv = *(const f32x4*)(gp + 1024 + ch0 + 16 * n), spv = *(const f32x4*)(gp + 2048 + ch0 + 16 * n);
#pragma unroll
            for (int ai = 0; ai < 2; ++ai)
#pragma unroll
                for (int m = 0; m < 4; ++m) { const int row = row0 + ai * HALF + m * 16; const bool pos0 = (row < MP) && ((row & 16383) == 0);
                    const size_t off = (size_t)row * 1024 + ch0 + 16 * n;
                    const u32x2 xw = *(const u32x2*)(XC + off); const float xc[4] = {bf_lo(xw.x), bf_hi(xw.x), bf_lo(xw.y), bf_hi(xw.y)};
                    f32x4 av, uv;
#pragma unroll
                    for (int j = 0; j < 4; ++j) { const float r = fsigmoid(acc[ai][0][m][n][j] + bav[j]), ig = fsigmoid(acc[ai][1][m][n][j] + bxv[j]);
                        const float log_a = -8.0f * r * spv[j]; const float a = fexp(log_a); const float mult = pos0 ? 1.0f : __builtin_sqrtf(fmaxf(1.0f - a * a, 0.0f));
                        av[j] = a; uv[j] = mult * ig * xc[j]; }
                    *(f32x4*)(Aout + off) = av; { u32x2 uw; uw.x = cvt_pk_bf16(uv[0], uv[1]); uw.y = cvt_pk_bf16(uv[2], uv[3]); *(u32x2*)((bf16_t*)(Aout + (size_t)MT * 1024) + off) = uw; } asm volatile("" ::: "memory"); }
        }
    }
};
struct EpiPool {
    static constexpr bool PERM = true;
    bf16_t* CAT; const float* spool;
    __device__ __forceinline__ void operator()(const f32x4 (&acc)[2][2][4][2], const Unit& u, int wr, int wc, int fr, int fq) const {
        const int row0 = u.pm * BM + wr * 64 + fr, col0 = u.pn * BM + wc * 32 + 8 * fq;
        f32x4 s0[2], s1[2];
#pragma unroll
        for (int bj = 0; bj < 2; ++bj) { s0[bj] = *(const f32x4*)(spool + col0 + bj * HALF); s1[bj] = *(const f32x4*)(spool + col0 + bj * HALF + 4); }
#pragma unroll
        for (int ai = 0; ai < 2; ++ai)
#pragma unroll
            for (int m = 0; m < 4; ++m) { bf16_t* rowp = CAT + (size_t)(row0 + ai * HALF + m * 16) * 2048 + 1024 + col0;
#pragma unroll
                for (int bj = 0; bj < 2; ++bj) { const f32x4 v0 = acc[ai][bj][m][0] * s0[bj], v1 = acc[ai][bj][m][1] * s1[bj];
                    u32x4 w; w.x = cvt_pk_bf16(v0[0], v0[1]); w.y = cvt_pk_bf16(v0[2], v0[3]); w.z = cvt_pk_bf16(v1[0], v1[1]); w.w = cvt_pk_bf16(v1[2], v1[3]);
                    *(u32x4*)(rowp + bj * HALF) = w; } }
    }
};
struct EpiResid {
    static constexpr bool PERM = false;
    const float* xinP; const float* xinS; float* xout; const float* gate;
    __device__ __forceinline__ void operator()(const f32x4 (&acc)[2][2][4][2], const Unit& u, int wr, int wc, int fr, int fq) const {
        const int row0 = u.pm * BM + wr * 64 + fr, col0 = u.pn * BM + wc * 32 + 4 * fq;
#pragma unroll
        for (int ai = 0; ai < 2; ++ai)
#pragma unroll
            for (int m = 0; m < 4; ++m) { const int row = row0 + ai * HALF + m * 16; const float* gp = gate + (size_t)seq_of_row(row) * 12288 + col0;
                const float* xi = (row < MP ? xinP + (size_t)row * DM : xinS + (size_t)(row - MP) * DM) + col0; float* xo = xout + (size_t)row * DM + col0;
#pragma unroll
                for (int bj = 0; bj < 2; ++bj)
#pragma unroll
                    for (int n = 0; n < 2; ++n) { const int o = bj * HALF + n * 16; *(f32x4*)(xo + o) = *(const f32x4*)(xi + o) + *(const f32x4*)(gp + o) * acc[ai][bj][m][n]; }
                asm volatile("" ::: "memory"); }
    }
};
struct EpiF32 {
    static constexpr bool PERM = false;
    float* C; int ldc;
    __device__ __forceinline__ void operator()(const f32x4 (&acc)[2][2][4][2], const Unit& u, int wr, int wc, int fr, int fq) const {
        const int row0 = u.pm * BM + wr * 64 + fr, col0 = u.pn * BM + wc * 32 + 4 * fq;
#pragma unroll
        for (int ai = 0; ai < 2; ++ai)
#pragma unroll
            for (int m = 0; m < 4; ++m) { float* rowp = C + (size_t)(row0 + ai * HALF + m * 16) * ldc + col0;
#pragma unroll
                for (int bj = 0; bj < 2; ++bj)
#pragma unroll
                    for (int n = 0; n < 2; ++n) *(f32x4*)(rowp + bj * HALF + n * 16) = acc[ai][bj][m][n]; }
    }
};
struct EpiQ {
    static constexpr bool PERM = true;
    static constexpr float QS = 0.07216878364870322f * 1.4426950408889634f;
    unsigned char* Q8; const float* rope;
    __device__ __forceinline__ void operator()(const f32x4 (&acc)[2][2][4][2], const Unit& u, int wr, int wc, int fr, int fq) const {
        const int row0 = u.pm * BM + wr * 64 + fr;
        if (u.pn < 8) {
            const int col0 = u.pn * BM + wc * 32 + 8 * fq;
#pragma unroll
            for (int ai = 0; ai < 2; ++ai)
#pragma unroll
                for (int m = 0; m < 4; ++m) { unsigned char* rowp = Q8 + (size_t)(row0 + ai * HALF + m * 16) * 3072;
#pragma unroll
                    for (int bj = 0; bj < 2; ++bj) { const f32x4 v0 = acc[ai][bj][m][0] * QS, v1 = acc[ai][bj][m][1] * QS; const int col = col0 + bj * HALF;
                        u32x2 w; w.x = cvt4_fp8(v0[0], v0[1], v0[2], v0[3]); w.y = cvt4_fp8(v1[0], v1[1], v1[2], v1[3]);
                        *(u32x2*)(rowp + (col >> 7) * 192 + (col & 127)) = w; } }
        } else {
            const int head = (u.pn - 8) * 4 + wc, j0 = 8 * fq;
#pragma unroll
            for (int ai = 0; ai < 2; ++ai)
#pragma unroll
                for (int m = 0; m < 4; ++m) { const int row = row0 + ai * HALF + m * 16; const float* rp = rope + (size_t)pos_of_row(row) * 64 + j0;
                    const f32x4 c0 = *(const f32x4*)(rp), c1 = *(const f32x4*)(rp + 4), s0 = *(const f32x4*)(rp + 32), s1 = *(const f32x4*)(rp + 36);
                    const f32x4 x10 = acc[ai][0][m][0] * QS, x11 = acc[ai][0][m][1] * QS, x20 = acc[ai][1][m][0] * QS, x21 = acc[ai][1][m][1] * QS;
                    const f32x4 a0 = x10 * c0 - x20 * s0, a1 = x11 * c1 - x21 * s1, b0 = x10 * s0 + x20 * c0, b1 = x11 * s1 + x21 * c1;
                    unsigned char* qp = Q8 + (size_t)row * 3072 + head * 192 + 128 + j0;
                    u32x2 w; w.x = cvt4_fp8(a0[0], a0[1], a0[2], a0[3]); w.y = cvt4_fp8(a1[0], a1[1], a1[2], a1[3]); *(u32x2*)qp = w;
                    w.x = cvt4_fp8(b0[0], b0[1], b0[2], b0[3]); w.y = cvt4_fp8(b1[0], b1[1], b1[2], b1[3]); *(u32x2*)(qp + 32) = w; }
        }
    }
};
struct EpiKV {
    static constexpr bool PERM = true;
    unsigned char* Kn8; bf16_t* V;
    __device__ __forceinline__ void operator()(const f32x4 (&acc)[2][2][4][2], const Unit& u, int wr, int wc, int fr, int fq) const {
        const int row0 = u.pm * BM + wr * 64 + fr, col0 = u.pn * 128 + wc * 32 + 8 * fq;
#pragma unroll
        for (int ai = 0; ai < 2; ++ai)
#pragma unroll
            for (int m = 0; m < 4; ++m) { const size_t off = (size_t)(row0 + ai * HALF + m * 16) * 2048 + col0;
                { const f32x4 v0 = acc[ai][0][m][0], v1 = acc[ai][0][m][1]; u32x2 w; w.x = cvt4_fp8(v0[0], v0[1], v0[2], v0[3]); w.y = cvt4_fp8(v1[0], v1[1], v1[2], v1[3]); *(u32x2*)(Kn8 + off) = w; }
                { const f32x4 v0 = acc[ai][1][m][0], v1 = acc[ai][1][m][1];
                  u32x4 w; w.x = cvt_pk_bf16(v0[0], v0[1]); w.y = cvt_pk_bf16(v0[2], v0[3]); w.z = cvt_pk_bf16(v1[0], v1[1]); w.w = cvt_pk_bf16(v1[2], v1[3]); *(u32x4*)(V + off) = w; } }
    }
};
#undef EPI_ROWS
}

#define XB_TMO      128
#define XB_XCNT(j)  (256  + 64 * (j))
#define XB_XSUB(j)  (1280 + 64 * (j))
#define XB_XGEN(j)  (2304 + 64 * (j))
#define XB_TOP      3328
#define XB_TOPGEN   3392
#define XCD_BAR_WORDS 3456
#define XB_SPIN_CAP (1u << 18)
__device__ __forceinline__ unsigned xb_ld(unsigned* p)              { return __hip_atomic_load(p, __ATOMIC_RELAXED, __HIP_MEMORY_SCOPE_AGENT); }
__device__ __forceinline__ unsigned xb_add(unsigned* p, unsigned v) { return __hip_atomic_fetch_add(p, v, __ATOMIC_RELAXED, __HIP_MEMORY_SCOPE_AGENT); }
__device__ __forceinline__ unsigned xb_xcc_id() { return (unsigned)__builtin_amdgcn_s_getreg((3 << 11) | 20) & 0xFu; }
#define XB_SPIN(cond, bar) do { unsigned _sp = 0; while (cond) { __builtin_amdgcn_s_sleep(1); \
    if ((++_sp & 255u) == 0u) { if (xb_ld(&(bar)[XB_TMO])) break; if (_sp > XB_SPIN_CAP) { atomicAdd(&(bar)[XB_TMO], 1u); break; } } } } while (0)
struct XcdBarrier { unsigned* bar; unsigned x; volatile LAS unsigned* st; };
__device__ __forceinline__ XcdBarrier xcd_barrier_post(unsigned* bar, volatile LAS unsigned* st) {
    XcdBarrier b; b.bar = bar; b.x = xb_xcc_id(); b.st = st;
    if (threadIdx.x == 0) (void)xb_add(&bar[XB_XCNT(b.x)], 1u);
    return b;
}
__device__ __forceinline__ void xcd_barrier_complete(unsigned* bar, unsigned x, unsigned& nloc, unsigned& nx) {
    const unsigned G = gridDim.x * gridDim.y * gridDim.z;
    unsigned sum, cnt, mine, sp = 0u;
    for (;;) {
        sum = 0u; cnt = 0u; mine = 0u;
#pragma unroll
        for (unsigned j = 0; j < 16; ++j) { const unsigned c = xb_ld(&bar[XB_XCNT(j)]); sum += c; cnt += (c > 0u) ? 1u : 0u; mine = (j == x) ? c : mine; }
        if (sum == G) break;
        __builtin_amdgcn_s_sleep(1);
        if ((++sp & 255u) == 0u) { if (xb_ld(&bar[XB_TMO])) break; if (sp > XB_SPIN_CAP) { atomicAdd(&bar[XB_TMO], 1u); break; } }
    }
    nloc = mine > 0u ? mine : 1u; nx = cnt > 0u ? cnt : 1u;
}
__device__ __forceinline__ void xcd_barrier(const XcdBarrier& b) {
    asm volatile("s_waitcnt vmcnt(0)" ::: "memory");
    __syncthreads();
    if (threadIdx.x == 0) {
        unsigned* bar = b.bar;
        __builtin_amdgcn_s_waitcnt(0);
        unsigned nloc = b.st[0], nx = b.st[1];
        if (nloc == 0u) { xcd_barrier_complete(bar, b.x, nloc, nx); b.st[0] = nloc; b.st[1] = nx; }
        const unsigned old = xb_add(&bar[XB_XSUB(b.x)], 1u);
        const unsigned gen = old / nloc;
        if (old + 1u == (gen + 1u) * nloc) {
            __builtin_amdgcn_fence(__ATOMIC_RELEASE, "agent");
            asm volatile("s_waitcnt vmcnt(0)" ::: "memory");
            const unsigned og = xb_add(&bar[XB_TOP], 1u);
            const unsigned tg = og / nx;
            if (og + 1u == (tg + 1u) * nx) xb_add(&bar[XB_TOPGEN], 1u);
            else XB_SPIN(xb_ld(&bar[XB_TOPGEN]) == tg, bar);
            __builtin_amdgcn_fence(__ATOMIC_ACQUIRE, "agent");
            xb_add(&bar[XB_XGEN(b.x)], 1u);
            asm volatile("s_waitcnt vmcnt(0)" ::: "memory");
        } else {
            XB_SPIN(xb_ld(&bar[XB_XGEN(b.x)]) == gen, bar);
            __builtin_amdgcn_fence(__ATOMIC_ACQUIRE, "agent");
            asm volatile("s_waitcnt vmcnt(0)" ::: "memory");
        }
    }
    __syncthreads();
}
constexpr float U8_SCALE = 256.0f, V8_SCALE = 16.0f;
__device__ __forceinline__ void convert_fp8_range(const float* src, unsigned char* dst, float scale, size_t n16, size_t i0, size_t stride) {
    for (size_t i = i0; i < n16; i += stride) { u32x4 w;
#pragma unroll
        for (int q = 0; q < 4; ++q) { f32x4 a = *(const f32x4*)(src + i * 16 + 4 * q) * scale;
#pragma unroll
            for (int j = 0; j < 4; ++j) a[j] = fminf(fmaxf(a[j], -448.0f), 448.0f);
            int t = 0; t = __builtin_amdgcn_cvt_pk_fp8_f32(a[0], a[1], t, false); t = __builtin_amdgcn_cvt_pk_fp8_f32(a[2], a[3], t, true); w[q] = (unsigned)t; }
        *(u32x4*)(dst + i * 16) = w; }
}
constexpr float U4_SCALE = 90.50966799f, V4_SCALE = 8.0f;
__device__ __forceinline__ void convert_fp4_rows(const float* src, unsigned char* dst, float scale, int nrows, int w0, int wstride, int lane) {
    for (int r = w0; r < nrows; r += wstride) { const float* sr = src + (size_t)r * 2048 + 4 * lane; u32x4 w;
        f32x4 a[8];
#pragma unroll
        for (int b = 0; b < 8; ++b) a[b] = *(const f32x4*)(sr + 256 * b) * scale;
#pragma unroll
        for (int q = 0; q < 4; ++q) { float e[8] = {a[2 * q][0], a[2 * q][1], a[2 * q][2], a[2 * q][3], a[2 * q + 1][0], a[2 * q + 1][1], a[2 * q + 1][2], a[2 * q + 1][3]};
#pragma unroll
            for (int j = 0; j < 8; ++j) e[j] = fminf(fmaxf(e[j], -6.0f), 6.0f);
            unsigned t = 0u; t = __builtin_amdgcn_cvt_scalef32_pk_fp4_f32(t, e[0], e[1], 1.0f, 0); t = __builtin_amdgcn_cvt_scalef32_pk_fp4_f32(t, e[2], e[3], 1.0f, 1);
            t = __builtin_amdgcn_cvt_scalef32_pk_fp4_f32(t, e[4], e[5], 1.0f, 2); t = __builtin_amdgcn_cvt_scalef32_pk_fp4_f32(t, e[6], e[7], 1.0f, 3); w[q] = t; }
        *(u32x4*)(dst + (size_t)r * 1024 + 16 * lane) = w; }
}
constexpr size_t MiB = (size_t)1 << 20;
constexpr size_t WS_CTL = 0, WS_WGATE = 1 * MiB, WS_WDQKV = 2 * MiB, WS_ZERO_BYTES = 6 * MiB;
constexpr size_t WS_WIN = 6 * MiB, WS_WOUTR = 18 * MiB, WS_WQ = 26 * MiB, WS_WUQ = 42 * MiB, WS_WUKV = 45 * MiB, WS_WOUTA = 47 * MiB;
constexpr size_t WS_WPOOL = 55 * MiB, WS_KEYS = 56 * MiB, WS_MOD = 57 * MiB, WS_ROPE = 61 * MiB, WS_SP = 65 * MiB, WS_SCAN = 66 * MiB;
constexpr size_t WS_U = 73 * MiB, WS_V = 137 * MiB;
constexpr size_t A_HN = 201 * MiB, A_GG = 337 * MiB, A_B2 = 405 * MiB, A_B3 = 541 * MiB, A_B4 = 677 * MiB;
constexpr size_t A_KN = 405 * MiB  , A_Q8 = 537 * MiB  , A_VV = 669 * MiB, A_KP = 933 * MiB, A_CQ = 942 * MiB, A_CKV = 976 * MiB, WS_END = 1009 * MiB;
constexpr int CW_BAR = 4096;
constexpr size_t SCAN_WORDS = (size_t)544 * 1024;
constexpr size_t O_Y = 0, O_CONV_P = 71303168, O_CONV_S = 71309312, O_H_P = 71407616, O_H_S = 71409664, O_POOL_P = 71442432, O_POOL_S = 71473152,
                 O_CKV = 71964672, O_KPE = 80877568, O_TOTAL = 83105792;
constexpr int LDS_BYTES = 147456, LDS_MISC = 147200;

struct Args { const float* in[36]; float* out; unsigned char* ws; int ph_lo, ph_hi; };

struct Ctx {
    LAS unsigned char* lds; int tid, lane, wave, vcu, G, gw, NGW;
    const float* const* in; float* out; unsigned char* ws;
};

__device__ __forceinline__ void transpose_item(const float* W, int N, int k0, int n0, bf16_t* WT, int dld, int drow0, int dcol0, LAS float* scr, int lane) {
#pragma unroll 8
    for (int i = 0; i < 32; ++i) { const int kk = 2 * i + (lane >> 5); scr[kk * 33 + (lane & 31)] = W[(size_t)(k0 + kk) * N + n0 + (lane & 31)]; }
    asm volatile("s_waitcnt lgkmcnt(0)" ::: "memory");
    const int c = lane & 7;
#pragma unroll
    for (int j = 0; j < 4; ++j) { const int n = (lane >> 3) + 8 * j; const LAS float* s = scr + (8 * c) * 33 + n;
        u32x4 o; o.x = cvt_pk_bf16(s[0 * 33], s[1 * 33]); o.y = cvt_pk_bf16(s[2 * 33], s[3 * 33]); o.z = cvt_pk_bf16(s[4 * 33], s[5 * 33]); o.w = cvt_pk_bf16(s[6 * 33], s[7 * 33]);
        *(u32x4*)(WT + (size_t)(drow0 + n) * dld + dcol0 + 8 * c) = o; }
    asm volatile("s_waitcnt lgkmcnt(0)" ::: "memory");
}
__device__ __forceinline__ void transpose_item_f8(const float* W, int N, int k0, int n0, unsigned char* WT, int dld, int drow0, int dcol0, LAS float* scr, int lane) {
#pragma unroll 8
    for (int i = 0; i < 32; ++i) { const int kk = 2 * i + (lane >> 5); scr[kk * 33 + (lane & 31)] = W[(size_t)(k0 + kk) * N + n0 + (lane & 31)]; }
    asm volatile("s_waitcnt lgkmcnt(0)" ::: "memory");
    const int c = lane & 7;
#pragma unroll
    for (int j = 0; j < 4; ++j) { const int n = (lane >> 3) + 8 * j; const LAS float* s = scr + (8 * c) * 33 + n;
        u32x2 o; o.x = cvt4_fp8(s[0 * 33], s[1 * 33], s[2 * 33], s[3 * 33]); o.y = cvt4_fp8(s[4 * 33], s[5 * 33], s[6 * 33], s[7 * 33]);
        *(u32x2*)(WT + (size_t)(drow0 + n) * dld + dcol0 + 8 * c) = o; }
    asm volatile("s_waitcnt lgkmcnt(0)" ::: "memory");
}
__device__ __forceinline__ void transpose_mat_item(const float* W, int K, int N, bf16_t* WT, int dld, int drow_base, int dcol_base, int item, LAS float* scr, int lane) {
    const int nblk = N / 32, kb = item / nblk, nb = item % nblk;
    transpose_item(W, N, 64 * kb, 32 * nb, WT, dld, drow_base + 32 * nb, dcol_base + 64 * kb, scr, lane);
}
__device__ __forceinline__ void convert_range(const float* src, bf16_t* dst, size_t n8, size_t i0, size_t stride) {
    for (size_t i = i0; i < n8; i += stride) { const f32x4 a = *(const f32x4*)(src + i * 8), b = *(const f32x4*)(src + i * 8 + 4);
        u32x4 w; w.x = cvt_pk_bf16(a[0], a[1]); w.y = cvt_pk_bf16(a[2], a[3]); w.z = cvt_pk_bf16(b[0], b[1]); w.w = cvt_pk_bf16(b[2], b[3]);
        *(u32x4*)(dst + i * 8) = w; }
}

__device__ __forceinline__ void ada_item(const Ctx& C, int item) {
    const int l = item / 96, nb = item % 96, n0 = nb * 128, w = C.wave, lane = C.lane;
    const float* cP = C.in[2]; const float* cS = C.in[3]; const float* W = C.in[9] + (size_t)l * 2048 * 12288 + n0 + 2 * lane; const float* bias = C.in[10] + (size_t)l * 12288 + n0;
    LAS float* scr = (LAS float*)(C.lds + w * 4608);
    LAS float* sum = (LAS float*)(C.lds + 36864);
    f32x2 acc[34];
#pragma unroll
    for (int s = 0; s < 34; ++s) acc[s] = (f32x2){0.f, 0.f};
    for (int sub = 0; sub < 8; ++sub) {
        const int k0 = 256 * w + 32 * sub;
#pragma unroll
        for (int i = 0; i < 17; ++i) { const int idx = lane + 64 * i, s = idx >> 5, kk = idx & 31;
            const float cv = (s < 2) ? cP[s * 2048 + k0 + kk] : cS[(s - 2) * 2048 + k0 + kk];
            scr[kk * 36 + s] = cv * fsigmoid(cv); }
        asm volatile("s_waitcnt lgkmcnt(0)" ::: "memory");
#pragma unroll 1
        for (int kq = 0; kq < 2; ++kq) {
            f32x2 wv[16];
#pragma unroll
            for (int kk = 0; kk < 16; ++kk) wv[kk] = *(const f32x2*)(W + (size_t)(k0 + 16 * kq + kk) * 12288);
#pragma unroll
            for (int kk = 0; kk < 16; ++kk) {
#pragma unroll
                for (int s4 = 0; s4 < 9; ++s4) { const f32x4 sv = *(const LAS f32x4*)(scr + (16 * kq + kk) * 36 + 4 * s4);
#pragma unroll
                    for (int i = 0; i < 4; ++i) if (4 * s4 + i < 34) acc[4 * s4 + i] += wv[kk] * sv[i]; }
                asm volatile("" ::: "memory");
            }
        }
        asm volatile("s_waitcnt lgkmcnt(0)" ::: "memory");
    }
    for (int ww = 0; ww < 8; ++ww) {
        if (w == ww) {
#pragma unroll
            for (int s = 0; s < 34; ++s) { LAS f32x2* p = (LAS f32x2*)(sum + s * 128) + lane; if (ww == 0) *p = acc[s]; else *p = *p + acc[s]; }
        }
        __syncthreads();
    }
    float* mod = (float*)(C.ws + WS_MOD);
    for (int s = w; s < 34; s += 8) { const f32x2 v = *((LAS f32x2*)(sum + s * 128) + lane) + *(const f32x2*)(bias + 2 * lane);
        *(f32x2*)(mod + ((size_t)l * NSEQ + s) * 12288 + n0 + 2 * lane) = v; }
    __syncthreads();
}

namespace bq {
constexpr int I_IN = 32 * 96, I_GATE = 16 * 8, I_POOL = 4 * 32, I_OUTR = 32 * 64, I_Q = 32 * 64, I_KEYS = 256, I_TAB = 16384  , I_DQ = 32 * 16, I_DKV = 32 * 10,
              I_ROPE = 1024, I_UQ = 8 * 96, I_UKV = 4 * 128, I_OUTA = 32 * 64;
constexpr int E_IN = I_IN, E_GATE = E_IN + I_GATE, E_POOL = E_GATE + I_POOL, E_OUTR = E_POOL + I_OUTR, E_Q0 = E_OUTR + I_Q, E_KEYS = E_Q0 + I_KEYS, E_TAB0 = E_KEYS + I_TAB, E_DQ = E_TAB0 + I_DQ,
              E_DKV = E_DQ + I_DKV, E_ROPE = E_DKV + I_ROPE, E_UQ = E_ROPE + I_UQ, E_UKV = E_UQ + I_UKV, E_OUTA = E_UKV + I_OUTA, E_Q1 = E_OUTA + I_Q, E_TAB1 = E_Q1 + I_TAB, NTOT = E_TAB1;
static_assert(NTOT % 8 == 0 && E_IN % 8 == 0 && E_POOL % 8 == 0 && E_OUTR % 8 == 0 && E_Q0 % 8 == 0 && E_KEYS % 8 == 0 && E_TAB0 % 8 == 0 && E_DKV % 8 == 0 && E_ROPE % 8 == 0 && E_UKV % 8 == 0 && E_OUTA % 8 == 0 && E_Q1 % 8 == 0, "queue segments are whole workgroup items");
constexpr int CW_QHEAD = 64, CW_DONE = 128;
constexpr int LDS_SLOT = LDS_MISC + 32;
constexpr size_t TAB_L1 = 16 * MiB;

__device__ __forceinline__ void fp4_row_pair(const float* src, unsigned char* dst, float scale, int r0, int lane) {
    f32x4 a[16];
#pragma unroll
    for (int b = 0; b < 16; ++b) a[b] = *(const f32x4*)(src + (size_t)(r0 + (b >> 3)) * 2048 + 4 * lane + 256 * (b & 7)) * scale;
#pragma unroll
    for (int rr = 0; rr < 2; ++rr) { u32x4 w;
#pragma unroll
        for (int q = 0; q < 4; ++q) { float e[8] = {a[8 * rr + 2 * q][0], a[8 * rr + 2 * q][1], a[8 * rr + 2 * q][2], a[8 * rr + 2 * q][3], a[8 * rr + 2 * q + 1][0], a[8 * rr + 2 * q + 1][1], a[8 * rr + 2 * q + 1][2], a[8 * rr + 2 * q + 1][3]};
#pragma unroll
            for (int j = 0; j < 8; ++j) e[j] = fminf(fmaxf(e[j], -6.0f), 6.0f);
            unsigned t = 0u; t = __builtin_amdgcn_cvt_scalef32_pk_fp4_f32(t, e[0], e[1], 1.0f, 0); t = __builtin_amdgcn_cvt_scalef32_pk_fp4_f32(t, e[2], e[3], 1.0f, 1);
            t = __builtin_amdgcn_cvt_scalef32_pk_fp4_f32(t, e[4], e[5], 1.0f, 2); t = __builtin_amdgcn_cvt_scalef32_pk_fp4_f32(t, e[6], e[7], 1.0f, 3); w[q] = t; }
        *(u32x4*)(dst + (size_t)(r0 + rr) * 1024 + 16 * lane) = w; }
}
__device__ __forceinline__ void table_item(const Ctx& C, int layer, int r, int lane) {
    const int t = r >> 13, rp = r & 8191;
    const float* src = (t ? C.in[34] : C.in[33]) + (size_t)layer * 16384 * 2048; unsigned char* dst = C.ws + (t ? WS_V : WS_U) + (size_t)layer * TAB_L1;
    fp4_row_pair(src, dst, t ? V4_SCALE : U4_SCALE, 2 * rp, lane);
}
__device__ __forceinline__ void wave_item(const Ctx& C, int it, LAS float* scr, int lane) {
    bf16_t* w_in = (bf16_t*)(C.ws + WS_WIN); bf16_t* w_outr = (bf16_t*)(C.ws + WS_WOUTR); bf16_t* w_q = (bf16_t*)(C.ws + WS_WQ);
    bf16_t* w_dqkv = (bf16_t*)(C.ws + WS_WDQKV); bf16_t* w_uq = (bf16_t*)(C.ws + WS_WUQ); bf16_t* w_ukv = (bf16_t*)(C.ws + WS_WUKV);
    bf16_t* w_outa = (bf16_t*)(C.ws + WS_WOUTA); bf16_t* w_gate = (bf16_t*)(C.ws + WS_WGATE); bf16_t* w_pool = (bf16_t*)(C.ws + WS_WPOOL);
    int r = it;
    if (r < I_IN) { transpose_mat_item(C.in[13], 2048, 3072, w_in, 2048, 0, 0, r, scr, lane); return; } r -= I_IN;
    if (r < I_GATE) {
        const int q = r / 8, sub = r % 8, h = q >> 1, gsel = q & 1;
        const float* src = (gsel ? C.in[18] : C.in[16]) + (size_t)h * 128 * 128;
        transpose_mat_item(src, 128, 128, w_gate, 256, h * 256 + gsel * 128, (h & 1) * 128, sub, scr, lane); return; } r -= I_GATE;
    if (r < I_POOL) { const int gq = r / 32, sub = r % 32;
        transpose_mat_item(C.in[21] + (size_t)gq * 256 * 256, 256, 256, w_pool, 256, gq * 256, 0, sub, scr, lane); return; } r -= I_POOL;
    if (r < I_OUTR) { transpose_mat_item(C.in[23], 2048, 2048, w_outr, 2048, 0, 0, r, scr, lane); return; } r -= I_OUTR;
    if (r < I_Q) { transpose_mat_item(C.in[31], 2048, 2048, w_q, 2048, 0, 0, r, scr, lane); return; } r -= I_Q;
    if (r < I_KEYS) { convert_range(C.in[32] + (size_t)r * 2048, (bf16_t*)(C.ws + WS_KEYS) + (size_t)r * 2048, 256, (size_t)lane, 64); return; } r -= I_KEYS;
    if (r < I_TAB) { table_item(C, 0, r, lane); return; } r -= I_TAB;
    if (r < I_DQ) { transpose_mat_item(C.in[24], 2048, 512, w_dqkv, 2048, 0, 0, r, scr, lane); return; } r -= I_DQ;
    if (r < I_DKV) { transpose_mat_item(C.in[27], 2048, 320, w_dqkv, 2048, 512, 0, r, scr, lane); return; } r -= I_DKV;
    if (r < I_ROPE) {
        float* rope = (float*)(C.ws + WS_ROPE);
        for (int q = 0; q < 8; ++q) { const int i = r * 512 + q * 64 + lane, pos = i >> 5, j = i & 31;
            double inv = 1.0; for (int qq = 0; qq < j; ++qq) inv *= 0.7498942093324559;
            const double rev = (double)pos * inv * 0.15915494309189535; const float fr = (float)(rev - __builtin_floor(rev));
            rope[(size_t)pos * 64 + j] = __builtin_amdgcn_cosf(fr); rope[(size_t)pos * 64 + 32 + j] = __builtin_amdgcn_sinf(fr); }
        return; } r -= I_ROPE;
    if (r < I_UQ) {
        const int kb = r / 96, nb = r % 96, n0 = 32 * nb, h = n0 / 192, d = n0 % 192;
        const int drow = (d < 128) ? h * 128 + d : 2048 + (h >> 2) * 256 + ((d - 128) >> 5) * 128 + (h & 3) * 32;
        transpose_item_f8(C.in[26], 3072, 64 * kb, n0, (unsigned char*)w_uq, 512, drow, 64 * kb, scr, lane); return; } r -= I_UQ;
    if (r < I_UKV) { const int nblk = 4096 / 32, kb = r / nblk, nb = r % nblk;
        transpose_item_f8(C.in[29], 4096, 64 * kb, 32 * nb, (unsigned char*)w_ukv, 256, 32 * nb, 64 * kb, scr, lane); return; } r -= I_UKV;
    if (r < I_OUTA) { const int nblk = 2048 / 32, kb = r / nblk, nb = r % nblk;
        transpose_item_f8(C.in[30], 2048, 64 * kb, 32 * nb, (unsigned char*)w_outa, 2048, 32 * nb, 64 * kb, scr, lane); return; } r -= I_OUTA;
    if (r < I_Q) { transpose_mat_item(C.in[31] + (size_t)2048 * 2048, 2048, 2048, w_q + (size_t)2048 * 2048, 2048, 0, 0, r, scr, lane); return; } r -= I_Q;
    table_item(C, 1, r, lane);
}
__device__ __forceinline__ void service(const Ctx& C, bool fill, int slot, int limit, bool signal = true) {
    unsigned* ctl = (unsigned*)(C.ws + WS_CTL); unsigned* qhead = ctl + CW_QHEAD; unsigned* done = ctl + CW_DONE + slot;
    volatile LAS int* lslot = (volatile LAS int*)(C.lds + LDS_SLOT);
    LAS float* scr = (LAS float*)(C.lds + 72704 + C.wave * 8448);
    __syncthreads();
    if (fill && signal && C.tid == 0) __hip_atomic_fetch_add(done, 1u, __ATOMIC_RELAXED, __HIP_MEMORY_SCOPE_AGENT);
    const unsigned lim = fill ? (unsigned)(NTOT / 8) : (unsigned)(limit / 8);
    for (;;) {
        if (C.tid == 0) { int it = -1;
            const unsigned h = __hip_atomic_load(qhead, __ATOMIC_RELAXED, __HIP_MEMORY_SCOPE_AGENT);
            bool go = h < lim;
            if (go && fill) go = __hip_atomic_load(done, __ATOMIC_RELAXED, __HIP_MEMORY_SCOPE_AGENT) < (unsigned)C.G;
            if (go) { const unsigned t = __hip_atomic_fetch_add(qhead, 1u, __ATOMIC_RELAXED, __HIP_MEMORY_SCOPE_AGENT); if (t < (unsigned)(NTOT / 8)) it = (int)t; }
            *lslot = it; }
        __syncthreads();
        const int it = *lslot;
        __syncthreads();
        if (it < 0) break;
        { Ctx D = C; int ln = C.lane; asm volatile("" : "+v"(ln)); D.lane = ln;
          wave_item(D, it * 8 + C.wave, scr, ln); }
    }
}
}

__device__ __forceinline__ void phase_prologue(const Ctx& C) {
    const int lane = C.lane;
    constexpr int NADA = 192;
    for (int it = C.vcu; it < NADA; it += C.G) ada_item(C, it);
    bq::service(C, true, 0, 0);
    const size_t gt = (size_t)C.vcu * 512 + C.tid, GT = (size_t)C.G * 512;
    { float* sp = (float*)(C.ws + WS_SP);
      for (size_t i = gt; i < 1024; i += GT) { sp[i] = C.in[17][i]; sp[1024 + i] = C.in[19][i]; const float y = fexp(-C.in[20][i]); sp[2048 + i] = (y < 0.03f) ? y * (1.0f - y * (0.5f - y * (0.33333333f - y * (0.25f - 0.2f * y)))) : 0.6931471805599453f * __builtin_amdgcn_logf(1.0f + y); } }
}
__device__ __forceinline__ void norm_mod_row(const float* xrow, const float* g, const float* shift, const float* scale, bf16_t* orow, int lane) {
    f32x4 v[8]; float ss = 0.f;
#pragma unroll
    for (int j = 0; j < 8; ++j) { v[j] = *((const f32x4*)xrow + lane + 64 * j); ss += (v[j].x * v[j].x + v[j].y * v[j].y) + (v[j].z * v[j].z + v[j].w * v[j].w); }
    const float rstd = __builtin_amdgcn_rsqf(wave_sum(ss) * (1.0f / DM) + RMS_EPS);
#pragma unroll
    for (int j = 0; j < 8; ++j) { const int q = lane + 64 * j; const f32x4 gv = *((const f32x4*)g + q), sc = *((const f32x4*)scale + q), sh = *((const f32x4*)shift + q);
        const f32x4 y = v[j] * rstd * gv * (sc + 1.0f) + sh;
        u32x2 w; w.x = cvt_pk_bf16(y.x, y.y); w.y = cvt_pk_bf16(y.z, y.w); *((u32x2*)orow + q) = w; }
}
__device__ __forceinline__ void phase_norm(const Ctx& C, const float* xP, const float* xS, const float* g, const float* modl, int part, bf16_t* hn) {
    const int lane = C.lane; int m = C.gw; if (m >= MT) return;
    f32x4 gv[8];
#pragma unroll
    for (int j = 0; j < 8; ++j) gv[j] = *((const f32x4*)g + lane + 64 * j);
    f32x4 nv[8];
    { const float* xr = (m < MP) ? xP + (size_t)m * DM : xS + (size_t)(m - MP) * DM;
#pragma unroll
      for (int j = 0; j < 8; ++j) nv[j] = *((const f32x4*)xr + lane + 64 * j); }
    for (; m < MT; m += C.NGW) {
        f32x4 v[8];
#pragma unroll
        for (int j = 0; j < 8; ++j) v[j] = nv[j];
        const int mn = m + C.NGW;
        if (mn < MT) { const float* xr = (mn < MP) ? xP + (size_t)mn * DM : xS + (size_t)(mn - MP) * DM;
#pragma unroll
            for (int j = 0; j < 8; ++j) nv[j] = *((const f32x4*)xr + lane + 64 * j); }
        const float* mp = modl + (size_t)seq_of_row(m) * 12288 + part * 2048;
        f32x4 sc[8], sh[8];
#pragma unroll
        for (int j = 0; j < 8; ++j) { const int q = lane + 64 * j; sh[j] = *((const f32x4*)mp + q); sc[j] = *((const f32x4*)(mp + 2048) + q); }
        float ss = 0.f;
#pragma unroll
        for (int j = 0; j < 8; ++j) ss += (v[j].x * v[j].x + v[j].y * v[j].y) + (v[j].z * v[j].z + v[j].w * v[j].w);
        const float rstd = __builtin_amdgcn_rsqf(wave_sum(ss) * (1.0f / DM) + RMS_EPS);
#pragma unroll
        for (int j = 0; j < 8; ++j) { const int q = lane + 64 * j; const f32x4 y = v[j] * rstd * gv[j] * (sc[j] + 1.0f) + sh[j];
            u32x2 w; w.x = cvt_pk_bf16(y.x, y.y); w.y = cvt_pk_bf16(y.z, y.w); *((u32x2*)(hn + (size_t)m * DM) + q) = w; }
    }
}
__device__ __forceinline__ void phase_resid_norm(const Ctx& C, const float* xP, const float* xS, const bf16_t* mix, float* X, const float* g, const float* modl, bf16_t* hn) {
    const int lane = C.lane; int m = C.gw; if (m >= MT) return;
    f32x4 gv[8];
#pragma unroll
    for (int j = 0; j < 8; ++j) gv[j] = *((const f32x4*)g + lane + 64 * j);
    f32x4 nx[8]; u32x2 nm[8];
    { const float* xr = (m < MP) ? xP + (size_t)m * DM : xS + (size_t)(m - MP) * DM;
#pragma unroll
      for (int j = 0; j < 8; ++j) { const int q = lane + 64 * j; nx[j] = *((const f32x4*)xr + q); nm[j] = *((const u32x2*)(mix + (size_t)m * DM) + q); } }
    for (; m < MT; m += C.NGW) {
        f32x4 v[8]; u32x2 mw[8];
#pragma unroll
        for (int j = 0; j < 8; ++j) { v[j] = nx[j]; mw[j] = nm[j]; }
        const int mn = m + C.NGW;
        if (mn < MT) { const float* xr = (mn < MP) ? xP + (size_t)mn * DM : xS + (size_t)(mn - MP) * DM;
#pragma unroll
            for (int j = 0; j < 8; ++j) { const int q = lane + 64 * j; nx[j] = *((const f32x4*)xr + q); nm[j] = *((const u32x2*)(mix + (size_t)mn * DM) + q); } }
        const float* mp = modl + (size_t)seq_of_row(m) * 12288;
        float ss = 0.f;
#pragma unroll
        for (int j = 0; j < 8; ++j) { const int q = lane + 64 * j; const f32x4 g1 = *((const f32x4*)(mp + 2 * 2048) + q);
            v[j] = v[j] + g1 * (f32x4){bf_lo(mw[j].x), bf_hi(mw[j].x), bf_lo(mw[j].y), bf_hi(mw[j].y)}; ss += (v[j].x * v[j].x + v[j].y * v[j].y) + (v[j].z * v[j].z + v[j].w * v[j].w);
            *((f32x4*)(X + (size_t)m * DM) + q) = v[j]; }
        const float rstd = __builtin_amdgcn_rsqf(wave_sum(ss) * (1.0f / DM) + RMS_EPS);
#pragma unroll
        for (int j = 0; j < 8; ++j) { const int q = lane + 64 * j; const f32x4 sh = *((const f32x4*)(mp + 3 * 2048) + q), sc = *((const f32x4*)(mp + 4 * 2048) + q);
            const f32x4 y = v[j] * rstd * gv[j] * (sc + 1.0f) + sh;
            u32x2 w; w.x = cvt_pk_bf16(y.x, y.y); w.y = cvt_pk_bf16(y.z, y.w); *((u32x2*)(hn + (size_t)m * DM) + q) = w; }
    }
}

__device__ __forceinline__ void ld8bf(const bf16_t* p, float (&v)[8]) { const u32x4 w = *(const u32x4*)p; v[0] = bf_lo(w.x); v[1] = bf_hi(w.x); v[2] = bf_lo(w.y); v[3] = bf_hi(w.y); v[4] = bf_lo(w.z); v[5] = bf_hi(w.z); v[6] = bf_lo(w.w); v[7] = bf_hi(w.w); }
__device__ __forceinline__ void ld8f(const float* p, float (&v)[8]) { const f32x4 a = *(const f32x4*)p, b = *(const f32x4*)(p + 4); v[0] = a.x; v[1] = a.y; v[2] = a.z; v[3] = a.w; v[4] = b.x; v[5] = b.y; v[6] = b.z; v[7] = b.w; }
__device__ __forceinline__ void st8bf(bf16_t* p, const float (&v)[8]) { u32x4 w; w.x = cvt_pk_bf16(v[0], v[1]); w.y = cvt_pk_bf16(v[2], v[3]); w.z = cvt_pk_bf16(v[4], v[5]); w.w = cvt_pk_bf16(v[6], v[7]); *(u32x4*)p = w; }
__device__ __forceinline__ void st8f(float* p, const float (&v)[8]) { *(f32x4*)p = (f32x4){v[0], v[1], v[2], v[3]}; *(f32x4*)(p + 4) = (f32x4){v[4], v[5], v[6], v[7]}; }

__device__ __forceinline__ void phase_convpool(const Ctx& C) {
    const bf16_t* __restrict__ REC = (const bf16_t*)(C.ws + A_B2); const bf16_t* __restrict__ PIN = REC + (size_t)MT * 1024;
    bf16_t* __restrict__ XC = (bf16_t*)(C.ws + A_B3); bf16_t* __restrict__ POOLED = XC + (size_t)MT * 1024;
    const float* convw = C.in[14]; const float* convb = C.in[15]; const float* st_conv = C.in[4]; const float* st_pool = C.in[6];
    const int NITEM = 2 * 544 * 128;
    for (int it0 = C.vcu * 512 + C.tid; it0 < NITEM; it0 += C.G * 512) {
        const bool is_pool = it0 >= 544 * 128; const int it = is_pool ? it0 - 544 * 128 : it0;
        const int chunk = it >> 7, ch0 = (it & 127) * 8;
        const bool samp = chunk >= 512; const int sb = chunk - 512;
        const int row0 = samp ? MP + sb * 64 : chunk * 64;
        const int t0 = samp ? 0 : (chunk & 255) * 64;
        const bool lastc = samp || ((chunk & 255) == 255);
        if (!is_pool) {
            float w0[8], w1[8], w2[8], w3[8], bb[8], p0[8], p1[8], p2[8];
            ld8f(convw + ch0, w0); ld8f(convw + 1024 + ch0, w1); ld8f(convw + 2048 + ch0, w2); ld8f(convw + 3072 + ch0, w3); ld8f(convb + ch0, bb);
            if (samp) { ld8f(st_conv + ((size_t)sb * 3 + 0) * 1024 + ch0, p0); ld8f(st_conv + ((size_t)sb * 3 + 1) * 1024 + ch0, p1); ld8f(st_conv + ((size_t)sb * 3 + 2) * 1024 + ch0, p2); }
            else if (t0 > 0) { ld8bf(REC + (size_t)(row0 - 3) * 1024 + ch0, p0); ld8bf(REC + (size_t)(row0 - 2) * 1024 + ch0, p1); ld8bf(REC + (size_t)(row0 - 1) * 1024 + ch0, p2); }
            else {
#pragma unroll
                for (int j = 0; j < 8; ++j) { p0[j] = 0.f; p1[j] = 0.f; p2[j] = 0.f; } }
            for (int tb = 0; tb < 64; tb += 8) {
                u32x4 raw[8];
#pragma unroll
                for (int q = 0; q < 8; ++q) raw[q] = *(const u32x4*)(REC + (size_t)(row0 + tb + q) * 1024 + ch0);
#pragma unroll
                for (int q = 0; q < 8; ++q) { const u32x4 w = raw[q]; const float cur[8] = {bf_lo(w.x), bf_hi(w.x), bf_lo(w.y), bf_hi(w.y), bf_lo(w.z), bf_hi(w.z), bf_lo(w.w), bf_hi(w.w)}; float o[8];
#pragma unroll
                    for (int j = 0; j < 8; ++j) { o[j] = bb[j] + w0[j] * p0[j] + w1[j] * p1[j] + w2[j] * p2[j] + w3[j] * cur[j]; p0[j] = p1[j]; p1[j] = p2[j]; p2[j] = cur[j]; }
                    st8bf(XC + (size_t)(row0 + tb + q) * 1024 + ch0, o); } }
            if (lastc) { float* dst = samp ? C.out + O_CONV_S + (size_t)sb * 3 * 1024 : C.out + O_CONV_P + (size_t)(chunk >> 8) * 3 * 1024;
                st8f(dst + ch0, p0); st8f(dst + 1024 + ch0, p1); st8f(dst + 2048 + ch0, p2); }
        } else {
            const int gsel = ch0 >> 8, w = 2 << gsel;
            float S[8];
#pragma unroll
            for (int j = 0; j < 8; ++j) S[j] = 0.f;
            for (int tt = 1 - w; tt < 0; ++tt) { float v[8];
                if (samp) ld8f(st_pool + ((size_t)sb * 15 + 15 + tt) * 1024 + ch0, v);
                else if (t0 + tt >= 0) ld8bf(PIN + (size_t)(row0 + tt) * 1024 + ch0, v);
                else {
#pragma unroll
                    for (int j = 0; j < 8; ++j) v[j] = 0.f; }
#pragma unroll
                for (int j = 0; j < 8; ++j) S[j] += v[j]; }
            for (int tb = 0; tb < 64; tb += 8) {
                u32x4 rawc[8]; float oldv[8][8];
#pragma unroll
                for (int q = 0; q < 8; ++q) rawc[q] = *(const u32x4*)(PIN + (size_t)(row0 + tb + q) * 1024 + ch0);
#pragma unroll
                for (int q = 0; q < 8; ++q) { const int tt = tb + q - w + 1;
                    if (tt >= 0 || (!samp && t0 + tt >= 0)) ld8bf(PIN + (size_t)(row0 + tt) * 1024 + ch0, oldv[q]);
                    else if (samp) ld8f(st_pool + ((size_t)sb * 15 + 15 + tt) * 1024 + ch0, oldv[q]);
                    else {
#pragma unroll
                        for (int j = 0; j < 8; ++j) oldv[q][j] = 0.f; } }
#pragma unroll
                for (int q = 0; q < 8; ++q) { const u32x4 wv = rawc[q]; const float cur[8] = {bf_lo(wv.x), bf_hi(wv.x), bf_lo(wv.y), bf_hi(wv.y), bf_lo(wv.z), bf_hi(wv.z), bf_lo(wv.w), bf_hi(wv.w)}; float o[8];
                    const int pos = samp ? 1024 + tb + q : t0 + tb + q; const float rc = 1.0f / (float)((pos + 1 < w) ? pos + 1 : w);
#pragma unroll
                    for (int j = 0; j < 8; ++j) { S[j] += cur[j]; o[j] = S[j] * rc - cur[j]; S[j] -= oldv[q][j]; }
                    st8bf(POOLED + (size_t)(row0 + tb + q) * 1024 + ch0, o); } }
            if (lastc) { float* dst = samp ? C.out + O_POOL_S + (size_t)sb * 15 * 1024 : C.out + O_POOL_P + (size_t)(chunk >> 8) * 15 * 1024;
                for (int i = 0; i < 15; ++i) { float v[8]; ld8bf(PIN + (size_t)(row0 + 49 + i) * 1024 + ch0, v); st8f(dst + (size_t)i * 1024 + ch0, v); } }
        }
    }
}

__device__ __forceinline__ void phase_scanA(const Ctx& C) {
    const float* __restrict__ A = (const float*)(C.ws + A_B4); const bf16_t* __restrict__ U = (const bf16_t*)(A + (size_t)MT * 1024);
    float* __restrict__ cP = (float*)(C.ws + WS_SCAN); float* __restrict__ cH = cP + SCAN_WORDS;
    for (int it = C.vcu * 512 + C.tid; it < 544 * 256; it += C.G * 512) {
        const int chunk = it >> 8, ch = (it & 255) * 4; const int row0 = chunk * 64;
        f32x4 P = {1.f, 1.f, 1.f, 1.f}, H = {0.f, 0.f, 0.f, 0.f};
        for (int tb = 0; tb < 64; tb += 8) { f32x4 av[8], uv[8];
#pragma unroll
            for (int q = 0; q < 8; ++q) { av[q] = *(const f32x4*)(A + (size_t)(row0 + tb + q) * 1024 + ch); const u32x2 uw = *(const u32x2*)(U + (size_t)(row0 + tb + q) * 1024 + ch); uv[q] = (f32x4){bf_lo(uw.x), bf_hi(uw.x), bf_lo(uw.y), bf_hi(uw.y)}; }
#pragma unroll
            for (int q = 0; q < 8; ++q) { H = av[q] * H + uv[q]; P = P * av[q]; } }
        *(f32x4*)(cP + (size_t)chunk * 1024 + ch) = P; *(f32x4*)(cH + (size_t)chunk * 1024 + ch) = H;
    }
}
__device__ __forceinline__ void phase_scanB(const Ctx& C) {
    const float* __restrict__ cP = (const float*)(C.ws + WS_SCAN); const float* __restrict__ cH = cP + SCAN_WORDS; float* __restrict__ cI = (float*)(C.ws + WS_SCAN) + 2 * SCAN_WORDS;
    const int it = C.vcu * 512 + C.tid;
    if (it < 2048) { const int s = it >> 10, ch = it & 1023; float carry = 0.f;
        for (int cb = 0; cb < 256; cb += 16) { float pv[16], hv[16];
#pragma unroll
            for (int q = 0; q < 16; ++q) { const size_t o = (size_t)(s * 256 + cb + q) * 1024 + ch; pv[q] = cP[o]; hv[q] = cH[o]; }
#pragma unroll
            for (int q = 0; q < 16; ++q) { cI[(size_t)(s * 256 + cb + q) * 1024 + ch] = carry; carry = pv[q] * carry + hv[q]; } } }
}
__device__ __forceinline__ void phase_scanC(const Ctx& C) {
    const float* __restrict__ A = (const float*)(C.ws + A_B4); const bf16_t* __restrict__ U = (const bf16_t*)(A + (size_t)MT * 1024); const float* __restrict__ cI = (const float*)(C.ws + WS_SCAN) + 2 * SCAN_WORDS;
    const bf16_t* __restrict__ GG = (const bf16_t*)(C.ws + A_GG); bf16_t* __restrict__ CAT = (bf16_t*)(C.ws + A_HN); const float* hprev = C.in[5];
    for (int it = C.vcu * 512 + C.tid; it < 544 * 256; it += C.G * 512) {
        const int chunk = it >> 8, ch = (it & 255) * 4; const int row0 = chunk * 64; const bool samp = chunk >= 512;
        f32x4 h = samp ? *(const f32x4*)(hprev + (size_t)(chunk - 512) * 1024 + ch) : *(const f32x4*)(cI + (size_t)chunk * 1024 + ch);
        for (int tb = 0; tb < 64; tb += 8) { f32x4 av[8], uv[8]; u32x2 gv[8];
#pragma unroll
            for (int q = 0; q < 8; ++q) { const size_t o = (size_t)(row0 + tb + q) * 1024 + ch; av[q] = *(const f32x4*)(A + o); { const u32x2 uw = *(const u32x2*)(U + o); uv[q] = (f32x4){bf_lo(uw.x), bf_hi(uw.x), bf_lo(uw.y), bf_hi(uw.y)}; } gv[q] = *(const u32x2*)(GG + o); }
#pragma unroll
            for (int q = 0; q < 8; ++q) { h = av[q] * h + uv[q];
                u32x2 w; w.x = cvt_pk_bf16(bf_lo(gv[q].x) * h.x, bf_hi(gv[q].x) * h.y); w.y = cvt_pk_bf16(bf_lo(gv[q].y) * h.z, bf_hi(gv[q].y) * h.w);
                *(u32x2*)(CAT + (size_t)(row0 + tb + q) * 2048 + ch) = w; } }
        if (samp) *(f32x4*)(C.out + O_H_S + (size_t)(chunk - 512) * 1024 + ch) = h;
        else if ((chunk & 255) == 255) *(f32x4*)(C.out + O_H_P + (size_t)(chunk >> 8) * 1024 + ch) = h;
    }
}

__device__ __forceinline__ void phase_latent(const Ctx& C) {
    const float* CQKV = (const float*)(C.ws + A_B3); bf16_t* CQ = (bf16_t*)(C.ws + A_CQ); bf16_t* CKV = (bf16_t*)(C.ws + A_CKV); unsigned char* KP = C.ws + A_KP;
    const float* gq = C.in[25]; const float* gkv = C.in[28]; const float* rope = (const float*)(C.ws + WS_ROPE); const int lane = C.lane;
    for (int m = C.gw; m < MT; m += C.NGW) {
        const float* r = CQKV + (size_t)m * 1024; const int kvr = kvrow_of_row(m);
        { float v[8]; ld8f(r + lane * 8, v); float ss = 0.f;
#pragma unroll
          for (int j = 0; j < 8; ++j) ss += v[j] * v[j];
          const float rstd = __builtin_amdgcn_rsqf(wave_sum(ss) * (1.0f / 512) + RMS_EPS); float g[8]; ld8f(gq + lane * 8, g);
#pragma unroll
          for (int j = 0; j < 8; ++j) v[j] = v[j] * rstd * g[j];
          { u32x2 w8; w8.x = cvt4_fp8(v[0], v[1], v[2], v[3]); w8.y = cvt4_fp8(v[4], v[5], v[6], v[7]); *(u32x2*)((unsigned char*)CQ + (size_t)m * 512 + lane * 8) = w8; } }
        { const f32x4 v = *(const f32x4*)(r + 512 + lane * 4); const float ss = (v.x * v.x + v.y * v.y) + (v.z * v.z + v.w * v.w);
          const float rstd = __builtin_amdgcn_rsqf(wave_sum(ss) * (1.0f / 256) + RMS_EPS); const f32x4 y = v * rstd * *(const f32x4*)(gkv + lane * 4);
          *(f32x4*)(C.out + O_CKV + (size_t)m * 256 + lane * 4) = y;
          *(unsigned*)((unsigned char*)CKV + (size_t)kvr * 256 + lane * 4) = cvt4_fp8(y.x, y.y, y.z, y.w); }
        { const float x = r[768 + lane]; const float xo = __shfl_xor(x, 32); const int j = lane & 31; const float* rp = rope + (size_t)pos_of_row(m) * 64;
          const float c = rp[j], s = rp[32 + j]; const float y = (lane < 32) ? x * c - xo * s : xo * s + x * c;
          C.out[O_KPE + (size_t)m * 64 + lane] = y; KP[(size_t)kvr * 64 + lane] = (unsigned char)(cvt4_fp8(y, 0.f, 0.f, 0.f) & 0xffu); }
    }
    const size_t gt = (size_t)C.vcu * 512 + C.tid, GT = (size_t)C.G * 512;
    for (size_t i = gt; i < (size_t)32 * 1024 * 256 / 8; i += GT) { const size_t e = i * 8, rowc = e / 256, col = e % 256, b = rowc / 1024, p = rowc % 1024;
        float v[8]; ld8f(C.in[7] + e, v); u32x2 w8; w8.x = cvt4_fp8(v[0], v[1], v[2], v[3]); w8.y = cvt4_fp8(v[4], v[5], v[6], v[7]); *(u32x2*)((unsigned char*)CKV + ((size_t)MP + b * 1088 + p) * 256 + col) = w8; }
    for (size_t i = gt; i < (size_t)32 * 1024 * 64 / 8; i += GT) { const size_t e = i * 8, rowc = e / 64, col = e % 64, b = rowc / 1024, p = rowc % 1024;
        float v[8]; ld8f(C.in[8] + e, v); u32x2 w8; w8.x = cvt4_fp8(v[0], v[1], v[2], v[3]); w8.y = cvt4_fp8(v[4], v[5], v[6], v[7]); *(u32x2*)(KP + ((size_t)MP + b * 1088 + p) * 64 + col) = w8; }
}
typedef __bf16 bf2_t __attribute__((ext_vector_type(2)));
__device__ __forceinline__ unsigned ford(float f) { const unsigned u = __float_as_uint(f); return (u & 0x80000000u) ? ~u : (u | 0x80000000u); }
__device__ __forceinline__ float funord(unsigned o) { return __uint_as_float((o & 0x80000000u) ? (o & 0x7fffffffu) : ~o); }
__device__ __forceinline__ unsigned umax(unsigned a, unsigned b) { return a > b ? a : b; }
__device__ __forceinline__ unsigned umin(unsigned a, unsigned b) { return a < b ? a : b; }
__device__ __forceinline__ void ins16(unsigned (&L)[16], unsigned x) {
#pragma unroll
    for (int i = 0; i < 16; ++i) { const unsigned t = umax(L[i], x); x = umin(L[i], x); L[i] = t; }
}
__device__ __forceinline__ void ins16p(unsigned (&K)[16], unsigned (&P)[16], unsigned key, unsigned pay) {
#pragma unroll
    for (int i = 0; i < 16; ++i) { const bool c = key > K[i]; const unsigned tk = c ? key : K[i], nk = c ? K[i] : key, tp = c ? pay : P[i], np = c ? P[i] : pay; K[i] = tk; P[i] = tp; key = nk; pay = np; }
}
__device__ __forceinline__ void sort16_desc(unsigned (&v)[16]) {
#pragma unroll
    for (int k = 2; k <= 16; k <<= 1)
#pragma unroll
        for (int j = k >> 1; j >= 1; j >>= 1)
#pragma unroll
            for (int i = 0; i < 16; ++i) { const int l = i ^ j; if (l > i) { const bool desc = ((i & k) == 0); const unsigned a = v[i], b = v[l], hi = umax(a, b), lo = umin(a, b); v[i] = desc ? hi : lo; v[l] = desc ? lo : hi; } }
}
__device__ __forceinline__ void merge16_desc(unsigned (&A)[16], const unsigned (&B)[16]) {
#pragma unroll
    for (int i = 0; i < 16; ++i) A[i] = umax(A[i], B[15 - i]);
#pragma unroll
    for (int st = 8; st >= 1; st >>= 1)
#pragma unroll
        for (int i = 0; i < 16; ++i) if ((i & st) == 0) { const unsigned a = A[i], b = A[i + st]; A[i] = umax(a, b); A[i + st] = umin(a, b); }
}
__device__ __forceinline__ void subkey_top16(const bf16_t* qrow  , const bf16_t* krow  , int hh, unsigned (&S)[16]) {
    bf16x8 qf[8];
#pragma unroll
    for (int s = 0; s < 8; ++s) qf[s] = *(const bf16x8*)(qrow + 16 * s);
    unsigned L[16];
#pragma unroll
    for (int i = 0; i < 16; ++i) L[i] = 0u;
#pragma unroll 1
    for (int kb = 0; kb < 4; ++kb) {
        bf16x8 kf[8];
#pragma unroll
        for (int s = 0; s < 8; ++s) kf[s] = *(const bf16x8*)(krow + (size_t)kb * 32 * 128 + 16 * s);
        f32x16 a = {0.f, 0.f, 0.f, 0.f, 0.f, 0.f, 0.f, 0.f, 0.f, 0.f, 0.f, 0.f, 0.f, 0.f, 0.f, 0.f};
#pragma unroll
        for (int s = 0; s < 8; ++s) a = __builtin_amdgcn_mfma_f32_32x32x16_bf16(kf[s], qf[s], a, 0, 0, 0);
        unsigned N[16];
#pragma unroll
        for (int r = 0; r < 16; ++r) { const unsigned idx = (unsigned)(32 * kb + (r & 3) + 8 * (r >> 2) + 4 * hh); N[r] = (ford(a[r]) & ~0x7fu) | idx; }
        sort16_desc(N); merge16_desc(L, N);
        asm volatile("" ::: "memory");
    }
    unsigned P[16];
#pragma unroll
    for (int i = 0; i < 16; ++i) P[i] = (unsigned)__shfl_xor((int)L[i], 32);
#pragma unroll
    for (int i = 0; i < 16; ++i) S[i] = L[i];
    merge16_desc(S, P);
}
__device__ __forceinline__ void phase_topk(const Ctx& C, int layer) {
    const bf16_t* Q = (const bf16_t*)(C.ws + A_B3); const bf16_t* KEYS = (const bf16_t*)(C.ws + WS_KEYS) + (size_t)layer * 8 * 2 * 128 * 128;
    int* IDX = (int*)(C.ws + A_B4); float* GATE = (float*)(C.ws + A_B4) + (size_t)MT * 128;
    const int lane = C.lane, r = lane & 31, hh = lane >> 5;
    for (int task = C.gw; task < (MT / 32) * 8; task += C.NGW) {
        const int tg = task >> 3, h = task & 7, m = tg * 32 + r;
        unsigned S1[16], S2[16];
        subkey_top16(Q + (size_t)m * 2048 + h * 256 + 8 * hh, KEYS + ((size_t)(h * 2 + 0) * 128 + r) * 128 + 8 * hh, hh, S1);
        subkey_top16(Q + (size_t)m * 2048 + h * 256 + 128 + 8 * hh, KEYS + ((size_t)(h * 2 + 1) * 128 + r) * 128 + 8 * hh, hh, S2);
#define CKEY(a, b) ((ford(funord(S1[a] & ~0x7fu) + funord(S2[b] & ~0x7fu)) & ~0xffu) | (unsigned)((a) << 4 | (b)))
        unsigned FK[16], G[16];
#pragma unroll
        for (int b = 0; b < 16; ++b) FK[b] = CKEY(0, b);
#pragma unroll
        for (int b = 0; b < 8; ++b) G[b] = CKEY(1, b);
#pragma unroll
        for (int b = 0; b < 5; ++b) G[8 + b] = CKEY(2, b);
#pragma unroll
        for (int b = 0; b < 3; ++b) G[13 + b] = CKEY(4, b);
        sort16_desc(G); merge16_desc(FK, G);
#pragma unroll
        for (int b = 0; b < 4; ++b) G[b] = CKEY(3, b);
#pragma unroll
        for (int b = 0; b < 2; ++b) { G[4 + b] = CKEY(5, b); G[6 + b] = CKEY(6, b); G[8 + b] = CKEY(7, b); }
#pragma unroll
        for (int a = 8; a < 14; ++a) G[2 + a] = CKEY(a, 0);
        sort16_desc(G); merge16_desc(FK, G);
        ins16(FK, CKEY(14, 0)); ins16(FK, CKEY(15, 0));
#undef CKEY
        unsigned I1p[4], I2p[4];
#pragma unroll
        for (int w = 0; w < 4; ++w) { I1p[w] = (S1[4 * w] & 0x7fu) | ((S1[4 * w + 1] & 0x7fu) << 8) | ((S1[4 * w + 2] & 0x7fu) << 16) | ((S1[4 * w + 3] & 0x7fu) << 24);
                                      I2p[w] = (S2[4 * w] & 0x7fu) | ((S2[4 * w + 1] & 0x7fu) << 8) | ((S2[4 * w + 2] & 0x7fu) << 16) | ((S2[4 * w + 3] & 0x7fu) << 24); }
        const float mx = funord(FK[0] & ~0xffu); float sum = 0.f;
#pragma unroll
        for (int i = 0; i < 16; ++i) sum += fexp(funord(FK[i] & ~0xffu) - mx);
        const float rs = 1.0f / sum;
        int oi[8]; float og[8];
#pragma unroll
        for (int i = 0; i < 8; ++i) { const unsigned key = hh ? FK[8 + i] : FK[i]; const unsigned a = (key >> 4) & 15u, b = key & 15u;
            const unsigned w1 = (a >> 2) == 0u ? I1p[0] : ((a >> 2) == 1u ? I1p[1] : ((a >> 2) == 2u ? I1p[2] : I1p[3]));
            const unsigned w2 = (b >> 2) == 0u ? I2p[0] : ((b >> 2) == 1u ? I2p[1] : ((b >> 2) == 2u ? I2p[2] : I2p[3]));
            oi[i] = (int)((((w1 >> ((a & 3u) * 8u)) & 0x7fu) << 7) | ((w2 >> ((b & 3u) * 8u)) & 0x7fu));
            og[i] = fexp(funord(key & ~0xffu) - mx) * rs; }
        const size_t o = (size_t)m * 128 + h * 16 + 8 * hh;
        *(u32x4*)(IDX + o) = (u32x4){(unsigned)oi[0], (unsigned)oi[1], (unsigned)oi[2], (unsigned)oi[3]}; *(u32x4*)(IDX + o + 4) = (u32x4){(unsigned)oi[4], (unsigned)oi[5], (unsigned)oi[6], (unsigned)oi[7]};
        *(f32x4*)(GATE + o) = (f32x4){og[0], og[1], og[2], og[3]}; *(f32x4*)(GATE + o + 4) = (f32x4){og[4], og[5], og[6], og[7]};
    }
}

template <int CTRL, int ROWMASK> __device__ __forceinline__ float dppf(float v) { return __builtin_bit_cast(float, __builtin_amdgcn_update_dpp(0, __builtin_bit_cast(int, v), CTRL, ROWMASK, 0xF, false)); }
__device__ __forceinline__ float wave_sum_u(float v) {
    v += dppf<0xB1, 0xF>(v); v += dppf<0x4E, 0xF>(v); v += dppf<0x141, 0xF>(v); v += dppf<0x140, 0xF>(v);
    v += dppf<0x142, 0xA>(v); v += dppf<0x143, 0xC>(v);
    return __builtin_bit_cast(float, __builtin_amdgcn_readlane(__builtin_bit_cast(int, v), 63));
}
struct RowSet4 { u32x4 u, v; };
__device__ __forceinline__ void load_rows4(RowSet4& R, const unsigned char* U4, const unsigned char* V4, int eid, int lane) {
    const size_t o = (size_t)eid * 1024 + lane * 16; R.u = *(const u32x4*)(U4 + o); R.v = *(const u32x4*)(V4 + o);
}
__device__ __forceinline__ void use_rows4(const u32x4 Ru, const u32x4 Rv, const float (&xf)[32], float gate, float (&out)[32]) {
    float d0 = 0.f, d1 = 0.f;
#define U4_STEP(w, b) { const f32x2 t = __builtin_amdgcn_cvt_scalef32_pk_f32_fp4(Ru[w], 1.0f, b); d0 = fmaf(xf[8 * (w) + 2 * (b)], t.x, d0); d1 = fmaf(xf[8 * (w) + 2 * (b) + 1], t.y, d1); }
#define U4_WORD(w) U4_STEP(w, 0) U4_STEP(w, 1) U4_STEP(w, 2) U4_STEP(w, 3)
    U4_WORD(0) U4_WORD(1) U4_WORD(2) U4_WORD(3)
#undef U4_WORD
#undef U4_STEP
    const float d = wave_sum_u(d0 + d1) * (1.0f / U4_SCALE);
    const float a = gelu_erf(d) * gate * (1.0f / V4_SCALE);
#define V4_STEP(w, b) { const f32x2 t = __builtin_amdgcn_cvt_scalef32_pk_f32_fp4(Rv[w], 1.0f, b); out[8 * (w) + 2 * (b)] = fmaf(a, t.x, out[8 * (w) + 2 * (b)]); out[8 * (w) + 2 * (b) + 1] = fmaf(a, t.y, out[8 * (w) + 2 * (b) + 1]); }
#define V4_WORD(w) V4_STEP(w, 0) V4_STEP(w, 1) V4_STEP(w, 2) V4_STEP(w, 3)
    V4_WORD(0) V4_WORD(1) V4_WORD(2) V4_WORD(3)
#undef V4_WORD
#undef V4_STEP
}
typedef _Float16 h16x2 __attribute__((ext_vector_type(2)));
__device__ __forceinline__ float dot_row4(const u32x4 Ru, const h16x2 (&xh)[16]) {
    float d0 = 0.f, d1 = 0.f;
#define U4_STEP(w, b, D) { const h16x2 t = __builtin_amdgcn_cvt_scalef32_pk_f16_fp4(Ru[w], 1.0f, b); D = __builtin_amdgcn_fdot2(xh[4 * (w) + (b)], t, D, false); }
#define U4_WORD(w) U4_STEP(w, 0, d0) U4_STEP(w, 1, d1) U4_STEP(w, 2, d0) U4_STEP(w, 3, d1)
    U4_WORD(0) U4_WORD(1) U4_WORD(2) U4_WORD(3)
#undef U4_WORD
#undef U4_STEP
    return wave_sum_u(d0 + d1);
}
typedef int i32x8 __attribute__((ext_vector_type(8)));
__device__ __forceinline__ float dot_row4_mfma(const u32x4 Ru, const i32x8& xhi, const i32x8& xlo, int dsel, bool dval) {
    const i32x8 a = {(int)Ru.x, (int)Ru.y, (int)Ru.z, (int)Ru.w, 0, 0, 0, 0};
    f32x4 d = {0.f, 0.f, 0.f, 0.f};
    d = __builtin_amdgcn_mfma_scale_f32_16x16x128_f8f6f4(a, xhi, d, 4, 0, 0, 127, 0, 127);
    d = __builtin_amdgcn_mfma_scale_f32_16x16x128_f8f6f4(a, xlo, d, 4, 0, 0, 127, 0, 123);
    float v = dsel == 0 ? d[0] : (dsel == 1 ? d[1] : (dsel == 2 ? d[2] : d[3]));
    v = dval ? v : 0.f;
    return wave_sum_u(v);
}
__device__ __forceinline__ void axpy_row4(const u32x4 Rv, float a, float (&out)[32]) {
#define V4_STEP(w, b) { const f32x2 t = __builtin_amdgcn_cvt_scalef32_pk_f32_fp4(Rv[w], 1.0f, b); out[8 * (w) + 2 * (b)] = fmaf(a, t.x, out[8 * (w) + 2 * (b)]); out[8 * (w) + 2 * (b) + 1] = fmaf(a, t.y, out[8 * (w) + 2 * (b) + 1]); }
#define V4_WORD(w) V4_STEP(w, 0) V4_STEP(w, 1) V4_STEP(w, 2) V4_STEP(w, 3)
    V4_WORD(0) V4_WORD(1) V4_WORD(2) V4_WORD(3)
#undef V4_WORD
#undef V4_STEP
}
__device__ __forceinline__ void phase_gather(const Ctx& C, int layer) {
    const bf16_t* HN2 = (const bf16_t*)(C.ws + A_B2); const unsigned char* U4 = C.ws + WS_U + (size_t)layer * bq::TAB_L1; const unsigned char* V4 = C.ws + WS_V + (size_t)layer * bq::TAB_L1;
    const int* IDX = (const int*)(C.ws + A_B4); const float* GATE = (const float*)(C.ws + A_B4) + (size_t)MT * 128;
    const float* mod = (const float*)(C.ws + WS_MOD); float* X = C.out + O_Y; bf16_t* HN = (bf16_t*)(C.ws + A_HN);
    const int lane = C.lane;
    int m = C.gw; if (m >= MT) return;
    LAS unsigned char* ring = C.lds + C.wave * 16384;
    int i0 = IDX[(size_t)m * 128 + lane], i1 = IDX[(size_t)m * 128 + 64 + lane];
    float g0 = GATE[(size_t)m * 128 + lane], g1 = GATE[(size_t)m * 128 + 64 + lane];
    u32x2 xw[8];
#pragma unroll
    for (int b = 0; b < 8; ++b) xw[b] = *(const u32x2*)(HN2 + (size_t)m * 2048 + 256 * b + 4 * lane);
#pragma unroll
    for (int b = 0; b < 8; ++b) asm volatile("" : "+v"(xw[b]));
    asm volatile("" : "+v"(i0), "+v"(i1), "+v"(g0), "+v"(g1));
    asm volatile("s_waitcnt vmcnt(0)" ::: "memory");
#define SB() __builtin_amdgcn_sched_barrier(0)
    const unsigned lo16 = (unsigned)lane * 16u;
#define ROW_DMA(T, eid_, s_) __builtin_amdgcn_global_load_lds((const unsigned*)((const char*)((T) + (size_t)(eid_) * 1024) + lo16), (LAS unsigned*)(ring + ((s_) & 15) * 1024), 16, 0, 0)
#define EIDC(j) __builtin_amdgcn_readlane(((j) < 64) ? i0 : i1, (j) & 63)
#pragma unroll
    for (int j = 0; j < 14; ++j) ROW_DMA(U4, __builtin_amdgcn_readlane(i0, j), j);
    for (;;) {
        const int mn = m + C.NGW; const bool has_next = mn < MT; const int mq = has_next ? mn : m;
        int ni0, ni1; float ng0, ng1; u32x2 nx[8];
        int lt = lane; asm volatile("" : "+v"(lt));
        { const int* ip = IDX + (size_t)mq * 128 + lt; const float* gp = GATE + (size_t)mq * 128 + lt; const bf16_t* xp = HN2 + (size_t)mq * 2048 + 4 * lt;
          asm volatile("global_load_dword %0, %1, off" : "=v"(ni0) : "v"(ip) : "memory");
          asm volatile("global_load_dword %0, %1, off offset:256" : "=v"(ni1) : "v"(ip) : "memory");
          asm volatile("global_load_dword %0, %1, off" : "=v"(ng0) : "v"(gp) : "memory");
          asm volatile("global_load_dword %0, %1, off offset:256" : "=v"(ng1) : "v"(gp) : "memory");
          asm volatile("global_load_dwordx2 %0, %1, off" : "=v"(nx[0]) : "v"(xp) : "memory");
          asm volatile("global_load_dwordx2 %0, %1, off offset:512" : "=v"(nx[1]) : "v"(xp) : "memory");
          asm volatile("global_load_dwordx2 %0, %1, off offset:1024" : "=v"(nx[2]) : "v"(xp) : "memory");
          asm volatile("global_load_dwordx2 %0, %1, off offset:1536" : "=v"(nx[3]) : "v"(xp) : "memory");
          asm volatile("global_load_dwordx2 %0, %1, off offset:2048" : "=v"(nx[4]) : "v"(xp) : "memory");
          asm volatile("global_load_dwordx2 %0, %1, off offset:2560" : "=v"(nx[5]) : "v"(xp) : "memory");
          asm volatile("global_load_dwordx2 %0, %1, off offset:3072" : "=v"(nx[6]) : "v"(xp) : "memory");
          asm volatile("global_load_dwordx2 %0, %1, off offset:3584" : "=v"(nx[7]) : "v"(xp) : "memory"); }
        i32x8 xhi, xlo;
#pragma unroll
        for (int b = 0; b < 8; ++b) { const float x0 = bf_lo(xw[b].x), x1 = bf_hi(xw[b].x), x2 = bf_lo(xw[b].y), x3 = bf_hi(xw[b].y);
            const float c0 = fminf(fmaxf(x0, -448.f), 448.f), c1 = fminf(fmaxf(x1, -448.f), 448.f), c2 = fminf(fmaxf(x2, -448.f), 448.f), c3 = fminf(fmaxf(x3, -448.f), 448.f);
            int th = 0; th = __builtin_amdgcn_cvt_pk_fp8_f32(c0, c1, th, false); th = __builtin_amdgcn_cvt_pk_fp8_f32(c2, c3, th, true);
            const f32x2 h01 = __builtin_amdgcn_cvt_pk_f32_fp8(th, false), h23 = __builtin_amdgcn_cvt_pk_f32_fp8(th, true);
            int tl = 0; tl = __builtin_amdgcn_cvt_pk_fp8_f32((c0 - h01.x) * 16.f, (c1 - h01.y) * 16.f, tl, false); tl = __builtin_amdgcn_cvt_pk_fp8_f32((c2 - h23.x) * 16.f, (c3 - h23.y) * 16.f, tl, true);
            xhi[b] = th; xlo[b] = tl; }
        const int dsel = lane & 3; const bool dval = ((lane & 15) >> 2) == (lane >> 4);
        { const int jj = lane & 15, gg = lane >> 4, srcA = (jj + 16 * (gg >> 1)) << 2, srcB = (jj + 16 * (2 + (gg >> 1))) << 2; const bool odd = gg & 1;
          i32x8 nh, nl;
#pragma unroll
          for (int d = 0; d < 4; ++d) {
              const int a0 = __builtin_amdgcn_ds_bpermute(srcA, xhi[d]), a1 = __builtin_amdgcn_ds_bpermute(srcA, xhi[4 + d]), b0 = __builtin_amdgcn_ds_bpermute(srcB, xhi[d]), b1 = __builtin_amdgcn_ds_bpermute(srcB, xhi[4 + d]);
              nh[d] = odd ? a1 : a0; nh[4 + d] = odd ? b1 : b0;
              const int c0 = __builtin_amdgcn_ds_bpermute(srcA, xlo[d]), c1 = __builtin_amdgcn_ds_bpermute(srcA, xlo[4 + d]), e0 = __builtin_amdgcn_ds_bpermute(srcB, xlo[d]), e1 = __builtin_amdgcn_ds_bpermute(srcB, xlo[4 + d]);
              nl[d] = odd ? c1 : c0; nl[4 + d] = odd ? e1 : e0; }
          xhi = nh; xlo = nl; }
        float dv0 = 0.f, dv1 = 0.f;
#define U_ITER2(e, VMN, DV, NEXT_T, NEXT_E0, NEXT_E1) do { ROW_DMA(NEXT_T, NEXT_E0, (e) + 14); ROW_DMA(NEXT_T, NEXT_E1, (e) + 15); asm volatile("s_waitcnt vmcnt(" #VMN ")" ::: "memory"); \
            const u32x4 ru0 = *(const LAS u32x4*)(ring + ((e) & 15) * 1024 + lo16), ru1 = *(const LAS u32x4*)(ring + (((e) + 1) & 15) * 1024 + lo16); \
            const float da = dot_row4_mfma(ru0, xhi, xlo, dsel, dval), db = dot_row4_mfma(ru1, xhi, xlo, dsel, dval); \
            DV = (lane == ((e) & 63)) ? da : DV; DV = (lane == (((e) + 1) & 63)) ? db : DV; } while (0)
#pragma unroll 1
        for (int e = 0; e < 14; e += 2) U_ITER2(e, 26, dv0, U4, EIDC(e + 14), EIDC(e + 15));
#pragma unroll 1
        for (int e = 14; e < 64; e += 2) U_ITER2(e, 14, dv0, U4, EIDC(e + 14), EIDC(e + 15));
#pragma unroll 1
        for (int e = 64; e < 114; e += 2) U_ITER2(e, 14, dv1, U4, EIDC(e + 14), EIDC(e + 15));
#pragma unroll 1
        for (int e = 114; e < 128; e += 2) U_ITER2(e, 14, dv1, V4, EIDC(e - 114), EIDC(e - 113));
#undef U_ITER2
        asm volatile("" : "+v"(ni0), "+v"(ni1), "+v"(ng0), "+v"(ng1));
#pragma unroll
        for (int b = 0; b < 8; ++b) asm volatile("" : "+v"(nx[b]));
        const float av0 = gelu_erf(dv0 * (1.0f / U4_SCALE)) * g0 * (1.0f / V4_SCALE), av1 = gelu_erf(dv1 * (1.0f / U4_SCALE)) * g1 * (1.0f / V4_SCALE);
        float out[32];
#pragma unroll
        for (int i = 0; i < 32; ++i) out[i] = 0.f;
#define V_ITER2(e, AV, NEXT_T, NEXT_E0, NEXT_E1) do { ROW_DMA(NEXT_T, NEXT_E0, (e) + 14); ROW_DMA(NEXT_T, NEXT_E1, (e) + 15); asm volatile("s_waitcnt vmcnt(14)" ::: "memory"); \
            const u32x4 rv0 = *(const LAS u32x4*)(ring + ((e) & 15) * 1024 + lo16), rv1 = *(const LAS u32x4*)(ring + (((e) + 1) & 15) * 1024 + lo16); \
            const float a0 = __builtin_bit_cast(float, __builtin_amdgcn_readlane(__builtin_bit_cast(int, AV), (e) & 63)), a1 = __builtin_bit_cast(float, __builtin_amdgcn_readlane(__builtin_bit_cast(int, AV), ((e) + 1) & 63)); \
            axpy_row4(rv0, a0, out); axpy_row4(rv1, a1, out); } while (0)
#pragma unroll 1
        for (int e = 0; e < 64; e += 2) V_ITER2(e, av0, V4, EIDC(e + 14), EIDC(e + 15));
#pragma unroll 1
        for (int e = 64; e < 114; e += 2) V_ITER2(e, av1, V4, EIDC(e + 14), EIDC(e + 15));
#pragma unroll 1
        for (int e = 114; e < 128; e += 2) V_ITER2(e, av1, U4, __builtin_amdgcn_readlane(ni0, e - 114), __builtin_amdgcn_readlane(ni0, e - 113));
#undef V_ITER2
        int le = lane; asm volatile("" : "+v"(le));
        const int sq = seq_of_row(m); const float* g2 = mod + ((size_t)layer * NSEQ + sq) * 12288 + 5 * 2048; float* xr = X + (size_t)m * DM;
        float ss = 0.f;
#pragma unroll
        for (int hb = 0; hb < 2; ++hb) {
            f32x4 xo[4], gg[4];
#pragma unroll
            for (int b = 0; b < 4; ++b) { const int c = 256 * (4 * hb + b) + 4 * le; xo[b] = *(const f32x4*)(xr + c); gg[b] = *(const f32x4*)(g2 + c); }
            SB();
#pragma unroll
            for (int b = 0; b < 4; ++b) {
#pragma unroll
                for (int j = 0; j < 4; ++j) { const float v = xo[b][j] + gg[b][j] * out[4 * (4 * hb + b) + j]; out[4 * (4 * hb + b) + j] = v; ss += v * v; } }
            SB();
        }
        const float rstd = __builtin_amdgcn_rsqf(wave_sum(ss) * (1.0f / DM) + RMS_EPS);
        if (layer == 0) {
            const float* n1g = C.in[11] + 2048; const float* mp = mod + ((size_t)1 * NSEQ + sq) * 12288;
#pragma unroll
            for (int hb = 0; hb < 2; ++hb) {
                f32x4 gv[4], sh[4], sc[4];
#pragma unroll
                for (int b = 0; b < 4; ++b) { const int c = 256 * (4 * hb + b) + 4 * le; gv[b] = *(const f32x4*)(n1g + c); sh[b] = *(const f32x4*)(mp + c); sc[b] = *(const f32x4*)(mp + 2048 + c); }
                SB();
#pragma unroll
                for (int b = 0; b < 4; ++b) { const int bb = 4 * hb + b, c = 256 * bb + 4 * le;
                    const f32x4 xs = {out[4 * bb], out[4 * bb + 1], out[4 * bb + 2], out[4 * bb + 3]}; const f32x4 y = xs * rstd * gv[b] * (sc[b] + 1.0f) + sh[b];
                    *(f32x4*)(xr + c) = xs; u32x2 w; w.x = cvt_pk_bf16(y[0], y[1]); w.y = cvt_pk_bf16(y[2], y[3]); *(u32x2*)(HN + (size_t)m * DM + c) = w; }
                SB();
            }
        } else {
            const float* fg = C.in[35];
            f32x4 gv[8];
#pragma unroll
            for (int b = 0; b < 8; ++b) gv[b] = *(const f32x4*)(fg + 256 * b + 4 * le);
            SB();
#pragma unroll
            for (int b = 0; b < 8; ++b) { const int c = 256 * b + 4 * le; const f32x4 xs = {out[4 * b], out[4 * b + 1], out[4 * b + 2], out[4 * b + 3]};
                *(f32x4*)(xr + c) = xs * rstd * gv[b]; }
        }
        if (!has_next) break;
        m = mn; i0 = ni0; i1 = ni1; g0 = ng0; g1 = ng1;
#pragma unroll
        for (int b = 0; b < 8; ++b) xw[b] = nx[b];
    }
    asm volatile("s_waitcnt vmcnt(0)" ::: "memory");
#undef ROW_DMA
#undef EIDC
#undef SB
}
namespace att {
constexpr int SHM_K = 64 * 208, SHM_V = 64 * 256;
constexpr int OFF_K = 0, OFF_V = 2 * SHM_K, OFF_WS = 2 * SHM_K + 2 * SHM_V;
constexpr float SCALE = 0.07216878364870322f;
constexpr float THR = 8.f;
__device__ __forceinline__ int crow(int r, int hi) { return (r & 3) + 8 * (r >> 2) + 4 * hi; }
constexpr float THR2 = THR * 1.4426950408889634f;
__device__ __forceinline__ void partialSM(f32x16& p0, f32x16& p1, float& mref, f32x16& negm, float& alpha, bool first) {
    float pmax = p0[0];
#pragma unroll
    for (int r = 1; r < 16; ++r) pmax = fmaxf(pmax, p0[r]);
#pragma unroll
    for (int r = 0; r < 16; ++r) pmax = fmaxf(pmax, p1[r]);
    { auto rr = __builtin_amdgcn_permlane32_swap(__float_as_uint(pmax), __float_as_uint(pmax), false, false);
      pmax = fmaxf(__uint_as_float(rr[0]), __uint_as_float(rr[1])); }
    if (__builtin_expect(!first && __all(pmax <= THR2), 1)) { alpha = 1.f; }
    else { const float dl = first ? pmax : fmaxf(pmax, 0.f); alpha = first ? 1.f : __builtin_amdgcn_exp2f(-dl); mref += dl;
#pragma unroll
        for (int r = 0; r < 16; ++r) { negm[r] = -mref; p0[r] -= dl; p1[r] -= dl; }
        asm volatile("" : "+v"(negm)); }
#pragma unroll
    for (int r = 0; r < 16; ++r) p0[r] = __builtin_amdgcn_exp2f(p0[r]);
#pragma unroll
    for (int r = 0; r < 16; ++r) p1[r] = __builtin_amdgcn_exp2f(p1[r]);
}
__device__ __forceinline__ void finishSM(const f32x16& p0, const f32x16& p1, float alpha, float& l_reg, bf16x8& pa0, bf16x8& pa1, bf16x8& pa2, bf16x8& pa3) {
    float ps = 0;
#pragma unroll
    for (int r = 0; r < 16; ++r) ps += p0[r];
#pragma unroll
    for (int r = 0; r < 16; ++r) ps += p1[r];
    { auto rr = __builtin_amdgcn_permlane32_swap(__float_as_uint(ps), __float_as_uint(ps), false, false);
      ps = __uint_as_float(rr[0]) + __uint_as_float(rr[1]); }
    l_reg = l_reg * alpha + ps;
#define PK4(P, BASE, OUT) do { unsigned a0 = cvt_pk_bf16(P[BASE + 0], P[BASE + 1]), a1 = cvt_pk_bf16(P[BASE + 2], P[BASE + 3]);   \
    unsigned b0 = cvt_pk_bf16(P[BASE + 4], P[BASE + 5]), b1 = cvt_pk_bf16(P[BASE + 6], P[BASE + 7]);                              \
    auto r0 = __builtin_amdgcn_permlane32_swap(a0, b0, false, false); auto r1 = __builtin_amdgcn_permlane32_swap(a1, b1, false, false); \
    u32x4 w = {r0[0], r1[0], r0[1], r1[1]}; OUT = __builtin_bit_cast(bf16x8, w); } while (0)
    PK4(p0, 0, pa0); PK4(p0, 8, pa1); PK4(p1, 0, pa2); PK4(p1, 8, pa3);
#undef PK4
}
template <int OFF> __device__ __forceinline__ bf16x8 k_read(int addr) { bf16x8 r; asm volatile("ds_read_b128 %0, %1 offset:%2" : "=v"(r) : "v"(addr), "i"(OFF) : "memory"); return r; }
template <int I> __device__ __forceinline__ bf16x8 kfrag(const int (&kad)[4]) { constexpr int d0 = I >> 1, half = I & 1; return k_read<(d0 >> 2) * 128 + half * 12288>(kad[d0 & 3]); }
__device__ __forceinline__ void packSM(const f32x16& p0, const f32x16& p1, bf16x8& pa0, bf16x8& pa1, bf16x8& pa2, bf16x8& pa3) {
#define PK4(P, BASE, OUT) do { unsigned a0 = cvt_pk_bf16(P[BASE + 0], P[BASE + 1]), a1 = cvt_pk_bf16(P[BASE + 2], P[BASE + 3]);   \
    unsigned b0 = cvt_pk_bf16(P[BASE + 4], P[BASE + 5]), b1 = cvt_pk_bf16(P[BASE + 6], P[BASE + 7]);                              \
    auto r0 = __builtin_amdgcn_permlane32_swap(a0, b0, false, false); auto r1 = __builtin_amdgcn_permlane32_swap(a1, b1, false, false); \
    u32x4 w = {r0[0], r1[0], r0[1], r1[1]}; OUT = __builtin_bit_cast(bf16x8, w); } while (0)
    PK4(p0, 0, pa0); PK4(p0, 8, pa1); PK4(p1, 0, pa2); PK4(p1, 8, pa3);
#undef PK4
}
__device__ __forceinline__ int v_rd_base(int lane) { return ((lane & 3) << 3) | (((lane >> 2) & 3) << 6) | (((lane >> 4) & 1) << 5) | (((lane >> 5) & 1) << 8); }
constexpr int v_rd_off(int d0, int ks, int half) { return d0 * 512 + ks * 4096 + half * 2048; }
template <int OFF> __device__ __forceinline__ s16x4 tr_read(int vb) {
    s16x4 r; asm volatile("ds_read_b64_tr_b16 %0, %1 offset:%2" : "=&v"(r) : "v"(vb), "i"(OFF) : "memory"); return r;
}
template <int D0> __device__ __forceinline__ void pv_one(f32x16& od, int vb, bf16x8 pa0, bf16x8 pa1, bf16x8 pa2, bf16x8 pa3) {
    const s16x4 l0 = tr_read<v_rd_off(D0, 0, 0)>(vb), h0 = tr_read<v_rd_off(D0, 0, 1)>(vb), l1 = tr_read<v_rd_off(D0, 1, 0)>(vb), h1 = tr_read<v_rd_off(D0, 1, 1)>(vb);
    const s16x4 l2 = tr_read<v_rd_off(D0, 2, 0)>(vb), h2 = tr_read<v_rd_off(D0, 2, 1)>(vb), l3 = tr_read<v_rd_off(D0, 3, 0)>(vb), h3 = tr_read<v_rd_off(D0, 3, 1)>(vb);
    asm volatile("s_waitcnt lgkmcnt(0)" ::: "memory"); __builtin_amdgcn_sched_barrier(0);
#define PKV(L, H) (bf16x8){L[0], L[1], L[2], L[3], H[0], H[1], H[2], H[3]}
    od = __builtin_amdgcn_mfma_f32_32x32x16_bf16(pa0, PKV(l0, h0), od, 0, 0, 0);
    od = __builtin_amdgcn_mfma_f32_32x32x16_bf16(pa1, PKV(l1, h1), od, 0, 0, 0);
    od = __builtin_amdgcn_mfma_f32_32x32x16_bf16(pa2, PKV(l2, h2), od, 0, 0, 0);
    od = __builtin_amdgcn_mfma_f32_32x32x16_bf16(pa3, PKV(l3, h3), od, 0, 0, 0);
#undef PKV
}
struct AUnit { int qrow0, kvrow0, ntiles, head, vis0, nact, rev; };

__device__ __forceinline__ bool next_unit(int i, int vcu, int G, AUnit& u) {
    int flat;
    if (G == 256) {
        if (i >= 10) return false;
        if (i < 8) { const int bh = vcu >> 3, s = vcu & 7, base = 16 * (i >> 1); const int qb = (i & 1) ? base + 15 - s : base + s; flat = bh * 64 + qb; }
        else flat = 2048 + vcu * 2 + (i - 8);
    } else { flat = i * G + vcu; if (flat >= 2560) return false; }
    u.rev = (G == 256 && i < 8) ? (i & 1) : 0;
    if (flat < 2048) { const int bh = flat >> 6, qb = flat & 63, b = bh >> 4; u.head = bh & 15; u.qrow0 = b * 16384 + qb * 256; u.kvrow0 = b * 16384; u.ntiles = 4 * qb + 4; u.vis0 = 4 * qb; u.nact = 8; }
    else { const int f = flat - 2048, b = f >> 4; u.head = f & 15; u.qrow0 = MP + b * 64; u.kvrow0 = MP + b * 1088; u.ntiles = 17; u.vis0 = 1 << 20; u.nact = 2; }
    return true;
}

__device__ __forceinline__ void attn_phase(const Ctx& C) {
    bf16_t* Qn = (bf16_t*)(C.ws + A_HN);
    const unsigned char* Q8 = C.ws + A_Q8; const unsigned char* Kn = C.ws + A_KN; const bf16_t* Vv = (const bf16_t*)(C.ws + A_VV);
    LAS unsigned char* lds = C.lds; const int wid = C.wave, lane = C.lane, r32 = lane & 31, hi = lane >> 5;
    LAS float* wsp = (LAS float*)(lds + OFF_WS) + wid * 64; LAS float* li_l = wsp; LAS float* al_l = wsp + 32;
    unsigned ka[2], kst[2]; bool kisn[2];
#pragma unroll
    for (int i = 0; i < 2; ++i) { const int o = ((wid + 8 * i) * 64 + lane) * 16, row = (o / 208) & 63, c = (o % 208) >> 4;
        kisn[i] = !(c >= 8 && c < 12); ka[i] = kisn[i] ? (unsigned)(row * 2048 + (c < 8 ? c : 0) * 16) : (unsigned)(A_KP - A_KN) + (unsigned)(row * 64 + (c - 8) * 16); kst[i] = kisn[i] ? 64u * 2048u : 64u * 64u; }
    const bool kp2 = wid < 5;
    unsigned va[2];
#pragma unroll
    for (int i = 0; i < 2; ++i) { const int by = ((wid * 2 + i) * 64 + lane) * 16, sub = by >> 9, within = by & 511, kk = (sub >> 2) * 8 + (within >> 6), cc = (sub & 3) * 32 + ((within & 63) >> 1);
        const int k = (kk & ~0xC) | ((kk & 4) << 1) | ((kk & 8) >> 1); va[i] = (unsigned)(k * 4096 + cc * 2); }
    const LAS unsigned char* kfr0 = lds + OFF_K + r32 * 208 + 32 * hi;
    const int vb0 = (int)(uintptr_t)(lds + OFF_V) + v_rd_base(lane);
#define ATT_BAR() __builtin_amdgcn_s_barrier()
#define ATT_ISSUE(j, kb, vbi) do { \
        __builtin_amdgcn_global_load_lds((const unsigned*)((const char*)Kn + kc[0]), (LAS unsigned*)(lds + OFF_K + (kb) * SHM_K + wid * 1024), 16, 0, 0); kc[0] += kst[0] * (unsigned)kdir; \
        if (kp2) { __builtin_amdgcn_global_load_lds((const unsigned*)((const char*)Kn + kc[1]), (LAS unsigned*)(lds + OFF_K + (kb) * SHM_K + (wid + 8) * 1024), 16, 0, 0); kc[1] += kst[1] * (unsigned)kdir; } \
      _Pragma("unroll") for (int _i = 0; _i < 2; ++_i) { \
        __builtin_amdgcn_global_load_lds((const unsigned*)((const char*)Vv + vc[_i]), (LAS unsigned*)(lds + OFF_V + (vbi) * SHM_V + (wid * 2 + _i) * 1024), 16, 0, 0); vc[_i] += (unsigned)(64 * 4096 * kdir); } } while (0)
#define PV_STEP(I, PA, L, H, WN) do { asm volatile("s_waitcnt lgkmcnt(" #WN ")" : "+v"(L), "+v"(H) :: "memory"); \
        o[(I) >> 2] = __builtin_amdgcn_mfma_f32_32x32x16_bf16(PA, ((bf16x8){L[0], L[1], L[2], L[3], H[0], H[1], H[2], H[3]}), o[(I) >> 2], 0, 0, 0); \
        if ((I) + 4 < 16) { L = tr_read<v_rd_off((((I) + 4) & 15) >> 2, (I) & 3, 0)>(vb); H = tr_read<v_rd_off((((I) + 4) & 15) >> 2, (I) & 3, 1)>(vb); } \
        __builtin_amdgcn_sched_barrier(0); } while (0)
#define PV_HEAD(VBI) do { vb = vb0 + (VBI) * SHM_V; \
      l0 = tr_read<v_rd_off(0, 0, 0)>(vb); h0 = tr_read<v_rd_off(0, 0, 1)>(vb); l1 = tr_read<v_rd_off(0, 1, 0)>(vb); h1 = tr_read<v_rd_off(0, 1, 1)>(vb); \
      l2 = tr_read<v_rd_off(0, 2, 0)>(vb); h2 = tr_read<v_rd_off(0, 2, 1)>(vb); l3 = tr_read<v_rd_off(0, 3, 0)>(vb); h3 = tr_read<v_rd_off(0, 3, 1)>(vb); } while (0)
#define PV_BODY() do { \
      __builtin_amdgcn_s_setprio(1); PV_STEP(0, pa0, l0, h0, 6);  PV_STEP(1, pa1, l1, h1, 6);  PV_STEP(2, pa2, l2, h2, 6);  PV_STEP(3, pa3, l3, h3, 6); \
      PV_STEP(4, pa0, l0, h0, 6);  PV_STEP(5, pa1, l1, h1, 6);  PV_STEP(6, pa2, l2, h2, 6);  PV_STEP(7, pa3, l3, h3, 6); \
      PV_STEP(8, pa0, l0, h0, 6);  PV_STEP(9, pa1, l1, h1, 6);  PV_STEP(10, pa2, l2, h2, 6); PV_STEP(11, pa3, l3, h3, 6); \
      PV_STEP(12, pa0, l0, h0, 6); PV_STEP(13, pa1, l1, h1, 4); PV_STEP(14, pa2, l2, h2, 2); PV_STEP(15, pa3, l3, h3, 0); __builtin_amdgcn_s_setprio(0); } while (0)
#define ATT_PV(VBI) do { PV_HEAD(VBI); PV_BODY(); } while (0)
    AUnit u;
#ifndef PROBE_ATT
#define PROBE_ATT 0
#endif
#if PROBE_ATT
    for (int ui2 = 0; next_unit(ui2 >> 1, C.vcu, C.G, u); ++ui2) { const bool dummy = !(ui2 & 1);
#else
    for (int ui = 0; next_unit(ui, C.vcu, C.G, u); ++ui) { const bool dummy = false;
#endif
        const bool active = wid < u.nact; const int vis = u.vis0 + (wid >> 1);
        const int qrow = u.qrow0 + wid * 32 + r32;
        i32x8 qf[3];
        if (active) { const unsigned char* qp = Q8 + (size_t)qrow * 3072 + u.head * 192 + 32 * hi;
#pragma unroll
            for (int s = 0; s < 3; ++s) { const u32x4 a = *(const u32x4*)(qp + 64 * s), b = *(const u32x4*)(qp + 64 * s + 16);
                qf[s] = (i32x8){(int)a.x, (int)a.y, (int)a.z, (int)a.w, (int)b.x, (int)b.y, (int)b.z, (int)b.w}; }
        } else {
#pragma unroll
            for (int s = 0; s < 3; ++s) qf[s] = (i32x8){0, 0, 0, 0, 0, 0, 0, 0};
        }
#pragma unroll
        for (int s = 0; s < 3; ++s) asm volatile("" : "+v"(qf[s]));
        float mref = 0.f, l_reg = 0.f; f32x16 o[4]; f32x16 negm;
#pragma unroll
        for (int r = 0; r < 16; ++r) negm[r] = 0.f;
        asm volatile("" : "+v"(negm));
#pragma unroll
        for (int d = 0; d < 4; ++d)
#pragma unroll
            for (int r = 0; r < 16; ++r) o[d][r] = 0.f;
        bf16x8 pa0, pa1, pa2, pa3;
        const int NT = u.ntiles;
        const int kdir = u.rev ? -1 : 1, t0 = u.rev ? u.ntiles - 1 : 0;
        bool started = false;
        unsigned kc[2], vc[2];
#pragma unroll
        for (int i = 0; i < 2; ++i) kc[i] = ka[i] + (kisn[i] ? (unsigned)u.kvrow0 * 2048u + (unsigned)u.head * 128u : (unsigned)u.kvrow0 * 64u) + kst[i] * (unsigned)t0;
#pragma unroll
        for (int i = 0; i < 2; ++i) vc[i] = va[i] + (unsigned)u.kvrow0 * 4096u + (unsigned)u.head * 256u + (unsigned)(64 * 4096) * (unsigned)t0;
        ATT_ISSUE(0, 0, 0);
        asm volatile("s_waitcnt vmcnt(0)" ::: "memory");
        ATT_BAR();
        int vb; s16x4 l0, h0, l1, h1, l2, h2, l3, h3;
        for (int j = 0; j < NT; ++j) {
            const int buf = j & 1;
            const int jt = u.rev ? NT - 1 - j : j;
            const bool doQK = active && jt <= vis;
            if (j + 1 < NT) ATT_ISSUE(j + 1, buf ^ 1, buf ^ 1);
            if (doQK) {
                f32x16 p0, p1;
                {
                    const LAS unsigned char* kf = kfr0 + buf * SHM_K;
                    i32x8 ka0[3], ka1[3];
#pragma unroll
                    for (int s = 0; s < 3; ++s) { const u32x4 a = *(const LAS u32x4*)(kf + 64 * s), b = *(const LAS u32x4*)(kf + 64 * s + 16), c = *(const LAS u32x4*)(kf + 32 * 208 + 64 * s), d = *(const LAS u32x4*)(kf + 32 * 208 + 64 * s + 16);
                        ka0[s] = (i32x8){(int)a.x, (int)a.y, (int)a.z, (int)a.w, (int)b.x, (int)b.y, (int)b.z, (int)b.w}; ka1[s] = (i32x8){(int)c.x, (int)c.y, (int)c.z, (int)c.w, (int)d.x, (int)d.y, (int)d.z, (int)d.w}; }
                    __builtin_amdgcn_s_setprio(1);
                    p0 = __builtin_amdgcn_mfma_scale_f32_32x32x64_f8f6f4(ka0[0], qf[0], negm, 0, 0, 0, 127, 0, 127);
                    p1 = __builtin_amdgcn_mfma_scale_f32_32x32x64_f8f6f4(ka1[0], qf[0], negm, 0, 0, 0, 127, 0, 127);
                    p0 = __builtin_amdgcn_mfma_scale_f32_32x32x64_f8f6f4(ka0[1], qf[1], p0, 0, 0, 0, 127, 0, 127);
                    p1 = __builtin_amdgcn_mfma_scale_f32_32x32x64_f8f6f4(ka1[1], qf[1], p1, 0, 0, 0, 127, 0, 127);
                    p0 = __builtin_amdgcn_mfma_scale_f32_32x32x64_f8f6f4(ka0[2], qf[2], p0, 0, 0, 0, 127, 0, 127);
                    p1 = __builtin_amdgcn_mfma_scale_f32_32x32x64_f8f6f4(ka1[2], qf[2], p1, 0, 0, 0, 127, 0, 127);
                    __builtin_amdgcn_s_setprio(0);
                }
                if ((PROBE_ATT == 2 || PROBE_ATT == 5) && dummy) { packSM(p0, p1, pa0, pa1, pa2, pa3); } else {
                float alpha; partialSM(p0, p1, mref, negm, alpha, !started); started = true;
                if (__any(alpha < 1.f)) { if (hi == 0) al_l[r32] = alpha; asm volatile("s_waitcnt lgkmcnt(0)" ::: "memory");
#pragma unroll
                    for (int r = 0; r < 16; ++r) { const float al = al_l[crow(r, hi)];
#pragma unroll
                        for (int d = 0; d < 4; ++d) o[d][r] *= al; } }
                finishSM(p0, p1, alpha, l_reg, pa0, pa1, pa2, pa3);
                }
                if (!((PROBE_ATT == 4 || PROBE_ATT == 5) && dummy)) ATT_PV(buf);
            }
            asm volatile("s_waitcnt vmcnt(0) lgkmcnt(0)" ::: "memory");
            ATT_BAR();
        }
        if (active && !dummy) {
            if (hi == 0) li_l[r32] = l_reg; asm volatile("s_waitcnt lgkmcnt(0)" ::: "memory");
            unsigned char* Ow = (unsigned char*)Qn + (size_t)(u.qrow0 + wid * 32) * 2048 + u.head * 128;
#pragma unroll
            for (int r = 0; r < 16; ++r) { const int orow = crow(r, hi); const float rl = __builtin_amdgcn_rcpf(li_l[orow]);
#pragma unroll
                for (int d0 = 0; d0 < 4; ++d0) { const unsigned w = cvt4_fp8(o[d0][r] * rl, 0.f, 0.f, 0.f); Ow[(size_t)orow * 2048 + d0 * 32 + r32] = (unsigned char)(w & 0xffu); } }
        }
    }
#undef ATT_BAR
#undef ATT_ISSUE
#undef ATT_PV
#undef PV_STEP
#undef PV_HEAD
#undef PV_BODY
}
}
#ifndef MK_SPLIT
#define MK_SPLIT 0
#endif
constexpr int N_PHASES = 22;

__global__ void __launch_bounds__(512, 2) mega_fwd(Args args) {
    extern __shared__ __attribute__((aligned(16))) unsigned char lds_raw[];
    Ctx C;
    C.lds = (LAS unsigned char*)lds_raw;
    C.tid = threadIdx.x; C.lane = C.tid & 63; C.wave = __builtin_amdgcn_readfirstlane(C.tid >> 6);
    C.G = gridDim.x; { const int bx = blockIdx.x; C.vcu = (C.G % 8 == 0) ? (bx % 8) * (C.G / 8) + bx / 8 : bx; }
    C.gw = C.vcu * 8 + C.wave; C.NGW = C.G * 8;
    C.in = args.in; C.out = args.out; C.ws = args.ws;
    volatile LAS unsigned* misc = (volatile LAS unsigned*)(C.lds + LDS_MISC);
    if (C.tid < 4) misc[C.tid] = 0u;
    __syncthreads();
    const int lo = args.ph_lo, hi = args.ph_hi;
    XcdBarrier bar; bar.bar = (unsigned*)(C.ws + WS_CTL) + CW_BAR; bar.x = 0; bar.st = misc;
    if (hi - lo > 1) bar = xcd_barrier_post((unsigned*)(C.ws + WS_CTL) + CW_BAR, misc);
#ifdef PH_ONLY
#define IN(k) ((k) == PH_ONLY)
#else
#define IN(k) (lo <= (k) && (k) < hi)
#endif
#define FILL(k) bq::service(C, true, (k), 0)
#define NEED(k, limit) do { if (IN(k) && (limit) > 0) bq::service(C, false, 0, (limit)); } while (0)
#define SEAM(k) do { if (IN(k) && IN((k) + 1)) xcd_barrier(bar); } while (0)
    unsigned char* ws = C.ws;
    const float* mod = (const float*)(ws + WS_MOD);
    float* X = C.out + O_Y;
    LAS unsigned char* glds = C.lds;

#ifdef PROBE_CLK
#define CLK_BEGIN(k) unsigned long long _t0 = 0, _r0 = 0; if ((k) == PROBE_CLK) { _t0 = __builtin_amdgcn_s_memtime(); _r0 = __builtin_amdgcn_s_memrealtime(); }
#define CLK_END(k) if ((k) == PROBE_CLK && blockIdx.x == 0 && threadIdx.x == 0) { const unsigned long long t1 = __builtin_amdgcn_s_memtime(), r1 = __builtin_amdgcn_s_memrealtime(); \
        const unsigned long long ticks = (t1 - _t0) * 1000ull / (r1 - _r0); while (__builtin_amdgcn_s_memrealtime() - r1 < ticks) __builtin_amdgcn_s_sleep(8); }
#else
#define CLK_BEGIN(k)
#define CLK_END(k)
#endif
    if (IN(0)) { phase_prologue(C); } SEAM(0);
    if (IN(1)) { phase_norm(C, C.in[0], C.in[1], C.in[11], mod, 0, (bf16_t*)(ws + A_HN)); } NEED(1, bq::E_IN); SEAM(1);
    if (IN(2)) {
        pg8::Gemm g{(const bf16_t*)(ws + A_HN), (const bf16_t*)(ws + WS_WIN), MT, 3072, 2048, 2048, 2048, 0, 0}; pg8::StaticOrder S; S.init(MT, 3072, C.G, (int)blockIdx.x);
        pg8::EpiZ E{(bf16_t*)(ws + A_GG), (bf16_t*)(ws + A_B2), (bf16_t*)(ws + A_B2) + (size_t)MT * 1024};
        CLK_BEGIN(2) pg8::gemm_phase<pg8::EpiZ>(glds, g, S, E); CLK_END(2) FILL(2); } SEAM(2);
    if (IN(3)) { phase_convpool(C); } NEED(3, bq::E_POOL); SEAM(3);
    if (IN(4)) {
        { pg8::Gemm g{(const bf16_t*)(ws + A_B3), (const bf16_t*)(ws + WS_WGATE), MT, 2048, 256, 1024, 256, 1, 256}; pg8::StaticOrder S; S.init(MT, 2048, C.G, (int)blockIdx.x);
          pg8::EpiGate E{(const bf16_t*)(ws + A_B3), (const float*)(ws + WS_SP), (float*)(ws + A_B4)};
          pg8::gemm_phase<pg8::EpiGate>(glds, g, S, E); }
        FILL(4); } SEAM(4);
    if (IN(5)) {
        { pg8::Gemm g{(const bf16_t*)(ws + A_B3) + (size_t)MT * 1024, (const bf16_t*)(ws + WS_WPOOL), MT, 1024, 256, 1024, 256, 0, 256}; pg8::StaticOrder S; S.init(MT, 1024, C.G, (int)blockIdx.x);
          pg8::EpiPool E{(bf16_t*)(ws + A_HN), C.in[22]};
          pg8::gemm_phase<pg8::EpiPool>(glds, g, S, E); }
        phase_scanA(C); FILL(5); } SEAM(5);
    if (IN(6)) { phase_scanB(C); } SEAM(6);
    if (IN(7)) { phase_scanC(C); } NEED(7, bq::E_OUTR); SEAM(7);
    if (IN(8)) {
        pg8::Gemm g{(const bf16_t*)(ws + A_HN), (const bf16_t*)(ws + WS_WOUTR), MT, 2048, 2048, 2048, 2048, 0, 0}; pg8::StaticOrder S; S.init(MT, 2048, C.G, (int)blockIdx.x);
        pg8::EpiBf16 E{(bf16_t*)(ws + A_B3), 2048};
        pg8::gemm_phase<pg8::EpiBf16>(glds, g, S, E); FILL(8); } SEAM(8);
#define PEER_BLOCK(P0, L) \
    if (IN(P0)) { phase_resid_norm(C, (L) == 0 ? C.in[0] : X, (L) == 0 ? C.in[1] : X + (size_t)MP * DM, (const bf16_t*)(ws + A_B3), X, C.in[12] + (L) * 2048, mod + (size_t)(L) * NSEQ * 12288, (bf16_t*)(ws + A_B2)); } NEED(P0, (L) == 0 ? bq::E_Q0 : bq::E_Q1); SEAM(P0); \
    if (IN(P0 + 1)) { pg8::Gemm g{(const bf16_t*)(ws + A_B2), (const bf16_t*)(ws + WS_WQ) + (size_t)(L) * 2048 * 2048, MT, 2048, 2048, 2048, 2048, 0, 0}; pg8::StaticOrder S; S.init(MT, 2048, C.G, (int)blockIdx.x); \
        pg8::EpiBf16 E{(bf16_t*)(ws + A_B3), 2048}; pg8::gemm_phase<pg8::EpiBf16>(glds, g, S, E); FILL(P0 + 1); } NEED(P0 + 1, (L) == 0 ? bq::E_KEYS : 0); SEAM(P0 + 1); \
    if (IN(P0 + 2)) { phase_topk(C, L); } NEED(P0 + 2, (L) == 0 ? bq::E_TAB0 : bq::NTOT); SEAM(P0 + 2); \
    if (IN(P0 + 3)) { CLK_BEGIN(P0 + 3) phase_gather(C, L); CLK_END(P0 + 3) }
    PEER_BLOCK(9, 0) NEED(12, bq::E_DKV); SEAM(12);
    if (IN(13)) {
        pg8::Gemm g{(const bf16_t*)(ws + A_HN), (const bf16_t*)(ws + WS_WDQKV), MT, 1024, 2048, 2048, 2048, 0, 0}; pg8::StaticOrder S; S.init(MT, 1024, C.G, (int)blockIdx.x);
        pg8::EpiF32 E{(float*)(ws + A_B3), 1024};
        pg8::gemm_phase<pg8::EpiF32>(glds, g, S, E); FILL(13); } NEED(13, bq::E_ROPE); SEAM(13);
    if (IN(14)) { phase_latent(C); } NEED(14, bq::E_UKV); SEAM(14);
    if (IN(15)) {
        { pg8::Gemm g{(const bf16_t*)(ws + A_CQ), (const bf16_t*)(ws + WS_WUQ), MT, 3072, 256, 256, 256, 0, 0};     pg8::StaticOrder S; S.init(MT, 3072, C.G, (int)blockIdx.x);
          pg8::EpiQ E{ws + A_Q8, (const float*)(ws + WS_ROPE)};
          pg8::gemm_phase<pg8::EpiQ, true>(glds, g, S, E); }
        { pg8::Gemm g{(const bf16_t*)(ws + A_CKV), (const bf16_t*)(ws + WS_WUKV), KVROWS, 4096, 128, 128, 128, 0, 0};     pg8::StaticOrder S; S.init(KVROWS, 4096, C.G, (int)blockIdx.x);
          pg8::EpiKV E{ws + A_KN, (bf16_t*)(ws + A_VV)};
          pg8::gemm_phase<pg8::EpiKV, true>(glds, g, S, E); } FILL(15); } SEAM(15);
    if (IN(16)) { CLK_BEGIN(16) att::attn_phase(C); CLK_END(16) } NEED(16, bq::E_OUTA); SEAM(16);
    if (IN(17)) {
        pg8::Gemm g{(const bf16_t*)(ws + A_HN), (const bf16_t*)(ws + WS_WOUTA), MT, 2048, 1024, 1024, 1024, 0, 0}; pg8::StaticOrder S; S.init(MT, 2048, C.G, (int)blockIdx.x);
        pg8::EpiBf16 E{(bf16_t*)(ws + A_B3), 2048};
        pg8::gemm_phase<pg8::EpiBf16, true>(glds, g, S, E); FILL(17); } SEAM(17);
    PEER_BLOCK(18, 1)
#undef PEER_BLOCK
#undef IN
#undef SEAM
#undef FILL
#undef NEED
}

extern "C" void kernel_launch(void* const* d_in, const int* in_sizes, int n_in, void* d_out, int out_size, void* d_ws, size_t ws_size, hipStream_t stream) {
    static int grid = 0;
    if (grid == 0) {
        if (n_in != 36 || out_size != (int)O_TOTAL || ws_size < WS_END) { fprintf(stderr, "kernel_launch: built for 36 inputs, %zu outputs, >= %zu B workspace; got n_in %d out %d ws %zu\n", (size_t)O_TOTAL, (size_t)WS_END, n_in, out_size, ws_size); grid = -1; return; }
        int dev = 0, cus = 0, per_cu = 0;
        if (hipGetDevice(&dev) != hipSuccess || hipDeviceGetAttribute(&cus, hipDeviceAttributeMultiprocessorCount, dev) != hipSuccess) { fprintf(stderr, "kernel_launch: device query failed\n"); grid = -1; return; }
        if (hipFuncSetAttribute((const void*)mega_fwd, hipFuncAttributeMaxDynamicSharedMemorySize, LDS_BYTES) != hipSuccess) { fprintf(stderr, "kernel_launch: hipFuncSetAttribute failed\n"); grid = -1; return; }
        if (hipOccupancyMaxActiveBlocksPerMultiprocessor(&per_cu, (const void*)mega_fwd, 512, LDS_BYTES) != hipSuccess || per_cu < 1) { fprintf(stderr, "kernel_launch: occupancy query says %d blocks per CU\n", per_cu); }
        (void)hipGetLastError();
        grid = cus;
    }
    if (grid < 0) return;
    (void)hipMemsetAsync(d_ws, 0, WS_ZERO_BYTES, stream);
    Args a{};
    for (int i = 0; i < 36; ++i) a.in[i] = (const float*)d_in[i];
    a.out = (float*)d_out; a.ws = (unsigned char*)d_ws;
#if MK_SPLIT
    for (int p = 0; p < N_PHASES; ++p) { a.ph_lo = p; a.ph_hi = p + 1; hipLaunchKernelGGL(mega_fwd, dim3(grid), dim3(512), LDS_BYTES, stream, a); }
#elif defined(PROBE_RANGES)
    { const int rg[][2] = {PROBE_RANGES};
      for (unsigned i = 0; i < sizeof(rg) / sizeof(rg[0]); ++i) { if (i) (void)hipMemsetAsync(d_ws, 0, 1 * MiB, stream); a.ph_lo = rg[i][0]; a.ph_hi = rg[i][1]; hipLaunchKernelGGL(mega_fwd, dim3(grid), dim3(512), LDS_BYTES, stream, a); } }
#else
    a.ph_lo = 0; a.ph_hi = N_PHASES; hipLaunchKernelGGL(mega_fwd, dim3(grid), dim3(512), LDS_BYTES, stream, a);
#endif
    const hipError_t le = hipPeekAtLastError();
    if (le != hipSuccess) fprintf(stderr, "kernel_launch: launch failed: %s\n", hipGetErrorName(le));
}
```

```cpp
#include <hip/hip_runtime.h>
#include <cstdio>
#include <cstdint>

#define LAS __attribute__((address_space(3)))
#define GAS __attribute__((address_space(1)))
typedef unsigned short bf16_t;
typedef short bf16x8 __attribute__((ext_vector_type(8)));
typedef short s16x4 __attribute__((ext_vector_type(4)));
typedef float f32x2 __attribute__((ext_vector_type(2)));
typedef float f32x4 __attribute__((ext_vector_type(4)));
typedef float f32x16 __attribute__((ext_vector_type(16)));
typedef unsigned u32x2 __attribute__((ext_vector_type(2)));
typedef unsigned u32x4 __attribute__((ext_vector_type(4)));
typedef int i32x4_t __attribute__((ext_vector_type(4)));
typedef int i32x8_t __attribute__((ext_vector_type(8)));

constexpr int DM = 2048;
constexpr int MP = 32768, MS = 2048, MT = MP + MS;
constexpr int NSEQ = 34;
constexpr int KVROWS = MP + 32 * 1088;
constexpr float RMS_EPS = 1e-6f;

__device__ __forceinline__ int seq_of_row(int m) { return m < MP ? (m >> 14) : 2 + ((m - MP) >> 6); }
__device__ __forceinline__ int pos_of_row(int m) { return m < MP ? (m & 16383) : 1024 + ((m - MP) & 63); }
__device__ __forceinline__ int kvrow_of_row(int m) { return m < MP ? m : MP + ((m - MP) >> 6) * 1088 + 1024 + ((m - MP) & 63); }

__device__ __forceinline__ unsigned cvt_pk_bf16(float lo, float hi) { unsigned r; asm volatile("v_cvt_pk_bf16_f32 %0, %1, %2" : "=v"(r) : "v"(lo), "v"(hi)); return r; }
__device__ __forceinline__ unsigned cvt4_fp8(float a, float b, float c, float d) { int t = 0;
    t = __builtin_amdgcn_cvt_pk_fp8_f32(fminf(fmaxf(a, -448.f), 448.f), fminf(fmaxf(b, -448.f), 448.f), t, false);
    t = __builtin_amdgcn_cvt_pk_fp8_f32(fminf(fmaxf(c, -448.f), 448.f), fminf(fmaxf(d, -448.f), 448.f), t, true); return (unsigned)t; }
__device__ __forceinline__ float bf_lo(unsigned w) { return __uint_as_float(w << 16); }
__device__ __forceinline__ float bf_hi(unsigned w) { return __uint_as_float(w & 0xffff0000u); }
__device__ __forceinline__ float fexp(float x) { return __builtin_amdgcn_exp2f(x * 1.4426950408889634f); }
__device__ __forceinline__ float fsigmoid(float x) { return __builtin_amdgcn_rcpf(1.0f + __builtin_amdgcn_exp2f(-1.4426950408889634f * x)); }
__device__ __forceinline__ float gelu_tanh(float x) { const float u = x * (1.0f + 0.044715f * x * x); return x * __builtin_amdgcn_rcpf(1.0f + __builtin_amdgcn_exp2f(-2.302208198f * u)); }
__device__ __forceinline__ float gelu_erf(float v) {
    const float av = __builtin_fabsf(v), t = __builtin_amdgcn_rcpf(av * 0.2316418882f + 1.0f);
    float q = t * 0.5307027145f + (-0.7265760135f); q = q * t + 0.7107068705f; q = q * t + (-0.142248368f); q = q * t + 0.127414796f; q = q * t;
    const float e = __builtin_amdgcn_exp2f((v * v) * (-0.72134752044f));
    const float m = v * (q * e); return v < 0.f ? m : v - m;
}
__device__ __forceinline__ float wave_sum(float v) {
#pragma unroll
    for (int o = 32; o >= 1; o >>= 1) v += __shfl_xor(v, o);
    return v;
}

namespace pg8 {
constexpr int BM = 256, BK = 64, HALF = 128, HTB = HALF * BK * 2, STAGE_BYTES = 8 * HTB, NXCD = 8, WGM = 8;
__host__ __device__ __forceinline__ int lds_byte(int r, int c) { const int st = (r >> 4) * 2 + (c >> 5), rr = r & 15, cc = c & 31, ob = rr * 64 + cc * 2; return st * 1024 + (ob ^ (((ob >> 9) & 1) << 5)); }
__host__ __device__ __forceinline__ void stage_rc(int b, int& R, int& C) { const int st = b / 1024, sb = b % 1024, swz = sb ^ (((sb >> 9) & 1) << 5); R = (st >> 1) * 16 + swz / 64; C = (st & 1) * 32 + (swz % 64) / 2; }
__host__ __device__ __forceinline__ int perm32(int rho) { const int n = rho >> 4, i = rho & 15; return 8 * (i >> 2) + 4 * n + (i & 3); }

struct Unit { int pm, pn; };
struct Gemm { const bf16_t* A; const bf16_t* Bt; int M, N, K, lda, ldb, kshift, kmul; };

struct StaticOrder {
    int nM, nN, nwg, G, c;
    __host__ __device__ void init(int M, int N, int G_, int c_) { nM = M / BM; nN = N / BM; nwg = nM * nN; G = G_; c = c_; }
    __host__ __device__ bool next(int i, Unit& u) const {
        const long L = (long)i * G + c; if (L >= nwg) return false;
        int wgid = (int)L; { const int q = nwg / NXCD, r = nwg % NXCD, xcd = wgid % NXCD, off = wgid / NXCD; wgid = (xcd < r ? xcd * (q + 1) : r * (q + 1) + (xcd - r) * q) + off; }
        const int nig = WGM * nN, gid = wgid / nig, fm = gid * WGM, gsz = (nM - fm) < WGM ? (nM - fm) : WGM;
        u.pm = fm + ((wgid % nig) % gsz); u.pn = (wgid % nig) / gsz; return true;
    }
};

template <class Epi, bool F8 = false>
__device__ __forceinline__ void gemm_phase(LAS unsigned char* lds, const Gemm g, const StaticOrder& S, const Epi& E) {
    const int tid = threadIdx.x, wid = __builtin_amdgcn_readfirstlane(tid >> 6), lane = tid & 63, wr = wid >> 2, wc = wid & 3, fr = lane & 15, fq = lane >> 4;
    int Kq = g.K; asm volatile("" : "+s"(Kq));
    const int K = Kq, nt = K / BK;
    unsigned voffA[2], voffB[2];
#pragma unroll
    for (int i = 0; i < 2; ++i) { int R, C; stage_rc(tid * 16 + i * 8192, R, C); const int Rb = Epi::PERM ? ((R & ~31) + perm32(R & 31)) : R;
        voffA[i] = (unsigned)(R * g.lda + C) * 2u; voffB[i] = (unsigned)(Rb * g.ldb + C) * 2u; }
    const size_t kstep = (size_t)(BK * 2);
    const size_t hstepA = (size_t)HALF * g.lda * 2, hstepB = (size_t)HALF * g.ldb * 2;
    const unsigned ldsw = (unsigned)wid * 1024u;
    const int aoff = lds_byte(wr * 64 + fr, fq * 8), boff = lds_byte(wc * 32 + fr, fq * 8);
#define PG8_SA(b, h) (((b) * 2 + (h)) * HTB)
#define PG8_SB(b, h) ((4 + (b) * 2 + (h)) * HTB)
#define PG8_STAGE(bufoff, gbase, voff) do { _Pragma("unroll") for (int _i = 0; _i < 2; ++_i) \
        __builtin_amdgcn_global_load_lds((const unsigned*)((const char*)(gbase) + (voff)[_i]), (LAS unsigned*)(lds + (bufoff) + ldsw + _i * 8192), 16, 0, 0); } while (0)
#define PG8_CAT(F) __builtin_shufflevector(__builtin_bit_cast(i32x4_t, (F)[0]), __builtin_bit_cast(i32x4_t, (F)[1]), 0, 1, 2, 3, 4, 5, 6, 7)
#define PG8_LDA(dst, b, h) do { _Pragma("unroll") for (int m = 0; m < 4; ++m) { _Pragma("unroll") for (int k = 0; k < 2; ++k) dst[m][k] = *(const LAS bf16x8*)(lds + PG8_SA(b, h) + aoff + m * 2048 + k * 1024); \
        if (F8) dst##8[m] = PG8_CAT(dst[m]); } } while (0)
#define PG8_LDB(dst, b, h) do { _Pragma("unroll") for (int n = 0; n < 2; ++n) { _Pragma("unroll") for (int k = 0; k < 2; ++k) dst[n][k] = *(const LAS bf16x8*)(lds + PG8_SB(b, h) + boff + n * 2048 + k * 1024); \
        if (F8) dst##8[n] = PG8_CAT(dst[n]); } } while (0)
#define PG8_MMA(ai, bj, At, Bt) do { __builtin_amdgcn_s_setprio(1); \
        if (F8) { _Pragma("unroll") for (int m = 0; m < 4; ++m) _Pragma("unroll") for (int n = 0; n < 2; ++n) \
            asm volatile("v_mfma_scale_f32_16x16x128_f8f6f4 %0, %1, %2, %0, %3, %3 op_sel_hi:[0,0,0]" : "+v"(acc[ai][bj][m][n]) : "v"(Bt##8[n]), "v"(At##8[m]), "v"(f8one)); } \
        else { _Pragma("unroll") for (int m = 0; m < 4; ++m) _Pragma("unroll") for (int n = 0; n < 2; ++n) _Pragma("unroll") for (int k = 0; k < 2; ++k) \
            acc[ai][bj][m][n] = __builtin_amdgcn_mfma_f32_16x16x32_bf16(Bt[n][k], At[m][k], acc[ai][bj][m][n], 0, 0, 0); } \
        __builtin_amdgcn_s_setprio(0); } while (0)
#define PG8_WAIT_V(n) asm volatile("s_waitcnt vmcnt(" #n ")" ::: "memory")
#define PG8_WAIT_L(n) asm volatile("s_waitcnt lgkmcnt(" #n ")" ::: "memory")
#define PG8_BAR __builtin_amdgcn_s_barrier()
#define PG8_SCHED __builtin_amdgcn_sched_barrier(0)
#define PG8_ABASE(u) ((const char*)g.A + (size_t)(u).pm * (2 * hstepA) + (size_t)(((u).pn >> g.kshift) * g.kmul) * 2)
#define PG8_BBASE(u) ((const char*)g.Bt + (size_t)(u).pn * (2 * hstepB))
    Unit cur, nxt; int ui = 0;
    if (!S.next(0, cur)) return;
    f32x4 acc[2][2][4][2];
#pragma unroll
    for (int a = 0; a < 2; ++a)
#pragma unroll
        for (int b = 0; b < 2; ++b)
#pragma unroll
            for (int m = 0; m < 4; ++m)
#pragma unroll
                for (int n = 0; n < 2; ++n) acc[a][b][m][n] = (f32x4){0.f, 0.f, 0.f, 0.f};
    bf16x8 At[4][2], B0[2][2], B1[2][2];
    i32x8_t At8[4], B08[2], B18[2]; int f8one = 127; asm volatile("" : "+v"(f8one));
    const char* cA = PG8_ABASE(cur); const char* cB = PG8_BBASE(cur);
    PG8_STAGE(PG8_SB(0, 0), cB, voffB); PG8_STAGE(PG8_SB(0, 1), cB + hstepB, voffB); PG8_STAGE(PG8_SA(0, 0), cA, voffA); PG8_STAGE(PG8_SA(0, 1), cA + hstepA, voffA);
    if (wr == 1) PG8_BAR;
    PG8_WAIT_V(2); PG8_BAR;
    PG8_STAGE(PG8_SB(1, 0), cB + kstep, voffB); PG8_STAGE(PG8_SA(1, 0), cA + kstep, voffA); PG8_STAGE(PG8_SB(1, 1), cB + hstepB + kstep, voffB);
    PG8_WAIT_V(6); PG8_BAR;
    for (;;) {
        const bool has_next = S.next(ui + 1, nxt);
        const char* nA = has_next ? PG8_ABASE(nxt) : cA; const char* nB = has_next ? PG8_BBASE(nxt) : cB;
        for (int t = 0; t < nt; t += 2) {
            const bool last = (t == nt - 2);
            const char* a1 = cA + (size_t)(t + 1) * kstep;
            const char* a2 = last ? nA : cA + (size_t)(t + 2) * kstep; const char* b2 = last ? nB : cB + (size_t)(t + 2) * kstep;
            const char* a3 = a2 + kstep; const char* b3 = b2 + kstep;
            PG8_LDB(B0, 0, 0); PG8_LDB(B1, 0, 1); PG8_SCHED; PG8_LDA(At, 0, 0); PG8_STAGE(PG8_SA(1, 1), a1 + hstepA, voffA);
            PG8_WAIT_V(8); PG8_WAIT_L(0); PG8_BAR; PG8_MMA(0, 0, At, B0); PG8_MMA(0, 1, At, B1); PG8_BAR; PG8_SCHED;
            PG8_LDA(At, 0, 1); PG8_STAGE(PG8_SB(0, 0), b2, voffB); PG8_STAGE(PG8_SB(0, 1), b2 + hstepB, voffB); PG8_STAGE(PG8_SA(0, 0), a2, voffA);
            PG8_WAIT_V(8); PG8_WAIT_L(0); PG8_BAR; PG8_MMA(1, 0, At, B0); PG8_MMA(1, 1, At, B1); PG8_BAR; PG8_SCHED;
            PG8_LDB(B0, 1, 0); PG8_LDB(B1, 1, 1); PG8_SCHED; PG8_LDA(At, 1, 0); PG8_STAGE(PG8_SA(0, 1), a2 + hstepA, voffA);
            PG8_WAIT_V(8); PG8_WAIT_L(0); PG8_BAR; PG8_MMA(0, 0, At, B0); PG8_MMA(0, 1, At, B1); PG8_BAR; PG8_SCHED;
            PG8_LDA(At, 1, 1); PG8_STAGE(PG8_SB(1, 0), b3, voffB); PG8_STAGE(PG8_SB(1, 1), b3 + hstepB, voffB); PG8_STAGE(PG8_SA(1, 0), a3, voffA);
            PG8_WAIT_V(8); PG8_WAIT_L(0); PG8_BAR; PG8_MMA(1, 0, At, B0); PG8_MMA(1, 1, At, B1); PG8_BAR; PG8_SCHED;
        }
        if (wr == 0) PG8_BAR;
        E(acc, cur, wr, wc, fr, fq);
        if (!has_next) break;
#pragma unroll
        for (int a = 0; a < 2; ++a)
#pragma unroll
            for (int b = 0; b < 2; ++b)
#pragma unroll
                for (int m = 0; m < 4; ++m)
#pragma unroll
                    for (int n = 0; n < 2; ++n) acc[a][b][m][n] = (f32x4){0.f, 0.f, 0.f, 0.f};
        cur = nxt; cA = nA; cB = nB; ++ui;
        if (wr == 1) PG8_BAR;
    }
    PG8_WAIT_V(0);
    PG8_BAR;
#undef PG8_SA
#undef PG8_SB
#undef PG8_STAGE
#undef PG8_LDA
#undef PG8_LDB
#undef PG8_MMA
#undef PG8_CAT
#undef PG8_WAIT_V
#undef PG8_WAIT_L
#undef PG8_BAR
#undef PG8_SCHED
#undef PG8_ABASE
#undef PG8_BBASE
}
}
namespace pg8 {
#define EPI_ROWS(expr_row) for (int ai = 0; ai < 2; ++ai) for (int m = 0; m < 4; ++m)
struct EpiBf16 {
    static constexpr bool PERM = true;
    bf16_t* O; int ldc;
    __device__ __forceinline__ void operator()(const f32x4 (&acc)[2][2][4][2], const Unit& u, int wr, int wc, int fr, int fq) const {
        const int row0 = u.pm * BM + wr * 64 + fr, col0 = u.pn * BM + wc * 32 + 8 * fq;
#pragma unroll
        for (int ai = 0; ai < 2; ++ai)
#pragma unroll
            for (int m = 0; m < 4; ++m) { bf16_t* rowp = O + (size_t)(row0 + ai * HALF + m * 16) * ldc + col0;
#pragma unroll
                for (int bj = 0; bj < 2; ++bj) { const f32x4 v0 = acc[ai][bj][m][0], v1 = acc[ai][bj][m][1];
                    u32x4 w; w.x = cvt_pk_bf16(v0[0], v0[1]); w.y = cvt_pk_bf16(v0[2], v0[3]); w.z = cvt_pk_bf16(v1[0], v1[1]); w.w = cvt_pk_bf16(v1[2], v1[3]);
                    *(u32x4*)(rowp + bj * HALF) = w; } }
    }
};
struct EpiZ {
    static constexpr bool PERM = true;
    bf16_t* GG; bf16_t* REC; bf16_t* POOL;
    __device__ __forceinline__ void operator()(const f32x4 (&acc)[2][2][4][2], const Unit& u, int wr, int wc, int fr, int fq) const {
        const int t = u.pn >> 2; bf16_t* base = GG + (size_t)t * ((size_t)MT * 1024);
        const int row0 = u.pm * BM + wr * 64 + fr, col0 = (u.pn & 3) * BM + wc * 32 + 8 * fq;
#pragma unroll
        for (int ai = 0; ai < 2; ++ai)
#pragma unroll
            for (int m = 0; m < 4; ++m) { bf16_t* rowp = base + (size_t)(row0 + ai * HALF + m * 16) * 1024 + col0;
#pragma unroll
                for (int bj = 0; bj < 2; ++bj) { f32x4 v0 = acc[ai][bj][m][0], v1 = acc[ai][bj][m][1];
                    if (t == 0) {
#pragma unroll
                        for (int j = 0; j < 4; ++j) { v0[j] = gelu_tanh(v0[j]); v1[j] = gelu_tanh(v1[j]); } }
                    u32x4 w; w.x = cvt_pk_bf16(v0[0], v0[1]); w.y = cvt_pk_bf16(v0[2], v0[3]); w.z = cvt_pk_bf16(v1[0], v1[1]); w.w = cvt_pk_bf16(v1[2], v1[3]);
                    *(u32x4*)(rowp + bj * HALF) = w; } }
    }
};
struct EpiGate {
    static constexpr bool PERM = false;
    const bf16_t* XC; const float* gp; float* Aout;
    __device__ __forceinline__ void operator()(const f32x4 (&acc)[2][2][4][2], const Unit& u, int wr, int wc, int fr, int fq) const {
        const int row0 = u.pm * BM + wr * 64 + fr, ch0 = u.pn * 128 + wc * 32 + 4 * fq;
#pragma unroll
        for (int n = 0; n < 2; ++n) {
            const f32x4 bav = *(const f32x4*)(gp + ch0 + 16 * n), bxv = *(const f32x4*)(gp + 1024 + ch0 + 16 * n), spv = *(const f32x4*)(gp + 2048 + ch0 + 16 * n);
#pragma unroll
            for (int ai = 0; ai < 2; ++ai)
#pragma unroll
                for (int m = 0; m < 4; ++m) { const int row = row0 + ai * HALF + m * 16; const bool pos0 = (row < MP) && ((row & 16383) == 0);
                    const size_t off = (size_t)row * 1024 + ch0 + 16 * n;
                    const u32x2 xw = *(const u32x2*)(XC + off); const float xc[4] = {bf_lo(xw.x), bf_hi(xw.x), bf_lo(xw.y), bf_hi(xw.y)};
                    f32x4 av, uv;
#pragma unroll
                    for (int j = 0; j < 4; ++j) { const float r = fsigmoid(acc[ai][0][m][n][j] + bav[j]), ig = fsigmoid(acc[ai][1][m][n][j] + bxv[j]);
                        const float log_a = -8.0f * r * spv[j]; const float a = fexp(log_a); const float mult = pos0 ? 1.0f : __builtin_sqrtf(fmaxf(1.0f - a * a, 0.0f));
                        av[j] = a; uv[j] = mult * ig * xc[j]; }
                    *(f32x4*)(Aout + off) = av; { u32x2 uw; uw.x = cvt_pk_bf16(uv[0], uv[1]); uw.y = cvt_pk_bf16(uv[2], uv[3]); *(u32x2*)((bf16_t*)(Aout + (size_t)MT * 1024) + off) = uw; } asm volatile("" ::: "memory"); }
        }
    }
};
struct EpiPool {
    static constexpr bool PERM = true;
    bf16_t* CAT; const float* spool;
    __device__ __forceinline__ void operator()(const f32x4 (&acc)[2][2][4][2], const Unit& u, int wr, int wc, int fr, int fq) const {
        const int row0 = u.pm * BM + wr * 64 + fr, col0 = u.pn * BM + wc * 32 + 8 * fq;
        f32x4 s0[2], s1[2];
#pragma unroll
        for (int bj = 0; bj < 2; ++bj) { s0[bj] = *(const f32x4*)(spool + col0 + bj * HALF); s1[bj] = *(const f32x4*)(spool + col0 + bj * HALF + 4); }
#pragma unroll
        for (int ai = 0; ai < 2; ++ai)
#pragma unroll
            for (int m = 0; m < 4; ++m) { bf16_t* rowp = CAT + (size_t)(row0 + ai * HALF + m * 16) * 2048 + 1024 + col0;
#pragma unroll
                for (int bj = 0; bj < 2; ++bj) { const f32x4 v0 = acc[ai][bj][m][0] * s0[bj], v1 = acc[ai][bj][m][1] * s1[bj];
                    u32x4 w; w.x = cvt_pk_bf16(v0[0], v0[1]); w.y = cvt_pk_bf16(v0[2], v0[3]); w.z = cvt_pk_bf16(v1[0], v1[1]); w.w = cvt_pk_bf16(v1[2], v1[3]);
                    *(u32x4*)(rowp + bj * HALF) = w; } }
    }
};
struct EpiResid {
    static constexpr bool PERM = false;
    const float* xinP; const float* xinS; float* xout; const float* gate;
    __device__ __forceinline__ void operator()(const f32x4 (&acc)[2][2][4][2], const Unit& u, int wr, int wc, int fr, int fq) const {
        const int row0 = u.pm * BM + wr * 64 + fr, col0 = u.pn * BM + wc * 32 + 4 * fq;
#pragma unroll
        for (int ai = 0; ai < 2; ++ai)
#pragma unroll
            for (int m = 0; m < 4; ++m) { const int row = row0 + ai * HALF + m * 16; const float* gp = gate + (size_t)seq_of_row(row) * 12288 + col0;
                const float* xi = (row < MP ? xinP + (size_t)row * DM : xinS + (size_t)(row - MP) * DM) + col0; float* xo = xout + (size_t)row * DM + col0;
#pragma unroll
                for (int bj = 0; bj < 2; ++bj)
#pragma unroll
                    for (int n = 0; n < 2; ++n) { const int o = bj * HALF + n * 16; *(f32x4*)(xo + o) = *(const f32x4*)(xi + o) + *(const f32x4*)(gp + o) * acc[ai][bj][m][n]; }
                asm volatile("" ::: "memory"); }
    }
};
struct EpiF32 {
    static constexpr bool PERM = false;
    float* C; int ldc;
    __device__ __forceinline__ void operator()(const f32x4 (&acc)[2][2][4][2], const Unit& u, int wr, int wc, int fr, int fq) const {
        const int row0 = u.pm * BM + wr * 64 + fr, col0 = u.pn * BM + wc * 32 + 4 * fq;
#pragma unroll
        for (int ai = 0; ai < 2; ++ai)
#pragma unroll
            for (int m = 0; m < 4; ++m) { float* rowp = C + (size_t)(row0 + ai * HALF + m * 16) * ldc + col0;
#pragma unroll
                for (int bj = 0; bj < 2; ++bj)
#pragma unroll
                    for (int n = 0; n < 2; ++n) *(f32x4*)(rowp + bj * HALF + n * 16) = acc[ai][bj][m][n]; }
    }
};
struct EpiQ {
    static constexpr bool PERM = true;
    static constexpr float QS = 0.07216878364870322f * 1.4426950408889634f;
    unsigned char* Q8; const float* rope;
    __device__ __forceinline__ void operator()(const f32x4 (&acc)[2][2][4][2], const Unit& u, int wr, int wc, int fr, int fq) const {
        const int row0 = u.pm * BM + wr * 64 + fr;
        if (u.pn < 8) {
            const int col0 = u.pn * BM + wc * 32 + 8 * fq;
#pragma unroll
            for (int ai = 0; ai < 2; ++ai)
#pragma unroll
                for (int m = 0; m < 4; ++m) { unsigned char* rowp = Q8 + (size_t)(row0 + ai * HALF + m * 16) * 3072;
#pragma unroll
                    for (int bj = 0; bj < 2; ++bj) { const f32x4 v0 = acc[ai][bj][m][0] * QS, v1 = acc[ai][bj][m][1] * QS; const int col = col0 + bj * HALF;
                        u32x2 w; w.x = cvt4_fp8(v0[0], v0[1], v0[2], v0[3]); w.y = cvt4_fp8(v1[0], v1[1], v1[2], v1[3]);
                        *(u32x2*)(rowp + (col >> 7) * 192 + (col & 127)) = w; } }
        } else {
            const int head = (u.pn - 8) * 4 + wc, j0 = 8 * fq;
#pragma unroll
            for (int ai = 0; ai < 2; ++ai)
#pragma unroll
                for (int m = 0; m < 4; ++m) { const int row = row0 + ai * HALF + m * 16; const float* rp = rope + (size_t)pos_of_row(row) * 64 + j0;
                    const f32x4 c0 = *(const f32x4*)(rp), c1 = *(const f32x4*)(rp + 4), s0 = *(const f32x4*)(rp + 32), s1 = *(const f32x4*)(rp + 36);
                    const f32x4 x10 = acc[ai][0][m][0] * QS, x11 = acc[ai][0][m][1] * QS, x20 = acc[ai][1][m][0] * QS, x21 = acc[ai][1][m][1] * QS;
                    const f32x4 a0 = x10 * c0 - x20 * s0, a1 = x11 * c1 - x21 * s1, b0 = x10 * s0 + x20 * c0, b1 = x11 * s1 + x21 * c1;
                    unsigned char* qp = Q8 + (size_t)row * 3072 + head * 192 + 128 + j0;
                    u32x2 w; w.x = cvt4_fp8(a0[0], a0[1], a0[2], a0[3]); w.y = cvt4_fp8(a1[0], a1[1], a1[2], a1[3]); *(u32x2*)qp = w;
                    w.x = cvt4_fp8(b0[0], b0[1], b0[2], b0[3]); w.y = cvt4_fp8(b1[0], b1[1], b1[2], b1[3]); *(u32x2*)(qp + 32) = w; }
        }
    }
};
struct EpiKV {
    static constexpr bool PERM = true;
    unsigned char* Kn8; bf16_t* V;
    __device__ __forceinline__ void operator()(const f32x4 (&acc)[2][2][4][2], const Unit& u, int wr, int wc, int fr, int fq) const {
        const int row0 = u.pm * BM + wr * 64 + fr, col0 = u.pn * 128 + wc * 32 + 8 * fq;
#pragma unroll
        for (int ai = 0; ai < 2; ++ai)
#pragma unroll
            for (int m = 0; m < 4; ++m) { const size_t off = (size_t)(row0 + ai * HALF + m * 16) * 2048 + col0;
                { const f32x4 v0 = acc[ai][0][m][0], v1 = acc[ai][0][m][1]; u32x2 w; w.x = cvt4_fp8(v0[0], v0[1], v0[2], v0[3]); w.y = cvt4_fp8(v1[0], v1[1], v1[2], v1[3]); *(u32x2*)(Kn8 + off) = w; }
                { const f32x4 v0 = acc[ai][1][m][0], v1 = acc[ai][1][m][1];
                  u32x4 w; w.x = cvt_pk_bf16(v0[0], v0[1]); w.y = cvt_pk_bf16(v0[2], v0[3]); w.z = cvt_pk_bf16(v1[0], v1[1]); w.w = cvt_pk_bf16(v1[2], v1[3]); *(u32x4*)(V + off) = w; } }
    }
};
#undef EPI_ROWS
}

#define XB_TMO      128
#define XB_XCNT(j)  (256  + 64 * (j))
#define XB_XSUB(j)  (1280 + 64 * (j))
#define XB_XGEN(j)  (2304 + 64 * (j))
#define XB_TOP      3328
#define XB_TOPGEN   3392
#define XCD_BAR_WORDS 3456
#define XB_SPIN_CAP (1u << 18)
__device__ __forceinline__ unsigned xb_ld(unsigned* p)              { return __hip_atomic_load(p, __ATOMIC_RELAXED, __HIP_MEMORY_SCOPE_AGENT); }
__device__ __forceinline__ unsigned xb_add(unsigned* p, unsigned v) { return __hip_atomic_fetch_add(p, v, __ATOMIC_RELAXED, __HIP_MEMORY_SCOPE_AGENT); }
__device__ __forceinline__ unsigned xb_xcc_id() { return (unsigned)__builtin_amdgcn_s_getreg((3 << 11) | 20) & 0xFu; }
#define XB_SPIN(cond, bar) do { unsigned _sp = 0; while (cond) { __builtin_amdgcn_s_sleep(1); \
    if ((++_sp & 255u) == 0u) { if (xb_ld(&(bar)[XB_TMO])) break; if (_sp > XB_SPIN_CAP) { atomicAdd(&(bar)[XB_TMO], 1u); break; } } } } while (0)
struct XcdBarrier { unsigned* bar; unsigned x; volatile LAS unsigned* st; };
__device__ __forceinline__ XcdBarrier xcd_barrier_post(unsigned* bar, volatile LAS unsigned* st) {
    XcdBarrier b; b.bar = bar; b.x = xb_xcc_id(); b.st = st;
    if (threadIdx.x == 0) (void)xb_add(&bar[XB_XCNT(b.x)], 1u);
    return b;
}
__device__ __forceinline__ void xcd_barrier_complete(unsigned* bar, unsigned x, unsigned& nloc, unsigned& nx) {
    const unsigned G = gridDim.x * gridDim.y * gridDim.z;
    unsigned sum, cnt, mine, sp = 0u;
    for (;;) {
        sum = 0u; cnt = 0u; mine = 0u;
#pragma unroll
        for (unsigned j = 0; j < 16; ++j) { const unsigned c = xb_ld(&bar[XB_XCNT(j)]); sum += c; cnt += (c > 0u) ? 1u : 0u; mine = (j == x) ? c : mine; }
        if (sum == G) break;
        __builtin_amdgcn_s_sleep(1);
        if ((++sp & 255u) == 0u) { if (xb_ld(&bar[XB_TMO])) break; if (sp > XB_SPIN_CAP) { atomicAdd(&bar[XB_TMO], 1u); break; } }
    }
    nloc = mine > 0u ? mine : 1u; nx = cnt > 0u ? cnt : 1u;
}
__device__ __forceinline__ void xcd_barrier(const XcdBarrier& b) {
    asm volatile("s_waitcnt vmcnt(0)" ::: "memory");
    __syncthreads();
    if (threadIdx.x == 0) {
        unsigned* bar = b.bar;
        __builtin_amdgcn_s_waitcnt(0);
        unsigned nloc = b.st[0], nx = b.st[1];
        if (nloc == 0u) { xcd_barrier_complete(bar, b.x, nloc, nx); b.st[0] = nloc; b.st[1] = nx; }
        const unsigned old = xb_add(&bar[XB_XSUB(b.x)], 1u);
        const unsigned gen = old / nloc;
        if (old + 1u == (gen + 1u) * nloc) {
            __builtin_amdgcn_fence(__ATOMIC_RELEASE, "agent");
            asm volatile("s_waitcnt vmcnt(0)" ::: "memory");
            const unsigned og = xb_add(&bar[XB_TOP], 1u);
            const unsigned tg = og / nx;
            if (og + 1u == (tg + 1u) * nx) xb_add(&bar[XB_TOPGEN], 1u);
            else XB_SPIN(xb_ld(&bar[XB_TOPGEN]) == tg, bar);
            __builtin_amdgcn_fence(__ATOMIC_ACQUIRE, "agent");
            xb_add(&bar[XB_XGEN(b.x)], 1u);
            asm volatile("s_waitcnt vmcnt(0)" ::: "memory");
        } else {
            XB_SPIN(xb_ld(&bar[XB_XGEN(b.x)]) == gen, bar);
            __builtin_amdgcn_fence(__ATOMIC_ACQUIRE, "agent");
            asm volatile("s_waitcnt vmcnt(0)" ::: "memory");
        }
    }
    __syncthreads();
}
constexpr float U8_SCALE = 256.0f, V8_SCALE = 16.0f;
__device__ __forceinline__ void convert_fp8_range(const float* src, unsigned char* dst, float scale, size_t n16, size_t i0, size_t stride) {
    for (size_t i = i0; i < n16; i += stride) { u32x4 w;
#pragma unroll
        for (int q = 0; q < 4; ++q) { f32x4 a = *(const f32x4*)(src + i * 16 + 4 * q) * scale;
#pragma unroll
            for (int j = 0; j < 4; ++j) a[j] = fminf(fmaxf(a[j], -448.0f), 448.0f);
            int t = 0; t = __builtin_amdgcn_cvt_pk_fp8_f32(a[0], a[1], t, false); t = __builtin_amdgcn_cvt_pk_fp8_f32(a[2], a[3], t, true); w[q] = (unsigned)t; }
        *(u32x4*)(dst + i * 16) = w; }
}
constexpr float U4_SCALE = 90.50966799f, V4_SCALE = 8.0f;
__device__ __forceinline__ void convert_fp4_rows(const float* src, unsigned char* dst, float scale, int nrows, int w0, int wstride, int lane) {
    for (int r = w0; r < nrows; r += wstride) { const float* sr = src + (size_t)r * 2048 + 4 * lane; u32x4 w;
        f32x4 a[8];
#pragma unroll
        for (int b = 0; b < 8; ++b) a[b] = *(const f32x4*)(sr + 256 * b) * scale;
#pragma unroll
        for (int q = 0; q < 4; ++q) { float e[8] = {a[2 * q][0], a[2 * q][1], a[2 * q][2], a[2 * q][3], a[2 * q + 1][0], a[2 * q + 1][1], a[2 * q + 1][2], a[2 * q + 1][3]};
#pragma unroll
            for (int j = 0; j < 8; ++j) e[j] = fminf(fmaxf(e[j], -6.0f), 6.0f);
            unsigned t = 0u; t = __builtin_amdgcn_cvt_scalef32_pk_fp4_f32(t, e[0], e[1], 1.0f, 0); t = __builtin_amdgcn_cvt_scalef32_pk_fp4_f32(t, e[2], e[3], 1.0f, 1);
            t = __builtin_amdgcn_cvt_scalef32_pk_fp4_f32(t, e[4], e[5], 1.0f, 2); t = __builtin_amdgcn_cvt_scalef32_pk_fp4_f32(t, e[6], e[7], 1.0f, 3); w[q] = t; }
        *(u32x4*)(dst + (size_t)r * 1024 + 16 * lane) = w; }
}
constexpr size_t MiB = (size_t)1 << 20;
constexpr size_t WS_CTL = 0, WS_WGATE = 1 * MiB, WS_WDQKV = 2 * MiB, WS_ZERO_BYTES = 6 * MiB;
constexpr size_t WS_WIN = 6 * MiB, WS_WOUTR = 18 * MiB, WS_WQ = 26 * MiB, WS_WUQ = 42 * MiB, WS_WUKV = 45 * MiB, WS_WOUTA = 47 * MiB;
constexpr size_t WS_WPOOL = 55 * MiB, WS_KEYS = 56 * MiB, WS_MOD = 57 * MiB, WS_ROPE = 61 * MiB, WS_SP = 65 * MiB, WS_SCAN = 66 * MiB;
constexpr size_t WS_U = 73 * MiB, WS_V = 137 * MiB;
constexpr size_t A_HN = 201 * MiB, A_GG = 337 * MiB, A_B2 = 405 * MiB, A_B3 = 541 * MiB, A_B4 = 677 * MiB;
constexpr size_t A_KN = 405 * MiB  , A_Q8 = 537 * MiB  , A_VV = 669 * MiB, A_KP = 933 * MiB, A_CQ = 942 * MiB, A_CKV = 976 * MiB, WS_END = 1009 * MiB;
constexpr int CW_BAR = 4096;
constexpr size_t SCAN_WORDS = (size_t)544 * 1024;
constexpr size_t O_Y = 0, O_CONV_P = 71303168, O_CONV_S = 71309312, O_H_P = 71407616, O_H_S = 71409664, O_POOL_P = 71442432, O_POOL_S = 71473152,
                 O_CKV = 71964672, O_KPE = 80877568, O_TOTAL = 83105792;
constexpr int LDS_BYTES = 147456, LDS_MISC = 147200;

struct Args { const float* in[36]; float* out; unsigned char* ws; int ph_lo, ph_hi; };

struct Ctx {
    LAS unsigned char* lds; int tid, lane, wave, vcu, G, gw, NGW;
    const float* const* in; float* out; unsigned char* ws;
};

__device__ __forceinline__ void transpose_item(const float* W, int N, int k0, int n0, bf16_t* WT, int dld, int drow0, int dcol0, LAS float* scr, int lane) {
#pragma unroll 8
    for (int i = 0; i < 32; ++i) { const int kk = 2 * i + (lane >> 5); scr[kk * 33 + (lane & 31)] = W[(size_t)(k0 + kk) * N + n0 + (lane & 31)]; }
    asm volatile("s_waitcnt lgkmcnt(0)" ::: "memory");
    const int c = lane & 7;
#pragma unroll
    for (int j = 0; j < 4; ++j) { const int n = (lane >> 3) + 8 * j; const LAS float* s = scr + (8 * c) * 33 + n;
        u32x4 o; o.x = cvt_pk_bf16(s[0 * 33], s[1 * 33]); o.y = cvt_pk_bf16(s[2 * 33], s[3 * 33]); o.z = cvt_pk_bf16(s[4 * 33], s[5 * 33]); o.w = cvt_pk_bf16(s[6 * 33], s[7 * 33]);
        *(u32x4*)(WT + (size_t)(drow0 + n) * dld + dcol0 + 8 * c) = o; }
    asm volatile("s_waitcnt lgkmcnt(0)" ::: "memory");
}
__device__ __forceinline__ void transpose_item_f8(const float* W, int N, int k0, int n0, unsigned char* WT, int dld, int drow0, int dcol0, LAS float* scr, int lane) {
#pragma unroll 8
    for (int i = 0; i < 32; ++i) { const int kk = 2 * i + (lane >> 5); scr[kk * 33 + (lane & 31)] = W[(size_t)(k0 + kk) * N + n0 + (lane & 31)]; }
    asm volatile("s_waitcnt lgkmcnt(0)" ::: "memory");
    const int c = lane & 7;
#pragma unroll
    for (int j = 0; j < 4; ++j) { const int n = (lane >> 3) + 8 * j; const LAS float* s = scr + (8 * c) * 33 + n;
        u32x2 o; o.x = cvt4_fp8(s[0 * 33], s[1 * 33], s[2 * 33], s[3 * 33]); o.y = cvt4_fp8(s[4 * 33], s[5 * 33], s[6 * 33], s[7 * 33]);
        *(u32x2*)(WT + (size_t)(drow0 + n) * dld + dcol0 + 8 * c) = o; }
    asm volatile("s_waitcnt lgkmcnt(0)" ::: "memory");
}
__device__ __forceinline__ void transpose_mat_item(const float* W, int K, int N, bf16_t* WT, int dld, int drow_base, int dcol_base, int item, LAS float* scr, int lane) {
    const int nblk = N / 32, kb = item / nblk, nb = item % nblk;
    transpose_item(W, N, 64 * kb, 32 * nb, WT, dld, drow_base + 32 * nb, dcol_base + 64 * kb, scr, lane);
}
__device__ __forceinline__ void convert_range(const float* src, bf16_t* dst, size_t n8, size_t i0, size_t stride) {
    for (size_t i = i0; i < n8; i += stride) { const f32x4 a = *(const f32x4*)(src + i * 8), b = *(const f32x4*)(src + i * 8 + 4);
        u32x4 w; w.x = cvt_pk_bf16(a[0], a[1]); w.y = cvt_pk_bf16(a[2], a[3]); w.z = cvt_pk_bf16(b[0], b[1]); w.w = cvt_pk_bf16(b[2], b[3]);
        *(u32x4*)(dst + i * 8) = w; }
}

__device__ __forceinline__ void ada_item(const Ctx& C, int item) {
    const int l = item / 96, nb = item % 96, n0 = nb * 128, w = C.wave, lane = C.lane;
    const float* cP = C.in[2]; const float* cS = C.in[3]; const float* W = C.in[9] + (size_t)l * 2048 * 12288 + n0 + 2 * lane; const float* bias = C.in[10] + (size_t)l * 12288 + n0;
    LAS float* scr = (LAS float*)(C.lds + w * 4608);
    LAS float* sum = (LAS float*)(C.lds + 36864);
    f32x2 acc[34];
#pragma unroll
    for (int s = 0; s < 34; ++s) acc[s] = (f32x2){0.f, 0.f};
    for (int sub = 0; sub < 8; ++sub) {
        const int k0 = 256 * w + 32 * sub;
#pragma unroll
        for (int i = 0; i < 17; ++i) { const int idx = lane + 64 * i, s = idx >> 5, kk = idx & 31;
            const float cv = (s < 2) ? cP[s * 2048 + k0 + kk] : cS[(s - 2) * 2048 + k0 + kk];
            scr[kk * 36 + s] = cv * fsigmoid(cv); }
        asm volatile("s_waitcnt lgkmcnt(0)" ::: "memory");
#pragma unroll 1
        for (int kq = 0; kq < 2; ++kq) {
            f32x2 wv[16];
#pragma unroll
            for (int kk = 0; kk < 16; ++kk) wv[kk] = *(const f32x2*)(W + (size_t)(k0 + 16 * kq + kk) * 12288);
#pragma unroll
            for (int kk = 0; kk < 16; ++kk) {
#pragma unroll
                for (int s4 = 0; s4 < 9; ++s4) { const f32x4 sv = *(const LAS f32x4*)(scr + (16 * kq + kk) * 36 + 4 * s4);
#pragma unroll
                    for (int i = 0; i < 4; ++i) if (4 * s4 + i < 34) acc[4 * s4 + i] += wv[kk] * sv[i]; }
                asm volatile("" ::: "memory");
            }
        }
        asm volatile("s_waitcnt lgkmcnt(0)" ::: "memory");
    }
    for (int ww = 0; ww < 8; ++ww) {
        if (w == ww) {
#pragma unroll
            for (int s = 0; s < 34; ++s) { LAS f32x2* p = (LAS f32x2*)(sum + s * 128) + lane; if (ww == 0) *p = acc[s]; else *p = *p + acc[s]; }
        }
        __syncthreads();
    }
    float* mod = (float*)(C.ws + WS_MOD);
    for (int s = w; s < 34; s += 8) { const f32x2 v = *((LAS f32x2*)(sum + s * 128) + lane) + *(const f32x2*)(bias + 2 * lane);
        *(f32x2*)(mod + ((size_t)l * NSEQ + s) * 12288 + n0 + 2 * lane) = v; }
    __syncthreads();
}

namespace bq {
constexpr int I_IN = 32 * 96, I_GATE = 16 * 8, I_POOL = 4 * 32, I_OUTR = 32 * 64, I_Q = 32 * 64, I_KEYS = 256, I_TAB = 16384  , I_DQ = 32 * 16, I_DKV = 32 * 10,
              I_ROPE = 1024, I_UQ = 8 * 96, I_UKV = 4 * 128, I_OUTA = 32 * 64;
constexpr int E_IN = I_IN, E_GATE = E_IN + I_GATE, E_POOL = E_GATE + I_POOL, E_OUTR = E_POOL + I_OUTR, E_Q0 = E_OUTR + I_Q, E_KEYS = E_Q0 + I_KEYS, E_TAB0 = E_KEYS + I_TAB, E_DQ = E_TAB0 + I_DQ,
              E_DKV = E_DQ + I_DKV, E_ROPE = E_DKV + I_ROPE, E_UQ = E_ROPE + I_UQ, E_UKV = E_UQ + I_UKV, E_OUTA = E_UKV + I_OUTA, E_Q1 = E_OUTA + I_Q, E_TAB1 = E_Q1 + I_TAB, NTOT = E_TAB1;
static_assert(NTOT % 8 == 0 && E_IN % 8 == 0 && E_POOL % 8 == 0 && E_OUTR % 8 == 0 && E_Q0 % 8 == 0 && E_KEYS % 8 == 0 && E_TAB0 % 8 == 0 && E_DKV % 8 == 0 && E_ROPE % 8 == 0 && E_UKV % 8 == 0 && E_OUTA % 8 == 0 && E_Q1 % 8 == 0, "queue segments are whole workgroup items");
constexpr int CW_QHEAD = 64, CW_DONE = 128;
constexpr int LDS_SLOT = LDS_MISC + 32;
constexpr size_t TAB_L1 = 16 * MiB;

__device__ __forceinline__ void fp4_row_pair(const float* src, unsigned char* dst, float scale, int r0, int lane) {
    f32x4 a[16];
#pragma unroll
    for (int b = 0; b < 16; ++b) a[b] = *(const f32x4*)(src + (size_t)(r0 + (b >> 3)) * 2048 + 4 * lane + 256 * (b & 7)) * scale;
#pragma unroll
    for (int rr = 0; rr < 2; ++rr) { u32x4 w;
#pragma unroll
        for (int q = 0; q < 4; ++q) { float e[8] = {a[8 * rr + 2 * q][0], a[8 * rr + 2 * q][1], a[8 * rr + 2 * q][2], a[8 * rr + 2 * q][3], a[8 * rr + 2 * q + 1][0], a[8 * rr + 2 * q + 1][1], a[8 * rr + 2 * q + 1][2], a[8 * rr + 2 * q + 1][3]};
#pragma unroll
            for (int j = 0; j < 8; ++j) e[j] = fminf(fmaxf(e[j], -6.0f), 6.0f);
            unsigned t = 0u; t = __builtin_amdgcn_cvt_scalef32_pk_fp4_f32(t, e[0], e[1], 1.0f, 0); t = __builtin_amdgcn_cvt_scalef32_pk_fp4_f32(t, e[2], e[3], 1.0f, 1);
            t = __builtin_amdgcn_cvt_scalef32_pk_fp4_f32(t, e[4], e[5], 1.0f, 2); t = __builtin_amdgcn_cvt_scalef32_pk_fp4_f32(t, e[6], e[7], 1.0f, 3); w[q] = t; }
        *(u32x4*)(dst + (size_t)(r0 + rr) * 1024 + 16 * lane) = w; }
}
__device__ __forceinline__ void table_item(const Ctx& C, int layer, int r, int lane) {
    const int t = r >> 13, rp = r & 8191;
    const float* src = (t ? C.in[34] : C.in[33]) + (size_t)layer * 16384 * 2048; unsigned char* dst = C.ws + (t ? WS_V : WS_U) + (size_t)layer * TAB_L1;
    fp4_row_pair(src, dst, t ? V4_SCALE : U4_SCALE, 2 * rp, lane);
}
__device__ __forceinline__ void wave_item(const Ctx& C, int it, LAS float* scr, int lane) {
    bf16_t* w_in = (bf16_t*)(C.ws + WS_WIN); bf16_t* w_outr = (bf16_t*)(C.ws + WS_WOUTR); bf16_t* w_q = (bf16_t*)(C.ws + WS_WQ);
    bf16_t* w_dqkv = (bf16_t*)(C.ws + WS_WDQKV); bf16_t* w_uq = (bf16_t*)(C.ws + WS_WUQ); bf16_t* w_ukv = (bf16_t*)(C.ws + WS_WUKV);
    bf16_t* w_outa = (bf16_t*)(C.ws + WS_WOUTA); bf16_t* w_gate = (bf16_t*)(C.ws + WS_WGATE); bf16_t* w_pool = (bf16_t*)(C.ws + WS_WPOOL);
    int r = it;
    if (r < I_IN) { transpose_mat_item(C.in[13], 2048, 3072, w_in, 2048, 0, 0, r, scr, lane); return; } r -= I_IN;
    if (r < I_GATE) {
        const int q = r / 8, sub = r % 8, h = q >> 1, gsel = q & 1;
        const float* src = (gsel ? C.in[18] : C.in[16]) + (size_t)h * 128 * 128;
        transpose_mat_item(src, 128, 128, w_gate, 256, h * 256 + gsel * 128, (h & 1) * 128, sub, scr, lane); return; } r -= I_GATE;
    if (r < I_POOL) { const int gq = r / 32, sub = r % 32;
        transpose_mat_item(C.in[21] + (size_t)gq * 256 * 256, 256, 256, w_pool, 256, gq * 256, 0, sub, scr, lane); return; } r -= I_POOL;
    if (r < I_OUTR) { transpose_mat_item(C.in[23], 2048, 2048, w_outr, 2048, 0, 0, r, scr, lane); return; } r -= I_OUTR;
    if (r < I_Q) { transpose_mat_item(C.in[31], 2048, 2048, w_q, 2048, 0, 0, r, scr, lane); return; } r -= I_Q;
    if (r < I_KEYS) { convert_range(C.in[32] + (size_t)r * 2048, (bf16_t*)(C.ws + WS_KEYS) + (size_t)r * 2048, 256, (size_t)lane, 64); return; } r -= I_KEYS;
    if (r < I_TAB) { table_item(C, 0, r, lane); return; } r -= I_TAB;
    if (r < I_DQ) { transpose_mat_item(C.in[24], 2048, 512, w_dqkv, 2048, 0, 0, r, scr, lane); return; } r -= I_DQ;
    if (r < I_DKV) { transpose_mat_item(C.in[27], 2048, 320, w_dqkv, 2048, 512, 0, r, scr, lane); return; } r -= I_DKV;
    if (r < I_ROPE) {
        float* rope = (float*)(C.ws + WS_ROPE);
        for (int q = 0; q < 8; ++q) { const int i = r * 512 + q * 64 + lane, pos = i >> 5, j = i & 31;
            double inv = 1.0; for (int qq = 0; qq < j; ++qq) inv *= 0.7498942093324559;
            const double rev = (double)pos * inv * 0.15915494309189535; const float fr = (float)(rev - __builtin_floor(rev));
            rope[(size_t)pos * 64 + j] = __builtin_amdgcn_cosf(fr); rope[(size_t)pos * 64 + 32 + j] = __builtin_amdgcn_sinf(fr); }
        return; } r -= I_ROPE;
    if (r < I_UQ) {
        const int kb = r / 96, nb = r % 96, n0 = 32 * nb, h = n0 / 192, d = n0 % 192;
        const int drow = (d < 128) ? h * 128 + d : 2048 + (h >> 2) * 256 + ((d - 128) >> 5) * 128 + (h & 3) * 32;
        transpose_item_f8(C.in[26], 3072, 64 * kb, n0, (unsigned char*)w_uq, 512, drow, 64 * kb, scr, lane); return; } r -= I_UQ;
    if (r < I_UKV) { const int nblk = 4096 / 32, kb = r / nblk, nb = r % nblk;
        transpose_item_f8(C.in[29], 4096, 64 * kb, 32 * nb, (unsigned char*)w_ukv, 256, 32 * nb, 64 * kb, scr, lane); return; } r -= I_UKV;
    if (r < I_OUTA) { const int nblk = 2048 / 32, kb = r / nblk, nb = r % nblk;
        transpose_item_f8(C.in[30], 2048, 64 * kb, 32 * nb, (unsigned char*)w_outa, 2048, 32 * nb, 64 * kb, scr, lane); return; } r -= I_OUTA;
    if (r < I_Q) { transpose_mat_item(C.in[31] + (size_t)2048 * 2048, 2048, 2048, w_q + (size_t)2048 * 2048, 2048, 0, 0, r, scr, lane); return; } r -= I_Q;
    table_item(C, 1, r, lane);
}
__device__ __forceinline__ void service(const Ctx& C, bool fill, int slot, int limit, bool signal = true) {
    unsigned* ctl = (unsigned*)(C.ws + WS_CTL); unsigned* qhead = ctl + CW_QHEAD; unsigned* done = ctl + CW_DONE + slot;
    volatile LAS int* lslot = (volatile LAS int*)(C.lds + LDS_SLOT);
    LAS float* scr = (LAS float*)(C.lds + 72704 + C.wave * 8448);
    __syncthreads();
    if (fill && signal && C.tid == 0) __hip_atomic_fetch_add(done, 1u, __ATOMIC_RELAXED, __HIP_MEMORY_SCOPE_AGENT);
    const unsigned lim = fill ? (unsigned)(NTOT / 8) : (unsigned)(limit / 8);
    for (;;) {
        if (C.tid == 0) { int it = -1;
            const unsigned h = __hip_atomic_load(qhead, __ATOMIC_RELAXED, __HIP_MEMORY_SCOPE_AGENT);
            bool go = h < lim;
            if (go && fill) go = __hip_atomic_load(done, __ATOMIC_RELAXED, __HIP_MEMORY_SCOPE_AGENT) < (unsigned)C.G;
            if (go) { const unsigned t = __hip_atomic_fetch_add(qhead, 1u, __ATOMIC_RELAXED, __HIP_MEMORY_SCOPE_AGENT); if (t < (unsigned)(NTOT / 8)) it = (int)t; }
            *lslot = it; }
        __syncthreads();
        const int it = *lslot;
        __syncthreads();
        if (it < 0) break;
        { Ctx D = C; int ln = C.lane; asm volatile("" : "+v"(ln)); D.lane = ln;
          wave_item(D, it * 8 + C.wave, scr, ln); }
    }
}
}

__device__ __forceinline__ void phase_prologue(const Ctx& C) {
    const int lane = C.lane;
    constexpr int NADA = 192;
    for (int it = C.vcu; it < NADA; it += C.G) ada_item(C, it);
    bq::service(C, true, 0, 0);
    const size_t gt = (size_t)C.vcu * 512 + C.tid, GT = (size_t)C.G * 512;
    { float* sp = (float*)(C.ws + WS_SP);
      for (size_t i = gt; i < 1024; i += GT) { sp[i] = C.in[17][i]; sp[1024 + i] = C.in[19][i]; const float y = fexp(-C.in[20][i]); sp[2048 + i] = (y < 0.03f) ? y * (1.0f - y * (0.5f - y * (0.33333333f - y * (0.25f - 0.2f * y)))) : 0.6931471805599453f * __builtin_amdgcn_logf(1.0f + y); } }
}
__device__ __forceinline__ void norm_mod_row(const float* xrow, const float* g, const float* shift, const float* scale, bf16_t* orow, int lane) {
    f32x4 v[8]; float ss = 0.f;
#pragma unroll
    for (int j = 0; j < 8; ++j) { v[j] = *((const f32x4*)xrow + lane + 64 * j); ss += (v[j].x * v[j].x + v[j].y * v[j].y) + (v[j].z * v[j].z + v[j].w * v[j].w); }
    const float rstd = __builtin_amdgcn_rsqf(wave_sum(ss) * (1.0f / DM) + RMS_EPS);
#pragma unroll
    for (int j = 0; j < 8; ++j) { const int q = lane + 64 * j; const f32x4 gv = *((const f32x4*)g + q), sc = *((const f32x4*)scale + q), sh = *((const f32x4*)shift + q);
        const f32x4 y = v[j] * rstd * gv * (sc + 1.0f) + sh;
        u32x2 w; w.x = cvt_pk_bf16(y.x, y.y); w.y = cvt_pk_bf16(y.z, y.w); *((u32x2*)orow + q) = w; }
}
__device__ __forceinline__ void phase_norm(const Ctx& C, const float* xP, const float* xS, const float* g, const float* modl, int part, bf16_t* hn) {
    const int lane = C.lane; int m = C.gw; if (m >= MT) return;
    f32x4 gv[8];
#pragma unroll
    for (int j = 0; j < 8; ++j) gv[j] = *((const f32x4*)g + lane + 64 * j);
    f32x4 nv[8];
    { const float* xr = (m < MP) ? xP + (size_t)m * DM : xS + (size_t)(m - MP) * DM;
#pragma unroll
      for (int j = 0; j < 8; ++j) nv[j] = *((const f32x4*)xr + lane + 64 * j); }
    for (; m < MT; m += C.NGW) {
        f32x4 v[8];
#pragma unroll
        for (int j = 0; j < 8; ++j) v[j] = nv[j];
        const int mn = m + C.NGW;
        if (mn < MT) { const float* xr = (mn < MP) ? xP + (size_t)mn * DM : xS + (size_t)(mn - MP) * DM;
#pragma unroll
            for (int j = 0; j < 8; ++j) nv[j] = *((const f32x4*)xr + lane + 64 * j); }
        const float* mp = modl + (size_t)seq_of_row(m) * 12288 + part * 2048;
        f32x4 sc[8], sh[8];
#pragma unroll
        for (int j = 0; j < 8; ++j) { const int q = lane + 64 * j; sh[j] = *((const f32x4*)mp + q); sc[j] = *((const f32x4*)(mp + 2048) + q); }
        float ss = 0.f;
#pragma unroll
        for (int j = 0; j < 8; ++j) ss += (v[j].x * v[j].x + v[j].y * v[j].y) + (v[j].z * v[j].z + v[j].w * v[j].w);
        const float rstd = __builtin_amdgcn_rsqf(wave_sum(ss) * (1.0f / DM) + RMS_EPS);
#pragma unroll
        for (int j = 0; j < 8; ++j) { const int q = lane + 64 * j; const f32x4 y = v[j] * rstd * gv[j] * (sc[j] + 1.0f) + sh[j];
            u32x2 w; w.x = cvt_pk_bf16(y.x, y.y); w.y = cvt_pk_bf16(y.z, y.w); *((u32x2*)(hn + (size_t)m * DM) + q) = w; }
    }
}
__device__ __forceinline__ void phase_resid_norm(const Ctx& C, const float* xP, const float* xS, const bf16_t* mix, float* X, const float* g, const float* modl, bf16_t* hn) {
    const int lane = C.lane; int m = C.gw; if (m >= MT) return;
    f32x4 gv[8];
#pragma unroll
    for (int j = 0; j < 8; ++j) gv[j] = *((const f32x4*)g + lane + 64 * j);
    f32x4 nx[8]; u32x2 nm[8];
    { const float* xr = (m < MP) ? xP + (size_t)m * DM : xS + (size_t)(m - MP) * DM;
#pragma unroll
      for (int j = 0; j < 8; ++j) { const int q = lane + 64 * j; nx[j] = *((const f32x4*)xr + q); nm[j] = *((const u32x2*)(mix + (size_t)m * DM) + q); } }
    for (; m < MT; m += C.NGW) {
        f32x4 v[8]; u32x2 mw[8];
#pragma unroll
        for (int j = 0; j < 8; ++j) { v[j] = nx[j]; mw[j] = nm[j]; }
        const int mn = m + C.NGW;
        if (mn < MT) { const float* xr = (mn < MP) ? xP + (size_t)mn * DM : xS + (size_t)(mn - MP) * DM;
#pragma unroll
            for (int j = 0; j < 8; ++j) { const int q = lane + 64 * j; nx[j] = *((const f32x4*)xr + q); nm[j] = *((const u32x2*)(mix + (size_t)mn * DM) + q); } }
        const float* mp = modl + (size_t)seq_of_row(m) * 12288;
        float ss = 0.f;
#pragma unroll
        for (int j = 0; j < 8; ++j) { const int q = lane + 64 * j; const f32x4 g1 = *((const f32x4*)(mp + 2 * 2048) + q);
            v[j] = v[j] + g1 * (f32x4){bf_lo(mw[j].x), bf_hi(mw[j].x), bf_lo(mw[j].y), bf_hi(mw[j].y)}; ss += (v[j].x * v[j].x + v[j].y * v[j].y) + (v[j].z * v[j].z + v[j].w * v[j].w);
            *((f32x4*)(X + (size_t)m * DM) + q) = v[j]; }
        const float rstd = __builtin_amdgcn_rsqf(wave_sum(ss) * (1.0f / DM) + RMS_EPS);
#pragma unroll
        for (int j = 0; j < 8; ++j) { const int q = lane + 64 * j; const f32x4 sh = *((const f32x4*)(mp + 3 * 2048) + q), sc = *((const f32x4*)(mp + 4 * 2048) + q);
            const f32x4 y = v[j] * rstd * gv[j] * (sc + 1.0f) + sh;
            u32x2 w; w.x = cvt_pk_bf16(y.x, y.y); w.y = cvt_pk_bf16(y.z, y.w); *((u32x2*)(hn + (size_t)m * DM) + q) = w; }
    }
}

__device__ __forceinline__ void ld8bf(const bf16_t* p, float (&v)[8]) { const u32x4 w = *(const u32x4*)p; v[0] = bf_lo(w.x); v[1] = bf_hi(w.x); v[2] = bf_lo(w.y); v[3] = bf_hi(w.y); v[4] = bf_lo(w.z); v[5] = bf_hi(w.z); v[6] = bf_lo(w.w); v[7] = bf_hi(w.w); }
__device__ __forceinline__ void ld8f(const float* p, float (&v)[8]) { const f32x4 a = *(const f32x4*)p, b = *(const f32x4*)(p + 4); v[0] = a.x; v[1] = a.y; v[2] = a.z; v[3] = a.w; v[4] = b.x; v[5] = b.y; v[6] = b.z; v[7] = b.w; }
__device__ __forceinline__ void st8bf(bf16_t* p, const float (&v)[8]) { u32x4 w; w.x = cvt_pk_bf16(v[0], v[1]); w.y = cvt_pk_bf16(v[2], v[3]); w.z = cvt_pk_bf16(v[4], v[5]); w.w = cvt_pk_bf16(v[6], v[7]); *(u32x4*)p = w; }
__device__ __forceinline__ void st8f(float* p, const float (&v)[8]) { *(f32x4*)p = (f32x4){v[0], v[1], v[2], v[3]}; *(f32x4*)(p + 4) = (f32x4){v[4], v[5], v[6], v[7]}; }

__device__ __forceinline__ void phase_convpool(const Ctx& C) {
    const bf16_t* __restrict__ REC = (const bf16_t*)(C.ws + A_B2); const bf16_t* __restrict__ PIN = REC + (size_t)MT * 1024;
    bf16_t* __restrict__ XC = (bf16_t*)(C.ws + A_B3); bf16_t* __restrict__ POOLED = XC + (size_t)MT * 1024;
    const float* convw = C.in[14]; const float* convb = C.in[15]; const float* st_conv = C.in[4]; const float* st_pool = C.in[6];
    const int NITEM = 2 * 544 * 128;
    for (int it0 = C.vcu * 512 + C.tid; it0 < NITEM; it0 += C.G * 512) {
        const bool is_pool = it0 >= 544 * 128; const int it = is_pool ? it0 - 544 * 128 : it0;
        const int chunk = it >> 7, ch0 = (it & 127) * 8;
        const bool samp = chunk >= 512; const int sb = chunk - 512;
        const int row0 = samp ? MP + sb * 64 : chunk * 64;
        const int t0 = samp ? 0 : (chunk & 255) * 64;
        const bool lastc = samp || ((chunk & 255) == 255);
        if (!is_pool) {
            float w0[8], w1[8], w2[8], w3[8], bb[8], p0[8], p1[8], p2[8];
            ld8f(convw + ch0, w0); ld8f(convw + 1024 + ch0, w1); ld8f(convw + 2048 + ch0, w2); ld8f(convw + 3072 + ch0, w3); ld8f(convb + ch0, bb);
            if (samp) { ld8f(st_conv + ((size_t)sb * 3 + 0) * 1024 + ch0, p0); ld8f(st_conv + ((size_t)sb * 3 + 1) * 1024 + ch0, p1); ld8f(st_conv + ((size_t)sb * 3 + 2) * 1024 + ch0, p2); }
            else if (t0 > 0) { ld8bf(REC + (size_t)(row0 - 3) * 1024 + ch0, p0); ld8bf(REC + (size_t)(row0 - 2) * 1024 + ch0, p1); ld8bf(REC + (size_t)(row0 - 1) * 1024 + ch0, p2); }
            else {
#pragma unroll
                for (int j = 0; j < 8; ++j) { p0[j] = 0.f; p1[j] = 0.f; p2[j] = 0.f; } }
            for (int tb = 0; tb < 64; tb += 8) {
                u32x4 raw[8];
#pragma unroll
                for (int q = 0; q < 8; ++q) raw[q] = *(const u32x4*)(REC + (size_t)(row0 + tb + q) * 1024 + ch0);
#pragma unroll
                for (int q = 0; q < 8; ++q) { const u32x4 w = raw[q]; const float cur[8] = {bf_lo(w.x), bf_hi(w.x), bf_lo(w.y), bf_hi(w.y), bf_lo(w.z), bf_hi(w.z), bf_lo(w.w), bf_hi(w.w)}; float o[8];
#pragma unroll
                    for (int j = 0; j < 8; ++j) { o[j] = bb[j] + w0[j] * p0[j] + w1[j] * p1[j] + w2[j] * p2[j] + w3[j] * cur[j]; p0[j] = p1[j]; p1[j] = p2[j]; p2[j] = cur[j]; }
                    st8bf(XC + (size_t)(row0 + tb + q) * 1024 + ch0, o); } }
            if (lastc) { float* dst = samp ? C.out + O_CONV_S + (size_t)sb * 3 * 1024 : C.out + O_CONV_P + (size_t)(chunk >> 8) * 3 * 1024;
                st8f(dst + ch0, p0); st8f(dst + 1024 + ch0, p1); st8f(dst + 2048 + ch0, p2); }
        } else {
            const int gsel = ch0 >> 8, w = 2 << gsel;
            float S[8];
#pragma unroll
            for (int j = 0; j < 8; ++j) S[j] = 0.f;
            for (int tt = 1 - w; tt < 0; ++tt) { float v[8];
                if (samp) ld8f(st_pool + ((size_t)sb * 15 + 15 + tt) * 1024 + ch0, v);
                else if (t0 + tt >= 0) ld8bf(PIN + (size_t)(row0 + tt) * 1024 + ch0, v);
                else {
#pragma unroll
                    for (int j = 0; j < 8; ++j) v[j] = 0.f; }
#pragma unroll
                for (int j = 0; j < 8; ++j) S[j] += v[j]; }
            for (int tb = 0; tb < 64; tb += 8) {
                u32x4 rawc[8]; float oldv[8][8];
#pragma unroll
                for (int q = 0; q < 8; ++q) rawc[q] = *(const u32x4*)(PIN + (size_t)(row0 + tb + q) * 1024 + ch0);
#pragma unroll
                for (int q = 0; q < 8; ++q) { const int tt = tb + q - w + 1;
                    if (tt >= 0 || (!samp && t0 + tt >= 0)) ld8bf(PIN + (size_t)(row0 + tt) * 1024 + ch0, oldv[q]);
                    else if (samp) ld8f(st_pool + ((size_t)sb * 15 + 15 + tt) * 1024 + ch0, oldv[q]);
                    else {
#pragma unroll
                        for (int j = 0; j < 8; ++j) oldv[q][j] = 0.f; } }
#pragma unroll
                for (int q = 0; q < 8; ++q) { const u32x4 wv = rawc[q]; const float cur[8] = {bf_lo(wv.x), bf_hi(wv.x), bf_lo(wv.y), bf_hi(wv.y), bf_lo(wv.z), bf_hi(wv.z), bf_lo(wv.w), bf_hi(wv.w)}; float o[8];
                    const int pos = samp ? 1024 + tb + q : t0 + tb + q; const float rc = 1.0f / (float)((pos + 1 < w) ? pos + 1 : w);
#pragma unroll
                    for (int j = 0; j < 8; ++j) { S[j] += cur[j]; o[j] = S[j] * rc - cur[j]; S[j] -= oldv[q][j]; }
                    st8bf(POOLED + (size_t)(row0 + tb + q) * 1024 + ch0, o); } }
            if (lastc) { float* dst = samp ? C.out + O_POOL_S + (size_t)sb * 15 * 1024 : C.out + O_POOL_P + (size_t)(chunk >> 8) * 15 * 1024;
                for (int i = 0; i < 15; ++i) { float v[8]; ld8bf(PIN + (size_t)(row0 + 49 + i) * 1024 + ch0, v); st8f(dst + (size_t)i * 1024 + ch0, v); } }
        }
    }
}

__device__ __forceinline__ void phase_scanA(const Ctx& C) {
    const float* __restrict__ A = (const float*)(C.ws + A_B4); const bf16_t* __restrict__ U = (const bf16_t*)(A + (size_t)MT * 1024);
    float* __restrict__ cP = (float*)(C.ws + WS_SCAN); float* __restrict__ cH = cP + SCAN_WORDS;
    for (int it = C.vcu * 512 + C.tid; it < 544 * 256; it += C.G * 512) {
        const int chunk = it >> 8, ch = (it & 255) * 4; const int row0 = chunk * 64;
        f32x4 P = {1.f, 1.f, 1.f, 1.f}, H = {0.f, 0.f, 0.f, 0.f};
        for (int tb = 0; tb < 64; tb += 8) { f32x4 av[8], uv[8];
#pragma unroll
            for (int q = 0; q < 8; ++q) { av[q] = *(const f32x4*)(A + (size_t)(row0 + tb + q) * 1024 + ch); const u32x2 uw = *(const u32x2*)(U + (size_t)(row0 + tb + q) * 1024 + ch); uv[q] = (f32x4){bf_lo(uw.x), bf_hi(uw.x), bf_lo(uw.y), bf_hi(uw.y)}; }
#pragma unroll
            for (int q = 0; q < 8; ++q) { H = av[q] * H + uv[q]; P = P * av[q]; } }
        *(f32x4*)(cP + (size_t)chunk * 1024 + ch) = P; *(f32x4*)(cH + (size_t)chunk * 1024 + ch) = H;
    }
}
__device__ __forceinline__ void phase_scanB(const Ctx& C) {
    const float* __restrict__ cP = (const float*)(C.ws + WS_SCAN); const float* __restrict__ cH = cP + SCAN_WORDS; float* __restrict__ cI = (float*)(C.ws + WS_SCAN) + 2 * SCAN_WORDS;
    const int it = C.vcu * 512 + C.tid;
    if (it < 2048) { const int s = it >> 10, ch = it & 1023; float carry = 0.f;
        for (int cb = 0; cb < 256; cb += 16) { float pv[16], hv[16];
#pragma unroll
            for (int q = 0; q < 16; ++q) { const size_t o = (size_t)(s * 256 + cb + q) * 1024 + ch; pv[q] = cP[o]; hv[q] = cH[o]; }
#pragma unroll
            for (int q = 0; q < 16; ++q) { cI[(size_t)(s * 256 + cb + q) * 1024 + ch] = carry; carry = pv[q] * carry + hv[q]; } } }
}
__device__ __forceinline__ void phase_scanC(const Ctx& C) {
    const float* __restrict__ A = (const float*)(C.ws + A_B4); const bf16_t* __restrict__ U = (const bf16_t*)(A + (size_t)MT * 1024); const float* __restrict__ cI = (const float*)(C.ws + WS_SCAN) + 2 * SCAN_WORDS;
    const bf16_t* __restrict__ GG = (const bf16_t*)(C.ws + A_GG); bf16_t* __restrict__ CAT = (bf16_t*)(C.ws + A_HN); const float* hprev = C.in[5];
    for (int it = C.vcu * 512 + C.tid; it < 544 * 256; it += C.G * 512) {
        const int chunk = it >> 8, ch = (it & 255) * 4; const int row0 = chunk * 64; const bool samp = chunk >= 512;
        f32x4 h = samp ? *(const f32x4*)(hprev + (size_t)(chunk - 512) * 1024 + ch) : *(const f32x4*)(cI + (size_t)chunk * 1024 + ch);
        for (int tb = 0; tb < 64; tb += 8) { f32x4 av[8], uv[8]; u32x2 gv[8];
#pragma unroll
            for (int q = 0; q < 8; ++q) { const size_t o = (size_t)(row0 + tb + q) * 1024 + ch; av[q] = *(const f32x4*)(A + o); { const u32x2 uw = *(const u32x2*)(U + o); uv[q] = (f32x4){bf_lo(uw.x), bf_hi(uw.x), bf_lo(uw.y), bf_hi(uw.y)}; } gv[q] = *(const u32x2*)(GG + o); }
#pragma unroll
            for (int q = 0; q < 8; ++q) { h = av[q] * h + uv[q];
                u32x2 w; w.x = cvt_pk_bf16(bf_lo(gv[q].x) * h.x, bf_hi(gv[q].x) * h.y); w.y = cvt_pk_bf16(bf_lo(gv[q].y) * h.z, bf_hi(gv[q].y) * h.w);
                *(u32x2*)(CAT + (size_t)(row0 + tb + q) * 2048 + ch) = w; } }
        if (samp) *(f32x4*)(C.out + O_H_S + (size_t)(chunk - 512) * 1024 + ch) = h;
        else if ((chunk & 255) == 255) *(f32x4*)(C.out + O_H_P + (size_t)(chunk >> 8) * 1024 + ch) = h;
    }
}

__device__ __forceinline__ void phase_latent(const Ctx& C) {
    const float* CQKV = (const float*)(C.ws + A_B3); bf16_t* CQ = (bf16_t*)(C.ws + A_CQ); bf16_t* CKV = (bf16_t*)(C.ws + A_CKV); unsigned char* KP = C.ws + A_KP;
    const float* gq = C.in[25]; const float* gkv = C.in[28]; const float* rope = (const float*)(C.ws + WS_ROPE); const int lane = C.lane;
    for (int m = C.gw; m < MT; m += C.NGW) {
        const float* r = CQKV + (size_t)m * 1024; const int kvr = kvrow_of_row(m);
        { float v[8]; ld8f(r + lane * 8, v); float ss = 0.f;
#pragma unroll
          for (int j = 0; j < 8; ++j) ss += v[j] * v[j];
          const float rstd = __builtin_amdgcn_rsqf(wave_sum(ss) * (1.0f / 512) + RMS_EPS); float g[8]; ld8f(gq + lane * 8, g);
#pragma unroll
          for (int j = 0; j < 8; ++j) v[j] = v[j] * rstd * g[j];
          { u32x2 w8; w8.x = cvt4_fp8(v[0], v[1], v[2], v[3]); w8.y = cvt4_fp8(v[4], v[5], v[6], v[7]); *(u32x2*)((unsigned char*)CQ + (size_t)m * 512 + lane * 8) = w8; } }
        { const f32x4 v = *(const f32x4*)(r + 512 + lane * 4); const float ss = (v.x * v.x + v.y * v.y) + (v.z * v.z + v.w * v.w);
          const float rstd = __builtin_amdgcn_rsqf(wave_sum(ss) * (1.0f / 256) + RMS_EPS); const f32x4 y = v * rstd * *(const f32x4*)(gkv + lane * 4);
          *(f32x4*)(C.out + O_CKV + (size_t)m * 256 + lane * 4) = y;
          *(unsigned*)((unsigned char*)CKV + (size_t)kvr * 256 + lane * 4) = cvt4_fp8(y.x, y.y, y.z, y.w); }
        { const float x = r[768 + lane]; const float xo = __shfl_xor(x, 32); const int j = lane & 31; const float* rp = rope + (size_t)pos_of_row(m) * 64;
          const float c = rp[j], s = rp[32 + j]; const float y = (lane < 32) ? x * c - xo * s : xo * s + x * c;
          C.out[O_KPE + (size_t)m * 64 + lane] = y; KP[(size_t)kvr * 64 + lane] = (unsigned char)(cvt4_fp8(y, 0.f, 0.f, 0.f) & 0xffu); }
    }
    const size_t gt = (size_t)C.vcu * 512 + C.tid, GT = (size_t)C.G * 512;
    for (size_t i = gt; i < (size_t)32 * 1024 * 256 / 8; i += GT) { const size_t e = i * 8, rowc = e / 256, col = e % 256, b = rowc / 1024, p = rowc % 1024;
        float v[8]; ld8f(C.in[7] + e, v); u32x2 w8; w8.x = cvt4_fp8(v[0], v[1], v[2], v[3]); w8.y = cvt4_fp8(v[4], v[5], v[6], v[7]); *(u32x2*)((unsigned char*)CKV + ((size_t)MP + b * 1088 + p) * 256 + col) = w8; }
    for (size_t i = gt; i < (size_t)32 * 1024 * 64 / 8; i += GT) { const size_t e = i * 8, rowc = e / 64, col = e % 64, b = rowc / 1024, p = rowc % 1024;
        float v[8]; ld8f(C.in[8] + e, v); u32x2 w8; w8.x = cvt4_fp8(v[0], v[1], v[2], v[3]); w8.y = cvt4_fp8(v[4], v[5], v[6], v[7]); *(u32x2*)(KP + ((size_t)MP + b * 1088 + p) * 64 + col) = w8; }
}
typedef __bf16 bf2_t __attribute__((ext_vector_type(2)));
__device__ __forceinline__ unsigned ford(float f) { const unsigned u = __float_as_uint(f); return (u & 0x80000000u) ? ~u : (u | 0x80000000u); }
__device__ __forceinline__ float funord(unsigned o) { return __uint_as_float((o & 0x80000000u) ? (o & 0x7fffffffu) : ~o); }
__device__ __forceinline__ unsigned umax(unsigned a, unsigned b) { return a > b ? a : b; }
__device__ __forceinline__ unsigned umin(unsigned a, unsigned b) { return a < b ? a : b; }
__device__ __forceinline__ void ins16(unsigned (&L)[16], unsigned x) {
#pragma unroll
    for (int i = 0; i < 16; ++i) { const unsigned t = umax(L[i], x); x = umin(L[i], x); L[i] = t; }
}
__device__ __forceinline__ void ins16p(unsigned (&K)[16], unsigned (&P)[16], unsigned key, unsigned pay) {
#pragma unroll
    for (int i = 0; i < 16; ++i) { const bool c = key > K[i]; const unsigned tk = c ? key : K[i], nk = c ? K[i] : key, tp = c ? pay : P[i], np = c ? P[i] : pay; K[i] = tk; P[i] = tp; key = nk; pay = np; }
}
__device__ __forceinline__ void sort16_desc(unsigned (&v)[16]) {
#pragma unroll
    for (int k = 2; k <= 16; k <<= 1)
#pragma unroll
        for (int j = k >> 1; j >= 1; j >>= 1)
#pragma unroll
            for (int i = 0; i < 16; ++i) { const int l = i ^ j; if (l > i) { const bool desc = ((i & k) == 0); const unsigned a = v[i], b = v[l], hi = umax(a, b), lo = umin(a, b); v[i] = desc ? hi : lo; v[l] = desc ? lo : hi; } }
}
__device__ __forceinline__ void merge16_desc(unsigned (&A)[16], const unsigned (&B)[16]) {
#pragma unroll
    for (int i = 0; i < 16; ++i) A[i] = umax(A[i], B[15 - i]);
#pragma unroll
    for (int st = 8; st >= 1; st >>= 1)
#pragma unroll
        for (int i = 0; i < 16; ++i) if ((i & st) == 0) { const unsigned a = A[i], b = A[i + st]; A[i] = umax(a, b); A[i + st] = umin(a, b); }
}
__device__ __forceinline__ void subkey_top16(const bf16_t* qrow  , const bf16_t* krow  , int hh, unsigned (&S)[16]) {
    bf16x8 qf[8];
#pragma unroll
    for (int s = 0; s < 8; ++s) qf[s] = *(const bf16x8*)(qrow + 16 * s);
    unsigned L[16];
#pragma unroll
    for (int i = 0; i < 16; ++i) L[i] = 0u;
#pragma unroll 1
    for (int kb = 0; kb < 4; ++kb) {
        bf16x8 kf[8];
#pragma unroll
        for (int s = 0; s < 8; ++s) kf[s] = *(const bf16x8*)(krow + (size_t)kb * 32 * 128 + 16 * s);
        f32x16 a = {0.f, 0.f, 0.f, 0.f, 0.f, 0.f, 0.f, 0.f, 0.f, 0.f, 0.f, 0.f, 0.f, 0.f, 0.f, 0.f};
#pragma unroll
        for (int s = 0; s < 8; ++s) a = __builtin_amdgcn_mfma_f32_32x32x16_bf16(kf[s], qf[s], a, 0, 0, 0);
        unsigned N[16];
#pragma unroll
        for (int r = 0; r < 16; ++r) { const unsigned idx = (unsigned)(32 * kb + (r & 3) + 8 * (r >> 2) + 4 * hh); N[r] = (ford(a[r]) & ~0x7fu) | idx; }
        sort16_desc(N); merge16_desc(L, N);
        asm volatile("" ::: "memory");
    }
    unsigned P[16];
#pragma unroll
    for (int i = 0; i < 16; ++i) P[i] = (unsigned)__shfl_xor((int)L[i], 32);
#pragma unroll
    for (int i = 0; i < 16; ++i) S[i] = L[i];
    merge16_desc(S, P);
}
__device__ __forceinline__ void phase_topk(const Ctx& C, int layer) {
    const bf16_t* Q = (const bf16_t*)(C.ws + A_B3); const bf16_t* KEYS = (const bf16_t*)(C.ws + WS_KEYS) + (size_t)layer * 8 * 2 * 128 * 128;
    int* IDX = (int*)(C.ws + A_B4); float* GATE = (float*)(C.ws + A_B4) + (size_t)MT * 128;
    const int lane = C.lane, r = lane & 31, hh = lane >> 5;
    for (int task = C.gw; task < (MT / 32) * 8; task += C.NGW) {
        const int tg = task >> 3, h = task & 7, m = tg * 32 + r;
        unsigned S1[16], S2[16];
        subkey_top16(Q + (size_t)m * 2048 + h * 256 + 8 * hh, KEYS + ((size_t)(h * 2 + 0) * 128 + r) * 128 + 8 * hh, hh, S1);
        subkey_top16(Q + (size_t)m * 2048 + h * 256 + 128 + 8 * hh, KEYS + ((size_t)(h * 2 + 1) * 128 + r) * 128 + 8 * hh, hh, S2);
#define CKEY(a, b) ((ford(funord(S1[a] & ~0x7fu) + funord(S2[b] & ~0x7fu)) & ~0xffu) | (unsigned)((a) << 4 | (b)))
        unsigned FK[16], G[16];
#pragma unroll
        for (int b = 0; b < 16; ++b) FK[b] = CKEY(0, b);
#pragma unroll
        for (int b = 0; b < 8; ++b) G[b] = CKEY(1, b);
#pragma unroll
        for (int b = 0; b < 5; ++b) G[8 + b] = CKEY(2, b);
#pragma unroll
        for (int b = 0; b < 3; ++b) G[13 + b] = CKEY(4, b);
        sort16_desc(G); merge16_desc(FK, G);
#pragma unroll
        for (int b = 0; b < 4; ++b) G[b] = CKEY(3, b);
#pragma unroll
        for (int b = 0; b < 2; ++b) { G[4 + b] = CKEY(5, b); G[6 + b] = CKEY(6, b); G[8 + b] = CKEY(7, b); }
#pragma unroll
        for (int a = 8; a < 14; ++a) G[2 + a] = CKEY(a, 0);
        sort16_desc(G); merge16_desc(FK, G);
        ins16(FK, CKEY(14, 0)); ins16(FK, CKEY(15, 0));
#undef CKEY
        unsigned I1p[4], I2p[4];
#pragma unroll
        for (int w = 0; w < 4; ++w) { I1p[w] = (S1[4 * w] & 0x7fu) | ((S1[4 * w + 1] & 0x7fu) << 8) | ((S1[4 * w + 2] & 0x7fu) << 16) | ((S1[4 * w + 3] & 0x7fu) << 24);
                                      I2p[w] = (S2[4 * w] & 0x7fu) | ((S2[4 * w + 1] & 0x7fu) << 8) | ((S2[4 * w + 2] & 0x7fu) << 16) | ((S2[4 * w + 3] & 0x7fu) << 24); }
        const float mx = funord(FK[0] & ~0xffu); float sum = 0.f;
#pragma unroll
        for (int i = 0; i < 16; ++i) sum += fexp(funord(FK[i] & ~0xffu) - mx);
        const float rs = 1.0f / sum;
        int oi[8]; float og[8];
#pragma unroll
        for (int i = 0; i < 8; ++i) { const unsigned key = hh ? FK[8 + i] : FK[i]; const unsigned a = (key >> 4) & 15u, b = key & 15u;
            const unsigned w1 = (a >> 2) == 0u ? I1p[0] : ((a >> 2) == 1u ? I1p[1] : ((a >> 2) == 2u ? I1p[2] : I1p[3]));
            const unsigned w2 = (b >> 2) == 0u ? I2p[0] : ((b >> 2) == 1u ? I2p[1] : ((b >> 2) == 2u ? I2p[2] : I2p[3]));
            oi[i] = (int)((((w1 >> ((a & 3u) * 8u)) & 0x7fu) << 7) | ((w2 >> ((b & 3u) * 8u)) & 0x7fu));
            og[i] = fexp(funord(key & ~0xffu) - mx) * rs; }
        const size_t o = (size_t)m * 128 + h * 16 + 8 * hh;
        *(u32x4*)(IDX + o) = (u32x4){(unsigned)oi[0], (unsigned)oi[1], (unsigned)oi[2], (unsigned)oi[3]}; *(u32x4*)(IDX + o + 4) = (u32x4){(unsigned)oi[4], (unsigned)oi[5], (unsigned)oi[6], (unsigned)oi[7]};
        *(f32x4*)(GATE + o) = (f32x4){og[0], og[1], og[2], og[3]}; *(f32x4*)(GATE + o + 4) = (f32x4){og[4], og[5], og[6], og[7]};
    }
}

template <int CTRL, int ROWMASK> __device__ __forceinline__ float dppf(float v) { return __builtin_bit_cast(float, __builtin_amdgcn_update_dpp(0, __builtin_bit_cast(int, v), CTRL, ROWMASK, 0xF, false)); }
__device__ __forceinline__ float wave_sum_u(float v) {
    v += dppf<0xB1, 0xF>(v); v += dppf<0x4E, 0xF>(v); v += dppf<0x141, 0xF>(v); v += dppf<0x140, 0xF>(v);
    v += dppf<0x142, 0xA>(v); v += dppf<0x143, 0xC>(v);
    return __builtin_bit_cast(float, __builtin_amdgcn_readlane(__builtin_bit_cast(int, v), 63));
}
struct RowSet4 { u32x4 u, v; };
__device__ __forceinline__ void load_rows4(RowSet4& R, const unsigned char* U4, const unsigned char* V4, int eid, int lane) {
    const size_t o = (size_t)eid * 1024 + lane * 16; R.u = *(const u32x4*)(U4 + o); R.v = *(const u32x4*)(V4 + o);
}
__device__ __forceinline__ void use_rows4(const u32x4 Ru, const u32x4 Rv, const float (&xf)[32], float gate, float (&out)[32]) {
    float d0 = 0.f, d1 = 0.f;
#define U4_STEP(w, b) { const f32x2 t = __builtin_amdgcn_cvt_scalef32_pk_f32_fp4(Ru[w], 1.0f, b); d0 = fmaf(xf[8 * (w) + 2 * (b)], t.x, d0); d1 = fmaf(xf[8 * (w) + 2 * (b) + 1], t.y, d1); }
#define U4_WORD(w) U4_STEP(w, 0) U4_STEP(w, 1) U4_STEP(w, 2) U4_STEP(w, 3)
    U4_WORD(0) U4_WORD(1) U4_WORD(2) U4_WORD(3)
#undef U4_WORD
#undef U4_STEP
    const float d = wave_sum_u(d0 + d1) * (1.0f / U4_SCALE);
    const float a = gelu_erf(d) * gate * (1.0f / V4_SCALE);
#define V4_STEP(w, b) { const f32x2 t = __builtin_amdgcn_cvt_scalef32_pk_f32_fp4(Rv[w], 1.0f, b); out[8 * (w) + 2 * (b)] = fmaf(a, t.x, out[8 * (w) + 2 * (b)]); out[8 * (w) + 2 * (b) + 1] = fmaf(a, t.y, out[8 * (w) + 2 * (b) + 1]); }
#define V4_WORD(w) V4_STEP(w, 0) V4_STEP(w, 1) V4_STEP(w, 2) V4_STEP(w, 3)
    V4_WORD(0) V4_WORD(1) V4_WORD(2) V4_WORD(3)
#undef V4_WORD
#undef V4_STEP
}
typedef _Float16 h16x2 __attribute__((ext_vector_type(2)));
__device__ __forceinline__ float dot_row4(const u32x4 Ru, const h16x2 (&xh)[16]) {
    float d0 = 0.f, d1 = 0.f;
#define U4_STEP(w, b, D) { const h16x2 t = __builtin_amdgcn_cvt_scalef32_pk_f16_fp4(Ru[w], 1.0f, b); D = __builtin_amdgcn_fdot2(xh[4 * (w) + (b)], t, D, false); }
#define U4_WORD(w) U4_STEP(w, 0, d0) U4_STEP(w, 1, d1) U4_STEP(w, 2, d0) U4_STEP(w, 3, d1)
    U4_WORD(0) U4_WORD(1) U4_WORD(2) U4_WORD(3)
#undef U4_WORD
#undef U4_STEP
    return wave_sum_u(d0 + d1);
}
typedef int i32x8 __attribute__((ext_vector_type(8)));
__device__ __forceinline__ float dot_row4_mfma(const u32x4 Ru, const i32x8& xhi, const i32x8& xlo, int dsel, bool dval) {
    const i32x8 a = {(int)Ru.x, (int)Ru.y, (int)Ru.z, (int)Ru.w, 0, 0, 0, 0};
    f32x4 d = {0.f, 0.f, 0.f, 0.f};
    d = __builtin_amdgcn_mfma_scale_f32_16x16x128_f8f6f4(a, xhi, d, 4, 0, 0, 127, 0, 127);
    d = __builtin_amdgcn_mfma_scale_f32_16x16x128_f8f6f4(a, xlo, d, 4, 0, 0, 127, 0, 123);
    float v = dsel == 0 ? d[0] : (dsel == 1 ? d[1] : (dsel == 2 ? d[2] : d[3]));
    v = dval ? v : 0.f;
    return wave_sum_u(v);
}
__device__ __forceinline__ void axpy_row4(const u32x4 Rv, float a, float (&out)[32]) {
#define V4_STEP(w, b) { const f32x2 t = __builtin_amdgcn_cvt_scalef32_pk_f32_fp4(Rv[w], 1.0f, b); out[8 * (w) + 2 * (b)] = fmaf(a, t.x, out[8 * (w) + 2 * (b)]); out[8 * (w) + 2 * (b) + 1] = fmaf(a, t.y, out[8 * (w) + 2 * (b) + 1]); }
#define V4_WORD(w) V4_STEP(w, 0) V4_STEP(w, 1) V4_STEP(w, 2) V4_STEP(w, 3)
    V4_WORD(0) V4_WORD(1) V4_WORD(2) V4_WORD(3)
#undef V4_WORD
#undef V4_STEP
}
__device__ __forceinline__ void phase_gather(const Ctx& C, int layer) {
    const bf16_t* HN2 = (const bf16_t*)(C.ws + A_B2); const unsigned char* U4 = C.ws + WS_U + (size_t)layer * bq::TAB_L1; const unsigned char* V4 = C.ws + WS_V + (size_t)layer * bq::TAB_L1;
    const int* IDX = (const int*)(C.ws + A_B4); const float* GATE = (const float*)(C.ws + A_B4) + (size_t)MT * 128;
    const float* mod = (const float*)(C.ws + WS_MOD); float* X = C.out + O_Y; bf16_t* HN = (bf16_t*)(C.ws + A_HN);
    const int lane = C.lane;
    int m = C.gw; if (m >= MT) return;
    LAS unsigned char* ring = C.lds + C.wave * 16384;
    int i0 = IDX[(size_t)m * 128 + lane], i1 = IDX[(size_t)m * 128 + 64 + lane];
    float g0 = GATE[(size_t)m * 128 + lane], g1 = GATE[(size_t)m * 128 + 64 + lane];
    u32x2 xw[8];
#pragma unroll
    for (int b = 0; b < 8; ++b) xw[b] = *(const u32x2*)(HN2 + (size_t)m * 2048 + 256 * b + 4 * lane);
#pragma unroll
    for (int b = 0; b < 8; ++b) asm volatile("" : "+v"(xw[b]));
    asm volatile("" : "+v"(i0), "+v"(i1), "+v"(g0), "+v"(g1));
    asm volatile("s_waitcnt vmcnt(0)" ::: "memory");
#define SB() __builtin_amdgcn_sched_barrier(0)
    const unsigned lo16 = (unsigned)lane * 16u;
#define ROW_DMA(T, eid_, s_) __builtin_amdgcn_global_load_lds((const unsigned*)((const char*)((T) + (size_t)(eid_) * 1024) + lo16), (LAS unsigned*)(ring + ((s_) & 15) * 1024), 16, 0, 0)
#define EIDC(j) __builtin_amdgcn_readlane(((j) < 64) ? i0 : i1, (j) & 63)
#pragma unroll
    for (int j = 0; j < 14; ++j) ROW_DMA(U4, __builtin_amdgcn_readlane(i0, j), j);
    for (;;) {
        const int mn = m + C.NGW; const bool has_next = mn < MT; const int mq = has_next ? mn : m;
        int ni0, ni1; float ng0, ng1; u32x2 nx[8];
        int lt = lane; asm volatile("" : "+v"(lt));
        { const int* ip = IDX + (size_t)mq * 128 + lt; const float* gp = GATE + (size_t)mq * 128 + lt; const bf16_t* xp = HN2 + (size_t)mq * 2048 + 4 * lt;
          asm volatile("global_load_dword %0, %1, off" : "=v"(ni0) : "v"(ip) : "memory");
          asm volatile("global_load_dword %0, %1, off offset:256" : "=v"(ni1) : "v"(ip) : "memory");
          asm volatile("global_load_dword %0, %1, off" : "=v"(ng0) : "v"(gp) : "memory");
          asm volatile("global_load_dword %0, %1, off offset:256" : "=v"(ng1) : "v"(gp) : "memory");
          asm volatile("global_load_dwordx2 %0, %1, off" : "=v"(nx[0]) : "v"(xp) : "memory");
          asm volatile("global_load_dwordx2 %0, %1, off offset:512" : "=v"(nx[1]) : "v"(xp) : "memory");
          asm volatile("global_load_dwordx2 %0, %1, off offset:1024" : "=v"(nx[2]) : "v"(xp) : "memory");
          asm volatile("global_load_dwordx2 %0, %1, off offset:1536" : "=v"(nx[3]) : "v"(xp) : "memory");
          asm volatile("global_load_dwordx2 %0, %1, off offset:2048" : "=v"(nx[4]) : "v"(xp) : "memory");
          asm volatile("global_load_dwordx2 %0, %1, off offset:2560" : "=v"(nx[5]) : "v"(xp) : "memory");
          asm volatile("global_load_dwordx2 %0, %1, off offset:3072" : "=v"(nx[6]) : "v"(xp) : "memory");
          asm volatile("global_load_dwordx2 %0, %1, off offset:3584" : "=v"(nx[7]) : "v"(xp) : "memory"); }
        i32x8 xhi, xlo;
#pragma unroll
        for (int b = 0; b < 8; ++b) { const float x0 = bf_lo(xw[b].x), x1 = bf_hi(xw[b].x), x2 = bf_lo(xw[b].y), x3 = bf_hi(xw[b].y);
            const float c0 = fminf(fmaxf(x0, -448.f), 448.f), c1 = fminf(fmaxf(x1, -448.f), 448.f), c2 = fminf(fmaxf(x2, -448.f), 448.f), c3 = fminf(fmaxf(x3, -448.f), 448.f);
            int th = 0; th = __builtin_amdgcn_cvt_pk_fp8_f32(c0, c1, th, false); th = __builtin_amdgcn_cvt_pk_fp8_f32(c2, c3, th, true);
            const f32x2 h01 = __builtin_amdgcn_cvt_pk_f32_fp8(th, false), h23 = __builtin_amdgcn_cvt_pk_f32_fp8(th, true);
            int tl = 0; tl = __builtin_amdgcn_cvt_pk_fp8_f32((c0 - h01.x) * 16.f, (c1 - h01.y) * 16.f, tl, false); tl = __builtin_amdgcn_cvt_pk_fp8_f32((c2 - h23.x) * 16.f, (c3 - h23.y) * 16.f, tl, true);
            xhi[b] = th; xlo[b] = tl; }
        const int dsel = lane & 3; const bool dval = ((lane & 15) >> 2) == (lane >> 4);
        { const int jj = lane & 15, gg = lane >> 4, srcA = (jj + 16 * (gg >> 1)) << 2, srcB = (jj + 16 * (2 + (gg >> 1))) << 2; const bool odd = gg & 1;
          i32x8 nh, nl;
#pragma unroll
          for (int d = 0; d < 4; ++d) {
              const int a0 = __builtin_amdgcn_ds_bpermute(srcA, xhi[d]), a1 = __builtin_amdgcn_ds_bpermute(srcA, xhi[4 + d]), b0 = __builtin_amdgcn_ds_bpermute(srcB, xhi[d]), b1 = __builtin_amdgcn_ds_bpermute(srcB, xhi[4 + d]);
              nh[d] = odd ? a1 : a0; nh[4 + d] = odd ? b1 : b0;
              const int c0 = __builtin_amdgcn_ds_bpermute(srcA, xlo[d]), c1 = __builtin_amdgcn_ds_bpermute(srcA, xlo[4 + d]), e0 = __builtin_amdgcn_ds_bpermute(srcB, xlo[d]), e1 = __builtin_amdgcn_ds_bpermute(srcB, xlo[4 + d]);
              nl[d] = odd ? c1 : c0; nl[4 + d] = odd ? e1 : e0; }
          xhi = nh; xlo = nl; }
        float dv0 = 0.f, dv1 = 0.f;
#define U_ITER2(e, VMN, DV, NEXT_T, NEXT_E0, NEXT_E1) do { ROW_DMA(NEXT_T, NEXT_E0, (e) + 14); ROW_DMA(NEXT_T, NEXT_E1, (e) + 15); asm volatile("s_waitcnt vmcnt(" #VMN ")" ::: "memory"); \
            const u32x4 ru0 = *(const LAS u32x4*)(ring + ((e) & 15) * 1024 + lo16), ru1 = *(const LAS u32x4*)(ring + (((e) + 1) & 15) * 1024 + lo16); \
            const float da = dot_row4_mfma(ru0, xhi, xlo, dsel, dval), db = dot_row4_mfma(ru1, xhi, xlo, dsel, dval); \
            DV = (lane == ((e) & 63)) ? da : DV; DV = (lane == (((e) + 1) & 63)) ? db : DV; } while (0)
#pragma unroll 1
        for (int e = 0; e < 14; e += 2) U_ITER2(e, 26, dv0, U4, EIDC(e + 14), EIDC(e + 15));
#pragma unroll 1
        for (int e = 14; e < 64; e += 2) U_ITER2(e, 14, dv0, U4, EIDC(e + 14), EIDC(e + 15));
#pragma unroll 1
        for (int e = 64; e < 114; e += 2) U_ITER2(e, 14, dv1, U4, EIDC(e + 14), EIDC(e + 15));
#pragma unroll 1
        for (int e = 114; e < 128; e += 2) U_ITER2(e, 14, dv1, V4, EIDC(e - 114), EIDC(e - 113));
#undef U_ITER2
        asm volatile("" : "+v"(ni0), "+v"(ni1), "+v"(ng0), "+v"(ng1));
#pragma unroll
        for (int b = 0; b < 8; ++b) asm volatile("" : "+v"(nx[b]));
        const float av0 = gelu_erf(dv0 * (1.0f / U4_SCALE)) * g0 * (1.0f / V4_SCALE), av1 = gelu_erf(dv1 * (1.0f / U4_SCALE)) * g1 * (1.0f / V4_SCALE);
        float out[32];
#pragma unroll
        for (int i = 0; i < 32; ++i) out[i] = 0.f;
#define V_ITER2(e, AV, NEXT_T, NEXT_E0, NEXT_E1) do { ROW_DMA(NEXT_T, NEXT_E0, (e) + 14); ROW_DMA(NEXT_T, NEXT_E1, (e) + 15); asm volatile("s_waitcnt vmcnt(14)" ::: "memory"); \
            const u32x4 rv0 = *(const LAS u32x4*)(ring + ((e) & 15) * 1024 + lo16), rv1 = *(const LAS u32x4*)(ring + (((e) + 1) & 15) * 1024 + lo16); \
            const float a0 = __builtin_bit_cast(float, __builtin_amdgcn_readlane(__builtin_bit_cast(int, AV), (e) & 63)), a1 = __builtin_bit_cast(float, __builtin_amdgcn_readlane(__builtin_bit_cast(int, AV), ((e) + 1) & 63)); \
            axpy_row4(rv0, a0, out); axpy_row4(rv1, a1, out); } while (0)
#pragma unroll 1
        for (int e = 0; e < 64; e += 2) V_ITER2(e, av0, V4, EIDC(e + 14), EIDC(e + 15));
#pragma unroll 1
        for (int e = 64; e < 114; e += 2) V_ITER2(e, av1, V4, EIDC(e + 14), EIDC(e + 15));
#pragma unroll 1
        for (int e = 114; e < 128; e += 2) V_ITER2(e, av1, U4, __builtin_amdgcn_readlane(ni0, e - 114), __builtin_amdgcn_readlane(ni0, e - 113));
#undef V_ITER2
        int le = lane; asm volatile("" : "+v"(le));
        const int sq = seq_of_row(m); const float* g2 = mod + ((size_t)layer * NSEQ + sq) * 12288 + 5 * 2048; float* xr = X + (size_t)m * DM;
        float ss = 0.f;
#pragma unroll
        for (int hb = 0; hb < 2; ++hb) {
            f32x4 xo[4], gg[4];
#pragma unroll
            for (int b = 0; b < 4; ++b) { const int c = 256 * (4 * hb + b) + 4 * le; xo[b] = *(const f32x4*)(xr + c); gg[b] = *(const f32x4*)(g2 + c); }
            SB();
#pragma unroll
            for (int b = 0; b < 4; ++b) {
#pragma unroll
                for (int j = 0; j < 4; ++j) { const float v = xo[b][j] + gg[b][j] * out[4 * (4 * hb + b) + j]; out[4 * (4 * hb + b) + j] = v; ss += v * v; } }
            SB();
        }
        const float rstd = __builtin_amdgcn_rsqf(wave_sum(ss) * (1.0f / DM) + RMS_EPS);
        if (layer == 0) {
            const float* n1g = C.in[11] + 2048; const float* mp = mod + ((size_t)1 * NSEQ + sq) * 12288;
#pragma unroll
            for (int hb = 0; hb < 2; ++hb) {
                f32x4 gv[4], sh[4], sc[4];
#pragma unroll
                for (int b = 0; b < 4; ++b) { const int c = 256 * (4 * hb + b) + 4 * le; gv[b] = *(const f32x4*)(n1g + c); sh[b] = *(const f32x4*)(mp + c); sc[b] = *(const f32x4*)(mp + 2048 + c); }
                SB();
#pragma unroll
                for (int b = 0; b < 4; ++b) { const int bb = 4 * hb + b, c = 256 * bb + 4 * le;
                    const f32x4 xs = {out[4 * bb], out[4 * bb + 1], out[4 * bb + 2], out[4 * bb + 3]}; const f32x4 y = xs * rstd * gv[b] * (sc[b] + 1.0f) + sh[b];
                    *(f32x4*)(xr + c) = xs; u32x2 w; w.x = cvt_pk_bf16(y[0], y[1]); w.y = cvt_pk_bf16(y[2], y[3]); *(u32x2*)(HN + (size_t)m * DM + c) = w; }
                SB();
            }
        } else {
            const float* fg = C.in[35];
            f32x4 gv[8];
#pragma unroll
            for (int b = 0; b < 8; ++b) gv[b] = *(const f32x4*)(fg + 256 * b + 4 * le);
            SB();
#pragma unroll
            for (int b = 0; b < 8; ++b) { const int c = 256 * b + 4 * le; const f32x4 xs = {out[4 * b], out[4 * b + 1], out[4 * b + 2], out[4 * b + 3]};
                *(f32x4*)(xr + c) = xs * rstd * gv[b]; }
        }
        if (!has_next) break;
        m = mn; i0 = ni0; i1 = ni1; g0 = ng0; g1 = ng1;
#pragma unroll
        for (int b = 0; b < 8; ++b) xw[b] = nx[b];
    }
    asm volatile("s_waitcnt vmcnt(0)" ::: "memory");
#undef ROW_DMA
#undef EIDC
#undef SB
}
namespace att {
constexpr int SHM_K = 64 * 208, SHM_V = 64 * 256;
constexpr int OFF_K = 0, OFF_V = 2 * SHM_K, OFF_WS = 2 * SHM_K + 2 * SHM_V;
constexpr float SCALE = 0.07216878364870322f;
constexpr float THR = 8.f;
__device__ __forceinline__ int crow(int r, int hi) { return (r & 3) + 8 * (r >> 2) + 4 * hi; }
constexpr float THR2 = THR * 1.4426950408889634f;
__device__ __forceinline__ void partialSM(f32x16& p0, f32x16& p1, float& mref, f32x16& negm, float& alpha, bool first) {
    float pmax = p0[0];
#pragma unroll
    for (int r = 1; r < 16; ++r) pmax = fmaxf(pmax, p0[r]);
#pragma unroll
    for (int r = 0; r < 16; ++r) pmax = fmaxf(pmax, p1[r]);
    { auto rr = __builtin_amdgcn_permlane32_swap(__float_as_uint(pmax), __float_as_uint(pmax), false, false);
      pmax = fmaxf(__uint_as_float(rr[0]), __uint_as_float(rr[1])); }
    if (__builtin_expect(!first && __all(pmax <= THR2), 1)) { alpha = 1.f; }
    else { const float dl = first ? pmax : fmaxf(pmax, 0.f); alpha = first ? 1.f : __builtin_amdgcn_exp2f(-dl); mref += dl;
#pragma unroll
        for (int r = 0; r < 16; ++r) { negm[r] = -mref; p0[r] -= dl; p1[r] -= dl; }
        asm volatile("" : "+v"(negm)); }
#pragma unroll
    for (int r = 0; r < 16; ++r) p0[r] = __builtin_amdgcn_exp2f(p0[r]);
#pragma unroll
    for (int r = 0; r < 16; ++r) p1[r] = __builtin_amdgcn_exp2f(p1[r]);
}
__device__ __forceinline__ void finishSM(const f32x16& p0, const f32x16& p1, float alpha, float& l_reg, bf16x8& pa0, bf16x8& pa1, bf16x8& pa2, bf16x8& pa3) {
    float ps = 0;
#pragma unroll
    for (int r = 0; r < 16; ++r) ps += p0[r];
#pragma unroll
    for (int r = 0; r < 16; ++r) ps += p1[r];
    { auto rr = __builtin_amdgcn_permlane32_swap(__float_as_uint(ps), __float_as_uint(ps), false, false);
      ps = __uint_as_float(rr[0]) + __uint_as_float(rr[1]); }
    l_reg = l_reg * alpha + ps;
#define PK4(P, BASE, OUT) do { unsigned a0 = cvt_pk_bf16(P[BASE + 0], P[BASE + 1]), a1 = cvt_pk_bf16(P[BASE + 2], P[BASE + 3]);   \
    unsigned b0 = cvt_pk_bf16(P[BASE + 4], P[BASE + 5]), b1 = cvt_pk_bf16(P[BASE + 6], P[BASE + 7]);                              \
    auto r0 = __builtin_amdgcn_permlane32_swap(a0, b0, false, false); auto r1 = __builtin_amdgcn_permlane32_swap(a1, b1, false, false); \
    u32x4 w = {r0[0], r1[0], r0[1], r1[1]}; OUT = __builtin_bit_cast(bf16x8, w); } while (0)
    PK4(p0, 0, pa0); PK4(p0, 8, pa1); PK4(p1, 0, pa2); PK4(p1, 8, pa3);
#undef PK4
}
template <int OFF> __device__ __forceinline__ bf16x8 k_read(int addr) { bf16x8 r; asm volatile("ds_read_b128 %0, %1 offset:%2" : "=v"(r) : "v"(addr), "i"(OFF) : "memory"); return r; }
template <int I> __device__ __forceinline__ bf16x8 kfrag(const int (&kad)[4]) { constexpr int d0 = I >> 1, half = I & 1; return k_read<(d0 >> 2) * 128 + half * 12288>(kad[d0 & 3]); }
__device__ __forceinline__ void packSM(const f32x16& p0, const f32x16& p1, bf16x8& pa0, bf16x8& pa1, bf16x8& pa2, bf16x8& pa3) {
#define PK4(P, BASE, OUT) do { unsigned a0 = cvt_pk_bf16(P[BASE + 0], P[BASE + 1]), a1 = cvt_pk_bf16(P[BASE + 2], P[BASE + 3]);   \
    unsigned b0 = cvt_pk_bf16(P[BASE + 4], P[BASE + 5]), b1 = cvt_pk_bf16(P[BASE + 6], P[BASE + 7]);                              \
    auto r0 = __builtin_amdgcn_permlane32_swap(a0, b0, false, false); auto r1 = __builtin_amdgcn_permlane32_swap(a1, b1, false, false); \
    u32x4 w = {r0[0], r1[0], r0[1], r1[1]}; OUT = __builtin_bit_cast(bf16x8, w); } while (0)
    PK4(p0, 0, pa0); PK4(p0, 8, pa1); PK4(p1, 0, pa2); PK4(p1, 8, pa3);
#undef PK4
}
__device__ __forceinline__ int v_rd_base(int lane) { return ((lane & 3) << 3) | (((lane >> 2) & 3) << 6) | (((lane >> 4) & 1) << 5) | (((lane >> 5) & 1) << 8); }
constexpr int v_rd_off(int d0, int ks, int half) { return d0 * 512 + ks * 4096 + half * 2048; }
template <int OFF> __device__ __forceinline__ s16x4 tr_read(int vb) {
    s16x4 r; asm volatile("ds_read_b64_tr_b16 %0, %1 offset:%2" : "=&v"(r) : "v"(vb), "i"(OFF) : "memory"); return r;
}
template <int D0> __device__ __forceinline__ void pv_one(f32x16& od, int vb, bf16x8 pa0, bf16x8 pa1, bf16x8 pa2, bf16x8 pa3) {
    const s16x4 l0 = tr_read<v_rd_off(D0, 0, 0)>(vb), h0 = tr_read<v_rd_off(D0, 0, 1)>(vb), l1 = tr_read<v_rd_off(D0, 1, 0)>(vb), h1 = tr_read<v_rd_off(D0, 1, 1)>(vb);
    const s16x4 l2 = tr_read<v_rd_off(D0, 2, 0)>(vb), h2 = tr_read<v_rd_off(D0, 2, 1)>(vb), l3 = tr_read<v_rd_off(D0, 3, 0)>(vb), h3 = tr_read<v_rd_off(D0, 3, 1)>(vb);
    asm volatile("s_waitcnt lgkmcnt(0)" ::: "memory"); __builtin_amdgcn_sched_barrier(0);
#define PKV(L, H) (bf16x8){L[0], L[1], L[2], L[3], H[0], H[1], H[2], H[3]}
    od = __builtin_amdgcn_mfma_f32_32x32x16_bf16(pa0, PKV(l0, h0), od, 0, 0, 0);
    od = __builtin_amdgcn_mfma_f32_32x32x16_bf16(pa1, PKV(l1, h1), od, 0, 0, 0);
    od = __builtin_amdgcn_mfma_f32_32x32x16_bf16(pa2, PKV(l2, h2), od, 0, 0, 0);
    od = __builtin_amdgcn_mfma_f32_32x32x16_bf16(pa3, PKV(l3, h3), od, 0, 0, 0);
#undef PKV
}
struct AUnit { int qrow0, kvrow0, ntiles, head, vis0, nact, rev; };

__device__ __forceinline__ bool next_unit(int i, int vcu, int G, AUnit& u) {
    int flat;
    if (G == 256) {
        if (i >= 10) return false;
        if (i < 8) { const int bh = vcu >> 3, s = vcu & 7, base = 16 * (i >> 1); const int qb = (i & 1) ? base + 15 - s : base + s; flat = bh * 64 + qb; }
        else flat = 2048 + vcu * 2 + (i - 8);
    } else { flat = i * G + vcu; if (flat >= 2560) return false; }
    u.rev = (G == 256 && i < 8) ? (i & 1) : 0;
    if (flat < 2048) { const int bh = flat >> 6, qb = flat & 63, b = bh >> 4; u.head = bh & 15; u.qrow0 = b * 16384 + qb * 256; u.kvrow0 = b * 16384; u.ntiles = 4 * qb + 4; u.vis0 = 4 * qb; u.nact = 8; }
    else { const int f = flat - 2048, b = f >> 4; u.head = f & 15; u.qrow0 = MP + b * 64; u.kvrow0 = MP + b * 1088; u.ntiles = 17; u.vis0 = 1 << 20; u.nact = 2; }
    return true;
}

__device__ __forceinline__ void attn_phase(const Ctx& C) {
    bf16_t* Qn = (bf16_t*)(C.ws + A_HN);
    const unsigned char* Q8 = C.ws + A_Q8; const unsigned char* Kn = C.ws + A_KN; const bf16_t* Vv = (const bf16_t*)(C.ws + A_VV);
    LAS unsigned char* lds = C.lds; const int wid = C.wave, lane = C.lane, r32 = lane & 31, hi = lane >> 5;
    LAS float* wsp = (LAS float*)(lds + OFF_WS) + wid * 64; LAS float* li_l = wsp; LAS float* al_l = wsp + 32;
    unsigned ka[2], kst[2]; bool kisn[2];
#pragma unroll
    for (int i = 0; i < 2; ++i) { const int o = ((wid + 8 * i) * 64 + lane) * 16, row = (o / 208) & 63, c = (o % 208) >> 4;
        kisn[i] = !(c >= 8 && c < 12); ka[i] = kisn[i] ? (unsigned)(row * 2048 + (c < 8 ? c : 0) * 16) : (unsigned)(A_KP - A_KN) + (unsigned)(row * 64 + (c - 8) * 16); kst[i] = kisn[i] ? 64u * 2048u : 64u * 64u; }
    const bool kp2 = wid < 5;
    unsigned va[2];
#pragma unroll
    for (int i = 0; i < 2; ++i) { const int by = ((wid * 2 + i) * 64 + lane) * 16, sub = by >> 9, within = by & 511, kk = (sub >> 2) * 8 + (within >> 6), cc = (sub & 3) * 32 + ((within & 63) >> 1);
        const int k = (kk & ~0xC) | ((kk & 4) << 1) | ((kk & 8) >> 1); va[i] = (unsigned)(k * 4096 + cc * 2); }
    const LAS unsigned char* kfr0 = lds + OFF_K + r32 * 208 + 32 * hi;
    const int vb0 = (int)(uintptr_t)(lds + OFF_V) + v_rd_base(lane);
#define ATT_BAR() __builtin_amdgcn_s_barrier()
#define ATT_ISSUE(j, kb, vbi) do { \
        __builtin_amdgcn_global_load_lds((const unsigned*)((const char*)Kn + kc[0]), (LAS unsigned*)(lds + OFF_K + (kb) * SHM_K + wid * 1024), 16, 0, 0); kc[0] += kst[0] * (unsigned)kdir; \
        if (kp2) { __builtin_amdgcn_global_load_lds((const unsigned*)((const char*)Kn + kc[1]), (LAS unsigned*)(lds + OFF_K + (kb) * SHM_K + (wid + 8) * 1024), 16, 0, 0); kc[1] += kst[1] * (unsigned)kdir; } \
      _Pragma("unroll") for (int _i = 0; _i < 2; ++_i) { \
        __builtin_amdgcn_global_load_lds((const unsigned*)((const char*)Vv + vc[_i]), (LAS unsigned*)(lds + OFF_V + (vbi) * SHM_V + (wid * 2 + _i) * 1024), 16, 0, 0); vc[_i] += (unsigned)(64 * 4096 * kdir); } } while (0)
#define PV_STEP(I, PA, L, H, WN) do { asm volatile("s_waitcnt lgkmcnt(" #WN ")" : "+v"(L), "+v"(H) :: "memory"); \
        o[(I) >> 2] = __builtin_amdgcn_mfma_f32_32x32x16_bf16(PA, ((bf16x8){L[0], L[1], L[2], L[3], H[0], H[1], H[2], H[3]}), o[(I) >> 2], 0, 0, 0); \
        if ((I) + 4 < 16) { L = tr_read<v_rd_off((((I) + 4) & 15) >> 2, (I) & 3, 0)>(vb); H = tr_read<v_rd_off((((I) + 4) & 15) >> 2, (I) & 3, 1)>(vb); } \
        __builtin_amdgcn_sched_barrier(0); } while (0)
#define PV_HEAD(VBI) do { vb = vb0 + (VBI) * SHM_V; \
      l0 = tr_read<v_rd_off(0, 0, 0)>(vb); h0 = tr_read<v_rd_off(0, 0, 1)>(vb); l1 = tr_read<v_rd_off(0, 1, 0)>(vb); h1 = tr_read<v_rd_off(0, 1, 1)>(vb); \
      l2 = tr_read<v_rd_off(0, 2, 0)>(vb); h2 = tr_read<v_rd_off(0, 2, 1)>(vb); l3 = tr_read<v_rd_off(0, 3, 0)>(vb); h3 = tr_read<v_rd_off(0, 3, 1)>(vb); } while (0)
#define PV_BODY() do { \
      __builtin_amdgcn_s_setprio(1); PV_STEP(0, pa0, l0, h0, 6);  PV_STEP(1, pa1, l1, h1, 6);  PV_STEP(2, pa2, l2, h2, 6);  PV_STEP(3, pa3, l3, h3, 6); \
      PV_STEP(4, pa0, l0, h0, 6);  PV_STEP(5, pa1, l1, h1, 6);  PV_STEP(6, pa2, l2, h2, 6);  PV_STEP(7, pa3, l3, h3, 6); \
      PV_STEP(8, pa0, l0, h0, 6);  PV_STEP(9, pa1, l1, h1, 6);  PV_STEP(10, pa2, l2, h2, 6); PV_STEP(11, pa3, l3, h3, 6); \
      PV_STEP(12, pa0, l0, h0, 6); PV_STEP(13, pa1, l1, h1, 4); PV_STEP(14, pa2, l2, h2, 2); PV_STEP(15, pa3, l3, h3, 0); __builtin_amdgcn_s_setprio(0); } while (0)
#define ATT_PV(VBI) do { PV_HEAD(VBI); PV_BODY(); } while (0)
    AUnit u;
#ifndef PROBE_ATT
#define PROBE_ATT 0
#endif
#if PROBE_ATT
    for (int ui2 = 0; next_unit(ui2 >> 1, C.vcu, C.G, u); ++ui2) { const bool dummy = !(ui2 & 1);
#else
    for (int ui = 0; next_unit(ui, C.vcu, C.G, u); ++ui) { const bool dummy = false;
#endif
        const bool active = wid < u.nact; const int vis = u.vis0 + (wid >> 1);
        const int qrow = u.qrow0 + wid * 32 + r32;
        i32x8 qf[3];
        if (active) { const unsigned char* qp = Q8 + (size_t)qrow * 3072 + u.head * 192 + 32 * hi;
#pragma unroll
            for (int s = 0; s < 3; ++s) { const u32x4 a = *(const u32x4*)(qp + 64 * s), b = *(const u32x4*)(qp + 64 * s + 16);
                qf[s] = (i32x8){(int)a.x, (int)a.y, (int)a.z, (int)a.w, (int)b.x, (int)b.y, (int)b.z, (int)b.w}; }
        } else {
#pragma unroll
            for (int s = 0; s < 3; ++s) qf[s] = (i32x8){0, 0, 0, 0, 0, 0, 0, 0};
        }
#pragma unroll
        for (int s = 0; s < 3; ++s) asm volatile("" : "+v"(qf[s]));
        float mref = 0.f, l_reg = 0.f; f32x16 o[4]; f32x16 negm;
#pragma unroll
        for (int r = 0; r < 16; ++r) negm[r] = 0.f;
        asm volatile("" : "+v"(negm));
#pragma unroll
        for (int d = 0; d < 4; ++d)
#pragma unroll
            for (int r = 0; r < 16; ++r) o[d][r] = 0.f;
        bf16x8 pa0, pa1, pa2, pa3;
        const int NT = u.ntiles;
        const int kdir = u.rev ? -1 : 1, t0 = u.rev ? u.ntiles - 1 : 0;
        bool started = false;
        unsigned kc[2], vc[2];
#pragma unroll
        for (int i = 0; i < 2; ++i) kc[i] = ka[i] + (kisn[i] ? (unsigned)u.kvrow0 * 2048u + (unsigned)u.head * 128u : (unsigned)u.kvrow0 * 64u) + kst[i] * (unsigned)t0;
#pragma unroll
        for (int i = 0; i < 2; ++i) vc[i] = va[i] + (unsigned)u.kvrow0 * 4096u + (unsigned)u.head * 256u + (unsigned)(64 * 4096) * (unsigned)t0;
        ATT_ISSUE(0, 0, 0);
        asm volatile("s_waitcnt vmcnt(0)" ::: "memory");
        ATT_BAR();
        int vb; s16x4 l0, h0, l1, h1, l2, h2, l3, h3;
        for (int j = 0; j < NT; ++j) {
            const int buf = j & 1;
            const int jt = u.rev ? NT - 1 - j : j;
            const bool doQK = active && jt <= vis;
            if (j + 1 < NT) ATT_ISSUE(j + 1, buf ^ 1, buf ^ 1);
            if (doQK) {
                f32x16 p0, p1;
                {
                    const LAS unsigned char* kf = kfr0 + buf * SHM_K;
                    i32x8 ka0[3], ka1[3];
#define KLOAD(s) do { const u32x4 a = *(const LAS u32x4*)(kf + 64 * (s)), b = *(const LAS u32x4*)(kf + 64 * (s) + 16), c = *(const LAS u32x4*)(kf + 32 * 208 + 64 * (s)), d = *(const LAS u32x4*)(kf + 32 * 208 + 64 * (s) + 16); \
        ka0[s] = (i32x8){(int)a.x, (int)a.y, (int)a.z, (int)a.w, (int)b.x, (int)b.y, (int)b.z, (int)b.w}; ka1[s] = (i32x8){(int)c.x, (int)c.y, (int)c.z, (int)c.w, (int)d.x, (int)d.y, (int)d.z, (int)d.w}; } while (0)
                    KLOAD(0); KLOAD(1);
                    __builtin_amdgcn_sched_barrier(0);
                    __builtin_amdgcn_s_setprio(1);
                    p0 = __builtin_amdgcn_mfma_scale_f32_32x32x64_f8f6f4(ka0[0], qf[0], negm, 0, 0, 0, 127, 0, 127);
                    p1 = __builtin_amdgcn_mfma_scale_f32_32x32x64_f8f6f4(ka1[0], qf[0], negm, 0, 0, 0, 127, 0, 127);
                    __builtin_amdgcn_sched_barrier(0);
                    KLOAD(2);
                    __builtin_amdgcn_sched_barrier(0);
                    p0 = __builtin_amdgcn_mfma_scale_f32_32x32x64_f8f6f4(ka0[1], qf[1], p0, 0, 0, 0, 127, 0, 127);
                    p1 = __builtin_amdgcn_mfma_scale_f32_32x32x64_f8f6f4(ka1[1], qf[1], p1, 0, 0, 0, 127, 0, 127);
                    __builtin_amdgcn_sched_barrier(0);
                    p0 = __builtin_amdgcn_mfma_scale_f32_32x32x64_f8f6f4(ka0[2], qf[2], p0, 0, 0, 0, 127, 0, 127);
                    p1 = __builtin_amdgcn_mfma_scale_f32_32x32x64_f8f6f4(ka1[2], qf[2], p1, 0, 0, 0, 127, 0, 127);
#undef KLOAD
                    __builtin_amdgcn_s_setprio(0);
                }
                if ((PROBE_ATT == 2 || PROBE_ATT == 5) && dummy) { packSM(p0, p1, pa0, pa1, pa2, pa3); } else {
                float alpha; partialSM(p0, p1, mref, negm, alpha, !started); started = true;
                if (__any(alpha < 1.f)) { if (hi == 0) al_l[r32] = alpha; asm volatile("s_waitcnt lgkmcnt(0)" ::: "memory");
#pragma unroll
                    for (int r = 0; r < 16; ++r) { const float al = al_l[crow(r, hi)];
#pragma unroll
                        for (int d = 0; d < 4; ++d) o[d][r] *= al; } }
                finishSM(p0, p1, alpha, l_reg, pa0, pa1, pa2, pa3);
                }
                if (!((PROBE_ATT == 4 || PROBE_ATT == 5) && dummy)) ATT_PV(buf);
            }
            asm volatile("s_waitcnt vmcnt(0) lgkmcnt(0)" ::: "memory");
            ATT_BAR();
        }
        if (active && !dummy) {
            if (hi == 0) li_l[r32] = l_reg; asm volatile("s_waitcnt lgkmcnt(0)" ::: "memory");
            unsigned char* Ow = (unsigned char*)Qn + (size_t)(u.qrow0 + wid * 32) * 2048 + u.head * 128;
#pragma unroll
            for (int r = 0; r < 16; ++r) { const int orow = crow(r, hi); const float rl = __builtin_amdgcn_rcpf(li_l[orow]);
#pragma unroll
                for (int d0 = 0; d0 < 4; ++d0) { const unsigned w = cvt4_fp8(o[d0][r] * rl, 0.f, 0.f, 0.f); Ow[(size_t)orow * 2048 + d0 * 32 + r32] = (unsigned char)(w & 0xffu); } }
        }
    }
#undef ATT_BAR
#undef ATT_ISSUE
#undef ATT_PV
#undef PV_STEP
#undef PV_HEAD
#undef PV_BODY
}
}
#ifndef MK_SPLIT
#define MK_SPLIT 0
#endif
constexpr int N_PHASES = 22;

__global__ void __launch_bounds__(512, 2) mega_fwd(Args args) {
    extern __shared__ __attribute__((aligned(16))) unsigned char lds_raw[];
    Ctx C;
    C.lds = (LAS unsigned char*)lds_raw;
    C.tid = threadIdx.x; C.lane = C.tid & 63; C.wave = __builtin_amdgcn_readfirstlane(C.tid >> 6);
    C.G = gridDim.x; { const int bx = blockIdx.x; C.vcu = (C.G % 8 == 0) ? (bx % 8) * (C.G / 8) + bx / 8 : bx; }
    C.gw = C.vcu * 8 + C.wave; C.NGW = C.G * 8;
    C.in = args.in; C.out = args.out; C.ws = args.ws;
    volatile LAS unsigned* misc = (volatile LAS unsigned*)(C.lds + LDS_MISC);
    if (C.tid < 4) misc[C.tid] = 0u;
    __syncthreads();
    const int lo = args.ph_lo, hi = args.ph_hi;
    XcdBarrier bar; bar.bar = (unsigned*)(C.ws + WS_CTL) + CW_BAR; bar.x = 0; bar.st = misc;
    if (hi - lo > 1) bar = xcd_barrier_post((unsigned*)(C.ws + WS_CTL) + CW_BAR, misc);
#ifdef PH_ONLY
#define IN(k) ((k) == PH_ONLY)
#else
#define IN(k) (lo <= (k) && (k) < hi)
#endif
#define FILL(k) bq::service(C, true, (k), 0)
#define NEED(k, limit) do { if (IN(k) && (limit) > 0) bq::service(C, false, 0, (limit)); } while (0)
#define SEAM(k) do { if (IN(k) && IN((k) + 1)) xcd_barrier(bar); } while (0)
    unsigned char* ws = C.ws;
    const float* mod = (const float*)(ws + WS_MOD);
    float* X = C.out + O_Y;
    LAS unsigned char* glds = C.lds;

#ifdef PROBE_CLK
#define CLK_BEGIN(k) unsigned long long _t0 = 0, _r0 = 0; if ((k) == PROBE_CLK) { _t0 = __builtin_amdgcn_s_memtime(); _r0 = __builtin_amdgcn_s_memrealtime(); }
#define CLK_END(k) if ((k) == PROBE_CLK && blockIdx.x == 0 && threadIdx.x == 0) { const unsigned long long t1 = __builtin_amdgcn_s_memtime(), r1 = __builtin_amdgcn_s_memrealtime(); \
        const unsigned long long ticks = (t1 - _t0) * 1000ull / (r1 - _r0); while (__builtin_amdgcn_s_memrealtime() - r1 < ticks) __builtin_amdgcn_s_sleep(8); }
#else
#define CLK_BEGIN(k)
#define CLK_END(k)
#endif
    if (IN(0)) { phase_prologue(C); } SEAM(0);
    if (IN(1)) { phase_norm(C, C.in[0], C.in[1], C.in[11], mod, 0, (bf16_t*)(ws + A_HN)); } NEED(1, bq::E_IN); SEAM(1);
    if (IN(2)) {
        pg8::Gemm g{(const bf16_t*)(ws + A_HN), (const bf16_t*)(ws + WS_WIN), MT, 3072, 2048, 2048, 2048, 0, 0}; pg8::StaticOrder S; S.init(MT, 3072, C.G, (int)blockIdx.x);
        pg8::EpiZ E{(bf16_t*)(ws + A_GG), (bf16_t*)(ws + A_B2), (bf16_t*)(ws + A_B2) + (size_t)MT * 1024};
        CLK_BEGIN(2) pg8::gemm_phase<pg8::EpiZ>(glds, g, S, E); CLK_END(2) FILL(2); } SEAM(2);
    if (IN(3)) { phase_convpool(C); } NEED(3, bq::E_POOL); SEAM(3);
    if (IN(4)) {
        { pg8::Gemm g{(const bf16_t*)(ws + A_B3), (const bf16_t*)(ws + WS_WGATE), MT, 2048, 256, 1024, 256, 1, 256}; pg8::StaticOrder S; S.init(MT, 2048, C.G, (int)blockIdx.x);
          pg8::EpiGate E{(const bf16_t*)(ws + A_B3), (const float*)(ws + WS_SP), (float*)(ws + A_B4)};
          pg8::gemm_phase<pg8::EpiGate>(glds, g, S, E); }
        FILL(4); } SEAM(4);
    if (IN(5)) {
        { pg8::Gemm g{(const bf16_t*)(ws + A_B3) + (size_t)MT * 1024, (const bf16_t*)(ws + WS_WPOOL), MT, 1024, 256, 1024, 256, 0, 256}; pg8::StaticOrder S; S.init(MT, 1024, C.G, (int)blockIdx.x);
          pg8::EpiPool E{(bf16_t*)(ws + A_HN), C.in[22]};
          pg8::gemm_phase<pg8::EpiPool>(glds, g, S, E); }
        phase_scanA(C); FILL(5); } SEAM(5);
    if (IN(6)) { phase_scanB(C); } SEAM(6);
    if (IN(7)) { phase_scanC(C); } NEED(7, bq::E_OUTR); SEAM(7);
    if (IN(8)) {
        pg8::Gemm g{(const bf16_t*)(ws + A_HN), (const bf16_t*)(ws + WS_WOUTR), MT, 2048, 2048, 2048, 2048, 0, 0}; pg8::StaticOrder S; S.init(MT, 2048, C.G, (int)blockIdx.x);
        pg8::EpiBf16 E{(bf16_t*)(ws + A_B3), 2048};
        pg8::gemm_phase<pg8::EpiBf16>(glds, g, S, E); FILL(8); } SEAM(8);
#define PEER_BLOCK(P0, L) \
    if (IN(P0)) { phase_resid_norm(C, (L) == 0 ? C.in[0] : X, (L) == 0 ? C.in[1] : X + (size_t)MP * DM, (const bf16_t*)(ws + A_B3), X, C.in[12] + (L) * 2048, mod + (size_t)(L) * NSEQ * 12288, (bf16_t*)(ws + A_B2)); } NEED(P0, (L) == 0 ? bq::E_Q0 : bq::E_Q1); SEAM(P0); \
    if (IN(P0 + 1)) { pg8::Gemm g{(const bf16_t*)(ws + A_B2), (const bf16_t*)(ws + WS_WQ) + (size_t)(L) * 2048 * 2048, MT, 2048, 2048, 2048, 2048, 0, 0}; pg8::StaticOrder S; S.init(MT, 2048, C.G, (int)blockIdx.x); \
        pg8::EpiBf16 E{(bf16_t*)(ws + A_B3), 2048}; pg8::gemm_phase<pg8::EpiBf16>(glds, g, S, E); FILL(P0 + 1); } NEED(P0 + 1, (L) == 0 ? bq::E_KEYS : 0); SEAM(P0 + 1); \
    if (IN(P0 + 2)) { phase_topk(C, L); } NEED(P0 + 2, (L) == 0 ? bq::E_TAB0 : bq::NTOT); SEAM(P0 + 2); \
    if (IN(P0 + 3)) { CLK_BEGIN(P0 + 3) phase_gather(C, L); CLK_END(P0 + 3) }
    PEER_BLOCK(9, 0) NEED(12, bq::E_DKV); SEAM(12);
    if (IN(13)) {
        pg8::Gemm g{(const bf16_t*)(ws + A_HN), (const bf16_t*)(ws + WS_WDQKV), MT, 1024, 2048, 2048, 2048, 0, 0}; pg8::StaticOrder S; S.init(MT, 1024, C.G, (int)blockIdx.x);
        pg8::EpiF32 E{(float*)(ws + A_B3), 1024};
        pg8::gemm_phase<pg8::EpiF32>(glds, g, S, E); FILL(13); } NEED(13, bq::E_ROPE); SEAM(13);
    if (IN(14)) { phase_latent(C); } NEED(14, bq::E_UKV); SEAM(14);
    if (IN(15)) {
        { pg8::Gemm g{(const bf16_t*)(ws + A_CQ), (const bf16_t*)(ws + WS_WUQ), MT, 3072, 256, 256, 256, 0, 0};     pg8::StaticOrder S; S.init(MT, 3072, C.G, (int)blockIdx.x);
          pg8::EpiQ E{ws + A_Q8, (const float*)(ws + WS_ROPE)};
          pg8::gemm_phase<pg8::EpiQ, true>(glds, g, S, E); }
        { pg8::Gemm g{(const bf16_t*)(ws + A_CKV), (const bf16_t*)(ws + WS_WUKV), KVROWS, 4096, 128, 128, 128, 0, 0};     pg8::StaticOrder S; S.init(KVROWS, 4096, C.G, (int)blockIdx.x);
          pg8::EpiKV E{ws + A_KN, (bf16_t*)(ws + A_VV)};
          pg8::gemm_phase<pg8::EpiKV, true>(glds, g, S, E); } FILL(15); } SEAM(15);
    if (IN(16)) { CLK_BEGIN(16) att::attn_phase(C); CLK_END(16) } NEED(16, bq::E_OUTA); SEAM(16);
    if (IN(17)) {
        pg8::Gemm g{(const bf16_t*)(ws + A_HN), (const bf16_t*)(ws + WS_WOUTA), MT, 2048, 1024, 1024, 1024, 0, 0}; pg8::StaticOrder S; S.init(MT, 2048, C.G, (int)blockIdx.x);
        pg8::EpiBf16 E{(bf16_t*)(ws + A_B3), 2048};
        pg8::gemm_phase<pg8::EpiBf16, true>(glds, g, S, E); FILL(17); } SEAM(17);
    PEER_BLOCK(18, 1)
#undef PEER_BLOCK
#undef IN
#undef SEAM
#undef FILL
#undef NEED
}

extern "C" void kernel_launch(void* const* d_in, const int* in_sizes, int n_in, void* d_out, int out_size, void* d_ws, size_t ws_size, hipStream_t stream) {
    static int grid = 0;
    if (grid == 0) {
        if (n_in != 36 || out_size != (int)O_TOTAL || ws_size < WS_END) { fprintf(stderr, "kernel_launch: built for 36 inputs, %zu outputs, >= %zu B workspace; got n_in %d out %d ws %zu\n", (size_t)O_TOTAL, (size_t)WS_END, n_in, out_size, ws_size); grid = -1; return; }
        int dev = 0, cus = 0, per_cu = 0;
        if (hipGetDevice(&dev) != hipSuccess || hipDeviceGetAttribute(&cus, hipDeviceAttributeMultiprocessorCount, dev) != hipSuccess) { fprintf(stderr, "kernel_launch: device query failed\n"); grid = -1; return; }
        if (hipFuncSetAttribute((const void*)mega_fwd, hipFuncAttributeMaxDynamicSharedMemorySize, LDS_BYTES) != hipSuccess) { fprintf(stderr, "kernel_launch: hipFuncSetAttribute failed\n"); grid = -1; return; }
        if (hipOccupancyMaxActiveBlocksPerMultiprocessor(&per_cu, (const void*)mega_fwd, 512, LDS_BYTES) != hipSuccess || per_cu < 1) { fprintf(stderr, "kernel_launch: occupancy query says %d blocks per CU\n", per_cu); }
        (void)hipGetLastError();
        grid = cus;
    }
    if (grid < 0) return;
    (void)hipMemsetAsync(d_ws, 0, WS_ZERO_BYTES, stream);
    Args a{};
    for (int i = 0; i < 36; ++i) a.in[i] = (const float*)d_in[i];
    a.out = (float*)d_out; a.ws = (unsigned char*)d_ws;
#if MK_SPLIT
    for (int p = 0; p < N_PHASES; ++p) { a.ph_lo = p; a.ph_hi = p + 1; hipLaunchKernelGGL(mega_fwd, dim3(grid), dim3(512), LDS_BYTES, stream, a); }
#elif defined(PROBE_RANGES)
    { const int rg[][2] = {PROBE_RANGES};
      for (unsigned i = 0; i < sizeof(rg) / sizeof(rg[0]); ++i) { if (i) (void)hipMemsetAsync(d_ws, 0, 1 * MiB, stream); a.ph_lo = rg[i][0]; a.ph_hi = rg[i][1]; hipLaunchKernelGGL(mega_fwd, dim3(grid), dim3(512), LDS_BYTES, stream, a); } }
#else
    a.ph_lo = 0; a.ph_hi = N_PHASES; hipLaunchKernelGGL(mega_fwd, dim3(grid), dim3(512), LDS_BYTES, stream, a);
#endif
    const hipError_t le = hipPeekAtLastError();
    if (le != hipSuccess) fprintf(stderr, "kernel_launch: launch failed: %s\n", hipGetErrorName(le));
}
```

```cpp
#include <hip/hip_runtime.h>
#include <cstdio>
#include <cstdint>

#define LAS __attribute__((address_space(3)))
#define GAS __attribute__((address_space(1)))
typedef unsigned short bf16_t;
typedef short bf16x8 __attribute__((ext_vector_type(8)));
typedef short s16x4 __attribute__((ext_vector_type(4)));
typedef float f32x2 __attribute__((ext_vector_type(2)));
typedef float f32x4 __attribute__((ext_vector_type(4)));
typedef float f32x16 __attribute__((ext_vector_type(16)));
typedef unsigned u32x2 __attribute__((ext_vector_type(2)));
typedef unsigned u32x4 __attribute__((ext_vector_type(4)));
typedef int i32x4_t __attribute__((ext_vector_type(4)));
typedef int i32x8_t __attribute__((ext_vector_type(8)));

constexpr int DM = 2048;
constexpr int MP = 32768, MS = 2048, MT = MP + MS;
constexpr int NSEQ = 34;
constexpr int KVROWS = MP + 32 * 1088;
constexpr float RMS_EPS = 1e-6f;

__device__ __forceinline__ int seq_of_row(int m) { return m < MP ? (m >> 14) : 2 + ((m - MP) >> 6); }
__device__ __forceinline__ int pos_of_row(int m) { return m < MP ? (m & 16383) : 1024 + ((m - MP) & 63); }
__device__ __forceinline__ int kvrow_of_row(int m) { return m < MP ? m : MP + ((m - MP) >> 6) * 1088 + 1024 + ((m - MP) & 63); }

__device__ __forceinline__ unsigned cvt_pk_bf16(float lo, float hi) { unsigned r; asm volatile("v_cvt_pk_bf16_f32 %0, %1, %2" : "=v"(r) : "v"(lo), "v"(hi)); return r; }
__device__ __forceinline__ unsigned cvt4_fp8(float a, float b, float c, float d) { int t = 0;
    t = __builtin_amdgcn_cvt_pk_fp8_f32(fminf(fmaxf(a, -448.f), 448.f), fminf(fmaxf(b, -448.f), 448.f), t, false);
    t = __builtin_amdgcn_cvt_pk_fp8_f32(fminf(fmaxf(c, -448.f), 448.f), fminf(fmaxf(d, -448.f), 448.f), t, true); return (unsigned)t; }
__device__ __forceinline__ float bf_lo(unsigned w) { return __uint_as_float(w << 16); }
__device__ __forceinline__ float bf_hi(unsigned w) { return __uint_as_float(w & 0xffff0000u); }
__device__ __forceinline__ float fexp(float x) { return __builtin_amdgcn_exp2f(x * 1.4426950408889634f); }
__device__ __forceinline__ float fsigmoid(float x) { return __builtin_amdgcn_rcpf(1.0f + __builtin_amdgcn_exp2f(-1.4426950408889634f * x)); }
__device__ __forceinline__ float gelu_tanh(float x) { const float u = x * (1.0f + 0.044715f * x * x); return x * __builtin_amdgcn_rcpf(1.0f + __builtin_amdgcn_exp2f(-2.302208198f * u)); }
__device__ __forceinline__ float gelu_erf(float v) {
    const float av = __builtin_fabsf(v), t = __builtin_amdgcn_rcpf(av * 0.2316418882f + 1.0f);
    float q = t * 0.5307027145f + (-0.7265760135f); q = q * t + 0.7107068705f; q = q * t + (-0.142248368f); q = q * t + 0.127414796f; q = q * t;
    const float e = __builtin_amdgcn_exp2f((v * v) * (-0.72134752044f));
    const float m = v * (q * e); return v < 0.f ? m : v - m;
}
__device__ __forceinline__ float wave_sum(float v) {
#pragma unroll
    for (int o = 32; o >= 1; o >>= 1) v += __shfl_xor(v, o);
    return v;
}

namespace pg8 {
constexpr int BM = 256, BK = 64, HALF = 128, HTB = HALF * BK * 2, STAGE_BYTES = 8 * HTB, NXCD = 8, WGM = 8;
__host__ __device__ __forceinline__ int lds_byte(int r, int c) { const int st = (r >> 4) * 2 + (c >> 5), rr = r & 15, cc = c & 31, ob = rr * 64 + cc * 2; return st * 1024 + (ob ^ (((ob >> 9) & 1) << 5)); }
__host__ __device__ __forceinline__ void stage_rc(int b, int& R, int& C) { const int st = b / 1024, sb = b % 1024, swz = sb ^ (((sb >> 9) & 1) << 5); R = (st >> 1) * 16 + swz / 64; C = (st & 1) * 32 + (swz % 64) / 2; }
__host__ __device__ __forceinline__ int perm32(int rho) { const int n = rho >> 4, i = rho & 15; return 8 * (i >> 2) + 4 * n + (i & 3); }

struct Unit { int pm, pn; };
struct Gemm { const bf16_t* A; const bf16_t* Bt; int M, N, K, lda, ldb, kshift, kmul; };

struct StaticOrder {
    int nM, nN, nwg, G, c;
    __host__ __device__ void init(int M, int N, int G_, int c_) { nM = M / BM; nN = N / BM; nwg = nM * nN; G = G_; c = c_; }
    __host__ __device__ bool next(int i, Unit& u) const {
        const long L = (long)i * G + c; if (L >= nwg) return false;
        int wgid = (int)L; { const int q = nwg / NXCD, r = nwg % NXCD, xcd = wgid % NXCD, off = wgid / NXCD; wgid = (xcd < r ? xcd * (q + 1) : r * (q + 1) + (xcd - r) * q) + off; }
        const int nig = WGM * nN, gid = wgid / nig, fm = gid * WGM, gsz = (nM - fm) < WGM ? (nM - fm) : WGM;
        u.pm = fm + ((wgid % nig) % gsz); u.pn = (wgid % nig) / gsz; return true;
    }
};

template <class Epi, bool F8 = false>
__device__ __forceinline__ void gemm_phase(LAS unsigned char* lds, const Gemm g, const StaticOrder& S, const Epi& E) {
    const int tid = threadIdx.x, wid = __builtin_amdgcn_readfirstlane(tid >> 6), lane = tid & 63, wr = wid >> 2, wc = wid & 3, fr = lane & 15, fq = lane >> 4;
    int Kq = g.K; asm volatile("" : "+s"(Kq));
    const int K = Kq, nt = K / BK;
    unsigned voffA[2], voffB[2];
#pragma unroll
    for (int i = 0; i < 2; ++i) { int R, C; stage_rc(tid * 16 + i * 8192, R, C); const int Rb = Epi::PERM ? ((R & ~31) + perm32(R & 31)) : R;
        voffA[i] = (unsigned)(R * g.lda + C) * 2u; voffB[i] = (unsigned)(Rb * g.ldb + C) * 2u; }
    const size_t kstep = (size_t)(BK * 2);
    const size_t hstepA = (size_t)HALF * g.lda * 2, hstepB = (size_t)HALF * g.ldb * 2;
    const unsigned ldsw = (unsigned)wid * 1024u;
    const int aoff = lds_byte(wr * 64 + fr, fq * 8), boff = lds_byte(wc * 32 + fr, fq * 8);
#define PG8_SA(b, h) (((b) * 2 + (h)) * HTB)
#define PG8_SB(b, h) ((4 + (b) * 2 + (h)) * HTB)
#define PG8_STAGE(bufoff, gbase, voff) do { _Pragma("unroll") for (int _i = 0; _i < 2; ++_i) \
        __builtin_amdgcn_global_load_lds((const unsigned*)((const char*)(gbase) + (voff)[_i]), (LAS unsigned*)(lds + (bufoff) + ldsw + _i * 8192), 16, 0, 0); } while (0)
#define PG8_CAT(F) __builtin_shufflevector(__builtin_bit_cast(i32x4_t, (F)[0]), __builtin_bit_cast(i32x4_t, (F)[1]), 0, 1, 2, 3, 4, 5, 6, 7)
#define PG8_LDA(dst, b, h) do { _Pragma("unroll") for (int m = 0; m < 4; ++m) { _Pragma("unroll") for (int k = 0; k < 2; ++k) dst[m][k] = *(const LAS bf16x8*)(lds + PG8_SA(b, h) + aoff + m * 2048 + k * 1024); \
        if (F8) dst##8[m] = PG8_CAT(dst[m]); } } while (0)
#define PG8_LDB(dst, b, h) do { _Pragma("unroll") for (int n = 0; n < 2; ++n) { _Pragma("unroll") for (int k = 0; k < 2; ++k) dst[n][k] = *(const LAS bf16x8*)(lds + PG8_SB(b, h) + boff + n * 2048 + k * 1024); \
        if (F8) dst##8[n] = PG8_CAT(dst[n]); } } while (0)
#define PG8_MMA(ai, bj, At, Bt) do { __builtin_amdgcn_s_setprio(1); \
        if (F8) { _Pragma("unroll") for (int m = 0; m < 4; ++m) _Pragma("unroll") for (int n = 0; n < 2; ++n) \
            asm volatile("v_mfma_scale_f32_16x16x128_f8f6f4 %0, %1, %2, %0, %3, %3 op_sel_hi:[0,0,0]" : "+v"(acc[ai][bj][m][n]) : "v"(Bt##8[n]), "v"(At##8[m]), "v"(f8one)); } \
        else { _Pragma("unroll") for (int m = 0; m < 4; ++m) _Pragma("unroll") for (int n = 0; n < 2; ++n) _Pragma("unroll") for (int k = 0; k < 2; ++k) \
            acc[ai][bj][m][n] = __builtin_amdgcn_mfma_f32_16x16x32_bf16(Bt[n][k], At[m][k], acc[ai][bj][m][n], 0, 0, 0); } \
        __builtin_amdgcn_s_setprio(0); } while (0)
#define PG8_WAIT_V(n) asm volatile("s_waitcnt vmcnt(" #n ")" ::: "memory")
#define PG8_WAIT_L(n) asm volatile("s_waitcnt lgkmcnt(" #n ")" ::: "memory")
#define PG8_BAR __builtin_amdgcn_s_barrier()
#define PG8_SCHED __builtin_amdgcn_sched_barrier(0)
#define PG8_ABASE(u) ((const char*)g.A + (size_t)(u).pm * (2 * hstepA) + (size_t)(((u).pn >> g.kshift) * g.kmul) * 2)
#define PG8_BBASE(u) ((const char*)g.Bt + (size_t)(u).pn * (2 * hstepB))
    Unit cur, nxt; int ui = 0;
    if (!S.next(0, cur)) return;
    f32x4 acc[2][2][4][2];
#pragma unroll
    for (int a = 0; a < 2; ++a)
#pragma unroll
        for (int b = 0; b < 2; ++b)
#pragma unroll
            for (int m = 0; m < 4; ++m)
#pragma unroll
                for (int n = 0; n < 2; ++n) acc[a][b][m][n] = (f32x4){0.f, 0.f, 0.f, 0.f};
    bf16x8 At[4][2], B0[2][2], B1[2][2];
    i32x8_t At8[4], B08[2], B18[2]; int f8one = 127; asm volatile("" : "+v"(f8one));
    const char* cA = PG8_ABASE(cur); const char* cB = PG8_BBASE(cur);
    PG8_STAGE(PG8_SB(0, 0), cB, voffB); PG8_STAGE(PG8_SB(0, 1), cB + hstepB, voffB); PG8_STAGE(PG8_SA(0, 0), cA, voffA); PG8_STAGE(PG8_SA(0, 1), cA + hstepA, voffA);
    if (wr == 1) PG8_BAR;
    PG8_WAIT_V(2); PG8_BAR;
    PG8_STAGE(PG8_SB(1, 0), cB + kstep, voffB); PG8_STAGE(PG8_SA(1, 0), cA + kstep, voffA); PG8_STAGE(PG8_SB(1, 1), cB + hstepB + kstep, voffB);
    PG8_WAIT_V(6); PG8_BAR;
    for (;;) {
        const bool has_next = S.next(ui + 1, nxt);
        const char* nA = has_next ? PG8_ABASE(nxt) : cA; const char* nB = has_next ? PG8_BBASE(nxt) : cB;
        for (int t = 0; t < nt; t += 2) {
            const bool last = (t == nt - 2);
            const char* a1 = cA + (size_t)(t + 1) * kstep;
            const char* a2 = last ? nA : cA + (size_t)(t + 2) * kstep; const char* b2 = last ? nB : cB + (size_t)(t + 2) * kstep;
            const char* a3 = a2 + kstep; const char* b3 = b2 + kstep;
            PG8_LDB(B0, 0, 0); PG8_LDB(B1, 0, 1); PG8_SCHED; PG8_LDA(At, 0, 0); PG8_STAGE(PG8_SA(1, 1), a1 + hstepA, voffA);
            PG8_WAIT_V(8); PG8_WAIT_L(0); PG8_BAR; PG8_MMA(0, 0, At, B0); PG8_MMA(0, 1, At, B1); PG8_BAR; PG8_SCHED;
            PG8_LDA(At, 0, 1); PG8_STAGE(PG8_SB(0, 0), b2, voffB); PG8_STAGE(PG8_SB(0, 1), b2 + hstepB, voffB); PG8_STAGE(PG8_SA(0, 0), a2, voffA);
            PG8_WAIT_V(8); PG8_WAIT_L(0); PG8_BAR; PG8_MMA(1, 0, At, B0); PG8_MMA(1, 1, At, B1); PG8_BAR; PG8_SCHED;
            PG8_LDB(B0, 1, 0); PG8_LDB(B1, 1, 1); PG8_SCHED; PG8_LDA(At, 1, 0); PG8_STAGE(PG8_SA(0, 1), a2 + hstepA, voffA);
            PG8_WAIT_V(8); PG8_WAIT_L(0); PG8_BAR; PG8_MMA(0, 0, At, B0); PG8_MMA(0, 1, At, B1); PG8_BAR; PG8_SCHED;
            PG8_LDA(At, 1, 1); PG8_STAGE(PG8_SB(1, 0), b3, voffB); PG8_STAGE(PG8_SB(1, 1), b3 + hstepB, voffB); PG8_STAGE(PG8_SA(1, 0), a3, voffA);
            PG8_WAIT_V(8); PG8_WAIT_L(0); PG8_BAR; PG8_MMA(1, 0, At, B0); PG8_MMA(1, 1, At, B1); PG8_BAR; PG8_SCHED;
        }
        if (wr == 0) PG8_BAR;
        E(acc, cur, wr, wc, fr, fq);
        if (!has_next) break;
#pragma unroll
        for (int a = 0; a < 2; ++a)
#pragma unroll
            for (int b = 0; b < 2; ++b)
#pragma unroll
                for (int m = 0; m < 4; ++m)
#pragma unroll
                    for (int n = 0; n < 2; ++n) acc[a][b][m][n] = (f32x4){0.f, 0.f, 0.f, 0.f};
        cur = nxt; cA = nA; cB = nB; ++ui;
        if (wr == 1) PG8_BAR;
    }
    PG8_WAIT_V(0);
    PG8_BAR;
#undef PG8_SA
#undef PG8_SB
#undef PG8_STAGE
#undef PG8_LDA
#undef PG8_LDB
#undef PG8_MMA
#undef PG8_CAT
#undef PG8_WAIT_V
#undef PG8_WAIT_L
#undef PG8_BAR
#undef PG8_SCHED
#undef PG8_ABASE
#undef PG8_BBASE
}
}
namespace pg8 {
#define EPI_ROWS(expr_row) for (int ai = 0; ai < 2; ++ai) for (int m = 0; m < 4; ++m)
struct EpiBf16 {
    static constexpr bool PERM = true;
    bf16_t* O; int ldc;
    __device__ __forceinline__ void operator()(const f32x4 (&acc)[2][2][4][2], const Unit& u, int wr, int wc, int fr, int fq) const {
        const int row0 = u.pm * BM + wr * 64 + fr, col0 = u.pn * BM + wc * 32 + 8 * fq;
#pragma unroll
        for (int ai = 0; ai < 2; ++ai)
#pragma unroll
            for (int m = 0; m < 4; ++m) { bf16_t* rowp = O + (size_t)(row0 + ai * HALF + m * 16) * ldc + col0;
#pragma unroll
                for (int bj = 0; bj < 2; ++bj) { const f32x4 v0 = acc[ai][bj][m][0], v1 = acc[ai][bj][m][1];
                    u32x4 w; w.x = cvt_pk_bf16(v0[0], v0[1]); w.y = cvt_pk_bf16(v0[2], v0[3]); w.z = cvt_pk_bf16(v1[0], v1[1]); w.w = cvt_pk_bf16(v1[2], v1[3]);
                    *(u32x4*)(rowp + bj * HALF) = w; } }
    }
};
struct EpiZ {
    static constexpr bool PERM = true;
    bf16_t* GG; bf16_t* REC; bf16_t* POOL;
    __device__ __forceinline__ void operator()(const f32x4 (&acc)[2][2][4][2], const Unit& u, int wr, int wc, int fr, int fq) const {
        const int t = u.pn >> 2; bf16_t* base = GG + (size_t)t * ((size_t)MT * 1024);
        const int row0 = u.pm * BM + wr * 64 + fr, col0 = (u.pn & 3) * BM + wc * 32 + 8 * fq;
#pragma unroll
        for (int ai = 0; ai < 2; ++ai)
#pragma unroll
            for (int m = 0; m < 4; ++m) { bf16_t* rowp = base + (size_t)(row0 + ai * HALF + m * 16) * 1024 + col0;
#pragma unroll
                for (int bj = 0; bj < 2; ++bj) { f32x4 v0 = acc[ai][bj][m][0], v1 = acc[ai][bj][m][1];
                    if (t == 0) {
#pragma unroll
                        for (int j = 0; j < 4; ++j) { v0[j] = gelu_tanh(v0[j]); v1[j] = gelu_tanh(v1[j]); } }
                    u32x4 w; w.x = cvt_pk_bf16(v0[0], v0[1]); w.y = cvt_pk_bf16(v0[2], v0[3]); w.z = cvt_pk_bf16(v1[0], v1[1]); w.w = cvt_pk_bf16(v1[2], v1[3]);
                    *(u32x4*)(rowp + bj * HALF) = w; } }
    }
};
struct EpiGate {
    static constexpr bool PERM = false;
    const bf16_t* XC; const float* gp; float* Aout;
    __device__ __forceinline__ void operator()(const f32x4 (&acc)[2][2][4][2], const Unit& u, int wr, int wc, int fr, int fq) const {
        const int row0 = u.pm * BM + wr * 64 + fr, ch0 = u.pn * 128 + wc * 32 + 4 * fq;
#pragma unroll
        for (int n = 0; n < 2; ++n) {
            const f32x4 bav = *(const f32x4*)(gp + ch0 + 16 * n), bxv = *(const f32x4*)(gp + 1024 + ch0 + 16 * n), spv = *(const f32x4*)(gp + 2048 + ch0 + 16 * n);
#pragma unroll
            for (int ai = 0; ai < 2; ++ai)
#pragma unroll
                for (int m = 0; m < 4; ++m) { const int row = row0 + ai * HALF + m * 16; const bool pos0 = (row < MP) && ((row & 16383) == 0);
                    const size_t off = (size_t)row * 1024 + ch0 + 16 * n;
                    const u32x2 xw = *(const u32x2*)(XC + off); const float xc[4] = {bf_lo(xw.x), bf_hi(xw.x), bf_lo(xw.y), bf_hi(xw.y)};
                    f32x4 av, uv;
#pragma unroll
                    for (int j = 0; j < 4; ++j) { const float r = fsigmoid(acc[ai][0][m][n][j] + bav[j]), ig = fsigmoid(acc[ai][1][m][n][j] + bxv[j]);
                        const float log_a = -8.0f * r * spv[j]; const float a = fexp(log_a); const float mult = pos0 ? 1.0f : __builtin_sqrtf(fmaxf(1.0f - a * a, 0.0f));
                        av[j] = a; uv[j] = mult * ig * xc[j]; }
                    *(f32x4*)(Aout + off) = av; { u32x2 uw; uw.x = cvt_pk_bf16(uv[0], uv[1]); uw.y = cvt_pk_bf16(uv[2], uv[3]); *(u32x2*)((bf16_t*)(Aout + (size_t)MT * 1024) + off) = uw; } asm volatile("" ::: "memory"); }
        }
    }
};
struct EpiPool {
    static constexpr bool PERM = true;
    bf16_t* CAT; const float* spool;
    __device__ __forceinline__ void operator()(const f32x4 (&acc)[2][2][4][2], const Unit& u, int wr, int wc, int fr, int fq) const {
        const int row0 = u.pm * BM + wr * 64 + fr, col0 = u.pn * BM + wc * 32 + 8 * fq;
        f32x4 s0[2], s1[2];
#pragma unroll
        for (int bj = 0; bj < 2; ++bj) { s0[bj] = *(const f32x4*)(spool + col0 + bj * HALF); s1[bj] = *(const f32x4*)(spool + col0 + bj * HALF + 4); }
#pragma unroll
        for (int ai = 0; ai < 2; ++ai)
#pragma unroll
            for (int m = 0; m < 4; ++m) { bf16_t* rowp = CAT + (size_t)(row0 + ai * HALF + m * 16) * 2048 + 1024 + col0;
#pragma unroll
                for (int bj = 0; bj < 2; ++bj) { const f32x4 v0 = acc[ai][bj][m][0] * s0[bj], v1 = acc[ai][bj][m][1] * s1[bj];
                    u32x4 w; w.x = cvt_pk_bf16(v0[0], v0[1]); w.y = cvt_pk_bf16(v0[2], v0[3]); w.z = cvt_pk_bf16(v1[0], v1[1]); w.w = cvt_pk_bf16(v1[2], v1[3]);
                    *(u32x4*)(rowp + bj * HALF) = w; } }
    }
};
struct EpiResid {
    static constexpr bool PERM = false;
    const float* xinP; const float* xinS; float* xout; const float* gate;
    __device__ __forceinline__ void operator()(const f32x4 (&acc)[2][2][4][2], const Unit& u, int wr, int wc, int fr, int fq) const {
        const int row0 = u.pm * BM + wr * 64 + fr, col0 = u.pn * BM + wc * 32 + 4 * fq;
#pragma unroll
        for (int ai = 0; ai < 2; ++ai)
#pragma unroll
            for (int m = 0; m < 4; ++m) { const int row = row0 + ai * HALF + m * 16; const float* gp = gate + (size_t)seq_of_row(row) * 12288 + col0;
                const float* xi = (row < MP ? xinP + (size_t)row * DM : xinS + (size_t)(row - MP) * DM) + col0; float* xo = xout + (size_t)row * DM + col0;
#pragma unroll
                for (int bj = 0; bj < 2; ++bj)
#pragma unroll
                    for (int n = 0; n < 2; ++n) { const int o = bj * HALF + n * 16; *(f32x4*)(xo + o) = *(const f32x4*)(xi + o) + *(const f32x4*)(gp + o) * acc[ai][bj][m][n]; }
                asm volatile("" ::: "memory"); }
    }
};
struct EpiF32 {
    static constexpr bool PERM = false;
    float* C; int ldc;
    __device__ __forceinline__ void operator()(const f32x4 (&acc)[2][2][4][2], const Unit& u, int wr, int wc, int fr, int fq) const {
        const int row0 = u.pm * BM + wr * 64 + fr, col0 = u.pn * BM + wc * 32 + 4 * fq;
#pragma unroll
        for (int ai = 0; ai < 2; ++ai)
#pragma unroll
            for (int m = 0; m < 4; ++m) { float* rowp = C + (size_t)(row0 + ai * HALF + m * 16) * ldc + col0;
#pragma unroll
                for (int bj = 0; bj < 2; ++bj)
#pragma unroll
                    for (int n = 0; n < 2; ++n) *(f32x4*)(rowp + bj * HALF + n * 16) = acc[ai][bj][m][n]; }
    }
};
struct EpiQ {
    static constexpr bool PERM = true;
    static constexpr float QS = 0.07216878364870322f * 1.4426950408889634f;
    unsigned char* Q8; const float* rope;
    __device__ __forceinline__ void operator()(const f32x4 (&acc)[2][2][4][2], const Unit& u, int wr, int wc, int fr, int fq) const {
        const int row0 = u.pm * BM + wr * 64 + fr;
        if (u.pn < 8) {
            const int col0 = u.pn * BM + wc * 32 + 8 * fq;
#pragma unroll
            for (int ai = 0; ai < 2; ++ai)
#pragma unroll
                for (int m = 0; m < 4; ++m) { unsigned char* rowp = Q8 + (size_t)(row0 + ai * HALF + m * 16) * 3072;
#pragma unroll
                    for (int bj = 0; bj < 2; ++bj) { const f32x4 v0 = acc[ai][bj][m][0] * QS, v1 = acc[ai][bj][m][1] * QS; const int col = col0 + bj * HALF;
                        u32x2 w; w.x = cvt4_fp8(v0[0], v0[1], v0[2], v0[3]); w.y = cvt4_fp8(v1[0], v1[1], v1[2], v1[3]);
                        *(u32x2*)(rowp + (col >> 7) * 192 + (col & 127)) = w; } }
        } else {
            const int head = (u.pn - 8) * 4 + wc, j0 = 8 * fq;
#pragma unroll
            for (int ai = 0; ai < 2; ++ai)
#pragma unroll
                for (int m = 0; m < 4; ++m) { const int row = row0 + ai * HALF + m * 16; const float* rp = rope + (size_t)pos_of_row(row) * 64 + j0;
                    const f32x4 c0 = *(const f32x4*)(rp), c1 = *(const f32x4*)(rp + 4), s0 = *(const f32x4*)(rp + 32), s1 = *(const f32x4*)(rp + 36);
                    const f32x4 x10 = acc[ai][0][m][0] * QS, x11 = acc[ai][0][m][1] * QS, x20 = acc[ai][1][m][0] * QS, x21 = acc[ai][1][m][1] * QS;
                    const f32x4 a0 = x10 * c0 - x20 * s0, a1 = x11 * c1 - x21 * s1, b0 = x10 * s0 + x20 * c0, b1 = x11 * s1 + x21 * c1;
                    unsigned char* qp = Q8 + (size_t)row * 3072 + head * 192 + 128 + j0;
                    u32x2 w; w.x = cvt4_fp8(a0[0], a0[1], a0[2], a0[3]); w.y = cvt4_fp8(a1[0], a1[1], a1[2], a1[3]); *(u32x2*)qp = w;
                    w.x = cvt4_fp8(b0[0], b0[1], b0[2], b0[3]); w.y = cvt4_fp8(b1[0], b1[1], b1[2], b1[3]); *(u32x2*)(qp + 32) = w; }
        }
    }
};
struct EpiKV {
    static constexpr bool PERM = true;
    unsigned char* Kn8; bf16_t* V;
    __device__ __forceinline__ void operator()(const f32x4 (&acc)[2][2][4][2], const Unit& u, int wr, int wc, int fr, int fq) const {
        const int row0 = u.pm * BM + wr * 64 + fr, col0 = u.pn * 128 + wc * 32 + 8 * fq;
#pragma unroll
        for (int ai = 0; ai < 2; ++ai)
#pragma unroll
            for (int m = 0; m < 4; ++m) { const size_t off = (size_t)(row0 + ai * HALF + m * 16) * 2048 + col0;
                { const f32x4 v0 = acc[ai][0][m][0], v1 = acc[ai][0][m][1]; u32x2 w; w.x = cvt4_fp8(v0[0], v0[1], v0[2], v0[3]); w.y = cvt4_fp8(v1[0], v1[1], v1[2], v1[3]); *(u32x2*)(Kn8 + off) = w; }
                { const f32x4 v0 = acc[ai][1][m][0], v1 = acc[ai][1][m][1];
                  u32x4 w; w.x = cvt_pk_bf16(v0[0], v0[1]); w.y = cvt_pk_bf16(v0[2], v0[3]); w.z = cvt_pk_bf16(v1[0], v1[1]); w.w = cvt_pk_bf16(v1[2], v1[3]); *(u32x4*)(V + off) = w; } }
    }
};
#undef EPI_ROWS
}

#define XB_TMO      128
#define XB_XCNT(j)  (256  + 64 * (j))
#define XB_XSUB(j)  (1280 + 64 * (j))
#define XB_XGEN(j)  (2304 + 64 * (j))
#define XB_TOP      3328
#define XB_TOPGEN   3392
#define XCD_BAR_WORDS 3456
#define XB_SPIN_CAP (1u << 18)
__device__ __forceinline__ unsigned xb_ld(unsigned* p)              { return __hip_atomic_load(p, __ATOMIC_RELAXED, __HIP_MEMORY_SCOPE_AGENT); }
__device__ __forceinline__ unsigned xb_add(unsigned* p, unsigned v) { return __hip_atomic_fetch_add(p, v, __ATOMIC_RELAXED, __HIP_MEMORY_SCOPE_AGENT); }
__device__ __forceinline__ unsigned xb_xcc_id() { return (unsigned)__builtin_amdgcn_s_getreg((3 << 11) | 20) & 0xFu; }
#define XB_SPIN(cond, bar) do { unsigned _sp = 0; while (cond) { __builtin_amdgcn_s_sleep(1); \
    if ((++_sp & 255u) == 0u) { if (xb_ld(&(bar)[XB_TMO])) break; if (_sp > XB_SPIN_CAP) { atomicAdd(&(bar)[XB_TMO], 1u); break; } } } } while (0)
struct XcdBarrier { unsigned* bar; unsigned x; volatile LAS unsigned* st; };
__device__ __forceinline__ XcdBarrier xcd_barrier_post(unsigned* bar, volatile LAS unsigned* st) {
    XcdBarrier b; b.bar = bar; b.x = xb_xcc_id(); b.st = st;
    if (threadIdx.x == 0) (void)xb_add(&bar[XB_XCNT(b.x)], 1u);
    return b;
}
__device__ __forceinline__ void xcd_barrier_complete(unsigned* bar, unsigned x, unsigned& nloc, unsigned& nx) {
    const unsigned G = gridDim.x * gridDim.y * gridDim.z;
    unsigned sum, cnt, mine, sp = 0u;
    for (;;) {
        sum = 0u; cnt = 0u; mine = 0u;
#pragma unroll
        for (unsigned j = 0; j < 16; ++j) { const unsigned c = xb_ld(&bar[XB_XCNT(j)]); sum += c; cnt += (c > 0u) ? 1u : 0u; mine = (j == x) ? c : mine; }
        if (sum == G) break;
        __builtin_amdgcn_s_sleep(1);
        if ((++sp & 255u) == 0u) { if (xb_ld(&bar[XB_TMO])) break; if (sp > XB_SPIN_CAP) { atomicAdd(&bar[XB_TMO], 1u); break; } }
    }
    nloc = mine > 0u ? mine : 1u; nx = cnt > 0u ? cnt : 1u;
}
__device__ __forceinline__ void xcd_barrier(const XcdBarrier& b) {
    asm volatile("s_waitcnt vmcnt(0)" ::: "memory");
    __syncthreads();
    if (threadIdx.x == 0) {
        unsigned* bar = b.bar;
        __builtin_amdgcn_s_waitcnt(0);
        unsigned nloc = b.st[0], nx = b.st[1];
        if (nloc == 0u) { xcd_barrier_complete(bar, b.x, nloc, nx); b.st[0] = nloc; b.st[1] = nx; }
        const unsigned old = xb_add(&bar[XB_XSUB(b.x)], 1u);
        const unsigned gen = old / nloc;
        if (old + 1u == (gen + 1u) * nloc) {
            __builtin_amdgcn_fence(__ATOMIC_RELEASE, "agent");
            asm volatile("s_waitcnt vmcnt(0)" ::: "memory");
            const unsigned og = xb_add(&bar[XB_TOP], 1u);
            const unsigned tg = og / nx;
            if (og + 1u == (tg + 1u) * nx) xb_add(&bar[XB_TOPGEN], 1u);
            else XB_SPIN(xb_ld(&bar[XB_TOPGEN]) == tg, bar);
            __builtin_amdgcn_fence(__ATOMIC_ACQUIRE, "agent");
            xb_add(&bar[XB_XGEN(b.x)], 1u);
            asm volatile("s_waitcnt vmcnt(0)" ::: "memory");
        } else {
            XB_SPIN(xb_ld(&bar[XB_XGEN(b.x)]) == gen, bar);
            __builtin_amdgcn_fence(__ATOMIC_ACQUIRE, "agent");
            asm volatile("s_waitcnt vmcnt(0)" ::: "memory");
        }
    }
    __syncthreads();
}
constexpr float U8_SCALE = 256.0f, V8_SCALE = 16.0f;
__device__ __forceinline__ void convert_fp8_range(const float* src, unsigned char* dst, float scale, size_t n16, size_t i0, size_t stride) {
    for (size_t i = i0; i < n16; i += stride) { u32x4 w;
#pragma unroll
        for (int q = 0; q < 4; ++q) { f32x4 a = *(const f32x4*)(src + i * 16 + 4 * q) * scale;
#pragma unroll
            for (int j = 0; j < 4; ++j) a[j] = fminf(fmaxf(a[j], -448.0f), 448.0f);
            int t = 0; t = __builtin_amdgcn_cvt_pk_fp8_f32(a[0], a[1], t, false); t = __builtin_amdgcn_cvt_pk_fp8_f32(a[2], a[3], t, true); w[q] = (unsigned)t; }
        *(u32x4*)(dst + i * 16) = w; }
}
constexpr float U4_SCALE = 90.50966799f, V4_SCALE = 8.0f;
__device__ __forceinline__ void convert_fp4_rows(const float* src, unsigned char* dst, float scale, int nrows, int w0, int wstride, int lane) {
    for (int r = w0; r < nrows; r += wstride) { const float* sr = src + (size_t)r * 2048 + 4 * lane; u32x4 w;
        f32x4 a[8];
#pragma unroll
        for (int b = 0; b < 8; ++b) a[b] = *(const f32x4*)(sr + 256 * b) * scale;
#pragma unroll
        for (int q = 0; q < 4; ++q) { float e[8] = {a[2 * q][0], a[2 * q][1], a[2 * q][2], a[2 * q][3], a[2 * q + 1][0], a[2 * q + 1][1], a[2 * q + 1][2], a[2 * q + 1][3]};
#pragma unroll
            for (int j = 0; j < 8; ++j) e[j] = fminf(fmaxf(e[j], -6.0f), 6.0f);
            unsigned t = 0u; t = __builtin_amdgcn_cvt_scalef32_pk_fp4_f32(t, e[0], e[1], 1.0f, 0); t = __builtin_amdgcn_cvt_scalef32_pk_fp4_f32(t, e[2], e[3], 1.0f, 1);
            t = __builtin_amdgcn_cvt_scalef32_pk_fp4_f32(t, e[4], e[5], 1.0f, 2); t = __builtin_amdgcn_cvt_scalef32_pk_fp4_f32(t, e[6], e[7], 1.0f, 3); w[q] = t; }
        *(u32x4*)(dst + (size_t)r * 1024 + 16 * lane) = w; }
}
constexpr size_t MiB = (size_t)1 << 20;
constexpr size_t WS_CTL = 0, WS_WGATE = 1 * MiB, WS_WDQKV = 2 * MiB, WS_ZERO_BYTES = 6 * MiB;
constexpr size_t WS_WIN = 6 * MiB, WS_WOUTR = 18 * MiB, WS_WQ = 26 * MiB, WS_WUQ = 42 * MiB, WS_WUKV = 45 * MiB, WS_WOUTA = 47 * MiB;
constexpr size_t WS_WPOOL = 55 * MiB, WS_KEYS = 56 * MiB, WS_MOD = 57 * MiB, WS_ROPE = 61 * MiB, WS_SP = 65 * MiB, WS_SCAN = 66 * MiB;
constexpr size_t WS_U = 73 * MiB, WS_V = 137 * MiB;
constexpr size_t A_HN = 201 * MiB, A_GG = 337 * MiB, A_B2 = 405 * MiB, A_B3 = 541 * MiB, A_B4 = 677 * MiB;
constexpr size_t A_KN = 405 * MiB  , A_Q8 = 537 * MiB  , A_VV = 669 * MiB, A_KP = 933 * MiB, A_CQ = 942 * MiB, A_CKV = 976 * MiB, WS_END = 1009 * MiB;
constexpr int CW_BAR = 4096;
constexpr size_t SCAN_WORDS = (size_t)544 * 1024;
constexpr size_t O_Y = 0, O_CONV_P = 71303168, O_CONV_S = 71309312, O_H_P = 71407616, O_H_S = 71409664, O_POOL_P = 71442432, O_POOL_S = 71473152,
                 O_CKV = 71964672, O_KPE = 80877568, O_TOTAL = 83105792;
constexpr int LDS_BYTES = 147456, LDS_MISC = 147200;

struct Args { const float* in[36]; float* out; unsigned char* ws; int ph_lo, ph_hi; };

struct Ctx {
    LAS unsigned char* lds; int tid, lane, wave, vcu, G, gw, NGW;
    const float* const* in; float* out; unsigned char* ws;
};

__device__ __forceinline__ void transpose_item(const float* W, int N, int k0, int n0, bf16_t* WT, int dld, int drow0, int dcol0, LAS float* scr, int lane) {
#pragma unroll 8
    for (int i = 0; i < 32; ++i) { const int kk = 2 * i + (lane >> 5); scr[kk * 33 + (lane & 31)] = W[(size_t)(k0 + kk) * N + n0 + (lane & 31)]; }
    asm volatile("s_waitcnt lgkmcnt(0)" ::: "memory");
    const int c = lane & 7;
#pragma unroll
    for (int j = 0; j < 4; ++j) { const int n = (lane >> 3) + 8 * j; const LAS float* s = scr + (8 * c) * 33 + n;
        u32x4 o; o.x = cvt_pk_bf16(s[0 * 33], s[1 * 33]); o.y = cvt_pk_bf16(s[2 * 33], s[3 * 33]); o.z = cvt_pk_bf16(s[4 * 33], s[5 * 33]); o.w = cvt_pk_bf16(s[6 * 33], s[7 * 33]);
        *(u32x4*)(WT + (size_t)(drow0 + n) * dld + dcol0 + 8 * c) = o; }
    asm volatile("s_waitcnt lgkmcnt(0)" ::: "memory");
}
__device__ __forceinline__ void transpose_item_f8(const float* W, int N, int k0, int n0, unsigned char* WT, int dld, int drow0, int dcol0, LAS float* scr, int lane) {
#pragma unroll 8
    for (int i = 0; i < 32; ++i) { const int kk = 2 * i + (lane >> 5); scr[kk * 33 + (lane & 31)] = W[(size_t)(k0 + kk) * N + n0 + (lane & 31)]; }
    asm volatile("s_waitcnt lgkmcnt(0)" ::: "memory");
    const int c = lane & 7;
#pragma unroll
    for (int j = 0; j < 4; ++j) { const int n = (lane >> 3) + 8 * j; const LAS float* s = scr + (8 * c) * 33 + n;
        u32x2 o; o.x = cvt4_fp8(s[0 * 33], s[1 * 33], s[2 * 33], s[3 * 33]); o.y = cvt4_fp8(s[4 * 33], s[5 * 33], s[6 * 33], s[7 * 33]);
        *(u32x2*)(WT + (size_t)(drow0 + n) * dld + dcol0 + 8 * c) = o; }
    asm volatile("s_waitcnt lgkmcnt(0)" ::: "memory");
}
__device__ __forceinline__ void transpose_mat_item(const float* W, int K, int N, bf16_t* WT, int dld, int drow_base, int dcol_base, int item, LAS float* scr, int lane) {
    const int nblk = N / 32, kb = item / nblk, nb = item % nblk;
    transpose_item(W, N, 64 * kb, 32 * nb, WT, dld, drow_base + 32 * nb, dcol_base + 64 * kb, scr, lane);
}
__device__ __forceinline__ void convert_range(const float* src, bf16_t* dst, size_t n8, size_t i0, size_t stride) {
    for (size_t i = i0; i < n8; i += stride) { const f32x4 a = *(const f32x4*)(src + i * 8), b = *(const f32x4*)(src + i * 8 + 4);
        u32x4 w; w.x = cvt_pk_bf16(a[0], a[1]); w.y = cvt_pk_bf16(a[2], a[3]); w.z = cvt_pk_bf16(b[0], b[1]); w.w = cvt_pk_bf16(b[2], b[3]);
        *(u32x4*)(dst + i * 8) = w; }
}

__device__ __forceinline__ void ada_item(const Ctx& C, int item) {
    const int l = item / 96, nb = item % 96, n0 = nb * 128, w = C.wave, lane = C.lane;
    const float* cP = C.in[2]; const float* cS = C.in[3]; const float* W = C.in[9] + (size_t)l * 2048 * 12288 + n0 + 2 * lane; const float* bias = C.in[10] + (size_t)l * 12288 + n0;
    LAS float* scr = (LAS float*)(C.lds + w * 4608);
    LAS float* sum = (LAS float*)(C.lds + 36864);
    f32x2 acc[34];
#pragma unroll
    for (int s = 0; s < 34; ++s) acc[s] = (f32x2){0.f, 0.f};
    for (int sub = 0; sub < 8; ++sub) {
        const int k0 = 256 * w + 32 * sub;
#pragma unroll
        for (int i = 0; i < 17; ++i) { const int idx = lane + 64 * i, s = idx >> 5, kk = idx & 31;
            const float cv = (s < 2) ? cP[s * 2048 + k0 + kk] : cS[(s - 2) * 2048 + k0 + kk];
            scr[kk * 36 + s] = cv * fsigmoid(cv); }
        asm volatile("s_waitcnt lgkmcnt(0)" ::: "memory");
#pragma unroll 1
        for (int kq = 0; kq < 2; ++kq) {
            f32x2 wv[16];
#pragma unroll
            for (int kk = 0; kk < 16; ++kk) wv[kk] = *(const f32x2*)(W + (size_t)(k0 + 16 * kq + kk) * 12288);
#pragma unroll
            for (int kk = 0; kk < 16; ++kk) {
#pragma unroll
                for (int s4 = 0; s4 < 9; ++s4) { const f32x4 sv = *(const LAS f32x4*)(scr + (16 * kq + kk) * 36 + 4 * s4);
#pragma unroll
                    for (int i = 0; i < 4; ++i) if (4 * s4 + i < 34) acc[4 * s4 + i] += wv[kk] * sv[i]; }
                asm volatile("" ::: "memory");
            }
        }
        asm volatile("s_waitcnt lgkmcnt(0)" ::: "memory");
    }
    for (int ww = 0; ww < 8; ++ww) {
        if (w == ww) {
#pragma unroll
            for (int s = 0; s < 34; ++s) { LAS f32x2* p = (LAS f32x2*)(sum + s * 128) + lane; if (ww == 0) *p = acc[s]; else *p = *p + acc[s]; }
        }
        __syncthreads();
    }
    float* mod = (float*)(C.ws + WS_MOD);
    for (int s = w; s < 34; s += 8) { const f32x2 v = *((LAS f32x2*)(sum + s * 128) + lane) + *(const f32x2*)(bias + 2 * lane);
        *(f32x2*)(mod + ((size_t)l * NSEQ + s) * 12288 + n0 + 2 * lane) = v; }
    __syncthreads();
}

namespace bq {
constexpr int I_IN = 32 * 96, I_GATE = 16 * 8, I_POOL = 4 * 32, I_OUTR = 32 * 64, I_Q = 32 * 64, I_KEYS = 256, I_TAB = 16384  , I_DQ = 32 * 16, I_DKV = 32 * 10,
              I_ROPE = 1024, I_UQ = 8 * 96, I_UKV = 4 * 128, I_OUTA = 32 * 64;
constexpr int E_IN = I_IN, E_GATE = E_IN + I_GATE, E_POOL = E_GATE + I_POOL, E_OUTR = E_POOL + I_OUTR, E_Q0 = E_OUTR + I_Q, E_KEYS = E_Q0 + I_KEYS, E_TAB0 = E_KEYS + I_TAB, E_DQ = E_TAB0 + I_DQ,
              E_DKV = E_DQ + I_DKV, E_ROPE = E_DKV + I_ROPE, E_UQ = E_ROPE + I_UQ, E_UKV = E_UQ + I_UKV, E_OUTA = E_UKV + I_OUTA, E_Q1 = E_OUTA + I_Q, E_TAB1 = E_Q1 + I_TAB, NTOT = E_TAB1;
static_assert(NTOT % 8 == 0 && E_IN % 8 == 0 && E_POOL % 8 == 0 && E_OUTR % 8 == 0 && E_Q0 % 8 == 0 && E_KEYS % 8 == 0 && E_TAB0 % 8 == 0 && E_DKV % 8 == 0 && E_ROPE % 8 == 0 && E_UKV % 8 == 0 && E_OUTA % 8 == 0 && E_Q1 % 8 == 0, "queue segments are whole workgroup items");
constexpr int CW_QHEAD = 64, CW_DONE = 128;
constexpr int LDS_SLOT = LDS_MISC + 32;
constexpr size_t TAB_L1 = 16 * MiB;

__device__ __forceinline__ void fp4_row_pair(const float* src, unsigned char* dst, float scale, int r0, int lane) {
    f32x4 a[16];
#pragma unroll
    for (int b = 0; b < 16; ++b) a[b] = *(const f32x4*)(src + (size_t)(r0 + (b >> 3)) * 2048 + 4 * lane + 256 * (b & 7)) * scale;
#pragma unroll
    for (int rr = 0; rr < 2; ++rr) { u32x4 w;
#pragma unroll
        for (int q = 0; q < 4; ++q) { float e[8] = {a[8 * rr + 2 * q][0], a[8 * rr + 2 * q][1], a[8 * rr + 2 * q][2], a[8 * rr + 2 * q][3], a[8 * rr + 2 * q + 1][0], a[8 * rr + 2 * q + 1][1], a[8 * rr + 2 * q + 1][2], a[8 * rr + 2 * q + 1][3]};
#pragma unroll
            for (int j = 0; j < 8; ++j) e[j] = fminf(fmaxf(e[j], -6.0f), 6.0f);
            unsigned t = 0u; t = __builtin_amdgcn_cvt_scalef32_pk_fp4_f32(t, e[0], e[1], 1.0f, 0); t = __builtin_amdgcn_cvt_scalef32_pk_fp4_f32(t, e[2], e[3], 1.0f, 1);
            t = __builtin_amdgcn_cvt_scalef32_pk_fp4_f32(t, e[4], e[5], 1.0f, 2); t = __builtin_amdgcn_cvt_scalef32_pk_fp4_f32(t, e[6], e[7], 1.0f, 3); w[q] = t; }
        *(u32x4*)(dst + (size_t)(r0 + rr) * 1024 + 16 * lane) = w; }
}
__device__ __forceinline__ void table_item(const Ctx& C, int layer, int r, int lane) {
    const int t = r >> 13, rp = r & 8191;
    const float* src = (t ? C.in[34] : C.in[33]) + (size_t)layer * 16384 * 2048; unsigned char* dst = C.ws + (t ? WS_V : WS_U) + (size_t)layer * TAB_L1;
    fp4_row_pair(src, dst, t ? V4_SCALE : U4_SCALE, 2 * rp, lane);
}
__device__ __forceinline__ void wave_item(const Ctx& C, int it, LAS float* scr, int lane) {
    bf16_t* w_in = (bf16_t*)(C.ws + WS_WIN); bf16_t* w_outr = (bf16_t*)(C.ws + WS_WOUTR); bf16_t* w_q = (bf16_t*)(C.ws + WS_WQ);
    bf16_t* w_dqkv = (bf16_t*)(C.ws + WS_WDQKV); bf16_t* w_uq = (bf16_t*)(C.ws + WS_WUQ); bf16_t* w_ukv = (bf16_t*)(C.ws + WS_WUKV);
    bf16_t* w_outa = (bf16_t*)(C.ws + WS_WOUTA); bf16_t* w_gate = (bf16_t*)(C.ws + WS_WGATE); bf16_t* w_pool = (bf16_t*)(C.ws + WS_WPOOL);
    int r = it;
    if (r < I_IN) { transpose_mat_item(C.in[13], 2048, 3072, w_in, 2048, 0, 0, r, scr, lane); return; } r -= I_IN;
    if (r < I_GATE) {
        const int q = r / 8, sub = r % 8, h = q >> 1, gsel = q & 1;
        const float* src = (gsel ? C.in[18] : C.in[16]) + (size_t)h * 128 * 128;
        transpose_mat_item(src, 128, 128, w_gate, 256, h * 256 + gsel * 128, (h & 1) * 128, sub, scr, lane); return; } r -= I_GATE;
    if (r < I_POOL) { const int gq = r / 32, sub = r % 32;
        transpose_mat_item(C.in[21] + (size_t)gq * 256 * 256, 256, 256, w_pool, 256, gq * 256, 0, sub, scr, lane); return; } r -= I_POOL;
    if (r < I_OUTR) { transpose_mat_item(C.in[23], 2048, 2048, w_outr, 2048, 0, 0, r, scr, lane); return; } r -= I_OUTR;
    if (r < I_Q) { transpose_mat_item(C.in[31], 2048, 2048, w_q, 2048, 0, 0, r, scr, lane); return; } r -= I_Q;
    if (r < I_KEYS) { convert_range(C.in[32] + (size_t)r * 2048, (bf16_t*)(C.ws + WS_KEYS) + (size_t)r * 2048, 256, (size_t)lane, 64); return; } r -= I_KEYS;
    if (r < I_TAB) { table_item(C, 0, r, lane); return; } r -= I_TAB;
    if (r < I_DQ) { transpose_mat_item(C.in[24], 2048, 512, w_dqkv, 2048, 0, 0, r, scr, lane); return; } r -= I_DQ;
    if (r < I_DKV) { transpose_mat_item(C.in[27], 2048, 320, w_dqkv, 2048, 512, 0, r, scr, lane); return; } r -= I_DKV;
    if (r < I_ROPE) {
        float* rope = (float*)(C.ws + WS_ROPE);
        for (int q = 0; q < 8; ++q) { const int i = r * 512 + q * 64 + lane, pos = i >> 5, j = i & 31;
            double inv = 1.0; for (int qq = 0; qq < j; ++qq) inv *= 0.7498942093324559;
            const double rev = (double)pos * inv * 0.15915494309189535; const float fr = (float)(rev - __builtin_floor(rev));
            rope[(size_t)pos * 64 + j] = __builtin_amdgcn_cosf(fr); rope[(size_t)pos * 64 + 32 + j] = __builtin_amdgcn_sinf(fr); }
        return; } r -= I_ROPE;
    if (r < I_UQ) {
        const int kb = r / 96, nb = r % 96, n0 = 32 * nb, h = n0 / 192, d = n0 % 192;
        const int drow = (d < 128) ? h * 128 + d : 2048 + (h >> 2) * 256 + ((d - 128) >> 5) * 128 + (h & 3) * 32;
        transpose_item_f8(C.in[26], 3072, 64 * kb, n0, (unsigned char*)w_uq, 512, drow, 64 * kb, scr, lane); return; } r -= I_UQ;
    if (r < I_UKV) { const int nblk = 4096 / 32, kb = r / nblk, nb = r % nblk;
        transpose_item_f8(C.in[29], 4096, 64 * kb, 32 * nb, (unsigned char*)w_ukv, 256, 32 * nb, 64 * kb, scr, lane); return; } r -= I_UKV;
    if (r < I_OUTA) { const int nblk = 2048 / 32, kb = r / nblk, nb = r % nblk;
        transpose_item_f8(C.in[30], 2048, 64 * kb, 32 * nb, (unsigned char*)w_outa, 2048, 32 * nb, 64 * kb, scr, lane); return; } r -= I_OUTA;
    if (r < I_Q) { transpose_mat_item(C.in[31] + (size_t)2048 * 2048, 2048, 2048, w_q + (size_t)2048 * 2048, 2048, 0, 0, r, scr, lane); return; } r -= I_Q;
    table_item(C, 1, r, lane);
}
__device__ __forceinline__ void service(const Ctx& C, bool fill, int slot, int limit, bool signal = true) {
    unsigned* ctl = (unsigned*)(C.ws + WS_CTL); unsigned* qhead = ctl + CW_QHEAD; unsigned* done = ctl + CW_DONE + slot;
    volatile LAS int* lslot = (volatile LAS int*)(C.lds + LDS_SLOT);
    LAS float* scr = (LAS float*)(C.lds + 72704 + C.wave * 8448);
    __syncthreads();
    if (fill && signal && C.tid == 0) __hip_atomic_fetch_add(done, 1u, __ATOMIC_RELAXED, __HIP_MEMORY_SCOPE_AGENT);
    const unsigned lim = fill ? (unsigned)(NTOT / 8) : (unsigned)(limit / 8);
    for (;;) {
        if (C.tid == 0) { int it = -1;
            const unsigned h = __hip_atomic_load(qhead, __ATOMIC_RELAXED, __HIP_MEMORY_SCOPE_AGENT);
            bool go = h < lim;
            if (go && fill) go = __hip_atomic_load(done, __ATOMIC_RELAXED, __HIP_MEMORY_SCOPE_AGENT) < (unsigned)C.G;
            if (go) { const unsigned t = __hip_atomic_fetch_add(qhead, 1u, __ATOMIC_RELAXED, __HIP_MEMORY_SCOPE_AGENT); if (t < (unsigned)(NTOT / 8)) it = (int)t; }
            *lslot = it; }
        __syncthreads();
        const int it = *lslot;
        __syncthreads();
        if (it < 0) break;
        { Ctx D = C; int ln = C.lane; asm volatile("" : "+v"(ln)); D.lane = ln;
          wave_item(D, it * 8 + C.wave, scr, ln); }
    }
}
}

__device__ __forceinline__ void phase_prologue(const Ctx& C) {
    const int lane = C.lane;
    constexpr int NADA = 192;
    for (int it = C.vcu; it < NADA; it += C.G) ada_item(C, it);
    bq::service(C, true, 0, 0);
    const size_t gt = (size_t)C.vcu * 512 + C.tid, GT = (size_t)C.G * 512;
    { float* sp = (float*)(C.ws + WS_SP);
      for (size_t i = gt; i < 1024; i += GT) { sp[i] = C.in[17][i]; sp[1024 + i] = C.in[19][i]; const float y = fexp(-C.in[20][i]); sp[2048 + i] = (y < 0.03f) ? y * (1.0f - y * (0.5f - y * (0.33333333f - y * (0.25f - 0.2f * y)))) : 0.6931471805599453f * __builtin_amdgcn_logf(1.0f + y); } }
}
__device__ __forceinline__ void norm_mod_row(const float* xrow, const float* g, const float* shift, const float* scale, bf16_t* orow, int lane) {
    f32x4 v[8]; float ss = 0.f;
#pragma unroll
    for (int j = 0; j < 8; ++j) { v[j] = *((const f32x4*)xrow + lane + 64 * j); ss += (v[j].x * v[j].x + v[j].y * v[j].y) + (v[j].z * v[j].z + v[j].w * v[j].w); }
    const float rstd = __builtin_amdgcn_rsqf(wave_sum(ss) * (1.0f / DM) + RMS_EPS);
#pragma unroll
    for (int j = 0; j < 8; ++j) { const int q = lane + 64 * j; const f32x4 gv = *((const f32x4*)g + q), sc = *((const f32x4*)scale + q), sh = *((const f32x4*)shift + q);
        const f32x4 y = v[j] * rstd * gv * (sc + 1.0f) + sh;
        u32x2 w; w.x = cvt_pk_bf16(y.x, y.y); w.y = cvt_pk_bf16(y.z, y.w); *((u32x2*)orow + q) = w; }
}
__device__ __forceinline__ void phase_norm(const Ctx& C, const float* xP, const float* xS, const float* g, const float* modl, int part, bf16_t* hn) {
    const int lane = C.lane; int m = C.gw; if (m >= MT) return;
    f32x4 gv[8];
#pragma unroll
    for (int j = 0; j < 8; ++j) gv[j] = *((const f32x4*)g + lane + 64 * j);
    f32x4 nv[8];
    { const float* xr = (m < MP) ? xP + (size_t)m * DM : xS + (size_t)(m - MP) * DM;
#pragma unroll
      for (int j = 0; j < 8; ++j) nv[j] = *((const f32x4*)xr + lane + 64 * j); }
    for (; m < MT; m += C.NGW) {
        f32x4 v[8];
#pragma unroll
        for (int j = 0; j < 8; ++j) v[j] = nv[j];
        const int mn = m + C.NGW;
        if (mn < MT) { const float* xr = (mn < MP) ? xP + (size_t)mn * DM : xS + (size_t)(mn - MP) * DM;
#pragma unroll
            for (int j = 0; j < 8; ++j) nv[j] = *((const f32x4*)xr + lane + 64 * j); }
        const float* mp = modl + (size_t)seq_of_row(m) * 12288 + part * 2048;
        f32x4 sc[8], sh[8];
#pragma unroll
        for (int j = 0; j < 8; ++j) { const int q = lane + 64 * j; sh[j] = *((const f32x4*)mp + q); sc[j] = *((const f32x4*)(mp + 2048) + q); }
        float ss = 0.f;
#pragma unroll
        for (int j = 0; j < 8; ++j) ss += (v[j].x * v[j].x + v[j].y * v[j].y) + (v[j].z * v[j].z + v[j].w * v[j].w);
        const float rstd = __builtin_amdgcn_rsqf(wave_sum(ss) * (1.0f / DM) + RMS_EPS);
#pragma unroll
        for (int j = 0; j < 8; ++j) { const int q = lane + 64 * j; const f32x4 y = v[j] * rstd * gv[j] * (sc[j] + 1.0f) + sh[j];
            u32x2 w; w.x = cvt_pk_bf16(y.x, y.y); w.y = cvt_pk_bf16(y.z, y.w); *((u32x2*)(hn + (size_t)m * DM) + q) = w; }
    }
}
__device__ __forceinline__ void phase_resid_norm(const Ctx& C, const float* xP, const float* xS, const bf16_t* mix, float* X, const float* g, const float* modl, bf16_t* hn) {
    const int lane = C.lane; int m = C.gw; if (m >= MT) return;
    f32x4 gv[8];
#pragma unroll
    for (int j = 0; j < 8; ++j) gv[j] = *((const f32x4*)g + lane + 64 * j);
    f32x4 nx[8]; u32x2 nm[8];
    { const float* xr = (m < MP) ? xP + (size_t)m * DM : xS + (size_t)(m - MP) * DM;
#pragma unroll
      for (int j = 0; j < 8; ++j) { const int q = lane + 64 * j; nx[j] = *((const f32x4*)xr + q); nm[j] = *((const u32x2*)(mix + (size_t)m * DM) + q); } }
    for (; m < MT; m += C.NGW) {
        f32x4 v[8]; u32x2 mw[8];
#pragma unroll
        for (int j = 0; j < 8; ++j) { v[j] = nx[j]; mw[j] = nm[j]; }
        const int mn = m + C.NGW;
        if (mn < MT) { const float* xr = (mn < MP) ? xP + (size_t)mn * DM : xS + (size_t)(mn - MP) * DM;
#pragma unroll
            for (int j = 0; j < 8; ++j) { const int q = lane + 64 * j; nx[j] = *((const f32x4*)xr + q); nm[j] = *((const u32x2*)(mix + (size_t)mn * DM) + q); } }
        const float* mp = modl + (size_t)seq_of_row(m) * 12288;
        float ss = 0.f;
#pragma unroll
        for (int j = 0; j < 8; ++j) { const int q = lane + 64 * j; const f32x4 g1 = *((const f32x4*)(mp + 2 * 2048) + q);
            v[j] = v[j] + g1 * (f32x4){bf_lo(mw[j].x), bf_hi(mw[j].x), bf_lo(mw[j].y), bf_hi(mw[j].y)}; ss += (v[j].x * v[j].x + v[j].y * v[j].y) + (v[j].z * v[j].z + v[j].w * v[j].w);
            *((f32x4*)(X + (size_t)m * DM) + q) = v[j]; }
        const float rstd = __builtin_amdgcn_rsqf(wave_sum(ss) * (1.0f / DM) + RMS_EPS);
#pragma unroll
        for (int j = 0; j < 8; ++j) { const int q = lane + 64 * j; const f32x4 sh = *((const f32x4*)(mp + 3 * 2048) + q), sc = *((const f32x4*)(mp + 4 * 2048) + q);
            const f32x4 y = v[j] * rstd * gv[j] * (sc + 1.0f) + sh;
            u32x2 w; w.x = cvt_pk_bf16(y.x, y.y); w.y = cvt_pk_bf16(y.z, y.w); *((u32x2*)(hn + (size_t)m * DM) + q) = w; }
    }
}

__device__ __forceinline__ void ld8bf(const bf16_t* p, float (&v)[8]) { const u32x4 w = *(const u32x4*)p; v[0] = bf_lo(w.x); v[1] = bf_hi(w.x); v[2] = bf_lo(w.y); v[3] = bf_hi(w.y); v[4] = bf_lo(w.z); v[5] = bf_hi(w.z); v[6] = bf_lo(w.w); v[7] = bf_hi(w.w); }
__device__ __forceinline__ void ld8f(const float* p, float (&v)[8]) { const f32x4 a = *(const f32x4*)p, b = *(const f32x4*)(p + 4); v[0] = a.x; v[1] = a.y; v[2] = a.z; v[3] = a.w; v[4] = b.x; v[5] = b.y; v[6] = b.z; v[7] = b.w; }
__device__ __forceinline__ void st8bf(bf16_t* p, const float (&v)[8]) { u32x4 w; w.x = cvt_pk_bf16(v[0], v[1]); w.y = cvt_pk_bf16(v[2], v[3]); w.z = cvt_pk_bf16(v[4], v[5]); w.w = cvt_pk_bf16(v[6], v[7]); *(u32x4*)p = w; }
__device__ __forceinline__ void st8f(float* p, const float (&v)[8]) { *(f32x4*)p = (f32x4){v[0], v[1], v[2], v[3]}; *(f32x4*)(p + 4) = (f32x4){v[4], v[5], v[6], v[7]}; }

__device__ __forceinline__ void phase_convpool(const Ctx& C) {
    const bf16_t* __restrict__ REC = (const bf16_t*)(C.ws + A_B2); const bf16_t* __restrict__ PIN = REC + (size_t)MT * 1024;
    bf16_t* __restrict__ XC = (bf16_t*)(C.ws + A_B3); bf16_t* __restrict__ POOLED = XC + (size_t)MT * 1024;
    const float* convw = C.in[14]; const float* convb = C.in[15]; const float* st_conv = C.in[4]; const float* st_pool = C.in[6];
    const int NITEM = 2 * 544 * 128;
    for (int it0 = C.vcu * 512 + C.tid; it0 < NITEM; it0 += C.G * 512) {
        const bool is_pool = it0 >= 544 * 128; const int it = is_pool ? it0 - 544 * 128 : it0;
        const int chunk = it >> 7, ch0 = (it & 127) * 8;
        const bool samp = chunk >= 512; const int sb = chunk - 512;
        const int row0 = samp ? MP + sb * 64 : chunk * 64;
        const int t0 = samp ? 0 : (chunk & 255) * 64;
        const bool lastc = samp || ((chunk & 255) == 255);
        if (!is_pool) {
            float w0[8], w1[8], w2[8], w3[8], bb[8], p0[8], p1[8], p2[8];
            ld8f(convw + ch0, w0); ld8f(convw + 1024 + ch0, w1); ld8f(convw + 2048 + ch0, w2); ld8f(convw + 3072 + ch0, w3); ld8f(convb + ch0, bb);
            if (samp) { ld8f(st_conv + ((size_t)sb * 3 + 0) * 1024 + ch0, p0); ld8f(st_conv + ((size_t)sb * 3 + 1) * 1024 + ch0, p1); ld8f(st_conv + ((size_t)sb * 3 + 2) * 1024 + ch0, p2); }
            else if (t0 > 0) { ld8bf(REC + (size_t)(row0 - 3) * 1024 + ch0, p0); ld8bf(REC + (size_t)(row0 - 2) * 1024 + ch0, p1); ld8bf(REC + (size_t)(row0 - 1) * 1024 + ch0, p2); }
            else {
#pragma unroll
                for (int j = 0; j < 8; ++j) { p0[j] = 0.f; p1[j] = 0.f; p2[j] = 0.f; } }
            for (int tb = 0; tb < 64; tb += 8) {
                u32x4 raw[8];
#pragma unroll
                for (int q = 0; q < 8; ++q) raw[q] = *(const u32x4*)(REC + (size_t)(row0 + tb + q) * 1024 + ch0);
#pragma unroll
                for (int q = 0; q < 8; ++q) { const u32x4 w = raw[q]; const float cur[8] = {bf_lo(w.x), bf_hi(w.x), bf_lo(w.y), bf_hi(w.y), bf_lo(w.z), bf_hi(w.z), bf_lo(w.w), bf_hi(w.w)}; float o[8];
#pragma unroll
                    for (int j = 0; j < 8; ++j) { o[j] = bb[j] + w0[j] * p0[j] + w1[j] * p1[j] + w2[j] * p2[j] + w3[j] * cur[j]; p0[j] = p1[j]; p1[j] = p2[j]; p2[j] = cur[j]; }
                    st8bf(XC + (size_t)(row0 + tb + q) * 1024 + ch0, o); } }
            if (lastc) { float* dst = samp ? C.out + O_CONV_S + (size_t)sb * 3 * 1024 : C.out + O_CONV_P + (size_t)(chunk >> 8) * 3 * 1024;
                st8f(dst + ch0, p0); st8f(dst + 1024 + ch0, p1); st8f(dst + 2048 + ch0, p2); }
        } else {
            const int gsel = ch0 >> 8, w = 2 << gsel;
            float S[8];
#pragma unroll
            for (int j = 0; j < 8; ++j) S[j] = 0.f;
            for (int tt = 1 - w; tt < 0; ++tt) { float v[8];
                if (samp) ld8f(st_pool + ((size_t)sb * 15 + 15 + tt) * 1024 + ch0, v);
                else if (t0 + tt >= 0) ld8bf(PIN + (size_t)(row0 + tt) * 1024 + ch0, v);
                else {
#pragma unroll
                    for (int j = 0; j < 8; ++j) v[j] = 0.f; }
#pragma unroll
                for (int j = 0; j < 8; ++j) S[j] += v[j]; }
            for (int tb = 0; tb < 64; tb += 8) {
                u32x4 rawc[8]; float oldv[8][8];
#pragma unroll
                for (int q = 0; q < 8; ++q) rawc[q] = *(const u32x4*)(PIN + (size_t)(row0 + tb + q) * 1024 + ch0);
#pragma unroll
                for (int q = 0; q < 8; ++q) { const int tt = tb + q - w + 1;
                    if (tt >= 0 || (!samp && t0 + tt >= 0)) ld8bf(PIN + (size_t)(row0 + tt) * 1024 + ch0, oldv[q]);
                    else if (samp) ld8f(st_pool + ((size_t)sb * 15 + 15 + tt) * 1024 + ch0, oldv[q]);
                    else {
#pragma unroll
                        for (int j = 0; j < 8; ++j) oldv[q][j] = 0.f; } }
#pragma unroll
                for (int q = 0; q < 8; ++q) { const u32x4 wv = rawc[q]; const float cur[8] = {bf_lo(wv.x), bf_hi(wv.x), bf_lo(wv.y), bf_hi(wv.y), bf_lo(wv.z), bf_hi(wv.z), bf_lo(wv.w), bf_hi(wv.w)}; float o[8];
                    const int pos = samp ? 1024 + tb + q : t0 + tb + q; const float rc = 1.0f / (float)((pos + 1 < w) ? pos + 1 : w);
#pragma unroll
                    for (int j = 0; j < 8; ++j) { S[j] += cur[j]; o[j] = S[j] * rc - cur[j]; S[j] -= oldv[q][j]; }
                    st8bf(POOLED + (size_t)(row0 + tb + q) * 1024 + ch0, o); } }
            if (lastc) { float* dst = samp ? C.out + O_POOL_S + (size_t)sb * 15 * 1024 : C.out + O_POOL_P + (size_t)(chunk >> 8) * 15 * 1024;
                for (int i = 0; i < 15; ++i) { float v[8]; ld8bf(PIN + (size_t)(row0 + 49 + i) * 1024 + ch0, v); st8f(dst + (size_t)i * 1024 + ch0, v); } }
        }
    }
}

__device__ __forceinline__ void phase_scanA(const Ctx& C) {
    const float* __restrict__ A = (const float*)(C.ws + A_B4); const bf16_t* __restrict__ U = (const bf16_t*)(A + (size_t)MT * 1024);
    float* __restrict__ cP = (float*)(C.ws + WS_SCAN); float* __restrict__ cH = cP + SCAN_WORDS;
    for (int it = C.vcu * 512 + C.tid; it < 544 * 256; it += C.G * 512) {
        const int chunk = it >> 8, ch = (it & 255) * 4; const int row0 = chunk * 64;
        f32x4 P = {1.f, 1.f, 1.f, 1.f}, H = {0.f, 0.f, 0.f, 0.f};
        for (int tb = 0; tb < 64; tb += 8) { f32x4 av[8], uv[8];
#pragma unroll
            for (int q = 0; q < 8; ++q) { av[q] = *(const f32x4*)(A + (size_t)(row0 + tb + q) * 1024 + ch); const u32x2 uw = *(const u32x2*)(U + (size_t)(row0 + tb + q) * 1024 + ch); uv[q] = (f32x4){bf_lo(uw.x), bf_hi(uw.x), bf_lo(uw.y), bf_hi(uw.y)}; }
#pragma unroll
            for (int q = 0; q < 8; ++q) { H = av[q] * H + uv[q]; P = P * av[q]; } }
        *(f32x4*)(cP + (size_t)chunk * 1024 + ch) = P; *(f32x4*)(cH + (size_t)chunk * 1024 + ch) = H;
    }
}
__device__ __forceinline__ void phase_scanB(const Ctx& C) {
    const float* __restrict__ cP = (const float*)(C.ws + WS_SCAN); const float* __restrict__ cH = cP + SCAN_WORDS; float* __restrict__ cI = (float*)(C.ws + WS_SCAN) + 2 * SCAN_WORDS;
    const int it = C.vcu * 512 + C.tid;
    if (it < 2048) { const int s = it >> 10, ch = it & 1023; float carry = 0.f;
        for (int cb = 0; cb < 256; cb += 16) { float pv[16], hv[16];
#pragma unroll
            for (int q = 0; q < 16; ++q) { const size_t o = (size_t)(s * 256 + cb + q) * 1024 + ch; pv[q] = cP[o]; hv[q] = cH[o]; }
#pragma unroll
            for (int q = 0; q < 16; ++q) { cI[(size_t)(s * 256 + cb + q) * 1024 + ch] = carry; carry = pv[q] * carry + hv[q]; } } }
}
__device__ __forceinline__ void phase_scanC(const Ctx& C) {
    const float* __restrict__ A = (const float*)(C.ws + A_B4); const bf16_t* __restrict__ U = (const bf16_t*)(A + (size_t)MT * 1024); const float* __restrict__ cI = (const float*)(C.ws + WS_SCAN) + 2 * SCAN_WORDS;
    const bf16_t* __restrict__ GG = (const bf16_t*)(C.ws + A_GG); bf16_t* __restrict__ CAT = (bf16_t*)(C.ws + A_HN); const float* hprev = C.in[5];
    for (int it = C.vcu * 512 + C.tid; it < 544 * 256; it += C.G * 512) {
        const int chunk = it >> 8, ch = (it & 255) * 4; const int row0 = chunk * 64; const bool samp = chunk >= 512;
        f32x4 h = samp ? *(const f32x4*)(hprev + (size_t)(chunk - 512) * 1024 + ch) : *(const f32x4*)(cI + (size_t)chunk * 1024 + ch);
        for (int tb = 0; tb < 64; tb += 8) { f32x4 av[8], uv[8]; u32x2 gv[8];
#pragma unroll
            for (int q = 0; q < 8; ++q) { const size_t o = (size_t)(row0 + tb + q) * 1024 + ch; av[q] = *(const f32x4*)(A + o); { const u32x2 uw = *(const u32x2*)(U + o); uv[q] = (f32x4){bf_lo(uw.x), bf_hi(uw.x), bf_lo(uw.y), bf_hi(uw.y)}; } gv[q] = *(const u32x2*)(GG + o); }
#pragma unroll
            for (int q = 0; q < 8; ++q) { h = av[q] * h + uv[q];
                u32x2 w; w.x = cvt_pk_bf16(bf_lo(gv[q].x) * h.x, bf_hi(gv[q].x) * h.y); w.y = cvt_pk_bf16(bf_lo(gv[q].y) * h.z, bf_hi(gv[q].y) * h.w);
                *(u32x2*)(CAT + (size_t)(row0 + tb + q) * 2048 + ch) = w; } }
        if (samp) *(f32x4*)(C.out + O_H_S + (size_t)(chunk - 512) * 1024 + ch) = h;
        else if ((chunk & 255) == 255) *(f32x4*)(C.out + O_H_P + (size_t)(chunk >> 8) * 1024 + ch) = h;
    }
}

__device__ __forceinline__ void phase_latent(const Ctx& C) {
    const float* CQKV = (const float*)(C.ws + A_B3); bf16_t* CQ = (bf16_t*)(C.ws + A_CQ); bf16_t* CKV = (bf16_t*)(C.ws + A_CKV); unsigned char* KP = C.ws + A_KP;
    const float* gq = C.in[25]; const float* gkv = C.in[28]; const float* rope = (const float*)(C.ws + WS_ROPE); const int lane = C.lane;
    for (int m = C.gw; m < MT; m += C.NGW) {
        const float* r = CQKV + (size_t)m * 1024; const int kvr = kvrow_of_row(m);
        { float v[8]; ld8f(r + lane * 8, v); float ss = 0.f;
#pragma unroll
          for (int j = 0; j < 8; ++j) ss += v[j] * v[j];
          const float rstd = __builtin_amdgcn_rsqf(wave_sum(ss) * (1.0f / 512) + RMS_EPS); float g[8]; ld8f(gq + lane * 8, g);
#pragma unroll
          for (int j = 0; j < 8; ++j) v[j] = v[j] * rstd * g[j];
          { u32x2 w8; w8.x = cvt4_fp8(v[0], v[1], v[2], v[3]); w8.y = cvt4_fp8(v[4], v[5], v[6], v[7]); *(u32x2*)((unsigned char*)CQ + (size_t)m * 512 + lane * 8) = w8; } }
        { const f32x4 v = *(const f32x4*)(r + 512 + lane * 4); const float ss = (v.x * v.x + v.y * v.y) + (v.z * v.z + v.w * v.w);
          const float rstd = __builtin_amdgcn_rsqf(wave_sum(ss) * (1.0f / 256) + RMS_EPS); const f32x4 y = v * rstd * *(const f32x4*)(gkv + lane * 4);
          *(f32x4*)(C.out + O_CKV + (size_t)m * 256 + lane * 4) = y;
          *(unsigned*)((unsigned char*)CKV + (size_t)kvr * 256 + lane * 4) = cvt4_fp8(y.x, y.y, y.z, y.w); }
        { const float x = r[768 + lane]; const float xo = __shfl_xor(x, 32); const int j = lane & 31; const float* rp = rope + (size_t)pos_of_row(m) * 64;
          const float c = rp[j], s = rp[32 + j]; const float y = (lane < 32) ? x * c - xo * s : xo * s + x * c;
          C.out[O_KPE + (size_t)m * 64 + lane] = y; KP[(size_t)kvr * 64 + lane] = (unsigned char)(cvt4_fp8(y, 0.f, 0.f, 0.f) & 0xffu); }
    }
    const size_t gt = (size_t)C.vcu * 512 + C.tid, GT = (size_t)C.G * 512;
    for (size_t i = gt; i < (size_t)32 * 1024 * 256 / 8; i += GT) { const size_t e = i * 8, rowc = e / 256, col = e % 256, b = rowc / 1024, p = rowc % 1024;
        float v[8]; ld8f(C.in[7] + e, v); u32x2 w8; w8.x = cvt4_fp8(v[0], v[1], v[2], v[3]); w8.y = cvt4_fp8(v[4], v[5], v[6], v[7]); *(u32x2*)((unsigned char*)CKV + ((size_t)MP + b * 1088 + p) * 256 + col) = w8; }
    for (size_t i = gt; i < (size_t)32 * 1024 * 64 / 8; i += GT) { const size_t e = i * 8, rowc = e / 64, col = e % 64, b = rowc / 1024, p = rowc % 1024;
        float v[8]; ld8f(C.in[8] + e, v); u32x2 w8; w8.x = cvt4_fp8(v[0], v[1], v[2], v[3]); w8.y = cvt4_fp8(v[4], v[5], v[6], v[7]); *(u32x2*)(KP + ((size_t)MP + b * 1088 + p) * 64 + col) = w8; }
}
typedef __bf16 bf2_t __attribute__((ext_vector_type(2)));
__device__ __forceinline__ unsigned ford(float f) { const unsigned u = __float_as_uint(f); return (u & 0x80000000u) ? ~u : (u | 0x80000000u); }
__device__ __forceinline__ float funord(unsigned o) { return __uint_as_float((o & 0x80000000u) ? (o & 0x7fffffffu) : ~o); }
__device__ __forceinline__ unsigned umax(unsigned a, unsigned b) { return a > b ? a : b; }
__device__ __forceinline__ unsigned umin(unsigned a, unsigned b) { return a < b ? a : b; }
__device__ __forceinline__ void ins16(unsigned (&L)[16], unsigned x) {
#pragma unroll
    for (int i = 0; i < 16; ++i) { const unsigned t = umax(L[i], x); x = umin(L[i], x); L[i] = t; }
}
__device__ __forceinline__ void ins16p(unsigned (&K)[16], unsigned (&P)[16], unsigned key, unsigned pay) {
#pragma unroll
    for (int i = 0; i < 16; ++i) { const bool c = key > K[i]; const unsigned tk = c ? key : K[i], nk = c ? K[i] : key, tp = c ? pay : P[i], np = c ? P[i] : pay; K[i] = tk; P[i] = tp; key = nk; pay = np; }
}
__device__ __forceinline__ void sort16_desc(unsigned (&v)[16]) {
#pragma unroll
    for (int k = 2; k <= 16; k <<= 1)
#pragma unroll
        for (int j = k >> 1; j >= 1; j >>= 1)
#pragma unroll
            for (int i = 0; i < 16; ++i) { const int l = i ^ j; if (l > i) { const bool desc = ((i & k) == 0); const unsigned a = v[i], b = v[l], hi = umax(a, b), lo = umin(a, b); v[i] = desc ? hi : lo; v[l] = desc ? lo : hi; } }
}
__device__ __forceinline__ void merge16_desc(unsigned (&A)[16], const unsigned (&B)[16]) {
#pragma unroll
    for (int i = 0; i < 16; ++i) A[i] = umax(A[i], B[15 - i]);
#pragma unroll
    for (int st = 8; st >= 1; st >>= 1)
#pragma unroll
        for (int i = 0; i < 16; ++i) if ((i & st) == 0) { const unsigned a = A[i], b = A[i + st]; A[i] = umax(a, b); A[i + st] = umin(a, b); }
}
__device__ __forceinline__ void subkey_top16(const bf16_t* qrow  , const bf16_t* krow  , int hh, unsigned (&S)[16]) {
    bf16x8 qf[8];
#pragma unroll
    for (int s = 0; s < 8; ++s) qf[s] = *(const bf16x8*)(qrow + 16 * s);
    unsigned L[16];
#pragma unroll
    for (int i = 0; i < 16; ++i) L[i] = 0u;
#pragma unroll 1
    for (int kb = 0; kb < 4; ++kb) {
        bf16x8 kf[8];
#pragma unroll
        for (int s = 0; s < 8; ++s) kf[s] = *(const bf16x8*)(krow + (size_t)kb * 32 * 128 + 16 * s);
        f32x16 a = {0.f, 0.f, 0.f, 0.f, 0.f, 0.f, 0.f, 0.f, 0.f, 0.f, 0.f, 0.f, 0.f, 0.f, 0.f, 0.f};
#pragma unroll
        for (int s = 0; s < 8; ++s) a = __builtin_amdgcn_mfma_f32_32x32x16_bf16(kf[s], qf[s], a, 0, 0, 0);
        unsigned N[16];
#pragma unroll
        for (int r = 0; r < 16; ++r) { const unsigned idx = (unsigned)(32 * kb + (r & 3) + 8 * (r >> 2) + 4 * hh); N[r] = (ford(a[r]) & ~0x7fu) | idx; }
        sort16_desc(N); merge16_desc(L, N);
        asm volatile("" ::: "memory");
    }
    unsigned P[16];
#pragma unroll
    for (int i = 0; i < 16; ++i) P[i] = (unsigned)__shfl_xor((int)L[i], 32);
#pragma unroll
    for (int i = 0; i < 16; ++i) S[i] = L[i];
    merge16_desc(S, P);
}
__device__ __forceinline__ void phase_topk(const Ctx& C, int layer) {
    const bf16_t* Q = (const bf16_t*)(C.ws + A_B3); const bf16_t* KEYS = (const bf16_t*)(C.ws + WS_KEYS) + (size_t)layer * 8 * 2 * 128 * 128;
    int* IDX = (int*)(C.ws + A_B4); float* GATE = (float*)(C.ws + A_B4) + (size_t)MT * 128;
    const int lane = C.lane, r = lane & 31, hh = lane >> 5;
    for (int task = C.gw; task < (MT / 32) * 8; task += C.NGW) {
        const int tg = task >> 3, h = task & 7, m = tg * 32 + r;
        unsigned S1[16], S2[16];
        subkey_top16(Q + (size_t)m * 2048 + h * 256 + 8 * hh, KEYS + ((size_t)(h * 2 + 0) * 128 + r) * 128 + 8 * hh, hh, S1);
        subkey_top16(Q + (size_t)m * 2048 + h * 256 + 128 + 8 * hh, KEYS + ((size_t)(h * 2 + 1) * 128 + r) * 128 + 8 * hh, hh, S2);
#define CKEY(a, b) ((ford(funord(S1[a] & ~0x7fu) + funord(S2[b] & ~0x7fu)) & ~0xffu) | (unsigned)((a) << 4 | (b)))
        unsigned FK[16], G[16];
#pragma unroll
        for (int b = 0; b < 16; ++b) FK[b] = CKEY(0, b);
#pragma unroll
        for (int b = 0; b < 8; ++b) G[b] = CKEY(1, b);
#pragma unroll
        for (int b = 0; b < 5; ++b) G[8 + b] = CKEY(2, b);
#pragma unroll
        for (int b = 0; b < 3; ++b) G[13 + b] = CKEY(4, b);
        sort16_desc(G); merge16_desc(FK, G);
#pragma unroll
        for (int b = 0; b < 4; ++b) G[b] = CKEY(3, b);
#pragma unroll
        for (int b = 0; b < 2; ++b) { G[4 + b] = CKEY(5, b); G[6 + b] = CKEY(6, b); G[8 + b] = CKEY(7, b); }
#pragma unroll
        for (int a = 8; a < 14; ++a) G[2 + a] = CKEY(a, 0);
        sort16_desc(G); merge16_desc(FK, G);
        ins16(FK, CKEY(14, 0)); ins16(FK, CKEY(15, 0));
#undef CKEY
        unsigned I1p[4], I2p[4];
#pragma unroll
        for (int w = 0; w < 4; ++w) { I1p[w] = (S1[4 * w] & 0x7fu) | ((S1[4 * w + 1] & 0x7fu) << 8) | ((S1[4 * w + 2] & 0x7fu) << 16) | ((S1[4 * w + 3] & 0x7fu) << 24);
                                      I2p[w] = (S2[4 * w] & 0x7fu) | ((S2[4 * w + 1] & 0x7fu) << 8) | ((S2[4 * w + 2] & 0x7fu) << 16) | ((S2[4 * w + 3] & 0x7fu) << 24); }
        const float mx = funord(FK[0] & ~0xffu); float sum = 0.f;
#pragma unroll
        for (int i = 0; i < 16; ++i) sum += fexp(funord(FK[i] & ~0xffu) - mx);
        const float rs = 1.0f / sum;
        int oi[8]; float og[8];
#pragma unroll
        for (int i = 0; i < 8; ++i) { const unsigned key = hh ? FK[8 + i] : FK[i]; const unsigned a = (key >> 4) & 15u, b = key & 15u;
            const unsigned w1 = (a >> 2) == 0u ? I1p[0] : ((a >> 2) == 1u ? I1p[1] : ((a >> 2) == 2u ? I1p[2] : I1p[3]));
            const unsigned w2 = (b >> 2) == 0u ? I2p[0] : ((b >> 2) == 1u ? I2p[1] : ((b >> 2) == 2u ? I2p[2] : I2p[3]));
            oi[i] = (int)((((w1 >> ((a & 3u) * 8u)) & 0x7fu) << 7) | ((w2 >> ((b & 3u) * 8u)) & 0x7fu));
            og[i] = fexp(funord(key & ~0xffu) - mx) * rs; }
        const size_t o = (size_t)m * 128 + h * 16 + 8 * hh;
        *(u32x4*)(IDX + o) = (u32x4){(unsigned)oi[0], (unsigned)oi[1], (unsigned)oi[2], (unsigned)oi[3]}; *(u32x4*)(IDX + o + 4) = (u32x4){(unsigned)oi[4], (unsigned)oi[5], (unsigned)oi[6], (unsigned)oi[7]};
        *(f32x4*)(GATE + o) = (f32x4){og[0], og[1], og[2], og[3]}; *(f32x4*)(GATE + o + 4) = (f32x4){og[4], og[5], og[6], og[7]};
    }
}

template <int CTRL, int ROWMASK> __device__ __forceinline__ float dppf(float v) { return __builtin_bit_cast(float, __builtin_amdgcn_update_dpp(0, __builtin_bit_cast(int, v), CTRL, ROWMASK, 0xF, false)); }
__device__ __forceinline__ float wave_sum_u(float v) {
    v += dppf<0xB1, 0xF>(v); v += dppf<0x4E, 0xF>(v); v += dppf<0x141, 0xF>(v); v += dppf<0x140, 0xF>(v);
    v += dppf<0x142, 0xA>(v); v += dppf<0x143, 0xC>(v);
    return __builtin_bit_cast(float, __builtin_amdgcn_readlane(__builtin_bit_cast(int, v), 63));
}
struct RowSet4 { u32x4 u, v; };
__device__ __forceinline__ void load_rows4(RowSet4& R, const unsigned char* U4, const unsigned char* V4, int eid, int lane) {
    const size_t o = (size_t)eid * 1024 + lane * 16; R.u = *(const u32x4*)(U4 + o); R.v = *(const u32x4*)(V4 + o);
}
__device__ __forceinline__ void use_rows4(const u32x4 Ru, const u32x4 Rv, const float (&xf)[32], float gate, float (&out)[32]) {
    float d0 = 0.f, d1 = 0.f;
#define U4_STEP(w, b) { const f32x2 t = __builtin_amdgcn_cvt_scalef32_pk_f32_fp4(Ru[w], 1.0f, b); d0 = fmaf(xf[8 * (w) + 2 * (b)], t.x, d0); d1 = fmaf(xf[8 * (w) + 2 * (b) + 1], t.y, d1); }
#define U4_WORD(w) U4_STEP(w, 0) U4_STEP(w, 1) U4_STEP(w, 2) U4_STEP(w, 3)
    U4_WORD(0) U4_WORD(1) U4_WORD(2) U4_WORD(3)
#undef U4_WORD
#undef U4_STEP
    const float d = wave_sum_u(d0 + d1) * (1.0f / U4_SCALE);
    const float a = gelu_erf(d) * gate * (1.0f / V4_SCALE);
#define V4_STEP(w, b) { const f32x2 t = __builtin_amdgcn_cvt_scalef32_pk_f32_fp4(Rv[w], 1.0f, b); out[8 * (w) + 2 * (b)] = fmaf(a, t.x, out[8 * (w) + 2 * (b)]); out[8 * (w) + 2 * (b) + 1] = fmaf(a, t.y, out[8 * (w) + 2 * (b) + 1]); }
#define V4_WORD(w) V4_STEP(w, 0) V4_STEP(w, 1) V4_STEP(w, 2) V4_STEP(w, 3)
    V4_WORD(0) V4_WORD(1) V4_WORD(2) V4_WORD(3)
#undef V4_WORD
#undef V4_STEP
}
typedef _Float16 h16x2 __attribute__((ext_vector_type(2)));
__device__ __forceinline__ float dot_row4(const u32x4 Ru, const h16x2 (&xh)[16]) {
    float d0 = 0.f, d1 = 0.f;
#define U4_STEP(w, b, D) { const h16x2 t = __builtin_amdgcn_cvt_scalef32_pk_f16_fp4(Ru[w], 1.0f, b); D = __builtin_amdgcn_fdot2(xh[4 * (w) + (b)], t, D, false); }
#define U4_WORD(w) U4_STEP(w, 0, d0) U4_STEP(w, 1, d1) U4_STEP(w, 2, d0) U4_STEP(w, 3, d1)
    U4_WORD(0) U4_WORD(1) U4_WORD(2) U4_WORD(3)
#undef U4_WORD
#undef U4_STEP
    return wave_sum_u(d0 + d1);
}
typedef int i32x8 __attribute__((ext_vector_type(8)));
__device__ __forceinline__ float dot_row4_mfma(const u32x4 Ru, const i32x8& xhi, int dsel, bool dval) {
    const i32x8 a = {(int)Ru.x, (int)Ru.y, (int)Ru.z, (int)Ru.w, 0, 0, 0, 0};
    f32x4 d = {0.f, 0.f, 0.f, 0.f};
    d = __builtin_amdgcn_mfma_scale_f32_16x16x128_f8f6f4(a, xhi, d, 4, 0, 0, 127, 0, 127);
    float v = dsel == 0 ? d[0] : (dsel == 1 ? d[1] : (dsel == 2 ? d[2] : d[3]));
    v = dval ? v : 0.f;
    return wave_sum_u(v);
}
__device__ __forceinline__ void axpy_row4(const u32x4 Rv, float a, float (&out)[32]) {
#define V4_STEP(w, b) { const f32x2 t = __builtin_amdgcn_cvt_scalef32_pk_f32_fp4(Rv[w], 1.0f, b); out[8 * (w) + 2 * (b)] = fmaf(a, t.x, out[8 * (w) + 2 * (b)]); out[8 * (w) + 2 * (b) + 1] = fmaf(a, t.y, out[8 * (w) + 2 * (b) + 1]); }
#define V4_WORD(w) V4_STEP(w, 0) V4_STEP(w, 1) V4_STEP(w, 2) V4_STEP(w, 3)
    V4_WORD(0) V4_WORD(1) V4_WORD(2) V4_WORD(3)
#undef V4_WORD
#undef V4_STEP
}
__device__ __forceinline__ void phase_gather(const Ctx& C, int layer) {
    const bf16_t* HN2 = (const bf16_t*)(C.ws + A_B2); const unsigned char* U4 = C.ws + WS_U + (size_t)layer * bq::TAB_L1; const unsigned char* V4 = C.ws + WS_V + (size_t)layer * bq::TAB_L1;
    const int* IDX = (const int*)(C.ws + A_B4); const float* GATE = (const float*)(C.ws + A_B4) + (size_t)MT * 128;
    const float* mod = (const float*)(C.ws + WS_MOD); float* X = C.out + O_Y; bf16_t* HN = (bf16_t*)(C.ws + A_HN);
    const int lane = C.lane;
    int m = C.gw; if (m >= MT) return;
    LAS unsigned char* ring = C.lds + C.wave * 16384;
    int i0 = IDX[(size_t)m * 128 + lane], i1 = IDX[(size_t)m * 128 + 64 + lane];
    float g0 = GATE[(size_t)m * 128 + lane], g1 = GATE[(size_t)m * 128 + 64 + lane];
    u32x2 xw[8];
#pragma unroll
    for (int b = 0; b < 8; ++b) xw[b] = *(const u32x2*)(HN2 + (size_t)m * 2048 + 256 * b + 4 * lane);
#pragma unroll
    for (int b = 0; b < 8; ++b) asm volatile("" : "+v"(xw[b]));
    asm volatile("" : "+v"(i0), "+v"(i1), "+v"(g0), "+v"(g1));
    asm volatile("s_waitcnt vmcnt(0)" ::: "memory");
#define SB() __builtin_amdgcn_sched_barrier(0)
    const unsigned lo16 = (unsigned)lane * 16u;
#define ROW_DMA(T, eid_, s_) __builtin_amdgcn_global_load_lds((const unsigned*)((const char*)((T) + (size_t)(eid_) * 1024) + lo16), (LAS unsigned*)(ring + ((s_) & 15) * 1024), 16, 0, 0)
#define EIDC(j) __builtin_amdgcn_readlane(((j) < 64) ? i0 : i1, (j) & 63)
#pragma unroll
    for (int j = 0; j < 14; ++j) ROW_DMA(U4, __builtin_amdgcn_readlane(i0, j), j);
    for (;;) {
        const int mn = m + C.NGW; const bool has_next = mn < MT; const int mq = has_next ? mn : m;
        int ni0, ni1; float ng0, ng1; u32x2 nx[8];
        int lt = lane; asm volatile("" : "+v"(lt));
        { const int* ip = IDX + (size_t)mq * 128 + lt; const float* gp = GATE + (size_t)mq * 128 + lt; const bf16_t* xp = HN2 + (size_t)mq * 2048 + 4 * lt;
          asm volatile("global_load_dword %0, %1, off" : "=v"(ni0) : "v"(ip) : "memory");
          asm volatile("global_load_dword %0, %1, off offset:256" : "=v"(ni1) : "v"(ip) : "memory");
          asm volatile("global_load_dword %0, %1, off" : "=v"(ng0) : "v"(gp) : "memory");
          asm volatile("global_load_dword %0, %1, off offset:256" : "=v"(ng1) : "v"(gp) : "memory");
          asm volatile("global_load_dwordx2 %0, %1, off" : "=v"(nx[0]) : "v"(xp) : "memory");
          asm volatile("global_load_dwordx2 %0, %1, off offset:512" : "=v"(nx[1]) : "v"(xp) : "memory");
          asm volatile("global_load_dwordx2 %0, %1, off offset:1024" : "=v"(nx[2]) : "v"(xp) : "memory");
          asm volatile("global_load_dwordx2 %0, %1, off offset:1536" : "=v"(nx[3]) : "v"(xp) : "memory");
          asm volatile("global_load_dwordx2 %0, %1, off offset:2048" : "=v"(nx[4]) : "v"(xp) : "memory");
          asm volatile("global_load_dwordx2 %0, %1, off offset:2560" : "=v"(nx[5]) : "v"(xp) : "memory");
          asm volatile("global_load_dwordx2 %0, %1, off offset:3072" : "=v"(nx[6]) : "v"(xp) : "memory");
          asm volatile("global_load_dwordx2 %0, %1, off offset:3584" : "=v"(nx[7]) : "v"(xp) : "memory"); }
        i32x8 xhi;
#pragma unroll
        for (int b = 0; b < 8; ++b) xhi[b] = (int)cvt4_fp8(bf_lo(xw[b].x), bf_hi(xw[b].x), bf_lo(xw[b].y), bf_hi(xw[b].y));
        const int dsel = lane & 3; const bool dval = ((lane & 15) >> 2) == (lane >> 4);
        { const int jj = lane & 15, gg = lane >> 4, srcA = (jj + 16 * (gg >> 1)) << 2, srcB = (jj + 16 * (2 + (gg >> 1))) << 2; const bool odd = gg & 1;
          i32x8 nh;
#pragma unroll
          for (int d = 0; d < 4; ++d) {
              const int a0 = __builtin_amdgcn_ds_bpermute(srcA, xhi[d]), a1 = __builtin_amdgcn_ds_bpermute(srcA, xhi[4 + d]), b0 = __builtin_amdgcn_ds_bpermute(srcB, xhi[d]), b1 = __builtin_amdgcn_ds_bpermute(srcB, xhi[4 + d]);
              nh[d] = odd ? a1 : a0; nh[4 + d] = odd ? b1 : b0; }
          xhi = nh; }
        float dv0 = 0.f, dv1 = 0.f;
#define U_ITER2(e, VMN, DV, NEXT_T, NEXT_E0, NEXT_E1) do { ROW_DMA(NEXT_T, NEXT_E0, (e) + 14); ROW_DMA(NEXT_T, NEXT_E1, (e) + 15); asm volatile("s_waitcnt vmcnt(" #VMN ")" ::: "memory"); \
            const u32x4 ru0 = *(const LAS u32x4*)(ring + ((e) & 15) * 1024 + lo16), ru1 = *(const LAS u32x4*)(ring + (((e) + 1) & 15) * 1024 + lo16); \
            const float da = dot_row4_mfma(ru0, xhi, dsel, dval), db = dot_row4_mfma(ru1, xhi, dsel, dval); \
            DV = (lane == ((e) & 63)) ? da : DV; DV = (lane == (((e) + 1) & 63)) ? db : DV; } while (0)
#pragma unroll 1
        for (int e = 0; e < 14; e += 2) U_ITER2(e, 26, dv0, U4, EIDC(e + 14), EIDC(e + 15));
#pragma unroll 1
        for (int e = 14; e < 64; e += 2) U_ITER2(e, 14, dv0, U4, EIDC(e + 14), EIDC(e + 15));
#pragma unroll 1
        for (int e = 64; e < 114; e += 2) U_ITER2(e, 14, dv1, U4, EIDC(e + 14), EIDC(e + 15));
#pragma unroll 1
        for (int e = 114; e < 128; e += 2) U_ITER2(e, 14, dv1, V4, EIDC(e - 114), EIDC(e - 113));
#undef U_ITER2
        asm volatile("" : "+v"(ni0), "+v"(ni1), "+v"(ng0), "+v"(ng1));
#pragma unroll
        for (int b = 0; b < 8; ++b) asm volatile("" : "+v"(nx[b]));
        const float av0 = gelu_erf(dv0 * (1.0f / U4_SCALE)) * g0 * (1.0f / V4_SCALE), av1 = gelu_erf(dv1 * (1.0f / U4_SCALE)) * g1 * (1.0f / V4_SCALE);
        float out[32];
#pragma unroll
        for (int i = 0; i < 32; ++i) out[i] = 0.f;
#define V_ITER2(e, AV, NEXT_T, NEXT_E0, NEXT_E1) do { ROW_DMA(NEXT_T, NEXT_E0, (e) + 14); ROW_DMA(NEXT_T, NEXT_E1, (e) + 15); asm volatile("s_waitcnt vmcnt(14)" ::: "memory"); \
            const u32x4 rv0 = *(const LAS u32x4*)(ring + ((e) & 15) * 1024 + lo16), rv1 = *(const LAS u32x4*)(ring + (((e) + 1) & 15) * 1024 + lo16); \
            const float a0 = __builtin_bit_cast(float, __builtin_amdgcn_readlane(__builtin_bit_cast(int, AV), (e) & 63)), a1 = __builtin_bit_cast(float, __builtin_amdgcn_readlane(__builtin_bit_cast(int, AV), ((e) + 1) & 63)); \
            axpy_row4(rv0, a0, out); axpy_row4(rv1, a1, out); } while (0)
#pragma unroll 1
        for (int e = 0; e < 64; e += 2) V_ITER2(e, av0, V4, EIDC(e + 14), EIDC(e + 15));
#pragma unroll 1
        for (int e = 64; e < 114; e += 2) V_ITER2(e, av1, V4, EIDC(e + 14), EIDC(e + 15));
#pragma unroll 1
        for (int e = 114; e < 128; e += 2) V_ITER2(e, av1, U4, __builtin_amdgcn_readlane(ni0, e - 114), __builtin_amdgcn_readlane(ni0, e - 113));
#undef V_ITER2
        int le = lane; asm volatile("" : "+v"(le));
        const int sq = seq_of_row(m); const float* g2 = mod + ((size_t)layer * NSEQ + sq) * 12288 + 5 * 2048; float* xr = X + (size_t)m * DM;
        float ss = 0.f;
#pragma unroll
        for (int hb = 0; hb < 2; ++hb) {
            f32x4 xo[4], gg[4];
#pragma unroll
            for (int b = 0; b < 4; ++b) { const int c = 256 * (4 * hb + b) + 4 * le; xo[b] = *(const f32x4*)(xr + c); gg[b] = *(const f32x4*)(g2 + c); }
            SB();
#pragma unroll
            for (int b = 0; b < 4; ++b) {
#pragma unroll
                for (int j = 0; j < 4; ++j) { const float v = xo[b][j] + gg[b][j] * out[4 * (4 * hb + b) + j]; out[4 * (4 * hb + b) + j] = v; ss += v * v; } }
            SB();
        }
        const float rstd = __builtin_amdgcn_rsqf(wave_sum(ss) * (1.0f / DM) + RMS_EPS);
        if (layer == 0) {
            const float* n1g = C.in[11] + 2048; const float* mp = mod + ((size_t)1 * NSEQ + sq) * 12288;
#pragma unroll
            for (int hb = 0; hb < 2; ++hb) {
                f32x4 gv[4], sh[4], sc[4];
#pragma unroll
                for (int b = 0; b < 4; ++b) { const int c = 256 * (4 * hb + b) + 4 * le; gv[b] = *(const f32x4*)(n1g + c); sh[b] = *(const f32x4*)(mp + c); sc[b] = *(const f32x4*)(mp + 2048 + c); }
                SB();
#pragma unroll
                for (int b = 0; b < 4; ++b) { const int bb = 4 * hb + b, c = 256 * bb + 4 * le;
                    const f32x4 xs = {out[4 * bb], out[4 * bb + 1], out[4 * bb + 2], out[4 * bb + 3]}; const f32x4 y = xs * rstd * gv[b] * (sc[b] + 1.0f) + sh[b];
                    *(f32x4*)(xr + c) = xs; u32x2 w; w.x = cvt_pk_bf16(y[0], y[1]); w.y = cvt_pk_bf16(y[2], y[3]); *(u32x2*)(HN + (size_t)m * DM + c) = w; }
                SB();
            }
        } else {
            const float* fg = C.in[35];
            f32x4 gv[8];
#pragma unroll
            for (int b = 0; b < 8; ++b) gv[b] = *(const f32x4*)(fg + 256 * b + 4 * le);
            SB();
#pragma unroll
            for (int b = 0; b < 8; ++b) { const int c = 256 * b + 4 * le; const f32x4 xs = {out[4 * b], out[4 * b + 1], out[4 * b + 2], out[4 * b + 3]};
                *(f32x4*)(xr + c) = xs * rstd * gv[b]; }
        }
        if (!has_next) break;
        m = mn; i0 = ni0; i1 = ni1; g0 = ng0; g1 = ng1;
#pragma unroll
        for (int b = 0; b < 8; ++b) xw[b] = nx[b];
    }
    asm volatile("s_waitcnt vmcnt(0)" ::: "memory");
#undef ROW_DMA
#undef EIDC
#undef SB
}
namespace att {
constexpr int SHM_K = 64 * 208, SHM_V = 64 * 256;
constexpr int OFF_K = 0, OFF_V = 2 * SHM_K, OFF_WS = 2 * SHM_K + 2 * SHM_V;
constexpr float SCALE = 0.07216878364870322f;
constexpr float THR = 8.f;
__device__ __forceinline__ int crow(int r, int hi) { return (r & 3) + 8 * (r >> 2) + 4 * hi; }
constexpr float THR2 = THR * 1.4426950408889634f;
__device__ __forceinline__ void partialSM(f32x16& p0, f32x16& p1, float& mref, f32x16& negm, float& alpha, bool first) {
    float pmax = p0[0];
#pragma unroll
    for (int r = 1; r < 16; ++r) pmax = fmaxf(pmax, p0[r]);
#pragma unroll
    for (int r = 0; r < 16; ++r) pmax = fmaxf(pmax, p1[r]);
    { auto rr = __builtin_amdgcn_permlane32_swap(__float_as_uint(pmax), __float_as_uint(pmax), false, false);
      pmax = fmaxf(__uint_as_float(rr[0]), __uint_as_float(rr[1])); }
    if (__builtin_expect(!first && __all(pmax <= THR2), 1)) { alpha = 1.f; }
    else { const float dl = first ? pmax : fmaxf(pmax, 0.f); alpha = first ? 1.f : __builtin_amdgcn_exp2f(-dl); mref += dl;
#pragma unroll
        for (int r = 0; r < 16; ++r) { negm[r] = -mref; p0[r] -= dl; p1[r] -= dl; }
        asm volatile("" : "+v"(negm)); }
#pragma unroll
    for (int r = 0; r < 16; ++r) p0[r] = __builtin_amdgcn_exp2f(p0[r]);
#pragma unroll
    for (int r = 0; r < 16; ++r) p1[r] = __builtin_amdgcn_exp2f(p1[r]);
}
__device__ __forceinline__ void finishSM(const f32x16& p0, const f32x16& p1, float alpha, float& l_reg, bf16x8& pa0, bf16x8& pa1, bf16x8& pa2, bf16x8& pa3) {
    float ps = 0;
#pragma unroll
    for (int r = 0; r < 16; ++r) ps += p0[r];
#pragma unroll
    for (int r = 0; r < 16; ++r) ps += p1[r];
    { auto rr = __builtin_amdgcn_permlane32_swap(__float_as_uint(ps), __float_as_uint(ps), false, false);
      ps = __uint_as_float(rr[0]) + __uint_as_float(rr[1]); }
    l_reg = l_reg * alpha + ps;
#define PK4(P, BASE, OUT) do { unsigned a0 = cvt_pk_bf16(P[BASE + 0], P[BASE + 1]), a1 = cvt_pk_bf16(P[BASE + 2], P[BASE + 3]);   \
    unsigned b0 = cvt_pk_bf16(P[BASE + 4], P[BASE + 5]), b1 = cvt_pk_bf16(P[BASE + 6], P[BASE + 7]);                              \
    auto r0 = __builtin_amdgcn_permlane32_swap(a0, b0, false, false); auto r1 = __builtin_amdgcn_permlane32_swap(a1, b1, false, false); \
    u32x4 w = {r0[0], r1[0], r0[1], r1[1]}; OUT = __builtin_bit_cast(bf16x8, w); } while (0)
    PK4(p0, 0, pa0); PK4(p0, 8, pa1); PK4(p1, 0, pa2); PK4(p1, 8, pa3);
#undef PK4
}
template <int OFF> __device__ __forceinline__ bf16x8 k_read(int addr) { bf16x8 r; asm volatile("ds_read_b128 %0, %1 offset:%2" : "=v"(r) : "v"(addr), "i"(OFF) : "memory"); return r; }
template <int I> __device__ __forceinline__ bf16x8 kfrag(const int (&kad)[4]) { constexpr int d0 = I >> 1, half = I & 1; return k_read<(d0 >> 2) * 128 + half * 12288>(kad[d0 & 3]); }
__device__ __forceinline__ void packSM(const f32x16& p0, const f32x16& p1, bf16x8& pa0, bf16x8& pa1, bf16x8& pa2, bf16x8& pa3) {
#define PK4(P, BASE, OUT) do { unsigned a0 = cvt_pk_bf16(P[BASE + 0], P[BASE + 1]), a1 = cvt_pk_bf16(P[BASE + 2], P[BASE + 3]);   \
    unsigned b0 = cvt_pk_bf16(P[BASE + 4], P[BASE + 5]), b1 = cvt_pk_bf16(P[BASE + 6], P[BASE + 7]);                              \
    auto r0 = __builtin_amdgcn_permlane32_swap(a0, b0, false, false); auto r1 = __builtin_amdgcn_permlane32_swap(a1, b1, false, false); \
    u32x4 w = {r0[0], r1[0], r0[1], r1[1]}; OUT = __builtin_bit_cast(bf16x8, w); } while (0)
    PK4(p0, 0, pa0); PK4(p0, 8, pa1); PK4(p1, 0, pa2); PK4(p1, 8, pa3);
#undef PK4
}
__device__ __forceinline__ int v_rd_base(int lane) { return ((lane & 3) << 3) | (((lane >> 2) & 3) << 6) | (((lane >> 4) & 1) << 5) | (((lane >> 5) & 1) << 8); }
constexpr int v_rd_off(int d0, int ks, int half) { return d0 * 512 + ks * 4096 + half * 2048; }
template <int OFF> __device__ __forceinline__ s16x4 tr_read(int vb) {
    s16x4 r; asm volatile("ds_read_b64_tr_b16 %0, %1 offset:%2" : "=&v"(r) : "v"(vb), "i"(OFF) : "memory"); return r;
}
template <int D0> __device__ __forceinline__ void pv_one(f32x16& od, int vb, bf16x8 pa0, bf16x8 pa1, bf16x8 pa2, bf16x8 pa3) {
    const s16x4 l0 = tr_read<v_rd_off(D0, 0, 0)>(vb), h0 = tr_read<v_rd_off(D0, 0, 1)>(vb), l1 = tr_read<v_rd_off(D0, 1, 0)>(vb), h1 = tr_read<v_rd_off(D0, 1, 1)>(vb);
    const s16x4 l2 = tr_read<v_rd_off(D0, 2, 0)>(vb), h2 = tr_read<v_rd_off(D0, 2, 1)>(vb), l3 = tr_read<v_rd_off(D0, 3, 0)>(vb), h3 = tr_read<v_rd_off(D0, 3, 1)>(vb);
    asm volatile("s_waitcnt lgkmcnt(0)" ::: "memory"); __builtin_amdgcn_sched_barrier(0);
#define PKV(L, H) (bf16x8){L[0], L[1], L[2], L[3], H[0], H[1], H[2], H[3]}
    od = __builtin_amdgcn_mfma_f32_32x32x16_bf16(pa0, PKV(l0, h0), od, 0, 0, 0);
    od = __builtin_amdgcn_mfma_f32_32x32x16_bf16(pa1, PKV(l1, h1), od, 0, 0, 0);
    od = __builtin_amdgcn_mfma_f32_32x32x16_bf16(pa2, PKV(l2, h2), od, 0, 0, 0);
    od = __builtin_amdgcn_mfma_f32_32x32x16_bf16(pa3, PKV(l3, h3), od, 0, 0, 0);
#undef PKV
}
struct AUnit { int qrow0, kvrow0, ntiles, head, vis0, nact, rev; };

__device__ __forceinline__ bool next_unit(int i, int vcu, int G, AUnit& u) {
    int flat;
    if (G == 256) {
        if (i >= 10) return false;
        if (i < 8) { const int bh = vcu >> 3, s = vcu & 7, base = 16 * (i >> 1); const int qb = (i & 1) ? base + 15 - s : base + s; flat = bh * 64 + qb; }
        else flat = 2048 + vcu * 2 + (i - 8);
    } else { flat = i * G + vcu; if (flat >= 2560) return false; }
    u.rev = (G == 256 && i < 8) ? (i & 1) : 0;
    if (flat < 2048) { const int bh = flat >> 6, qb = flat & 63, b = bh >> 4; u.head = bh & 15; u.qrow0 = b * 16384 + qb * 256; u.kvrow0 = b * 16384; u.ntiles = 4 * qb + 4; u.vis0 = 4 * qb; u.nact = 8; }
    else { const int f = flat - 2048, b = f >> 4; u.head = f & 15; u.qrow0 = MP + b * 64; u.kvrow0 = MP + b * 1088; u.ntiles = 17; u.vis0 = 1 << 20; u.nact = 2; }
    return true;
}

__device__ __forceinline__ void attn_phase(const Ctx& C) {
    bf16_t* Qn = (bf16_t*)(C.ws + A_HN);
    const unsigned char* Q8 = C.ws + A_Q8; const unsigned char* Kn = C.ws + A_KN; const bf16_t* Vv = (const bf16_t*)(C.ws + A_VV);
    LAS unsigned char* lds = C.lds; const int wid = C.wave, lane = C.lane, r32 = lane & 31, hi = lane >> 5;
    LAS float* wsp = (LAS float*)(lds + OFF_WS) + wid * 64; LAS float* li_l = wsp; LAS float* al_l = wsp + 32;
    unsigned ka[2], kst[2]; bool kisn[2];
#pragma unroll
    for (int i = 0; i < 2; ++i) { const int o = ((wid + 8 * i) * 64 + lane) * 16, row = (o / 208) & 63, c = (o % 208) >> 4;
        kisn[i] = !(c >= 8 && c < 12); ka[i] = kisn[i] ? (unsigned)(row * 2048 + (c < 8 ? c : 0) * 16) : (unsigned)(A_KP - A_KN) + (unsigned)(row * 64 + (c - 8) * 16); kst[i] = kisn[i] ? 64u * 2048u : 64u * 64u; }
    const bool kp2 = wid < 5;
    unsigned va[2];
#pragma unroll
    for (int i = 0; i < 2; ++i) { const int by = ((wid * 2 + i) * 64 + lane) * 16, sub = by >> 9, within = by & 511, kk = (sub >> 2) * 8 + (within >> 6), cc = (sub & 3) * 32 + ((within & 63) >> 1);
        const int k = (kk & ~0xC) | ((kk & 4) << 1) | ((kk & 8) >> 1); va[i] = (unsigned)(k * 4096 + cc * 2); }
    const LAS unsigned char* kfr0 = lds + OFF_K + r32 * 208 + 32 * hi;
    const int vb0 = (int)(uintptr_t)(lds + OFF_V) + v_rd_base(lane);
#define ATT_BAR() __builtin_amdgcn_s_barrier()
#define ATT_ISSUE(j, kb, vbi) do { \
        __builtin_amdgcn_global_load_lds((const unsigned*)((const char*)Kn + kc[0]), (LAS unsigned*)(lds + OFF_K + (kb) * SHM_K + wid * 1024), 16, 0, 0); kc[0] += kst[0] * (unsigned)kdir; \
        if (kp2) { __builtin_amdgcn_global_load_lds((const unsigned*)((const char*)Kn + kc[1]), (LAS unsigned*)(lds + OFF_K + (kb) * SHM_K + (wid + 8) * 1024), 16, 0, 0); kc[1] += kst[1] * (unsigned)kdir; } \
      _Pragma("unroll") for (int _i = 0; _i < 2; ++_i) { \
        __builtin_amdgcn_global_load_lds((const unsigned*)((const char*)Vv + vc[_i]), (LAS unsigned*)(lds + OFF_V + (vbi) * SHM_V + (wid * 2 + _i) * 1024), 16, 0, 0); vc[_i] += (unsigned)(64 * 4096 * kdir); } } while (0)
#define PV_STEP(I, PA, L, H, WN) do { asm volatile("s_waitcnt lgkmcnt(" #WN ")" : "+v"(L), "+v"(H) :: "memory"); \
        o[(I) >> 2] = __builtin_amdgcn_mfma_f32_32x32x16_bf16(PA, ((bf16x8){L[0], L[1], L[2], L[3], H[0], H[1], H[2], H[3]}), o[(I) >> 2], 0, 0, 0); \
        if ((I) + 4 < 16) { L = tr_read<v_rd_off((((I) + 4) & 15) >> 2, (I) & 3, 0)>(vb); H = tr_read<v_rd_off((((I) + 4) & 15) >> 2, (I) & 3, 1)>(vb); } \
        __builtin_amdgcn_sched_barrier(0); } while (0)
#define PV_HEAD(VBI) do { vb = vb0 + (VBI) * SHM_V; \
      l0 = tr_read<v_rd_off(0, 0, 0)>(vb); h0 = tr_read<v_rd_off(0, 0, 1)>(vb); l1 = tr_read<v_rd_off(0, 1, 0)>(vb); h1 = tr_read<v_rd_off(0, 1, 1)>(vb); \
      l2 = tr_read<v_rd_off(0, 2, 0)>(vb); h2 = tr_read<v_rd_off(0, 2, 1)>(vb); l3 = tr_read<v_rd_off(0, 3, 0)>(vb); h3 = tr_read<v_rd_off(0, 3, 1)>(vb); } while (0)
#define PV_BODY() do { \
      __builtin_amdgcn_s_setprio(1); PV_STEP(0, pa0, l0, h0, 6);  PV_STEP(1, pa1, l1, h1, 6);  PV_STEP(2, pa2, l2, h2, 6);  PV_STEP(3, pa3, l3, h3, 6); \
      PV_STEP(4, pa0, l0, h0, 6);  PV_STEP(5, pa1, l1, h1, 6);  PV_STEP(6, pa2, l2, h2, 6);  PV_STEP(7, pa3, l3, h3, 6); \
      PV_STEP(8, pa0, l0, h0, 6);  PV_STEP(9, pa1, l1, h1, 6);  PV_STEP(10, pa2, l2, h2, 6); PV_STEP(11, pa3, l3, h3, 6); \
      PV_STEP(12, pa0, l0, h0, 6); PV_STEP(13, pa1, l1, h1, 4); PV_STEP(14, pa2, l2, h2, 2); PV_STEP(15, pa3, l3, h3, 0); __builtin_amdgcn_s_setprio(0); } while (0)
#define ATT_PV(VBI) do { PV_HEAD(VBI); PV_BODY(); } while (0)
    AUnit u;
#ifndef PROBE_ATT
#define PROBE_ATT 0
#endif
#if PROBE_ATT
    for (int ui2 = 0; next_unit(ui2 >> 1, C.vcu, C.G, u); ++ui2) { const bool dummy = !(ui2 & 1);
#else
    for (int ui = 0; next_unit(ui, C.vcu, C.G, u); ++ui) { const bool dummy = false;
#endif
        const bool active = wid < u.nact; const int vis = u.vis0 + (wid >> 1);
        const int qrow = u.qrow0 + wid * 32 + r32;
        i32x8 qf[3];
        if (active) { const unsigned char* qp = Q8 + (size_t)qrow * 3072 + u.head * 192 + 32 * hi;
#pragma unroll
            for (int s = 0; s < 3; ++s) { const u32x4 a = *(const u32x4*)(qp + 64 * s), b = *(const u32x4*)(qp + 64 * s + 16);
                qf[s] = (i32x8){(int)a.x, (int)a.y, (int)a.z, (int)a.w, (int)b.x, (int)b.y, (int)b.z, (int)b.w}; }
        } else {
#pragma unroll
            for (int s = 0; s < 3; ++s) qf[s] = (i32x8){0, 0, 0, 0, 0, 0, 0, 0};
        }
#pragma unroll
        for (int s = 0; s < 3; ++s) asm volatile("" : "+v"(qf[s]));
        float mref = 0.f, l_reg = 0.f; f32x16 o[4]; f32x16 negm;
#pragma unroll
        for (int r = 0; r < 16; ++r) negm[r] = 0.f;
        asm volatile("" : "+v"(negm));
#pragma unroll
        for (int d = 0; d < 4; ++d)
#pragma unroll
            for (int r = 0; r < 16; ++r) o[d][r] = 0.f;
        bf16x8 pa0, pa1, pa2, pa3;
        const int NT = u.ntiles;
        const int kdir = u.rev ? -1 : 1, t0 = u.rev ? u.ntiles - 1 : 0;
        bool started = false;
        unsigned kc[2], vc[2];
#pragma unroll
        for (int i = 0; i < 2; ++i) kc[i] = ka[i] + (kisn[i] ? (unsigned)u.kvrow0 * 2048u + (unsigned)u.head * 128u : (unsigned)u.kvrow0 * 64u) + kst[i] * (unsigned)t0;
#pragma unroll
        for (int i = 0; i < 2; ++i) vc[i] = va[i] + (unsigned)u.kvrow0 * 4096u + (unsigned)u.head * 256u + (unsigned)(64 * 4096) * (unsigned)t0;
        ATT_ISSUE(0, 0, 0);
        asm volatile("s_waitcnt vmcnt(0)" ::: "memory");
        ATT_BAR();
        int vb; s16x4 l0, h0, l1, h1, l2, h2, l3, h3;
        for (int j = 0; j < NT; ++j) {
            const int buf = j & 1;
            const int jt = u.rev ? NT - 1 - j : j;
            const bool doQK = active && jt <= vis;
            if (j + 1 < NT) ATT_ISSUE(j + 1, buf ^ 1, buf ^ 1);
            if (doQK) {
                f32x16 p0, p1;
                {
                    const LAS unsigned char* kf = kfr0 + buf * SHM_K;
                    i32x8 ka0[3], ka1[3];
#define KLOAD(s) do { const u32x4 a = *(const LAS u32x4*)(kf + 64 * (s)), b = *(const LAS u32x4*)(kf + 64 * (s) + 16), c = *(const LAS u32x4*)(kf + 32 * 208 + 64 * (s)), d = *(const LAS u32x4*)(kf + 32 * 208 + 64 * (s) + 16); \
        ka0[s] = (i32x8){(int)a.x, (int)a.y, (int)a.z, (int)a.w, (int)b.x, (int)b.y, (int)b.z, (int)b.w}; ka1[s] = (i32x8){(int)c.x, (int)c.y, (int)c.z, (int)c.w, (int)d.x, (int)d.y, (int)d.z, (int)d.w}; } while (0)
                    KLOAD(0); KLOAD(1);
                    __builtin_amdgcn_sched_barrier(0);
                    __builtin_amdgcn_s_setprio(1);
                    p0 = __builtin_amdgcn_mfma_scale_f32_32x32x64_f8f6f4(ka0[0], qf[0], negm, 0, 0, 0, 127, 0, 127);
                    p1 = __builtin_amdgcn_mfma_scale_f32_32x32x64_f8f6f4(ka1[0], qf[0], negm, 0, 0, 0, 127, 0, 127);
                    __builtin_amdgcn_sched_barrier(0);
                    KLOAD(2);
                    __builtin_amdgcn_sched_barrier(0);
                    p0 = __builtin_amdgcn_mfma_scale_f32_32x32x64_f8f6f4(ka0[1], qf[1], p0, 0, 0, 0, 127, 0, 127);
                    p1 = __builtin_amdgcn_mfma_scale_f32_32x32x64_f8f6f4(ka1[1], qf[1], p1, 0, 0, 0, 127, 0, 127);
                    __builtin_amdgcn_sched_barrier(0);
                    p0 = __builtin_amdgcn_mfma_scale_f32_32x32x64_f8f6f4(ka0[2], qf[2], p0, 0, 0, 0, 127, 0, 127);
                    p1 = __builtin_amdgcn_mfma_scale_f32_32x32x64_f8f6f4(ka1[2], qf[2], p1, 0, 0, 0, 127, 0, 127);
#undef KLOAD
                    __builtin_amdgcn_s_setprio(0);
                }
                if ((PROBE_ATT == 2 || PROBE_ATT == 5) && dummy) { packSM(p0, p1, pa0, pa1, pa2, pa3); } else {
                float alpha; partialSM(p0, p1, mref, negm, alpha, !started); started = true;
                if (__any(alpha < 1.f)) { if (hi == 0) al_l[r32] = alpha; asm volatile("s_waitcnt lgkmcnt(0)" ::: "memory");
#pragma unroll
                    for (int r = 0; r < 16; ++r) { const float al = al_l[crow(r, hi)];
#pragma unroll
                        for (int d = 0; d < 4; ++d) o[d][r] *= al; } }
                finishSM(p0, p1, alpha, l_reg, pa0, pa1, pa2, pa3);
                }
                if (!((PROBE_ATT == 4 || PROBE_ATT == 5) && dummy)) ATT_PV(buf);
            }
            asm volatile("s_waitcnt vmcnt(0) lgkmcnt(0)" ::: "memory");
            ATT_BAR();
        }
        if (active && !dummy) {
            if (hi == 0) li_l[r32] = l_reg; asm volatile("s_waitcnt lgkmcnt(0)" ::: "memory");
            unsigned char* Ow = (unsigned char*)Qn + (size_t)(u.qrow0 + wid * 32) * 2048 + u.head * 128;
#pragma unroll
            for (int r = 0; r < 16; ++r) { const int orow = crow(r, hi); const float rl = __builtin_amdgcn_rcpf(li_l[orow]);
#pragma unroll
                for (int d0 = 0; d0 < 4; ++d0) { const unsigned w = cvt4_fp8(o[d0][r] * rl, 0.f, 0.f, 0.f); Ow[(size_t)orow * 2048 + d0 * 32 + r32] = (unsigned char)(w & 0xffu); } }
        }
    }
#undef ATT_BAR
#undef ATT_ISSUE
#undef ATT_PV
#undef PV_STEP
#undef PV_HEAD
#undef PV_BODY
}
}
#ifndef MK_SPLIT
#define MK_SPLIT 0
#endif
constexpr int N_PHASES = 22;

__global__ void __launch_bounds__(512, 2) mega_fwd(Args args) {
    extern __shared__ __attribute__((aligned(16))) unsigned char lds_raw[];
    Ctx C;
    C.lds = (LAS unsigned char*)lds_raw;
    C.tid = threadIdx.x; C.lane = C.tid & 63; C.wave = __builtin_amdgcn_readfirstlane(C.tid >> 6);
    C.G = gridDim.x; { const int bx = blockIdx.x; C.vcu = (C.G % 8 == 0) ? (bx % 8) * (C.G / 8) + bx / 8 : bx; }
    C.gw = C.vcu * 8 + C.wave; C.NGW = C.G * 8;
    C.in = args.in; C.out = args.out; C.ws = args.ws;
    volatile LAS unsigned* misc = (volatile LAS unsigned*)(C.lds + LDS_MISC);
    if (C.tid < 4) misc[C.tid] = 0u;
    __syncthreads();
    const int lo = args.ph_lo, hi = args.ph_hi;
    XcdBarrier bar; bar.bar = (unsigned*)(C.ws + WS_CTL) + CW_BAR; bar.x = 0; bar.st = misc;
    if (hi - lo > 1) bar = xcd_barrier_post((unsigned*)(C.ws + WS_CTL) + CW_BAR, misc);
#ifdef PH_ONLY
#define IN(k) ((k) == PH_ONLY)
#else
#define IN(k) (lo <= (k) && (k) < hi)
#endif
#define FILL(k) bq::service(C, true, (k), 0)
#define NEED(k, limit) do { if (IN(k) && (limit) > 0) bq::service(C, false, 0, (limit)); } while (0)
#define SEAM(k) do { if (IN(k) && IN((k) + 1)) xcd_barrier(bar); } while (0)
    unsigned char* ws = C.ws;
    const float* mod = (const float*)(ws + WS_MOD);
    float* X = C.out + O_Y;
    LAS unsigned char* glds = C.lds;

#ifdef PROBE_CLK
#define CLK_BEGIN(k) unsigned long long _t0 = 0, _r0 = 0; if ((k) == PROBE_CLK) { _t0 = __builtin_amdgcn_s_memtime(); _r0 = __builtin_amdgcn_s_memrealtime(); }
#define CLK_END(k) if ((k) == PROBE_CLK && blockIdx.x == 0 && threadIdx.x == 0) { const unsigned long long t1 = __builtin_amdgcn_s_memtime(), r1 = __builtin_amdgcn_s_memrealtime(); \
        const unsigned long long ticks = (t1 - _t0) * 1000ull / (r1 - _r0); while (__builtin_amdgcn_s_memrealtime() - r1 < ticks) __builtin_amdgcn_s_sleep(8); }
#else
#define CLK_BEGIN(k)
#define CLK_END(k)
#endif
    if (IN(0)) { phase_prologue(C); } SEAM(0);
    if (IN(1)) { phase_norm(C, C.in[0], C.in[1], C.in[11], mod, 0, (bf16_t*)(ws + A_HN)); } NEED(1, bq::E_IN); SEAM(1);
    if (IN(2)) {
        pg8::Gemm g{(const bf16_t*)(ws + A_HN), (const bf16_t*)(ws + WS_WIN), MT, 3072, 2048, 2048, 2048, 0, 0}; pg8::StaticOrder S; S.init(MT, 3072, C.G, (int)blockIdx.x);
        pg8::EpiZ E{(bf16_t*)(ws + A_GG), (bf16_t*)(ws + A_B2), (bf16_t*)(ws + A_B2) + (size_t)MT * 1024};
        CLK_BEGIN(2) pg8::gemm_phase<pg8::EpiZ>(glds, g, S, E); CLK_END(2) FILL(2); } SEAM(2);
    if (IN(3)) { phase_convpool(C); } NEED(3, bq::E_POOL); SEAM(3);
    if (IN(4)) {
        { pg8::Gemm g{(const bf16_t*)(ws + A_B3), (const bf16_t*)(ws + WS_WGATE), MT, 2048, 256, 1024, 256, 1, 256}; pg8::StaticOrder S; S.init(MT, 2048, C.G, (int)blockIdx.x);
          pg8::EpiGate E{(const bf16_t*)(ws + A_B3), (const float*)(ws + WS_SP), (float*)(ws + A_B4)};
          pg8::gemm_phase<pg8::EpiGate>(glds, g, S, E); }
        FILL(4); } SEAM(4);
    if (IN(5)) {
        { pg8::Gemm g{(const bf16_t*)(ws + A_B3) + (size_t)MT * 1024, (const bf16_t*)(ws + WS_WPOOL), MT, 1024, 256, 1024, 256, 0, 256}; pg8::StaticOrder S; S.init(MT, 1024, C.G, (int)blockIdx.x);
          pg8::EpiPool E{(bf16_t*)(ws + A_HN), C.in[22]};
          pg8::gemm_phase<pg8::EpiPool>(glds, g, S, E); }
        phase_scanA(C); FILL(5); } SEAM(5);
    if (IN(6)) { phase_scanB(C); } SEAM(6);
    if (IN(7)) { phase_scanC(C); } NEED(7, bq::E_OUTR); SEAM(7);
    if (IN(8)) {
        pg8::Gemm g{(const bf16_t*)(ws + A_HN), (const bf16_t*)(ws + WS_WOUTR), MT, 2048, 2048, 2048, 2048, 0, 0}; pg8::StaticOrder S; S.init(MT, 2048, C.G, (int)blockIdx.x);
        pg8::EpiBf16 E{(bf16_t*)(ws + A_B3), 2048};
        pg8::gemm_phase<pg8::EpiBf16>(glds, g, S, E); FILL(8); } SEAM(8);
#define PEER_BLOCK(P0, L) \
    if (IN(P0)) { phase_resid_norm(C, (L) == 0 ? C.in[0] : X, (L) == 0 ? C.in[1] : X + (size_t)MP * DM, (const bf16_t*)(ws + A_B3), X, C.in[12] + (L) * 2048, mod + (size_t)(L) * NSEQ * 12288, (bf16_t*)(ws + A_B2)); } NEED(P0, (L) == 0 ? bq::E_Q0 : bq::E_Q1); SEAM(P0); \
    if (IN(P0 + 1)) { pg8::Gemm g{(const bf16_t*)(ws + A_B2), (const bf16_t*)(ws + WS_WQ) + (size_t)(L) * 2048 * 2048, MT, 2048, 2048, 2048, 2048, 0, 0}; pg8::StaticOrder S; S.init(MT, 2048, C.G, (int)blockIdx.x); \
        pg8::EpiBf16 E{(bf16_t*)(ws + A_B3), 2048}; pg8::gemm_phase<pg8::EpiBf16>(glds, g, S, E); FILL(P0 + 1); } NEED(P0 + 1, (L) == 0 ? bq::E_KEYS : 0); SEAM(P0 + 1); \
    if (IN(P0 + 2)) { phase_topk(C, L); } NEED(P0 + 2, (L) == 0 ? bq::E_TAB0 : bq::NTOT); SEAM(P0 + 2); \
    if (IN(P0 + 3)) { CLK_BEGIN(P0 + 3) phase_gather(C, L); CLK_END(P0 + 3) }
    PEER_BLOCK(9, 0) NEED(12, bq::E_DKV); SEAM(12);
    if (IN(13)) {
        pg8::Gemm g{(const bf16_t*)(ws + A_HN), (const bf16_t*)(ws + WS_WDQKV), MT, 1024, 2048, 2048, 2048, 0, 0}; pg8::StaticOrder S; S.init(MT, 1024, C.G, (int)blockIdx.x);
        pg8::EpiF32 E{(float*)(ws + A_B3), 1024};
        pg8::gemm_phase<pg8::EpiF32>(glds, g, S, E); FILL(13); } NEED(13, bq::E_ROPE); SEAM(13);
    if (IN(14)) { phase_latent(C); } NEED(14, bq::E_UKV); SEAM(14);
    if (IN(15)) {
        { pg8::Gemm g{(const bf16_t*)(ws + A_CQ), (const bf16_t*)(ws + WS_WUQ), MT, 3072, 256, 256, 256, 0, 0};     pg8::StaticOrder S; S.init(MT, 3072, C.G, (int)blockIdx.x);
          pg8::EpiQ E{ws + A_Q8, (const float*)(ws + WS_ROPE)};
          pg8::gemm_phase<pg8::EpiQ, true>(glds, g, S, E); }
        { pg8::Gemm g{(const bf16_t*)(ws + A_CKV), (const bf16_t*)(ws + WS_WUKV), KVROWS, 4096, 128, 128, 128, 0, 0};     pg8::StaticOrder S; S.init(KVROWS, 4096, C.G, (int)blockIdx.x);
          pg8::EpiKV E{ws + A_KN, (bf16_t*)(ws + A_VV)};
          pg8::gemm_phase<pg8::EpiKV, true>(glds, g, S, E); } FILL(15); } SEAM(15);
    if (IN(16)) { CLK_BEGIN(16) att::attn_phase(C); CLK_END(16) } NEED(16, bq::E_OUTA); SEAM(16);
    if (IN(17)) {
        pg8::Gemm g{(const bf16_t*)(ws + A_HN), (const bf16_t*)(ws + WS_WOUTA), MT, 2048, 1024, 1024, 1024, 0, 0}; pg8::StaticOrder S; S.init(MT, 2048, C.G, (int)blockIdx.x);
        pg8::EpiBf16 E{(bf16_t*)(ws + A_B3), 2048};
        pg8::gemm_phase<pg8::EpiBf16, true>(glds, g, S, E); FILL(17); } SEAM(17);
    PEER_BLOCK(18, 1)
#undef PEER_BLOCK
#undef IN
#undef SEAM
#undef FILL
#undef NEED
}

extern "C" void kernel_launch(void* const* d_in, const int* in_sizes, int n_in, void* d_out, int out_size, void* d_ws, size_t ws_size, hipStream_t stream) {
    static int grid = 0;
    if (grid == 0) {
        if (n_in != 36 || out_size != (int)O_TOTAL || ws_size < WS_END) { fprintf(stderr, "kernel_launch: built for 36 inputs, %zu outputs, >= %zu B workspace; got n_in %d out %d ws %zu\n", (size_t)O_TOTAL, (size_t)WS_END, n_in, out_size, ws_size); grid = -1; return; }
        int dev = 0, cus = 0, per_cu = 0;
        if (hipGetDevice(&dev) != hipSuccess || hipDeviceGetAttribute(&cus, hipDeviceAttributeMultiprocessorCount, dev) != hipSuccess) { fprintf(stderr, "kernel_launch: device query failed\n"); grid = -1; return; }
        if (hipFuncSetAttribute((const void*)mega_fwd, hipFuncAttributeMaxDynamicSharedMemorySize, LDS_BYTES) != hipSuccess) { fprintf(stderr, "kernel_launch: hipFuncSetAttribute failed\n"); grid = -1; return; }
        if (hipOccupancyMaxActiveBlocksPerMultiprocessor(&per_cu, (const void*)mega_fwd, 512, LDS_BYTES) != hipSuccess || per_cu < 1) { fprintf(stderr, "kernel_launch: occupancy query says %d blocks per CU\n", per_cu); }
        (void)hipGetLastError();
        grid = cus;
    }
    if (grid < 0) return;
    (void)hipMemsetAsync(d_ws, 0, WS_ZERO_BYTES, stream);
    Args a{};
    for (int i = 0; i < 36; ++i) a.in[i] = (const float*)d_in[i];
    a.out = (float*)d_out; a.ws = (unsigned char*)d_ws;
#if MK_SPLIT
    for (int p = 0; p < N_PHASES; ++p) { a.ph_lo = p; a.ph_hi = p + 1; hipLaunchKernelGGL(mega_fwd, dim3(grid), dim3(512), LDS_BYTES, stream, a); }
#elif defined(PROBE_RANGES)
    { const int rg[][2] = {PROBE_RANGES};
      for (unsigned i = 0; i < sizeof(rg) / sizeof(rg[0]); ++i) { if (i) (void)hipMemsetAsync(d_ws, 0, 1 * MiB, stream); a.ph_lo = rg[i][0]; a.ph_hi = rg[i][1]; hipLaunchKernelGGL(mega_fwd, dim3(grid), dim3(512), LDS_BYTES, stream, a); } }
#else
    a.ph_lo = 0; a.ph_hi = N_PHASES; hipLaunchKernelGGL(mega_fwd, dim3(grid), dim3(512), LDS_BYTES, stream, a);
#endif
    const hipError_t le = hipPeekAtLastError();
    if (le != hipSuccess) fprintf(stderr, "kernel_launch: launch failed: %s\n", hipGetErrorName(le));
}
```
